# Optimizing an MI355X kernel written in HIP

```python
import jax
import jax.numpy as jnp
from jax import lax
import numpy as np

D_MODEL = 2048
BATCH = 4
SEQ = 2048
DEPTH = 2

CTX_LEN = 256
GRID_W = 64
N_MIXERS = 2
HEAD_SIZE = 64
N_HEADS = D_MODEL // HEAD_SIZE
DECAY_LORA = 96
ICLR_LORA = 96
GATE_LORA = 256
POOL_WINDOWS = (2, 4, 8, 16)
N_POOL_GROUPS = len(POOL_WINDOWS)
POOL_GROUP = D_MODEL // N_POOL_GROUPS
D_FF = 5632
N_EXPERTS = 8
TOP_K = 2
D_FF_EXPERT = 7168
N_RWKV_LAYERS = (DEPTH + N_MIXERS - 1) // N_MIXERS
N_POOL_LAYERS = DEPTH // N_MIXERS
N_DENSE_LAYERS = (DEPTH + 1) // 2
N_MOE_LAYERS = DEPTH // 2
DEEPNORM_ALPHA = (2.0 * DEPTH) ** 0.25
DEEPNORM_BETA = (8.0 * DEPTH) ** -0.25
LN_EPS = 1e-5
GN_EPS = 64e-5
POS_BASE = 10000.0

kernel_name = 'hybrid_rwkv7_pool_moe_flow_trunk'


def layer_norm(x, w, b):
    xf = x.astype(jnp.float32)
    mu = jnp.mean(xf, axis=-1, keepdims=True)
    var = jnp.mean(jnp.square(xf - mu), axis=-1, keepdims=True)
    return ((xf - mu) * lax.rsqrt(var + LN_EPS) * w + b).astype(x.dtype)


def post_norm(x, y, w, b):
    return layer_norm(DEEPNORM_ALPHA * x + y, w, b)


def adaln(cond, w_mod, b_mod):
    m = jax.nn.silu(cond) @ w_mod + b_mod
    return jnp.split(m, 6, axis=-1)


def grid_position_embedding(rows, d):
    quarter = d // 4
    omega = 1.0 / (POS_BASE ** (jnp.arange(quarter, dtype=jnp.float32) / quarter))
    row = jnp.repeat(jnp.arange(rows, dtype=jnp.float32), GRID_W)
    col = jnp.tile(jnp.arange(GRID_W, dtype=jnp.float32), rows)
    ar = row[:, None] * omega[None, :]
    ac = col[:, None] * omega[None, :]
    return jnp.concatenate([jnp.sin(ar), jnp.cos(ar), jnp.sin(ac), jnp.cos(ac)], axis=-1)


def centred_shift(h):
    hp = jnp.pad(h, ((0, 0), (1, 1), (0, 0)))
    return 0.5 * (hp[:, :-2] + hp[:, 2:]) - h


def to_heads(t):
    return t.reshape(t.shape[0], t.shape[1], N_HEADS, HEAD_SIZE).astype(jnp.float32)


def wkv7_scan(decay, k, v, kk, b, s0, r, reverse):
    emit = r is not None
    xs = (decay, k, v, kk, b) + ((r,) if emit else ())
    xs = tuple(jnp.moveaxis(t, 1, 0) for t in xs)

    def step(S, inp):
        w_t, k_t, v_t, kk_t, b_t = inp[:5]
        sa = jnp.einsum('bhvk,bhk->bhv', S, kk_t)
        S = S * w_t[:, :, None, :] - sa[..., None] * b_t[:, :, None, :] + v_t[..., None] * k_t[:, :, None, :]
        y = jnp.einsum('bhvk,bhk->bhv', S, inp[5]) if emit else None
        return S, y

    s_final, ys = lax.scan(step, s0, xs, reverse=reverse)
    return s_final, (jnp.moveaxis(ys, 0, 1) if emit else None)


def rwkv7_mixer(h_lat, h_ctx, mu, w_r, w_k, w_v, w_o, dw0, dw1, dw2, ia0, ia1, ia2,
                g1, g2, k_k, k_a, r_k, gn_w, gn_b, ctx_out):
    B = h_lat.shape[0]
    states = [jnp.zeros((B, N_HEADS, HEAD_SIZE, HEAD_SIZE), jnp.float32) for _ in range(2)]
    outs = []
    for h, emit in ((h_ctx, ctx_out), (h_lat, True)):
        T = h.shape[1]
        xx = centred_shift(h)
        mix = lambda n: h + xx * mu[n]
        xw, xk, xv, xa = mix(1), mix(2), mix(3), mix(4)
        k = xk @ w_k
        v = to_heads(xv @ w_v)
        r = to_heads(mix(0) @ w_r) if emit else None
        kk = to_heads(k * k_k)
        kk = kk / jnp.maximum(jnp.linalg.norm(kk, axis=-1, keepdims=True), 1e-12)
        y_sum, bonus = 0.0, 0.0
        for d in range(2):
            logw = -jax.nn.softplus(-(dw0[d] + jnp.tanh(xw @ dw1[d]) @ dw2[d])) - 0.5
            decay = to_heads(jnp.exp(-jnp.exp(logw.astype(jnp.float32))))
            a = jax.nn.sigmoid(ia0[d] + (xa @ ia1[d]) @ ia2[d])
            k_d = to_heads(k * (1.0 + (a - 1.0) * k_a))
            states[d], y = wkv7_scan(decay, k_d, v, kk, kk * to_heads(a), states[d], r, reverse=(d == 1))
            if emit:
                y_sum = y_sum + y
                bonus = bonus + jnp.sum(r * k_d * r_k, axis=-1, keepdims=True) * v
        if emit:
            mean = jnp.mean(y_sum, axis=-1, keepdims=True)
            var = jnp.mean(jnp.square(y_sum - mean), axis=-1, keepdims=True)
            o = ((y_sum - mean) * lax.rsqrt(var + GN_EPS)).reshape(B, T, D_MODEL) * gn_w + gn_b
            o = (o + bonus.reshape(B, T, D_MODEL)).astype(h.dtype)
            gate = jax.nn.sigmoid(mix(5) @ g1) @ g2
            outs.append((o * gate) @ w_o)
        else:
            outs.append(None)
    return outs[1], outs[0]


def multiscale_pool(h, w_pool, scale):
    B, T, D = h.shape
    hf = h.astype(jnp.float32)
    cs = jnp.pad(jnp.cumsum(hf, axis=1), ((0, 0), (1, 0), (0, 0)))
    t = jnp.arange(T)
    groups = []
    for g, win in enumerate(POOL_WINDOWS):
        lo = jnp.clip(t - win // 2, 0, T)
        hi = jnp.clip(t + win // 2, 0, T)
        sl = slice(g * POOL_GROUP, (g + 1) * POOL_GROUP)
        window_sum = cs[:, hi, sl] - cs[:, lo, sl]
        count = (hi - lo).astype(jnp.float32)[None, :, None]
        groups.append(window_sum / count - hf[:, :, sl])
    pooled = jnp.stack(groups, axis=2).astype(h.dtype)
    y = jnp.einsum('btgp,gpq->btgq', pooled, w_pool).reshape(B, T, D)
    return y * scale


def swiglu(h, w1, w3, w2):
    return (jax.nn.silu(h @ w1) * (h @ w3)) @ w2


def moe_swiglu(h, router, w1, w3, w2):
    probs = jax.nn.softmax((h @ router).astype(jnp.float32), axis=-1)
    top_p, top_i = lax.top_k(probs, TOP_K)
    top_p = top_p / jnp.sum(top_p, axis=-1, keepdims=True)
    combine = jnp.sum(jax.nn.one_hot(top_i, N_EXPERTS, dtype=jnp.float32) * top_p[..., None], axis=-2).astype(h.dtype)
    y = jnp.zeros_like(h)
    for e in range(N_EXPERTS):
        y = y + combine[..., e:e + 1] * swiglu(h, w1[e], w3[e], w2[e])
    return y


def setup_inputs(seed: int = 0) -> dict:
    key = jax.random.key(seed)
    keys = iter(jax.random.split(key, 48))

    def normal(shape, scale):
        return scale * jax.random.normal(next(keys), shape, jnp.float32)

    def uniform(shape, lo, hi):
        return jax.random.uniform(next(keys), shape, jnp.float32, lo, hi)

    D = D_MODEL
    s = D ** -0.5
    NR, NP, ND, NM = N_RWKV_LAYERS, N_POOL_LAYERS, N_DENSE_LAYERS, N_MOE_LAYERS
    return {
        'x': normal((BATCH, SEQ, D), 1.0),
        'c': normal((BATCH, D), 1.0),
        'ctx': normal((BATCH, CTX_LEN, D), 1.0),
        'c_ctx': normal((D,), 1.0),
        'w_mod': normal((DEPTH, D, 6 * D), 0.5 * s),
        'b_mod': normal((DEPTH, 6 * D), 0.02),
        'ln_w': 1.0 + normal((DEPTH, 2, D), 0.02),
        'ln_b': normal((DEPTH, 2, D), 0.02),
        'rwkv_mu': uniform((NR, 6, D), 0.0, 1.0),
        'rwkv_w_r': normal((NR, D, D), s),
        'rwkv_w_k': normal((NR, D, D), 0.5 * s),
        'rwkv_w_v': normal((NR, D, D), s),
        'rwkv_w_o': normal((NR, D, D), DEEPNORM_BETA * s),
        'rwkv_decay_w0': uniform((NR, 2, D), -6.0, -1.0),
        'rwkv_decay_w1': normal((NR, 2, D, DECAY_LORA), s),
        'rwkv_decay_w2': normal((NR, 2, DECAY_LORA, D), 0.1 * DECAY_LORA ** -0.5),
        'rwkv_iclr_a0': normal((NR, 2, D), 0.1),
        'rwkv_iclr_a1': normal((NR, 2, D, ICLR_LORA), s),
        'rwkv_iclr_a2': normal((NR, 2, ICLR_LORA, D), 0.5 * ICLR_LORA ** -0.5),
        'rwkv_gate_g1': normal((NR, D, GATE_LORA), s),
        'rwkv_gate_g2': normal((NR, GATE_LORA, D), GATE_LORA ** -0.5),
        'rwkv_k_k': 0.85 + normal((NR, D), 0.02),
        'rwkv_k_a': 1.0 + normal((NR, D), 0.02),
        'rwkv_r_k': -0.04 + normal((NR, N_HEADS, HEAD_SIZE), 0.01),
        'rwkv_gn_w': 1.0 + normal((NR, D), 0.02),
        'rwkv_gn_b': normal((NR, D), 0.02),
        'pool_w': normal((NP, N_POOL_GROUPS, POOL_GROUP, POOL_GROUP), DEEPNORM_BETA * POOL_GROUP ** -0.5),
        'pool_scale': 1.0 + normal((NP, D), 0.02),
        'ffn_w1': normal((ND, D, D_FF), s),
        'ffn_w3': normal((ND, D, D_FF), s),
        'ffn_w2': normal((ND, D_FF, D), DEEPNORM_BETA * D_FF ** -0.5),
        'moe_router': normal((NM, D, N_EXPERTS), s),
        'moe_w1': normal((NM, N_EXPERTS, D, D_FF_EXPERT), s),
        'moe_w3': normal((NM, N_EXPERTS, D, D_FF_EXPERT), s),
        'moe_w2': normal((NM, N_EXPERTS, D_FF_EXPERT, D), DEEPNORM_BETA * D_FF_EXPERT ** -0.5),
    }


def reference(x, c, ctx, c_ctx, w_mod, b_mod, ln_w, ln_b,
              rwkv_mu, rwkv_w_r, rwkv_w_k, rwkv_w_v, rwkv_w_o,
              rwkv_decay_w0, rwkv_decay_w1, rwkv_decay_w2,
              rwkv_iclr_a0, rwkv_iclr_a1, rwkv_iclr_a2,
              rwkv_gate_g1, rwkv_gate_g2, rwkv_k_k, rwkv_k_a, rwkv_r_k,
              rwkv_gn_w, rwkv_gn_b,
              pool_w, pool_scale,
              ffn_w1, ffn_w3, ffn_w2,
              moe_router, moe_w1, moe_w3, moe_w2):
    B, T, D = x.shape
    rows = T // GRID_W
    x = x + grid_position_embedding(rows, D).astype(x.dtype)[None]
    xc = ctx
    for i in range(DEPTH):
        mixer = i % N_MIXERS
        j = i // N_MIXERS
        f = i // 2
        ctx_later = any(l % N_MIXERS == 0 for l in range(i + 1, DEPTH))
        if i % 2 == 0:
            ffn = lambda t: swiglu(t, ffn_w1[f], ffn_w3[f], ffn_w2[f])
        else:
            ffn = lambda t: moe_swiglu(t, moe_router[f], moe_w1[f], moe_w3[f], moe_w2[f])

        sh1, sc1, g1, sh2, sc2, g2 = [t[:, None, :] for t in adaln(c, w_mod[i], b_mod[i])]
        h = x * (1.0 + sc1) + sh1
        if mixer == 0 or ctx_later:
            csh1, csc1, cg1, csh2, csc2, cg2 = adaln(c_ctx, w_mod[i], b_mod[i])
            hc = xc * (1.0 + csc1) + csh1
        if mixer == 0:
            y, yc = rwkv7_mixer(h, hc, rwkv_mu[j], rwkv_w_r[j], rwkv_w_k[j], rwkv_w_v[j], rwkv_w_o[j],
                                rwkv_decay_w0[j], rwkv_decay_w1[j], rwkv_decay_w2[j],
                                rwkv_iclr_a0[j], rwkv_iclr_a1[j], rwkv_iclr_a2[j],
                                rwkv_gate_g1[j], rwkv_gate_g2[j], rwkv_k_k[j], rwkv_k_a[j], rwkv_r_k[j],
                                rwkv_gn_w[j], rwkv_gn_b[j], ctx_out=ctx_later)
        else:
            y = multiscale_pool(h, pool_w[j], pool_scale[j])
            yc = multiscale_pool(hc, pool_w[j], pool_scale[j]) if ctx_later else None
        x = post_norm(x, g1 * y, ln_w[i, 0], ln_b[i, 0])
        h = x * (1.0 + sc2) + sh2
        x = post_norm(x, g2 * ffn(h), ln_w[i, 1], ln_b[i, 1])
        if ctx_later:
            xc = post_norm(xc, cg1 * yc, ln_w[i, 0], ln_b[i, 0])
            hc = xc * (1.0 + csc2) + csh2
            xc = post_norm(xc, cg2 * ffn(hc), ln_w[i, 1], ln_b[i, 1])
    return x
```

```cpp
#include <hip/hip_runtime.h>
#include <cstdio>
#include <cstdint>

#ifndef MK_N_LAUNCHES
#define MK_N_LAUNCHES 1
#endif

#define LAS __attribute__((address_space(3)))
#define PG8_LAS __attribute__((address_space(3)))
typedef unsigned short bf16_t;
typedef short bf16x8 __attribute__((ext_vector_type(8)));
typedef float f32x4 __attribute__((ext_vector_type(4)));
typedef float f32x2 __attribute__((ext_vector_type(2)));
typedef unsigned u32x4 __attribute__((ext_vector_type(4)));
typedef unsigned u32x2 __attribute__((ext_vector_type(2)));
typedef int i32x8 __attribute__((ext_vector_type(8)));
typedef int i32x4 __attribute__((ext_vector_type(4)));

constexpr int D = 2048, NB = 4, T = 2048, TC = 256, NH = 32, HS = 64;
constexpr int ML = NB * T;
constexpr int MC = NB * TC;
constexpr int MT = ML + MC;
constexpr int DFF = 5632, DFE = 7168, NE = 8;
constexpr int MOD_N = 6 * D;
constexpr int MROWS_PAD = 2 * ML + NE * 256;
constexpr float ALPHA = 1.41421356237309515f;
constexpr float LN_EPS = 1e-5f, GN_EPS = 64e-5f;

__device__ __forceinline__ unsigned f2bf(float f) { unsigned u = __builtin_bit_cast(unsigned, f); return (u + 0x7fffu + ((u >> 16) & 1u)) >> 16; }
typedef __bf16 bf16x2v __attribute__((ext_vector_type(2)));
__device__ __forceinline__ unsigned pk2(float lo, float hi) { const f32x2 v = {lo, hi}; return __builtin_bit_cast(unsigned, __builtin_convertvector(v, bf16x2v)); }
__device__ __forceinline__ float clamp8(float x) { return fminf(fmaxf(x, -440.f), 440.f); }
__device__ __forceinline__ unsigned pk4_fp8(float a, float b, float c, float d) { int v = __builtin_amdgcn_cvt_pk_fp8_f32(clamp8(a), clamp8(b), 0, false); v = __builtin_amdgcn_cvt_pk_fp8_f32(clamp8(c), clamp8(d), v, true); return (unsigned)v; }
__device__ __forceinline__ float bflo(unsigned w) { return __builtin_bit_cast(float, w << 16); }
__device__ __forceinline__ float bfhi(unsigned w) { return __builtin_bit_cast(float, w & 0xffff0000u); }
__device__ __forceinline__ float fexp(float x) { return __builtin_amdgcn_exp2f(x * 1.44269504088896341f); }
__device__ __forceinline__ float flog(float x) { return __builtin_amdgcn_logf(x) * 0.69314718055994531f; }
__device__ __forceinline__ float sigmoidf_(float x) { return 1.0f / (1.0f + fexp(-x)); }
__device__ __forceinline__ float siluf_(float x) { return x / (1.0f + fexp(-x)); }
__device__ __forceinline__ float tanhf_(float x) { return 1.0f - 2.0f / (1.0f + fexp(2.0f * x)); }
__device__ __forceinline__ float wave_sum(float v) {
#pragma unroll
    for (int o = 1; o < 64; o <<= 1) v += __shfl_xor(v, o);
    return v;
}
__device__ __forceinline__ int lane_id() { int l; asm volatile("v_mbcnt_lo_u32_b32 %0, -1, 0\n\tv_mbcnt_hi_u32_b32 %0, -1, %0" : "=v"(l)); return l; }
template <int CTRL> __device__ __forceinline__ float dpp_f(float v) { return __builtin_bit_cast(float, __builtin_amdgcn_update_dpp(0, __builtin_bit_cast(int, v), CTRL, 0xF, 0xF, true)); }
__device__ __forceinline__ float sum8(float v) {
    v += dpp_f<0xB1>(v);
    v += dpp_f<0x4E>(v);
    v += dpp_f<0x141>(v);
    return v;
}
__device__ __forceinline__ const char* uptr(const void* p) {
    unsigned long long v = (unsigned long long)p;
    unsigned lo = (unsigned)__builtin_amdgcn_readfirstlane((int)(unsigned)v), hi = (unsigned)__builtin_amdgcn_readfirstlane((int)(unsigned)(v >> 32));
    return (const char*)(((unsigned long long)hi << 32) | lo);
}

namespace pg8 {
constexpr int BM = 256, BK = 64, HALF = 128, HTB = HALF * BK * 2  , STAGE_BYTES = 8 * HTB, NXCD = 8, WGM = 8;
__host__ __device__ __forceinline__ int lds_byte(int r, int c) { const int st = (r >> 4) * 2 + (c >> 5), rr = r & 15, cc = c & 31, ob = rr * 64 + cc * 2; return st * 1024 + (ob ^ (((ob >> 9) & 1) << 5)); }
__host__ __device__ __forceinline__ void stage_rc(int b, int& R, int& C) { const int st = b / 1024, sb = b % 1024, swz = sb ^ (((sb >> 9) & 1) << 5); R = (st >> 1) * 16 + swz / 64; C = (st & 1) * 32 + (swz % 64) / 2; }
__host__ __device__ __forceinline__ int perm32(int rho) { const int n = rho >> 4, i = rho & 15; return 8 * (i >> 2) + 4 * n + (i & 3); }
__device__ __forceinline__ unsigned cvt_pk_bf16(float lo, float hi) { unsigned r; asm volatile("v_cvt_pk_bf16_f32 %0, %1, %2" : "=v"(r) : "v"(lo), "v"(hi)); return r; }

struct Unit { const char* A; const char* B; bf16_t* O; const float* bias; int pm, pn, ldc, act; };
struct Shape { int ldaB, ldbB, nt, sc; };
__host__ __device__ __forceinline__ Shape shape_bf16(int lda, int ldb, int K) { return Shape{2 * lda, 2 * ldb, K / 64, 0}; }
__host__ __device__ __forceinline__ Shape shape_fp8(int lda, int ldb, int K, int ea, int eb) { return Shape{lda, ldb, K / 128, ((127 - ea) << 8) | (127 - eb)}; }

__device__ __forceinline__ void tile_of(int l, int nM, int nN, int& pm, int& pn) {
    const int nwg = nM * nN; int wgid = l;
    { const int q = nwg / NXCD, r = nwg % NXCD, xcd = wgid % NXCD, off = wgid / NXCD; wgid = (xcd < r ? xcd * (q + 1) : r * (q + 1) + (xcd - r) * q) + off; }
    const int nig = WGM * nN, gid = wgid / nig, fm = gid * WGM, gsz = (nM - fm) < WGM ? (nM - fm) : WGM;
    pm = fm + ((wgid % nig) % gsz); pn = (wgid % nig) / gsz;
}

enum Act { ACT_NONE = 0, ACT_TANH = 1, ACT_SIGMOID = 2, ACT_EW = 3, ACT_BIAS_SIGMOID = 4, ACT_COLSCALE = 5 };
__device__ __forceinline__ float act_apply(float v, float b, int act) {
    if (act == ACT_TANH) return tanhf_(v);
    if (act == ACT_SIGMOID) return sigmoidf_(v);
    if (act == ACT_EW) { const float z = -(v + b); const float sp = (z > 20.f) ? z : flog(1.0f + fexp(z)); return fexp(-sp - 0.5f); }
    if (act == ACT_BIAS_SIGMOID) return sigmoidf_(v + b);
    if (act == ACT_COLSCALE) return v * b;
    return v;
}
struct EpiAct {
    static constexpr bool PERM = true, AFTER_DRAIN = false;
    __device__ __forceinline__ void operator()(const f32x4 (&acc)[2][2][4][2], const Unit& u, int wr, int wc) const {
        const int lane_ = lane_id(), fr = lane_ & 15, fq = lane_ >> 4;
        const int row0 = u.pm * BM + wr * 64 + fr, col0 = u.pn * BM + wc * 32 + 8 * fq; const int act = u.act;
        f32x4 bv[2][2];
#pragma unroll
        for (int bj = 0; bj < 2; ++bj)
#pragma unroll
            for (int n = 0; n < 2; ++n) bv[bj][n] = u.bias ? *(const f32x4*)(u.bias + col0 + bj * HALF + 4 * n) : (f32x4){0.f, 0.f, 0.f, 0.f};
#pragma unroll
        for (int ai = 0; ai < 2; ++ai)
#pragma unroll
            for (int m = 0; m < 4; ++m) { bf16_t* rowp = u.O + (size_t)(row0 + ai * HALF + m * 16) * u.ldc + col0;
#pragma unroll
                for (int bj = 0; bj < 2; ++bj) { f32x4 v0 = acc[ai][bj][m][0], v1 = acc[ai][bj][m][1];
                    if (act != ACT_NONE) {
#pragma unroll
                        for (int j = 0; j < 4; ++j) { v0[j] = act_apply(v0[j], bv[bj][0][j], act); v1[j] = act_apply(v1[j], bv[bj][1][j], act); } }
                    u32x4 w; w.x = cvt_pk_bf16(v0[0], v0[1]); w.y = cvt_pk_bf16(v0[2], v0[3]); w.z = cvt_pk_bf16(v1[0], v1[1]); w.w = cvt_pk_bf16(v1[2], v1[3]);
                    *(u32x4*)(rowp + bj * HALF) = w; } }
    }
};
struct EpiSwiglu {
    static constexpr bool PERM = true, AFTER_DRAIN = false;
    __device__ __forceinline__ void operator()(const f32x4 (&acc)[2][2][4][2], const Unit& u, int wr, int wc) const {
        const int lane_ = lane_id(), fr = lane_ & 15, fq = lane_ >> 4;
        const int row0 = u.pm * BM + wr * 64 + fr, col0 = u.pn * HALF + wc * 32 + 8 * fq;
#pragma unroll
        for (int ai = 0; ai < 2; ++ai)
#pragma unroll
            for (int m = 0; m < 4; ++m) { bf16_t* rowp = u.O + (size_t)(row0 + ai * HALF + m * 16) * u.ldc + col0;
                f32x4 o0, o1;
#pragma unroll
                for (int j = 0; j < 4; ++j) { o0[j] = siluf_(acc[ai][0][m][0][j]) * acc[ai][1][m][0][j]; o1[j] = siluf_(acc[ai][0][m][1][j]) * acc[ai][1][m][1][j]; }
                u32x4 w; w.x = cvt_pk_bf16(o0[0], o0[1]); w.y = cvt_pk_bf16(o0[2], o0[3]); w.z = cvt_pk_bf16(o1[0], o1[1]); w.w = cvt_pk_bf16(o1[2], o1[3]);
                *(u32x4*)rowp = w; }
    }
};

struct EpiSwiglu8 {
    static constexpr bool PERM = true, AFTER_DRAIN = false;
    __device__ __forceinline__ void operator()(const f32x4 (&acc)[2][2][4][2], const Unit& u, int wr, int wc) const {
        const int lane_ = lane_id(), fr = lane_ & 15, fq = lane_ >> 4;
        const int row0 = u.pm * BM + wr * 64 + fr, col0 = u.pn * HALF + wc * 32 + 8 * fq;
#pragma unroll
        for (int ai = 0; ai < 2; ++ai)
#pragma unroll
            for (int m = 0; m < 4; ++m) { unsigned char* rowp = (unsigned char*)u.O + (size_t)(row0 + ai * HALF + m * 16) * u.ldc + col0;
                f32x4 o0, o1;
#pragma unroll
                for (int j = 0; j < 4; ++j) { o0[j] = siluf_(acc[ai][0][m][0][j]) * acc[ai][1][m][0][j] * 8.0f; o1[j] = siluf_(acc[ai][0][m][1][j]) * acc[ai][1][m][1][j] * 8.0f; }
                u32x2 w; w.x = pk4_fp8(o0[0], o0[1], o0[2], o0[3]); w.y = pk4_fp8(o1[0], o1[1], o1[2], o1[3]);
                *(u32x2*)rowp = w; }
    }
};

template <class Epi, class Sched, bool ALIGN_EPI = true, bool SP2 = true, bool FP8 = false>
__device__ __forceinline__ void gemm_phase(PG8_LAS unsigned char* lds, const Shape g, const Sched& S, const Epi& E) {
    const int lane = lane_id(), wid = __builtin_amdgcn_readfirstlane((int)(threadIdx.x >> 6)), tid = wid * 64 + lane, wr = wid >> 2, wc = wid & 3, fr = lane & 15, fq = lane >> 4;
    const int nt = g.nt;
    unsigned voffA[2], voffB[2];
#pragma unroll
    for (int i = 0; i < 2; ++i) { int R, C; stage_rc(tid * 16 + i * 8192, R, C); const int Rb = Epi::PERM ? ((R & ~31) + perm32(R & 31)) : R;
        voffA[i] = (unsigned)(R * g.ldaB + C * 2); voffB[i] = (unsigned)(Rb * g.ldbB + C * 2); }
    const size_t kstep = (size_t)(BK * 2);
    const size_t hstepA = (size_t)HALF * g.ldaB, hstepB = (size_t)HALF * g.ldbB;
    const unsigned ldsw = (unsigned)wid * 1024u;
    const int aoff = lds_byte(wr * 64 + fr, fq * 8), boff = lds_byte(wc * 32 + fr, fq * 8);
#define PG8_SA(b, h) (((b) * 2 + (h)) * HTB)
#define PG8_SB(b, h) ((4 + (b) * 2 + (h)) * HTB)
#define PG8_STAGE(bufoff, gbase, voff) do { _Pragma("unroll") for (int _i = 0; _i < 2; ++_i) \
        __builtin_amdgcn_global_load_lds((const unsigned*)((const char*)(gbase) + (voff)[_i]), (PG8_LAS unsigned*)(lds + (bufoff) + ldsw + _i * 8192), 16, 0, 0); } while (0)
#define PG8_LDA(dst, b, h) do { _Pragma("unroll") for (int m = 0; m < 4; ++m) _Pragma("unroll") for (int k = 0; k < 2; ++k) dst[m][k] = *(const PG8_LAS bf16x8*)(lds + PG8_SA(b, h) + aoff + m * 2048 + k * 1024); } while (0)
#define PG8_LDB(dst, b, h) do { _Pragma("unroll") for (int n = 0; n < 2; ++n) _Pragma("unroll") for (int k = 0; k < 2; ++k) dst[n][k] = *(const PG8_LAS bf16x8*)(lds + PG8_SB(b, h) + boff + n * 2048 + k * 1024); } while (0)
#define PG8_MMA(ai, bj, At, Bt) do { __builtin_amdgcn_s_setprio(1); _Pragma("unroll") for (int m = 0; m < 4; ++m) _Pragma("unroll") for (int n = 0; n < 2; ++n) { \
        if constexpr (FP8) { const i32x4 b0_ = __builtin_bit_cast(i32x4, Bt[n][0]), b1_ = __builtin_bit_cast(i32x4, Bt[n][1]), a0_ = __builtin_bit_cast(i32x4, At[m][0]), a1_ = __builtin_bit_cast(i32x4, At[m][1]); \
            const i32x8 B8_ = __builtin_shufflevector(b0_, b1_, 0, 1, 2, 3, 4, 5, 6, 7), A8_ = __builtin_shufflevector(a0_, a1_, 0, 1, 2, 3, 4, 5, 6, 7); \
            asm volatile("v_mfma_scale_f32_16x16x128_f8f6f4 %0, %1, %2, %0, %3, %3 op_sel:[0,1,0] op_sel_hi:[0,0,0]" : "+v"(acc[ai][bj][m][n]) : "v"(B8_), "v"(A8_), "v"(g.sc)); } \
        else { _Pragma("unroll") for (int k = 0; k < 2; ++k) acc[ai][bj][m][n] = __builtin_amdgcn_mfma_f32_16x16x32_bf16(Bt[n][k], At[m][k], acc[ai][bj][m][n], 0, 0, 0); } } \
        __builtin_amdgcn_s_setprio(0); } while (0)
#define PG8_WAIT_V(n) asm volatile("s_waitcnt vmcnt(" #n ")" ::: "memory")
#define PG8_WAIT_L(n) asm volatile("s_waitcnt lgkmcnt(" #n ")" ::: "memory")
#define PG8_BAR __builtin_amdgcn_s_barrier()
#define PG8_SCHED __builtin_amdgcn_sched_barrier(0)
    Unit cur, nxt; int ui = 0;
    if (!S.next(0, cur)) return;
    f32x4 acc[2][2][4][2];
#pragma unroll
    for (int a = 0; a < 2; ++a)
#pragma unroll
        for (int b = 0; b < 2; ++b)
#pragma unroll
            for (int m = 0; m < 4; ++m)
#pragma unroll
                for (int n = 0; n < 2; ++n) acc[a][b][m][n] = (f32x4){0.f, 0.f, 0.f, 0.f};
    bf16x8 At[4][2], B0[2][2], B1[2][2];
    const char* cA = cur.A; const char* cB = cur.B;
    S.a_ready(cur);
    if constexpr (SP2) {
        PG8_STAGE(PG8_SB(0, 0), cB, voffB); PG8_STAGE(PG8_SB(0, 1), cB + hstepB, voffB); PG8_STAGE(PG8_SA(0, 0), cA, voffA); PG8_STAGE(PG8_SA(0, 1), cA + hstepA, voffA);
        if (wr == 1) PG8_BAR;
        PG8_WAIT_V(2); PG8_BAR;
        PG8_STAGE(PG8_SB(1, 0), cB + kstep, voffB); PG8_STAGE(PG8_SA(1, 0), cA + kstep, voffA); PG8_STAGE(PG8_SB(1, 1), cB + hstepB + kstep, voffB);
        PG8_WAIT_V(6); PG8_BAR;
    } else {
        PG8_STAGE(PG8_SB(0, 0), cB, voffB); PG8_STAGE(PG8_SA(0, 0), cA, voffA); PG8_STAGE(PG8_SB(0, 1), cB + hstepB, voffB); PG8_STAGE(PG8_SA(0, 1), cA + hstepA, voffA);
        if (wr == 1) PG8_BAR;
        PG8_WAIT_V(4); PG8_BAR;
        PG8_STAGE(PG8_SB(1, 0), cB + kstep, voffB); PG8_STAGE(PG8_SA(1, 0), cA + kstep, voffA); PG8_STAGE(PG8_SB(1, 1), cB + hstepB + kstep, voffB);
        PG8_WAIT_V(6); PG8_BAR;
    }
    for (;;) {
        const bool has_next = S.next(ui + 1, nxt);
        const char* nA = has_next ? nxt.A : cA; const char* nB = has_next ? nxt.B : cB;
        for (int t = 0; t < nt; t += 2) {
            const bool last = (t == nt - 2);
            const char* a1 = cA + (size_t)(t + 1) * kstep;
            const char* a2 = last ? nA : cA + (size_t)(t + 2) * kstep; const char* b2 = last ? nB : cB + (size_t)(t + 2) * kstep;
            const char* a3 = a2 + kstep; const char* b3 = b2 + kstep;
            if (last && has_next) S.a_ready(nxt);
            if constexpr (SP2) {
            PG8_LDB(B0, 0, 0); PG8_LDB(B1, 0, 1); PG8_SCHED; PG8_LDA(At, 0, 0); PG8_STAGE(PG8_SA(1, 1), a1 + hstepA, voffA);
            PG8_WAIT_V(8); PG8_WAIT_L(0); PG8_BAR; PG8_MMA(0, 0, At, B0); PG8_MMA(0, 1, At, B1); PG8_BAR; PG8_SCHED;
            PG8_LDA(At, 0, 1); PG8_STAGE(PG8_SB(0, 0), b2, voffB); PG8_STAGE(PG8_SB(0, 1), b2 + hstepB, voffB); PG8_STAGE(PG8_SA(0, 0), a2, voffA);
            PG8_WAIT_V(8); PG8_WAIT_L(0); PG8_BAR; PG8_MMA(1, 0, At, B0); PG8_MMA(1, 1, At, B1); PG8_BAR; PG8_SCHED;
            PG8_LDB(B0, 1, 0); PG8_LDB(B1, 1, 1); PG8_SCHED; PG8_LDA(At, 1, 0); PG8_STAGE(PG8_SA(0, 1), a2 + hstepA, voffA);
            PG8_WAIT_V(8); PG8_WAIT_L(0); PG8_BAR; PG8_MMA(0, 0, At, B0); PG8_MMA(0, 1, At, B1); PG8_BAR; PG8_SCHED;
            PG8_LDA(At, 1, 1); PG8_STAGE(PG8_SB(1, 0), b3, voffB); PG8_STAGE(PG8_SB(1, 1), b3 + hstepB, voffB); PG8_STAGE(PG8_SA(1, 0), a3, voffA);
            PG8_WAIT_V(8); PG8_WAIT_L(0); PG8_BAR; PG8_MMA(1, 0, At, B0); PG8_MMA(1, 1, At, B1); PG8_BAR; PG8_SCHED;
            } else {
            PG8_LDB(B0, 0, 0); PG8_SCHED; PG8_LDA(At, 0, 0); PG8_STAGE(PG8_SA(1, 1), a1 + hstepA, voffA);
            PG8_WAIT_L(8); PG8_BAR; PG8_WAIT_L(0); PG8_MMA(0, 0, At, B0); PG8_BAR; PG8_SCHED;
            PG8_LDB(B1, 0, 1); PG8_STAGE(PG8_SB(0, 0), b2, voffB);
            PG8_BAR; PG8_WAIT_L(0); PG8_MMA(0, 1, At, B1); PG8_BAR;
            PG8_LDA(At, 0, 1); PG8_STAGE(PG8_SA(0, 0), a2, voffA);
            PG8_BAR; PG8_WAIT_L(0); PG8_MMA(1, 0, At, B0); PG8_BAR; PG8_SCHED;
            PG8_STAGE(PG8_SB(0, 1), b2 + hstepB, voffB);
            PG8_WAIT_V(6); PG8_BAR; PG8_MMA(1, 1, At, B1); PG8_BAR;
            PG8_LDB(B0, 1, 0); PG8_SCHED; PG8_LDA(At, 1, 0); PG8_STAGE(PG8_SA(0, 1), a2 + hstepA, voffA);
            PG8_WAIT_L(8); PG8_BAR; PG8_WAIT_L(0); PG8_MMA(0, 0, At, B0); PG8_BAR; PG8_SCHED;
            PG8_LDB(B1, 1, 1); PG8_STAGE(PG8_SB(1, 0), b3, voffB);
            PG8_BAR; PG8_WAIT_L(0); PG8_MMA(0, 1, At, B1); PG8_BAR;
            PG8_LDA(At, 1, 1); PG8_STAGE(PG8_SA(1, 0), a3, voffA);
            PG8_BAR; PG8_WAIT_L(0); PG8_MMA(1, 0, At, B0); PG8_BAR; PG8_SCHED;
            PG8_STAGE(PG8_SB(1, 1), b3 + hstepB, voffB);
            PG8_WAIT_V(6); PG8_BAR; PG8_MMA(1, 1, At, B1); PG8_BAR;
            }
        }
        if constexpr (ALIGN_EPI) { if (wr == 0) PG8_BAR; }
        if constexpr (FP8) asm volatile("s_nop 15\n\ts_nop 15\n\ts_nop 15" ::: "memory");
        if constexpr (!Epi::AFTER_DRAIN) { E(acc, cur, wr, wc); S.done(cur); }
        if (!has_next) break;
#pragma unroll
        for (int a = 0; a < 2; ++a)
#pragma unroll
            for (int b = 0; b < 2; ++b)
#pragma unroll
                for (int m = 0; m < 4; ++m)
#pragma unroll
                    for (int n = 0; n < 2; ++n) acc[a][b][m][n] = (f32x4){0.f, 0.f, 0.f, 0.f};
        cur = nxt; cA = nA; cB = nB; ++ui;
        if constexpr (ALIGN_EPI) { if (wr == 1) PG8_BAR; }
    }
    PG8_WAIT_V(0);
    if constexpr (!ALIGN_EPI) { if (wr == 0) PG8_BAR; }
    PG8_BAR;
    if constexpr (Epi::AFTER_DRAIN) { E.fused(acc, cur, wr, wc, fr, fq, lds, wid, lane); S.done(cur); }
#undef PG8_SA
#undef PG8_SB
#undef PG8_STAGE
#undef PG8_LDA
#undef PG8_LDB
#undef PG8_MMA
#undef PG8_WAIT_V
#undef PG8_WAIT_L
#undef PG8_BAR
#undef PG8_SCHED
}

}

#ifndef MOE_FP8
#define MOE_FP8 1
#endif
#ifndef FFN_FP8
#define FFN_FP8 0
#endif
constexpr size_t MiB = 1u << 20;
constexpr size_t WS_CTL = 0, CTL_ZERO_BYTES = 1 * MiB;
constexpr size_t WS_MOD = 1 * MiB;
constexpr size_t WS_TOK = 2 * MiB;
constexpr size_t WS_SB  = 3 * MiB;
constexpr size_t WS_POS = 6 * MiB;
constexpr size_t WS_XR  = 22 * MiB;
constexpr size_t WS_W   = 86 * MiB;
constexpr size_t W_WR = WS_W, W_WK = W_WR + 8 * MiB, W_WV = W_WK + 8 * MiB, W_WO = W_WV + 8 * MiB;
constexpr size_t W_WLD = W_WO + 8 * MiB, W_ALD = W_WLD + 1 * MiB, W_G1 = W_ALD + 1 * MiB;
constexpr size_t W_WLU = W_G1 + 1 * MiB, W_ALU = W_WLU + 2 * MiB, W_G2 = W_ALU + 2 * MiB;
constexpr size_t W_PW = W_G2 + 1 * MiB;
constexpr size_t W_F13 = W_PW + 2 * MiB;
constexpr size_t W_F2 = W_F13 + 44 * MiB;
constexpr size_t W_M13 = W_F2 + 22 * MiB;
constexpr size_t W_M2 = W_M13 + 448 * MiB;
constexpr size_t WS_A = W_M2 + 224 * MiB;
constexpr size_t A_A6 = WS_A, A6_STRIDE = 36 * MiB;
constexpr size_t A_R = WS_A + 216 * MiB, A_KX = WS_A + 248 * MiB, A_V = WS_A + 284 * MiB;
constexpr size_t A_LW = WS_A + 320 * MiB, A_LA = WS_A + 325 * MiB, A_G1O = WS_A + 330 * MiB;
constexpr size_t A_EW = WS_A + 336 * MiB, A_AA = WS_A + 408 * MiB;
constexpr size_t A_GATE = WS_A + 480 * MiB, A_YD = WS_A + 512 * MiB;
constexpr size_t A_AO = WS_A + 580 * MiB, A_YO = WS_A + 612 * MiB;
constexpr size_t A_H2 = WS_A, A_U = WS_A + 32 * MiB, A_YF = WS_A + 120 * MiB, A_HP = WS_A + 152 * MiB, A_PP = WS_A + 184 * MiB, A_YP = WS_A + 216 * MiB, A_H2B = WS_A + 248 * MiB;
constexpr size_t A_HG = WS_A + 280 * MiB, A_UG = WS_A + 352 * MiB, A_Y2 = WS_A + 604 * MiB;
constexpr size_t WS_END = WS_A + 676 * MiB;
static_assert(A_YO + 32 * MiB <= WS_END && A_Y2 + (size_t)MROWS_PAD * D * 2 <= WS_END && A_UG + (size_t)MROWS_PAD * DFE * 2 <= A_Y2 && A_HG + (size_t)MROWS_PAD * D * 2 <= A_UG, "ws map");
static_assert(W_M13 + (size_t)NE * 2 * DFE * D * 2 == W_M2 && W_M2 + (size_t)NE * D * DFE * 2 == WS_A && W_F13 + (size_t)2 * DFF * D * 2 == W_F2, "weight map");
constexpr int CW_BAR = 4096;
constexpr int CW_GCNT = 16384;

constexpr int LDS_BYTES = 147456;
constexpr int MISC_OFF = 131072 + 320;

#define XB_TMO      128
#define XB_XCNT(j)  (256  + 64 * (j))
#define XB_XSUB(j)  (1280 + 64 * (j))
#define XB_XGEN(j)  (2304 + 64 * (j))
#define XB_TOP      3328
#define XB_TOPGEN   3392
#define XCD_BAR_WORDS 3456
#define XB_SPIN_CAP (1u << 18)
__device__ __forceinline__ unsigned xb_ld(unsigned* p)              { return __hip_atomic_load(p, __ATOMIC_RELAXED, __HIP_MEMORY_SCOPE_AGENT); }
__device__ __forceinline__ unsigned xb_add(unsigned* p, unsigned v) { return __hip_atomic_fetch_add(p, v, __ATOMIC_RELAXED, __HIP_MEMORY_SCOPE_AGENT); }
__device__ __forceinline__ unsigned xb_xcc_id() { return (unsigned)__builtin_amdgcn_s_getreg((3 << 11) | 20) & 0xFu; }
#define XB_SPIN(cond, bar) do { unsigned _sp = 0; while (cond) { __builtin_amdgcn_s_sleep(1); \
    if ((++_sp & 255u) == 0u) { if (xb_ld(&(bar)[XB_TMO])) break; if (_sp > XB_SPIN_CAP) { atomicAdd(&(bar)[XB_TMO], 1u); break; } } } } while (0)
struct XcdBarrier { unsigned* bar; unsigned x; volatile LAS unsigned* st; };
__device__ __forceinline__ XcdBarrier xcd_barrier_post(unsigned* bar, volatile LAS unsigned* st) {
    XcdBarrier b; b.bar = bar; b.x = xb_xcc_id(); b.st = st;
    if (threadIdx.x == 0) (void)xb_add(&bar[XB_XCNT(b.x)], 1u);
    return b;
}
__device__ __forceinline__ void xcd_barrier_complete(unsigned* bar, unsigned x, unsigned& nloc, unsigned& nx) {
    const unsigned G = gridDim.x * gridDim.y * gridDim.z;
    unsigned sum, cnt, mine, sp = 0u;
    for (;;) {
        sum = 0u; cnt = 0u; mine = 0u;
#pragma unroll
        for (unsigned j = 0; j < 16; ++j) { const unsigned c = xb_ld(&bar[XB_XCNT(j)]); sum += c; cnt += (c > 0u) ? 1u : 0u; mine = (j == x) ? c : mine; }
        if (sum == G) break;
        __builtin_amdgcn_s_sleep(1);
        if ((++sp & 255u) == 0u) { if (xb_ld(&bar[XB_TMO])) break; if (sp > XB_SPIN_CAP) { atomicAdd(&bar[XB_TMO], 1u); break; } }
    }
    nloc = mine > 0u ? mine : 1u; nx = cnt > 0u ? cnt : 1u;
}
__device__ __forceinline__ void xcd_barrier(const XcdBarrier& b) {
    asm volatile("s_waitcnt vmcnt(0)" ::: "memory");
    __syncthreads();
    if (threadIdx.x == 0) {
        unsigned* bar = b.bar;
        __builtin_amdgcn_s_waitcnt(0);
        unsigned nloc = b.st[0], nx = b.st[1];
        if (nloc == 0u) { xcd_barrier_complete(bar, b.x, nloc, nx); b.st[0] = nloc; b.st[1] = nx; }
        const unsigned old = xb_add(&bar[XB_XSUB(b.x)], 1u);
        const unsigned gen = old / nloc;
        if (old + 1u == (gen + 1u) * nloc) {
            __builtin_amdgcn_fence(__ATOMIC_RELEASE, "agent");
            asm volatile("s_waitcnt vmcnt(0)" ::: "memory");
            const unsigned og = xb_add(&bar[XB_TOP], 1u);
            const unsigned tg = og / nx;
            if (og + 1u == (tg + 1u) * nx) xb_add(&bar[XB_TOPGEN], 1u);
            else XB_SPIN(xb_ld(&bar[XB_TOPGEN]) == tg, bar);
            __builtin_amdgcn_fence(__ATOMIC_ACQUIRE, "agent");
            xb_add(&bar[XB_XGEN(b.x)], 1u);
            asm volatile("s_waitcnt vmcnt(0)" ::: "memory");
        } else {
            XB_SPIN(xb_ld(&bar[XB_XGEN(b.x)]) == gen, bar);
            __builtin_amdgcn_fence(__ATOMIC_ACQUIRE, "agent");
            asm volatile("s_waitcnt vmcnt(0)" ::: "memory");
        }
    }
    __syncthreads();
}

struct Args { const float* in[35]; float* out; unsigned char* ws; int ph_lo, ph_hi, li, pad; };
static_assert(sizeof(Args) == 35 * 8 + 8 + 8 + 16, "Args has no padding");
enum In { I_X = 0, I_C, I_CTX, I_CCTX, I_WMOD, I_BMOD, I_LNW, I_LNB, I_MU, I_WR, I_WK, I_WV, I_WO, I_DW0, I_DW1, I_DW2, I_IA0, I_IA1, I_IA2, I_G1, I_G2, I_KK, I_KA, I_RK, I_GNW, I_GNB,
          I_POOLW, I_POOLS, I_FW1, I_FW3, I_FW2, I_ROUTER, I_MW1, I_MW3, I_MW2 };
struct Frame {
    LAS unsigned char* lds; int wave, vcu, G, gw, NGW;
    unsigned char* ws; unsigned* ctl;
};
#define LDS_WAIT() asm volatile("s_waitcnt lgkmcnt(0)" ::: "memory")
__device__ __forceinline__ void unpack8(const u32x4 w, float (&f)[8]) { f[0] = bflo(w.x); f[1] = bfhi(w.x); f[2] = bflo(w.y); f[3] = bfhi(w.y); f[4] = bflo(w.z); f[5] = bfhi(w.z); f[6] = bflo(w.w); f[7] = bfhi(w.w); }

__device__ __forceinline__ void p0_mod(const Frame& F, const Args& a) {
    const int lane = lane_id(), tid = F.wave * 64 + lane; (void)tid;
    LAS float* sc = (LAS float*)F.lds;
    LAS float* red = (LAS float*)(F.lds + 40960);
    const float* c = a.in[I_C]; const float* cc = a.in[I_CCTX];
    for (int i = tid; i < 5 * D; i += 512) { const int j = i / D, k = i % D; const float v = j < 4 ? c[j * D + k] : cc[k]; sc[i] = siluf_(v); }
    __syncthreads();
    float* MOD = (float*)(F.ws + WS_MOD);
    const int x = lane & 15, q = lane >> 4;
    for (int u = blockIdx.x; u < 2 * (MOD_N / 64); u += F.G) {
        const int l = u / (MOD_N / 64), cb = u % (MOD_N / 64);
        const float* W = a.in[I_WMOD] + (size_t)l * D * MOD_N + cb * 64 + 4 * x;
        float acc[5][4];
#pragma unroll
        for (int j = 0; j < 5; ++j)
#pragma unroll
            for (int e = 0; e < 4; ++e) acc[j][e] = 0.f;
#pragma unroll 8
        for (int i = 0; i < 64; ++i) {
            const int k = F.wave * 256 + 4 * i + q;
            const f32x4 w = *(const f32x4*)(W + (size_t)k * MOD_N);
#pragma unroll
            for (int j = 0; j < 5; ++j) { const float s = sc[j * D + k];
#pragma unroll
                for (int e = 0; e < 4; ++e) acc[j][e] += s * w[e]; }
        }
#pragma unroll
        for (int j = 0; j < 5; ++j)
#pragma unroll
            for (int e = 0; e < 4; ++e) { float v = acc[j][e]; v += __shfl_xor(v, 16); v += __shfl_xor(v, 32); acc[j][e] = v; }
        __syncthreads();
        if (q == 0) {
#pragma unroll
            for (int j = 0; j < 5; ++j)
#pragma unroll
                for (int e = 0; e < 4; ++e) red[(F.wave * 5 + j) * 64 + 4 * x + e] = acc[j][e];
        }
        __syncthreads();
        if (tid < 320) { const int j = tid / 64, col = tid % 64; float s = 0.f;
#pragma unroll
            for (int w = 0; w < 8; ++w) s += red[(w * 5 + j) * 64 + col];
            MOD[(size_t)(l * 5 + j) * MOD_N + cb * 64 + col] = s + a.in[I_BMOD][l * MOD_N + cb * 64 + col]; }
    }
    __syncthreads();
}
__device__ __forceinline__ void p0_pos(const Frame& F) {
    const int lane = lane_id(), tid = F.wave * 64 + lane; (void)tid;
    float* POS = (float*)(F.ws + WS_POS);
    for (int t = F.gw; t < T; t += F.NGW) {
        const float frow = (float)(t >> 6), fcol = (float)(t & 63);
#pragma unroll
        for (int j = 0; j < 8; ++j) { const int c0 = 4 * lane + 256 * j; f32x4 o;
#pragma unroll
            for (int e = 0; e < 4; ++e) { const int c = c0 + e, qi = c >> 9, i = c & 511;
                const float omega = fexp(-(float)i * (9.21034037197618f / 512.0f));
                float rev = ((qi < 2) ? frow : fcol) * omega * 0.15915494309189535f;
                rev -= floorf(rev);
                o[e] = (qi & 1) ? __builtin_amdgcn_cosf(rev) : __builtin_amdgcn_sinf(rev); }
            *(f32x4*)(POS + (size_t)t * D + c0) = o; }
    }
}
constexpr int TI_RWKV = 4096, TI_F1 = TI_RWKV + 2816, TI_F3 = TI_F1 + 2816, TI_F2 = TI_F3 + 2816, TI_POOL = TI_F2 + 256, TI_M1 = TI_POOL + 8 * 3584, TI_M3 = TI_M1 + 8 * 3584, TI_M2 = TI_M3 + 8 * 3584;
struct TrItem { const float* src; unsigned char* dst; int src_ld, dst_ld  , k0, n0, drow0, f8; float sc; };
__device__ __forceinline__ TrItem tr_decode(const Frame& F, const Args& a, int it) {
    TrItem t; t.f8 = 0; t.sc = 1.0f;
    if (it < TI_RWKV) { const int m = it >> 10, r = it & 1023, kb = r >> 5, nb = r & 31;
        t.src = a.in[I_WR + m]; t.src_ld = D; t.dst = F.ws + W_WR + (size_t)m * 8 * MiB; t.dst_ld = 2 * D; t.k0 = 64 * kb; t.n0 = 64 * nb; t.drow0 = 64 * nb; }
    else if (it < TI_F3) { const int w3 = it >= TI_F1, r = it - (w3 ? TI_F1 : TI_RWKV), kb = r / 88, nb = r % 88, n0 = 64 * nb;
        t.src = a.in[w3 ? I_FW3 : I_FW1]; t.src_ld = DFF; t.dst = F.ws + W_F13; t.dst_ld = FFN_FP8 ? D : 2 * D; t.k0 = 64 * kb; t.n0 = n0; t.drow0 = (n0 >> 7) * 256 + (n0 & 127) + 128 * w3; t.f8 = FFN_FP8; t.sc = FFN_FP8 ? 64.0f : 1.0f; }
    else if (it < TI_F2) { const int r = it - TI_F3, kb = r >> 5, nb = r & 31;
        t.src = a.in[I_FW2]; t.src_ld = D; t.dst = F.ws + W_F2; t.dst_ld = FFN_FP8 ? DFF : 2 * DFF; t.k0 = 64 * kb; t.n0 = 64 * nb; t.drow0 = 64 * nb; t.f8 = FFN_FP8; t.sc = FFN_FP8 ? 256.0f : 1.0f; }
    else if (it < TI_POOL) { const int r = it - TI_F2, g = r >> 6, kb = (r >> 3) & 7, nb = r & 7;
        t.src = a.in[I_POOLW] + (size_t)g * 512 * 512; t.src_ld = 512; t.dst = F.ws + W_PW + (size_t)g * 512 * 512 * 2; t.dst_ld = 2 * 512; t.k0 = 64 * kb; t.n0 = 64 * nb; t.drow0 = 64 * nb; }
    else if (it < TI_M3) { const int w3 = it >= TI_M1, r = it - (w3 ? TI_M1 : TI_POOL), e = r / 3584, rr = r % 3584, kb = rr / 112, nb = rr % 112, n0 = 64 * nb;
        t.src = a.in[w3 ? I_MW3 : I_MW1] + (size_t)e * D * DFE; t.src_ld = DFE; t.dst_ld = MOE_FP8 ? D : 2 * D; t.dst = F.ws + W_M13 + (size_t)e * 2 * DFE * t.dst_ld; t.k0 = 64 * kb; t.n0 = n0;
        t.drow0 = (n0 >> 7) * 256 + (n0 & 127) + 128 * w3; t.f8 = MOE_FP8; t.sc = MOE_FP8 ? 64.0f : 1.0f; }
    else { const int r = it - TI_M3, e = r / 3584, rr = r % 3584, kb = rr >> 5, nb = rr & 31;
        t.src = a.in[I_MW2] + (size_t)e * DFE * D; t.src_ld = D; t.dst_ld = MOE_FP8 ? DFE : 2 * DFE; t.dst = F.ws + W_M2 + (size_t)e * D * t.dst_ld; t.k0 = 64 * kb; t.n0 = 64 * nb; t.drow0 = 64 * nb; t.f8 = MOE_FP8; t.sc = MOE_FP8 ? 256.0f : 1.0f; }
    return t;
}
__device__ __forceinline__ void tr_load(const TrItem& t, f32x4 (&r)[4][4], int lane) {
    const int x = lane & 15, q = lane >> 4; const float* p = t.src + (size_t)(t.k0 + 4 * q) * t.src_ld + t.n0 + 4 * x;
#pragma unroll
    for (int i = 0; i < 4; ++i)
#pragma unroll
        for (int s = 0; s < 4; ++s) r[i][s] = __builtin_nontemporal_load((const f32x4*)(p + (size_t)(16 * i + s) * t.src_ld));
}
__device__ __forceinline__ void tr_store(const TrItem& t, const f32x4 (&r)[4][4], LAS unsigned* scr, int lane) {
    const int x = lane & 15, q = lane >> 4;
    if (t.f8) {
#pragma unroll
        for (int i = 0; i < 4; ++i)
#pragma unroll
            for (int jj = 0; jj < 4; ++jj) scr[(4 * x + jj) * 17 + 4 * i + q] = pk4_fp8(r[i][0][jj] * t.sc, r[i][1][jj] * t.sc, r[i][2][jj] * t.sc, r[i][3][jj] * t.sc);
        LDS_WAIT();
        const int c = lane & 3;
#pragma unroll
        for (int rr = 0; rr < 4; ++rr) { const int n = (lane >> 2) + 16 * rr; const LAS unsigned* s = scr + n * 17 + 4 * c;
            u32x4 o; o.x = s[0]; o.y = s[1]; o.z = s[2]; o.w = s[3];
            *(u32x4*)(t.dst + (size_t)(t.drow0 + n) * t.dst_ld + t.k0 + 16 * c) = o; }
    } else {
#pragma unroll
        for (int i = 0; i < 4; ++i)
#pragma unroll
            for (int jj = 0; jj < 4; ++jj) { scr[(4 * x + jj) * 33 + 8 * i + 2 * q] = pk2(r[i][0][jj], r[i][1][jj]); scr[(4 * x + jj) * 33 + 8 * i + 2 * q + 1] = pk2(r[i][2][jj], r[i][3][jj]); }
        LDS_WAIT();
        const int c = lane & 7;
#pragma unroll
        for (int rr = 0; rr < 8; ++rr) { const int n = (lane >> 3) + 8 * rr; const LAS unsigned* s = scr + n * 33 + 4 * c;
            u32x4 o; o.x = s[0]; o.y = s[1]; o.z = s[2]; o.w = s[3];
            *(u32x4*)(t.dst + (size_t)(t.drow0 + n) * t.dst_ld + 2 * (t.k0 + 8 * c)) = o; }
    }
    LDS_WAIT();
}
__device__ __forceinline__ void p0_transpose_range(const Frame& F, const Args& a, int lo, int hi, int gw, int ngw, LAS unsigned* scr) {
    const int lane = lane_id();
    int it = lo + gw; if (it >= hi) return;
    f32x4 ra[4][4], rb[4][4];
    TrItem ta = tr_decode(F, a, it), tb = ta; tr_load(ta, ra, lane);
    for (;;) {
        const int i2 = it + ngw; const bool h2 = i2 < hi;
        if (h2) { tb = tr_decode(F, a, i2); tr_load(tb, rb, lane); }
        tr_store(ta, ra, scr, lane);
        if (!h2) break;
        const int i3 = i2 + ngw; const bool h3 = i3 < hi;
        if (h3) { ta = tr_decode(F, a, i3); tr_load(ta, ra, lane); }
        tr_store(tb, rb, scr, lane);
        if (!h3) break;
        it = i3;
    }
}
__device__ __forceinline__ void p0_small(const Frame& F, const Args& a) {
    const int lane = lane_id(), tid = F.wave * 64 + lane; (void)tid;
    bf16_t* WLD = (bf16_t*)(F.ws + W_WLD); bf16_t* ALD = (bf16_t*)(F.ws + W_ALD); bf16_t* G1T = (bf16_t*)(F.ws + W_G1);
    bf16_t* WLU = (bf16_t*)(F.ws + W_WLU); bf16_t* ALU = (bf16_t*)(F.ws + W_ALU); bf16_t* G2T = (bf16_t*)(F.ws + W_G2);
    const int gt = F.gw * 64 + lane, NT_ = F.NGW * 64;
    for (int i = gt; i < 256 * D; i += NT_) { const int n = i >> 11, k = i & 2047;
        float w = 0.f, v = 0.f;
        if (n < 192) { const int d = n >= 96, nn = n - 96 * d; w = a.in[I_DW1][((size_t)d * D + k) * 96 + nn]; v = a.in[I_IA1][((size_t)d * D + k) * 96 + nn]; }
        WLD[i] = (bf16_t)f2bf(w); ALD[i] = (bf16_t)f2bf(v); G1T[i] = (bf16_t)f2bf(a.in[I_G1][(size_t)k * 256 + n]); }
    for (int i = gt; i < 2 * D * 256; i += NT_) { const int n = i >> 8, k = i & 255, d = n >> 11, cidx = n & 2047, kk = k - 96 * d;
        float w = 0.f, v = 0.f;
        if (kk >= 0 && kk < 96) { w = a.in[I_DW2][((size_t)d * 96 + kk) * D + cidx]; v = a.in[I_IA2][((size_t)d * 96 + kk) * D + cidx]; }
        WLU[i] = (bf16_t)f2bf(w); ALU[i] = (bf16_t)f2bf(v); }
    for (int i = gt; i < D * 256; i += NT_) { const int n = i >> 8, k = i & 255; G2T[i] = (bf16_t)f2bf(a.in[I_G2][(size_t)k * D + n]); }
}

__device__ __forceinline__ void p1_mix(const Frame& F, const Args& a) {
    const int lane = lane_id(), tid = F.wave * 64 + lane; (void)tid;
    const float* MOD = (const float*)(F.ws + WS_MOD); const float* POS = (const float*)(F.ws + WS_POS);
    float* XR = (float*)(F.ws + WS_XR);
    for (int blk = F.gw; blk < MT / 8; blk += F.NGW) {
        const int m0 = blk * 8; const bool lat = m0 < ML;
        int t0, Tseq, modrow; const float* xs;
        if (lat) { t0 = m0 % T; Tseq = T; modrow = m0 / T; xs = a.in[I_X] + (size_t)m0 * D; }
        else { const int mm = m0 - ML; t0 = mm % TC; Tseq = TC; modrow = 4; xs = a.in[I_CTX] + (size_t)mm * D; }
        const float* sh = MOD + (size_t)modrow * MOD_N; const float* scp = sh + D;
        const float* ps = POS + (size_t)t0 * D;
        for (int j = 0; j < 8; ++j) {
            const int c = 4 * lane + 256 * j;
            const f32x4 shv = *(const f32x4*)(sh + c); const f32x4 scv = *(const f32x4*)(scp + c) + 1.0f;
            f32x4 mu[6];
#pragma unroll
            for (int n = 0; n < 6; ++n) mu[n] = *(const f32x4*)(a.in[I_MU] + n * D + c);
            f32x4 hm1 = (f32x4){0.f, 0.f, 0.f, 0.f}, h0, x00;
            if (t0 > 0) { f32x4 xv = *(const f32x4*)(xs - D + c); if (lat) xv += *(const f32x4*)(ps - D + c); hm1 = xv * scv + shv; }
            { x00 = *(const f32x4*)(xs + c); if (lat) x00 += *(const f32x4*)(ps + c); h0 = x00 * scv + shv; }
            for (int r = 0; r < 8; ++r) {
                f32x4 hp1 = (f32x4){0.f, 0.f, 0.f, 0.f}, x0n = (f32x4){0.f, 0.f, 0.f, 0.f};
                if (t0 + r + 1 < Tseq) { x0n = *(const f32x4*)(xs + (size_t)(r + 1) * D + c); if (lat) x0n += *(const f32x4*)(ps + (size_t)(r + 1) * D + c); hp1 = x0n * scv + shv; }
                const f32x4 xx = (hm1 + hp1) * 0.5f - h0;
                const size_t o = (size_t)(m0 + r) * D + c;
#pragma unroll
                for (int n = 0; n < 6; ++n) { if (!lat && (n == 0 || n == 5)) continue;
                    const f32x4 v = h0 + xx * mu[n]; u32x2 w; w.x = pk2(v[0], v[1]); w.y = pk2(v[2], v[3]);
                    *(u32x2*)((bf16_t*)(F.ws + A_A6 + (size_t)n * A6_STRIDE) + o) = w; }
                if (lat) *(f32x4*)(XR + o) = x00;
                hm1 = h0; h0 = hp1; x00 = x0n;
            }
        }
    }
}

__device__ __forceinline__ void p4_scan(const Frame& F, const Args& a) {
    const int lane = lane_id(), tid = F.wave * 64 + lane; (void)tid;
    LAS float* OP = (LAS float*)F.lds;
    LAS float* YS = (LAS float*)(F.lds + 49152);
    const bf16_t* KX = (const bf16_t*)(F.ws + A_KX); const bf16_t* VV = (const bf16_t*)(F.ws + A_V); const bf16_t* RR = (const bf16_t*)(F.ws + A_R);
    const bf16_t* EW = (const bf16_t*)(F.ws + A_EW); const bf16_t* AA = (const bf16_t*)(F.ws + A_AA);
    const int tl = tid >> 5, cp = tid & 31, vi = tid >> 3, kg = tid & 7;
    for (int s = blockIdx.x; s < NB * NH * 2; s += F.G) {
        const int b = s >> 6, h = (s >> 1) & 31, d = s & 1;
        const int ch = h * HS + 2 * cp;
        const float kkc0 = a.in[I_KK][ch], kkc1 = a.in[I_KK][ch + 1], kac0 = a.in[I_KA][ch], kac1 = a.in[I_KA][ch + 1], rkc0 = a.in[I_RK][ch], rkc1 = a.in[I_RK][ch + 1];
        bf16_t* YD = (bf16_t*)(F.ws + A_YD + (size_t)d * 32 * MiB); float* SB = (float*)(F.ws + WS_SB) + (size_t)d * ML * NH;
        float S[8];
#pragma unroll
        for (int j = 0; j < 8; ++j) S[j] = 0.f;
        unsigned rk = 0, rv = 0, rr = 0, re = 0, ra = 0;
#define SCAN_ROW0(ci) (((ci) < 16) ? (ML + b * TC + (d ? 15 - (ci) : (ci)) * 16) : (b * T + (d ? 127 - ((ci) - 16) : ((ci) - 16)) * 16))
#define SCAN_LOAD(ci) do { const int row_ = SCAN_ROW0(ci) + tl; const size_t o_ = (size_t)row_ * D + ch, o2_ = (size_t)row_ * (2 * D) + d * D + ch; \
        rk = *(const unsigned*)(KX + o_); rv = *(const unsigned*)(VV + o_); rr = ((ci) >= 16) ? *(const unsigned*)(RR + o_) : 0u; re = *(const unsigned*)(EW + o2_); ra = *(const unsigned*)(AA + o2_); } while (0)
#define SCAN_PREP(ci) do { LAS float* B_ = OP + ((ci) & 1) * 6144 + tl * 64 + 2 * cp; \
        const float k0 = bflo(rk), k1 = bfhi(rk), q0 = k0 * kkc0, q1 = k1 * kkc1; float n2 = q0 * q0 + q1 * q1; \
        n2 += __shfl_xor(n2, 1); n2 += __shfl_xor(n2, 2); n2 += __shfl_xor(n2, 4); n2 += __shfl_xor(n2, 8); n2 += __shfl_xor(n2, 16); \
        const float inv = 1.0f / fmaxf(sqrtf(n2), 1e-12f), kn0 = q0 * inv, kn1 = q1 * inv; \
        const float a0 = bflo(ra), a1 = bfhi(ra), kd0 = k0 * (1.0f + (a0 - 1.0f) * kac0), kd1 = k1 * (1.0f + (a1 - 1.0f) * kac1); \
        const float r0 = bflo(rr), r1 = bfhi(rr); \
        *(LAS f32x2*)(B_ + 0 * 1024) = (f32x2){kn0, kn1}; \
        *(LAS f32x2*)(B_ + 1 * 1024) = (f32x2){fexp(-bflo(re)), fexp(-bfhi(re))}; \
        *(LAS f32x2*)(B_ + 2 * 1024) = (f32x2){kn0 * a0, kn1 * a1}; \
        *(LAS f32x2*)(B_ + 3 * 1024) = (f32x2){kd0, kd1}; \
        *(LAS f32x2*)(B_ + 4 * 1024) = (f32x2){r0, r1}; \
        *(LAS f32x2*)(B_ + 5 * 1024) = (f32x2){bflo(rv), bfhi(rv)}; \
        if ((ci) >= 16) { float sb = r0 * kd0 * rkc0 + r1 * kd1 * rkc1; \
            sb += __shfl_xor(sb, 1); sb += __shfl_xor(sb, 2); sb += __shfl_xor(sb, 4); sb += __shfl_xor(sb, 8); sb += __shfl_xor(sb, 16); \
            if (cp == 0) SB[(size_t)(SCAN_ROW0(ci) + tl) * NH + h] = sb; } } while (0)
        __syncthreads();
        SCAN_LOAD(0); SCAN_PREP(0);
        __syncthreads();
        for (int ci = 0; ci < 144; ++ci) {
            if (ci + 1 < 144) SCAN_LOAD(ci + 1);
            const LAS float* B = OP + (ci & 1) * 6144; LAS float* Y = YS + (ci & 1) * 1024;
#pragma unroll 4
            for (int st = 0; st < 16; ++st) {
                const int tk = d ? 15 - st : st; const LAS float* p = B + tk * 64 + 8 * kg;
                const f32x4 kkA = *(const LAS f32x4*)(p), kkB = *(const LAS f32x4*)(p + 4);
                const f32x4 wA = *(const LAS f32x4*)(p + 1024), wB = *(const LAS f32x4*)(p + 1028);
                const f32x4 bA = *(const LAS f32x4*)(p + 2048), bB = *(const LAS f32x4*)(p + 2052);
                const f32x4 dA = *(const LAS f32x4*)(p + 3072), dB = *(const LAS f32x4*)(p + 3076);
                const f32x4 rA = *(const LAS f32x4*)(p + 4096), rB = *(const LAS f32x4*)(p + 4100);
                const float v = B[5 * 1024 + tk * 64 + vi];
                float sa = (S[0] * kkA[0] + S[1] * kkA[1]) + (S[2] * kkA[2] + S[3] * kkA[3]) + (S[4] * kkB[0] + S[5] * kkB[1]) + (S[6] * kkB[2] + S[7] * kkB[3]);
                sa = sum8(sa);
#pragma unroll
                for (int j = 0; j < 4; ++j) { S[j] = S[j] * wA[j] + (v * dA[j] - sa * bA[j]); S[4 + j] = S[4 + j] * wB[j] + (v * dB[j] - sa * bB[j]); }
                float y = (S[0] * rA[0] + S[1] * rA[1]) + (S[2] * rA[2] + S[3] * rA[3]) + (S[4] * rB[0] + S[5] * rB[1]) + (S[6] * rB[2] + S[7] * rB[3]);
                y = sum8(y);
                if (kg == 0) Y[tk * 64 + vi] = y;
            }
            if (ci + 1 < 144) SCAN_PREP(ci + 1);
            __syncthreads();
            if (ci >= 16) { const f32x2 yv = *(const LAS f32x2*)(Y + tl * 64 + 2 * cp);
                *(unsigned*)(YD + (size_t)(SCAN_ROW0(ci) + tl) * D + ch) = pk2(yv.x, yv.y); }
        }
#undef SCAN_ROW0
#undef SCAN_LOAD
#undef SCAN_PREP
    }
    __syncthreads();
}

constexpr int SL_KA = 0, SL_RM = 2048, SL_BK = 4096, SL_VC = 8192, SL_ARK = 10240, SL_AAK = 11264, SL_TN = 11776, SL_GC = 12288, SL_BYTES = 12544;
constexpr int SC_PAR = 8 * SL_BYTES;
typedef short s16x8 __attribute__((ext_vector_type(8)));
__device__ __forceinline__ s16x8 mk8(unsigned a, unsigned b, unsigned c, unsigned d) { u32x4 v; v.x = a; v.y = b; v.z = c; v.w = d; return __builtin_bit_cast(s16x8, v); }
__device__ __forceinline__ f32x4 mfma16(s16x8 a, s16x8 b, f32x4 c) { return __builtin_amdgcn_mfma_f32_16x16x32_bf16(a, b, c, 0, 0, 0); }
__device__ __forceinline__ s16x8 mk_d(const f32x4 x) { return mk8(pk2(x[0], x[1]), pk2(x[2], x[3]), 0u, 0u); }
__device__ __forceinline__ void p4_scan2(const Frame& F, const Args& a, unsigned char* yd_base, float* sb_base) {
    const int lane = lane_id(), tt = lane & 15, q = lane >> 4;
    const bf16_t* KX = (const bf16_t*)(F.ws + A_KX); const bf16_t* VV = (const bf16_t*)(F.ws + A_V); const bf16_t* RR = (const bf16_t*)(F.ws + A_R);
    const bf16_t* EW = (const bf16_t*)(F.ws + A_EW); const bf16_t* AA = (const bf16_t*)(F.ws + A_AA);
    LAS unsigned char* slot_w = F.lds + F.wave * SL_BYTES;
    LAS float* PAR = (LAS float*)(F.lds + SC_PAR);
    s16x8 SelF[2];
#pragma unroll
    for (int sel = 0; sel < 2; ++sel) { unsigned w[4];
#pragma unroll
        for (int jj = 0; jj < 4; ++jj) { const int j0 = 2 * jj, j1 = 2 * jj + 1; const bool h0 = (q == (tt >> 2)) && (j0 == 4 * sel + (tt & 3)), h1 = (q == (tt >> 2)) && (j1 == 4 * sel + (tt & 3));
            w[jj] = (h0 ? 0x3f80u : 0u) | (h1 ? 0x3f800000u : 0u); }
        SelF[sel] = mk8(w[0], w[1], w[2], w[3]); }
    for (int s = blockIdx.x; s < NB * NH * 2; s += F.G) {
        const int b = s >> 6, h = (s >> 1) & 31, d = s & 1;
        bf16_t* YD = (bf16_t*)(yd_base + (size_t)d * 32 * MiB); float* SB = sb_base + (size_t)d * ML * NH;
        __syncthreads();
        if (F.wave == 0) { PAR[lane] = a.in[I_KK][h * HS + lane]; PAR[64 + lane] = a.in[I_KA][h * HS + lane]; PAR[128 + lane] = a.in[I_RK][h * HS + lane]; }
        __syncthreads();
        f32x4 G[4];
#pragma unroll
        for (int tk = 0; tk < 4; ++tk) G[tk] = (f32x4){0.f, 0.f, 0.f, 0.f};
#define S2_ROW0(ci) (((ci) < 16) ? (ML + b * TC + (d ? 15 - (ci) : (ci)) * 16) : (b * T + (d ? 127 - ((ci) - 16) : ((ci) - 16)) * 16))
        u32x2 rk[4], rv[4], rr[4], re[4], ra[4];
#define S2_LOAD(ci) do { const int row_ = S2_ROW0(ci) + (d ? 15 - tt : tt); const size_t o_ = (size_t)row_ * D + h * HS + 4 * q, o2_ = (size_t)row_ * (2 * D) + d * D + h * HS + 4 * q; \
        _Pragma("unroll") for (int g_ = 0; g_ < 4; ++g_) { rk[g_] = *(const u32x2*)(KX + o_ + 16 * g_); rv[g_] = *(const u32x2*)(VV + o_ + 16 * g_); \
            rr[g_] = ((ci) >= 16) ? *(const u32x2*)(RR + o_ + 16 * g_) : (u32x2){0u, 0u}; re[g_] = *(const u32x2*)(EW + o2_ + 16 * g_); ra[g_] = *(const u32x2*)(AA + o2_ + 16 * g_); } } while (0)
        S2_LOAD(F.wave);
        for (int rnd = 0; rnd < 18; ++rnd) {
            const int ci = rnd * 8 + F.wave; const bool lat = rnd >= 2;
            {
                float kf[4][4], af[4][4], ef[4][4], vf[4][4], rf[4][4];
#pragma unroll
                for (int g = 0; g < 4; ++g) {
                    kf[g][0] = bflo(rk[g].x); kf[g][1] = bfhi(rk[g].x); kf[g][2] = bflo(rk[g].y); kf[g][3] = bfhi(rk[g].y);
                    af[g][0] = bflo(ra[g].x); af[g][1] = bfhi(ra[g].x); af[g][2] = bflo(ra[g].y); af[g][3] = bfhi(ra[g].y);
                    ef[g][0] = bflo(re[g].x); ef[g][1] = bfhi(re[g].x); ef[g][2] = bflo(re[g].y); ef[g][3] = bfhi(re[g].y);
                    vf[g][0] = bflo(rv[g].x); vf[g][1] = bfhi(rv[g].x); vf[g][2] = bflo(rv[g].y); vf[g][3] = bfhi(rv[g].y);
                    rf[g][0] = bflo(rr[g].x); rf[g][1] = bfhi(rr[g].x); rf[g][2] = bflo(rr[g].y); rf[g][3] = bfhi(rr[g].y); }
                float kkv[4][4]; float n2 = 0.f;
#pragma unroll
                for (int g = 0; g < 4; ++g) { const f32x4 kc = *(const LAS f32x4*)(PAR + 16 * g + 4 * q);
#pragma unroll
                    for (int i = 0; i < 4; ++i) { kkv[g][i] = kf[g][i] * kc[i]; n2 += kkv[g][i] * kkv[g][i]; } }
                n2 += __shfl_xor(n2, 16); n2 += __shfl_xor(n2, 32);
                const float inv = 1.0f / fmaxf(sqrtf(n2), 1e-12f);
                float sb = 0.f;
                unsigned KaP[4][2], BmP[4][2], KmP[4][2], RmP[4][2], VP[4][2]; f32x4 gend[4];
#pragma unroll
                for (int g = 0; g < 4; ++g) { const f32x4 kac = *(const LAS f32x4*)(PAR + 64 + 16 * g + 4 * q), rkc = *(const LAS f32x4*)(PAR + 128 + 16 * g + 4 * q);
                    float ka_[4], bm_[4], km_[4], rm_[4];
#pragma unroll
                    for (int i = 0; i < 4; ++i) {
                        float L = ef[g][i];
                        L += dpp_f<0x111>(L); L += dpp_f<0x112>(L); L += dpp_f<0x114>(L); L += dpp_f<0x118>(L);
                        const float gt = fexp(-L), gi = fexp(L), gm1 = fexp(ef[g][i] - L);
                        const float kk = kkv[g][i] * inv, kd = kf[g][i] * (1.0f + (af[g][i] - 1.0f) * kac[i]);
                        ka_[i] = kk * gm1; bm_[i] = kk * af[g][i] * gi; km_[i] = kd * gi; rm_[i] = rf[g][i] * gt;
                        sb += rf[g][i] * kd * rkc[i]; gend[g][i] = gt; }
                    KaP[g][0] = pk2(ka_[0], ka_[1]); KaP[g][1] = pk2(ka_[2], ka_[3]); BmP[g][0] = pk2(bm_[0], bm_[1]); BmP[g][1] = pk2(bm_[2], bm_[3]);
                    KmP[g][0] = pk2(km_[0], km_[1]); KmP[g][1] = pk2(km_[2], km_[3]); RmP[g][0] = pk2(rm_[0], rm_[1]); RmP[g][1] = pk2(rm_[2], rm_[3]);
                    VP[g][0] = rv[g].x; VP[g][1] = rv[g].y; }
                if (lat) { sb += __shfl_xor(sb, 16); sb += __shfl_xor(sb, 32); if (q == 0) SB[(size_t)(S2_ROW0(ci) + (d ? 15 - tt : tt)) * NH + h] = sb; }
                s16x8 KaF[2], BmF[2], KmF[2], RmF[2], VF[2];
#pragma unroll
                for (int kb = 0; kb < 2; ++kb) { KaF[kb] = mk8(KaP[2 * kb][0], KaP[2 * kb][1], KaP[2 * kb + 1][0], KaP[2 * kb + 1][1]); BmF[kb] = mk8(BmP[2 * kb][0], BmP[2 * kb][1], BmP[2 * kb + 1][0], BmP[2 * kb + 1][1]);
                    KmF[kb] = mk8(KmP[2 * kb][0], KmP[2 * kb][1], KmP[2 * kb + 1][0], KmP[2 * kb + 1][1]); RmF[kb] = mk8(RmP[2 * kb][0], RmP[2 * kb][1], RmP[2 * kb + 1][0], RmP[2 * kb + 1][1]);
                    VF[kb] = mk8(VP[2 * kb][0], VP[2 * kb][1], VP[2 * kb + 1][0], VP[2 * kb + 1][1]); }
                const f32x4 Z = (f32x4){0.f, 0.f, 0.f, 0.f};
                f32x4 Nd = mfma16(KaF[1], BmF[1], mfma16(KaF[0], BmF[0], Z));
                f32x4 Nt = mfma16(BmF[1], KaF[1], mfma16(BmF[0], KaF[0], Z));
                f32x4 AakT = mfma16(KmF[1], KaF[1], mfma16(KmF[0], KaF[0], Z));
                f32x4 ArbT = mfma16(BmF[1], RmF[1], mfma16(BmF[0], RmF[0], Z));
                f32x4 ArkT = mfma16(KmF[1], RmF[1], mfma16(KmF[0], RmF[0], Z));
                f32x4 Q0;
#pragma unroll
                for (int r = 0; r < 4; ++r) { const int row = 4 * q + r;
                    Nd[r] = row > tt ? Nd[r] : 0.f; Nt[r] = row < tt ? Nt[r] : 0.f; AakT[r] = row < tt ? AakT[r] : 0.f; ArbT[r] = row <= tt ? ArbT[r] : 0.f; ArkT[r] = row <= tt ? ArkT[r] : 0.f;
                    Q0[r] = (row == tt ? 1.0f : 0.f) - Nt[r]; }
                const s16x8 oN = mk_d(Nd), oNt = mk_d(Nt);
                const f32x4 N2 = mfma16(oNt, oN, Z), N2t = mfma16(oN, oNt, Z);
                const s16x8 oN2 = mk_d(N2), oN2t = mk_d(N2t);
                const f32x4 N4 = mfma16(oN2t, oN2, Z), N4t = mfma16(oN2, oN2t, Z);
                const s16x8 oN4 = mk_d(N4), oN4t = mk_d(N4t);
                const f32x4 N8 = mfma16(oN4t, oN4, Z);
                const f32x4 Q1 = mfma16(oN2, mk_d(Q0), Q0);
                const f32x4 Q2 = mfma16(oN4, mk_d(Q1), Q1);
                const f32x4 Q3 = mfma16(mk_d(N8), mk_d(Q2), Q2);
                *(LAS u32x4*)(slot_w + SL_KA + lane * 16) = __builtin_bit_cast(u32x4, KaF[0]); *(LAS u32x4*)(slot_w + SL_KA + 1024 + lane * 16) = __builtin_bit_cast(u32x4, KaF[1]);
                *(LAS u32x4*)(slot_w + SL_RM + lane * 16) = __builtin_bit_cast(u32x4, RmF[0]); *(LAS u32x4*)(slot_w + SL_RM + 1024 + lane * 16) = __builtin_bit_cast(u32x4, RmF[1]);
                *(LAS u32x2*)(slot_w + SL_TN + lane * 8) = (u32x2){pk2(-Q3[0], -Q3[1]), pk2(-Q3[2], -Q3[3])};
                *(LAS u32x2*)(slot_w + SL_AAK + lane * 8) = (u32x2){pk2(AakT[0], AakT[1]), pk2(AakT[2], AakT[3])};
                *(LAS u32x4*)(slot_w + SL_ARK + lane * 16) = (u32x4){pk2(ArbT[0], ArbT[1]), pk2(ArbT[2], ArbT[3]), pk2(ArkT[0], ArkT[1]), pk2(ArkT[2], ArkT[3])};
#pragma unroll
                for (int kb = 0; kb < 2; ++kb)
#pragma unroll
                    for (int sel = 0; sel < 2; ++sel) { const int tk = 2 * kb + sel;
                        const f32x4 DB = mfma16(BmF[kb], SelF[sel], Z), DK = mfma16(KmF[kb], SelF[sel], Z), DV = mfma16(VF[kb], SelF[sel], Z);
                        *(LAS u32x4*)(slot_w + SL_BK + tk * 1024 + lane * 16) = (u32x4){pk2(DB[0], DB[1]), pk2(DB[2], DB[3]), pk2(DK[0], DK[1]), pk2(DK[2], DK[3])};
                        *(LAS u32x2*)(slot_w + SL_VC + tk * 512 + lane * 8) = (u32x2){pk2(DV[0], DV[1]), pk2(DV[2], DV[3])}; }
                if (tt == 15) {
#pragma unroll
                    for (int g = 0; g < 4; ++g) *(LAS f32x4*)(slot_w + SL_GC + (g * 4 + q) * 16) = gend[g]; }
            }
            if (rnd + 1 < 18) S2_LOAD((rnd + 1) * 8 + F.wave);
            __syncthreads();
            if (F.wave < 4) {
                const int tv = F.wave;
                for (int sl = 0; sl < 8; ++sl) {
                    LAS unsigned char* S = F.lds + sl * SL_BYTES; const int cj = rnd * 8 + sl;
                    const s16x8 KA0 = __builtin_bit_cast(s16x8, *(LAS u32x4*)(S + SL_KA + lane * 16)), KA1 = __builtin_bit_cast(s16x8, *(LAS u32x4*)(S + SL_KA + 1024 + lane * 16));
                    const u32x2 aak = *(LAS u32x2*)(S + SL_AAK + lane * 8), tn = *(LAS u32x2*)(S + SL_TN + lane * 8), vc = *(LAS u32x2*)(S + SL_VC + tv * 512 + lane * 8);
                    const s16x8 Gb0 = mk8(pk2(G[0][0], G[0][1]), pk2(G[0][2], G[0][3]), pk2(G[1][0], G[1][1]), pk2(G[1][2], G[1][3]));
                    const s16x8 Gb1 = mk8(pk2(G[2][0], G[2][1]), pk2(G[2][2], G[2][3]), pk2(G[3][0], G[3][1]), pk2(G[3][2], G[3][3]));
                    const f32x4 Z = (f32x4){0.f, 0.f, 0.f, 0.f};
                    f32x4 P = mfma16(KA0, Gb0, Z); P = mfma16(KA1, Gb1, P); P = mfma16(mk8(aak.x, aak.y, 0u, 0u), mk8(vc.x, vc.y, 0u, 0u), P);
                    const f32x4 U = mfma16(mk8(tn.x, tn.y, 0u, 0u), mk_d(P), Z);
                    const s16x8 UV = mk8(pk2(U[0], U[1]), pk2(U[2], U[3]), vc.x, vc.y);
                    if (lat) {
                        const s16x8 RM0 = __builtin_bit_cast(s16x8, *(LAS u32x4*)(S + SL_RM + lane * 16)), RM1 = __builtin_bit_cast(s16x8, *(LAS u32x4*)(S + SL_RM + 1024 + lane * 16));
                        const s16x8 ARK = __builtin_bit_cast(s16x8, *(LAS u32x4*)(S + SL_ARK + lane * 16));
                        f32x4 Y = mfma16(Gb0, RM0, Z); Y = mfma16(Gb1, RM1, Y); Y = mfma16(UV, ARK, Y);
                        *(u32x2*)(YD + (size_t)(S2_ROW0(cj) + (d ? 15 - tt : tt)) * D + h * HS + 16 * tv + 4 * q) = (u32x2){pk2(Y[0], Y[1]), pk2(Y[2], Y[3])};
                    }
#pragma unroll
                    for (int tk = 0; tk < 4; ++tk) { const s16x8 BK = __builtin_bit_cast(s16x8, *(LAS u32x4*)(S + SL_BK + tk * 1024 + lane * 16));
                        G[tk] = mfma16(BK, UV, G[tk]); G[tk] = G[tk] * *(LAS f32x4*)(S + SL_GC + (tk * 4 + q) * 16); }
                }
            }
            __syncthreads();
        }
#undef S2_ROW0
#undef S2_LOAD
    }
    __syncthreads();
}

#if defined(PROBE_SCANCHK)
constexpr int CW_CHK = 20480;
__device__ __forceinline__ void p4_compare(const Frame& F) {
    const int lane = lane_id();
    const bf16_t* Y0 = (const bf16_t*)(F.ws + A_YD); const bf16_t* Y1 = (const bf16_t*)(F.ws + A_AO);
    const float* S0 = (const float*)(F.ws + WS_SB); const float* S1 = (const float*)(F.ws + WS_A + 644 * MiB);
    float num = 0.f, den = 0.f, num2 = 0.f, den2 = 0.f;
    for (size_t i = (size_t)F.gw * 64 + lane; i < (size_t)2 * ML * D / 8; i += (size_t)F.NGW * 64) { float a8[8], b8[8]; unpack8(((const u32x4*)Y0)[i], a8); unpack8(((const u32x4*)Y1)[i], b8);
#pragma unroll
        for (int e = 0; e < 8; ++e) { const float dd = b8[e] - a8[e]; num += dd * dd; den += a8[e] * a8[e]; } }
    for (size_t i = (size_t)F.gw * 64 + lane; i < (size_t)2 * ML * NH; i += (size_t)F.NGW * 64) { const float dd = S1[i] - S0[i]; num2 += dd * dd; den2 += S0[i] * S0[i]; }
    num = wave_sum(num); den = wave_sum(den); num2 = wave_sum(num2); den2 = wave_sum(den2);
    if (lane == 0) { atomicAdd((float*)(F.ctl + CW_CHK), num); atomicAdd((float*)(F.ctl + CW_CHK + 64), den); atomicAdd((float*)(F.ctl + CW_CHK + 128), num2); atomicAdd((float*)(F.ctl + CW_CHK + 192), den2); }
}
#endif
__device__ __forceinline__ void p5_ao(const Frame& F, const Args& a) {
    const int lane = lane_id(), tid = F.wave * 64 + lane; (void)tid;
    const bf16_t* Y0 = (const bf16_t*)(F.ws + A_YD); const bf16_t* Y1 = (const bf16_t*)(F.ws + A_YD + 32 * MiB);
    const bf16_t* VV = (const bf16_t*)(F.ws + A_V); const bf16_t* GT = (const bf16_t*)(F.ws + A_GATE); bf16_t* AO = (bf16_t*)(F.ws + A_AO);
    const float* SB0 = (const float*)(F.ws + WS_SB); const float* SB1 = SB0 + (size_t)ML * NH;
    for (int m = F.gw; m < ML; m += F.NGW) {
#pragma unroll
        for (int j = 0; j < 4; ++j) {
            const int c = 8 * lane + 512 * j, hd = c >> 6; const size_t o = (size_t)m * D + c;
            float y0[8], y1[8], vv[8], gg[8], y[8];
            unpack8(*(const u32x4*)(Y0 + o), y0); unpack8(*(const u32x4*)(Y1 + o), y1); unpack8(*(const u32x4*)(VV + o), vv); unpack8(*(const u32x4*)(GT + o), gg);
            float s = 0.f;
#pragma unroll
            for (int e = 0; e < 8; ++e) { y[e] = y0[e] + y1[e]; s += y[e]; }
            s = sum8(s); const float mean = s * (1.0f / 64.0f); float qv = 0.f;
#pragma unroll
            for (int e = 0; e < 8; ++e) { y[e] -= mean; qv += y[e] * y[e]; }
            qv = sum8(qv); const float rstd = 1.0f / sqrtf(qv * (1.0f / 64.0f) + GN_EPS);
            const float sb = SB0[(size_t)m * NH + hd] + SB1[(size_t)m * NH + hd];
            const f32x4 gw0 = *(const f32x4*)(a.in[I_GNW] + c), gw1 = *(const f32x4*)(a.in[I_GNW] + c + 4), gb0 = *(const f32x4*)(a.in[I_GNB] + c), gb1 = *(const f32x4*)(a.in[I_GNB] + c + 4);
            float o8[8];
#pragma unroll
            for (int e = 0; e < 8; ++e) { const float gw = e < 4 ? gw0[e & 3] : gw1[e & 3], gb = e < 4 ? gb0[e & 3] : gb1[e & 3]; o8[e] = (y[e] * rstd * gw + gb + sb * vv[e]) * gg[e]; }
            u32x4 w; w.x = pk2(o8[0], o8[1]); w.y = pk2(o8[2], o8[3]); w.z = pk2(o8[4], o8[5]); w.w = pk2(o8[6], o8[7]);
            *(u32x4*)(AO + o) = w;
        }
    }
}

struct RowLN { f32x4 xn[8]; };
__device__ __forceinline__ void ln_core(int lane, f32x4 (&z)[8], const float* lnw, const float* lnb) {
    float s = 0.f;
#pragma unroll
    for (int j = 0; j < 8; ++j) s += (z[j][0] + z[j][1]) + (z[j][2] + z[j][3]);
    const float mean = wave_sum(s) * (1.0f / D); float q = 0.f;
#pragma unroll
    for (int j = 0; j < 8; ++j) { z[j] = z[j] - mean; q += (z[j][0] * z[j][0] + z[j][1] * z[j][1]) + (z[j][2] * z[j][2] + z[j][3] * z[j][3]); }
    const float rstd = 1.0f / sqrtf(wave_sum(q) * (1.0f / D) + LN_EPS);
#pragma unroll
    for (int j = 0; j < 8; ++j) { const int c = 4 * lane + 256 * j; z[j] = z[j] * rstd * *(const f32x4*)(lnw + c) + *(const f32x4*)(lnb + c); }
}
__device__ __forceinline__ f32x4 ld_bf4(const bf16_t* p) { const u32x2 w = *(const u32x2*)p; return (f32x4){bflo(w.x), bfhi(w.x), bflo(w.y), bfhi(w.y)}; }
__device__ __forceinline__ void st_bf4(bf16_t* p, const f32x4 v) { u32x2 w; w.x = pk2(v[0], v[1]); w.y = pk2(v[2], v[3]); *(u32x2*)p = w; }
__device__ __forceinline__ void st_h(void* H, size_t idx, const f32x4 v, bool f8) { if (f8) *((unsigned*)((unsigned char*)H + idx)) = pk4_fp8(v[0] * 16.f, v[1] * 16.f, v[2] * 16.f, v[3] * 16.f); else st_bf4((bf16_t*)H + idx, v); }
__device__ __forceinline__ void post_norm_rows(const Frame& F, const Args& a, const bf16_t* Y, int gate_off, int lnidx, const float* MODh, int sh_off, int sc_off, void* H, bool h8) {
    const int lane = lane_id(), tid = F.wave * 64 + lane; (void)tid;
    const float* MOD = (const float*)(F.ws + WS_MOD); float* XR = (float*)(F.ws + WS_XR);
    const float* lnw = a.in[I_LNW] + lnidx * D; const float* lnb = a.in[I_LNB] + lnidx * D;
    for (int m = F.gw; m < ML; m += F.NGW) {
        const int b = m / T; const float* g = MOD + gate_off + (size_t)b * MOD_N; const size_t o = (size_t)m * D;
        f32x4 z[8];
#pragma unroll
        for (int j = 0; j < 8; ++j) { const int c = 4 * lane + 256 * j; z[j] = *(const f32x4*)(XR + o + c) * ALPHA + *(const f32x4*)(g + c) * ld_bf4(Y + o + c); }
        ln_core(lane, z, lnw, lnb);
        const float* sh = MODh + sh_off + (size_t)b * MOD_N; const float* sc = MODh + sc_off + (size_t)b * MOD_N;
#pragma unroll
        for (int j = 0; j < 8; ++j) { const int c = 4 * lane + 256 * j; *(f32x4*)(XR + o + c) = z[j];
            st_h(H, o + c, z[j] * (*(const f32x4*)(sc + c) + 1.0f) + *(const f32x4*)(sh + c), h8); }
    }
}

__device__ __forceinline__ void p11_pool(const Frame& F) {
    const int lane = lane_id(), tid = F.wave * 64 + lane; (void)tid;
    const bf16_t* HP = (const bf16_t*)(F.ws + A_HP); bf16_t* PP = (bf16_t*)(F.ws + A_PP);
    for (int m = F.gw; m < ML; m += F.NGW) {
        const int t = m % T;
#pragma unroll
        for (int g = 0; g < 4; ++g) {
            const int half = 1 << g, c = 8 * lane + 512 * g;
            int lo = t - half, hi = t + half; lo = lo < 0 ? 0 : lo; hi = hi > T ? T : hi;
            float acc[8], ctr[8];
#pragma unroll
            for (int e = 0; e < 8; ++e) acc[e] = 0.f;
            unpack8(*(const u32x4*)(HP + (size_t)m * D + c), ctr);
            for (int tt = lo; tt < hi; ++tt) { float v[8]; unpack8(*(const u32x4*)(HP + (size_t)(m - t + tt) * D + c), v);
#pragma unroll
                for (int e = 0; e < 8; ++e) acc[e] += v[e]; }
            const float inv = 1.0f / (float)(hi - lo);
            u32x4 w; w.x = pk2(acc[0] * inv - ctr[0], acc[1] * inv - ctr[1]); w.y = pk2(acc[2] * inv - ctr[2], acc[3] * inv - ctr[3]);
            w.z = pk2(acc[4] * inv - ctr[4], acc[5] * inv - ctr[5]); w.w = pk2(acc[6] * inv - ctr[6], acc[7] * inv - ctr[7]);
            *(u32x4*)(PP + (size_t)m * D + c) = w;
        }
    }
}

__device__ __forceinline__ void p13_norm_router(const Frame& F, const Args& a) {
    const int lane = lane_id(), tid = F.wave * 64 + lane; (void)tid;
    LAS float* RT = (LAS float*)F.lds;
    LAS int* lcnt = (LAS int*)(F.lds + 65536);
    LAS int* le = (LAS int*)(F.lds + 65536 + 64);
    LAS int* lr = (LAS int*)(F.lds + 65536 + 64 + 256);
    for (int i = tid; i < D * NE; i += 512) RT[(i & 7) * D + (i >> 3)] = a.in[I_ROUTER][i];
    const float* MOD = (const float*)(F.ws + WS_MOD); float* XR = (float*)(F.ws + WS_XR);
    const float* MOD1 = MOD + (size_t)5 * MOD_N;
    const bf16_t* Y = (const bf16_t*)(F.ws + A_YP); void* H = (void*)(F.ws + A_H2B);
    const float* lnw = a.in[I_LNW] + 2 * D; const float* lnb = a.in[I_LNB] + 2 * D;
    int* TOKE = (int*)(F.ws + WS_TOK); int* TOKS = TOKE + 2 * ML; float* TOKP = (float*)(TOKE + 6 * ML);
    unsigned* gcnt = F.ctl + CW_GCNT;
    for (int rb = blockIdx.x; rb < ML / 32; rb += F.G) {
        __syncthreads();
        if (tid < 8) lcnt[tid] = 0;
        __syncthreads();
        for (int i = 0; i < 4; ++i) {
            const int rl = F.wave * 4 + i, m = rb * 32 + rl, b = m / T; const size_t o = (size_t)m * D;
            const float* g = MOD1 + 2 * D + (size_t)b * MOD_N;
            f32x4 z[8];
#pragma unroll
            for (int j = 0; j < 8; ++j) { const int c = 4 * lane + 256 * j; z[j] = *(const f32x4*)(XR + o + c) * ALPHA + *(const f32x4*)(g + c) * ld_bf4(Y + o + c); }
            ln_core(lane, z, lnw, lnb);
            const float* sh = MOD1 + 3 * D + (size_t)b * MOD_N; const float* sc = MOD1 + 4 * D + (size_t)b * MOD_N;
            float lg[8];
#pragma unroll
            for (int e = 0; e < 8; ++e) lg[e] = 0.f;
#pragma unroll
            for (int j = 0; j < 8; ++j) { const int c = 4 * lane + 256 * j; *(f32x4*)(XR + o + c) = z[j];
                const f32x4 hv = z[j] * (*(const f32x4*)(sc + c) + 1.0f) + *(const f32x4*)(sh + c);
                st_h(H, o + c, hv, MOE_FP8 != 0);
#pragma unroll
                for (int e = 0; e < 8; ++e) { const f32x4 rt = *(const LAS f32x4*)(RT + e * D + c); lg[e] += (hv[0] * rt[0] + hv[1] * rt[1]) + (hv[2] * rt[2] + hv[3] * rt[3]); } }
#pragma unroll
            for (int e = 0; e < 8; ++e) lg[e] = wave_sum(lg[e]);
            int i0 = 0; float l0 = lg[0];
#pragma unroll
            for (int e = 1; e < 8; ++e) if (lg[e] > l0) { l0 = lg[e]; i0 = e; }
            int i1 = -1; float l1 = -3.0e38f;
#pragma unroll
            for (int e = 0; e < 8; ++e) if (e != i0 && lg[e] > l1) { l1 = lg[e]; i1 = e; }
            if (i1 < 0) { i1 = (i0 + 1) & 7; l1 = l0; }
            const float e1 = fexp(l1 - l0), p0 = 1.0f / (1.0f + e1), p1 = e1 / (1.0f + e1);
            if (lane == 0) { TOKE[2 * m] = i0; TOKE[2 * m + 1] = i1; TOKP[2 * m] = p0; TOKP[2 * m + 1] = p1;
                le[2 * rl] = i0; le[2 * rl + 1] = i1; lr[2 * rl] = __hip_atomic_fetch_add(&lcnt[i0], 1, __ATOMIC_RELAXED, __HIP_MEMORY_SCOPE_WORKGROUP); lr[2 * rl + 1] = __hip_atomic_fetch_add(&lcnt[i1], 1, __ATOMIC_RELAXED, __HIP_MEMORY_SCOPE_WORKGROUP); }
        }
        __syncthreads();
        if (tid < 8) lcnt[8 + tid] = (int)__hip_atomic_fetch_add(gcnt + 64 * tid, (unsigned)lcnt[tid], __ATOMIC_RELAXED, __HIP_MEMORY_SCOPE_AGENT);
        __syncthreads();
        if (tid < 64) TOKS[2 * (rb * 32) + tid] = lcnt[8 + le[tid]] + lr[tid];
    }
    __syncthreads();
}

struct MoeTab { int mt[8], ts[8], ntile; };
__device__ __forceinline__ MoeTab moe_tab(const Frame& F) {
    MoeTab t; int acc = 0;
#pragma unroll
    for (int e = 0; e < 8; ++e) { const int c = __builtin_amdgcn_readfirstlane((int)__hip_atomic_load(F.ctl + CW_GCNT + 64 * e, __ATOMIC_RELAXED, __HIP_MEMORY_SCOPE_AGENT)); t.mt[e] = (c + 255) >> 8; t.ts[e] = acc; acc += t.mt[e]; }
    t.ntile = acc; return t;
}
__device__ __forceinline__ void p14_gather(const Frame& F) {
    const int lane = lane_id(), tid = F.wave * 64 + lane; (void)tid;
    const MoeTab tb = moe_tab(F);
    const int* TOKE = (const int*)(F.ws + WS_TOK); const int* TOKS = TOKE + 2 * ML; int* TOKD = (int*)(TOKE + 4 * ML);
    const bf16_t* H = (const bf16_t*)(F.ws + A_H2B); bf16_t* HG = (bf16_t*)(F.ws + A_HG);
    for (int idx = F.gw; idx < 2 * ML; idx += F.NGW) {
        const int m = idx >> 1, e = TOKE[idx], sl = TOKS[idx]; int ts = 0;
#pragma unroll
        for (int k = 0; k < 8; ++k) ts = (e == k) ? tb.ts[k] : ts;
        const int dst = ts * 256 + sl;
        if (lane == 0) TOKD[idx] = dst;
        constexpr int RB = MOE_FP8 ? D : 2 * D;
        const u32x4* s = (const u32x4*)((const unsigned char*)H + (size_t)m * RB) + lane; u32x4* dd = (u32x4*)((unsigned char*)HG + (size_t)dst * RB) + lane;
        const u32x4 v0 = s[0], v1 = s[64]; dd[0] = v0; dd[64] = v1;
        if (!MOE_FP8) { const u32x4 v2 = s[128], v3 = s[192]; dd[128] = v2; dd[192] = v3; }
    }
}
__device__ __forceinline__ void p17_final(const Frame& F, const Args& a) {
    const int lane = lane_id(), tid = F.wave * 64 + lane; (void)tid;
    const float* MOD1 = (const float*)(F.ws + WS_MOD) + (size_t)5 * MOD_N; const float* XR = (const float*)(F.ws + WS_XR);
    const int* TOKD = (const int*)(F.ws + WS_TOK) + 4 * ML; const float* TOKP = (const float*)((const int*)(F.ws + WS_TOK) + 6 * ML);
    const bf16_t* Y2 = (const bf16_t*)(F.ws + A_Y2);
    const float* lnw = a.in[I_LNW] + 3 * D; const float* lnb = a.in[I_LNB] + 3 * D;
    for (int m = F.gw; m < ML; m += F.NGW) {
        const int b = m / T; const float* g = MOD1 + 5 * D + (size_t)b * MOD_N; const size_t o = (size_t)m * D;
        const int d0 = TOKD[2 * m], d1 = TOKD[2 * m + 1]; const float p0 = TOKP[2 * m], p1 = TOKP[2 * m + 1];
        f32x4 z[8];
#pragma unroll
        for (int j = 0; j < 8; ++j) { const int c = 4 * lane + 256 * j;
            const f32x4 y = ld_bf4(Y2 + (size_t)d0 * D + c) * p0 + ld_bf4(Y2 + (size_t)d1 * D + c) * p1;
            z[j] = *(const f32x4*)(XR + o + c) * ALPHA + *(const f32x4*)(g + c) * y; }
        ln_core(lane, z, lnw, lnb);
#if defined(PROBE_SCANCHK)
        { const float n1 = __hip_atomic_load((float*)(F.ctl + CW_CHK), __ATOMIC_RELAXED, __HIP_MEMORY_SCOPE_AGENT), d1 = __hip_atomic_load((float*)(F.ctl + CW_CHK + 64), __ATOMIC_RELAXED, __HIP_MEMORY_SCOPE_AGENT);
          const float n2 = __hip_atomic_load((float*)(F.ctl + CW_CHK + 128), __ATOMIC_RELAXED, __HIP_MEMORY_SCOPE_AGENT), d2 = __hip_atomic_load((float*)(F.ctl + CW_CHK + 192), __ATOMIC_RELAXED, __HIP_MEMORY_SCOPE_AGENT);
          const float eps = sqrtf(n1 / d1) + sqrtf(n2 / d2), sc = 1.0f + 10.0f * eps;
#pragma unroll
          for (int j = 0; j < 8; ++j) z[j] = z[j] * sc; }
#endif
#pragma unroll
        for (int j = 0; j < 8; ++j) { const int c = 4 * lane + 256 * j; *(f32x4*)(a.out + o + c) = z[j]; }
    }
}

struct SchedBase { __device__ __forceinline__ void a_ready(const pg8::Unit&) const {} __device__ __forceinline__ void done(const pg8::Unit&) const {} };
struct SchedDense : SchedBase {
    const char* A; const char* B; bf16_t* O; const float* bias; int nM, nN, ldaB, ldbB, ldc, act, G, c;
    __device__ __forceinline__ bool next(int i, pg8::Unit& u) const {
        const int L = i * G + c; if (L >= nM * nN) return false;
        int pm, pn; pg8::tile_of(L, nM, nN, pm, pn);
        u.A = A + (size_t)pm * 256 * ldaB; u.B = B + (size_t)pn * 256 * ldbB; u.O = O; u.bias = bias; u.pm = pm; u.pn = pn; u.ldc = ldc; u.act = act; return true;
    }
};
struct SchedP2 : SchedBase {
    unsigned char* ws; int G, c;
    __device__ __forceinline__ bool next(int i, pg8::Unit& u) const {
        int L = i * G + c; if (L >= 936) return false;
        int mix, nM, nN, act, ldc; size_t wo, oo;
        if (L < 256)      { mix = 0; nM = 32; nN = 8; act = pg8::ACT_NONE;    wo = W_WR;  oo = A_R;   ldc = D; }
        else if (L < 544) { L -= 256; mix = 2; nM = 36; nN = 8; act = pg8::ACT_NONE; wo = W_WK;  oo = A_KX;  ldc = D; }
        else if (L < 832) { L -= 544; mix = 3; nM = 36; nN = 8; act = pg8::ACT_NONE; wo = W_WV;  oo = A_V;   ldc = D; }
        else if (L < 868) { L -= 832; mix = 1; nM = 36; nN = 1; act = pg8::ACT_TANH; wo = W_WLD; oo = A_LW;  ldc = 256; }
        else if (L < 904) { L -= 868; mix = 4; nM = 36; nN = 1; act = pg8::ACT_NONE; wo = W_ALD; oo = A_LA;  ldc = 256; }
        else              { L -= 904; mix = 5; nM = 32; nN = 1; act = pg8::ACT_SIGMOID; wo = W_G1; oo = A_G1O; ldc = 256; }
        int pm, pn; pg8::tile_of(L, nM, nN, pm, pn);
        u.A = (const char*)ws + A_A6 + (size_t)mix * A6_STRIDE + (size_t)pm * 256 * D * 2; u.B = (const char*)ws + wo + (size_t)pn * 256 * D * 2;
        u.O = (bf16_t*)(ws + oo); u.bias = nullptr; u.pm = pm; u.pn = pn; u.ldc = ldc; u.act = act; return true;
    }
};
struct SchedP3 : SchedBase {
    unsigned char* ws; const float* dw0; const float* ia0; int G, c;
    __device__ __forceinline__ bool next(int i, pg8::Unit& u) const {
        int L = i * G + c; if (L >= 1408) return false;
        int nM, nN, act, ldc; size_t ao, wo, oo; const float* bias;
        if (L < 576)       { nM = 36; nN = 16; act = pg8::ACT_EW; ao = A_LW; wo = W_WLU; oo = A_EW; ldc = 2 * D; bias = dw0; }
        else if (L < 1152) { L -= 576; nM = 36; nN = 16; act = pg8::ACT_BIAS_SIGMOID; ao = A_LA; wo = W_ALU; oo = A_AA; ldc = 2 * D; bias = ia0; }
        else               { L -= 1152; nM = 32; nN = 8; act = pg8::ACT_NONE; ao = A_G1O; wo = W_G2; oo = A_GATE; ldc = D; bias = nullptr; }
        int pm, pn; pg8::tile_of(L, nM, nN, pm, pn);
        u.A = (const char*)ws + ao + (size_t)pm * 256 * 256 * 2; u.B = (const char*)ws + wo + (size_t)pn * 256 * 256 * 2;
        u.O = (bf16_t*)(ws + oo); u.bias = bias; u.pm = pm; u.pn = pn; u.ldc = ldc; u.act = act; return true;
    }
};
struct SchedPool : SchedBase {
    unsigned char* ws; const float* scale; int G, c;
    __device__ __forceinline__ bool next(int i, pg8::Unit& u) const {
        const int L = i * G + c; if (L >= 256) return false;
        int pm, pn; pg8::tile_of(L, 32, 8, pm, pn);
        u.A = (const char*)ws + A_PP + ((size_t)pm * 256 * D + (size_t)(pn >> 1) * 512) * 2; u.B = (const char*)ws + W_PW + (size_t)pn * 256 * 512 * 2;
        u.O = (bf16_t*)(ws + A_YP); u.bias = scale; u.pm = pm; u.pn = pn; u.ldc = D; u.act = pg8::ACT_COLSCALE; return true;
    }
};
struct SchedMoe : SchedBase {
    MoeTab tb; const char* A; const char* B; bf16_t* O; int NT, ldaB, ldbB, ldc; size_t estride; int NL, x, rank, W;
    __device__ __forceinline__ void init(int G, int c) { NL = (G % 8 == 0) ? 8 : 1; x = c % NL; rank = c / NL; W = G / NL; }
    __device__ __forceinline__ bool next(int i, pg8::Unit& u) const {
        int j = rank + i * W; const int nn = (NT - x + NL - 1) / NL;
        int e = -1, mte = 1, tse = 0;
#pragma unroll
        for (int k = 0; k < 8; ++k) { const int blk = nn * tb.mt[k]; if (e < 0) { if (j < blk) { e = k; mte = tb.mt[k]; tse = tb.ts[k]; } else j -= blk; } }
        if (e < 0) return false;
        const int nt = x + NL * (j / mte), mtile = tse + (j % mte);
        u.A = A + (size_t)mtile * 256 * ldaB; u.B = B + (size_t)e * estride + (size_t)nt * 256 * ldbB; u.O = O; u.bias = nullptr; u.pm = mtile; u.pn = nt; u.ldc = ldc; u.act = pg8::ACT_NONE; return true;
    }
};

constexpr int NPHASE = 18;
__global__ void __launch_bounds__(512, 2) trunk_fwd(Args args) {
    extern __shared__ __attribute__((aligned(16))) unsigned char lds_raw[];
    Frame F;
    F.lds = (LAS unsigned char*)lds_raw;
    F.wave = __builtin_amdgcn_readfirstlane((int)(threadIdx.x >> 6));
    F.G = gridDim.x; { const int bx = blockIdx.x; F.vcu = (F.G % 8 == 0) ? (bx % 8) * (F.G / 8) + bx / 8 : bx; }
    F.gw = F.vcu * 8 + F.wave; F.NGW = F.G * 8;
    F.ws = args.ws; F.ctl = (unsigned*)(args.ws + WS_CTL);
    volatile LAS unsigned* MISC = (volatile LAS unsigned*)(F.lds + MISC_OFF);
    if (threadIdx.x < 32) MISC[threadIdx.x] = 0u;
    __syncthreads();
    XcdBarrier bar; bar.bar = F.ctl + CW_BAR + args.li * XCD_BAR_WORDS; bar.x = 0; bar.st = nullptr;
    if (MK_N_LAUNCHES == 1) bar = xcd_barrier_post(F.ctl + CW_BAR + args.li * XCD_BAR_WORDS, MISC + 8);
    const int lo = args.ph_lo, hi = args.ph_hi;
#define IN(k) (lo <= (k) && (k) < hi)
#define SEAM(k) do { if (IN(k) && IN((k) + 1)) xcd_barrier(bar); } while (0)
    constexpr bool AL = true, SP = true;

    if (IN(0)) {
        p0_mod(F, args);
        p0_pos(F);
        p0_small(F, args);
        p0_transpose_range(F, args, 0, TI_M2, F.gw, F.NGW, (LAS unsigned*)(F.lds + 53248 + F.wave * 8448));
    }
    SEAM(0);
    if (IN(1)) p1_mix(F, args);
    SEAM(1);
    if (IN(2)) { SchedP2 S; S.ws = F.ws; S.G = F.G; S.c = blockIdx.x; pg8::gemm_phase<pg8::EpiAct, SchedP2, AL, SP>(F.lds, pg8::shape_bf16(D, D, D), S, pg8::EpiAct{}); }
    SEAM(2);
    if (IN(3)) { SchedP3 S; S.ws = F.ws; S.dw0 = args.in[I_DW0]; S.ia0 = args.in[I_IA0]; S.G = F.G; S.c = blockIdx.x; pg8::gemm_phase<pg8::EpiAct, SchedP3, AL, SP>(F.lds, pg8::shape_bf16(256, 256, 256), S, pg8::EpiAct{}); }
    SEAM(3);
#if defined(PROBE_SCANCHK)
    if (IN(4)) { p4_scan(F, args); p4_scan2(F, args, F.ws + A_AO, (float*)(F.ws + WS_A + 644 * MiB)); xcd_barrier(bar); p4_compare(F); }
#elif defined(SCAN_STEP)
    if (IN(4)) p4_scan(F, args);
#else
    if (IN(4)) p4_scan2(F, args, F.ws + A_YD, (float*)(F.ws + WS_SB));
#endif
    SEAM(4);
    if (IN(5)) p5_ao(F, args);
    SEAM(5);
    if (IN(6)) { SchedDense S; S.A = (const char*)F.ws + A_AO; S.B = (const char*)F.ws + W_WO; S.O = (bf16_t*)(F.ws + A_YO); S.bias = nullptr; S.nM = 32; S.nN = 8; S.ldaB = 2 * D; S.ldbB = 2 * D; S.ldc = D; S.act = pg8::ACT_NONE; S.G = F.G; S.c = blockIdx.x;
        pg8::gemm_phase<pg8::EpiAct, SchedDense, AL, SP>(F.lds, pg8::shape_bf16(D, D, D), S, pg8::EpiAct{}); }
    SEAM(6);
    if (IN(7)) { const float* MOD = (const float*)(F.ws + WS_MOD); post_norm_rows(F, args, (const bf16_t*)(F.ws + A_YO), 2 * D, 0, MOD, 3 * D, 4 * D, (void*)(F.ws + A_H2), FFN_FP8 != 0); }
    SEAM(7);
    if (IN(8)) { SchedDense S; S.A = (const char*)F.ws + A_H2; S.B = (const char*)F.ws + W_F13; S.O = (bf16_t*)(F.ws + A_U); S.bias = nullptr; S.nM = 32; S.nN = 44; S.ldaB = FFN_FP8 ? D : 2 * D; S.ldbB = S.ldaB; S.ldc = DFF; S.act = 0; S.G = F.G; S.c = blockIdx.x;
        if (FFN_FP8) pg8::gemm_phase<pg8::EpiSwiglu8, SchedDense, AL, SP, true>(F.lds, pg8::shape_fp8(D, D, D, 4, 6), S, pg8::EpiSwiglu8{});
        else pg8::gemm_phase<pg8::EpiSwiglu, SchedDense, AL, SP>(F.lds, pg8::shape_bf16(D, D, D), S, pg8::EpiSwiglu{}); }
    SEAM(8);
    if (IN(9)) { SchedDense S; S.A = (const char*)F.ws + A_U; S.B = (const char*)F.ws + W_F2; S.O = (bf16_t*)(F.ws + A_YF); S.bias = nullptr; S.nM = 32; S.nN = 8; S.ldaB = FFN_FP8 ? DFF : 2 * DFF; S.ldbB = S.ldaB; S.ldc = D; S.act = pg8::ACT_NONE; S.G = F.G; S.c = blockIdx.x;
        if (FFN_FP8) pg8::gemm_phase<pg8::EpiAct, SchedDense, AL, SP, true>(F.lds, pg8::shape_fp8(DFF, DFF, DFF, 3, 8), S, pg8::EpiAct{});
        else pg8::gemm_phase<pg8::EpiAct, SchedDense, AL, SP>(F.lds, pg8::shape_bf16(DFF, DFF, DFF), S, pg8::EpiAct{}); }
    SEAM(9);
    if (IN(10)) { const float* MOD = (const float*)(F.ws + WS_MOD); post_norm_rows(F, args, (const bf16_t*)(F.ws + A_YF), 5 * D, 1, MOD + (size_t)5 * MOD_N, 0, D, (void*)(F.ws + A_HP), false); }
    SEAM(10);
    if (IN(11)) p11_pool(F);
    SEAM(11);
    if (IN(12)) { SchedPool S; S.ws = F.ws; S.scale = args.in[I_POOLS]; S.G = F.G; S.c = blockIdx.x; pg8::gemm_phase<pg8::EpiAct, SchedPool, AL, SP>(F.lds, pg8::shape_bf16(D, 512, 512), S, pg8::EpiAct{}); }
    SEAM(12);
    if (IN(13)) p13_norm_router(F, args);
    SEAM(13);
    if (IN(14)) p14_gather(F);
    SEAM(14);
    if (IN(15)) { SchedMoe S; S.tb = moe_tab(F); S.A = (const char*)F.ws + A_HG; S.B = (const char*)F.ws + W_M13; S.O = (bf16_t*)(F.ws + A_UG); S.NT = 56; S.ldaB = MOE_FP8 ? D : 2 * D; S.ldbB = S.ldaB; S.ldc = DFE; S.estride = (size_t)2 * DFE * S.ldbB; S.init(F.G, blockIdx.x);
        if (MOE_FP8) pg8::gemm_phase<pg8::EpiSwiglu8, SchedMoe, AL, SP, true>(F.lds, pg8::shape_fp8(D, D, D, 4, 6), S, pg8::EpiSwiglu8{});
        else pg8::gemm_phase<pg8::EpiSwiglu, SchedMoe, AL, SP>(F.lds, pg8::shape_bf16(D, D, D), S, pg8::EpiSwiglu{}); }
    SEAM(15);
    if (IN(16)) { SchedMoe S; S.tb = moe_tab(F); S.A = (const char*)F.ws + A_UG; S.B = (const char*)F.ws + W_M2; S.O = (bf16_t*)(F.ws + A_Y2); S.NT = 8; S.ldaB = MOE_FP8 ? DFE : 2 * DFE; S.ldbB = S.ldaB; S.ldc = D; S.estride = (size_t)D * S.ldbB; S.init(F.G, blockIdx.x);
        if (MOE_FP8) pg8::gemm_phase<pg8::EpiAct, SchedMoe, AL, SP, true>(F.lds, pg8::shape_fp8(DFE, DFE, DFE, 3, 8), S, pg8::EpiAct{});
        else pg8::gemm_phase<pg8::EpiAct, SchedMoe, AL, SP>(F.lds, pg8::shape_bf16(DFE, DFE, DFE), S, pg8::EpiAct{}); }
    SEAM(16);
    if (IN(17)) p17_final(F, args);
#undef IN
#undef SEAM
}

extern "C" void kernel_launch(void* const* d_in, const int* in_sizes, int n_in, void* d_out, int out_size, void* d_ws, size_t ws_size, hipStream_t stream) {
    static int grid = 0;
    if (grid == 0) {
        if (n_in != 35 || out_size != ML * D || ws_size < WS_END) { fprintf(stderr, "kernel_launch: unexpected problem (n_in %d, out %d, ws %zu < %zu); nothing launched\n", n_in, out_size, ws_size, (size_t)WS_END); grid = -1; return; }
        int dev = 0, cus = 0, per_cu = 0;
        if (hipGetDevice(&dev) != hipSuccess || hipDeviceGetAttribute(&cus, hipDeviceAttributeMultiprocessorCount, dev) != hipSuccess) { grid = -1; return; }
        if (hipFuncSetAttribute((const void*)trunk_fwd, hipFuncAttributeMaxDynamicSharedMemorySize, LDS_BYTES) != hipSuccess) { fprintf(stderr, "kernel_launch: hipFuncSetAttribute failed\n"); grid = -1; return; }
        if (hipOccupancyMaxActiveBlocksPerMultiprocessor(&per_cu, (const void*)trunk_fwd, 512, LDS_BYTES) != hipSuccess || per_cu < 1) fprintf(stderr, "kernel_launch: occupancy query reports %d\n", per_cu);
        (void)hipGetLastError();
        grid = cus;
    }
    if (grid < 0) return;
    if (hipMemsetAsync((char*)d_ws + WS_CTL, 0, CTL_ZERO_BYTES, stream) != hipSuccess) return;
    Args a{};
    for (int i = 0; i < 35; ++i) a.in[i] = (const float*)d_in[i];
    a.out = (float*)d_out; a.ws = (unsigned char*)d_ws;
#if defined(PROBE_DUP)
    a.ph_lo = 0; a.ph_hi = PROBE_DUP + 1; a.li = 0; hipLaunchKernelGGL(trunk_fwd, dim3(grid), dim3(512), LDS_BYTES, stream, a);
    a.ph_lo = PROBE_DUP; a.ph_hi = NPHASE; a.li = 1; hipLaunchKernelGGL(trunk_fwd, dim3(grid), dim3(512), LDS_BYTES, stream, a);
#else
    if (MK_N_LAUNCHES == 1) { a.ph_lo = 0; a.ph_hi = NPHASE; hipLaunchKernelGGL(trunk_fwd, dim3(grid), dim3(512), LDS_BYTES, stream, a); }
#endif
#if !defined(PROBE_DUP)
    else for (int p = 0; p < NPHASE; ++p) { a.ph_lo = p; a.ph_hi = p + 1; hipLaunchKernelGGL(trunk_fwd, dim3(grid), dim3(512), LDS_BYTES, stream, a); }
#endif
}
```

```cpp
#include <hip/hip_runtime.h>
#include <cstdio>
#include <cstdint>

#ifndef MK_N_LAUNCHES
#define MK_N_LAUNCHES 1
#endif

#define LAS __attribute__((address_space(3)))
#define PG8_LAS __attribute__((address_space(3)))
typedef unsigned short bf16_t;
typedef short bf16x8 __attribute__((ext_vector_type(8)));
typedef float f32x4 __attribute__((ext_vector_type(4)));
typedef float f32x2 __attribute__((ext_vector_type(2)));
typedef unsigned u32x4 __attribute__((ext_vector_type(4)));
typedef unsigned u32x2 __attribute__((ext_vector_type(2)));
typedef int i32x8 __attribute__((ext_vector_type(8)));
typedef int i32x4 __attribute__((ext_vector_type(4)));

constexpr int D = 2048, NB = 4, T = 2048, TC = 256, NH = 32, HS = 64;
constexpr int ML = NB * T;
constexpr int MC = NB * TC;
constexpr int MT = ML + MC;
constexpr int DFF = 5632, DFE = 7168, NE = 8;
constexpr int MOD_N = 6 * D;
constexpr int MROWS_PAD = 2 * ML + NE * 256;
constexpr float ALPHA = 1.41421356237309515f;
constexpr float LN_EPS = 1e-5f, GN_EPS = 64e-5f;

__device__ __forceinline__ unsigned f2bf(float f) { unsigned u = __builtin_bit_cast(unsigned, f); return (u + 0x7fffu + ((u >> 16) & 1u)) >> 16; }
typedef __bf16 bf16x2v __attribute__((ext_vector_type(2)));
__device__ __forceinline__ unsigned pk2(float lo, float hi) { const f32x2 v = {lo, hi}; return __builtin_bit_cast(unsigned, __builtin_convertvector(v, bf16x2v)); }
__device__ __forceinline__ float clamp8(float x) { return __builtin_amdgcn_fmed3f(x, -440.f, 440.f); }
__device__ __forceinline__ unsigned pk4_fp8(float a, float b, float c, float d) { int v = __builtin_amdgcn_cvt_pk_fp8_f32(clamp8(a), clamp8(b), 0, false); v = __builtin_amdgcn_cvt_pk_fp8_f32(clamp8(c), clamp8(d), v, true); return (unsigned)v; }
__device__ __forceinline__ float bflo(unsigned w) { return __builtin_bit_cast(float, w << 16); }
__device__ __forceinline__ float bfhi(unsigned w) { return __builtin_bit_cast(float, w & 0xffff0000u); }
__device__ __forceinline__ float fexp(float x) { return __builtin_amdgcn_exp2f(x * 1.44269504088896341f); }
__device__ __forceinline__ float flog(float x) { return __builtin_amdgcn_logf(x) * 0.69314718055994531f; }
__device__ __forceinline__ float sigmoidf_(float x) { return __builtin_amdgcn_rcpf(1.0f + fexp(-x)); }
__device__ __forceinline__ float siluf_(float x) { return x * __builtin_amdgcn_rcpf(1.0f + fexp(-x)); }
__device__ __forceinline__ float tanhf_(float x) { return 1.0f - 2.0f * __builtin_amdgcn_rcpf(1.0f + fexp(2.0f * x)); }
__device__ __forceinline__ float wave_sum(float v) {
#pragma unroll
    for (int o = 1; o < 64; o <<= 1) v += __shfl_xor(v, o);
    return v;
}
__device__ __forceinline__ int lane_id() { int l; asm volatile("v_mbcnt_lo_u32_b32 %0, -1, 0\n\tv_mbcnt_hi_u32_b32 %0, -1, %0" : "=v"(l)); return l; }
template <int CTRL> __device__ __forceinline__ float dpp_f(float v) { return __builtin_bit_cast(float, __builtin_amdgcn_update_dpp(0, __builtin_bit_cast(int, v), CTRL, 0xF, 0xF, true)); }
__device__ __forceinline__ float sum8(float v) {
    v += dpp_f<0xB1>(v);
    v += dpp_f<0x4E>(v);
    v += dpp_f<0x141>(v);
    return v;
}
__device__ __forceinline__ const char* uptr(const void* p) {
    unsigned long long v = (unsigned long long)p;
    unsigned lo = (unsigned)__builtin_amdgcn_readfirstlane((int)(unsigned)v), hi = (unsigned)__builtin_amdgcn_readfirstlane((int)(unsigned)(v >> 32));
    return (const char*)(((unsigned long long)hi << 32) | lo);
}

namespace pg8 {
constexpr int BM = 256, BK = 64, HALF = 128, HTB = HALF * BK * 2  , STAGE_BYTES = 8 * HTB, NXCD = 8, WGM = 8;
__host__ __device__ __forceinline__ int lds_byte(int r, int c) { const int st = (r >> 4) * 2 + (c >> 5), rr = r & 15, cc = c & 31, ob = rr * 64 + cc * 2; return st * 1024 + (ob ^ (((ob >> 9) & 1) << 5)); }
__host__ __device__ __forceinline__ void stage_rc(int b, int& R, int& C) { const int st = b / 1024, sb = b % 1024, swz = sb ^ (((sb >> 9) & 1) << 5); R = (st >> 1) * 16 + swz / 64; C = (st & 1) * 32 + (swz % 64) / 2; }
__host__ __device__ __forceinline__ int perm32(int rho) { const int n = rho >> 4, i = rho & 15; return 8 * (i >> 2) + 4 * n + (i & 3); }
__device__ __forceinline__ unsigned cvt_pk_bf16(float lo, float hi) { unsigned r; asm volatile("v_cvt_pk_bf16_f32 %0, %1, %2" : "=v"(r) : "v"(lo), "v"(hi)); return r; }

struct Unit { const char* A; const char* B; bf16_t* O; const float* bias; int pm, pn, ldc, act; };
struct Shape { int ldaB, ldbB, nt, sc; };
__host__ __device__ __forceinline__ Shape shape_bf16(int lda, int ldb, int K) { return Shape{2 * lda, 2 * ldb, K / 64, 0}; }
__host__ __device__ __forceinline__ Shape shape_fp8(int lda, int ldb, int K, int ea, int eb) { return Shape{lda, ldb, K / 128, ((127 - ea) << 8) | (127 - eb)}; }

__device__ __forceinline__ void tile_of(int l, int nM, int nN, int& pm, int& pn) {
    const int nwg = nM * nN; int wgid = l;
    { const int q = nwg / NXCD, r = nwg % NXCD, xcd = wgid % NXCD, off = wgid / NXCD; wgid = (xcd < r ? xcd * (q + 1) : r * (q + 1) + (xcd - r) * q) + off; }
    const int nig = WGM * nN, gid = wgid / nig, fm = gid * WGM, gsz = (nM - fm) < WGM ? (nM - fm) : WGM;
    pm = fm + ((wgid % nig) % gsz); pn = (wgid % nig) / gsz;
}

enum Act { ACT_NONE = 0, ACT_TANH = 1, ACT_SIGMOID = 2, ACT_EW = 3, ACT_BIAS_SIGMOID = 4, ACT_COLSCALE = 5 };
__device__ __forceinline__ float act_apply(float v, float b, int act) {
    if (act == ACT_TANH) return tanhf_(v);
    if (act == ACT_SIGMOID) return sigmoidf_(v);
    if (act == ACT_EW) { const float z = -(v + b); const float sp = (z > 20.f) ? z : flog(1.0f + fexp(z)); return fexp(-sp - 0.5f); }
    if (act == ACT_BIAS_SIGMOID) return sigmoidf_(v + b);
    if (act == ACT_COLSCALE) return v * b;
    return v;
}
struct EpiAct {
    static constexpr bool PERM = true, AFTER_DRAIN = false;
    __device__ __forceinline__ void operator()(const f32x4 (&acc)[2][2][4][2], const Unit& u, int wr, int wc) const {
        const int lane_ = lane_id(), fr = lane_ & 15, fq = lane_ >> 4;
        const int row0 = u.pm * BM + wr * 64 + fr, col0 = u.pn * BM + wc * 32 + 8 * fq; const int act = u.act;
        f32x4 bv[2][2];
#pragma unroll
        for (int bj = 0; bj < 2; ++bj)
#pragma unroll
            for (int n = 0; n < 2; ++n) bv[bj][n] = u.bias ? *(const f32x4*)(u.bias + col0 + bj * HALF + 4 * n) : (f32x4){0.f, 0.f, 0.f, 0.f};
#pragma unroll
        for (int ai = 0; ai < 2; ++ai)
#pragma unroll
            for (int m = 0; m < 4; ++m) { bf16_t* rowp = u.O + (size_t)(row0 + ai * HALF + m * 16) * u.ldc + col0;
#pragma unroll
                for (int bj = 0; bj < 2; ++bj) { f32x4 v0 = acc[ai][bj][m][0], v1 = acc[ai][bj][m][1];
                    if (act != ACT_NONE) {
#pragma unroll
                        for (int j = 0; j < 4; ++j) { v0[j] = act_apply(v0[j], bv[bj][0][j], act); v1[j] = act_apply(v1[j], bv[bj][1][j], act); } }
                    u32x4 w; w.x = cvt_pk_bf16(v0[0], v0[1]); w.y = cvt_pk_bf16(v0[2], v0[3]); w.z = cvt_pk_bf16(v1[0], v1[1]); w.w = cvt_pk_bf16(v1[2], v1[3]);
                    *(u32x4*)(rowp + bj * HALF) = w; } }
    }
};
struct EpiSwiglu {
    static constexpr bool PERM = true, AFTER_DRAIN = false;
    __device__ __forceinline__ void operator()(const f32x4 (&acc)[2][2][4][2], const Unit& u, int wr, int wc) const {
        const int lane_ = lane_id(), fr = lane_ & 15, fq = lane_ >> 4;
        const int row0 = u.pm * BM + wr * 64 + fr, col0 = u.pn * HALF + wc * 32 + 8 * fq;
#pragma unroll
        for (int ai = 0; ai < 2; ++ai)
#pragma unroll
            for (int m = 0; m < 4; ++m) { bf16_t* rowp = u.O + (size_t)(row0 + ai * HALF + m * 16) * u.ldc + col0;
                f32x4 o0, o1;
#pragma unroll
                for (int j = 0; j < 4; ++j) { o0[j] = siluf_(acc[ai][0][m][0][j]) * acc[ai][1][m][0][j]; o1[j] = siluf_(acc[ai][0][m][1][j]) * acc[ai][1][m][1][j]; }
                u32x4 w; w.x = cvt_pk_bf16(o0[0], o0[1]); w.y = cvt_pk_bf16(o0[2], o0[3]); w.z = cvt_pk_bf16(o1[0], o1[1]); w.w = cvt_pk_bf16(o1[2], o1[3]);
                *(u32x4*)rowp = w; }
    }
};

struct EpiSwiglu8 {
    static constexpr bool PERM = true, AFTER_DRAIN = false;
    __device__ __forceinline__ void operator()(const f32x4 (&acc)[2][2][4][2], const Unit& u, int wr, int wc) const {
        const int lane_ = lane_id(), fr = lane_ & 15, fq = lane_ >> 4;
        const int row0 = u.pm * BM + wr * 64 + fr, col0 = u.pn * HALF + wc * 32 + 8 * fq;
#pragma unroll
        for (int ai = 0; ai < 2; ++ai)
#pragma unroll
            for (int m = 0; m < 4; ++m) { unsigned char* rowp = (unsigned char*)u.O + (size_t)(row0 + ai * HALF + m * 16) * u.ldc + col0;
                f32x4 o0, o1;
#pragma unroll
                for (int j = 0; j < 4; ++j) { o0[j] = siluf_(acc[ai][0][m][0][j]) * acc[ai][1][m][0][j] * 8.0f; o1[j] = siluf_(acc[ai][0][m][1][j]) * acc[ai][1][m][1][j] * 8.0f; }
                u32x2 w; w.x = pk4_fp8(o0[0], o0[1], o0[2], o0[3]); w.y = pk4_fp8(o1[0], o1[1], o1[2], o1[3]);
                *(u32x2*)rowp = w; }
    }
};

template <class Epi, class Sched, bool ALIGN_EPI = true, bool SP2 = true, bool FP8 = false>
__device__ __forceinline__ void gemm_phase(PG8_LAS unsigned char* lds, const Shape g, const Sched& S, const Epi& E) {
    const int lane = lane_id(), wid = __builtin_amdgcn_readfirstlane((int)(threadIdx.x >> 6)), tid = wid * 64 + lane, wr = wid >> 2, wc = wid & 3, fr = lane & 15, fq = lane >> 4;
    const int nt = g.nt;
    unsigned voffA[2], voffB[2];
#pragma unroll
    for (int i = 0; i < 2; ++i) { int R, C; stage_rc(tid * 16 + i * 8192, R, C); const int Rb = Epi::PERM ? ((R & ~31) + perm32(R & 31)) : R;
        voffA[i] = (unsigned)(R * g.ldaB + C * 2); voffB[i] = (unsigned)(Rb * g.ldbB + C * 2); }
    const size_t kstep = (size_t)(BK * 2);
    const size_t hstepA = (size_t)HALF * g.ldaB, hstepB = (size_t)HALF * g.ldbB;
    const unsigned ldsw = (unsigned)wid * 1024u;
    const int aoff = lds_byte(wr * 64 + fr, fq * 8), boff = lds_byte(wc * 32 + fr, fq * 8);
#define PG8_SA(b, h) (((b) * 2 + (h)) * HTB)
#define PG8_SB(b, h) ((4 + (b) * 2 + (h)) * HTB)
#define PG8_STAGE(bufoff, gbase, voff) do { _Pragma("unroll") for (int _i = 0; _i < 2; ++_i) \
        __builtin_amdgcn_global_load_lds((const unsigned*)((const char*)(gbase) + (voff)[_i]), (PG8_LAS unsigned*)(lds + (bufoff) + ldsw + _i * 8192), 16, 0, 0); } while (0)
#define PG8_LDA(dst, b, h) do { _Pragma("unroll") for (int m = 0; m < 4; ++m) _Pragma("unroll") for (int k = 0; k < 2; ++k) dst[m][k] = *(const PG8_LAS bf16x8*)(lds + PG8_SA(b, h) + aoff + m * 2048 + k * 1024); } while (0)
#define PG8_LDB(dst, b, h) do { _Pragma("unroll") for (int n = 0; n < 2; ++n) _Pragma("unroll") for (int k = 0; k < 2; ++k) dst[n][k] = *(const PG8_LAS bf16x8*)(lds + PG8_SB(b, h) + boff + n * 2048 + k * 1024); } while (0)
#define PG8_MMA(ai, bj, At, Bt) do { __builtin_amdgcn_s_setprio(1); _Pragma("unroll") for (int m = 0; m < 4; ++m) _Pragma("unroll") for (int n = 0; n < 2; ++n) { \
        if constexpr (FP8) { const i32x4 b0_ = __builtin_bit_cast(i32x4, Bt[n][0]), b1_ = __builtin_bit_cast(i32x4, Bt[n][1]), a0_ = __builtin_bit_cast(i32x4, At[m][0]), a1_ = __builtin_bit_cast(i32x4, At[m][1]); \
            const i32x8 B8_ = __builtin_shufflevector(b0_, b1_, 0, 1, 2, 3, 4, 5, 6, 7), A8_ = __builtin_shufflevector(a0_, a1_, 0, 1, 2, 3, 4, 5, 6, 7); \
            asm volatile("v_mfma_scale_f32_16x16x128_f8f6f4 %0, %1, %2, %0, %3, %3 op_sel:[0,1,0] op_sel_hi:[0,0,0]" : "+v"(acc[ai][bj][m][n]) : "v"(B8_), "v"(A8_), "v"(g.sc)); } \
        else { _Pragma("unroll") for (int k = 0; k < 2; ++k) acc[ai][bj][m][n] = __builtin_amdgcn_mfma_f32_16x16x32_bf16(Bt[n][k], At[m][k], acc[ai][bj][m][n], 0, 0, 0); } } \
        __builtin_amdgcn_s_setprio(0); } while (0)
#define PG8_WAIT_V(n) asm volatile("s_waitcnt vmcnt(" #n ")" ::: "memory")
#define PG8_WAIT_L(n) asm volatile("s_waitcnt lgkmcnt(" #n ")" ::: "memory")
#define PG8_BAR __builtin_amdgcn_s_barrier()
#define PG8_SCHED __builtin_amdgcn_sched_barrier(0)
    Unit cur, nxt; int ui = 0;
    if (!S.next(0, cur)) return;
    f32x4 acc[2][2][4][2];
#pragma unroll
    for (int a = 0; a < 2; ++a)
#pragma unroll
        for (int b = 0; b < 2; ++b)
#pragma unroll
            for (int m = 0; m < 4; ++m)
#pragma unroll
                for (int n = 0; n < 2; ++n) acc[a][b][m][n] = (f32x4){0.f, 0.f, 0.f, 0.f};
    bf16x8 At[4][2], B0[2][2], B1[2][2];
    const char* cA = cur.A; const char* cB = cur.B;
    S.a_ready(cur);
    if constexpr (SP2) {
        PG8_STAGE(PG8_SB(0, 0), cB, voffB); PG8_STAGE(PG8_SB(0, 1), cB + hstepB, voffB); PG8_STAGE(PG8_SA(0, 0), cA, voffA); PG8_STAGE(PG8_SA(0, 1), cA + hstepA, voffA);
        if (wr == 1) PG8_BAR;
        PG8_WAIT_V(2); PG8_BAR;
        PG8_STAGE(PG8_SB(1, 0), cB + kstep, voffB); PG8_STAGE(PG8_SA(1, 0), cA + kstep, voffA); PG8_STAGE(PG8_SB(1, 1), cB + hstepB + kstep, voffB);
        PG8_WAIT_V(6); PG8_BAR;
    } else {
        PG8_STAGE(PG8_SB(0, 0), cB, voffB); PG8_STAGE(PG8_SA(0, 0), cA, voffA); PG8_STAGE(PG8_SB(0, 1), cB + hstepB, voffB); PG8_STAGE(PG8_SA(0, 1), cA + hstepA, voffA);
        if (wr == 1) PG8_BAR;
        PG8_WAIT_V(4); PG8_BAR;
        PG8_STAGE(PG8_SB(1, 0), cB + kstep, voffB); PG8_STAGE(PG8_SA(1, 0), cA + kstep, voffA); PG8_STAGE(PG8_SB(1, 1), cB + hstepB + kstep, voffB);
        PG8_WAIT_V(6); PG8_BAR;
    }
    for (;;) {
        const bool has_next = S.next(ui + 1, nxt);
        const char* nA = has_next ? nxt.A : cA; const char* nB = has_next ? nxt.B : cB;
        for (int t = 0; t < nt; t += 2) {
            const bool last = (t == nt - 2);
            const char* a1 = cA + (size_t)(t + 1) * kstep;
            const char* a2 = last ? nA : cA + (size_t)(t + 2) * kstep; const char* b2 = last ? nB : cB + (size_t)(t + 2) * kstep;
            const char* a3 = a2 + kstep; const char* b3 = b2 + kstep;
            if (last && has_next) S.a_ready(nxt);
            if constexpr (SP2) {
            PG8_LDB(B0, 0, 0); PG8_LDB(B1, 0, 1); PG8_SCHED; PG8_LDA(At, 0, 0); PG8_STAGE(PG8_SA(1, 1), a1 + hstepA, voffA);
            PG8_WAIT_V(8); PG8_WAIT_L(0); PG8_BAR; PG8_MMA(0, 0, At, B0); PG8_MMA(0, 1, At, B1); PG8_BAR; PG8_SCHED;
            PG8_LDA(At, 0, 1); PG8_STAGE(PG8_SB(0, 0), b2, voffB); PG8_STAGE(PG8_SB(0, 1), b2 + hstepB, voffB); PG8_STAGE(PG8_SA(0, 0), a2, voffA);
            PG8_WAIT_V(8); PG8_WAIT_L(0); PG8_BAR; PG8_MMA(1, 0, At, B0); PG8_MMA(1, 1, At, B1); PG8_BAR; PG8_SCHED;
            PG8_LDB(B0, 1, 0); PG8_LDB(B1, 1, 1); PG8_SCHED; PG8_LDA(At, 1, 0); PG8_STAGE(PG8_SA(0, 1), a2 + hstepA, voffA);
            PG8_WAIT_V(8); PG8_WAIT_L(0); PG8_BAR; PG8_MMA(0, 0, At, B0); PG8_MMA(0, 1, At, B1); PG8_BAR; PG8_SCHED;
            PG8_LDA(At, 1, 1); PG8_STAGE(PG8_SB(1, 0), b3, voffB); PG8_STAGE(PG8_SB(1, 1), b3 + hstepB, voffB); PG8_STAGE(PG8_SA(1, 0), a3, voffA);
            PG8_WAIT_V(8); PG8_WAIT_L(0); PG8_BAR; PG8_MMA(1, 0, At, B0); PG8_MMA(1, 1, At, B1); PG8_BAR; PG8_SCHED;
            } else {
            PG8_LDB(B0, 0, 0); PG8_SCHED; PG8_LDA(At, 0, 0); PG8_STAGE(PG8_SA(1, 1), a1 + hstepA, voffA);
            PG8_WAIT_L(8); PG8_BAR; PG8_WAIT_L(0); PG8_MMA(0, 0, At, B0); PG8_BAR; PG8_SCHED;
            PG8_LDB(B1, 0, 1); PG8_STAGE(PG8_SB(0, 0), b2, voffB);
            PG8_BAR; PG8_WAIT_L(0); PG8_MMA(0, 1, At, B1); PG8_BAR;
            PG8_LDA(At, 0, 1); PG8_STAGE(PG8_SA(0, 0), a2, voffA);
            PG8_BAR; PG8_WAIT_L(0); PG8_MMA(1, 0, At, B0); PG8_BAR; PG8_SCHED;
            PG8_STAGE(PG8_SB(0, 1), b2 + hstepB, voffB);
            PG8_WAIT_V(6); PG8_BAR; PG8_MMA(1, 1, At, B1); PG8_BAR;
            PG8_LDB(B0, 1, 0); PG8_SCHED; PG8_LDA(At, 1, 0); PG8_STAGE(PG8_SA(0, 1), a2 + hstepA, voffA);
            PG8_WAIT_L(8); PG8_BAR; PG8_WAIT_L(0); PG8_MMA(0, 0, At, B0); PG8_BAR; PG8_SCHED;
            PG8_LDB(B1, 1, 1); PG8_STAGE(PG8_SB(1, 0), b3, voffB);
            PG8_BAR; PG8_WAIT_L(0); PG8_MMA(0, 1, At, B1); PG8_BAR;
            PG8_LDA(At, 1, 1); PG8_STAGE(PG8_SA(1, 0), a3, voffA);
            PG8_BAR; PG8_WAIT_L(0); PG8_MMA(1, 0, At, B0); PG8_BAR; PG8_SCHED;
            PG8_STAGE(PG8_SB(1, 1), b3 + hstepB, voffB);
            PG8_WAIT_V(6); PG8_BAR; PG8_MMA(1, 1, At, B1); PG8_BAR;
            }
        }
        if constexpr (ALIGN_EPI) { if (wr == 0) PG8_BAR; }
        if constexpr (FP8) asm volatile("s_nop 15\n\ts_nop 15\n\ts_nop 15" ::: "memory");
        if constexpr (!Epi::AFTER_DRAIN) { E(acc, cur, wr, wc); S.done(cur); }
        if (!has_next) break;
#pragma unroll
        for (int a = 0; a < 2; ++a)
#pragma unroll
            for (int b = 0; b < 2; ++b)
#pragma unroll
                for (int m = 0; m < 4; ++m)
#pragma unroll
                    for (int n = 0; n < 2; ++n) acc[a][b][m][n] = (f32x4){0.f, 0.f, 0.f, 0.f};
        cur = nxt; cA = nA; cB = nB; ++ui;
        if constexpr (ALIGN_EPI) { if (wr == 1) PG8_BAR; }
    }
    PG8_WAIT_V(0);
    if constexpr (!ALIGN_EPI) { if (wr == 0) PG8_BAR; }
    PG8_BAR;
    if constexpr (Epi::AFTER_DRAIN) { E.fused(acc, cur, wr, wc, fr, fq, lds, wid, lane); S.done(cur); }
#undef PG8_SA
#undef PG8_SB
#undef PG8_STAGE
#undef PG8_LDA
#undef PG8_LDB
#undef PG8_MMA
#undef PG8_WAIT_V
#undef PG8_WAIT_L
#undef PG8_BAR
#undef PG8_SCHED
}

}

#ifndef MOE_FP8
#define MOE_FP8 1
#endif
#ifndef FFN_FP8
#define FFN_FP8 0
#endif
constexpr size_t MiB = 1u << 20;
constexpr size_t WS_CTL = 0, CTL_ZERO_BYTES = 1 * MiB;
constexpr size_t WS_MOD = 1 * MiB;
constexpr size_t WS_TOK = 2 * MiB;
constexpr size_t WS_SB  = 3 * MiB;
constexpr size_t WS_POS = 6 * MiB;
constexpr size_t WS_XR  = 22 * MiB;
constexpr size_t WS_W   = 86 * MiB;
constexpr size_t W_WR = WS_W, W_WK = W_WR + 8 * MiB, W_WV = W_WK + 8 * MiB, W_WO = W_WV + 8 * MiB;
constexpr size_t W_WLD = W_WO + 8 * MiB, W_ALD = W_WLD + 1 * MiB, W_G1 = W_ALD + 1 * MiB;
constexpr size_t W_WLU = W_G1 + 1 * MiB, W_ALU = W_WLU + 2 * MiB, W_G2 = W_ALU + 2 * MiB;
constexpr size_t W_PW = W_G2 + 1 * MiB;
constexpr size_t W_F13 = W_PW + 2 * MiB;
constexpr size_t W_F2 = W_F13 + 44 * MiB;
constexpr size_t W_M13 = W_F2 + 22 * MiB;
constexpr size_t W_M2 = W_M13 + 448 * MiB;
constexpr size_t WS_A = W_M2 + 224 * MiB;
constexpr size_t A_A6 = WS_A, A6_STRIDE = 36 * MiB;
constexpr size_t A_R = WS_A + 216 * MiB, A_KX = WS_A + 248 * MiB, A_V = WS_A + 284 * MiB;
constexpr size_t A_LW = WS_A + 320 * MiB, A_LA = WS_A + 325 * MiB, A_G1O = WS_A + 330 * MiB;
constexpr size_t A_EW = WS_A + 336 * MiB, A_AA = WS_A + 408 * MiB;
constexpr size_t A_GATE = WS_A + 480 * MiB, A_YD = WS_A + 512 * MiB;
constexpr size_t A_AO = WS_A + 580 * MiB, A_YO = WS_A + 612 * MiB;
constexpr size_t A_H2 = WS_A, A_U = WS_A + 32 * MiB, A_YF = WS_A + 120 * MiB, A_HP = WS_A + 152 * MiB, A_PP = WS_A + 184 * MiB, A_YP = WS_A + 216 * MiB, A_H2B = WS_A + 248 * MiB;
constexpr size_t A_HG = WS_A + 280 * MiB, A_UG = WS_A + 352 * MiB, A_Y2 = WS_A + 604 * MiB;
constexpr size_t WS_END = WS_A + 676 * MiB;
static_assert(A_YO + 32 * MiB <= WS_END && A_Y2 + (size_t)MROWS_PAD * D * 2 <= WS_END && A_UG + (size_t)MROWS_PAD * DFE * 2 <= A_Y2 && A_HG + (size_t)MROWS_PAD * D * 2 <= A_UG, "ws map");
static_assert(W_M13 + (size_t)NE * 2 * DFE * D * 2 == W_M2 && W_M2 + (size_t)NE * D * DFE * 2 == WS_A && W_F13 + (size_t)2 * DFF * D * 2 == W_F2, "weight map");
constexpr int CW_BAR = 4096;
constexpr int CW_GCNT = 16384;

constexpr int LDS_BYTES = 147456;
constexpr int MISC_OFF = 131072 + 320;

#define XB_TMO      128
#define XB_XCNT(j)  (256  + 64 * (j))
#define XB_XSUB(j)  (1280 + 64 * (j))
#define XB_XGEN(j)  (2304 + 64 * (j))
#define XB_TOP      3328
#define XB_TOPGEN   3392
#define XCD_BAR_WORDS 3456
#define XB_SPIN_CAP (1u << 18)
__device__ __forceinline__ unsigned xb_ld(unsigned* p)              { return __hip_atomic_load(p, __ATOMIC_RELAXED, __HIP_MEMORY_SCOPE_AGENT); }
__device__ __forceinline__ unsigned xb_add(unsigned* p, unsigned v) { return __hip_atomic_fetch_add(p, v, __ATOMIC_RELAXED, __HIP_MEMORY_SCOPE_AGENT); }
__device__ __forceinline__ unsigned xb_xcc_id() { return (unsigned)__builtin_amdgcn_s_getreg((3 << 11) | 20) & 0xFu; }
#define XB_SPIN(cond, bar) do { unsigned _sp = 0; while (cond) { __builtin_amdgcn_s_sleep(1); \
    if ((++_sp & 255u) == 0u) { if (xb_ld(&(bar)[XB_TMO])) break; if (_sp > XB_SPIN_CAP) { atomicAdd(&(bar)[XB_TMO], 1u); break; } } } } while (0)
struct XcdBarrier { unsigned* bar; unsigned x; volatile LAS unsigned* st; };
__device__ __forceinline__ XcdBarrier xcd_barrier_post(unsigned* bar, volatile LAS unsigned* st) {
    XcdBarrier b; b.bar = bar; b.x = xb_xcc_id(); b.st = st;
    if (threadIdx.x == 0) (void)xb_add(&bar[XB_XCNT(b.x)], 1u);
    return b;
}
__device__ __forceinline__ void xcd_barrier_complete(unsigned* bar, unsigned x, unsigned& nloc, unsigned& nx) {
    const unsigned G = gridDim.x * gridDim.y * gridDim.z;
    unsigned sum, cnt, mine, sp = 0u;
    for (;;) {
        sum = 0u; cnt = 0u; mine = 0u;
#pragma unroll
        for (unsigned j = 0; j < 16; ++j) { const unsigned c = xb_ld(&bar[XB_XCNT(j)]); sum += c; cnt += (c > 0u) ? 1u : 0u; mine = (j == x) ? c : mine; }
        if (sum == G) break;
        __builtin_amdgcn_s_sleep(1);
        if ((++sp & 255u) == 0u) { if (xb_ld(&bar[XB_TMO])) break; if (sp > XB_SPIN_CAP) { atomicAdd(&bar[XB_TMO], 1u); break; } }
    }
    nloc = mine > 0u ? mine : 1u; nx = cnt > 0u ? cnt : 1u;
}
__device__ __forceinline__ void xcd_barrier(const XcdBarrier& b) {
    asm volatile("s_waitcnt vmcnt(0)" ::: "memory");
    __syncthreads();
    if (threadIdx.x == 0) {
        unsigned* bar = b.bar;
        __builtin_amdgcn_s_waitcnt(0);
        unsigned nloc = b.st[0], nx = b.st[1];
        if (nloc == 0u) { xcd_barrier_complete(bar, b.x, nloc, nx); b.st[0] = nloc; b.st[1] = nx; }
        const unsigned old = xb_add(&bar[XB_XSUB(b.x)], 1u);
        const unsigned gen = old / nloc;
        if (old + 1u == (gen + 1u) * nloc) {
            __builtin_amdgcn_fence(__ATOMIC_RELEASE, "agent");
            asm volatile("s_waitcnt vmcnt(0)" ::: "memory");
            const unsigned og = xb_add(&bar[XB_TOP], 1u);
            const unsigned tg = og / nx;
            if (og + 1u == (tg + 1u) * nx) xb_add(&bar[XB_TOPGEN], 1u);
            else XB_SPIN(xb_ld(&bar[XB_TOPGEN]) == tg, bar);
            __builtin_amdgcn_fence(__ATOMIC_ACQUIRE, "agent");
            xb_add(&bar[XB_XGEN(b.x)], 1u);
            asm volatile("s_waitcnt vmcnt(0)" ::: "memory");
        } else {
            XB_SPIN(xb_ld(&bar[XB_XGEN(b.x)]) == gen, bar);
            __builtin_amdgcn_fence(__ATOMIC_ACQUIRE, "agent");
            asm volatile("s_waitcnt vmcnt(0)" ::: "memory");
        }
    }
    __syncthreads();
}

struct Args { const float* in[35]; float* out; unsigned char* ws; int ph_lo, ph_hi, li, pad; };
static_assert(sizeof(Args) == 35 * 8 + 8 + 8 + 16, "Args has no padding");
enum In { I_X = 0, I_C, I_CTX, I_CCTX, I_WMOD, I_BMOD, I_LNW, I_LNB, I_MU, I_WR, I_WK, I_WV, I_WO, I_DW0, I_DW1, I_DW2, I_IA0, I_IA1, I_IA2, I_G1, I_G2, I_KK, I_KA, I_RK, I_GNW, I_GNB,
          I_POOLW, I_POOLS, I_FW1, I_FW3, I_FW2, I_ROUTER, I_MW1, I_MW3, I_MW2 };
struct Frame {
    LAS unsigned char* lds; int wave, vcu, G, gw, NGW;
    unsigned char* ws; unsigned* ctl;
};
#define LDS_WAIT() asm volatile("s_waitcnt lgkmcnt(0)" ::: "memory")
__device__ __forceinline__ void unpack8(const u32x4 w, float (&f)[8]) { f[0] = bflo(w.x); f[1] = bfhi(w.x); f[2] = bflo(w.y); f[3] = bfhi(w.y); f[4] = bflo(w.z); f[5] = bfhi(w.z); f[6] = bflo(w.w); f[7] = bfhi(w.w); }

__device__ __forceinline__ void p0_mod(const Frame& F, const Args& a) {
    const int lane = lane_id(), tid = F.wave * 64 + lane; (void)tid;
    LAS float* sc = (LAS float*)F.lds;
    LAS float* red = (LAS float*)(F.lds + 40960);
    const float* c = a.in[I_C]; const float* cc = a.in[I_CCTX];
    for (int i = tid; i < 5 * D; i += 512) { const int j = i / D, k = i % D; const float v = j < 4 ? c[j * D + k] : cc[k]; sc[i] = siluf_(v); }
    __syncthreads();
    float* MOD = (float*)(F.ws + WS_MOD);
    const int x = lane & 15, q = lane >> 4;
    for (int u = blockIdx.x; u < 2 * (MOD_N / 64); u += F.G) {
        const int l = u / (MOD_N / 64), cb = u % (MOD_N / 64);
        const float* W = a.in[I_WMOD] + (size_t)l * D * MOD_N + cb * 64 + 4 * x;
        float acc[5][4];
#pragma unroll
        for (int j = 0; j < 5; ++j)
#pragma unroll
            for (int e = 0; e < 4; ++e) acc[j][e] = 0.f;
#pragma unroll 8
        for (int i = 0; i < 64; ++i) {
            const int k = F.wave * 256 + 4 * i + q;
            const f32x4 w = *(const f32x4*)(W + (size_t)k * MOD_N);
#pragma unroll
            for (int j = 0; j < 5; ++j) { const float s = sc[j * D + k];
#pragma unroll
                for (int e = 0; e < 4; ++e) acc[j][e] += s * w[e]; }
        }
#pragma unroll
        for (int j = 0; j < 5; ++j)
#pragma unroll
            for (int e = 0; e < 4; ++e) { float v = acc[j][e]; v += __shfl_xor(v, 16); v += __shfl_xor(v, 32); acc[j][e] = v; }
        __syncthreads();
        if (q == 0) {
#pragma unroll
            for (int j = 0; j < 5; ++j)
#pragma unroll
                for (int e = 0; e < 4; ++e) red[(F.wave * 5 + j) * 64 + 4 * x + e] = acc[j][e];
        }
        __syncthreads();
        if (tid < 320) { const int j = tid / 64, col = tid % 64; float s = 0.f;
#pragma unroll
            for (int w = 0; w < 8; ++w) s += red[(w * 5 + j) * 64 + col];
            MOD[(size_t)(l * 5 + j) * MOD_N + cb * 64 + col] = s + a.in[I_BMOD][l * MOD_N + cb * 64 + col]; }
    }
    __syncthreads();
}
__device__ __forceinline__ void p0_pos(const Frame& F) {
    const int lane = lane_id(), tid = F.wave * 64 + lane; (void)tid;
    float* POS = (float*)(F.ws + WS_POS);
    for (int t = F.gw; t < T; t += F.NGW) {
        const float frow = (float)(t >> 6), fcol = (float)(t & 63);
#pragma unroll
        for (int j = 0; j < 8; ++j) { const int c0 = 4 * lane + 256 * j; f32x4 o;
#pragma unroll
            for (int e = 0; e < 4; ++e) { const int c = c0 + e, qi = c >> 9, i = c & 511;
                const float omega = fexp(-(float)i * (9.21034037197618f / 512.0f));
                float rev = ((qi < 2) ? frow : fcol) * omega * 0.15915494309189535f;
                rev -= floorf(rev);
                o[e] = (qi & 1) ? __builtin_amdgcn_cosf(rev) : __builtin_amdgcn_sinf(rev); }
            *(f32x4*)(POS + (size_t)t * D + c0) = o; }
    }
}
constexpr int TI_RWKV = 4096, TI_F1 = TI_RWKV + 2816, TI_F3 = TI_F1 + 2816, TI_F2 = TI_F3 + 2816, TI_POOL = TI_F2 + 256, TI_M1 = TI_POOL + 8 * 3584, TI_M3 = TI_M1 + 8 * 3584, TI_M2 = TI_M3 + 8 * 3584;
struct TrItem { const float* src; unsigned char* dst; int src_ld, dst_ld  , k0, n0, drow0, f8; float sc; };
__device__ __forceinline__ TrItem tr_decode(const Frame& F, const Args& a, int it) {
    TrItem t; t.f8 = 0; t.sc = 1.0f;
    if (it < TI_RWKV) { const int m = it >> 10, r = it & 1023, kb = r >> 5, nb = r & 31;
        t.src = a.in[I_WR + m]; t.src_ld = D; t.dst = F.ws + W_WR + (size_t)m * 8 * MiB; t.dst_ld = 2 * D; t.k0 = 64 * kb; t.n0 = 64 * nb; t.drow0 = 64 * nb; }
    else if (it < TI_F3) { const int w3 = it >= TI_F1, r = it - (w3 ? TI_F1 : TI_RWKV), kb = r / 88, nb = r % 88, n0 = 64 * nb;
        t.src = a.in[w3 ? I_FW3 : I_FW1]; t.src_ld = DFF; t.dst = F.ws + W_F13; t.dst_ld = FFN_FP8 ? D : 2 * D; t.k0 = 64 * kb; t.n0 = n0; t.drow0 = (n0 >> 7) * 256 + (n0 & 127) + 128 * w3; t.f8 = FFN_FP8; t.sc = FFN_FP8 ? 64.0f : 1.0f; }
    else if (it < TI_F2) { const int r = it - TI_F3, kb = r >> 5, nb = r & 31;
        t.src = a.in[I_FW2]; t.src_ld = D; t.dst = F.ws + W_F2; t.dst_ld = FFN_FP8 ? DFF : 2 * DFF; t.k0 = 64 * kb; t.n0 = 64 * nb; t.drow0 = 64 * nb; t.f8 = FFN_FP8; t.sc = FFN_FP8 ? 256.0f : 1.0f; }
    else if (it < TI_POOL) { const int r = it - TI_F2, g = r >> 6, kb = (r >> 3) & 7, nb = r & 7;
        t.src = a.in[I_POOLW] + (size_t)g * 512 * 512; t.src_ld = 512; t.dst = F.ws + W_PW + (size_t)g * 512 * 512 * 2; t.dst_ld = 2 * 512; t.k0 = 64 * kb; t.n0 = 64 * nb; t.drow0 = 64 * nb; }
    else if (it < TI_M3) { const int w3 = it >= TI_M1, r = it - (w3 ? TI_M1 : TI_POOL), e = r / 3584, rr = r % 3584, kb = rr / 112, nb = rr % 112, n0 = 64 * nb;
        t.src = a.in[w3 ? I_MW3 : I_MW1] + (size_t)e * D * DFE; t.src_ld = DFE; t.dst_ld = MOE_FP8 ? D : 2 * D; t.dst = F.ws + W_M13 + (size_t)e * 2 * DFE * t.dst_ld; t.k0 = 64 * kb; t.n0 = n0;
        t.drow0 = (n0 >> 7) * 256 + (n0 & 127) + 128 * w3; t.f8 = MOE_FP8; t.sc = MOE_FP8 ? 64.0f : 1.0f; }
    else { const int r = it - TI_M3, e = r / 3584, rr = r % 3584, kb = rr >> 5, nb = rr & 31;
        t.src = a.in[I_MW2] + (size_t)e * DFE * D; t.src_ld = D; t.dst_ld = MOE_FP8 ? DFE : 2 * DFE; t.dst = F.ws + W_M2 + (size_t)e * D * t.dst_ld; t.k0 = 64 * kb; t.n0 = 64 * nb; t.drow0 = 64 * nb; t.f8 = MOE_FP8; t.sc = MOE_FP8 ? 256.0f : 1.0f; }
    return t;
}
__device__ __forceinline__ void tr_load(const TrItem& t, f32x4 (&r)[4][4], int lane) {
    const int x = lane & 15, q = lane >> 4; const float* p = t.src + (size_t)(t.k0 + 4 * q) * t.src_ld + t.n0 + 4 * x;
#pragma unroll
    for (int i = 0; i < 4; ++i)
#pragma unroll
        for (int s = 0; s < 4; ++s) r[i][s] = __builtin_nontemporal_load((const f32x4*)(p + (size_t)(16 * i + s) * t.src_ld));
}
__device__ __forceinline__ void tr_store(const TrItem& t, const f32x4 (&r)[4][4], LAS unsigned* scr, int lane) {
    const int x = lane & 15, q = lane >> 4;
    if (t.f8) {
#pragma unroll
        for (int i = 0; i < 4; ++i)
#pragma unroll
            for (int jj = 0; jj < 4; ++jj) scr[(4 * x + jj) * 17 + 4 * i + q] = pk4_fp8(r[i][0][jj] * t.sc, r[i][1][jj] * t.sc, r[i][2][jj] * t.sc, r[i][3][jj] * t.sc);
        LDS_WAIT();
        const int c = lane & 3;
#pragma unroll
        for (int rr = 0; rr < 4; ++rr) { const int n = (lane >> 2) + 16 * rr; const LAS unsigned* s = scr + n * 17 + 4 * c;
            u32x4 o; o.x = s[0]; o.y = s[1]; o.z = s[2]; o.w = s[3];
            *(u32x4*)(t.dst + (size_t)(t.drow0 + n) * t.dst_ld + t.k0 + 16 * c) = o; }
    } else {
#pragma unroll
        for (int i = 0; i < 4; ++i)
#pragma unroll
            for (int jj = 0; jj < 4; ++jj) { scr[(4 * x + jj) * 33 + 8 * i + 2 * q] = pk2(r[i][0][jj], r[i][1][jj]); scr[(4 * x + jj) * 33 + 8 * i + 2 * q + 1] = pk2(r[i][2][jj], r[i][3][jj]); }
        LDS_WAIT();
        const int c = lane & 7;
#pragma unroll
        for (int rr = 0; rr < 8; ++rr) { const int n = (lane >> 3) + 8 * rr; const LAS unsigned* s = scr + n * 33 + 4 * c;
            u32x4 o; o.x = s[0]; o.y = s[1]; o.z = s[2]; o.w = s[3];
            *(u32x4*)(t.dst + (size_t)(t.drow0 + n) * t.dst_ld + 2 * (t.k0 + 8 * c)) = o; }
    }
    LDS_WAIT();
}
__device__ __forceinline__ void p0_transpose_range(const Frame& F, const Args& a, int lo, int hi, int gw, int ngw, LAS unsigned* scr) {
    const int lane = lane_id();
    int it = lo + gw; if (it >= hi) return;
    f32x4 ra[4][4], rb[4][4];
    TrItem ta = tr_decode(F, a, it), tb = ta; tr_load(ta, ra, lane);
    for (;;) {
        const int i2 = it + ngw; const bool h2 = i2 < hi;
        if (h2) { tb = tr_decode(F, a, i2); tr_load(tb, rb, lane); }
        tr_store(ta, ra, scr, lane);
        if (!h2) break;
        const int i3 = i2 + ngw; const bool h3 = i3 < hi;
        if (h3) { ta = tr_decode(F, a, i3); tr_load(ta, ra, lane); }
        tr_store(tb, rb, scr, lane);
        if (!h3) break;
        it = i3;
    }
}
__device__ __forceinline__ void p0_small(const Frame& F, const Args& a) {
    const int lane = lane_id(), tid = F.wave * 64 + lane; (void)tid;
    bf16_t* WLD = (bf16_t*)(F.ws + W_WLD); bf16_t* ALD = (bf16_t*)(F.ws + W_ALD); bf16_t* G1T = (bf16_t*)(F.ws + W_G1);
    bf16_t* WLU = (bf16_t*)(F.ws + W_WLU); bf16_t* ALU = (bf16_t*)(F.ws + W_ALU); bf16_t* G2T = (bf16_t*)(F.ws + W_G2);
    const int gt = F.gw * 64 + lane, NT_ = F.NGW * 64;
    for (int i = gt; i < 256 * D; i += NT_) { const int n = i >> 11, k = i & 2047;
        float w = 0.f, v = 0.f;
        if (n < 192) { const int d = n >= 96, nn = n - 96 * d; w = a.in[I_DW1][((size_t)d * D + k) * 96 + nn]; v = a.in[I_IA1][((size_t)d * D + k) * 96 + nn]; }
        WLD[i] = (bf16_t)f2bf(w); ALD[i] = (bf16_t)f2bf(v); G1T[i] = (bf16_t)f2bf(a.in[I_G1][(size_t)k * 256 + n]); }
    for (int i = gt; i < 2 * D * 256; i += NT_) { const int n = i >> 8, k = i & 255, d = n >> 11, cidx = n & 2047, kk = k - 96 * d;
        float w = 0.f, v = 0.f;
        if (kk >= 0 && kk < 96) { w = a.in[I_DW2][((size_t)d * 96 + kk) * D + cidx]; v = a.in[I_IA2][((size_t)d * 96 + kk) * D + cidx]; }
        WLU[i] = (bf16_t)f2bf(w); ALU[i] = (bf16_t)f2bf(v); }
    for (int i = gt; i < D * 256; i += NT_) { const int n = i >> 8, k = i & 255; G2T[i] = (bf16_t)f2bf(a.in[I_G2][(size_t)k * D + n]); }
}

__device__ __forceinline__ void p1_mix(const Frame& F, const Args& a) {
    const int lane = lane_id(), tid = F.wave * 64 + lane; (void)tid;
    const float* MOD = (const float*)(F.ws + WS_MOD); const float* POS = (const float*)(F.ws + WS_POS);
    float* XR = (float*)(F.ws + WS_XR);
    for (int blk = F.gw; blk < MT / 8; blk += F.NGW) {
        const int m0 = blk * 8; const bool lat = m0 < ML;
        int t0, Tseq, modrow; const float* xs;
        if (lat) { t0 = m0 % T; Tseq = T; modrow = m0 / T; xs = a.in[I_X] + (size_t)m0 * D; }
        else { const int mm = m0 - ML; t0 = mm % TC; Tseq = TC; modrow = 4; xs = a.in[I_CTX] + (size_t)mm * D; }
        const float* sh = MOD + (size_t)modrow * MOD_N; const float* scp = sh + D;
        const float* ps = POS + (size_t)t0 * D;
        for (int j = 0; j < 8; ++j) {
            const int c = 4 * lane + 256 * j;
            const f32x4 shv = *(const f32x4*)(sh + c); const f32x4 scv = *(const f32x4*)(scp + c) + 1.0f;
            f32x4 mu[6];
#pragma unroll
            for (int n = 0; n < 6; ++n) mu[n] = *(const f32x4*)(a.in[I_MU] + n * D + c);
            f32x4 hm1 = (f32x4){0.f, 0.f, 0.f, 0.f}, h0, x00;
            if (t0 > 0) { f32x4 xv = *(const f32x4*)(xs - D + c); if (lat) xv += *(const f32x4*)(ps - D + c); hm1 = xv * scv + shv; }
            { x00 = *(const f32x4*)(xs + c); if (lat) x00 += *(const f32x4*)(ps + c); h0 = x00 * scv + shv; }
            for (int r = 0; r < 8; ++r) {
                f32x4 hp1 = (f32x4){0.f, 0.f, 0.f, 0.f}, x0n = (f32x4){0.f, 0.f, 0.f, 0.f};
                if (t0 + r + 1 < Tseq) { x0n = *(const f32x4*)(xs + (size_t)(r + 1) * D + c); if (lat) x0n += *(const f32x4*)(ps + (size_t)(r + 1) * D + c); hp1 = x0n * scv + shv; }
                const f32x4 xx = (hm1 + hp1) * 0.5f - h0;
                const size_t o = (size_t)(m0 + r) * D + c;
#pragma unroll
                for (int n = 0; n < 6; ++n) { if (!lat && (n == 0 || n == 5)) continue;
                    const f32x4 v = h0 + xx * mu[n]; u32x2 w; w.x = pk2(v[0], v[1]); w.y = pk2(v[2], v[3]);
                    *(u32x2*)((bf16_t*)(F.ws + A_A6 + (size_t)n * A6_STRIDE) + o) = w; }
                if (lat) *(f32x4*)(XR + o) = x00;
                hm1 = h0; h0 = hp1; x00 = x0n;
            }
        }
    }
}

__device__ __forceinline__ void p4_scan(const Frame& F, const Args& a) {
    const int lane = lane_id(), tid = F.wave * 64 + lane; (void)tid;
    LAS float* OP = (LAS float*)F.lds;
    LAS float* YS = (LAS float*)(F.lds + 49152);
    const bf16_t* KX = (const bf16_t*)(F.ws + A_KX); const bf16_t* VV = (const bf16_t*)(F.ws + A_V); const bf16_t* RR = (const bf16_t*)(F.ws + A_R);
    const bf16_t* EW = (const bf16_t*)(F.ws + A_EW); const bf16_t* AA = (const bf16_t*)(F.ws + A_AA);
    const int tl = tid >> 5, cp = tid & 31, vi = tid >> 3, kg = tid & 7;
    for (int s = blockIdx.x; s < NB * NH * 2; s += F.G) {
        const int b = s >> 6, h = (s >> 1) & 31, d = s & 1;
        const int ch = h * HS + 2 * cp;
        const float kkc0 = a.in[I_KK][ch], kkc1 = a.in[I_KK][ch + 1], kac0 = a.in[I_KA][ch], kac1 = a.in[I_KA][ch + 1], rkc0 = a.in[I_RK][ch], rkc1 = a.in[I_RK][ch + 1];
        bf16_t* YD = (bf16_t*)(F.ws + A_YD + (size_t)d * 32 * MiB); float* SB = (float*)(F.ws + WS_SB) + (size_t)d * ML * NH;
        float S[8];
#pragma unroll
        for (int j = 0; j < 8; ++j) S[j] = 0.f;
        unsigned rk = 0, rv = 0, rr = 0, re = 0, ra = 0;
#define SCAN_ROW0(ci) (((ci) < 16) ? (ML + b * TC + (d ? 15 - (ci) : (ci)) * 16) : (b * T + (d ? 127 - ((ci) - 16) : ((ci) - 16)) * 16))
#define SCAN_LOAD(ci) do { const int row_ = SCAN_ROW0(ci) + tl; const size_t o_ = (size_t)row_ * D + ch, o2_ = (size_t)row_ * (2 * D) + d * D + ch; \
        rk = *(const unsigned*)(KX + o_); rv = *(const unsigned*)(VV + o_); rr = ((ci) >= 16) ? *(const unsigned*)(RR + o_) : 0u; re = *(const unsigned*)(EW + o2_); ra = *(const unsigned*)(AA + o2_); } while (0)
#define SCAN_PREP(ci) do { LAS float* B_ = OP + ((ci) & 1) * 6144 + tl * 64 + 2 * cp; \
        const float k0 = bflo(rk), k1 = bfhi(rk), q0 = k0 * kkc0, q1 = k1 * kkc1; float n2 = q0 * q0 + q1 * q1; \
        n2 += __shfl_xor(n2, 1); n2 += __shfl_xor(n2, 2); n2 += __shfl_xor(n2, 4); n2 += __shfl_xor(n2, 8); n2 += __shfl_xor(n2, 16); \
        const float inv = 1.0f / fmaxf(sqrtf(n2), 1e-12f), kn0 = q0 * inv, kn1 = q1 * inv; \
        const float a0 = bflo(ra), a1 = bfhi(ra), kd0 = k0 * (1.0f + (a0 - 1.0f) * kac0), kd1 = k1 * (1.0f + (a1 - 1.0f) * kac1); \
        const float r0 = bflo(rr), r1 = bfhi(rr); \
        *(LAS f32x2*)(B_ + 0 * 1024) = (f32x2){kn0, kn1}; \
        *(LAS f32x2*)(B_ + 1 * 1024) = (f32x2){fexp(-bflo(re)), fexp(-bfhi(re))}; \
        *(LAS f32x2*)(B_ + 2 * 1024) = (f32x2){kn0 * a0, kn1 * a1}; \
        *(LAS f32x2*)(B_ + 3 * 1024) = (f32x2){kd0, kd1}; \
        *(LAS f32x2*)(B_ + 4 * 1024) = (f32x2){r0, r1}; \
        *(LAS f32x2*)(B_ + 5 * 1024) = (f32x2){bflo(rv), bfhi(rv)}; \
        if ((ci) >= 16) { float sb = r0 * kd0 * rkc0 + r1 * kd1 * rkc1; \
            sb += __shfl_xor(sb, 1); sb += __shfl_xor(sb, 2); sb += __shfl_xor(sb, 4); sb += __shfl_xor(sb, 8); sb += __shfl_xor(sb, 16); \
            if (cp == 0) SB[(size_t)(SCAN_ROW0(ci) + tl) * NH + h] = sb; } } while (0)
        __syncthreads();
        SCAN_LOAD(0); SCAN_PREP(0);
        __syncthreads();
        for (int ci = 0; ci < 144; ++ci) {
            if (ci + 1 < 144) SCAN_LOAD(ci + 1);
            const LAS float* B = OP + (ci & 1) * 6144; LAS float* Y = YS + (ci & 1) * 1024;
#pragma unroll 4
            for (int st = 0; st < 16; ++st) {
                const int tk = d ? 15 - st : st; const LAS float* p = B + tk * 64 + 8 * kg;
                const f32x4 kkA = *(const LAS f32x4*)(p), kkB = *(const LAS f32x4*)(p + 4);
                const f32x4 wA = *(const LAS f32x4*)(p + 1024), wB = *(const LAS f32x4*)(p + 1028);
                const f32x4 bA = *(const LAS f32x4*)(p + 2048), bB = *(const LAS f32x4*)(p + 2052);
                const f32x4 dA = *(const LAS f32x4*)(p + 3072), dB = *(const LAS f32x4*)(p + 3076);
                const f32x4 rA = *(const LAS f32x4*)(p + 4096), rB = *(const LAS f32x4*)(p + 4100);
                const float v = B[5 * 1024 + tk * 64 + vi];
                float sa = (S[0] * kkA[0] + S[1] * kkA[1]) + (S[2] * kkA[2] + S[3] * kkA[3]) + (S[4] * kkB[0] + S[5] * kkB[1]) + (S[6] * kkB[2] + S[7] * kkB[3]);
                sa = sum8(sa);
#pragma unroll
                for (int j = 0; j < 4; ++j) { S[j] = S[j] * wA[j] + (v * dA[j] - sa * bA[j]); S[4 + j] = S[4 + j] * wB[j] + (v * dB[j] - sa * bB[j]); }
                float y = (S[0] * rA[0] + S[1] * rA[1]) + (S[2] * rA[2] + S[3] * rA[3]) + (S[4] * rB[0] + S[5] * rB[1]) + (S[6] * rB[2] + S[7] * rB[3]);
                y = sum8(y);
                if (kg == 0) Y[tk * 64 + vi] = y;
            }
            if (ci + 1 < 144) SCAN_PREP(ci + 1);
            __syncthreads();
            if (ci >= 16) { const f32x2 yv = *(const LAS f32x2*)(Y + tl * 64 + 2 * cp);
                *(unsigned*)(YD + (size_t)(SCAN_ROW0(ci) + tl) * D + ch) = pk2(yv.x, yv.y); }
        }
#undef SCAN_ROW0
#undef SCAN_LOAD
#undef SCAN_PREP
    }
    __syncthreads();
}

constexpr int SL_KA = 0, SL_RM = 2048, SL_BK = 4096, SL_VC = 8192, SL_ARK = 10240, SL_AAK = 11264, SL_TN = 11776, SL_GC = 12288, SL_BYTES = 12544;
constexpr int SC_PAR = 8 * SL_BYTES;
typedef short s16x8 __attribute__((ext_vector_type(8)));
__device__ __forceinline__ s16x8 mk8(unsigned a, unsigned b, unsigned c, unsigned d) { u32x4 v; v.x = a; v.y = b; v.z = c; v.w = d; return __builtin_bit_cast(s16x8, v); }
__device__ __forceinline__ f32x4 mfma16(s16x8 a, s16x8 b, f32x4 c) { return __builtin_amdgcn_mfma_f32_16x16x32_bf16(a, b, c, 0, 0, 0); }
__device__ __forceinline__ s16x8 mk_d(const f32x4 x) { return mk8(pk2(x[0], x[1]), pk2(x[2], x[3]), 0u, 0u); }
__device__ __forceinline__ void p4_scan2(const Frame& F, const Args& a, unsigned char* yd_base, float* sb_base) {
    const int lane = lane_id(), tt = lane & 15, q = lane >> 4;
    const bf16_t* KX = (const bf16_t*)(F.ws + A_KX); const bf16_t* VV = (const bf16_t*)(F.ws + A_V); const bf16_t* RR = (const bf16_t*)(F.ws + A_R);
    const bf16_t* EW = (const bf16_t*)(F.ws + A_EW); const bf16_t* AA = (const bf16_t*)(F.ws + A_AA);
    LAS unsigned char* slot_w = F.lds + F.wave * SL_BYTES;
    LAS float* PAR = (LAS float*)(F.lds + SC_PAR);
    s16x8 SelF[2];
#pragma unroll
    for (int sel = 0; sel < 2; ++sel) { unsigned w[4];
#pragma unroll
        for (int jj = 0; jj < 4; ++jj) { const int j0 = 2 * jj, j1 = 2 * jj + 1; const bool h0 = (q == (tt >> 2)) && (j0 == 4 * sel + (tt & 3)), h1 = (q == (tt >> 2)) && (j1 == 4 * sel + (tt & 3));
            w[jj] = (h0 ? 0x3f80u : 0u) | (h1 ? 0x3f800000u : 0u); }
        SelF[sel] = mk8(w[0], w[1], w[2], w[3]); }
    for (int s = blockIdx.x; s < NB * NH * 2; s += F.G) {
        const int b = s >> 6, h = (s >> 1) & 31, d = s & 1;
        bf16_t* YD = (bf16_t*)(yd_base + (size_t)d * 32 * MiB); float* SB = sb_base + (size_t)d * ML * NH;
        __syncthreads();
        if (F.wave == 0) { PAR[lane] = a.in[I_KK][h * HS + lane]; PAR[64 + lane] = a.in[I_KA][h * HS + lane]; PAR[128 + lane] = a.in[I_RK][h * HS + lane]; }
        __syncthreads();
        f32x4 G[4];
#pragma unroll
        for (int tk = 0; tk < 4; ++tk) G[tk] = (f32x4){0.f, 0.f, 0.f, 0.f};
#define S2_ROW0(ci) (((ci) < 16) ? (ML + b * TC + (d ? 15 - (ci) : (ci)) * 16) : (b * T + (d ? 127 - ((ci) - 16) : ((ci) - 16)) * 16))
        u32x2 rk[4], rv[4], rr[4], re[4], ra[4];
#define S2_LOAD(ci) do { const int row_ = S2_ROW0(ci) + (d ? 15 - tt : tt); const size_t o_ = (size_t)row_ * D + h * HS + 4 * q, o2_ = (size_t)row_ * (2 * D) + d * D + h * HS + 4 * q; \
        _Pragma("unroll") for (int g_ = 0; g_ < 4; ++g_) { rk[g_] = *(const u32x2*)(KX + o_ + 16 * g_); rv[g_] = *(const u32x2*)(VV + o_ + 16 * g_); \
            rr[g_] = ((ci) >= 16) ? *(const u32x2*)(RR + o_ + 16 * g_) : (u32x2){0u, 0u}; re[g_] = *(const u32x2*)(EW + o2_ + 16 * g_); ra[g_] = *(const u32x2*)(AA + o2_ + 16 * g_); } } while (0)
        S2_LOAD(F.wave);
        for (int rnd = 0; rnd < 18; ++rnd) {
            const int ci = rnd * 8 + F.wave; const bool lat = rnd >= 2;
            {
                float kf[4][4], af[4][4], ef[4][4], vf[4][4], rf[4][4];
#pragma unroll
                for (int g = 0; g < 4; ++g) {
                    kf[g][0] = bflo(rk[g].x); kf[g][1] = bfhi(rk[g].x); kf[g][2] = bflo(rk[g].y); kf[g][3] = bfhi(rk[g].y);
                    af[g][0] = bflo(ra[g].x); af[g][1] = bfhi(ra[g].x); af[g][2] = bflo(ra[g].y); af[g][3] = bfhi(ra[g].y);
                    ef[g][0] = bflo(re[g].x); ef[g][1] = bfhi(re[g].x); ef[g][2] = bflo(re[g].y); ef[g][3] = bfhi(re[g].y);
                    vf[g][0] = bflo(rv[g].x); vf[g][1] = bfhi(rv[g].x); vf[g][2] = bflo(rv[g].y); vf[g][3] = bfhi(rv[g].y);
                    rf[g][0] = bflo(rr[g].x); rf[g][1] = bfhi(rr[g].x); rf[g][2] = bflo(rr[g].y); rf[g][3] = bfhi(rr[g].y); }
                unsigned VP[4][2];
#pragma unroll
                for (int g = 0; g < 4; ++g) { VP[g][0] = rv[g].x; VP[g][1] = rv[g].y; }
                if (rnd + 1 < 18) S2_LOAD((rnd + 1) * 8 + F.wave);
                float kkv[4][4]; float n2 = 0.f;
#pragma unroll
                for (int g = 0; g < 4; ++g) { const f32x4 kc = *(const LAS f32x4*)(PAR + 16 * g + 4 * q);
#pragma unroll
                    for (int i = 0; i < 4; ++i) { kkv[g][i] = kf[g][i] * kc[i]; n2 += kkv[g][i] * kkv[g][i]; } }
                n2 += __shfl_xor(n2, 16); n2 += __shfl_xor(n2, 32);
                const float inv = 1.0f / fmaxf(sqrtf(n2), 1e-12f);
                float sb = 0.f;
                unsigned KaP[4][2], BmP[4][2], KmP[4][2], RmP[4][2]; f32x4 gend[4];
#pragma unroll
                for (int g = 0; g < 4; ++g) { const f32x4 kac = *(const LAS f32x4*)(PAR + 64 + 16 * g + 4 * q), rkc = *(const LAS f32x4*)(PAR + 128 + 16 * g + 4 * q);
                    float ka_[4], bm_[4], km_[4], rm_[4];
#pragma unroll
                    for (int i = 0; i < 4; ++i) {
                        float L = ef[g][i];
                        L += dpp_f<0x111>(L); L += dpp_f<0x112>(L); L += dpp_f<0x114>(L); L += dpp_f<0x118>(L);
                        const float gt = fexp(-L), gi = fexp(L), gm1 = fexp(ef[g][i] - L);
                        const float kk = kkv[g][i] * inv, kd = kf[g][i] * (1.0f + (af[g][i] - 1.0f) * kac[i]);
                        ka_[i] = kk * gm1; bm_[i] = kk * af[g][i] * gi; km_[i] = kd * gi; rm_[i] = rf[g][i] * gt;
                        sb += rf[g][i] * kd * rkc[i]; gend[g][i] = gt; }
                    KaP[g][0] = pk2(ka_[0], ka_[1]); KaP[g][1] = pk2(ka_[2], ka_[3]); BmP[g][0] = pk2(bm_[0], bm_[1]); BmP[g][1] = pk2(bm_[2], bm_[3]);
                    KmP[g][0] = pk2(km_[0], km_[1]); KmP[g][1] = pk2(km_[2], km_[3]); RmP[g][0] = pk2(rm_[0], rm_[1]); RmP[g][1] = pk2(rm_[2], rm_[3]);
                }
                if (lat) { sb += __shfl_xor(sb, 16); sb += __shfl_xor(sb, 32); if (q == 0) SB[(size_t)(S2_ROW0(ci) + (d ? 15 - tt : tt)) * NH + h] = sb; }
                s16x8 KaF[2], BmF[2], KmF[2], RmF[2], VF[2];
#pragma unroll
                for (int kb = 0; kb < 2; ++kb) { KaF[kb] = mk8(KaP[2 * kb][0], KaP[2 * kb][1], KaP[2 * kb + 1][0], KaP[2 * kb + 1][1]); BmF[kb] = mk8(BmP[2 * kb][0], BmP[2 * kb][1], BmP[2 * kb + 1][0], BmP[2 * kb + 1][1]);
                    KmF[kb] = mk8(KmP[2 * kb][0], KmP[2 * kb][1], KmP[2 * kb + 1][0], KmP[2 * kb + 1][1]); RmF[kb] = mk8(RmP[2 * kb][0], RmP[2 * kb][1], RmP[2 * kb + 1][0], RmP[2 * kb + 1][1]);
                    VF[kb] = mk8(VP[2 * kb][0], VP[2 * kb][1], VP[2 * kb + 1][0], VP[2 * kb + 1][1]); }
                const f32x4 Z = (f32x4){0.f, 0.f, 0.f, 0.f};
                f32x4 Nd = mfma16(KaF[1], BmF[1], mfma16(KaF[0], BmF[0], Z));
                f32x4 Nt = mfma16(BmF[1], KaF[1], mfma16(BmF[0], KaF[0], Z));
                f32x4 AakT = mfma16(KmF[1], KaF[1], mfma16(KmF[0], KaF[0], Z));
                f32x4 ArbT = mfma16(BmF[1], RmF[1], mfma16(BmF[0], RmF[0], Z));
                f32x4 ArkT = mfma16(KmF[1], RmF[1], mfma16(KmF[0], RmF[0], Z));
                f32x4 Q0;
#pragma unroll
                for (int r = 0; r < 4; ++r) { const int row = 4 * q + r;
                    Nd[r] = row > tt ? Nd[r] : 0.f; Nt[r] = row < tt ? Nt[r] : 0.f; AakT[r] = row < tt ? AakT[r] : 0.f; ArbT[r] = row <= tt ? ArbT[r] : 0.f; ArkT[r] = row <= tt ? ArkT[r] : 0.f;
                    Q0[r] = (row == tt ? 1.0f : 0.f) - Nt[r]; }
                const s16x8 oN = mk_d(Nd), oNt = mk_d(Nt);
                const f32x4 N2 = mfma16(oNt, oN, Z), N2t = mfma16(oN, oNt, Z);
                const s16x8 oN2 = mk_d(N2), oN2t = mk_d(N2t);
                const f32x4 N4 = mfma16(oN2t, oN2, Z), N4t = mfma16(oN2, oN2t, Z);
                const s16x8 oN4 = mk_d(N4), oN4t = mk_d(N4t);
                const f32x4 N8 = mfma16(oN4t, oN4, Z);
                const f32x4 Q1 = mfma16(oN2, mk_d(Q0), Q0);
                const f32x4 Q2 = mfma16(oN4, mk_d(Q1), Q1);
                const f32x4 Q3 = mfma16(mk_d(N8), mk_d(Q2), Q2);
                *(LAS u32x4*)(slot_w + SL_KA + lane * 16) = __builtin_bit_cast(u32x4, KaF[0]); *(LAS u32x4*)(slot_w + SL_KA + 1024 + lane * 16) = __builtin_bit_cast(u32x4, KaF[1]);
                *(LAS u32x4*)(slot_w + SL_RM + lane * 16) = __builtin_bit_cast(u32x4, RmF[0]); *(LAS u32x4*)(slot_w + SL_RM + 1024 + lane * 16) = __builtin_bit_cast(u32x4, RmF[1]);
                *(LAS u32x2*)(slot_w + SL_TN + lane * 8) = (u32x2){pk2(-Q3[0], -Q3[1]), pk2(-Q3[2], -Q3[3])};
                *(LAS u32x2*)(slot_w + SL_AAK + lane * 8) = (u32x2){pk2(AakT[0], AakT[1]), pk2(AakT[2], AakT[3])};
                *(LAS u32x4*)(slot_w + SL_ARK + lane * 16) = (u32x4){pk2(ArbT[0], ArbT[1]), pk2(ArbT[2], ArbT[3]), pk2(ArkT[0], ArkT[1]), pk2(ArkT[2], ArkT[3])};
#pragma unroll
                for (int kb = 0; kb < 2; ++kb)
#pragma unroll
                    for (int sel = 0; sel < 2; ++sel) { const int tk = 2 * kb + sel;
                        const f32x4 DB = mfma16(BmF[kb], SelF[sel], Z), DK = mfma16(KmF[kb], SelF[sel], Z), DV = mfma16(VF[kb], SelF[sel], Z);
                        *(LAS u32x4*)(slot_w + SL_BK + tk * 1024 + lane * 16) = (u32x4){pk2(DB[0], DB[1]), pk2(DB[2], DB[3]), pk2(DK[0], DK[1]), pk2(DK[2], DK[3])};
                        *(LAS u32x2*)(slot_w + SL_VC + tk * 512 + lane * 8) = (u32x2){pk2(DV[0], DV[1]), pk2(DV[2], DV[3])}; }
                if (tt == 15) {
#pragma unroll
                    for (int g = 0; g < 4; ++g) *(LAS f32x4*)(slot_w + SL_GC + (g * 4 + q) * 16) = gend[g]; }
            }
            __syncthreads();
            if (F.wave < 4) {
                const int tv = F.wave;
                for (int sl = 0; sl < 8; ++sl) {
                    LAS unsigned char* S = F.lds + sl * SL_BYTES; const int cj = rnd * 8 + sl;
                    const s16x8 KA0 = __builtin_bit_cast(s16x8, *(LAS u32x4*)(S + SL_KA + lane * 16)), KA1 = __builtin_bit_cast(s16x8, *(LAS u32x4*)(S + SL_KA + 1024 + lane * 16));
                    const u32x2 aak = *(LAS u32x2*)(S + SL_AAK + lane * 8), tn = *(LAS u32x2*)(S + SL_TN + lane * 8), vc = *(LAS u32x2*)(S + SL_VC + tv * 512 + lane * 8);
                    const s16x8 Gb0 = mk8(pk2(G[0][0], G[0][1]), pk2(G[0][2], G[0][3]), pk2(G[1][0], G[1][1]), pk2(G[1][2], G[1][3]));
                    const s16x8 Gb1 = mk8(pk2(G[2][0], G[2][1]), pk2(G[2][2], G[2][3]), pk2(G[3][0], G[3][1]), pk2(G[3][2], G[3][3]));
                    const f32x4 Z = (f32x4){0.f, 0.f, 0.f, 0.f};
                    f32x4 P = mfma16(KA0, Gb0, Z); P = mfma16(KA1, Gb1, P); P = mfma16(mk8(aak.x, aak.y, 0u, 0u), mk8(vc.x, vc.y, 0u, 0u), P);
                    const f32x4 U = mfma16(mk8(tn.x, tn.y, 0u, 0u), mk_d(P), Z);
                    const s16x8 UV = mk8(pk2(U[0], U[1]), pk2(U[2], U[3]), vc.x, vc.y);
                    if (lat) {
                        const s16x8 RM0 = __builtin_bit_cast(s16x8, *(LAS u32x4*)(S + SL_RM + lane * 16)), RM1 = __builtin_bit_cast(s16x8, *(LAS u32x4*)(S + SL_RM + 1024 + lane * 16));
                        const s16x8 ARK = __builtin_bit_cast(s16x8, *(LAS u32x4*)(S + SL_ARK + lane * 16));
                        f32x4 Y = mfma16(Gb0, RM0, Z); Y = mfma16(Gb1, RM1, Y); Y = mfma16(UV, ARK, Y);
                        *(u32x2*)(YD + (size_t)(S2_ROW0(cj) + (d ? 15 - tt : tt)) * D + h * HS + 16 * tv + 4 * q) = (u32x2){pk2(Y[0], Y[1]), pk2(Y[2], Y[3])};
                    }
#pragma unroll
                    for (int tk = 0; tk < 4; ++tk) { const s16x8 BK = __builtin_bit_cast(s16x8, *(LAS u32x4*)(S + SL_BK + tk * 1024 + lane * 16));
                        G[tk] = mfma16(BK, UV, G[tk]); G[tk] = G[tk] * *(LAS f32x4*)(S + SL_GC + (tk * 4 + q) * 16); }
                }
            }
            __syncthreads();
        }
#undef S2_ROW0
#undef S2_LOAD
    }
    __syncthreads();
}

#if defined(PROBE_SCANCHK)
constexpr int CW_CHK = 20480;
__device__ __forceinline__ void p4_compare(const Frame& F) {
    const int lane = lane_id();
    const bf16_t* Y0 = (const bf16_t*)(F.ws + A_YD); const bf16_t* Y1 = (const bf16_t*)(F.ws + A_AO);
    const float* S0 = (const float*)(F.ws + WS_SB); const float* S1 = (const float*)(F.ws + WS_A + 644 * MiB);
    float num = 0.f, den = 0.f, num2 = 0.f, den2 = 0.f;
    for (size_t i = (size_t)F.gw * 64 + lane; i < (size_t)2 * ML * D / 8; i += (size_t)F.NGW * 64) { float a8[8], b8[8]; unpack8(((const u32x4*)Y0)[i], a8); unpack8(((const u32x4*)Y1)[i], b8);
#pragma unroll
        for (int e = 0; e < 8; ++e) { const float dd = b8[e] - a8[e]; num += dd * dd; den += a8[e] * a8[e]; } }
    for (size_t i = (size_t)F.gw * 64 + lane; i < (size_t)2 * ML * NH; i += (size_t)F.NGW * 64) { const float dd = S1[i] - S0[i]; num2 += dd * dd; den2 += S0[i] * S0[i]; }
    num = wave_sum(num); den = wave_sum(den); num2 = wave_sum(num2); den2 = wave_sum(den2);
    if (lane == 0) { atomicAdd((float*)(F.ctl + CW_CHK), num); atomicAdd((float*)(F.ctl + CW_CHK + 64), den); atomicAdd((float*)(F.ctl + CW_CHK + 128), num2); atomicAdd((float*)(F.ctl + CW_CHK + 192), den2); }
}
#endif
__device__ __forceinline__ void p5_ao(const Frame& F, const Args& a) {
    const int lane = lane_id(), tid = F.wave * 64 + lane; (void)tid;
    const bf16_t* Y0 = (const bf16_t*)(F.ws + A_YD); const bf16_t* Y1 = (const bf16_t*)(F.ws + A_YD + 32 * MiB);
    const bf16_t* VV = (const bf16_t*)(F.ws + A_V); const bf16_t* GT = (const bf16_t*)(F.ws + A_GATE); bf16_t* AO = (bf16_t*)(F.ws + A_AO);
    const float* SB0 = (const float*)(F.ws + WS_SB); const float* SB1 = SB0 + (size_t)ML * NH;
    for (int m = F.gw; m < ML; m += F.NGW) {
#pragma unroll
        for (int j = 0; j < 4; ++j) {
            const int c = 8 * lane + 512 * j, hd = c >> 6; const size_t o = (size_t)m * D + c;
            float y0[8], y1[8], vv[8], gg[8], y[8];
            unpack8(*(const u32x4*)(Y0 + o), y0); unpack8(*(const u32x4*)(Y1 + o), y1); unpack8(*(const u32x4*)(VV + o), vv); unpack8(*(const u32x4*)(GT + o), gg);
            float s = 0.f;
#pragma unroll
            for (int e = 0; e < 8; ++e) { y[e] = y0[e] + y1[e]; s += y[e]; }
            s = sum8(s); const float mean = s * (1.0f / 64.0f); float qv = 0.f;
#pragma unroll
            for (int e = 0; e < 8; ++e) { y[e] -= mean; qv += y[e] * y[e]; }
            qv = sum8(qv); const float rstd = 1.0f / sqrtf(qv * (1.0f / 64.0f) + GN_EPS);
            const float sb = SB0[(size_t)m * NH + hd] + SB1[(size_t)m * NH + hd];
            const f32x4 gw0 = *(const f32x4*)(a.in[I_GNW] + c), gw1 = *(const f32x4*)(a.in[I_GNW] + c + 4), gb0 = *(const f32x4*)(a.in[I_GNB] + c), gb1 = *(const f32x4*)(a.in[I_GNB] + c + 4);
            float o8[8];
#pragma unroll
            for (int e = 0; e < 8; ++e) { const float gw = e < 4 ? gw0[e & 3] : gw1[e & 3], gb = e < 4 ? gb0[e & 3] : gb1[e & 3]; o8[e] = (y[e] * rstd * gw + gb + sb * vv[e]) * gg[e]; }
            u32x4 w; w.x = pk2(o8[0], o8[1]); w.y = pk2(o8[2], o8[3]); w.z = pk2(o8[4], o8[5]); w.w = pk2(o8[6], o8[7]);
            *(u32x4*)(AO + o) = w;
        }
    }
}

struct RowLN { f32x4 xn[8]; };
__device__ __forceinline__ void ln_core(int lane, f32x4 (&z)[8], const float* lnw, const float* lnb) {
    float s = 0.f;
#pragma unroll
    for (int j = 0; j < 8; ++j) s += (z[j][0] + z[j][1]) + (z[j][2] + z[j][3]);
    const float mean = wave_sum(s) * (1.0f / D); float q = 0.f;
#pragma unroll
    for (int j = 0; j < 8; ++j) { z[j] = z[j] - mean; q += (z[j][0] * z[j][0] + z[j][1] * z[j][1]) + (z[j][2] * z[j][2] + z[j][3] * z[j][3]); }
    const float rstd = 1.0f / sqrtf(wave_sum(q) * (1.0f / D) + LN_EPS);
#pragma unroll
    for (int j = 0; j < 8; ++j) { const int c = 4 * lane + 256 * j; z[j] = z[j] * rstd * *(const f32x4*)(lnw + c) + *(const f32x4*)(lnb + c); }
}
__device__ __forceinline__ f32x4 ld_bf4(const bf16_t* p) { const u32x2 w = *(const u32x2*)p; return (f32x4){bflo(w.x), bfhi(w.x), bflo(w.y), bfhi(w.y)}; }
__device__ __forceinline__ void st_bf4(bf16_t* p, const f32x4 v) { u32x2 w; w.x = pk2(v[0], v[1]); w.y = pk2(v[2], v[3]); *(u32x2*)p = w; }
__device__ __forceinline__ void st_h(void* H, size_t idx, const f32x4 v, bool f8) { if (f8) *((unsigned*)((unsigned char*)H + idx)) = pk4_fp8(v[0] * 16.f, v[1] * 16.f, v[2] * 16.f, v[3] * 16.f); else st_bf4((bf16_t*)H + idx, v); }
__device__ __forceinline__ void post_norm_rows(const Frame& F, const Args& a, const bf16_t* Y, int gate_off, int lnidx, const float* MODh, int sh_off, int sc_off, void* H, bool h8) {
    const int lane = lane_id(), tid = F.wave * 64 + lane; (void)tid;
    const float* MOD = (const float*)(F.ws + WS_MOD); float* XR = (float*)(F.ws + WS_XR);
    const float* lnw = a.in[I_LNW] + lnidx * D; const float* lnb = a.in[I_LNB] + lnidx * D;
    for (int m = F.gw; m < ML; m += F.NGW) {
        const int b = m / T; const float* g = MOD + gate_off + (size_t)b * MOD_N; const size_t o = (size_t)m * D;
        f32x4 z[8];
#pragma unroll
        for (int j = 0; j < 8; ++j) { const int c = 4 * lane + 256 * j; z[j] = *(const f32x4*)(XR + o + c) * ALPHA + *(const f32x4*)(g + c) * ld_bf4(Y + o + c); }
        ln_core(lane, z, lnw, lnb);
        const float* sh = MODh + sh_off + (size_t)b * MOD_N; const float* sc = MODh + sc_off + (size_t)b * MOD_N;
#pragma unroll
        for (int j = 0; j < 8; ++j) { const int c = 4 * lane + 256 * j; *(f32x4*)(XR + o + c) = z[j];
            st_h(H, o + c, z[j] * (*(const f32x4*)(sc + c) + 1.0f) + *(const f32x4*)(sh + c), h8); }
    }
}

__device__ __forceinline__ void p11_pool(const Frame& F) {
    const int lane = lane_id(), tid = F.wave * 64 + lane; (void)tid;
    const bf16_t* HP = (const bf16_t*)(F.ws + A_HP); bf16_t* PP = (bf16_t*)(F.ws + A_PP);
    for (int m = F.gw; m < ML; m += F.NGW) {
        const int t = m % T;
#pragma unroll
        for (int g = 0; g < 4; ++g) {
            const int half = 1 << g, c = 8 * lane + 512 * g;
            int lo = t - half, hi = t + half; lo = lo < 0 ? 0 : lo; hi = hi > T ? T : hi;
            float acc[8], ctr[8];
#pragma unroll
            for (int e = 0; e < 8; ++e) acc[e] = 0.f;
            unpack8(*(const u32x4*)(HP + (size_t)m * D + c), ctr);
            for (int tt = lo; tt < hi; ++tt) { float v[8]; unpack8(*(const u32x4*)(HP + (size_t)(m - t + tt) * D + c), v);
#pragma unroll
                for (int e = 0; e < 8; ++e) acc[e] += v[e]; }
            const float inv = 1.0f / (float)(hi - lo);
            u32x4 w; w.x = pk2(acc[0] * inv - ctr[0], acc[1] * inv - ctr[1]); w.y = pk2(acc[2] * inv - ctr[2], acc[3] * inv - ctr[3]);
            w.z = pk2(acc[4] * inv - ctr[4], acc[5] * inv - ctr[5]); w.w = pk2(acc[6] * inv - ctr[6], acc[7] * inv - ctr[7]);
            *(u32x4*)(PP + (size_t)m * D + c) = w;
        }
    }
}

__device__ __forceinline__ void p13_norm_router(const Frame& F, const Args& a) {
    const int lane = lane_id(), tid = F.wave * 64 + lane; (void)tid;
    LAS float* RT = (LAS float*)F.lds;
    LAS int* lcnt = (LAS int*)(F.lds + 65536);
    LAS int* le = (LAS int*)(F.lds + 65536 + 64);
    LAS int* lr = (LAS int*)(F.lds + 65536 + 64 + 256);
    for (int i = tid; i < D * NE; i += 512) RT[(i & 7) * D + (i >> 3)] = a.in[I_ROUTER][i];
    const float* MOD = (const float*)(F.ws + WS_MOD); float* XR = (float*)(F.ws + WS_XR);
    const float* MOD1 = MOD + (size_t)5 * MOD_N;
    const bf16_t* Y = (const bf16_t*)(F.ws + A_YP); void* H = (void*)(F.ws + A_H2B);
    const float* lnw = a.in[I_LNW] + 2 * D; const float* lnb = a.in[I_LNB] + 2 * D;
    int* TOKE = (int*)(F.ws + WS_TOK); int* TOKS = TOKE + 2 * ML; float* TOKP = (float*)(TOKE + 6 * ML);
    unsigned* gcnt = F.ctl + CW_GCNT;
    for (int rb = blockIdx.x; rb < ML / 32; rb += F.G) {
        __syncthreads();
        if (tid < 8) lcnt[tid] = 0;
        __syncthreads();
        for (int i = 0; i < 4; ++i) {
            const int rl = F.wave * 4 + i, m = rb * 32 + rl, b = m / T; const size_t o = (size_t)m * D;
            const float* g = MOD1 + 2 * D + (size_t)b * MOD_N;
            f32x4 z[8];
#pragma unroll
            for (int j = 0; j < 8; ++j) { const int c = 4 * lane + 256 * j; z[j] = *(const f32x4*)(XR + o + c) * ALPHA + *(const f32x4*)(g + c) * ld_bf4(Y + o + c); }
            ln_core(lane, z, lnw, lnb);
            const float* sh = MOD1 + 3 * D + (size_t)b * MOD_N; const float* sc = MOD1 + 4 * D + (size_t)b * MOD_N;
            float lg[8];
#pragma unroll
            for (int e = 0; e < 8; ++e) lg[e] = 0.f;
#pragma unroll
            for (int j = 0; j < 8; ++j) { const int c = 4 * lane + 256 * j; *(f32x4*)(XR + o + c) = z[j];
                const f32x4 hv = z[j] * (*(const f32x4*)(sc + c) + 1.0f) + *(const f32x4*)(sh + c);
                st_h(H, o + c, hv, MOE_FP8 != 0);
#pragma unroll
                for (int e = 0; e < 8; ++e) { const f32x4 rt = *(const LAS f32x4*)(RT + e * D + c); lg[e] += (hv[0] * rt[0] + hv[1] * rt[1]) + (hv[2] * rt[2] + hv[3] * rt[3]); } }
#pragma unroll
            for (int e = 0; e < 8; ++e) lg[e] = wave_sum(lg[e]);
            int i0 = 0; float l0 = lg[0];
#pragma unroll
            for (int e = 1; e < 8; ++e) if (lg[e] > l0) { l0 = lg[e]; i0 = e; }
            int i1 = -1; float l1 = -3.0e38f;
#pragma unroll
            for (int e = 0; e < 8; ++e) if (e != i0 && lg[e] > l1) { l1 = lg[e]; i1 = e; }
            if (i1 < 0) { i1 = (i0 + 1) & 7; l1 = l0; }
            const float e1 = fexp(l1 - l0), p0 = 1.0f / (1.0f + e1), p1 = e1 / (1.0f + e1);
            if (lane == 0) { TOKE[2 * m] = i0; TOKE[2 * m + 1] = i1; TOKP[2 * m] = p0; TOKP[2 * m + 1] = p1;
                le[2 * rl] = i0; le[2 * rl + 1] = i1; lr[2 * rl] = __hip_atomic_fetch_add(&lcnt[i0], 1, __ATOMIC_RELAXED, __HIP_MEMORY_SCOPE_WORKGROUP); lr[2 * rl + 1] = __hip_atomic_fetch_add(&lcnt[i1], 1, __ATOMIC_RELAXED, __HIP_MEMORY_SCOPE_WORKGROUP); }
        }
        __syncthreads();
        if (tid < 8) lcnt[8 + tid] = (int)__hip_atomic_fetch_add(gcnt + 64 * tid, (unsigned)lcnt[tid], __ATOMIC_RELAXED, __HIP_MEMORY_SCOPE_AGENT);
        __syncthreads();
        if (tid < 64) TOKS[2 * (rb * 32) + tid] = lcnt[8 + le[tid]] + lr[tid];
    }
    __syncthreads();
}

struct MoeTab { int mt[8], ts[8], ntile; };
__device__ __forceinline__ MoeTab moe_tab(const Frame& F) {
    MoeTab t; int acc = 0;
#pragma unroll
    for (int e = 0; e < 8; ++e) { const int c = __builtin_amdgcn_readfirstlane((int)__hip_atomic_load(F.ctl + CW_GCNT + 64 * e, __ATOMIC_RELAXED, __HIP_MEMORY_SCOPE_AGENT)); t.mt[e] = (c + 255) >> 8; t.ts[e] = acc; acc += t.mt[e]; }
    t.ntile = acc; return t;
}
__device__ __forceinline__ void p14_gather(const Frame& F) {
    const int lane = lane_id(), tid = F.wave * 64 + lane; (void)tid;
    const MoeTab tb = moe_tab(F);
    const int* TOKE = (const int*)(F.ws + WS_TOK); const int* TOKS = TOKE + 2 * ML; int* TOKD = (int*)(TOKE + 4 * ML);
    const bf16_t* H = (const bf16_t*)(F.ws + A_H2B); bf16_t* HG = (bf16_t*)(F.ws + A_HG);
    for (int idx = F.gw; idx < 2 * ML; idx += F.NGW) {
        const int m = idx >> 1, e = TOKE[idx], sl = TOKS[idx]; int ts = 0;
#pragma unroll
        for (int k = 0; k < 8; ++k) ts = (e == k) ? tb.ts[k] : ts;
        const int dst = ts * 256 + sl;
        if (lane == 0) TOKD[idx] = dst;
        constexpr int RB = MOE_FP8 ? D : 2 * D;
        const u32x4* s = (const u32x4*)((const unsigned char*)H + (size_t)m * RB) + lane; u32x4* dd = (u32x4*)((unsigned char*)HG + (size_t)dst * RB) + lane;
        const u32x4 v0 = s[0], v1 = s[64]; dd[0] = v0; dd[64] = v1;
        if (!MOE_FP8) { const u32x4 v2 = s[128], v3 = s[192]; dd[128] = v2; dd[192] = v3; }
    }
}
__device__ __forceinline__ void p17_final(const Frame& F, const Args& a) {
    const int lane = lane_id(), tid = F.wave * 64 + lane; (void)tid;
    const float* MOD1 = (const float*)(F.ws + WS_MOD) + (size_t)5 * MOD_N; const float* XR = (const float*)(F.ws + WS_XR);
    const int* TOKD = (const int*)(F.ws + WS_TOK) + 4 * ML; const float* TOKP = (const float*)((const int*)(F.ws + WS_TOK) + 6 * ML);
    const bf16_t* Y2 = (const bf16_t*)(F.ws + A_Y2);
    const float* lnw = a.in[I_LNW] + 3 * D; const float* lnb = a.in[I_LNB] + 3 * D;
    for (int m = F.gw; m < ML; m += F.NGW) {
        const int b = m / T; const float* g = MOD1 + 5 * D + (size_t)b * MOD_N; const size_t o = (size_t)m * D;
        const int d0 = TOKD[2 * m], d1 = TOKD[2 * m + 1]; const float p0 = TOKP[2 * m], p1 = TOKP[2 * m + 1];
        f32x4 z[8];
#pragma unroll
        for (int j = 0; j < 8; ++j) { const int c = 4 * lane + 256 * j;
            const f32x4 y = ld_bf4(Y2 + (size_t)d0 * D + c) * p0 + ld_bf4(Y2 + (size_t)d1 * D + c) * p1;
            z[j] = *(const f32x4*)(XR + o + c) * ALPHA + *(const f32x4*)(g + c) * y; }
        ln_core(lane, z, lnw, lnb);
#if defined(PROBE_SCANCHK)
        { const float n1 = __hip_atomic_load((float*)(F.ctl + CW_CHK), __ATOMIC_RELAXED, __HIP_MEMORY_SCOPE_AGENT), d1 = __hip_atomic_load((float*)(F.ctl + CW_CHK + 64), __ATOMIC_RELAXED, __HIP_MEMORY_SCOPE_AGENT);
          const float n2 = __hip_atomic_load((float*)(F.ctl + CW_CHK + 128), __ATOMIC_RELAXED, __HIP_MEMORY_SCOPE_AGENT), d2 = __hip_atomic_load((float*)(F.ctl + CW_CHK + 192), __ATOMIC_RELAXED, __HIP_MEMORY_SCOPE_AGENT);
          const float eps = sqrtf(n1 / d1) + sqrtf(n2 / d2), sc = 1.0f + 10.0f * eps;
#pragma unroll
          for (int j = 0; j < 8; ++j) z[j] = z[j] * sc; }
#endif
#pragma unroll
        for (int j = 0; j < 8; ++j) { const int c = 4 * lane + 256 * j; *(f32x4*)(a.out + o + c) = z[j]; }
    }
}

struct SchedBase { __device__ __forceinline__ void a_ready(const pg8::Unit&) const {} __device__ __forceinline__ void done(const pg8::Unit&) const {} };
struct SchedDense : SchedBase {
    const char* A; const char* B; bf16_t* O; const float* bias; int nM, nN, ldaB, ldbB, ldc, act, G, c;
    __device__ __forceinline__ bool next(int i, pg8::Unit& u) const {
        const int L = i * G + c; if (L >= nM * nN) return false;
        int pm, pn; pg8::tile_of(L, nM, nN, pm, pn);
        u.A = A + (size_t)pm * 256 * ldaB; u.B = B + (size_t)pn * 256 * ldbB; u.O = O; u.bias = bias; u.pm = pm; u.pn = pn; u.ldc = ldc; u.act = act; return true;
    }
};
struct SchedP2 : SchedBase {
    unsigned char* ws; int G, c;
    __device__ __forceinline__ bool next(int i, pg8::Unit& u) const {
        int L = i * G + c; if (L >= 936) return false;
        int mix, nM, nN, act, ldc; size_t wo, oo;
        if (L < 256)      { mix = 0; nM = 32; nN = 8; act = pg8::ACT_NONE;    wo = W_WR;  oo = A_R;   ldc = D; }
        else if (L < 544) { L -= 256; mix = 2; nM = 36; nN = 8; act = pg8::ACT_NONE; wo = W_WK;  oo = A_KX;  ldc = D; }
        else if (L < 832) { L -= 544; mix = 3; nM = 36; nN = 8; act = pg8::ACT_NONE; wo = W_WV;  oo = A_V;   ldc = D; }
        else if (L < 868) { L -= 832; mix = 1; nM = 36; nN = 1; act = pg8::ACT_TANH; wo = W_WLD; oo = A_LW;  ldc = 256; }
        else if (L < 904) { L -= 868; mix = 4; nM = 36; nN = 1; act = pg8::ACT_NONE; wo = W_ALD; oo = A_LA;  ldc = 256; }
        else              { L -= 904; mix = 5; nM = 32; nN = 1; act = pg8::ACT_SIGMOID; wo = W_G1; oo = A_G1O; ldc = 256; }
        int pm, pn; pg8::tile_of(L, nM, nN, pm, pn);
        u.A = (const char*)ws + A_A6 + (size_t)mix * A6_STRIDE + (size_t)pm * 256 * D * 2; u.B = (const char*)ws + wo + (size_t)pn * 256 * D * 2;
        u.O = (bf16_t*)(ws + oo); u.bias = nullptr; u.pm = pm; u.pn = pn; u.ldc = ldc; u.act = act; return true;
    }
};
struct SchedP3 : SchedBase {
    unsigned char* ws; const float* dw0; const float* ia0; int G, c;
    __device__ __forceinline__ bool next(int i, pg8::Unit& u) const {
        int L = i * G + c; if (L >= 1408) return false;
        int nM, nN, act, ldc; size_t ao, wo, oo; const float* bias;
        if (L < 576)       { nM = 36; nN = 16; act = pg8::ACT_EW; ao = A_LW; wo = W_WLU; oo = A_EW; ldc = 2 * D; bias = dw0; }
        else if (L < 1152) { L -= 576; nM = 36; nN = 16; act = pg8::ACT_BIAS_SIGMOID; ao = A_LA; wo = W_ALU; oo = A_AA; ldc = 2 * D; bias = ia0; }
        else               { L -= 1152; nM = 32; nN = 8; act = pg8::ACT_NONE; ao = A_G1O; wo = W_G2; oo = A_GATE; ldc = D; bias = nullptr; }
        int pm, pn; pg8::tile_of(L, nM, nN, pm, pn);
        u.A = (const char*)ws + ao + (size_t)pm * 256 * 256 * 2; u.B = (const char*)ws + wo + (size_t)pn * 256 * 256 * 2;
        u.O = (bf16_t*)(ws + oo); u.bias = bias; u.pm = pm; u.pn = pn; u.ldc = ldc; u.act = act; return true;
    }
};
struct SchedPool : SchedBase {
    unsigned char* ws; const float* scale; int G, c;
    __device__ __forceinline__ bool next(int i, pg8::Unit& u) const {
        const int L = i * G + c; if (L >= 256) return false;
        int pm, pn; pg8::tile_of(L, 32, 8, pm, pn);
        u.A = (const char*)ws + A_PP + ((size_t)pm * 256 * D + (size_t)(pn >> 1) * 512) * 2; u.B = (const char*)ws + W_PW + (size_t)pn * 256 * 512 * 2;
        u.O = (bf16_t*)(ws + A_YP); u.bias = scale; u.pm = pm; u.pn = pn; u.ldc = D; u.act = pg8::ACT_COLSCALE; return true;
    }
};
struct SchedMoe : SchedBase {
    MoeTab tb; const char* A; const char* B; bf16_t* O; int NT, ldaB, ldbB, ldc; size_t estride; int NL, x, rank, W;
    __device__ __forceinline__ void init(int G, int c) { NL = (G % 8 == 0) ? 8 : 1; x = c % NL; rank = c / NL; W = G / NL; }
    __device__ __forceinline__ bool next(int i, pg8::Unit& u) const {
        int j = rank + i * W; const int nn = (NT - x + NL - 1) / NL;
        int e = -1, mte = 1, tse = 0;
#pragma unroll
        for (int k = 0; k < 8; ++k) { const int blk = nn * tb.mt[k]; if (e < 0) { if (j < blk) { e = k; mte = tb.mt[k]; tse = tb.ts[k]; } else j -= blk; } }
        if (e < 0) return false;
        const int nt = x + NL * (j / mte), mtile = tse + (j % mte);
        u.A = A + (size_t)mtile * 256 * ldaB; u.B = B + (size_t)e * estride + (size_t)nt * 256 * ldbB; u.O = O; u.bias = nullptr; u.pm = mtile; u.pn = nt; u.ldc = ldc; u.act = pg8::ACT_NONE; return true;
    }
};

constexpr int NPHASE = 18;
__global__ void __launch_bounds__(512, 2) trunk_fwd(Args args) {
    extern __shared__ __attribute__((aligned(16))) unsigned char lds_raw[];
    Frame F;
    F.lds = (LAS unsigned char*)lds_raw;
    F.wave = __builtin_amdgcn_readfirstlane((int)(threadIdx.x >> 6));
    F.G = gridDim.x; { const int bx = blockIdx.x; F.vcu = (F.G % 8 == 0) ? (bx % 8) * (F.G / 8) + bx / 8 : bx; }
    F.gw = F.vcu * 8 + F.wave; F.NGW = F.G * 8;
    F.ws = args.ws; F.ctl = (unsigned*)(args.ws + WS_CTL);
    volatile LAS unsigned* MISC = (volatile LAS unsigned*)(F.lds + MISC_OFF);
    if (threadIdx.x < 32) MISC[threadIdx.x] = 0u;
    __syncthreads();
    XcdBarrier bar; bar.bar = F.ctl + CW_BAR + args.li * XCD_BAR_WORDS; bar.x = 0; bar.st = nullptr;
    if (MK_N_LAUNCHES == 1) bar = xcd_barrier_post(F.ctl + CW_BAR + args.li * XCD_BAR_WORDS, MISC + 8);
    const int lo = args.ph_lo, hi = args.ph_hi;
#define IN(k) (lo <= (k) && (k) < hi)
#define SEAM(k) do { if (IN(k) && IN((k) + 1)) xcd_barrier(bar); } while (0)
    constexpr bool AL = true, SP = true;

    if (IN(0)) {
        p0_mod(F, args);
        p0_pos(F);
        p0_small(F, args);
#if defined(PROBE_P0A)
        p0_mod(F, args); p0_pos(F); p0_small(F, args);
#endif
        p0_transpose_range(F, args, 0, TI_M2, F.gw, F.NGW, (LAS unsigned*)(F.lds + 53248 + F.wave * 8448));
    }
    SEAM(0);
    if (IN(1)) p1_mix(F, args);
    SEAM(1);
    if (IN(2)) { SchedP2 S; S.ws = F.ws; S.G = F.G; S.c = blockIdx.x; pg8::gemm_phase<pg8::EpiAct, SchedP2, AL, SP>(F.lds, pg8::shape_bf16(D, D, D), S, pg8::EpiAct{}); }
    SEAM(2);
    if (IN(3)) { SchedP3 S; S.ws = F.ws; S.dw0 = args.in[I_DW0]; S.ia0 = args.in[I_IA0]; S.G = F.G; S.c = blockIdx.x; pg8::gemm_phase<pg8::EpiAct, SchedP3, AL, SP>(F.lds, pg8::shape_bf16(256, 256, 256), S, pg8::EpiAct{}); }
    SEAM(3);
#if defined(PROBE_SCANCHK)
    if (IN(4)) { p4_scan(F, args); p4_scan2(F, args, F.ws + A_AO, (float*)(F.ws + WS_A + 644 * MiB)); xcd_barrier(bar); p4_compare(F); }
#elif defined(SCAN_STEP)
    if (IN(4)) p4_scan(F, args);
#else
    if (IN(4)) p4_scan2(F, args, F.ws + A_YD, (float*)(F.ws + WS_SB));
#endif
    SEAM(4);
    if (IN(5)) p5_ao(F, args);
    SEAM(5);
    if (IN(6)) { SchedDense S; S.A = (const char*)F.ws + A_AO; S.B = (const char*)F.ws + W_WO; S.O = (bf16_t*)(F.ws + A_YO); S.bias = nullptr; S.nM = 32; S.nN = 8; S.ldaB = 2 * D; S.ldbB = 2 * D; S.ldc = D; S.act = pg8::ACT_NONE; S.G = F.G; S.c = blockIdx.x;
        pg8::gemm_phase<pg8::EpiAct, SchedDense, AL, SP>(F.lds, pg8::shape_bf16(D, D, D), S, pg8::EpiAct{}); }
    SEAM(6);
    if (IN(7)) { const float* MOD = (const float*)(F.ws + WS_MOD); post_norm_rows(F, args, (const bf16_t*)(F.ws + A_YO), 2 * D, 0, MOD, 3 * D, 4 * D, (void*)(F.ws + A_H2), FFN_FP8 != 0); }
    SEAM(7);
    if (IN(8)) { SchedDense S; S.A = (const char*)F.ws + A_H2; S.B = (const char*)F.ws + W_F13; S.O = (bf16_t*)(F.ws + A_U); S.bias = nullptr; S.nM = 32; S.nN = 44; S.ldaB = FFN_FP8 ? D : 2 * D; S.ldbB = S.ldaB; S.ldc = DFF; S.act = 0; S.G = F.G; S.c = blockIdx.x;
        if (FFN_FP8) pg8::gemm_phase<pg8::EpiSwiglu8, SchedDense, AL, SP, true>(F.lds, pg8::shape_fp8(D, D, D, 4, 6), S, pg8::EpiSwiglu8{});
        else pg8::gemm_phase<pg8::EpiSwiglu, SchedDense, AL, SP>(F.lds, pg8::shape_bf16(D, D, D), S, pg8::EpiSwiglu{}); }
    SEAM(8);
    if (IN(9)) { SchedDense S; S.A = (const char*)F.ws + A_U; S.B = (const char*)F.ws + W_F2; S.O = (bf16_t*)(F.ws + A_YF); S.bias = nullptr; S.nM = 32; S.nN = 8; S.ldaB = FFN_FP8 ? DFF : 2 * DFF; S.ldbB = S.ldaB; S.ldc = D; S.act = pg8::ACT_NONE; S.G = F.G; S.c = blockIdx.x;
        if (FFN_FP8) pg8::gemm_phase<pg8::EpiAct, SchedDense, AL, SP, true>(F.lds, pg8::shape_fp8(DFF, DFF, DFF, 3, 8), S, pg8::EpiAct{});
        else pg8::gemm_phase<pg8::EpiAct, SchedDense, AL, SP>(F.lds, pg8::shape_bf16(DFF, DFF, DFF), S, pg8::EpiAct{}); }
    SEAM(9);
    if (IN(10)) { const float* MOD = (const float*)(F.ws + WS_MOD); post_norm_rows(F, args, (const bf16_t*)(F.ws + A_YF), 5 * D, 1, MOD + (size_t)5 * MOD_N, 0, D, (void*)(F.ws + A_HP), false); }
    SEAM(10);
    if (IN(11)) p11_pool(F);
    SEAM(11);
    if (IN(12)) { SchedPool S; S.ws = F.ws; S.scale = args.in[I_POOLS]; S.G = F.G; S.c = blockIdx.x; pg8::gemm_phase<pg8::EpiAct, SchedPool, AL, SP>(F.lds, pg8::shape_bf16(D, 512, 512), S, pg8::EpiAct{}); }
    SEAM(12);
    if (IN(13)) p13_norm_router(F, args);
    SEAM(13);
    if (IN(14)) p14_gather(F);
    SEAM(14);
    if (IN(15)) { SchedMoe S; S.tb = moe_tab(F); S.A = (const char*)F.ws + A_HG; S.B = (const char*)F.ws + W_M13; S.O = (bf16_t*)(F.ws + A_UG); S.NT = 56; S.ldaB = MOE_FP8 ? D : 2 * D; S.ldbB = S.ldaB; S.ldc = DFE; S.estride = (size_t)2 * DFE * S.ldbB; S.init(F.G, blockIdx.x);
        if (MOE_FP8) pg8::gemm_phase<pg8::EpiSwiglu8, SchedMoe, AL, SP, true>(F.lds, pg8::shape_fp8(D, D, D, 4, 6), S, pg8::EpiSwiglu8{});
        else pg8::gemm_phase<pg8::EpiSwiglu, SchedMoe, AL, SP>(F.lds, pg8::shape_bf16(D, D, D), S, pg8::EpiSwiglu{}); }
    SEAM(15);
    if (IN(16)) { SchedMoe S; S.tb = moe_tab(F); S.A = (const char*)F.ws + A_UG; S.B = (const char*)F.ws + W_M2; S.O = (bf16_t*)(F.ws + A_Y2); S.NT = 8; S.ldaB = MOE_FP8 ? DFE : 2 * DFE; S.ldbB = S.ldaB; S.ldc = D; S.estride = (size_t)D * S.ldbB; S.init(F.G, blockIdx.x);
        if (MOE_FP8) pg8::gemm_phase<pg8::EpiAct, SchedMoe, AL, SP, true>(F.lds, pg8::shape_fp8(DFE, DFE, DFE, 3, 8), S, pg8::EpiAct{});
        else pg8::gemm_phase<pg8::EpiAct, SchedMoe, AL, SP>(F.lds, pg8::shape_bf16(DFE, DFE, DFE), S, pg8::EpiAct{}); }
    SEAM(16);
    if (IN(17)) p17_final(F, args);
#undef IN
#undef SEAM
}

extern "C" void kernel_launch(void* const* d_in, const int* in_sizes, int n_in, void* d_out, int out_size, void* d_ws, size_t ws_size, hipStream_t stream) {
    static int grid = 0;
    if (grid == 0) {
        if (n_in != 35 || out_size != ML * D || ws_size < WS_END) { fprintf(stderr, "kernel_launch: unexpected problem (n_in %d, out %d, ws %zu < %zu); nothing launched\n", n_in, out_size, ws_size, (size_t)WS_END); grid = -1; return; }
        int dev = 0, cus = 0, per_cu = 0;
        if (hipGetDevice(&dev) != hipSuccess || hipDeviceGetAttribute(&cus, hipDeviceAttributeMultiprocessorCount, dev) != hipSuccess) { grid = -1; return; }
        if (hipFuncSetAttribute((const void*)trunk_fwd, hipFuncAttributeMaxDynamicSharedMemorySize, LDS_BYTES) != hipSuccess) { fprintf(stderr, "kernel_launch: hipFuncSetAttribute failed\n"); grid = -1; return; }
        if (hipOccupancyMaxActiveBlocksPerMultiprocessor(&per_cu, (const void*)trunk_fwd, 512, LDS_BYTES) != hipSuccess || per_cu < 1) fprintf(stderr, "kernel_launch: occupancy query reports %d\n", per_cu);
        (void)hipGetLastError();
        grid = cus;
    }
    if (grid < 0) return;
    if (hipMemsetAsync((char*)d_ws + WS_CTL, 0, CTL_ZERO_BYTES, stream) != hipSuccess) return;
    Args a{};
    for (int i = 0; i < 35; ++i) a.in[i] = (const float*)d_in[i];
    a.out = (float*)d_out; a.ws = (unsigned char*)d_ws;
#if defined(PROBE_DUP)
    a.ph_lo = 0; a.ph_hi = PROBE_DUP + 1; a.li = 0; hipLaunchKernelGGL(trunk_fwd, dim3(grid), dim3(512), LDS_BYTES, stream, a);
    a.ph_lo = PROBE_DUP; a.ph_hi = NPHASE; a.li = 1; hipLaunchKernelGGL(trunk_fwd, dim3(grid), dim3(512), LDS_BYTES, stream, a);
#else
    if (MK_N_LAUNCHES == 1) { a.ph_lo = 0; a.ph_hi = NPHASE; hipLaunchKernelGGL(trunk_fwd, dim3(grid), dim3(512), LDS_BYTES, stream, a); }
#endif
#if !defined(PROBE_DUP)
    else for (int p = 0; p < NPHASE; ++p) { a.ph_lo = p; a.ph_hi = p + 1; hipLaunchKernelGGL(trunk_fwd, dim3(grid), dim3(512), LDS_BYTES, stream, a); }
#endif
}
```

```cpp
#include <hip/hip_runtime.h>
#include <cstdio>
#include <cstdint>

#ifndef MK_N_LAUNCHES
#define MK_N_LAUNCHES 1
#endif

#define LAS __attribute__((address_space(3)))
#define PG8_LAS __attribute__((address_space(3)))
typedef unsigned short bf16_t;
typedef short bf16x8 __attribute__((ext_vector_type(8)));
typedef float f32x4 __attribute__((ext_vector_type(4)));
typedef float f32x2 __attribute__((ext_vector_type(2)));
typedef unsigned u32x4 __attribute__((ext_vector_type(4)));
typedef unsigned u32x2 __attribute__((ext_vector_type(2)));
typedef int i32x8 __attribute__((ext_vector_type(8)));
typedef int i32x4 __attribute__((ext_vector_type(4)));

constexpr int D = 2048, NB = 4, T = 2048, TC = 256, NH = 32, HS = 64;
constexpr int ML = NB * T;
constexpr int MC = NB * TC;
constexpr int MT = ML + MC;
constexpr int DFF = 5632, DFE = 7168, NE = 8;
constexpr int MOD_N = 6 * D;
constexpr int MROWS_PAD = 2 * ML + NE * 256;
constexpr float ALPHA = 1.41421356237309515f;
constexpr float LN_EPS = 1e-5f, GN_EPS = 64e-5f;

__device__ __forceinline__ unsigned f2bf(float f) { unsigned u = __builtin_bit_cast(unsigned, f); return (u + 0x7fffu + ((u >> 16) & 1u)) >> 16; }
typedef __bf16 bf16x2v __attribute__((ext_vector_type(2)));
__device__ __forceinline__ unsigned pk2(float lo, float hi) { const f32x2 v = {lo, hi}; return __builtin_bit_cast(unsigned, __builtin_convertvector(v, bf16x2v)); }
__device__ __forceinline__ float clamp8(float x) { return __builtin_amdgcn_fmed3f(x, -440.f, 440.f); }
__device__ __forceinline__ unsigned pk4_fp8(float a, float b, float c, float d) { int v = __builtin_amdgcn_cvt_pk_fp8_f32(clamp8(a), clamp8(b), 0, false); v = __builtin_amdgcn_cvt_pk_fp8_f32(clamp8(c), clamp8(d), v, true); return (unsigned)v; }
__device__ __forceinline__ float bflo(unsigned w) { return __builtin_bit_cast(float, w << 16); }
__device__ __forceinline__ float bfhi(unsigned w) { return __builtin_bit_cast(float, w & 0xffff0000u); }
__device__ __forceinline__ float fexp(float x) { return __builtin_amdgcn_exp2f(x * 1.44269504088896341f); }
__device__ __forceinline__ float flog(float x) { return __builtin_amdgcn_logf(x) * 0.69314718055994531f; }
__device__ __forceinline__ float sigmoidf_(float x) { return __builtin_amdgcn_rcpf(1.0f + fexp(-x)); }
__device__ __forceinline__ float siluf_(float x) { return x * __builtin_amdgcn_rcpf(1.0f + fexp(-x)); }
__device__ __forceinline__ float tanhf_(float x) { return 1.0f - 2.0f * __builtin_amdgcn_rcpf(1.0f + fexp(2.0f * x)); }
__device__ __forceinline__ float wave_sum(float v) {
#pragma unroll
    for (int o = 1; o < 64; o <<= 1) v += __shfl_xor(v, o);
    return v;
}
__device__ __forceinline__ int lane_id() { int l; asm volatile("v_mbcnt_lo_u32_b32 %0, -1, 0\n\tv_mbcnt_hi_u32_b32 %0, -1, %0" : "=v"(l)); return l; }
template <int CTRL> __device__ __forceinline__ float dpp_f(float v) { return __builtin_bit_cast(float, __builtin_amdgcn_update_dpp(0, __builtin_bit_cast(int, v), CTRL, 0xF, 0xF, true)); }
__device__ __forceinline__ float sum8(float v) {
    v += dpp_f<0xB1>(v);
    v += dpp_f<0x4E>(v);
    v += dpp_f<0x141>(v);
    return v;
}
__device__ __forceinline__ const char* uptr(const void* p) {
    unsigned long long v = (unsigned long long)p;
    unsigned lo = (unsigned)__builtin_amdgcn_readfirstlane((int)(unsigned)v), hi = (unsigned)__builtin_amdgcn_readfirstlane((int)(unsigned)(v >> 32));
    return (const char*)(((unsigned long long)hi << 32) | lo);
}

namespace pg8 {
constexpr int BM = 256, BK = 64, HALF = 128, HTB = HALF * BK * 2  , STAGE_BYTES = 8 * HTB, NXCD = 8, WGM = 8;
__host__ __device__ __forceinline__ int lds_byte(int r, int c) { const int st = (r >> 4) * 2 + (c >> 5), rr = r & 15, cc = c & 31, ob = rr * 64 + cc * 2; return st * 1024 + (ob ^ (((ob >> 9) & 1) << 5)); }
__host__ __device__ __forceinline__ void stage_rc(int b, int& R, int& C) { const int st = b / 1024, sb = b % 1024, swz = sb ^ (((sb >> 9) & 1) << 5); R = (st >> 1) * 16 + swz / 64; C = (st & 1) * 32 + (swz % 64) / 2; }
__host__ __device__ __forceinline__ int perm32(int rho) { const int n = rho >> 4, i = rho & 15; return 8 * (i >> 2) + 4 * n + (i & 3); }
__device__ __forceinline__ unsigned cvt_pk_bf16(float lo, float hi) { unsigned r; asm volatile("v_cvt_pk_bf16_f32 %0, %1, %2" : "=v"(r) : "v"(lo), "v"(hi)); return r; }

struct Unit { const char* A; const char* B; bf16_t* O; const float* bias; int pm, pn, ldc, act; };
struct Shape { int ldaB, ldbB, nt, sc; };
__host__ __device__ __forceinline__ Shape shape_bf16(int lda, int ldb, int K) { return Shape{2 * lda, 2 * ldb, K / 64, 0}; }
__host__ __device__ __forceinline__ Shape shape_fp8(int lda, int ldb, int K, int ea, int eb) { return Shape{lda, ldb, K / 128, ((127 - ea) << 8) | (127 - eb)}; }

__device__ __forceinline__ void tile_of(int l, int nM, int nN, int& pm, int& pn) {
    const int nwg = nM * nN; int wgid = l;
    { const int q = nwg / NXCD, r = nwg % NXCD, xcd = wgid % NXCD, off = wgid / NXCD; wgid = (xcd < r ? xcd * (q + 1) : r * (q + 1) + (xcd - r) * q) + off; }
    const int nig = WGM * nN, gid = wgid / nig, fm = gid * WGM, gsz = (nM - fm) < WGM ? (nM - fm) : WGM;
    pm = fm + ((wgid % nig) % gsz); pn = (wgid % nig) / gsz;
}

enum Act { ACT_NONE = 0, ACT_TANH = 1, ACT_SIGMOID = 2, ACT_EW = 3, ACT_BIAS_SIGMOID = 4, ACT_COLSCALE = 5 };
__device__ __forceinline__ float act_apply(float v, float b, int act) {
    if (act == ACT_TANH) return tanhf_(v);
    if (act == ACT_SIGMOID) return sigmoidf_(v);
    if (act == ACT_EW) { const float z = -(v + b); const float sp = (z > 20.f) ? z : flog(1.0f + fexp(z)); return fexp(-sp - 0.5f); }
    if (act == ACT_BIAS_SIGMOID) return sigmoidf_(v + b);
    if (act == ACT_COLSCALE) return v * b;
    return v;
}
struct EpiAct {
    static constexpr bool PERM = true, AFTER_DRAIN = false;
    __device__ __forceinline__ void operator()(const f32x4 (&acc)[2][2][4][2], const Unit& u, int wr, int wc) const {
        const int lane_ = lane_id(), fr = lane_ & 15, fq = lane_ >> 4;
        const int row0 = u.pm * BM + wr * 64 + fr, col0 = u.pn * BM + wc * 32 + 8 * fq; const int act = u.act;
        f32x4 bv[2][2];
#pragma unroll
        for (int bj = 0; bj < 2; ++bj)
#pragma unroll
            for (int n = 0; n < 2; ++n) bv[bj][n] = u.bias ? *(const f32x4*)(u.bias + col0 + bj * HALF + 4 * n) : (f32x4){0.f, 0.f, 0.f, 0.f};
#pragma unroll
        for (int ai = 0; ai < 2; ++ai)
#pragma unroll
            for (int m = 0; m < 4; ++m) { bf16_t* rowp = u.O + (size_t)(row0 + ai * HALF + m * 16) * u.ldc + col0;
#pragma unroll
                for (int bj = 0; bj < 2; ++bj) { f32x4 v0 = acc[ai][bj][m][0], v1 = acc[ai][bj][m][1];
                    if (act != ACT_NONE) {
#pragma unroll
                        for (int j = 0; j < 4; ++j) { v0[j] = act_apply(v0[j], bv[bj][0][j], act); v1[j] = act_apply(v1[j], bv[bj][1][j], act); } }
                    u32x4 w; w.x = cvt_pk_bf16(v0[0], v0[1]); w.y = cvt_pk_bf16(v0[2], v0[3]); w.z = cvt_pk_bf16(v1[0], v1[1]); w.w = cvt_pk_bf16(v1[2], v1[3]);
                    *(u32x4*)(rowp + bj * HALF) = w; } }
    }
};
struct EpiSwiglu {
    static constexpr bool PERM = true, AFTER_DRAIN = false;
    __device__ __forceinline__ void operator()(const f32x4 (&acc)[2][2][4][2], const Unit& u, int wr, int wc) const {
        const int lane_ = lane_id(), fr = lane_ & 15, fq = lane_ >> 4;
        const int row0 = u.pm * BM + wr * 64 + fr, col0 = u.pn * HALF + wc * 32 + 8 * fq;
#pragma unroll
        for (int ai = 0; ai < 2; ++ai)
#pragma unroll
            for (int m = 0; m < 4; ++m) { bf16_t* rowp = u.O + (size_t)(row0 + ai * HALF + m * 16) * u.ldc + col0;
                f32x4 o0, o1;
#pragma unroll
                for (int j = 0; j < 4; ++j) { o0[j] = siluf_(acc[ai][0][m][0][j]) * acc[ai][1][m][0][j]; o1[j] = siluf_(acc[ai][0][m][1][j]) * acc[ai][1][m][1][j]; }
                u32x4 w; w.x = cvt_pk_bf16(o0[0], o0[1]); w.y = cvt_pk_bf16(o0[2], o0[3]); w.z = cvt_pk_bf16(o1[0], o1[1]); w.w = cvt_pk_bf16(o1[2], o1[3]);
                *(u32x4*)rowp = w; }
    }
};

struct EpiSwiglu8 {
    static constexpr bool PERM = true, AFTER_DRAIN = false;
    __device__ __forceinline__ void operator()(const f32x4 (&acc)[2][2][4][2], const Unit& u, int wr, int wc) const {
        const int lane_ = lane_id(), fr = lane_ & 15, fq = lane_ >> 4;
        const int row0 = u.pm * BM + wr * 64 + fr, col0 = u.pn * HALF + wc * 32 + 8 * fq;
#pragma unroll
        for (int ai = 0; ai < 2; ++ai)
#pragma unroll
            for (int m = 0; m < 4; ++m) { unsigned char* rowp = (unsigned char*)u.O + (size_t)(row0 + ai * HALF + m * 16) * u.ldc + col0;
                f32x4 o0, o1;
#pragma unroll
                for (int j = 0; j < 4; ++j) { o0[j] = siluf_(acc[ai][0][m][0][j]) * acc[ai][1][m][0][j] * 8.0f; o1[j] = siluf_(acc[ai][0][m][1][j]) * acc[ai][1][m][1][j] * 8.0f; }
                u32x2 w; w.x = pk4_fp8(o0[0], o0[1], o0[2], o0[3]); w.y = pk4_fp8(o1[0], o1[1], o1[2], o1[3]);
                *(u32x2*)rowp = w; }
    }
};

template <class Epi, class Sched, bool ALIGN_EPI = true, bool SP2 = true, bool FP8 = false>
__device__ __forceinline__ void gemm_phase(PG8_LAS unsigned char* lds, const Shape g, const Sched& S, const Epi& E) {
    const int lane = lane_id(), wid = __builtin_amdgcn_readfirstlane((int)(threadIdx.x >> 6)), tid = wid * 64 + lane, wr = wid >> 2, wc = wid & 3, fr = lane & 15, fq = lane >> 4;
    const int nt = g.nt;
    unsigned voffA[2], voffB[2];
#pragma unroll
    for (int i = 0; i < 2; ++i) { int R, C; stage_rc(tid * 16 + i * 8192, R, C); const int Rb = Epi::PERM ? ((R & ~31) + perm32(R & 31)) : R;
        voffA[i] = (unsigned)(R * g.ldaB + C * 2); voffB[i] = (unsigned)(Rb * g.ldbB + C * 2); }
    const size_t kstep = (size_t)(BK * 2);
    const size_t hstepA = (size_t)HALF * g.ldaB, hstepB = (size_t)HALF * g.ldbB;
    const unsigned ldsw = (unsigned)wid * 1024u;
    const int aoff = lds_byte(wr * 64 + fr, fq * 8), boff = lds_byte(wc * 32 + fr, fq * 8);
#define PG8_SA(b, h) (((b) * 2 + (h)) * HTB)
#define PG8_SB(b, h) ((4 + (b) * 2 + (h)) * HTB)
#define PG8_STAGE(bufoff, gbase, voff) do { _Pragma("unroll") for (int _i = 0; _i < 2; ++_i) \
        __builtin_amdgcn_global_load_lds((const unsigned*)((const char*)(gbase) + (voff)[_i]), (PG8_LAS unsigned*)(lds + (bufoff) + ldsw + _i * 8192), 16, 0, 0); } while (0)
#define PG8_LDA(dst, b, h) do { _Pragma("unroll") for (int m = 0; m < 4; ++m) _Pragma("unroll") for (int k = 0; k < 2; ++k) dst[m][k] = *(const PG8_LAS bf16x8*)(lds + PG8_SA(b, h) + aoff + m * 2048 + k * 1024); } while (0)
#define PG8_LDB(dst, b, h) do { _Pragma("unroll") for (int n = 0; n < 2; ++n) _Pragma("unroll") for (int k = 0; k < 2; ++k) dst[n][k] = *(const PG8_LAS bf16x8*)(lds + PG8_SB(b, h) + boff + n * 2048 + k * 1024); } while (0)
#define PG8_MMA(ai, bj, At, Bt) do { __builtin_amdgcn_s_setprio(1); _Pragma("unroll") for (int m = 0; m < 4; ++m) _Pragma("unroll") for (int n = 0; n < 2; ++n) { \
        if constexpr (FP8) { const i32x4 b0_ = __builtin_bit_cast(i32x4, Bt[n][0]), b1_ = __builtin_bit_cast(i32x4, Bt[n][1]), a0_ = __builtin_bit_cast(i32x4, At[m][0]), a1_ = __builtin_bit_cast(i32x4, At[m][1]); \
            const i32x8 B8_ = __builtin_shufflevector(b0_, b1_, 0, 1, 2, 3, 4, 5, 6, 7), A8_ = __builtin_shufflevector(a0_, a1_, 0, 1, 2, 3, 4, 5, 6, 7); \
            asm volatile("v_mfma_scale_f32_16x16x128_f8f6f4 %0, %1, %2, %0, %3, %3 op_sel:[0,1,0] op_sel_hi:[0,0,0]" : "+v"(acc[ai][bj][m][n]) : "v"(B8_), "v"(A8_), "v"(g.sc)); } \
        else { _Pragma("unroll") for (int k = 0; k < 2; ++k) acc[ai][bj][m][n] = __builtin_amdgcn_mfma_f32_16x16x32_bf16(Bt[n][k], At[m][k], acc[ai][bj][m][n], 0, 0, 0); } } \
        __builtin_amdgcn_s_setprio(0); } while (0)
#define PG8_WAIT_V(n) asm volatile("s_waitcnt vmcnt(" #n ")" ::: "memory")
#define PG8_WAIT_L(n) asm volatile("s_waitcnt lgkmcnt(" #n ")" ::: "memory")
#define PG8_BAR __builtin_amdgcn_s_barrier()
#define PG8_SCHED __builtin_amdgcn_sched_barrier(0)
    Unit cur, nxt; int ui = 0;
    if (!S.next(0, cur)) return;
    f32x4 acc[2][2][4][2];
#pragma unroll
    for (int a = 0; a < 2; ++a)
#pragma unroll
        for (int b = 0; b < 2; ++b)
#pragma unroll
            for (int m = 0; m < 4; ++m)
#pragma unroll
                for (int n = 0; n < 2; ++n) acc[a][b][m][n] = (f32x4){0.f, 0.f, 0.f, 0.f};
    bf16x8 At[4][2], B0[2][2], B1[2][2];
    const char* cA = cur.A; const char* cB = cur.B;
    S.a_ready(cur);
    if constexpr (SP2) {
        PG8_STAGE(PG8_SB(0, 0), cB, voffB); PG8_STAGE(PG8_SB(0, 1), cB + hstepB, voffB); PG8_STAGE(PG8_SA(0, 0), cA, voffA); PG8_STAGE(PG8_SA(0, 1), cA + hstepA, voffA);
        if (wr == 1) PG8_BAR;
        PG8_WAIT_V(2); PG8_BAR;
        PG8_STAGE(PG8_SB(1, 0), cB + kstep, voffB); PG8_STAGE(PG8_SA(1, 0), cA + kstep, voffA); PG8_STAGE(PG8_SB(1, 1), cB + hstepB + kstep, voffB);
        PG8_WAIT_V(6); PG8_BAR;
    } else {
        PG8_STAGE(PG8_SB(0, 0), cB, voffB); PG8_STAGE(PG8_SA(0, 0), cA, voffA); PG8_STAGE(PG8_SB(0, 1), cB + hstepB, voffB); PG8_STAGE(PG8_SA(0, 1), cA + hstepA, voffA);
        if (wr == 1) PG8_BAR;
        PG8_WAIT_V(4); PG8_BAR;
        PG8_STAGE(PG8_SB(1, 0), cB + kstep, voffB); PG8_STAGE(PG8_SA(1, 0), cA + kstep, voffA); PG8_STAGE(PG8_SB(1, 1), cB + hstepB + kstep, voffB);
        PG8_WAIT_V(6); PG8_BAR;
    }
    for (;;) {
        const bool has_next = S.next(ui + 1, nxt);
        const char* nA = has_next ? nxt.A : cA; const char* nB = has_next ? nxt.B : cB;
        for (int t = 0; t < nt; t += 2) {
            const bool last = (t == nt - 2);
            const char* a1 = cA + (size_t)(t + 1) * kstep;
            const char* a2 = last ? nA : cA + (size_t)(t + 2) * kstep; const char* b2 = last ? nB : cB + (size_t)(t + 2) * kstep;
            const char* a3 = a2 + kstep; const char* b3 = b2 + kstep;
            if (last && has_next) S.a_ready(nxt);
            if constexpr (SP2) {
            PG8_LDB(B0, 0, 0); PG8_LDB(B1, 0, 1); PG8_SCHED; PG8_LDA(At, 0, 0); PG8_STAGE(PG8_SA(1, 1), a1 + hstepA, voffA);
            PG8_WAIT_V(8); PG8_WAIT_L(0); PG8_BAR; PG8_MMA(0, 0, At, B0); PG8_MMA(0, 1, At, B1); PG8_BAR; PG8_SCHED;
            PG8_LDA(At, 0, 1); PG8_STAGE(PG8_SB(0, 0), b2, voffB); PG8_STAGE(PG8_SB(0, 1), b2 + hstepB, voffB); PG8_STAGE(PG8_SA(0, 0), a2, voffA);
            PG8_WAIT_V(8); PG8_WAIT_L(0); PG8_BAR; PG8_MMA(1, 0, At, B0); PG8_MMA(1, 1, At, B1); PG8_BAR; PG8_SCHED;
            PG8_LDB(B0, 1, 0); PG8_LDB(B1, 1, 1); PG8_SCHED; PG8_LDA(At, 1, 0); PG8_STAGE(PG8_SA(0, 1), a2 + hstepA, voffA);
            PG8_WAIT_V(8); PG8_WAIT_L(0); PG8_BAR; PG8_MMA(0, 0, At, B0); PG8_MMA(0, 1, At, B1); PG8_BAR; PG8_SCHED;
            PG8_LDA(At, 1, 1); PG8_STAGE(PG8_SB(1, 0), b3, voffB); PG8_STAGE(PG8_SB(1, 1), b3 + hstepB, voffB); PG8_STAGE(PG8_SA(1, 0), a3, voffA);
            PG8_WAIT_V(8); PG8_WAIT_L(0); PG8_BAR; PG8_MMA(1, 0, At, B0); PG8_MMA(1, 1, At, B1); PG8_BAR; PG8_SCHED;
            } else {
            PG8_LDB(B0, 0, 0); PG8_SCHED; PG8_LDA(At, 0, 0); PG8_STAGE(PG8_SA(1, 1), a1 + hstepA, voffA);
            PG8_WAIT_L(8); PG8_BAR; PG8_WAIT_L(0); PG8_MMA(0, 0, At, B0); PG8_BAR; PG8_SCHED;
            PG8_LDB(B1, 0, 1); PG8_STAGE(PG8_SB(0, 0), b2, voffB);
            PG8_BAR; PG8_WAIT_L(0); PG8_MMA(0, 1, At, B1); PG8_BAR;
            PG8_LDA(At, 0, 1); PG8_STAGE(PG8_SA(0, 0), a2, voffA);
            PG8_BAR; PG8_WAIT_L(0); PG8_MMA(1, 0, At, B0); PG8_BAR; PG8_SCHED;
            PG8_STAGE(PG8_SB(0, 1), b2 + hstepB, voffB);
            PG8_WAIT_V(6); PG8_BAR; PG8_MMA(1, 1, At, B1); PG8_BAR;
            PG8_LDB(B0, 1, 0); PG8_SCHED; PG8_LDA(At, 1, 0); PG8_STAGE(PG8_SA(0, 1), a2 + hstepA, voffA);
            PG8_WAIT_L(8); PG8_BAR; PG8_WAIT_L(0); PG8_MMA(0, 0, At, B0); PG8_BAR; PG8_SCHED;
            PG8_LDB(B1, 1, 1); PG8_STAGE(PG8_SB(1, 0), b3, voffB);
            PG8_BAR; PG8_WAIT_L(0); PG8_MMA(0, 1, At, B1); PG8_BAR;
            PG8_LDA(At, 1, 1); PG8_STAGE(PG8_SA(1, 0), a3, voffA);
            PG8_BAR; PG8_WAIT_L(0); PG8_MMA(1, 0, At, B0); PG8_BAR; PG8_SCHED;
            PG8_STAGE(PG8_SB(1, 1), b3 + hstepB, voffB);
            PG8_WAIT_V(6); PG8_BAR; PG8_MMA(1, 1, At, B1); PG8_BAR;
            }
        }
        if constexpr (ALIGN_EPI) { if (wr == 0) PG8_BAR; }
        if constexpr (FP8) asm volatile("s_nop 15\n\ts_nop 15\n\ts_nop 15" ::: "memory");
        if constexpr (!Epi::AFTER_DRAIN) { E(acc, cur, wr, wc); S.done(cur); }
        if (!has_next) break;
#pragma unroll
        for (int a = 0; a < 2; ++a)
#pragma unroll
            for (int b = 0; b < 2; ++b)
#pragma unroll
                for (int m = 0; m < 4; ++m)
#pragma unroll
                    for (int n = 0; n < 2; ++n) acc[a][b][m][n] = (f32x4){0.f, 0.f, 0.f, 0.f};
        cur = nxt; cA = nA; cB = nB; ++ui;
        if constexpr (ALIGN_EPI) { if (wr == 1) PG8_BAR; }
    }
    PG8_WAIT_V(0);
    if constexpr (!ALIGN_EPI) { if (wr == 0) PG8_BAR; }
    PG8_BAR;
    if constexpr (Epi::AFTER_DRAIN) { E.fused(acc, cur, wr, wc, fr, fq, lds, wid, lane); S.done(cur); }
#undef PG8_SA
#undef PG8_SB
#undef PG8_STAGE
#undef PG8_LDA
#undef PG8_LDB
#undef PG8_MMA
#undef PG8_WAIT_V
#undef PG8_WAIT_L
#undef PG8_BAR
#undef PG8_SCHED
}

}

#ifndef MOE_FP8
#define MOE_FP8 1
#endif
#ifndef FFN_FP8
#define FFN_FP8 0
#endif
constexpr size_t MiB = 1u << 20;
constexpr size_t WS_CTL = 0, CTL_ZERO_BYTES = 1 * MiB;
constexpr size_t WS_MOD = 1 * MiB;
constexpr size_t WS_TOK = 2 * MiB;
constexpr size_t WS_SB  = 3 * MiB;
constexpr size_t WS_POS = 6 * MiB;
constexpr size_t WS_XR  = 22 * MiB;
constexpr size_t WS_W   = 86 * MiB;
constexpr size_t W_WR = WS_W, W_WK = W_WR + 8 * MiB, W_WV = W_WK + 8 * MiB, W_WO = W_WV + 8 * MiB;
constexpr size_t W_WLD = W_WO + 8 * MiB, W_ALD = W_WLD + 1 * MiB, W_G1 = W_ALD + 1 * MiB;
constexpr size_t W_WLU = W_G1 + 1 * MiB, W_ALU = W_WLU + 2 * MiB, W_G2 = W_ALU + 2 * MiB;
constexpr size_t W_PW = W_G2 + 1 * MiB;
constexpr size_t W_F13 = W_PW + 2 * MiB;
constexpr size_t W_F2 = W_F13 + 44 * MiB;
constexpr size_t W_M13 = W_F2 + 22 * MiB;
constexpr size_t W_M2 = W_M13 + 448 * MiB;
constexpr size_t WS_A = W_M2 + 224 * MiB;
constexpr size_t A_A6 = WS_A, A6_STRIDE = 36 * MiB;
constexpr size_t A_R = WS_A + 216 * MiB, A_KX = WS_A + 248 * MiB, A_V = WS_A + 284 * MiB;
constexpr size_t A_LW = WS_A + 320 * MiB, A_LA = WS_A + 325 * MiB, A_G1O = WS_A + 330 * MiB;
constexpr size_t A_EW = WS_A + 336 * MiB, A_AA = WS_A + 408 * MiB;
constexpr size_t A_GATE = WS_A + 480 * MiB, A_YD = WS_A + 512 * MiB;
constexpr size_t A_AO = WS_A + 580 * MiB, A_YO = WS_A + 612 * MiB;
constexpr size_t A_H2 = WS_A, A_U = WS_A + 32 * MiB, A_YF = WS_A + 120 * MiB, A_HP = WS_A + 152 * MiB, A_PP = WS_A + 184 * MiB, A_YP = WS_A + 216 * MiB, A_H2B = WS_A + 248 * MiB;
constexpr size_t A_HG = WS_A + 280 * MiB, A_UG = WS_A + 352 * MiB, A_Y2 = WS_A + 604 * MiB;
constexpr size_t WS_END = WS_A + 676 * MiB;
static_assert(A_YO + 32 * MiB <= WS_END && A_Y2 + (size_t)MROWS_PAD * D * 2 <= WS_END && A_UG + (size_t)MROWS_PAD * DFE * 2 <= A_Y2 && A_HG + (size_t)MROWS_PAD * D * 2 <= A_UG, "ws map");
static_assert(W_M13 + (size_t)NE * 2 * DFE * D * 2 == W_M2 && W_M2 + (size_t)NE * D * DFE * 2 == WS_A && W_F13 + (size_t)2 * DFF * D * 2 == W_F2, "weight map");
constexpr int CW_BAR = 4096;
constexpr int CW_GCNT = 16384;

constexpr int LDS_BYTES = 147456;
constexpr int MISC_OFF = 131072 + 320;

#define XB_TMO      128
#define XB_XCNT(j)  (256  + 64 * (j))
#define XB_XSUB(j)  (1280 + 64 * (j))
#define XB_XGEN(j)  (2304 + 64 * (j))
#define XB_TOP      3328
#define XB_TOPGEN   3392
#define XCD_BAR_WORDS 3456
#define XB_SPIN_CAP (1u << 18)
__device__ __forceinline__ unsigned xb_ld(unsigned* p)              { return __hip_atomic_load(p, __ATOMIC_RELAXED, __HIP_MEMORY_SCOPE_AGENT); }
__device__ __forceinline__ unsigned xb_add(unsigned* p, unsigned v) { return __hip_atomic_fetch_add(p, v, __ATOMIC_RELAXED, __HIP_MEMORY_SCOPE_AGENT); }
__device__ __forceinline__ unsigned xb_xcc_id() { return (unsigned)__builtin_amdgcn_s_getreg((3 << 11) | 20) & 0xFu; }
#define XB_SPIN(cond, bar) do { unsigned _sp = 0; while (cond) { __builtin_amdgcn_s_sleep(1); \
    if ((++_sp & 255u) == 0u) { if (xb_ld(&(bar)[XB_TMO])) break; if (_sp > XB_SPIN_CAP) { atomicAdd(&(bar)[XB_TMO], 1u); break; } } } } while (0)
struct XcdBarrier { unsigned* bar; unsigned x; volatile LAS unsigned* st; };
__device__ __forceinline__ XcdBarrier xcd_barrier_post(unsigned* bar, volatile LAS unsigned* st) {
    XcdBarrier b; b.bar = bar; b.x = xb_xcc_id(); b.st = st;
    if (threadIdx.x == 0) (void)xb_add(&bar[XB_XCNT(b.x)], 1u);
    return b;
}
__device__ __forceinline__ void xcd_barrier_complete(unsigned* bar, unsigned x, unsigned& nloc, unsigned& nx) {
    const unsigned G = gridDim.x * gridDim.y * gridDim.z;
    unsigned sum, cnt, mine, sp = 0u;
    for (;;) {
        sum = 0u; cnt = 0u; mine = 0u;
#pragma unroll
        for (unsigned j = 0; j < 16; ++j) { const unsigned c = xb_ld(&bar[XB_XCNT(j)]); sum += c; cnt += (c > 0u) ? 1u : 0u; mine = (j == x) ? c : mine; }
        if (sum == G) break;
        __builtin_amdgcn_s_sleep(1);
        if ((++sp & 255u) == 0u) { if (xb_ld(&bar[XB_TMO])) break; if (sp > XB_SPIN_CAP) { atomicAdd(&bar[XB_TMO], 1u); break; } }
    }
    nloc = mine > 0u ? mine : 1u; nx = cnt > 0u ? cnt : 1u;
}
__device__ __forceinline__ void xcd_barrier(const XcdBarrier& b) {
    asm volatile("s_waitcnt vmcnt(0)" ::: "memory");
    __syncthreads();
    if (threadIdx.x == 0) {
        unsigned* bar = b.bar;
        __builtin_amdgcn_s_waitcnt(0);
        unsigned nloc = b.st[0], nx = b.st[1];
        if (nloc == 0u) { xcd_barrier_complete(bar, b.x, nloc, nx); b.st[0] = nloc; b.st[1] = nx; }
        const unsigned old = xb_add(&bar[XB_XSUB(b.x)], 1u);
        const unsigned gen = old / nloc;
        if (old + 1u == (gen + 1u) * nloc) {
            __builtin_amdgcn_fence(__ATOMIC_RELEASE, "agent");
            asm volatile("s_waitcnt vmcnt(0)" ::: "memory");
            const unsigned og = xb_add(&bar[XB_TOP], 1u);
            const unsigned tg = og / nx;
            if (og + 1u == (tg + 1u) * nx) xb_add(&bar[XB_TOPGEN], 1u);
            else XB_SPIN(xb_ld(&bar[XB_TOPGEN]) == tg, bar);
            __builtin_amdgcn_fence(__ATOMIC_ACQUIRE, "agent");
            xb_add(&bar[XB_XGEN(b.x)], 1u);
            asm volatile("s_waitcnt vmcnt(0)" ::: "memory");
        } else {
            XB_SPIN(xb_ld(&bar[XB_XGEN(b.x)]) == gen, bar);
            __builtin_amdgcn_fence(__ATOMIC_ACQUIRE, "agent");
            asm volatile("s_waitcnt vmcnt(0)" ::: "memory");
        }
    }
    __syncthreads();
}

struct Args { const float* in[35]; float* out; unsigned char* ws; int ph_lo, ph_hi, li, pad; };
static_assert(sizeof(Args) == 35 * 8 + 8 + 8 + 16, "Args has no padding");
enum In { I_X = 0, I_C, I_CTX, I_CCTX, I_WMOD, I_BMOD, I_LNW, I_LNB, I_MU, I_WR, I_WK, I_WV, I_WO, I_DW0, I_DW1, I_DW2, I_IA0, I_IA1, I_IA2, I_G1, I_G2, I_KK, I_KA, I_RK, I_GNW, I_GNB,
          I_POOLW, I_POOLS, I_FW1, I_FW3, I_FW2, I_ROUTER, I_MW1, I_MW3, I_MW2 };
struct Frame {
    LAS unsigned char* lds; int wave, vcu, G, gw, NGW;
    unsigned char* ws; unsigned* ctl;
};
#define LDS_WAIT() asm volatile("s_waitcnt lgkmcnt(0)" ::: "memory")
__device__ __forceinline__ void unpack8(const u32x4 w, float (&f)[8]) { f[0] = bflo(w.x); f[1] = bfhi(w.x); f[2] = bflo(w.y); f[3] = bfhi(w.y); f[4] = bflo(w.z); f[5] = bfhi(w.z); f[6] = bflo(w.w); f[7] = bfhi(w.w); }

__device__ __forceinline__ void p0_mod(const Frame& F, const Args& a) {
    const int lane = lane_id(), tid = F.wave * 64 + lane; (void)tid;
    LAS float* sc = (LAS float*)F.lds;
    LAS float* red = (LAS float*)(F.lds + 40960);
    const float* c = a.in[I_C]; const float* cc = a.in[I_CCTX];
    for (int i = tid; i < 5 * D; i += 512) { const int j = i / D, k = i % D; const float v = j < 4 ? c[j * D + k] : cc[k]; sc[i] = siluf_(v); }
    __syncthreads();
    float* MOD = (float*)(F.ws + WS_MOD);
    const int x = lane & 15, q = lane >> 4;
    for (int u = blockIdx.x; u < 2 * (MOD_N / 64); u += F.G) {
        const int l = u / (MOD_N / 64), cb = u % (MOD_N / 64);
        const float* W = a.in[I_WMOD] + (size_t)l * D * MOD_N + cb * 64 + 4 * x;
        float acc[5][4];
#pragma unroll
        for (int j = 0; j < 5; ++j)
#pragma unroll
            for (int e = 0; e < 4; ++e) acc[j][e] = 0.f;
#pragma unroll 8
        for (int i = 0; i < 64; ++i) {
            const int k = F.wave * 256 + 4 * i + q;
            const f32x4 w = *(const f32x4*)(W + (size_t)k * MOD_N);
#pragma unroll
            for (int j = 0; j < 5; ++j) { const float s = sc[j * D + k];
#pragma unroll
                for (int e = 0; e < 4; ++e) acc[j][e] += s * w[e]; }
        }
#pragma unroll
        for (int j = 0; j < 5; ++j)
#pragma unroll
            for (int e = 0; e < 4; ++e) { float v = acc[j][e]; v += __shfl_xor(v, 16); v += __shfl_xor(v, 32); acc[j][e] = v; }
        __syncthreads();
        if (q == 0) {
#pragma unroll
            for (int j = 0; j < 5; ++j)
#pragma unroll
                for (int e = 0; e < 4; ++e) red[(F.wave * 5 + j) * 64 + 4 * x + e] = acc[j][e];
        }
        __syncthreads();
        if (tid < 320) { const int j = tid / 64, col = tid % 64; float s = 0.f;
#pragma unroll
            for (int w = 0; w < 8; ++w) s += red[(w * 5 + j) * 64 + col];
            MOD[(size_t)(l * 5 + j) * MOD_N + cb * 64 + col] = s + a.in[I_BMOD][l * MOD_N + cb * 64 + col]; }
    }
    __syncthreads();
}
__device__ __forceinline__ void p0_pos(const Frame& F) {
    const int lane = lane_id(), tid = F.wave * 64 + lane; (void)tid;
    float* POS = (float*)(F.ws + WS_POS);
    for (int t = F.gw; t < T; t += F.NGW) {
        const float frow = (float)(t >> 6), fcol = (float)(t & 63);
#pragma unroll
        for (int j = 0; j < 8; ++j) { const int c0 = 4 * lane + 256 * j; f32x4 o;
#pragma unroll
            for (int e = 0; e < 4; ++e) { const int c = c0 + e, qi = c >> 9, i = c & 511;
                const float omega = fexp(-(float)i * (9.21034037197618f / 512.0f));
                float rev = ((qi < 2) ? frow : fcol) * omega * 0.15915494309189535f;
                rev -= floorf(rev);
                o[e] = (qi & 1) ? __builtin_amdgcn_cosf(rev) : __builtin_amdgcn_sinf(rev); }
            *(f32x4*)(POS + (size_t)t * D + c0) = o; }
    }
}
constexpr int TI_RWKV = 4096, TI_F1 = TI_RWKV + 2816, TI_F3 = TI_F1 + 2816, TI_F2 = TI_F3 + 2816, TI_POOL = TI_F2 + 256, TI_M1 = TI_POOL + 8 * 3584, TI_M3 = TI_M1 + 8 * 3584, TI_M2 = TI_M3 + 8 * 3584;
struct TrItem { const float* src; unsigned char* dst; int src_ld, dst_ld  , k0, n0, drow0, f8; float sc; };
__device__ __forceinline__ TrItem tr_decode(const Frame& F, const Args& a, int it) {
    TrItem t; t.f8 = 0; t.sc = 1.0f;
    if (it < TI_RWKV) { const int m = it >> 10, r = it & 1023, kb = r >> 5, nb = r & 31;
        t.src = a.in[I_WR + m]; t.src_ld = D; t.dst = F.ws + W_WR + (size_t)m * 8 * MiB; t.dst_ld = 2 * D; t.k0 = 64 * kb; t.n0 = 64 * nb; t.drow0 = 64 * nb; }
    else if (it < TI_F3) { const int w3 = it >= TI_F1, r = it - (w3 ? TI_F1 : TI_RWKV), kb = r / 88, nb = r % 88, n0 = 64 * nb;
        t.src = a.in[w3 ? I_FW3 : I_FW1]; t.src_ld = DFF; t.dst = F.ws + W_F13; t.dst_ld = FFN_FP8 ? D : 2 * D; t.k0 = 64 * kb; t.n0 = n0; t.drow0 = (n0 >> 7) * 256 + (n0 & 127) + 128 * w3; t.f8 = FFN_FP8; t.sc = FFN_FP8 ? 64.0f : 1.0f; }
    else if (it < TI_F2) { const int r = it - TI_F3, kb = r >> 5, nb = r & 31;
        t.src = a.in[I_FW2]; t.src_ld = D; t.dst = F.ws + W_F2; t.dst_ld = FFN_FP8 ? DFF : 2 * DFF; t.k0 = 64 * kb; t.n0 = 64 * nb; t.drow0 = 64 * nb; t.f8 = FFN_FP8; t.sc = FFN_FP8 ? 256.0f : 1.0f; }
    else if (it < TI_POOL) { const int r = it - TI_F2, g = r >> 6, kb = (r >> 3) & 7, nb = r & 7;
        t.src = a.in[I_POOLW] + (size_t)g * 512 * 512; t.src_ld = 512; t.dst = F.ws + W_PW + (size_t)g * 512 * 512 * 2; t.dst_ld = 2 * 512; t.k0 = 64 * kb; t.n0 = 64 * nb; t.drow0 = 64 * nb; }
    else if (it < TI_M3) { const int w3 = it >= TI_M1, r = it - (w3 ? TI_M1 : TI_POOL), e = r / 3584, rr = r % 3584, kb = rr / 112, nb = rr % 112, n0 = 64 * nb;
        t.src = a.in[w3 ? I_MW3 : I_MW1] + (size_t)e * D * DFE; t.src_ld = DFE; t.dst_ld = MOE_FP8 ? D : 2 * D; t.dst = F.ws + W_M13 + (size_t)e * 2 * DFE * t.dst_ld; t.k0 = 64 * kb; t.n0 = n0;
        t.drow0 = (n0 >> 7) * 256 + (n0 & 127) + 128 * w3; t.f8 = MOE_FP8; t.sc = MOE_FP8 ? 64.0f : 1.0f; }
    else { const int r = it - TI_M3, e = r / 3584, rr = r % 3584, kb = rr >> 5, nb = rr & 31;
        t.src = a.in[I_MW2] + (size_t)e * DFE * D; t.src_ld = D; t.dst_ld = MOE_FP8 ? DFE : 2 * DFE; t.dst = F.ws + W_M2 + (size_t)e * D * t.dst_ld; t.k0 = 64 * kb; t.n0 = 64 * nb; t.drow0 = 64 * nb; t.f8 = MOE_FP8; t.sc = MOE_FP8 ? 256.0f : 1.0f; }
    return t;
}
__device__ __forceinline__ void tr_load(const TrItem& t, f32x4 (&r)[4][4], int lane) {
    const int x = lane & 15, q = lane >> 4; const float* p = t.src + (size_t)(t.k0 + 4 * q) * t.src_ld + t.n0 + 4 * x;
#pragma unroll
    for (int i = 0; i < 4; ++i)
#pragma unroll
        for (int s = 0; s < 4; ++s) r[i][s] = __builtin_nontemporal_load((const f32x4*)(p + (size_t)(16 * i + s) * t.src_ld));
}
__device__ __forceinline__ void tr_store(const TrItem& t, const f32x4 (&r)[4][4], LAS unsigned* scr, int lane) {
    const int x = lane & 15, q = lane >> 4;
    if (t.f8) {
#pragma unroll
        for (int i = 0; i < 4; ++i)
#pragma unroll
            for (int jj = 0; jj < 4; ++jj) scr[(4 * x + jj) * 17 + 4 * i + q] = pk4_fp8(r[i][0][jj] * t.sc, r[i][1][jj] * t.sc, r[i][2][jj] * t.sc, r[i][3][jj] * t.sc);
        LDS_WAIT();
        const int c = lane & 3;
#pragma unroll
        for (int rr = 0; rr < 4; ++rr) { const int n = (lane >> 2) + 16 * rr; const LAS unsigned* s = scr + n * 17 + 4 * c;
            u32x4 o; o.x = s[0]; o.y = s[1]; o.z = s[2]; o.w = s[3];
            *(u32x4*)(t.dst + (size_t)(t.drow0 + n) * t.dst_ld + t.k0 + 16 * c) = o; }
    } else {
#pragma unroll
        for (int i = 0; i < 4; ++i)
#pragma unroll
            for (int jj = 0; jj < 4; ++jj) { scr[(4 * x + jj) * 33 + 8 * i + 2 * q] = pk2(r[i][0][jj], r[i][1][jj]); scr[(4 * x + jj) * 33 + 8 * i + 2 * q + 1] = pk2(r[i][2][jj], r[i][3][jj]); }
        LDS_WAIT();
        const int c = lane & 7;
#pragma unroll
        for (int rr = 0; rr < 8; ++rr) { const int n = (lane >> 3) + 8 * rr; const LAS unsigned* s = scr + n * 33 + 4 * c;
            u32x4 o; o.x = s[0]; o.y = s[1]; o.z = s[2]; o.w = s[3];
            *(u32x4*)(t.dst + (size_t)(t.drow0 + n) * t.dst_ld + 2 * (t.k0 + 8 * c)) = o; }
    }
    LDS_WAIT();
}
__device__ __forceinline__ void p0_transpose_range(const Frame& F, const Args& a, int lo, int hi, int gw, int ngw, LAS unsigned* scr) {
    const int lane = lane_id();
    int it = lo + gw; if (it >= hi) return;
    f32x4 ra[4][4], rb[4][4];
    TrItem ta = tr_decode(F, a, it), tb = ta; tr_load(ta, ra, lane);
    for (;;) {
        const int i2 = it + ngw; const bool h2 = i2 < hi;
        if (h2) { tb = tr_decode(F, a, i2); tr_load(tb, rb, lane); }
        tr_store(ta, ra, scr, lane);
        if (!h2) break;
        const int i3 = i2 + ngw; const bool h3 = i3 < hi;
        if (h3) { ta = tr_decode(F, a, i3); tr_load(ta, ra, lane); }
        tr_store(tb, rb, scr, lane);
        if (!h3) break;
        it = i3;
    }
}
__device__ __forceinline__ void p0_small(const Frame& F, const Args& a) {
    const int lane = lane_id(), tid = F.wave * 64 + lane; (void)tid;
    bf16_t* WLD = (bf16_t*)(F.ws + W_WLD); bf16_t* ALD = (bf16_t*)(F.ws + W_ALD); bf16_t* G1T = (bf16_t*)(F.ws + W_G1);
    bf16_t* WLU = (bf16_t*)(F.ws + W_WLU); bf16_t* ALU = (bf16_t*)(F.ws + W_ALU); bf16_t* G2T = (bf16_t*)(F.ws + W_G2);
    const int gt = F.gw * 64 + lane, NT_ = F.NGW * 64;
    for (int i = gt; i < 256 * D; i += NT_) { const int n = i >> 11, k = i & 2047;
        float w = 0.f, v = 0.f;
        if (n < 192) { const int d = n >= 96, nn = n - 96 * d; w = a.in[I_DW1][((size_t)d * D + k) * 96 + nn]; v = a.in[I_IA1][((size_t)d * D + k) * 96 + nn]; }
        WLD[i] = (bf16_t)f2bf(w); ALD[i] = (bf16_t)f2bf(v); G1T[i] = (bf16_t)f2bf(a.in[I_G1][(size_t)k * 256 + n]); }
    for (int i = gt; i < 2 * D * 256; i += NT_) { const int n = i >> 8, k = i & 255, d = n >> 11, cidx = n & 2047, kk = k - 96 * d;
        float w = 0.f, v = 0.f;
        if (kk >= 0 && kk < 96) { w = a.in[I_DW2][((size_t)d * 96 + kk) * D + cidx]; v = a.in[I_IA2][((size_t)d * 96 + kk) * D + cidx]; }
        WLU[i] = (bf16_t)f2bf(w); ALU[i] = (bf16_t)f2bf(v); }
    for (int i = gt; i < D * 256; i += NT_) { const int n = i >> 8, k = i & 255; G2T[i] = (bf16_t)f2bf(a.in[I_G2][(size_t)k * D + n]); }
}

__device__ __forceinline__ void p1_mix(const Frame& F, const Args& a) {
    const int lane = lane_id(), tid = F.wave * 64 + lane; (void)tid;
    const float* MOD = (const float*)(F.ws + WS_MOD); const float* POS = (const float*)(F.ws + WS_POS);
    float* XR = (float*)(F.ws + WS_XR);
    for (int blk = F.gw; blk < MT / 8; blk += F.NGW) {
        const int m0 = blk * 8; const bool lat = m0 < ML;
        int t0, Tseq, modrow; const float* xs;
        if (lat) { t0 = m0 % T; Tseq = T; modrow = m0 / T; xs = a.in[I_X] + (size_t)m0 * D; }
        else { const int mm = m0 - ML; t0 = mm % TC; Tseq = TC; modrow = 4; xs = a.in[I_CTX] + (size_t)mm * D; }
        const float* sh = MOD + (size_t)modrow * MOD_N; const float* scp = sh + D;
        const float* ps = POS + (size_t)t0 * D;
        for (int j = 0; j < 8; ++j) {
            const int c = 4 * lane + 256 * j;
            const f32x4 shv = *(const f32x4*)(sh + c); const f32x4 scv = *(const f32x4*)(scp + c) + 1.0f;
            f32x4 mu[6];
#pragma unroll
            for (int n = 0; n < 6; ++n) mu[n] = *(const f32x4*)(a.in[I_MU] + n * D + c);
            f32x4 hm1 = (f32x4){0.f, 0.f, 0.f, 0.f}, h0, x00;
            if (t0 > 0) { f32x4 xv = *(const f32x4*)(xs - D + c); if (lat) xv += *(const f32x4*)(ps - D + c); hm1 = xv * scv + shv; }
            { x00 = *(const f32x4*)(xs + c); if (lat) x00 += *(const f32x4*)(ps + c); h0 = x00 * scv + shv; }
            for (int r = 0; r < 8; ++r) {
                f32x4 hp1 = (f32x4){0.f, 0.f, 0.f, 0.f}, x0n = (f32x4){0.f, 0.f, 0.f, 0.f};
                if (t0 + r + 1 < Tseq) { x0n = *(const f32x4*)(xs + (size_t)(r + 1) * D + c); if (lat) x0n += *(const f32x4*)(ps + (size_t)(r + 1) * D + c); hp1 = x0n * scv + shv; }
                const f32x4 xx = (hm1 + hp1) * 0.5f - h0;
                const size_t o = (size_t)(m0 + r) * D + c;
#pragma unroll
                for (int n = 0; n < 6; ++n) { if (!lat && (n == 0 || n == 5)) continue;
                    const f32x4 v = h0 + xx * mu[n]; u32x2 w; w.x = pk2(v[0], v[1]); w.y = pk2(v[2], v[3]);
                    *(u32x2*)((bf16_t*)(F.ws + A_A6 + (size_t)n * A6_STRIDE) + o) = w; }
                if (lat) *(f32x4*)(XR + o) = x00;
                hm1 = h0; h0 = hp1; x00 = x0n;
            }
        }
    }
}

__device__ __forceinline__ void p4_scan(const Frame& F, const Args& a) {
    const int lane = lane_id(), tid = F.wave * 64 + lane; (void)tid;
    LAS float* OP = (LAS float*)F.lds;
    LAS float* YS = (LAS float*)(F.lds + 49152);
    const bf16_t* KX = (const bf16_t*)(F.ws + A_KX); const bf16_t* VV = (const bf16_t*)(F.ws + A_V); const bf16_t* RR = (const bf16_t*)(F.ws + A_R);
    const bf16_t* EW = (const bf16_t*)(F.ws + A_EW); const bf16_t* AA = (const bf16_t*)(F.ws + A_AA);
    const int tl = tid >> 5, cp = tid & 31, vi = tid >> 3, kg = tid & 7;
    for (int s = blockIdx.x; s < NB * NH * 2; s += F.G) {
        const int b = s >> 6, h = (s >> 1) & 31, d = s & 1;
        const int ch = h * HS + 2 * cp;
        const float kkc0 = a.in[I_KK][ch], kkc1 = a.in[I_KK][ch + 1], kac0 = a.in[I_KA][ch], kac1 = a.in[I_KA][ch + 1], rkc0 = a.in[I_RK][ch], rkc1 = a.in[I_RK][ch + 1];
        bf16_t* YD = (bf16_t*)(F.ws + A_YD + (size_t)d * 32 * MiB); float* SB = (float*)(F.ws + WS_SB) + (size_t)d * ML * NH;
        float S[8];
#pragma unroll
        for (int j = 0; j < 8; ++j) S[j] = 0.f;
        unsigned rk = 0, rv = 0, rr = 0, re = 0, ra = 0;
#define SCAN_ROW0(ci) (((ci) < 16) ? (ML + b * TC + (d ? 15 - (ci) : (ci)) * 16) : (b * T + (d ? 127 - ((ci) - 16) : ((ci) - 16)) * 16))
#define SCAN_LOAD(ci) do { const int row_ = SCAN_ROW0(ci) + tl; const size_t o_ = (size_t)row_ * D + ch, o2_ = (size_t)row_ * (2 * D) + d * D + ch; \
        rk = *(const unsigned*)(KX + o_); rv = *(const unsigned*)(VV + o_); rr = ((ci) >= 16) ? *(const unsigned*)(RR + o_) : 0u; re = *(const unsigned*)(EW + o2_); ra = *(const unsigned*)(AA + o2_); } while (0)
#define SCAN_PREP(ci) do { LAS float* B_ = OP + ((ci) & 1) * 6144 + tl * 64 + 2 * cp; \
        const float k0 = bflo(rk), k1 = bfhi(rk), q0 = k0 * kkc0, q1 = k1 * kkc1; float n2 = q0 * q0 + q1 * q1; \
        n2 += __shfl_xor(n2, 1); n2 += __shfl_xor(n2, 2); n2 += __shfl_xor(n2, 4); n2 += __shfl_xor(n2, 8); n2 += __shfl_xor(n2, 16); \
        const float inv = 1.0f / fmaxf(sqrtf(n2), 1e-12f), kn0 = q0 * inv, kn1 = q1 * inv; \
        const float a0 = bflo(ra), a1 = bfhi(ra), kd0 = k0 * (1.0f + (a0 - 1.0f) * kac0), kd1 = k1 * (1.0f + (a1 - 1.0f) * kac1); \
        const float r0 = bflo(rr), r1 = bfhi(rr); \
        *(LAS f32x2*)(B_ + 0 * 1024) = (f32x2){kn0, kn1}; \
        *(LAS f32x2*)(B_ + 1 * 1024) = (f32x2){fexp(-bflo(re)), fexp(-bfhi(re))}; \
        *(LAS f32x2*)(B_ + 2 * 1024) = (f32x2){kn0 * a0, kn1 * a1}; \
        *(LAS f32x2*)(B_ + 3 * 1024) = (f32x2){kd0, kd1}; \
        *(LAS f32x2*)(B_ + 4 * 1024) = (f32x2){r0, r1}; \
        *(LAS f32x2*)(B_ + 5 * 1024) = (f32x2){bflo(rv), bfhi(rv)}; \
        if ((ci) >= 16) { float sb = r0 * kd0 * rkc0 + r1 * kd1 * rkc1; \
            sb += __shfl_xor(sb, 1); sb += __shfl_xor(sb, 2); sb += __shfl_xor(sb, 4); sb += __shfl_xor(sb, 8); sb += __shfl_xor(sb, 16); \
            if (cp == 0) SB[(size_t)(SCAN_ROW0(ci) + tl) * NH + h] = sb; } } while (0)
        __syncthreads();
        SCAN_LOAD(0); SCAN_PREP(0);
        __syncthreads();
        for (int ci = 0; ci < 144; ++ci) {
            if (ci + 1 < 144) SCAN_LOAD(ci + 1);
            const LAS float* B = OP + (ci & 1) * 6144; LAS float* Y = YS + (ci & 1) * 1024;
#pragma unroll 4
            for (int st = 0; st < 16; ++st) {
                const int tk = d ? 15 - st : st; const LAS float* p = B + tk * 64 + 8 * kg;
                const f32x4 kkA = *(const LAS f32x4*)(p), kkB = *(const LAS f32x4*)(p + 4);
                const f32x4 wA = *(const LAS f32x4*)(p + 1024), wB = *(const LAS f32x4*)(p + 1028);
                const f32x4 bA = *(const LAS f32x4*)(p + 2048), bB = *(const LAS f32x4*)(p + 2052);
                const f32x4 dA = *(const LAS f32x4*)(p + 3072), dB = *(const LAS f32x4*)(p + 3076);
                const f32x4 rA = *(const LAS f32x4*)(p + 4096), rB = *(const LAS f32x4*)(p + 4100);
                const float v = B[5 * 1024 + tk * 64 + vi];
                float sa = (S[0] * kkA[0] + S[1] * kkA[1]) + (S[2] * kkA[2] + S[3] * kkA[3]) + (S[4] * kkB[0] + S[5] * kkB[1]) + (S[6] * kkB[2] + S[7] * kkB[3]);
                sa = sum8(sa);
#pragma unroll
                for (int j = 0; j < 4; ++j) { S[j] = S[j] * wA[j] + (v * dA[j] - sa * bA[j]); S[4 + j] = S[4 + j] * wB[j] + (v * dB[j] - sa * bB[j]); }
                float y = (S[0] * rA[0] + S[1] * rA[1]) + (S[2] * rA[2] + S[3] * rA[3]) + (S[4] * rB[0] + S[5] * rB[1]) + (S[6] * rB[2] + S[7] * rB[3]);
                y = sum8(y);
                if (kg == 0) Y[tk * 64 + vi] = y;
            }
            if (ci + 1 < 144) SCAN_PREP(ci + 1);
            __syncthreads();
            if (ci >= 16) { const f32x2 yv = *(const LAS f32x2*)(Y + tl * 64 + 2 * cp);
                *(unsigned*)(YD + (size_t)(SCAN_ROW0(ci) + tl) * D + ch) = pk2(yv.x, yv.y); }
        }
#undef SCAN_ROW0
#undef SCAN_LOAD
#undef SCAN_PREP
    }
    __syncthreads();
}

constexpr int SL_KA = 0, SL_RM = 2048, SL_BK = 4096, SL_VC = 8192, SL_ARK = 10240, SL_AAK = 11264, SL_TN = 11776, SL_GC = 12288, SL_BYTES = 12544;
constexpr int SC_PAR = 8 * SL_BYTES;
typedef short s16x8 __attribute__((ext_vector_type(8)));
__device__ __forceinline__ s16x8 mk8(unsigned a, unsigned b, unsigned c, unsigned d) { u32x4 v; v.x = a; v.y = b; v.z = c; v.w = d; return __builtin_bit_cast(s16x8, v); }
__device__ __forceinline__ f32x4 mfma16(s16x8 a, s16x8 b, f32x4 c) { return __builtin_amdgcn_mfma_f32_16x16x32_bf16(a, b, c, 0, 0, 0); }
__device__ __forceinline__ s16x8 mk_d(const f32x4 x) { return mk8(pk2(x[0], x[1]), pk2(x[2], x[3]), 0u, 0u); }
__device__ __forceinline__ void p4_scan2(const Frame& F, const Args& a, unsigned char* yd_base, float* sb_base) {
    const int lane = lane_id(), tt = lane & 15, q = lane >> 4;
    const bf16_t* KX = (const bf16_t*)(F.ws + A_KX); const bf16_t* VV = (const bf16_t*)(F.ws + A_V); const bf16_t* RR = (const bf16_t*)(F.ws + A_R);
    const bf16_t* EW = (const bf16_t*)(F.ws + A_EW); const bf16_t* AA = (const bf16_t*)(F.ws + A_AA);
    LAS unsigned char* slot_w = F.lds + F.wave * SL_BYTES;
    LAS float* PAR = (LAS float*)(F.lds + SC_PAR);
    s16x8 SelF[2];
#pragma unroll
    for (int sel = 0; sel < 2; ++sel) { unsigned w[4];
#pragma unroll
        for (int jj = 0; jj < 4; ++jj) { const int j0 = 2 * jj, j1 = 2 * jj + 1; const bool h0 = (q == (tt >> 2)) && (j0 == 4 * sel + (tt & 3)), h1 = (q == (tt >> 2)) && (j1 == 4 * sel + (tt & 3));
            w[jj] = (h0 ? 0x3f80u : 0u) | (h1 ? 0x3f800000u : 0u); }
        SelF[sel] = mk8(w[0], w[1], w[2], w[3]); }
    for (int s = blockIdx.x; s < NB * NH * 2; s += F.G) {
        const int b = s >> 6, h = (s >> 1) & 31, d = s & 1;
        bf16_t* YD = (bf16_t*)(yd_base + (size_t)d * 32 * MiB); float* SB = sb_base + (size_t)d * ML * NH;
        __syncthreads();
        if (F.wave == 0) { PAR[lane] = a.in[I_KK][h * HS + lane]; PAR[64 + lane] = a.in[I_KA][h * HS + lane]; PAR[128 + lane] = a.in[I_RK][h * HS + lane]; }
        __syncthreads();
        f32x4 G[4];
#pragma unroll
        for (int tk = 0; tk < 4; ++tk) G[tk] = (f32x4){0.f, 0.f, 0.f, 0.f};
#define S2_ROW0(ci) (((ci) < 16) ? (ML + b * TC + (d ? 15 - (ci) : (ci)) * 16) : (b * T + (d ? 127 - ((ci) - 16) : ((ci) - 16)) * 16))
        u32x2 rk[4], rv[4], rr[4], re[4], ra[4];
#define S2_LOAD(ci) do { const int row_ = S2_ROW0(ci) + (d ? 15 - tt : tt); const size_t o_ = (size_t)row_ * D + h * HS + 4 * q, o2_ = (size_t)row_ * (2 * D) + d * D + h * HS + 4 * q; \
        _Pragma("unroll") for (int g_ = 0; g_ < 4; ++g_) { rk[g_] = *(const u32x2*)(KX + o_ + 16 * g_); rv[g_] = *(const u32x2*)(VV + o_ + 16 * g_); \
            rr[g_] = ((ci) >= 16) ? *(const u32x2*)(RR + o_ + 16 * g_) : (u32x2){0u, 0u}; re[g_] = *(const u32x2*)(EW + o2_ + 16 * g_); ra[g_] = *(const u32x2*)(AA + o2_ + 16 * g_); } } while (0)
        S2_LOAD(F.wave);
        for (int rnd = 0; rnd < 18; ++rnd) {
            const int ci = rnd * 8 + F.wave; const bool lat = rnd >= 2;
            {
                float kf[4][4], af[4][4], ef[4][4], vf[4][4], rf[4][4];
#pragma unroll
                for (int g = 0; g < 4; ++g) {
                    kf[g][0] = bflo(rk[g].x); kf[g][1] = bfhi(rk[g].x); kf[g][2] = bflo(rk[g].y); kf[g][3] = bfhi(rk[g].y);
                    af[g][0] = bflo(ra[g].x); af[g][1] = bfhi(ra[g].x); af[g][2] = bflo(ra[g].y); af[g][3] = bfhi(ra[g].y);
                    ef[g][0] = bflo(re[g].x); ef[g][1] = bfhi(re[g].x); ef[g][2] = bflo(re[g].y); ef[g][3] = bfhi(re[g].y);
                    vf[g][0] = bflo(rv[g].x); vf[g][1] = bfhi(rv[g].x); vf[g][2] = bflo(rv[g].y); vf[g][3] = bfhi(rv[g].y);
                    rf[g][0] = bflo(rr[g].x); rf[g][1] = bfhi(rr[g].x); rf[g][2] = bflo(rr[g].y); rf[g][3] = bfhi(rr[g].y); }
                unsigned VP[4][2];
#pragma unroll
                for (int g = 0; g < 4; ++g) { VP[g][0] = rv[g].x; VP[g][1] = rv[g].y; }
                if (rnd + 1 < 18) S2_LOAD((rnd + 1) * 8 + F.wave);
                float kkv[4][4]; float n2 = 0.f;
#pragma unroll
                for (int g = 0; g < 4; ++g) { const f32x4 kc = *(const LAS f32x4*)(PAR + 16 * g + 4 * q);
#pragma unroll
                    for (int i = 0; i < 4; ++i) { kkv[g][i] = kf[g][i] * kc[i]; n2 += kkv[g][i] * kkv[g][i]; } }
                n2 += __shfl_xor(n2, 16); n2 += __shfl_xor(n2, 32);
                const float inv = 1.0f / fmaxf(sqrtf(n2), 1e-12f);
                float sb = 0.f;
                unsigned KaP[4][2], BmP[4][2], KmP[4][2], RmP[4][2]; f32x4 gend[4];
#pragma unroll
                for (int g = 0; g < 4; ++g) { const f32x4 kac = *(const LAS f32x4*)(PAR + 64 + 16 * g + 4 * q), rkc = *(const LAS f32x4*)(PAR + 128 + 16 * g + 4 * q);
                    float ka_[4], bm_[4], km_[4], rm_[4];
#pragma unroll
                    for (int i = 0; i < 4; ++i) {
                        float L = ef[g][i];
                        L += dpp_f<0x111>(L); L += dpp_f<0x112>(L); L += dpp_f<0x114>(L); L += dpp_f<0x118>(L);
                        const float gt = fexp(-L), gi = fexp(L), gm1 = fexp(ef[g][i] - L);
                        const float kk = kkv[g][i] * inv, kd = kf[g][i] * (1.0f + (af[g][i] - 1.0f) * kac[i]);
                        ka_[i] = kk * gm1; bm_[i] = kk * af[g][i] * gi; km_[i] = kd * gi; rm_[i] = rf[g][i] * gt;
                        sb += rf[g][i] * kd * rkc[i]; gend[g][i] = gt; }
                    KaP[g][0] = pk2(ka_[0], ka_[1]); KaP[g][1] = pk2(ka_[2], ka_[3]); BmP[g][0] = pk2(bm_[0], bm_[1]); BmP[g][1] = pk2(bm_[2], bm_[3]);
                    KmP[g][0] = pk2(km_[0], km_[1]); KmP[g][1] = pk2(km_[2], km_[3]); RmP[g][0] = pk2(rm_[0], rm_[1]); RmP[g][1] = pk2(rm_[2], rm_[3]);
                }
                if (lat) { sb += __shfl_xor(sb, 16); sb += __shfl_xor(sb, 32); if (q == 0) SB[(size_t)(S2_ROW0(ci) + (d ? 15 - tt : tt)) * NH + h] = sb; }
                s16x8 KaF[2], BmF[2], KmF[2], RmF[2], VF[2];
#pragma unroll
                for (int kb = 0; kb < 2; ++kb) { KaF[kb] = mk8(KaP[2 * kb][0], KaP[2 * kb][1], KaP[2 * kb + 1][0], KaP[2 * kb + 1][1]); BmF[kb] = mk8(BmP[2 * kb][0], BmP[2 * kb][1], BmP[2 * kb + 1][0], BmP[2 * kb + 1][1]);
                    KmF[kb] = mk8(KmP[2 * kb][0], KmP[2 * kb][1], KmP[2 * kb + 1][0], KmP[2 * kb + 1][1]); RmF[kb] = mk8(RmP[2 * kb][0], RmP[2 * kb][1], RmP[2 * kb + 1][0], RmP[2 * kb + 1][1]);
                    VF[kb] = mk8(VP[2 * kb][0], VP[2 * kb][1], VP[2 * kb + 1][0], VP[2 * kb + 1][1]); }
                const f32x4 Z = (f32x4){0.f, 0.f, 0.f, 0.f};
                f32x4 Nd = mfma16(KaF[1], BmF[1], mfma16(KaF[0], BmF[0], Z));
                f32x4 Nt = mfma16(BmF[1], KaF[1], mfma16(BmF[0], KaF[0], Z));
                f32x4 AakT = mfma16(KmF[1], KaF[1], mfma16(KmF[0], KaF[0], Z));
                f32x4 ArbT = mfma16(BmF[1], RmF[1], mfma16(BmF[0], RmF[0], Z));
                f32x4 ArkT = mfma16(KmF[1], RmF[1], mfma16(KmF[0], RmF[0], Z));
                f32x4 Q0;
#pragma unroll
                for (int r = 0; r < 4; ++r) { const int row = 4 * q + r;
                    Nd[r] = row > tt ? Nd[r] : 0.f; Nt[r] = row < tt ? Nt[r] : 0.f; AakT[r] = row < tt ? AakT[r] : 0.f; ArbT[r] = row <= tt ? ArbT[r] : 0.f; ArkT[r] = row <= tt ? ArkT[r] : 0.f;
                    Q0[r] = (row == tt ? 1.0f : 0.f) - Nt[r]; }
                const s16x8 oN = mk_d(Nd), oNt = mk_d(Nt);
                const f32x4 N2 = mfma16(oNt, oN, Z), N2t = mfma16(oN, oNt, Z);
                const s16x8 oN2 = mk_d(N2), oN2t = mk_d(N2t);
                const f32x4 N4 = mfma16(oN2t, oN2, Z), N4t = mfma16(oN2, oN2t, Z);
                const s16x8 oN4 = mk_d(N4), oN4t = mk_d(N4t);
                const f32x4 N8 = mfma16(oN4t, oN4, Z);
                const f32x4 Q1 = mfma16(oN2, mk_d(Q0), Q0);
                const f32x4 Q2 = mfma16(oN4, mk_d(Q1), Q1);
                const f32x4 Q3 = mfma16(mk_d(N8), mk_d(Q2), Q2);
                *(LAS u32x4*)(slot_w + SL_KA + lane * 16) = __builtin_bit_cast(u32x4, KaF[0]); *(LAS u32x4*)(slot_w + SL_KA + 1024 + lane * 16) = __builtin_bit_cast(u32x4, KaF[1]);
                *(LAS u32x4*)(slot_w + SL_RM + lane * 16) = __builtin_bit_cast(u32x4, RmF[0]); *(LAS u32x4*)(slot_w + SL_RM + 1024 + lane * 16) = __builtin_bit_cast(u32x4, RmF[1]);
                *(LAS u32x2*)(slot_w + SL_TN + lane * 8) = (u32x2){pk2(-Q3[0], -Q3[1]), pk2(-Q3[2], -Q3[3])};
                *(LAS u32x2*)(slot_w + SL_AAK + lane * 8) = (u32x2){pk2(AakT[0], AakT[1]), pk2(AakT[2], AakT[3])};
                *(LAS u32x4*)(slot_w + SL_ARK + lane * 16) = (u32x4){pk2(ArbT[0], ArbT[1]), pk2(ArbT[2], ArbT[3]), pk2(ArkT[0], ArkT[1]), pk2(ArkT[2], ArkT[3])};
#pragma unroll
                for (int kb = 0; kb < 2; ++kb)
#pragma unroll
                    for (int sel = 0; sel < 2; ++sel) { const int tk = 2 * kb + sel;
                        const f32x4 DB = mfma16(BmF[kb], SelF[sel], Z), DK = mfma16(KmF[kb], SelF[sel], Z), DV = mfma16(VF[kb], SelF[sel], Z);
                        *(LAS u32x4*)(slot_w + SL_BK + tk * 1024 + lane * 16) = (u32x4){pk2(DB[0], DB[1]), pk2(DB[2], DB[3]), pk2(DK[0], DK[1]), pk2(DK[2], DK[3])};
                        *(LAS u32x2*)(slot_w + SL_VC + tk * 512 + lane * 8) = (u32x2){pk2(DV[0], DV[1]), pk2(DV[2], DV[3])}; }
                if (tt == 15) {
#pragma unroll
                    for (int g = 0; g < 4; ++g) *(LAS f32x4*)(slot_w + SL_GC + (g * 4 + q) * 16) = gend[g]; }
            }
            __syncthreads();
            if (F.wave < 4) {
                const int tv = F.wave;
                for (int sl = 0; sl < 8; ++sl) {
                    LAS unsigned char* S = F.lds + sl * SL_BYTES; const int cj = rnd * 8 + sl;
                    const s16x8 KA0 = __builtin_bit_cast(s16x8, *(LAS u32x4*)(S + SL_KA + lane * 16)), KA1 = __builtin_bit_cast(s16x8, *(LAS u32x4*)(S + SL_KA + 1024 + lane * 16));
                    const u32x2 aak = *(LAS u32x2*)(S + SL_AAK + lane * 8), tn = *(LAS u32x2*)(S + SL_TN + lane * 8), vc = *(LAS u32x2*)(S + SL_VC + tv * 512 + lane * 8);
                    const s16x8 Gb0 = mk8(pk2(G[0][0], G[0][1]), pk2(G[0][2], G[0][3]), pk2(G[1][0], G[1][1]), pk2(G[1][2], G[1][3]));
                    const s16x8 Gb1 = mk8(pk2(G[2][0], G[2][1]), pk2(G[2][2], G[2][3]), pk2(G[3][0], G[3][1]), pk2(G[3][2], G[3][3]));
                    const f32x4 Z = (f32x4){0.f, 0.f, 0.f, 0.f};
                    f32x4 P = mfma16(KA0, Gb0, Z); P = mfma16(KA1, Gb1, P); P = mfma16(mk8(aak.x, aak.y, 0u, 0u), mk8(vc.x, vc.y, 0u, 0u), P);
                    const f32x4 U = mfma16(mk8(tn.x, tn.y, 0u, 0u), mk_d(P), Z);
                    const s16x8 UV = mk8(pk2(U[0], U[1]), pk2(U[2], U[3]), vc.x, vc.y);
                    if (lat) {
                        const s16x8 RM0 = __builtin_bit_cast(s16x8, *(LAS u32x4*)(S + SL_RM + lane * 16)), RM1 = __builtin_bit_cast(s16x8, *(LAS u32x4*)(S + SL_RM + 1024 + lane * 16));
                        const s16x8 ARK = __builtin_bit_cast(s16x8, *(LAS u32x4*)(S + SL_ARK + lane * 16));
                        f32x4 Y = mfma16(Gb0, RM0, Z); Y = mfma16(Gb1, RM1, Y); Y = mfma16(UV, ARK, Y);
                        *(u32x2*)(YD + (size_t)(S2_ROW0(cj) + (d ? 15 - tt : tt)) * D + h * HS + 16 * tv + 4 * q) = (u32x2){pk2(Y[0], Y[1]), pk2(Y[2], Y[3])};
                    }
#pragma unroll
                    for (int tk = 0; tk < 4; ++tk) { const s16x8 BK = __builtin_bit_cast(s16x8, *(LAS u32x4*)(S + SL_BK + tk * 1024 + lane * 16));
                        G[tk] = mfma16(BK, UV, G[tk]); G[tk] = G[tk] * *(LAS f32x4*)(S + SL_GC + (tk * 4 + q) * 16); }
                }
            }
            __syncthreads();
        }
#undef S2_ROW0
#undef S2_LOAD
    }
    __syncthreads();
}

#if defined(PROBE_SCANCHK)
constexpr int CW_CHK = 20480;
__device__ __forceinline__ void p4_compare(const Frame& F) {
    const int lane = lane_id();
    const bf16_t* Y0 = (const bf16_t*)(F.ws + A_YD); const bf16_t* Y1 = (const bf16_t*)(F.ws + A_AO);
    const float* S0 = (const float*)(F.ws + WS_SB); const float* S1 = (const float*)(F.ws + WS_A + 644 * MiB);
    float num = 0.f, den = 0.f, num2 = 0.f, den2 = 0.f;
    for (size_t i = (size_t)F.gw * 64 + lane; i < (size_t)2 * ML * D / 8; i += (size_t)F.NGW * 64) { float a8[8], b8[8]; unpack8(((const u32x4*)Y0)[i], a8); unpack8(((const u32x4*)Y1)[i], b8);
#pragma unroll
        for (int e = 0; e < 8; ++e) { const float dd = b8[e] - a8[e]; num += dd * dd; den += a8[e] * a8[e]; } }
    for (size_t i = (size_t)F.gw * 64 + lane; i < (size_t)2 * ML * NH; i += (size_t)F.NGW * 64) { const float dd = S1[i] - S0[i]; num2 += dd * dd; den2 += S0[i] * S0[i]; }
    num = wave_sum(num); den = wave_sum(den); num2 = wave_sum(num2); den2 = wave_sum(den2);
    if (lane == 0) { atomicAdd((float*)(F.ctl + CW_CHK), num); atomicAdd((float*)(F.ctl + CW_CHK + 64), den); atomicAdd((float*)(F.ctl + CW_CHK + 128), num2); atomicAdd((float*)(F.ctl + CW_CHK + 192), den2); }
}
#endif
__device__ __forceinline__ void p5_ao(const Frame& F, const Args& a) {
    const int lane = lane_id(), tid = F.wave * 64 + lane; (void)tid;
    const bf16_t* Y0 = (const bf16_t*)(F.ws + A_YD); const bf16_t* Y1 = (const bf16_t*)(F.ws + A_YD + 32 * MiB);
    const bf16_t* VV = (const bf16_t*)(F.ws + A_V); const bf16_t* GT = (const bf16_t*)(F.ws + A_GATE); bf16_t* AO = (bf16_t*)(F.ws + A_AO);
    const float* SB0 = (const float*)(F.ws + WS_SB); const float* SB1 = SB0 + (size_t)ML * NH;
    for (int m = F.gw; m < ML; m += F.NGW) {
#pragma unroll
        for (int j = 0; j < 4; ++j) {
            const int c = 8 * lane + 512 * j, hd = c >> 6; const size_t o = (size_t)m * D + c;
            float y0[8], y1[8], vv[8], gg[8], y[8];
            unpack8(*(const u32x4*)(Y0 + o), y0); unpack8(*(const u32x4*)(Y1 + o), y1); unpack8(*(const u32x4*)(VV + o), vv); unpack8(*(const u32x4*)(GT + o), gg);
            float s = 0.f;
#pragma unroll
            for (int e = 0; e < 8; ++e) { y[e] = y0[e] + y1[e]; s += y[e]; }
            s = sum8(s); const float mean = s * (1.0f / 64.0f); float qv = 0.f;
#pragma unroll
            for (int e = 0; e < 8; ++e) { y[e] -= mean; qv += y[e] * y[e]; }
            qv = sum8(qv); const float rstd = 1.0f / sqrtf(qv * (1.0f / 64.0f) + GN_EPS);
            const float sb = SB0[(size_t)m * NH + hd] + SB1[(size_t)m * NH + hd];
            const f32x4 gw0 = *(const f32x4*)(a.in[I_GNW] + c), gw1 = *(const f32x4*)(a.in[I_GNW] + c + 4), gb0 = *(const f32x4*)(a.in[I_GNB] + c), gb1 = *(const f32x4*)(a.in[I_GNB] + c + 4);
            float o8[8];
#pragma unroll
            for (int e = 0; e < 8; ++e) { const float gw = e < 4 ? gw0[e & 3] : gw1[e & 3], gb = e < 4 ? gb0[e & 3] : gb1[e & 3]; o8[e] = (y[e] * rstd * gw + gb + sb * vv[e]) * gg[e]; }
            u32x4 w; w.x = pk2(o8[0], o8[1]); w.y = pk2(o8[2], o8[3]); w.z = pk2(o8[4], o8[5]); w.w = pk2(o8[6], o8[7]);
            *(u32x4*)(AO + o) = w;
        }
    }
}

struct RowLN { f32x4 xn[8]; };
__device__ __forceinline__ void ln_core(int lane, f32x4 (&z)[8], const float* lnw, const float* lnb) {
    float s = 0.f;
#pragma unroll
    for (int j = 0; j < 8; ++j) s += (z[j][0] + z[j][1]) + (z[j][2] + z[j][3]);
    const float mean = wave_sum(s) * (1.0f / D); float q = 0.f;
#pragma unroll
    for (int j = 0; j < 8; ++j) { z[j] = z[j] - mean; q += (z[j][0] * z[j][0] + z[j][1] * z[j][1]) + (z[j][2] * z[j][2] + z[j][3] * z[j][3]); }
    const float rstd = 1.0f / sqrtf(wave_sum(q) * (1.0f / D) + LN_EPS);
#pragma unroll
    for (int j = 0; j < 8; ++j) { const int c = 4 * lane + 256 * j; z[j] = z[j] * rstd * *(const f32x4*)(lnw + c) + *(const f32x4*)(lnb + c); }
}
__device__ __forceinline__ f32x4 ld_bf4(const bf16_t* p) { const u32x2 w = *(const u32x2*)p; return (f32x4){bflo(w.x), bfhi(w.x), bflo(w.y), bfhi(w.y)}; }
__device__ __forceinline__ void st_bf4(bf16_t* p, const f32x4 v) { u32x2 w; w.x = pk2(v[0], v[1]); w.y = pk2(v[2], v[3]); *(u32x2*)p = w; }
__device__ __forceinline__ void st_h(void* H, size_t idx, const f32x4 v, bool f8) { if (f8) *((unsigned*)((unsigned char*)H + idx)) = pk4_fp8(v[0] * 16.f, v[1] * 16.f, v[2] * 16.f, v[3] * 16.f); else st_bf4((bf16_t*)H + idx, v); }
__device__ __forceinline__ void post_norm_rows(const Frame& F, const Args& a, const bf16_t* Y, int gate_off, int lnidx, const float* MODh, int sh_off, int sc_off, void* H, bool h8) {
    const int lane = lane_id(), tid = F.wave * 64 + lane; (void)tid;
    const float* MOD = (const float*)(F.ws + WS_MOD); float* XR = (float*)(F.ws + WS_XR);
    const float* lnw = a.in[I_LNW] + lnidx * D; const float* lnb = a.in[I_LNB] + lnidx * D;
    for (int m = F.gw; m < ML; m += F.NGW) {
        const int b = m / T; const float* g = MOD + gate_off + (size_t)b * MOD_N; const size_t o = (size_t)m * D;
        f32x4 z[8];
#pragma unroll
        for (int j = 0; j < 8; ++j) { const int c = 4 * lane + 256 * j; z[j] = *(const f32x4*)(XR + o + c) * ALPHA + *(const f32x4*)(g + c) * ld_bf4(Y + o + c); }
        ln_core(lane, z, lnw, lnb);
        const float* sh = MODh + sh_off + (size_t)b * MOD_N; const float* sc = MODh + sc_off + (size_t)b * MOD_N;
#pragma unroll
        for (int j = 0; j < 8; ++j) { const int c = 4 * lane + 256 * j; *(f32x4*)(XR + o + c) = z[j];
            st_h(H, o + c, z[j] * (*(const f32x4*)(sc + c) + 1.0f) + *(const f32x4*)(sh + c), h8); }
    }
}

__device__ __forceinline__ void p11_pool(const Frame& F) {
    const int lane = lane_id(), tid = F.wave * 64 + lane; (void)tid;
    const bf16_t* HP = (const bf16_t*)(F.ws + A_HP); bf16_t* PP = (bf16_t*)(F.ws + A_PP);
    for (int m = F.gw; m < ML; m += F.NGW) {
        const int t = m % T;
#pragma unroll
        for (int g = 0; g < 4; ++g) {
            const int half = 1 << g, c = 8 * lane + 512 * g;
            int lo = t - half, hi = t + half; lo = lo < 0 ? 0 : lo; hi = hi > T ? T : hi;
            float acc[8], ctr[8];
#pragma unroll
            for (int e = 0; e < 8; ++e) acc[e] = 0.f;
            unpack8(*(const u32x4*)(HP + (size_t)m * D + c), ctr);
            for (int tt = lo; tt < hi; ++tt) { float v[8]; unpack8(*(const u32x4*)(HP + (size_t)(m - t + tt) * D + c), v);
#pragma unroll
                for (int e = 0; e < 8; ++e) acc[e] += v[e]; }
            const float inv = 1.0f / (float)(hi - lo);
            u32x4 w; w.x = pk2(acc[0] * inv - ctr[0], acc[1] * inv - ctr[1]); w.y = pk2(acc[2] * inv - ctr[2], acc[3] * inv - ctr[3]);
            w.z = pk2(acc[4] * inv - ctr[4], acc[5] * inv - ctr[5]); w.w = pk2(acc[6] * inv - ctr[6], acc[7] * inv - ctr[7]);
            *(u32x4*)(PP + (size_t)m * D + c) = w;
        }
    }
}

__device__ __forceinline__ void p13_norm_router(const Frame& F, const Args& a) {
    const int lane = lane_id(), tid = F.wave * 64 + lane; (void)tid;
    LAS float* RT = (LAS float*)F.lds;
    LAS int* lcnt = (LAS int*)(F.lds + 65536);
    LAS int* le = (LAS int*)(F.lds + 65536 + 64);
    LAS int* lr = (LAS int*)(F.lds + 65536 + 64 + 256);
    for (int i = tid; i < D * NE; i += 512) RT[(i & 7) * D + (i >> 3)] = a.in[I_ROUTER][i];
    const float* MOD = (const float*)(F.ws + WS_MOD); float* XR = (float*)(F.ws + WS_XR);
    const float* MOD1 = MOD + (size_t)5 * MOD_N;
    const bf16_t* Y = (const bf16_t*)(F.ws + A_YP); void* H = (void*)(F.ws + A_H2B);
    const float* lnw = a.in[I_LNW] + 2 * D; const float* lnb = a.in[I_LNB] + 2 * D;
    int* TOKE = (int*)(F.ws + WS_TOK); int* TOKS = TOKE + 2 * ML; float* TOKP = (float*)(TOKE + 6 * ML);
    unsigned* gcnt = F.ctl + CW_GCNT;
    for (int rb = blockIdx.x; rb < ML / 32; rb += F.G) {
        __syncthreads();
        if (tid < 8) lcnt[tid] = 0;
        __syncthreads();
        for (int i = 0; i < 4; ++i) {
            const int rl = F.wave * 4 + i, m = rb * 32 + rl, b = m / T; const size_t o = (size_t)m * D;
            const float* g = MOD1 + 2 * D + (size_t)b * MOD_N;
            f32x4 z[8];
#pragma unroll
            for (int j = 0; j < 8; ++j) { const int c = 4 * lane + 256 * j; z[j] = *(const f32x4*)(XR + o + c) * ALPHA + *(const f32x4*)(g + c) * ld_bf4(Y + o + c); }
            ln_core(lane, z, lnw, lnb);
            const float* sh = MOD1 + 3 * D + (size_t)b * MOD_N; const float* sc = MOD1 + 4 * D + (size_t)b * MOD_N;
            float lg[8];
#pragma unroll
            for (int e = 0; e < 8; ++e) lg[e] = 0.f;
#pragma unroll
            for (int j = 0; j < 8; ++j) { const int c = 4 * lane + 256 * j; *(f32x4*)(XR + o + c) = z[j];
                const f32x4 hv = z[j] * (*(const f32x4*)(sc + c) + 1.0f) + *(const f32x4*)(sh + c);
                st_h(H, o + c, hv, MOE_FP8 != 0);
#pragma unroll
                for (int e = 0; e < 8; ++e) { const f32x4 rt = *(const LAS f32x4*)(RT + e * D + c); lg[e] += (hv[0] * rt[0] + hv[1] * rt[1]) + (hv[2] * rt[2] + hv[3] * rt[3]); } }
#pragma unroll
            for (int e = 0; e < 8; ++e) lg[e] = wave_sum(lg[e]);
            int i0 = 0; float l0 = lg[0];
#pragma unroll
            for (int e = 1; e < 8; ++e) if (lg[e] > l0) { l0 = lg[e]; i0 = e; }
            int i1 = -1; float l1 = -3.0e38f;
#pragma unroll
            for (int e = 0; e < 8; ++e) if (e != i0 && lg[e] > l1) { l1 = lg[e]; i1 = e; }
            if (i1 < 0) { i1 = (i0 + 1) & 7; l1 = l0; }
            const float e1 = fexp(l1 - l0), p0 = 1.0f / (1.0f + e1), p1 = e1 / (1.0f + e1);
            if (lane == 0) { TOKE[2 * m] = i0; TOKE[2 * m + 1] = i1; TOKP[2 * m] = p0; TOKP[2 * m + 1] = p1;
                le[2 * rl] = i0; le[2 * rl + 1] = i1; lr[2 * rl] = __hip_atomic_fetch_add(&lcnt[i0], 1, __ATOMIC_RELAXED, __HIP_MEMORY_SCOPE_WORKGROUP); lr[2 * rl + 1] = __hip_atomic_fetch_add(&lcnt[i1], 1, __ATOMIC_RELAXED, __HIP_MEMORY_SCOPE_WORKGROUP); }
        }
        __syncthreads();
        if (tid < 8) lcnt[8 + tid] = (int)__hip_atomic_fetch_add(gcnt + 64 * tid, (unsigned)lcnt[tid], __ATOMIC_RELAXED, __HIP_MEMORY_SCOPE_AGENT);
        __syncthreads();
        if (tid < 64) TOKS[2 * (rb * 32) + tid] = lcnt[8 + le[tid]] + lr[tid];
    }
    __syncthreads();
}

struct MoeTab { int mt[8], ts[8], ntile; };
__device__ __forceinline__ MoeTab moe_tab(const Frame& F) {
    MoeTab t; int acc = 0;
#pragma unroll
    for (int e = 0; e < 8; ++e) { const int c = __builtin_amdgcn_readfirstlane((int)__hip_atomic_load(F.ctl + CW_GCNT + 64 * e, __ATOMIC_RELAXED, __HIP_MEMORY_SCOPE_AGENT)); t.mt[e] = (c + 255) >> 8; t.ts[e] = acc; acc += t.mt[e]; }
    t.ntile = acc; return t;
}
__device__ __forceinline__ void p14_gather(const Frame& F) {
    const int lane = lane_id(), tid = F.wave * 64 + lane; (void)tid;
    const MoeTab tb = moe_tab(F);
    const int* TOKE = (const int*)(F.ws + WS_TOK); const int* TOKS = TOKE + 2 * ML; int* TOKD = (int*)(TOKE + 4 * ML);
    const bf16_t* H = (const bf16_t*)(F.ws + A_H2B); bf16_t* HG = (bf16_t*)(F.ws + A_HG);
    for (int idx = F.gw; idx < 2 * ML; idx += F.NGW) {
        const int m = idx >> 1, e = TOKE[idx], sl = TOKS[idx]; int ts = 0;
#pragma unroll
        for (int k = 0; k < 8; ++k) ts = (e == k) ? tb.ts[k] : ts;
        const int dst = ts * 256 + sl;
        if (lane == 0) TOKD[idx] = dst;
        constexpr int RB = MOE_FP8 ? D : 2 * D;
        const u32x4* s = (const u32x4*)((const unsigned char*)H + (size_t)m * RB) + lane; u32x4* dd = (u32x4*)((unsigned char*)HG + (size_t)dst * RB) + lane;
        const u32x4 v0 = s[0], v1 = s[64]; dd[0] = v0; dd[64] = v1;
        if (!MOE_FP8) { const u32x4 v2 = s[128], v3 = s[192]; dd[128] = v2; dd[192] = v3; }
    }
}
__device__ __forceinline__ void p17_final(const Frame& F, const Args& a) {
    const int lane = lane_id(), tid = F.wave * 64 + lane; (void)tid;
    const float* MOD1 = (const float*)(F.ws + WS_MOD) + (size_t)5 * MOD_N; const float* XR = (const float*)(F.ws + WS_XR);
    const int* TOKD = (const int*)(F.ws + WS_TOK) + 4 * ML; const float* TOKP = (const float*)((const int*)(F.ws + WS_TOK) + 6 * ML);
    const bf16_t* Y2 = (const bf16_t*)(F.ws + A_Y2);
    const float* lnw = a.in[I_LNW] + 3 * D; const float* lnb = a.in[I_LNB] + 3 * D;
    for (int m = F.gw; m < ML; m += F.NGW) {
        const int b = m / T; const float* g = MOD1 + 5 * D + (size_t)b * MOD_N; const size_t o = (size_t)m * D;
        const int d0 = TOKD[2 * m], d1 = TOKD[2 * m + 1]; const float p0 = TOKP[2 * m], p1 = TOKP[2 * m + 1];
        f32x4 z[8];
#pragma unroll
        for (int j = 0; j < 8; ++j) { const int c = 4 * lane + 256 * j;
            const f32x4 y = ld_bf4(Y2 + (size_t)d0 * D + c) * p0 + ld_bf4(Y2 + (size_t)d1 * D + c) * p1;
            z[j] = *(const f32x4*)(XR + o + c) * ALPHA + *(const f32x4*)(g + c) * y; }
        ln_core(lane, z, lnw, lnb);
#if defined(PROBE_SCANCHK)
        { const float n1 = __hip_atomic_load((float*)(F.ctl + CW_CHK), __ATOMIC_RELAXED, __HIP_MEMORY_SCOPE_AGENT), d1 = __hip_atomic_load((float*)(F.ctl + CW_CHK + 64), __ATOMIC_RELAXED, __HIP_MEMORY_SCOPE_AGENT);
          const float n2 = __hip_atomic_load((float*)(F.ctl + CW_CHK + 128), __ATOMIC_RELAXED, __HIP_MEMORY_SCOPE_AGENT), d2 = __hip_atomic_load((float*)(F.ctl + CW_CHK + 192), __ATOMIC_RELAXED, __HIP_MEMORY_SCOPE_AGENT);
          const float eps = sqrtf(n1 / d1) + sqrtf(n2 / d2), sc = 1.0f + 10.0f * eps;
#pragma unroll
          for (int j = 0; j < 8; ++j) z[j] = z[j] * sc; }
#endif
#pragma unroll
        for (int j = 0; j < 8; ++j) { const int c = 4 * lane + 256 * j; *(f32x4*)(a.out + o + c) = z[j]; }
    }
}

struct SchedBase { __device__ __forceinline__ void a_ready(const pg8::Unit&) const {} __device__ __forceinline__ void done(const pg8::Unit&) const {} };
struct SchedDense : SchedBase {
    const char* A; const char* B; bf16_t* O; const float* bias; int nM, nN, ldaB, ldbB, ldc, act, G, c;
    __device__ __forceinline__ bool next(int i, pg8::Unit& u) const {
        const int L = i * G + c; if (L >= nM * nN) return false;
        int pm, pn; pg8::tile_of(L, nM, nN, pm, pn);
        u.A = A + (size_t)pm * 256 * ldaB; u.B = B + (size_t)pn * 256 * ldbB; u.O = O; u.bias = bias; u.pm = pm; u.pn = pn; u.ldc = ldc; u.act = act; return true;
    }
};
struct SchedP2 : SchedBase {
    unsigned char* ws; int G, c;
    __device__ __forceinline__ bool next(int i, pg8::Unit& u) const {
        int L = i * G + c; if (L >= 936) return false;
        int mix, nM, nN, act, ldc; size_t wo, oo;
        if (L < 256)      { mix = 0; nM = 32; nN = 8; act = pg8::ACT_NONE;    wo = W_WR;  oo = A_R;   ldc = D; }
        else if (L < 544) { L -= 256; mix = 2; nM = 36; nN = 8; act = pg8::ACT_NONE; wo = W_WK;  oo = A_KX;  ldc = D; }
        else if (L < 832) { L -= 544; mix = 3; nM = 36; nN = 8; act = pg8::ACT_NONE; wo = W_WV;  oo = A_V;   ldc = D; }
        else if (L < 868) { L -= 832; mix = 1; nM = 36; nN = 1; act = pg8::ACT_TANH; wo = W_WLD; oo = A_LW;  ldc = 256; }
        else if (L < 904) { L -= 868; mix = 4; nM = 36; nN = 1; act = pg8::ACT_NONE; wo = W_ALD; oo = A_LA;  ldc = 256; }
        else              { L -= 904; mix = 5; nM = 32; nN = 1; act = pg8::ACT_SIGMOID; wo = W_G1; oo = A_G1O; ldc = 256; }
        int pm, pn; pg8::tile_of(L, nM, nN, pm, pn);
        u.A = (const char*)ws + A_A6 + (size_t)mix * A6_STRIDE + (size_t)pm * 256 * D * 2; u.B = (const char*)ws + wo + (size_t)pn * 256 * D * 2;
        u.O = (bf16_t*)(ws + oo); u.bias = nullptr; u.pm = pm; u.pn = pn; u.ldc = ldc; u.act = act; return true;
    }
};
struct SchedP3 : SchedBase {
    unsigned char* ws; const float* dw0; const float* ia0; int G, c;
    __device__ __forceinline__ bool next(int i, pg8::Unit& u) const {
        int L = i * G + c; if (L >= 1408) return false;
        int nM, nN, act, ldc; size_t ao, wo, oo; const float* bias;
        if (L < 576)       { nM = 36; nN = 16; act = pg8::ACT_EW; ao = A_LW; wo = W_WLU; oo = A_EW; ldc = 2 * D; bias = dw0; }
        else if (L < 1152) { L -= 576; nM = 36; nN = 16; act = pg8::ACT_BIAS_SIGMOID; ao = A_LA; wo = W_ALU; oo = A_AA; ldc = 2 * D; bias = ia0; }
        else               { L -= 1152; nM = 32; nN = 8; act = pg8::ACT_NONE; ao = A_G1O; wo = W_G2; oo = A_GATE; ldc = D; bias = nullptr; }
        int pm, pn; pg8::tile_of(L, nM, nN, pm, pn);
        u.A = (const char*)ws + ao + (size_t)pm * 256 * 256 * 2; u.B = (const char*)ws + wo + (size_t)pn * 256 * 256 * 2;
        u.O = (bf16_t*)(ws + oo); u.bias = bias; u.pm = pm; u.pn = pn; u.ldc = ldc; u.act = act; return true;
    }
};
struct SchedPool : SchedBase {
    unsigned char* ws; const float* scale; int G, c;
    __device__ __forceinline__ bool next(int i, pg8::Unit& u) const {
        const int L = i * G + c; if (L >= 256) return false;
        int pm, pn; pg8::tile_of(L, 32, 8, pm, pn);
        u.A = (const char*)ws + A_PP + ((size_t)pm * 256 * D + (size_t)(pn >> 1) * 512) * 2; u.B = (const char*)ws + W_PW + (size_t)pn * 256 * 512 * 2;
        u.O = (bf16_t*)(ws + A_YP); u.bias = scale; u.pm = pm; u.pn = pn; u.ldc = D; u.act = pg8::ACT_COLSCALE; return true;
    }
};
struct SchedMoe : SchedBase {
    MoeTab tb; const char* A; const char* B; bf16_t* O; int NT, ldaB, ldbB, ldc; size_t estride; int NL, x, rank, W;
    __device__ __forceinline__ void init(int G, int c) { NL = (G % 8 == 0) ? 8 : 1; x = c % NL; rank = c / NL; W = G / NL; }
    __device__ __forceinline__ bool next(int i, pg8::Unit& u) const {
        int j = rank + i * W; const int nn = (NT - x + NL - 1) / NL;
        int e = -1, mte = 1, tse = 0;
#pragma unroll
        for (int k = 0; k < 8; ++k) { const int blk = nn * tb.mt[k]; if (e < 0) { if (j < blk) { e = k; mte = tb.mt[k]; tse = tb.ts[k]; } else j -= blk; } }
        if (e < 0) return false;
        const int nt = x + NL * (j / mte), mtile = tse + (j % mte);
        u.A = A + (size_t)mtile * 256 * ldaB; u.B = B + (size_t)e * estride + (size_t)nt * 256 * ldbB; u.O = O; u.bias = nullptr; u.pm = mtile; u.pn = nt; u.ldc = ldc; u.act = pg8::ACT_NONE; return true;
    }
};

constexpr int NPHASE = 18;
#ifndef CONV_P2
#define CONV_P2 6656
#endif
#ifndef CONV_P8
#define CONV_P8 8960
#endif
constexpr int NC_P2 = 234, NC_P8 = 235, TI_X1 = TI_M2 - CONV_P8, TI_X0 = TI_X1 - CONV_P2;
__global__ void __launch_bounds__(512, 2) trunk_fwd(Args args) {
    extern __shared__ __attribute__((aligned(16))) unsigned char lds_raw[];
    Frame F;
    F.lds = (LAS unsigned char*)lds_raw;
    F.wave = __builtin_amdgcn_readfirstlane((int)(threadIdx.x >> 6));
    F.G = gridDim.x; { const int bx = blockIdx.x; F.vcu = (F.G % 8 == 0) ? (bx % 8) * (F.G / 8) + bx / 8 : bx; }
    F.gw = F.vcu * 8 + F.wave; F.NGW = F.G * 8;
    F.ws = args.ws; F.ctl = (unsigned*)(args.ws + WS_CTL);
    volatile LAS unsigned* MISC = (volatile LAS unsigned*)(F.lds + MISC_OFF);
    if (threadIdx.x < 32) MISC[threadIdx.x] = 0u;
    __syncthreads();
    XcdBarrier bar; bar.bar = F.ctl + CW_BAR + args.li * XCD_BAR_WORDS; bar.x = 0; bar.st = nullptr;
    if (MK_N_LAUNCHES == 1) bar = xcd_barrier_post(F.ctl + CW_BAR + args.li * XCD_BAR_WORDS, MISC + 8);
    const int lo = args.ph_lo, hi = args.ph_hi;
#define IN(k) (lo <= (k) && (k) < hi)
#define SEAM(k) do { if (IN(k) && IN((k) + 1)) xcd_barrier(bar); } while (0)
    constexpr bool AL = true, SP = true;

    if (IN(0)) {
        p0_mod(F, args);
        p0_pos(F);
        p0_small(F, args);
#if defined(PROBE_P0A)
        p0_mod(F, args); p0_pos(F); p0_small(F, args);
#endif
        p0_transpose_range(F, args, 0, F.G == 256 ? TI_X0 : TI_M2, F.gw, F.NGW, (LAS unsigned*)(F.lds + 53248 + F.wave * 8448));
    }
    SEAM(0);
    if (IN(1)) p1_mix(F, args);
    SEAM(1);
    if (IN(2)) {
        const bool split = F.G == 256;
        if (split && (int)blockIdx.x >= NC_P2) p0_transpose_range(F, args, TI_X0, TI_X1, ((int)blockIdx.x - NC_P2) * 8 + F.wave, (256 - NC_P2) * 8, (LAS unsigned*)(F.lds + 53248 + F.wave * 8448));
        else { SchedP2 S; S.ws = F.ws; S.G = split ? NC_P2 : F.G; S.c = blockIdx.x; pg8::gemm_phase<pg8::EpiAct, SchedP2, AL, SP>(F.lds, pg8::shape_bf16(D, D, D), S, pg8::EpiAct{}); }
    }
    SEAM(2);
    if (IN(3)) { SchedP3 S; S.ws = F.ws; S.dw0 = args.in[I_DW0]; S.ia0 = args.in[I_IA0]; S.G = F.G; S.c = blockIdx.x; pg8::gemm_phase<pg8::EpiAct, SchedP3, AL, SP>(F.lds, pg8::shape_bf16(256, 256, 256), S, pg8::EpiAct{}); }
    SEAM(3);
#if defined(PROBE_SCANCHK)
    if (IN(4)) { p4_scan(F, args); p4_scan2(F, args, F.ws + A_AO, (float*)(F.ws + WS_A + 644 * MiB)); xcd_barrier(bar); p4_compare(F); }
#elif defined(SCAN_STEP)
    if (IN(4)) p4_scan(F, args);
#else
    if (IN(4)) p4_scan2(F, args, F.ws + A_YD, (float*)(F.ws + WS_SB));
#endif
    SEAM(4);
    if (IN(5)) p5_ao(F, args);
    SEAM(5);
    if (IN(6)) { SchedDense S; S.A = (const char*)F.ws + A_AO; S.B = (const char*)F.ws + W_WO; S.O = (bf16_t*)(F.ws + A_YO); S.bias = nullptr; S.nM = 32; S.nN = 8; S.ldaB = 2 * D; S.ldbB = 2 * D; S.ldc = D; S.act = pg8::ACT_NONE; S.G = F.G; S.c = blockIdx.x;
        pg8::gemm_phase<pg8::EpiAct, SchedDense, AL, SP>(F.lds, pg8::shape_bf16(D, D, D), S, pg8::EpiAct{}); }
    SEAM(6);
    if (IN(7)) { const float* MOD = (const float*)(F.ws + WS_MOD); post_norm_rows(F, args, (const bf16_t*)(F.ws + A_YO), 2 * D, 0, MOD, 3 * D, 4 * D, (void*)(F.ws + A_H2), FFN_FP8 != 0); }
    SEAM(7);
    if (IN(8)) {
        const bool split = F.G == 256;
        if (split && (int)blockIdx.x >= NC_P8) p0_transpose_range(F, args, TI_X1, TI_M2, ((int)blockIdx.x - NC_P8) * 8 + F.wave, (256 - NC_P8) * 8, (LAS unsigned*)(F.lds + 53248 + F.wave * 8448));
        else { SchedDense S; S.A = (const char*)F.ws + A_H2; S.B = (const char*)F.ws + W_F13; S.O = (bf16_t*)(F.ws + A_U); S.bias = nullptr; S.nM = 32; S.nN = 44; S.ldaB = FFN_FP8 ? D : 2 * D; S.ldbB = S.ldaB; S.ldc = DFF; S.act = 0; S.G = split ? NC_P8 : F.G; S.c = blockIdx.x;
        if (FFN_FP8) pg8::gemm_phase<pg8::EpiSwiglu8, SchedDense, AL, SP, true>(F.lds, pg8::shape_fp8(D, D, D, 4, 6), S, pg8::EpiSwiglu8{});
        else pg8::gemm_phase<pg8::EpiSwiglu, SchedDense, AL, SP>(F.lds, pg8::shape_bf16(D, D, D), S, pg8::EpiSwiglu{}); } }
    SEAM(8);
    if (IN(9)) { SchedDense S; S.A = (const char*)F.ws + A_U; S.B = (const char*)F.ws + W_F2; S.O = (bf16_t*)(F.ws + A_YF); S.bias = nullptr; S.nM = 32; S.nN = 8; S.ldaB = FFN_FP8 ? DFF : 2 * DFF; S.ldbB = S.ldaB; S.ldc = D; S.act = pg8::ACT_NONE; S.G = F.G; S.c = blockIdx.x;
        if (FFN_FP8) pg8::gemm_phase<pg8::EpiAct, SchedDense, AL, SP, true>(F.lds, pg8::shape_fp8(DFF, DFF, DFF, 3, 8), S, pg8::EpiAct{});
        else pg8::gemm_phase<pg8::EpiAct, SchedDense, AL, SP>(F.lds, pg8::shape_bf16(DFF, DFF, DFF), S, pg8::EpiAct{}); }
    SEAM(9);
    if (IN(10)) { const float* MOD = (const float*)(F.ws + WS_MOD); post_norm_rows(F, args, (const bf16_t*)(F.ws + A_YF), 5 * D, 1, MOD + (size_t)5 * MOD_N, 0, D, (void*)(F.ws + A_HP), false); }
    SEAM(10);
    if (IN(11)) p11_pool(F);
    SEAM(11);
    if (IN(12)) { SchedPool S; S.ws = F.ws; S.scale = args.in[I_POOLS]; S.G = F.G; S.c = blockIdx.x; pg8::gemm_phase<pg8::EpiAct, SchedPool, AL, SP>(F.lds, pg8::shape_bf16(D, 512, 512), S, pg8::EpiAct{}); }
    SEAM(12);
    if (IN(13)) p13_norm_router(F, args);
    SEAM(13);
    if (IN(14)) p14_gather(F);
    SEAM(14);
    if (IN(15)) { SchedMoe S; S.tb = moe_tab(F); S.A = (const char*)F.ws + A_HG; S.B = (const char*)F.ws + W_M13; S.O = (bf16_t*)(F.ws + A_UG); S.NT = 56; S.ldaB = MOE_FP8 ? D : 2 * D; S.ldbB = S.ldaB; S.ldc = DFE; S.estride = (size_t)2 * DFE * S.ldbB; S.init(F.G, blockIdx.x);
        if (MOE_FP8) pg8::gemm_phase<pg8::EpiSwiglu8, SchedMoe, AL, SP, true>(F.lds, pg8::shape_fp8(D, D, D, 4, 6), S, pg8::EpiSwiglu8{});
        else pg8::gemm_phase<pg8::EpiSwiglu, SchedMoe, AL, SP>(F.lds, pg8::shape_bf16(D, D, D), S, pg8::EpiSwiglu{}); }
    SEAM(15);
    if (IN(16)) { SchedMoe S; S.tb = moe_tab(F); S.A = (const char*)F.ws + A_UG; S.B = (const char*)F.ws + W_M2; S.O = (bf16_t*)(F.ws + A_Y2); S.NT = 8; S.ldaB = MOE_FP8 ? DFE : 2 * DFE; S.ldbB = S.ldaB; S.ldc = D; S.estride = (size_t)D * S.ldbB; S.init(F.G, blockIdx.x);
        if (MOE_FP8) pg8::gemm_phase<pg8::EpiAct, SchedMoe, AL, SP, true>(F.lds, pg8::shape_fp8(DFE, DFE, DFE, 3, 8), S, pg8::EpiAct{});
        else pg8::gemm_phase<pg8::EpiAct, SchedMoe, AL, SP>(F.lds, pg8::shape_bf16(DFE, DFE, DFE), S, pg8::EpiAct{}); }
    SEAM(16);
    if (IN(17)) p17_final(F, args);
#undef IN
#undef SEAM
}

extern "C" void kernel_launch(void* const* d_in, const int* in_sizes, int n_in, void* d_out, int out_size, void* d_ws, size_t ws_size, hipStream_t stream) {
    static int grid = 0;
    if (grid == 0) {
        if (n_in != 35 || out_size != ML * D || ws_size < WS_END) { fprintf(stderr, "kernel_launch: unexpected problem (n_in %d, out %d, ws %zu < %zu); nothing launched\n", n_in, out_size, ws_size, (size_t)WS_END); grid = -1; return; }
        int dev = 0, cus = 0, per_cu = 0;
        if (hipGetDevice(&dev) != hipSuccess || hipDeviceGetAttribute(&cus, hipDeviceAttributeMultiprocessorCount, dev) != hipSuccess) { grid = -1; return; }
        if (hipFuncSetAttribute((const void*)trunk_fwd, hipFuncAttributeMaxDynamicSharedMemorySize, LDS_BYTES) != hipSuccess) { fprintf(stderr, "kernel_launch: hipFuncSetAttribute failed\n"); grid = -1; return; }
        if (hipOccupancyMaxActiveBlocksPerMultiprocessor(&per_cu, (const void*)trunk_fwd, 512, LDS_BYTES) != hipSuccess || per_cu < 1) fprintf(stderr, "kernel_launch: occupancy query reports %d\n", per_cu);
        (void)hipGetLastError();
        grid = cus;
    }
    if (grid < 0) return;
    if (hipMemsetAsync((char*)d_ws + WS_CTL, 0, CTL_ZERO_BYTES, stream) != hipSuccess) return;
    Args a{};
    for (int i = 0; i < 35; ++i) a.in[i] = (const float*)d_in[i];
    a.out = (float*)d_out; a.ws = (unsigned char*)d_ws;
#if defined(PROBE_DUP)
    a.ph_lo = 0; a.ph_hi = PROBE_DUP + 1; a.li = 0; hipLaunchKernelGGL(trunk_fwd, dim3(grid), dim3(512), LDS_BYTES, stream, a);
    a.ph_lo = PROBE_DUP; a.ph_hi = NPHASE; a.li = 1; hipLaunchKernelGGL(trunk_fwd, dim3(grid), dim3(512), LDS_BYTES, stream, a);
#else
    if (MK_N_LAUNCHES == 1) { a.ph_lo = 0; a.ph_hi = NPHASE; hipLaunchKernelGGL(trunk_fwd, dim3(grid), dim3(512), LDS_BYTES, stream, a); }
#endif
#if !defined(PROBE_DUP)
    else for (int p = 0; p < NPHASE; ++p) { a.ph_lo = p; a.ph_hi = p + 1; hipLaunchKernelGGL(trunk_fwd, dim3(grid), dim3(512), LDS_BYTES, stream, a); }
#endif
}
```

```cpp
#include <hip/hip_runtime.h>
#include <cstdio>
#include <cstdint>

#ifndef MK_N_LAUNCHES
#define MK_N_LAUNCHES 1
#endif

#define LAS __attribute__((address_space(3)))
#define PG8_LAS __attribute__((address_space(3)))
typedef unsigned short bf16_t;
typedef short bf16x8 __attribute__((ext_vector_type(8)));
typedef float f32x4 __attribute__((ext_vector_type(4)));
typedef float f32x2 __attribute__((ext_vector_type(2)));
typedef unsigned u32x4 __attribute__((ext_vector_type(4)));
typedef unsigned u32x2 __attribute__((ext_vector_type(2)));
typedef int i32x8 __attribute__((ext_vector_type(8)));
typedef int i32x4 __attribute__((ext_vector_type(4)));

constexpr int D = 2048, NB = 4, T = 2048, TC = 256, NH = 32, HS = 64;
constexpr int ML = NB * T;
constexpr int MC = NB * TC;
constexpr int MT = ML + MC;
constexpr int DFF = 5632, DFE = 7168, NE = 8;
constexpr int MOD_N = 6 * D;
constexpr int MROWS_PAD = 2 * ML + NE * 256;
constexpr float ALPHA = 1.41421356237309515f;
constexpr float LN_EPS = 1e-5f, GN_EPS = 64e-5f;

__device__ __forceinline__ unsigned f2bf(float f) { unsigned u = __builtin_bit_cast(unsigned, f); return (u + 0x7fffu + ((u >> 16) & 1u)) >> 16; }
typedef __bf16 bf16x2v __attribute__((ext_vector_type(2)));
__device__ __forceinline__ unsigned pk2(float lo, float hi) { const f32x2 v = {lo, hi}; return __builtin_bit_cast(unsigned, __builtin_convertvector(v, bf16x2v)); }
__device__ __forceinline__ float clamp8(float x) { return __builtin_amdgcn_fmed3f(x, -440.f, 440.f); }
__device__ __forceinline__ unsigned pk4_fp8(float a, float b, float c, float d) { int v = __builtin_amdgcn_cvt_pk_fp8_f32(clamp8(a), clamp8(b), 0, false); v = __builtin_amdgcn_cvt_pk_fp8_f32(clamp8(c), clamp8(d), v, true); return (unsigned)v; }
__device__ __forceinline__ float bflo(unsigned w) { return __builtin_bit_cast(float, w << 16); }
__device__ __forceinline__ float bfhi(unsigned w) { return __builtin_bit_cast(float, w & 0xffff0000u); }
__device__ __forceinline__ float fexp(float x) { return __builtin_amdgcn_exp2f(x * 1.44269504088896341f); }
__device__ __forceinline__ float flog(float x) { return __builtin_amdgcn_logf(x) * 0.69314718055994531f; }
__device__ __forceinline__ float sigmoidf_(float x) { return __builtin_amdgcn_rcpf(1.0f + fexp(-x)); }
__device__ __forceinline__ float siluf_(float x) { return x * __builtin_amdgcn_rcpf(1.0f + fexp(-x)); }
__device__ __forceinline__ float tanhf_(float x) { return 1.0f - 2.0f * __builtin_amdgcn_rcpf(1.0f + fexp(2.0f * x)); }
__device__ __forceinline__ float wave_sum(float v) {
#pragma unroll
    for (int o = 1; o < 64; o <<= 1) v += __shfl_xor(v, o);
    return v;
}
__device__ __forceinline__ int lane_id() { int l; asm volatile("v_mbcnt_lo_u32_b32 %0, -1, 0\n\tv_mbcnt_hi_u32_b32 %0, -1, %0" : "=v"(l)); return l; }
template <int CTRL> __device__ __forceinline__ float dpp_f(float v) { return __builtin_bit_cast(float, __builtin_amdgcn_update_dpp(0, __builtin_bit_cast(int, v), CTRL, 0xF, 0xF, true)); }
__device__ __forceinline__ float sum8(float v) {
    v += dpp_f<0xB1>(v);
    v += dpp_f<0x4E>(v);
    v += dpp_f<0x141>(v);
    return v;
}
__device__ __forceinline__ const char* uptr(const void* p) {
    unsigned long long v = (unsigned long long)p;
    unsigned lo = (unsigned)__builtin_amdgcn_readfirstlane((int)(unsigned)v), hi = (unsigned)__builtin_amdgcn_readfirstlane((int)(unsigned)(v >> 32));
    return (const char*)(((unsigned long long)hi << 32) | lo);
}

namespace pg8 {
constexpr int BM = 256, BK = 64, HALF = 128, HTB = HALF * BK * 2  , STAGE_BYTES = 8 * HTB, NXCD = 8, WGM = 8;
__host__ __device__ __forceinline__ int lds_byte(int r, int c) { const int st = (r >> 4) * 2 + (c >> 5), rr = r & 15, cc = c & 31, ob = rr * 64 + cc * 2; return st * 1024 + (ob ^ (((ob >> 9) & 1) << 5)); }
__host__ __device__ __forceinline__ void stage_rc(int b, int& R, int& C) { const int st = b / 1024, sb = b % 1024, swz = sb ^ (((sb >> 9) & 1) << 5); R = (st >> 1) * 16 + swz / 64; C = (st & 1) * 32 + (swz % 64) / 2; }
__host__ __device__ __forceinline__ int perm32(int rho) { const int n = rho >> 4, i = rho & 15; return 8 * (i >> 2) + 4 * n + (i & 3); }
__device__ __forceinline__ unsigned cvt_pk_bf16(float lo, float hi) { unsigned r; asm volatile("v_cvt_pk_bf16_f32 %0, %1, %2" : "=v"(r) : "v"(lo), "v"(hi)); return r; }

struct Unit { const char* A; const char* B; bf16_t* O; const float* bias; int pm, pn, ldc, act; };
struct Shape { int ldaB, ldbB, nt, sc; };
__host__ __device__ __forceinline__ Shape shape_bf16(int lda, int ldb, int K) { return Shape{2 * lda, 2 * ldb, K / 64, 0}; }
__host__ __device__ __forceinline__ Shape shape_fp8(int lda, int ldb, int K, int ea, int eb) { return Shape{lda, ldb, K / 128, ((127 - ea) << 8) | (127 - eb)}; }

__device__ __forceinline__ void tile_of(int l, int nM, int nN, int& pm, int& pn) {
    const int nwg = nM * nN; int wgid = l;
    { const int q = nwg / NXCD, r = nwg % NXCD, xcd = wgid % NXCD, off = wgid / NXCD; wgid = (xcd < r ? xcd * (q + 1) : r * (q + 1) + (xcd - r) * q) + off; }
    const int nig = WGM * nN, gid = wgid / nig, fm = gid * WGM, gsz = (nM - fm) < WGM ? (nM - fm) : WGM;
    pm = fm + ((wgid % nig) % gsz); pn = (wgid % nig) / gsz;
}

enum Act { ACT_NONE = 0, ACT_TANH = 1, ACT_SIGMOID = 2, ACT_EW = 3, ACT_BIAS_SIGMOID = 4, ACT_COLSCALE = 5 };
__device__ __forceinline__ float act_apply(float v, float b, int act) {
    if (act == ACT_TANH) return tanhf_(v);
    if (act == ACT_SIGMOID) return sigmoidf_(v);
    if (act == ACT_EW) { const float z = -(v + b); const float sp = (z > 20.f) ? z : flog(1.0f + fexp(z)); return fexp(-sp - 0.5f); }
    if (act == ACT_BIAS_SIGMOID) return sigmoidf_(v + b);
    if (act == ACT_COLSCALE) return v * b;
    return v;
}
struct EpiAct {
    static constexpr bool PERM = true, AFTER_DRAIN = false;
    __device__ __forceinline__ void operator()(const f32x4 (&acc)[2][2][4][2], const Unit& u, int wr, int wc) const {
        const int lane_ = lane_id(), fr = lane_ & 15, fq = lane_ >> 4;
        const int row0 = u.pm * BM + wr * 64 + fr, col0 = u.pn * BM + wc * 32 + 8 * fq; const int act = u.act;
        f32x4 bv[2][2];
#pragma unroll
        for (int bj = 0; bj < 2; ++bj)
#pragma unroll
            for (int n = 0; n < 2; ++n) bv[bj][n] = u.bias ? *(const f32x4*)(u.bias + col0 + bj * HALF + 4 * n) : (f32x4){0.f, 0.f, 0.f, 0.f};
#pragma unroll
        for (int ai = 0; ai < 2; ++ai)
#pragma unroll
            for (int m = 0; m < 4; ++m) { bf16_t* rowp = u.O + (size_t)(row0 + ai * HALF + m * 16) * u.ldc + col0;
#pragma unroll
                for (int bj = 0; bj < 2; ++bj) { f32x4 v0 = acc[ai][bj][m][0], v1 = acc[ai][bj][m][1];
                    if (act != ACT_NONE) {
#pragma unroll
                        for (int j = 0; j < 4; ++j) { v0[j] = act_apply(v0[j], bv[bj][0][j], act); v1[j] = act_apply(v1[j], bv[bj][1][j], act); } }
                    u32x4 w; w.x = cvt_pk_bf16(v0[0], v0[1]); w.y = cvt_pk_bf16(v0[2], v0[3]); w.z = cvt_pk_bf16(v1[0], v1[1]); w.w = cvt_pk_bf16(v1[2], v1[3]);
                    *(u32x4*)(rowp + bj * HALF) = w; } }
    }
};
struct EpiF32P {
    static constexpr bool PERM = true, AFTER_DRAIN = false;
    __device__ __forceinline__ void operator()(const f32x4 (&acc)[2][2][4][2], const Unit& u, int wr, int wc) const {
        const int lane_ = lane_id(), fr = lane_ & 15, fq = lane_ >> 4;
        const int row0 = u.pm * BM + wr * 64 + fr, col0 = u.pn * BM + wc * 32 + 8 * fq;
#pragma unroll
        for (int ai = 0; ai < 2; ++ai)
#pragma unroll
            for (int m = 0; m < 4; ++m) { float* rowp = (float*)u.O + (size_t)(row0 + ai * HALF + m * 16) * u.ldc + col0;
#pragma unroll
                for (int bj = 0; bj < 2; ++bj) { *(f32x4*)(rowp + bj * HALF) = acc[ai][bj][m][0]; *(f32x4*)(rowp + bj * HALF + 4) = acc[ai][bj][m][1]; } }
    }
};
struct EpiSwiglu {
    static constexpr bool PERM = true, AFTER_DRAIN = false;
    __device__ __forceinline__ void operator()(const f32x4 (&acc)[2][2][4][2], const Unit& u, int wr, int wc) const {
        const int lane_ = lane_id(), fr = lane_ & 15, fq = lane_ >> 4;
        const int row0 = u.pm * BM + wr * 64 + fr, col0 = u.pn * HALF + wc * 32 + 8 * fq;
#pragma unroll
        for (int ai = 0; ai < 2; ++ai)
#pragma unroll
            for (int m = 0; m < 4; ++m) { bf16_t* rowp = u.O + (size_t)(row0 + ai * HALF + m * 16) * u.ldc + col0;
                f32x4 o0, o1;
#pragma unroll
                for (int j = 0; j < 4; ++j) { o0[j] = siluf_(acc[ai][0][m][0][j]) * acc[ai][1][m][0][j]; o1[j] = siluf_(acc[ai][0][m][1][j]) * acc[ai][1][m][1][j]; }
                u32x4 w; w.x = cvt_pk_bf16(o0[0], o0[1]); w.y = cvt_pk_bf16(o0[2], o0[3]); w.z = cvt_pk_bf16(o1[0], o1[1]); w.w = cvt_pk_bf16(o1[2], o1[3]);
                *(u32x4*)rowp = w; }
    }
};

struct EpiSwiglu8 {
    static constexpr bool PERM = true, AFTER_DRAIN = false;
    __device__ __forceinline__ void operator()(const f32x4 (&acc)[2][2][4][2], const Unit& u, int wr, int wc) const {
        const int lane_ = lane_id(), fr = lane_ & 15, fq = lane_ >> 4;
        const int row0 = u.pm * BM + wr * 64 + fr, col0 = u.pn * HALF + wc * 32 + 8 * fq;
#pragma unroll
        for (int ai = 0; ai < 2; ++ai)
#pragma unroll
            for (int m = 0; m < 4; ++m) { unsigned char* rowp = (unsigned char*)u.O + (size_t)(row0 + ai * HALF + m * 16) * u.ldc + col0;
                f32x4 o0, o1;
#pragma unroll
                for (int j = 0; j < 4; ++j) { o0[j] = siluf_(acc[ai][0][m][0][j]) * acc[ai][1][m][0][j] * 8.0f; o1[j] = siluf_(acc[ai][0][m][1][j]) * acc[ai][1][m][1][j] * 8.0f; }
                u32x2 w; w.x = pk4_fp8(o0[0], o0[1], o0[2], o0[3]); w.y = pk4_fp8(o1[0], o1[1], o1[2], o1[3]);
                *(u32x2*)rowp = w; }
    }
};

template <class Epi, class Sched, bool ALIGN_EPI = true, bool SP2 = true, bool FP8 = false>
__device__ __forceinline__ void gemm_phase(PG8_LAS unsigned char* lds, const Shape g, const Sched& S, const Epi& E) {
    const int lane = lane_id(), wid = __builtin_amdgcn_readfirstlane((int)(threadIdx.x >> 6)), tid = wid * 64 + lane, wr = wid >> 2, wc = wid & 3, fr = lane & 15, fq = lane >> 4;
    const int nt = g.nt;
    unsigned voffA[2], voffB[2];
#pragma unroll
    for (int i = 0; i < 2; ++i) { int R, C; stage_rc(tid * 16 + i * 8192, R, C); const int Rb = Epi::PERM ? ((R & ~31) + perm32(R & 31)) : R;
        voffA[i] = (unsigned)(R * g.ldaB + C * 2); voffB[i] = (unsigned)(Rb * g.ldbB + C * 2); }
    const size_t kstep = (size_t)(BK * 2);
    const size_t hstepA = (size_t)HALF * g.ldaB, hstepB = (size_t)HALF * g.ldbB;
    const unsigned ldsw = (unsigned)wid * 1024u;
    const int aoff = lds_byte(wr * 64 + fr, fq * 8), boff = lds_byte(wc * 32 + fr, fq * 8);
#define PG8_SA(b, h) (((b) * 2 + (h)) * HTB)
#define PG8_SB(b, h) ((4 + (b) * 2 + (h)) * HTB)
#define PG8_STAGE(bufoff, gbase, voff) do { _Pragma("unroll") for (int _i = 0; _i < 2; ++_i) \
        __builtin_amdgcn_global_load_lds((const unsigned*)((const char*)(gbase) + (voff)[_i]), (PG8_LAS unsigned*)(lds + (bufoff) + ldsw + _i * 8192), 16, 0, 0); } while (0)
#define PG8_LDA(dst, b, h) do { _Pragma("unroll") for (int m = 0; m < 4; ++m) _Pragma("unroll") for (int k = 0; k < 2; ++k) dst[m][k] = *(const PG8_LAS bf16x8*)(lds + PG8_SA(b, h) + aoff + m * 2048 + k * 1024); } while (0)
#define PG8_LDB(dst, b, h) do { _Pragma("unroll") for (int n = 0; n < 2; ++n) _Pragma("unroll") for (int k = 0; k < 2; ++k) dst[n][k] = *(const PG8_LAS bf16x8*)(lds + PG8_SB(b, h) + boff + n * 2048 + k * 1024); } while (0)
#define PG8_MMA(ai, bj, At, Bt) do { __builtin_amdgcn_s_setprio(1); _Pragma("unroll") for (int m = 0; m < 4; ++m) _Pragma("unroll") for (int n = 0; n < 2; ++n) { \
        if constexpr (FP8) { const i32x4 b0_ = __builtin_bit_cast(i32x4, Bt[n][0]), b1_ = __builtin_bit_cast(i32x4, Bt[n][1]), a0_ = __builtin_bit_cast(i32x4, At[m][0]), a1_ = __builtin_bit_cast(i32x4, At[m][1]); \
            const i32x8 B8_ = __builtin_shufflevector(b0_, b1_, 0, 1, 2, 3, 4, 5, 6, 7), A8_ = __builtin_shufflevector(a0_, a1_, 0, 1, 2, 3, 4, 5, 6, 7); \
            asm volatile("v_mfma_scale_f32_16x16x128_f8f6f4 %0, %1, %2, %0, %3, %3 op_sel:[0,1,0] op_sel_hi:[0,0,0]" : "+v"(acc[ai][bj][m][n]) : "v"(B8_), "v"(A8_), "v"(g.sc)); } \
        else { _Pragma("unroll") for (int k = 0; k < 2; ++k) acc[ai][bj][m][n] = __builtin_amdgcn_mfma_f32_16x16x32_bf16(Bt[n][k], At[m][k], acc[ai][bj][m][n], 0, 0, 0); } } \
        __builtin_amdgcn_s_setprio(0); } while (0)
#define PG8_WAIT_V(n) asm volatile("s_waitcnt vmcnt(" #n ")" ::: "memory")
#define PG8_WAIT_L(n) asm volatile("s_waitcnt lgkmcnt(" #n ")" ::: "memory")
#define PG8_BAR __builtin_amdgcn_s_barrier()
#define PG8_SCHED __builtin_amdgcn_sched_barrier(0)
    Unit cur, nxt; int ui = 0;
    if (!S.next(0, cur)) return;
    f32x4 acc[2][2][4][2];
#pragma unroll
    for (int a = 0; a < 2; ++a)
#pragma unroll
        for (int b = 0; b < 2; ++b)
#pragma unroll
            for (int m = 0; m < 4; ++m)
#pragma unroll
                for (int n = 0; n < 2; ++n) acc[a][b][m][n] = (f32x4){0.f, 0.f, 0.f, 0.f};
    bf16x8 At[4][2], B0[2][2], B1[2][2];
    const char* cA = cur.A; const char* cB = cur.B;
    S.a_ready(cur);
    if constexpr (SP2) {
        PG8_STAGE(PG8_SB(0, 0), cB, voffB); PG8_STAGE(PG8_SB(0, 1), cB + hstepB, voffB); PG8_STAGE(PG8_SA(0, 0), cA, voffA); PG8_STAGE(PG8_SA(0, 1), cA + hstepA, voffA);
        if (wr == 1) PG8_BAR;
        PG8_WAIT_V(2); PG8_BAR;
        PG8_STAGE(PG8_SB(1, 0), cB + kstep, voffB); PG8_STAGE(PG8_SA(1, 0), cA + kstep, voffA); PG8_STAGE(PG8_SB(1, 1), cB + hstepB + kstep, voffB);
        PG8_WAIT_V(6); PG8_BAR;
    } else {
        PG8_STAGE(PG8_SB(0, 0), cB, voffB); PG8_STAGE(PG8_SA(0, 0), cA, voffA); PG8_STAGE(PG8_SB(0, 1), cB + hstepB, voffB); PG8_STAGE(PG8_SA(0, 1), cA + hstepA, voffA);
        if (wr == 1) PG8_BAR;
        PG8_WAIT_V(4); PG8_BAR;
        PG8_STAGE(PG8_SB(1, 0), cB + kstep, voffB); PG8_STAGE(PG8_SA(1, 0), cA + kstep, voffA); PG8_STAGE(PG8_SB(1, 1), cB + hstepB + kstep, voffB);
        PG8_WAIT_V(6); PG8_BAR;
    }
    for (;;) {
        const bool has_next = S.next(ui + 1, nxt);
        const char* nA = has_next ? nxt.A : cA; const char* nB = has_next ? nxt.B : cB;
        for (int t = 0; t < nt; t += 2) {
            const bool last = (t == nt - 2);
            const char* a1 = cA + (size_t)(t + 1) * kstep;
            const char* a2 = last ? nA : cA + (size_t)(t + 2) * kstep; const char* b2 = last ? nB : cB + (size_t)(t + 2) * kstep;
            const char* a3 = a2 + kstep; const char* b3 = b2 + kstep;
            if (last && has_next) S.a_ready(nxt);
            if constexpr (SP2) {
            PG8_LDB(B0, 0, 0); PG8_LDB(B1, 0, 1); PG8_SCHED; PG8_LDA(At, 0, 0); PG8_STAGE(PG8_SA(1, 1), a1 + hstepA, voffA);
            PG8_WAIT_V(8); PG8_WAIT_L(0); PG8_BAR; PG8_MMA(0, 0, At, B0); PG8_MMA(0, 1, At, B1); PG8_BAR; PG8_SCHED;
            PG8_LDA(At, 0, 1); PG8_STAGE(PG8_SB(0, 0), b2, voffB); PG8_STAGE(PG8_SB(0, 1), b2 + hstepB, voffB); PG8_STAGE(PG8_SA(0, 0), a2, voffA);
            PG8_WAIT_V(8); PG8_WAIT_L(0); PG8_BAR; PG8_MMA(1, 0, At, B0); PG8_MMA(1, 1, At, B1); PG8_BAR; PG8_SCHED;
            PG8_LDB(B0, 1, 0); PG8_LDB(B1, 1, 1); PG8_SCHED; PG8_LDA(At, 1, 0); PG8_STAGE(PG8_SA(0, 1), a2 + hstepA, voffA);
            PG8_WAIT_V(8); PG8_WAIT_L(0); PG8_BAR; PG8_MMA(0, 0, At, B0); PG8_MMA(0, 1, At, B1); PG8_BAR; PG8_SCHED;
            PG8_LDA(At, 1, 1); PG8_STAGE(PG8_SB(1, 0), b3, voffB); PG8_STAGE(PG8_SB(1, 1), b3 + hstepB, voffB); PG8_STAGE(PG8_SA(1, 0), a3, voffA);
            PG8_WAIT_V(8); PG8_WAIT_L(0); PG8_BAR; PG8_MMA(1, 0, At, B0); PG8_MMA(1, 1, At, B1); PG8_BAR; PG8_SCHED;
            } else {
            PG8_LDB(B0, 0, 0); PG8_SCHED; PG8_LDA(At, 0, 0); PG8_STAGE(PG8_SA(1, 1), a1 + hstepA, voffA);
            PG8_WAIT_L(8); PG8_BAR; PG8_WAIT_L(0); PG8_MMA(0, 0, At, B0); PG8_BAR; PG8_SCHED;
            PG8_LDB(B1, 0, 1); PG8_STAGE(PG8_SB(0, 0), b2, voffB);
            PG8_BAR; PG8_WAIT_L(0); PG8_MMA(0, 1, At, B1); PG8_BAR;
            PG8_LDA(At, 0, 1); PG8_STAGE(PG8_SA(0, 0), a2, voffA);
            PG8_BAR; PG8_WAIT_L(0); PG8_MMA(1, 0, At, B0); PG8_BAR; PG8_SCHED;
            PG8_STAGE(PG8_SB(0, 1), b2 + hstepB, voffB);
            PG8_WAIT_V(6); PG8_BAR; PG8_MMA(1, 1, At, B1); PG8_BAR;
            PG8_LDB(B0, 1, 0); PG8_SCHED; PG8_LDA(At, 1, 0); PG8_STAGE(PG8_SA(0, 1), a2 + hstepA, voffA);
            PG8_WAIT_L(8); PG8_BAR; PG8_WAIT_L(0); PG8_MMA(0, 0, At, B0); PG8_BAR; PG8_SCHED;
            PG8_LDB(B1, 1, 1); PG8_STAGE(PG8_SB(1, 0), b3, voffB);
            PG8_BAR; PG8_WAIT_L(0); PG8_MMA(0, 1, At, B1); PG8_BAR;
            PG8_LDA(At, 1, 1); PG8_STAGE(PG8_SA(1, 0), a3, voffA);
            PG8_BAR; PG8_WAIT_L(0); PG8_MMA(1, 0, At, B0); PG8_BAR; PG8_SCHED;
            PG8_STAGE(PG8_SB(1, 1), b3 + hstepB, voffB);
            PG8_WAIT_V(6); PG8_BAR; PG8_MMA(1, 1, At, B1); PG8_BAR;
            }
        }
        if constexpr (ALIGN_EPI) { if (wr == 0) PG8_BAR; }
        if constexpr (FP8) asm volatile("s_nop 15\n\ts_nop 15\n\ts_nop 15" ::: "memory");
        if constexpr (!Epi::AFTER_DRAIN) { E(acc, cur, wr, wc); S.done(cur); }
        if (!has_next) break;
#pragma unroll
        for (int a = 0; a < 2; ++a)
#pragma unroll
            for (int b = 0; b < 2; ++b)
#pragma unroll
                for (int m = 0; m < 4; ++m)
#pragma unroll
                    for (int n = 0; n < 2; ++n) acc[a][b][m][n] = (f32x4){0.f, 0.f, 0.f, 0.f};
        cur = nxt; cA = nA; cB = nB; ++ui;
        if constexpr (ALIGN_EPI) { if (wr == 1) PG8_BAR; }
    }
    PG8_WAIT_V(0);
    if constexpr (!ALIGN_EPI) { if (wr == 0) PG8_BAR; }
    PG8_BAR;
    if constexpr (Epi::AFTER_DRAIN) { E.fused(acc, cur, wr, wc, fr, fq, lds, wid, lane); S.done(cur); }
#undef PG8_SA
#undef PG8_SB
#undef PG8_STAGE
#undef PG8_LDA
#undef PG8_LDB
#undef PG8_MMA
#undef PG8_WAIT_V
#undef PG8_WAIT_L
#undef PG8_BAR
#undef PG8_SCHED
}

}

#ifndef MOE_FP8
#define MOE_FP8 1
#endif
#ifndef FFN_FP8
#define FFN_FP8 0
#endif
constexpr size_t MiB = 1u << 20;
constexpr size_t WS_CTL = 0, CTL_ZERO_BYTES = 1 * MiB;
constexpr size_t WS_MOD = 1 * MiB;
constexpr size_t WS_TOK = 2 * MiB;
constexpr size_t WS_SB  = 3 * MiB;
constexpr size_t WS_POS = 6 * MiB;
constexpr size_t WS_XR  = 22 * MiB;
constexpr size_t WS_W   = 86 * MiB;
constexpr size_t W_WR = WS_W, W_WK = W_WR + 8 * MiB, W_WV = W_WK + 8 * MiB, W_WO = W_WV + 8 * MiB;
constexpr size_t W_WLD = W_WO + 8 * MiB, W_ALD = W_WLD + 1 * MiB, W_G1 = W_ALD + 1 * MiB;
constexpr size_t W_WLU = W_G1 + 1 * MiB, W_ALU = W_WLU + 2 * MiB, W_G2 = W_ALU + 2 * MiB;
constexpr size_t W_PW = W_G2 + 1 * MiB;
constexpr size_t W_F13 = W_PW + 2 * MiB;
constexpr size_t W_F2 = W_F13 + 44 * MiB;
constexpr size_t W_M13 = W_F2 + 22 * MiB;
constexpr size_t W_M2 = W_M13 + 448 * MiB;
constexpr size_t WS_A = W_M2 + 224 * MiB;
constexpr size_t A_A6 = WS_A, A6_STRIDE = 36 * MiB;
constexpr size_t A_R = WS_A + 216 * MiB, A_KX = WS_A + 248 * MiB, A_V = WS_A + 284 * MiB;
constexpr size_t A_LW = WS_A + 320 * MiB, A_LA = WS_A + 325 * MiB, A_G1O = WS_A + 330 * MiB;
constexpr size_t A_EW = WS_A + 336 * MiB, A_AA = WS_A + 408 * MiB;
constexpr size_t A_GATE = WS_A + 480 * MiB, A_YD = WS_A + 512 * MiB;
constexpr size_t A_AO = WS_A + 580 * MiB, A_YO = WS_A + 612 * MiB;
constexpr size_t A_H2 = WS_A, A_U = WS_A + 32 * MiB, A_YF = WS_A + 120 * MiB, A_HP = WS_A + 152 * MiB, A_PP = WS_A + 184 * MiB, A_YP = WS_A + 216 * MiB, A_H2B = WS_A + 248 * MiB;
constexpr size_t A_HG = WS_A + 280 * MiB, A_UG = WS_A + 352 * MiB, A_Y2 = WS_A + 604 * MiB;
constexpr size_t WS_PART = WS_A + 676 * MiB;
constexpr int MOE_KS = 7, MOE_RT = 64;
constexpr size_t WS_END = WS_PART + 112 * MiB;
static_assert(A_YO + 32 * MiB <= WS_PART && A_Y2 + (size_t)MROWS_PAD * D * 2 <= WS_END && A_UG + (size_t)MROWS_PAD * DFE * 2 <= A_Y2 && A_HG + (size_t)MROWS_PAD * D * 2 <= A_UG, "ws map");
static_assert(W_M13 + (size_t)NE * 2 * DFE * D * 2 == W_M2 && W_M2 + (size_t)NE * D * DFE * 2 == WS_A && W_F13 + (size_t)2 * DFF * D * 2 == W_F2, "weight map");
constexpr int CW_BAR = 4096;
constexpr int CW_GCNT = 16384;

constexpr int LDS_BYTES = 147456;
constexpr int MISC_OFF = 131072 + 320;

#define XB_TMO      128
#define XB_XCNT(j)  (256  + 64 * (j))
#define XB_XSUB(j)  (1280 + 64 * (j))
#define XB_XGEN(j)  (2304 + 64 * (j))
#define XB_TOP      3328
#define XB_TOPGEN   3392
#define XCD_BAR_WORDS 3456
#define XB_SPIN_CAP (1u << 18)
__device__ __forceinline__ unsigned xb_ld(unsigned* p)              { return __hip_atomic_load(p, __ATOMIC_RELAXED, __HIP_MEMORY_SCOPE_AGENT); }
__device__ __forceinline__ unsigned xb_add(unsigned* p, unsigned v) { return __hip_atomic_fetch_add(p, v, __ATOMIC_RELAXED, __HIP_MEMORY_SCOPE_AGENT); }
__device__ __forceinline__ unsigned xb_xcc_id() { return (unsigned)__builtin_amdgcn_s_getreg((3 << 11) | 20) & 0xFu; }
#define XB_SPIN(cond, bar) do { unsigned _sp = 0; while (cond) { __builtin_amdgcn_s_sleep(1); \
    if ((++_sp & 255u) == 0u) { if (xb_ld(&(bar)[XB_TMO])) break; if (_sp > XB_SPIN_CAP) { atomicAdd(&(bar)[XB_TMO], 1u); break; } } } } while (0)
struct XcdBarrier { unsigned* bar; unsigned x; volatile LAS unsigned* st; };
__device__ __forceinline__ XcdBarrier xcd_barrier_post(unsigned* bar, volatile LAS unsigned* st) {
    XcdBarrier b; b.bar = bar; b.x = xb_xcc_id(); b.st = st;
    if (threadIdx.x == 0) (void)xb_add(&bar[XB_XCNT(b.x)], 1u);
    return b;
}
__device__ __forceinline__ void xcd_barrier_complete(unsigned* bar, unsigned x, unsigned& nloc, unsigned& nx) {
    const unsigned G = gridDim.x * gridDim.y * gridDim.z;
    unsigned sum, cnt, mine, sp = 0u;
    for (;;) {
        sum = 0u; cnt = 0u; mine = 0u;
#pragma unroll
        for (unsigned j = 0; j < 16; ++j) { const unsigned c = xb_ld(&bar[XB_XCNT(j)]); sum += c; cnt += (c > 0u) ? 1u : 0u; mine = (j == x) ? c : mine; }
        if (sum == G) break;
        __builtin_amdgcn_s_sleep(1);
        if ((++sp & 255u) == 0u) { if (xb_ld(&bar[XB_TMO])) break; if (sp > XB_SPIN_CAP) { atomicAdd(&bar[XB_TMO], 1u); break; } }
    }
    nloc = mine > 0u ? mine : 1u; nx = cnt > 0u ? cnt : 1u;
}
__device__ __forceinline__ void xcd_barrier(const XcdBarrier& b) {
    asm volatile("s_waitcnt vmcnt(0)" ::: "memory");
    __syncthreads();
    if (threadIdx.x == 0) {
        unsigned* bar = b.bar;
        __builtin_amdgcn_s_waitcnt(0);
        unsigned nloc = b.st[0], nx = b.st[1];
        if (nloc == 0u) { xcd_barrier_complete(bar, b.x, nloc, nx); b.st[0] = nloc; b.st[1] = nx; }
        const unsigned old = xb_add(&bar[XB_XSUB(b.x)], 1u);
        const unsigned gen = old / nloc;
        if (old + 1u == (gen + 1u) * nloc) {
            __builtin_amdgcn_fence(__ATOMIC_RELEASE, "agent");
            asm volatile("s_waitcnt vmcnt(0)" ::: "memory");
            const unsigned og = xb_add(&bar[XB_TOP], 1u);
            const unsigned tg = og / nx;
            if (og + 1u == (tg + 1u) * nx) xb_add(&bar[XB_TOPGEN], 1u);
            else XB_SPIN(xb_ld(&bar[XB_TOPGEN]) == tg, bar);
            __builtin_amdgcn_fence(__ATOMIC_ACQUIRE, "agent");
            xb_add(&bar[XB_XGEN(b.x)], 1u);
            asm volatile("s_waitcnt vmcnt(0)" ::: "memory");
        } else {
            XB_SPIN(xb_ld(&bar[XB_XGEN(b.x)]) == gen, bar);
            __builtin_amdgcn_fence(__ATOMIC_ACQUIRE, "agent");
            asm volatile("s_waitcnt vmcnt(0)" ::: "memory");
        }
    }
    __syncthreads();
}

struct Args { const float* in[35]; float* out; unsigned char* ws; int ph_lo, ph_hi, li, pad; };
static_assert(sizeof(Args) == 35 * 8 + 8 + 8 + 16, "Args has no padding");
enum In { I_X = 0, I_C, I_CTX, I_CCTX, I_WMOD, I_BMOD, I_LNW, I_LNB, I_MU, I_WR, I_WK, I_WV, I_WO, I_DW0, I_DW1, I_DW2, I_IA0, I_IA1, I_IA2, I_G1, I_G2, I_KK, I_KA, I_RK, I_GNW, I_GNB,
          I_POOLW, I_POOLS, I_FW1, I_FW3, I_FW2, I_ROUTER, I_MW1, I_MW3, I_MW2 };
struct Frame {
    LAS unsigned char* lds; int wave, vcu, G, gw, NGW;
    unsigned char* ws; unsigned* ctl;
};
#define LDS_WAIT() asm volatile("s_waitcnt lgkmcnt(0)" ::: "memory")
__device__ __forceinline__ void unpack8(const u32x4 w, float (&f)[8]) { f[0] = bflo(w.x); f[1] = bfhi(w.x); f[2] = bflo(w.y); f[3] = bfhi(w.y); f[4] = bflo(w.z); f[5] = bfhi(w.z); f[6] = bflo(w.w); f[7] = bfhi(w.w); }

__device__ __forceinline__ void p0_mod(const Frame& F, const Args& a) {
    const int lane = lane_id(), tid = F.wave * 64 + lane; (void)tid;
    LAS float* sc = (LAS float*)F.lds;
    LAS float* red = (LAS float*)(F.lds + 40960);
    const float* c = a.in[I_C]; const float* cc = a.in[I_CCTX];
    for (int i = tid; i < 5 * D; i += 512) { const int j = i / D, k = i % D; const float v = j < 4 ? c[j * D + k] : cc[k]; sc[i] = siluf_(v); }
    __syncthreads();
    float* MOD = (float*)(F.ws + WS_MOD);
    const int x = lane & 15, q = lane >> 4;
    for (int u = blockIdx.x; u < 2 * (MOD_N / 64); u += F.G) {
        const int l = u / (MOD_N / 64), cb = u % (MOD_N / 64);
        const float* W = a.in[I_WMOD] + (size_t)l * D * MOD_N + cb * 64 + 4 * x;
        float acc[5][4];
#pragma unroll
        for (int j = 0; j < 5; ++j)
#pragma unroll
            for (int e = 0; e < 4; ++e) acc[j][e] = 0.f;
#pragma unroll 8
        for (int i = 0; i < 64; ++i) {
            const int k = F.wave * 256 + 4 * i + q;
            const f32x4 w = *(const f32x4*)(W + (size_t)k * MOD_N);
#pragma unroll
            for (int j = 0; j < 5; ++j) { const float s = sc[j * D + k];
#pragma unroll
                for (int e = 0; e < 4; ++e) acc[j][e] += s * w[e]; }
        }
#pragma unroll
        for (int j = 0; j < 5; ++j)
#pragma unroll
            for (int e = 0; e < 4; ++e) { float v = acc[j][e]; v += __shfl_xor(v, 16); v += __shfl_xor(v, 32); acc[j][e] = v; }
        __syncthreads();
        if (q == 0) {
#pragma unroll
            for (int j = 0; j < 5; ++j)
#pragma unroll
                for (int e = 0; e < 4; ++e) red[(F.wave * 5 + j) * 64 + 4 * x + e] = acc[j][e];
        }
        __syncthreads();
        if (tid < 320) { const int j = tid / 64, col = tid % 64; float s = 0.f;
#pragma unroll
            for (int w = 0; w < 8; ++w) s += red[(w * 5 + j) * 64 + col];
            MOD[(size_t)(l * 5 + j) * MOD_N + cb * 64 + col] = s + a.in[I_BMOD][l * MOD_N + cb * 64 + col]; }
    }
    __syncthreads();
}
__device__ __forceinline__ void p0_pos(const Frame& F) {
    const int lane = lane_id(), tid = F.wave * 64 + lane; (void)tid;
    float* POS = (float*)(F.ws + WS_POS);
    for (int t = F.gw; t < T; t += F.NGW) {
        const float frow = (float)(t >> 6), fcol = (float)(t & 63);
#pragma unroll
        for (int j = 0; j < 8; ++j) { const int c0 = 4 * lane + 256 * j; f32x4 o;
#pragma unroll
            for (int e = 0; e < 4; ++e) { const int c = c0 + e, qi = c >> 9, i = c & 511;
                const float omega = fexp(-(float)i * (9.21034037197618f / 512.0f));
                float rev = ((qi < 2) ? frow : fcol) * omega * 0.15915494309189535f;
                rev -= floorf(rev);
                o[e] = (qi & 1) ? __builtin_amdgcn_cosf(rev) : __builtin_amdgcn_sinf(rev); }
            *(f32x4*)(POS + (size_t)t * D + c0) = o; }
    }
}
constexpr int TN_F13 = FFN_FP8 ? 1408 : 2816, TN_F2 = FFN_FP8 ? 1408 : 2816, TN_M = MOE_FP8 ? 1792 : 3584;
constexpr int TI_RWKV = 4096, TI_F1 = TI_RWKV + TN_F13, TI_F3 = TI_F1 + TN_F13, TI_F2 = TI_F3 + TN_F2, TI_POOL = TI_F2 + 256, TI_M1 = TI_POOL + 8 * TN_M, TI_M3 = TI_M1 + 8 * TN_M, TI_M2 = TI_M3 + 8 * TN_M;
struct TrItem { const float* src; unsigned char* dst; int src_ld, dst_ld  , k0  , kbyte  , n0, drow0, f8; float sc; };
__device__ __forceinline__ TrItem tr_decode(const Frame& F, const Args& a, int it) {
    TrItem t; t.f8 = 0; t.sc = 1.0f; int kb, nb;
    if (it < TI_RWKV) { const int m = it >> 10, r = it & 1023; kb = r >> 5; nb = r & 31;
        t.src = a.in[I_WR + m]; t.src_ld = D; t.dst = F.ws + W_WR + (size_t)m * 8 * MiB; t.dst_ld = 2 * D; t.drow0 = 64 * nb; }
    else if (it < TI_F3) { const int w3 = it >= TI_F1, r = it - (w3 ? TI_F1 : TI_RWKV); kb = r / 88; nb = r % 88; const int n0 = 64 * nb;
        t.src = a.in[w3 ? I_FW3 : I_FW1]; t.src_ld = DFF; t.dst = F.ws + W_F13; t.dst_ld = FFN_FP8 ? D : 2 * D; t.drow0 = (n0 >> 7) * 256 + (n0 & 127) + 128 * w3; t.f8 = FFN_FP8; t.sc = FFN_FP8 ? 64.0f : 1.0f; }
    else if (it < TI_F2) { const int r = it - TI_F3; kb = r >> 5; nb = r & 31;
        t.src = a.in[I_FW2]; t.src_ld = D; t.dst = F.ws + W_F2; t.dst_ld = FFN_FP8 ? DFF : 2 * DFF; t.drow0 = 64 * nb; t.f8 = FFN_FP8; t.sc = FFN_FP8 ? 256.0f : 1.0f; }
    else if (it < TI_POOL) { const int r = it - TI_F2, g = r >> 6; kb = (r >> 3) & 7; nb = r & 7;
        t.src = a.in[I_POOLW] + (size_t)g * 512 * 512; t.src_ld = 512; t.dst = F.ws + W_PW + (size_t)g * 512 * 512 * 2; t.dst_ld = 2 * 512; t.drow0 = 64 * nb; }
    else if (it < TI_M3) { const int w3 = it >= TI_M1, r = it - (w3 ? TI_M1 : TI_POOL), e = r / TN_M, rr = r % TN_M; kb = rr / 112; nb = rr % 112; const int n0 = 64 * nb;
        t.src = a.in[w3 ? I_MW3 : I_MW1] + (size_t)e * D * DFE; t.src_ld = DFE; t.dst_ld = MOE_FP8 ? D : 2 * D; t.dst = F.ws + W_M13 + (size_t)e * 2 * DFE * t.dst_ld;
        t.drow0 = (n0 >> 7) * 256 + (n0 & 127) + 128 * w3; t.f8 = MOE_FP8; t.sc = MOE_FP8 ? 64.0f : 1.0f; }
    else { const int r = it - TI_M3, e = r / TN_M, rr = r % TN_M; kb = rr >> 5; nb = rr & 31;
        t.src = a.in[I_MW2] + (size_t)e * DFE * D; t.src_ld = D; t.dst_ld = MOE_FP8 ? DFE : 2 * DFE; t.dst = F.ws + W_M2 + (size_t)e * D * t.dst_ld; t.drow0 = 64 * nb; t.f8 = MOE_FP8; t.sc = MOE_FP8 ? 256.0f : 1.0f; }
    t.n0 = 64 * nb; t.kbyte = 128 * kb; t.k0 = t.f8 ? 128 * kb : 64 * kb; return t;
}
__device__ __forceinline__ void tr_load(const TrItem& t, int h, f32x4 (&r)[4][4], int lane) {
    const int x = lane & 15, q = lane >> 4; const float* p = t.src + (size_t)(t.k0 + 64 * h + 4 * q) * t.src_ld + t.n0 + 4 * x;
#pragma unroll
    for (int i = 0; i < 4; ++i)
#pragma unroll
        for (int s = 0; s < 4; ++s) r[i][s] = __builtin_nontemporal_load((const f32x4*)(p + (size_t)(16 * i + s) * t.src_ld));
}
__device__ __forceinline__ void tr_store(const TrItem& t, int h, const f32x4 (&r)[4][4], LAS unsigned* scr, int lane) {
    const int x = lane & 15, q = lane >> 4;
    if (t.f8) {
#pragma unroll
        for (int i = 0; i < 4; ++i)
#pragma unroll
            for (int jj = 0; jj < 4; ++jj) scr[(4 * x + jj) * 33 + 16 * h + 4 * i + q] = pk4_fp8(r[i][0][jj] * t.sc, r[i][1][jj] * t.sc, r[i][2][jj] * t.sc, r[i][3][jj] * t.sc);
        if (h == 0) return;
    } else {
#pragma unroll
        for (int i = 0; i < 4; ++i)
#pragma unroll
            for (int jj = 0; jj < 4; ++jj) { scr[(4 * x + jj) * 33 + 8 * i + 2 * q] = pk2(r[i][0][jj], r[i][1][jj]); scr[(4 * x + jj) * 33 + 8 * i + 2 * q + 1] = pk2(r[i][2][jj], r[i][3][jj]); }
    }
    LDS_WAIT();
    const int c = lane & 7;
#pragma unroll
    for (int rr = 0; rr < 8; ++rr) { const int n = (lane >> 3) + 8 * rr; const LAS unsigned* s = scr + n * 33 + 4 * c;
        u32x4 o; o.x = s[0]; o.y = s[1]; o.z = s[2]; o.w = s[3];
        *(u32x4*)(t.dst + (size_t)(t.drow0 + n) * t.dst_ld + t.kbyte + 16 * c) = o; }
    LDS_WAIT();
}
__device__ __forceinline__ void p0_transpose_range(const Frame& F, const Args& a, int lo, int hi, int gw, int ngw, LAS unsigned* scr) {
    const int lane = lane_id();
    int it = lo + gw; if (it >= hi) return;
    f32x4 ra[4][4], rb[4][4];
    TrItem ta = tr_decode(F, a, it), tb = ta; int ha = 0, hb = 0; tr_load(ta, 0, ra, lane);
    for (;;) {
        bool hasb; if (ta.f8 && ha == 0) { tb = ta; hb = 1; hasb = true; } else { it += ngw; hasb = it < hi; if (hasb) { tb = tr_decode(F, a, it); hb = 0; } }
        if (hasb) tr_load(tb, hb, rb, lane);
        tr_store(ta, ha, ra, scr, lane);
        if (!hasb) break;
        bool hasa; if (tb.f8 && hb == 0) { ta = tb; ha = 1; hasa = true; } else { it += ngw; hasa = it < hi; if (hasa) { ta = tr_decode(F, a, it); ha = 0; } }
        if (hasa) tr_load(ta, ha, ra, lane);
        tr_store(tb, hb, rb, scr, lane);
        if (!hasa) break;
    }
}
#if defined(PROBE_READ)
__device__ __forceinline__ void probe_read(const Frame& F, const Args& a) {
    const int lane = lane_id(); float acc = 0.f;
    for (int m = 0; m < 3; ++m) { const float* base = a.in[I_MW1 + m]; const size_t n16 = (size_t)NE * D * DFE / 4;
        if (PROBE_READ == 1) { for (size_t i = (size_t)F.gw * 64 + lane; i < n16; i += (size_t)F.NGW * 64 * 16) {
                f32x4 r[16];
#pragma unroll
                for (int u = 0; u < 16; ++u) { const size_t j = i + (size_t)u * F.NGW * 64; r[u] = j < n16 ? __builtin_nontemporal_load((const f32x4*)base + j) : (f32x4){0.f, 0.f, 0.f, 0.f}; }
#pragma unroll
                for (int u = 0; u < 16; ++u) acc += r[u][0] + r[u][3]; } }
        else { const int ld = (m == 2) ? D : DFE; const int nblk = ld / 64; const size_t rows = (size_t)NE * D * DFE / ld; const size_t items = rows / 64 * nblk; const int x = lane & 15, q = lane >> 4;
            for (size_t it = F.gw; it < items; it += F.NGW) { const size_t kb = it / nblk, nb = it % nblk; const float* p = base + (kb * 64 + 4 * q) * ld + nb * 64 + 4 * x;
                f32x4 r[16];
#pragma unroll
                for (int u = 0; u < 16; ++u) r[u] = __builtin_nontemporal_load((const f32x4*)(p + (size_t)((u >> 2) * 16 + (u & 3)) * ld));
#pragma unroll
                for (int u = 0; u < 16; ++u) acc += r[u][0] + r[u][3]; } }
    }
    if (acc == 1.2345e-30f) ((float*)(F.ws + WS_PART))[F.gw * 64 + lane] = acc;
}
#endif
__device__ __forceinline__ void p0_small(const Frame& F, const Args& a) {
    const int lane = lane_id(), tid = F.wave * 64 + lane; (void)tid;
    bf16_t* WLD = (bf16_t*)(F.ws + W_WLD); bf16_t* ALD = (bf16_t*)(F.ws + W_ALD); bf16_t* G1T = (bf16_t*)(F.ws + W_G1);
    bf16_t* WLU = (bf16_t*)(F.ws + W_WLU); bf16_t* ALU = (bf16_t*)(F.ws + W_ALU); bf16_t* G2T = (bf16_t*)(F.ws + W_G2);
    const int gt = F.gw * 64 + lane, NT_ = F.NGW * 64;
    for (int i = gt; i < 256 * D; i += NT_) { const int n = i >> 11, k = i & 2047;
        float w = 0.f, v = 0.f;
        if (n < 192) { const int d = n >= 96, nn = n - 96 * d; w = a.in[I_DW1][((size_t)d * D + k) * 96 + nn]; v = a.in[I_IA1][((size_t)d * D + k) * 96 + nn]; }
        WLD[i] = (bf16_t)f2bf(w); ALD[i] = (bf16_t)f2bf(v); G1T[i] = (bf16_t)f2bf(a.in[I_G1][(size_t)k * 256 + n]); }
    for (int i = gt; i < 2 * D * 256; i += NT_) { const int n = i >> 8, k = i & 255, d = n >> 11, cidx = n & 2047, kk = k - 96 * d;
        float w = 0.f, v = 0.f;
        if (kk >= 0 && kk < 96) { w = a.in[I_DW2][((size_t)d * 96 + kk) * D + cidx]; v = a.in[I_IA2][((size_t)d * 96 + kk) * D + cidx]; }
        WLU[i] = (bf16_t)f2bf(w); ALU[i] = (bf16_t)f2bf(v); }
    for (int i = gt; i < D * 256; i += NT_) { const int n = i >> 8, k = i & 255; G2T[i] = (bf16_t)f2bf(a.in[I_G2][(size_t)k * D + n]); }
}

__device__ __forceinline__ void p1_mix(const Frame& F, const Args& a) {
    const int lane = lane_id(), tid = F.wave * 64 + lane; (void)tid;
    const float* MOD = (const float*)(F.ws + WS_MOD); const float* POS = (const float*)(F.ws + WS_POS);
    float* XR = (float*)(F.ws + WS_XR);
    for (int blk = F.gw; blk < MT / 8; blk += F.NGW) {
        const int m0 = blk * 8; const bool lat = m0 < ML;
        int t0, Tseq, modrow; const float* xs;
        if (lat) { t0 = m0 % T; Tseq = T; modrow = m0 / T; xs = a.in[I_X] + (size_t)m0 * D; }
        else { const int mm = m0 - ML; t0 = mm % TC; Tseq = TC; modrow = 4; xs = a.in[I_CTX] + (size_t)mm * D; }
        const float* sh = MOD + (size_t)modrow * MOD_N; const float* scp = sh + D;
        const float* ps = POS + (size_t)t0 * D;
        for (int j = 0; j < 8; ++j) {
            const int c = 4 * lane + 256 * j;
            const f32x4 shv = *(const f32x4*)(sh + c); const f32x4 scv = *(const f32x4*)(scp + c) + 1.0f;
            f32x4 mu[6];
#pragma unroll
            for (int n = 0; n < 6; ++n) mu[n] = *(const f32x4*)(a.in[I_MU] + n * D + c);
            f32x4 hm1 = (f32x4){0.f, 0.f, 0.f, 0.f}, h0, x00;
            if (t0 > 0) { f32x4 xv = *(const f32x4*)(xs - D + c); if (lat) xv += *(const f32x4*)(ps - D + c); hm1 = xv * scv + shv; }
            { x00 = *(const f32x4*)(xs + c); if (lat) x00 += *(const f32x4*)(ps + c); h0 = x00 * scv + shv; }
            for (int r = 0; r < 8; ++r) {
                f32x4 hp1 = (f32x4){0.f, 0.f, 0.f, 0.f}, x0n = (f32x4){0.f, 0.f, 0.f, 0.f};
                if (t0 + r + 1 < Tseq) { x0n = *(const f32x4*)(xs + (size_t)(r + 1) * D + c); if (lat) x0n += *(const f32x4*)(ps + (size_t)(r + 1) * D + c); hp1 = x0n * scv + shv; }
                const f32x4 xx = (hm1 + hp1) * 0.5f - h0;
                const size_t o = (size_t)(m0 + r) * D + c;
#pragma unroll
                for (int n = 0; n < 6; ++n) { if (!lat && (n == 0 || n == 5)) continue;
                    const f32x4 v = h0 + xx * mu[n]; u32x2 w; w.x = pk2(v[0], v[1]); w.y = pk2(v[2], v[3]);
                    *(u32x2*)((bf16_t*)(F.ws + A_A6 + (size_t)n * A6_STRIDE) + o) = w; }
                if (lat) *(f32x4*)(XR + o) = x00;
                hm1 = h0; h0 = hp1; x00 = x0n;
            }
        }
    }
}

__device__ __forceinline__ void p4_scan(const Frame& F, const Args& a) {
    const int lane = lane_id(), tid = F.wave * 64 + lane; (void)tid;
    LAS float* OP = (LAS float*)F.lds;
    LAS float* YS = (LAS float*)(F.lds + 49152);
    const bf16_t* KX = (const bf16_t*)(F.ws + A_KX); const bf16_t* VV = (const bf16_t*)(F.ws + A_V); const bf16_t* RR = (const bf16_t*)(F.ws + A_R);
    const bf16_t* EW = (const bf16_t*)(F.ws + A_EW); const bf16_t* AA = (const bf16_t*)(F.ws + A_AA);
    const int tl = tid >> 5, cp = tid & 31, vi = tid >> 3, kg = tid & 7;
    for (int s = blockIdx.x; s < NB * NH * 2; s += F.G) {
        const int b = s >> 6, h = (s >> 1) & 31, d = s & 1;
        const int ch = h * HS + 2 * cp;
        const float kkc0 = a.in[I_KK][ch], kkc1 = a.in[I_KK][ch + 1], kac0 = a.in[I_KA][ch], kac1 = a.in[I_KA][ch + 1], rkc0 = a.in[I_RK][ch], rkc1 = a.in[I_RK][ch + 1];
        bf16_t* YD = (bf16_t*)(F.ws + A_YD + (size_t)d * 32 * MiB); float* SB = (float*)(F.ws + WS_SB) + (size_t)d * ML * NH;
        float S[8];
#pragma unroll
        for (int j = 0; j < 8; ++j) S[j] = 0.f;
        unsigned rk = 0, rv = 0, rr = 0, re = 0, ra = 0;
#define SCAN_ROW0(ci) (((ci) < 16) ? (ML + b * TC + (d ? 15 - (ci) : (ci)) * 16) : (b * T + (d ? 127 - ((ci) - 16) : ((ci) - 16)) * 16))
#define SCAN_LOAD(ci) do { const int row_ = SCAN_ROW0(ci) + tl; const size_t o_ = (size_t)row_ * D + ch, o2_ = (size_t)row_ * (2 * D) + d * D + ch; \
        rk = *(const unsigned*)(KX + o_); rv = *(const unsigned*)(VV + o_); rr = ((ci) >= 16) ? *(const unsigned*)(RR + o_) : 0u; re = *(const unsigned*)(EW + o2_); ra = *(const unsigned*)(AA + o2_); } while (0)
#define SCAN_PREP(ci) do { LAS float* B_ = OP + ((ci) & 1) * 6144 + tl * 64 + 2 * cp; \
        const float k0 = bflo(rk), k1 = bfhi(rk), q0 = k0 * kkc0, q1 = k1 * kkc1; float n2 = q0 * q0 + q1 * q1; \
        n2 += __shfl_xor(n2, 1); n2 += __shfl_xor(n2, 2); n2 += __shfl_xor(n2, 4); n2 += __shfl_xor(n2, 8); n2 += __shfl_xor(n2, 16); \
        const float inv = 1.0f / fmaxf(sqrtf(n2), 1e-12f), kn0 = q0 * inv, kn1 = q1 * inv; \
        const float a0 = bflo(ra), a1 = bfhi(ra), kd0 = k0 * (1.0f + (a0 - 1.0f) * kac0), kd1 = k1 * (1.0f + (a1 - 1.0f) * kac1); \
        const float r0 = bflo(rr), r1 = bfhi(rr); \
        *(LAS f32x2*)(B_ + 0 * 1024) = (f32x2){kn0, kn1}; \
        *(LAS f32x2*)(B_ + 1 * 1024) = (f32x2){fexp(-bflo(re)), fexp(-bfhi(re))}; \
        *(LAS f32x2*)(B_ + 2 * 1024) = (f32x2){kn0 * a0, kn1 * a1}; \
        *(LAS f32x2*)(B_ + 3 * 1024) = (f32x2){kd0, kd1}; \
        *(LAS f32x2*)(B_ + 4 * 1024) = (f32x2){r0, r1}; \
        *(LAS f32x2*)(B_ + 5 * 1024) = (f32x2){bflo(rv), bfhi(rv)}; \
        if ((ci) >= 16) { float sb = r0 * kd0 * rkc0 + r1 * kd1 * rkc1; \
            sb += __shfl_xor(sb, 1); sb += __shfl_xor(sb, 2); sb += __shfl_xor(sb, 4); sb += __shfl_xor(sb, 8); sb += __shfl_xor(sb, 16); \
            if (cp == 0) SB[(size_t)(SCAN_ROW0(ci) + tl) * NH + h] = sb; } } while (0)
        __syncthreads();
        SCAN_LOAD(0); SCAN_PREP(0);
        __syncthreads();
        for (int ci = 0; ci < 144; ++ci) {
            if (ci + 1 < 144) SCAN_LOAD(ci + 1);
            const LAS float* B = OP + (ci & 1) * 6144; LAS float* Y = YS + (ci & 1) * 1024;
#pragma unroll 4
            for (int st = 0; st < 16; ++st) {
                const int tk = d ? 15 - st : st; const LAS float* p = B + tk * 64 + 8 * kg;
                const f32x4 kkA = *(const LAS f32x4*)(p), kkB = *(const LAS f32x4*)(p + 4);
                const f32x4 wA = *(const LAS f32x4*)(p + 1024), wB = *(const LAS f32x4*)(p + 1028);
                const f32x4 bA = *(const LAS f32x4*)(p + 2048), bB = *(const LAS f32x4*)(p + 2052);
                const f32x4 dA = *(const LAS f32x4*)(p + 3072), dB = *(const LAS f32x4*)(p + 3076);
                const f32x4 rA = *(const LAS f32x4*)(p + 4096), rB = *(const LAS f32x4*)(p + 4100);
                const float v = B[5 * 1024 + tk * 64 + vi];
                float sa = (S[0] * kkA[0] + S[1] * kkA[1]) + (S[2] * kkA[2] + S[3] * kkA[3]) + (S[4] * kkB[0] + S[5] * kkB[1]) + (S[6] * kkB[2] + S[7] * kkB[3]);
                sa = sum8(sa);
#pragma unroll
                for (int j = 0; j < 4; ++j) { S[j] = S[j] * wA[j] + (v * dA[j] - sa * bA[j]); S[4 + j] = S[4 + j] * wB[j] + (v * dB[j] - sa * bB[j]); }
                float y = (S[0] * rA[0] + S[1] * rA[1]) + (S[2] * rA[2] + S[3] * rA[3]) + (S[4] * rB[0] + S[5] * rB[1]) + (S[6] * rB[2] + S[7] * rB[3]);
                y = sum8(y);
                if (kg == 0) Y[tk * 64 + vi] = y;
            }
            if (ci + 1 < 144) SCAN_PREP(ci + 1);
            __syncthreads();
            if (ci >= 16) { const f32x2 yv = *(const LAS f32x2*)(Y + tl * 64 + 2 * cp);
                *(unsigned*)(YD + (size_t)(SCAN_ROW0(ci) + tl) * D + ch) = pk2(yv.x, yv.y); }
        }
#undef SCAN_ROW0
#undef SCAN_LOAD
#undef SCAN_PREP
    }
    __syncthreads();
}

constexpr int SL_KA = 0, SL_RM = 2048, SL_BK = 4096, SL_VC = 8192, SL_ARK = 10240, SL_AAK = 11264, SL_TN = 11776, SL_GC = 12288, SL_BYTES = 12544;
constexpr int SC_PAR = 8 * SL_BYTES;
typedef short s16x8 __attribute__((ext_vector_type(8)));
__device__ __forceinline__ s16x8 mk8(unsigned a, unsigned b, unsigned c, unsigned d) { u32x4 v; v.x = a; v.y = b; v.z = c; v.w = d; return __builtin_bit_cast(s16x8, v); }
__device__ __forceinline__ f32x4 mfma16(s16x8 a, s16x8 b, f32x4 c) { return __builtin_amdgcn_mfma_f32_16x16x32_bf16(a, b, c, 0, 0, 0); }
__device__ __forceinline__ s16x8 mk_d(const f32x4 x) { return mk8(pk2(x[0], x[1]), pk2(x[2], x[3]), 0u, 0u); }
__device__ __forceinline__ void p4_scan2(const Frame& F, const Args& a, unsigned char* yd_base, float* sb_base) {
    const int lane = lane_id(), tt = lane & 15, q = lane >> 4;
    const bf16_t* KX = (const bf16_t*)(F.ws + A_KX); const bf16_t* VV = (const bf16_t*)(F.ws + A_V); const bf16_t* RR = (const bf16_t*)(F.ws + A_R);
    const bf16_t* EW = (const bf16_t*)(F.ws + A_EW); const bf16_t* AA = (const bf16_t*)(F.ws + A_AA);
    LAS unsigned char* slot_w = F.lds + F.wave * SL_BYTES;
    LAS float* PAR = (LAS float*)(F.lds + SC_PAR);
    s16x8 SelF[2];
#pragma unroll
    for (int sel = 0; sel < 2; ++sel) { unsigned w[4];
#pragma unroll
        for (int jj = 0; jj < 4; ++jj) { const int j0 = 2 * jj, j1 = 2 * jj + 1; const bool h0 = (q == (tt >> 2)) && (j0 == 4 * sel + (tt & 3)), h1 = (q == (tt >> 2)) && (j1 == 4 * sel + (tt & 3));
            w[jj] = (h0 ? 0x3f80u : 0u) | (h1 ? 0x3f800000u : 0u); }
        SelF[sel] = mk8(w[0], w[1], w[2], w[3]); }
    for (int s = blockIdx.x; s < NB * NH * 2; s += F.G) {
        const int b = s >> 6, h = (s >> 1) & 31, d = s & 1;
        bf16_t* YD = (bf16_t*)(yd_base + (size_t)d * 32 * MiB); float* SB = sb_base + (size_t)d * ML * NH;
        __syncthreads();
        if (F.wave == 0) { PAR[lane] = a.in[I_KK][h * HS + lane]; PAR[64 + lane] = a.in[I_KA][h * HS + lane]; PAR[128 + lane] = a.in[I_RK][h * HS + lane]; }
        __syncthreads();
        f32x4 G[4];
#pragma unroll
        for (int tk = 0; tk < 4; ++tk) G[tk] = (f32x4){0.f, 0.f, 0.f, 0.f};
#define S2_ROW0(ci) (((ci) < 16) ? (ML + b * TC + (d ? 15 - (ci) : (ci)) * 16) : (b * T + (d ? 127 - ((ci) - 16) : ((ci) - 16)) * 16))
        u32x2 rk[4], rv[4], rr[4], re[4], ra[4];
#define S2_LOAD(ci) do { const int row_ = S2_ROW0(ci) + (d ? 15 - tt : tt); const size_t o_ = (size_t)row_ * D + h * HS + 4 * q, o2_ = (size_t)row_ * (2 * D) + d * D + h * HS + 4 * q; \
        _Pragma("unroll") for (int g_ = 0; g_ < 4; ++g_) { rk[g_] = *(const u32x2*)(KX + o_ + 16 * g_); rv[g_] = *(const u32x2*)(VV + o_ + 16 * g_); \
            rr[g_] = ((ci) >= 16) ? *(const u32x2*)(RR + o_ + 16 * g_) : (u32x2){0u, 0u}; re[g_] = *(const u32x2*)(EW + o2_ + 16 * g_); ra[g_] = *(const u32x2*)(AA + o2_ + 16 * g_); } } while (0)
        S2_LOAD(F.wave);
        for (int rnd = 0; rnd < 18; ++rnd) {
            const int ci = rnd * 8 + F.wave; const bool lat = rnd >= 2;
            {
                float kf[4][4], af[4][4], ef[4][4], vf[4][4], rf[4][4];
#pragma unroll
                for (int g = 0; g < 4; ++g) {
                    kf[g][0] = bflo(rk[g].x); kf[g][1] = bfhi(rk[g].x); kf[g][2] = bflo(rk[g].y); kf[g][3] = bfhi(rk[g].y);
                    af[g][0] = bflo(ra[g].x); af[g][1] = bfhi(ra[g].x); af[g][2] = bflo(ra[g].y); af[g][3] = bfhi(ra[g].y);
                    ef[g][0] = bflo(re[g].x); ef[g][1] = bfhi(re[g].x); ef[g][2] = bflo(re[g].y); ef[g][3] = bfhi(re[g].y);
                    vf[g][0] = bflo(rv[g].x); vf[g][1] = bfhi(rv[g].x); vf[g][2] = bflo(rv[g].y); vf[g][3] = bfhi(rv[g].y);
                    rf[g][0] = bflo(rr[g].x); rf[g][1] = bfhi(rr[g].x); rf[g][2] = bflo(rr[g].y); rf[g][3] = bfhi(rr[g].y); }
                unsigned VP[4][2];
#pragma unroll
                for (int g = 0; g < 4; ++g) { VP[g][0] = rv[g].x; VP[g][1] = rv[g].y; }
                if (rnd + 1 < 18) S2_LOAD((rnd + 1) * 8 + F.wave);
                float kkv[4][4]; float n2 = 0.f;
#pragma unroll
                for (int g = 0; g < 4; ++g) { const f32x4 kc = *(const LAS f32x4*)(PAR + 16 * g + 4 * q);
#pragma unroll
                    for (int i = 0; i < 4; ++i) { kkv[g][i] = kf[g][i] * kc[i]; n2 += kkv[g][i] * kkv[g][i]; } }
                n2 += __shfl_xor(n2, 16); n2 += __shfl_xor(n2, 32);
                const float inv = 1.0f / fmaxf(sqrtf(n2), 1e-12f);
                float sb = 0.f;
                unsigned KaP[4][2], BmP[4][2], KmP[4][2], RmP[4][2]; f32x4 gend[4];
#pragma unroll
                for (int g = 0; g < 4; ++g) { const f32x4 kac = *(const LAS f32x4*)(PAR + 64 + 16 * g + 4 * q), rkc = *(const LAS f32x4*)(PAR + 128 + 16 * g + 4 * q);
                    float ka_[4], bm_[4], km_[4], rm_[4];
#pragma unroll
                    for (int i = 0; i < 4; ++i) {
                        float L = ef[g][i];
                        L += dpp_f<0x111>(L); L += dpp_f<0x112>(L); L += dpp_f<0x114>(L); L += dpp_f<0x118>(L);
                        const float gt = fexp(-L), gi = fexp(L), gm1 = fexp(ef[g][i] - L);
                        const float kk = kkv[g][i] * inv, kd = kf[g][i] * (1.0f + (af[g][i] - 1.0f) * kac[i]);
                        ka_[i] = kk * gm1; bm_[i] = kk * af[g][i] * gi; km_[i] = kd * gi; rm_[i] = rf[g][i] * gt;
                        sb += rf[g][i] * kd * rkc[i]; gend[g][i] = gt; }
                    KaP[g][0] = pk2(ka_[0], ka_[1]); KaP[g][1] = pk2(ka_[2], ka_[3]); BmP[g][0] = pk2(bm_[0], bm_[1]); BmP[g][1] = pk2(bm_[2], bm_[3]);
                    KmP[g][0] = pk2(km_[0], km_[1]); KmP[g][1] = pk2(km_[2], km_[3]); RmP[g][0] = pk2(rm_[0], rm_[1]); RmP[g][1] = pk2(rm_[2], rm_[3]);
                }
                if (lat) { sb += __shfl_xor(sb, 16); sb += __shfl_xor(sb, 32); if (q == 0) SB[(size_t)(S2_ROW0(ci) + (d ? 15 - tt : tt)) * NH + h] = sb; }
                s16x8 KaF[2], BmF[2], KmF[2], RmF[2], VF[2];
#pragma unroll
                for (int kb = 0; kb < 2; ++kb) { KaF[kb] = mk8(KaP[2 * kb][0], KaP[2 * kb][1], KaP[2 * kb + 1][0], KaP[2 * kb + 1][1]); BmF[kb] = mk8(BmP[2 * kb][0], BmP[2 * kb][1], BmP[2 * kb + 1][0], BmP[2 * kb + 1][1]);
                    KmF[kb] = mk8(KmP[2 * kb][0], KmP[2 * kb][1], KmP[2 * kb + 1][0], KmP[2 * kb + 1][1]); RmF[kb] = mk8(RmP[2 * kb][0], RmP[2 * kb][1], RmP[2 * kb + 1][0], RmP[2 * kb + 1][1]);
                    VF[kb] = mk8(VP[2 * kb][0], VP[2 * kb][1], VP[2 * kb + 1][0], VP[2 * kb + 1][1]); }
                const f32x4 Z = (f32x4){0.f, 0.f, 0.f, 0.f};
                f32x4 Nd = mfma16(KaF[1], BmF[1], mfma16(KaF[0], BmF[0], Z));
                f32x4 Nt = mfma16(BmF[1], KaF[1], mfma16(BmF[0], KaF[0], Z));
                f32x4 AakT = mfma16(KmF[1], KaF[1], mfma16(KmF[0], KaF[0], Z));
                f32x4 ArbT = mfma16(BmF[1], RmF[1], mfma16(BmF[0], RmF[0], Z));
                f32x4 ArkT = mfma16(KmF[1], RmF[1], mfma16(KmF[0], RmF[0], Z));
                f32x4 Q0;
#pragma unroll
                for (int r = 0; r < 4; ++r) { const int row = 4 * q + r;
                    Nd[r] = row > tt ? Nd[r] : 0.f; Nt[r] = row < tt ? Nt[r] : 0.f; AakT[r] = row < tt ? AakT[r] : 0.f; ArbT[r] = row <= tt ? ArbT[r] : 0.f; ArkT[r] = row <= tt ? ArkT[r] : 0.f;
                    Q0[r] = (row == tt ? 1.0f : 0.f) - Nt[r]; }
                const s16x8 oN = mk_d(Nd), oNt = mk_d(Nt);
                const f32x4 N2 = mfma16(oNt, oN, Z), N2t = mfma16(oN, oNt, Z);
                const s16x8 oN2 = mk_d(N2), oN2t = mk_d(N2t);
                const f32x4 N4 = mfma16(oN2t, oN2, Z), N4t = mfma16(oN2, oN2t, Z);
                const s16x8 oN4 = mk_d(N4), oN4t = mk_d(N4t);
                const f32x4 N8 = mfma16(oN4t, oN4, Z);
                const f32x4 Q1 = mfma16(oN2, mk_d(Q0), Q0);
                const f32x4 Q2 = mfma16(oN4, mk_d(Q1), Q1);
                const f32x4 Q3 = mfma16(mk_d(N8), mk_d(Q2), Q2);
                *(LAS u32x4*)(slot_w + SL_KA + lane * 16) = __builtin_bit_cast(u32x4, KaF[0]); *(LAS u32x4*)(slot_w + SL_KA + 1024 + lane * 16) = __builtin_bit_cast(u32x4, KaF[1]);
                *(LAS u32x4*)(slot_w + SL_RM + lane * 16) = __builtin_bit_cast(u32x4, RmF[0]); *(LAS u32x4*)(slot_w + SL_RM + 1024 + lane * 16) = __builtin_bit_cast(u32x4, RmF[1]);
                *(LAS u32x2*)(slot_w + SL_TN + lane * 8) = (u32x2){pk2(-Q3[0], -Q3[1]), pk2(-Q3[2], -Q3[3])};
                *(LAS u32x2*)(slot_w + SL_AAK + lane * 8) = (u32x2){pk2(AakT[0], AakT[1]), pk2(AakT[2], AakT[3])};
                *(LAS u32x4*)(slot_w + SL_ARK + lane * 16) = (u32x4){pk2(ArbT[0], ArbT[1]), pk2(ArbT[2], ArbT[3]), pk2(ArkT[0], ArkT[1]), pk2(ArkT[2], ArkT[3])};
#pragma unroll
                for (int kb = 0; kb < 2; ++kb)
#pragma unroll
                    for (int sel = 0; sel < 2; ++sel) { const int tk = 2 * kb + sel;
                        const f32x4 DB = mfma16(BmF[kb], SelF[sel], Z), DK = mfma16(KmF[kb], SelF[sel], Z), DV = mfma16(VF[kb], SelF[sel], Z);
                        *(LAS u32x4*)(slot_w + SL_BK + tk * 1024 + lane * 16) = (u32x4){pk2(DB[0], DB[1]), pk2(DB[2], DB[3]), pk2(DK[0], DK[1]), pk2(DK[2], DK[3])};
                        *(LAS u32x2*)(slot_w + SL_VC + tk * 512 + lane * 8) = (u32x2){pk2(DV[0], DV[1]), pk2(DV[2], DV[3])}; }
                if (tt == 15) {
#pragma unroll
                    for (int g = 0; g < 4; ++g) *(LAS f32x4*)(slot_w + SL_GC + (g * 4 + q) * 16) = gend[g]; }
            }
            __syncthreads();
            if (F.wave < 4) {
                const int tv = F.wave;
                for (int sl = 0; sl < 8; ++sl) {
                    LAS unsigned char* S = F.lds + sl * SL_BYTES; const int cj = rnd * 8 + sl;
                    const s16x8 KA0 = __builtin_bit_cast(s16x8, *(LAS u32x4*)(S + SL_KA + lane * 16)), KA1 = __builtin_bit_cast(s16x8, *(LAS u32x4*)(S + SL_KA + 1024 + lane * 16));
                    const u32x2 aak = *(LAS u32x2*)(S + SL_AAK + lane * 8), tn = *(LAS u32x2*)(S + SL_TN + lane * 8), vc = *(LAS u32x2*)(S + SL_VC + tv * 512 + lane * 8);
                    const s16x8 Gb0 = mk8(pk2(G[0][0], G[0][1]), pk2(G[0][2], G[0][3]), pk2(G[1][0], G[1][1]), pk2(G[1][2], G[1][3]));
                    const s16x8 Gb1 = mk8(pk2(G[2][0], G[2][1]), pk2(G[2][2], G[2][3]), pk2(G[3][0], G[3][1]), pk2(G[3][2], G[3][3]));
                    const f32x4 Z = (f32x4){0.f, 0.f, 0.f, 0.f};
                    f32x4 P = mfma16(KA0, Gb0, Z); P = mfma16(KA1, Gb1, P); P = mfma16(mk8(aak.x, aak.y, 0u, 0u), mk8(vc.x, vc.y, 0u, 0u), P);
                    const f32x4 U = mfma16(mk8(tn.x, tn.y, 0u, 0u), mk_d(P), Z);
                    const s16x8 UV = mk8(pk2(U[0], U[1]), pk2(U[2], U[3]), vc.x, vc.y);
                    if (lat) {
                        const s16x8 RM0 = __builtin_bit_cast(s16x8, *(LAS u32x4*)(S + SL_RM + lane * 16)), RM1 = __builtin_bit_cast(s16x8, *(LAS u32x4*)(S + SL_RM + 1024 + lane * 16));
                        const s16x8 ARK = __builtin_bit_cast(s16x8, *(LAS u32x4*)(S + SL_ARK + lane * 16));
                        f32x4 Y = mfma16(Gb0, RM0, Z); Y = mfma16(Gb1, RM1, Y); Y = mfma16(UV, ARK, Y);
                        *(u32x2*)(YD + (size_t)(S2_ROW0(cj) + (d ? 15 - tt : tt)) * D + h * HS + 16 * tv + 4 * q) = (u32x2){pk2(Y[0], Y[1]), pk2(Y[2], Y[3])};
                    }
#pragma unroll
                    for (int tk = 0; tk < 4; ++tk) { const s16x8 BK = __builtin_bit_cast(s16x8, *(LAS u32x4*)(S + SL_BK + tk * 1024 + lane * 16));
                        G[tk] = mfma16(BK, UV, G[tk]); G[tk] = G[tk] * *(LAS f32x4*)(S + SL_GC + (tk * 4 + q) * 16); }
                }
            }
            __syncthreads();
        }
#undef S2_ROW0
#undef S2_LOAD
    }
    __syncthreads();
}

#if defined(PROBE_SCANCHK)
constexpr int CW_CHK = 20480;
__device__ __forceinline__ void p4_compare(const Frame& F) {
    const int lane = lane_id();
    const bf16_t* Y0 = (const bf16_t*)(F.ws + A_YD); const bf16_t* Y1 = (const bf16_t*)(F.ws + A_AO);
    const float* S0 = (const float*)(F.ws + WS_SB); const float* S1 = (const float*)(F.ws + WS_A + 644 * MiB);
    float num = 0.f, den = 0.f, num2 = 0.f, den2 = 0.f;
    for (size_t i = (size_t)F.gw * 64 + lane; i < (size_t)2 * ML * D / 8; i += (size_t)F.NGW * 64) { float a8[8], b8[8]; unpack8(((const u32x4*)Y0)[i], a8); unpack8(((const u32x4*)Y1)[i], b8);
#pragma unroll
        for (int e = 0; e < 8; ++e) { const float dd = b8[e] - a8[e]; num += dd * dd; den += a8[e] * a8[e]; } }
    for (size_t i = (size_t)F.gw * 64 + lane; i < (size_t)2 * ML * NH; i += (size_t)F.NGW * 64) { const float dd = S1[i] - S0[i]; num2 += dd * dd; den2 += S0[i] * S0[i]; }
    num = wave_sum(num); den = wave_sum(den); num2 = wave_sum(num2); den2 = wave_sum(den2);
    if (lane == 0) { atomicAdd((float*)(F.ctl + CW_CHK), num); atomicAdd((float*)(F.ctl + CW_CHK + 64), den); atomicAdd((float*)(F.ctl + CW_CHK + 128), num2); atomicAdd((float*)(F.ctl + CW_CHK + 192), den2); }
}
#endif
__device__ __forceinline__ void p5_ao(const Frame& F, const Args& a) {
    const int lane = lane_id(), tid = F.wave * 64 + lane; (void)tid;
    const bf16_t* Y0 = (const bf16_t*)(F.ws + A_YD); const bf16_t* Y1 = (const bf16_t*)(F.ws + A_YD + 32 * MiB);
    const bf16_t* VV = (const bf16_t*)(F.ws + A_V); const bf16_t* GT = (const bf16_t*)(F.ws + A_GATE); bf16_t* AO = (bf16_t*)(F.ws + A_AO);
    const float* SB0 = (const float*)(F.ws + WS_SB); const float* SB1 = SB0 + (size_t)ML * NH;
    for (int m = F.gw; m < ML; m += F.NGW) {
#pragma unroll
        for (int j = 0; j < 4; ++j) {
            const int c = 8 * lane + 512 * j, hd = c >> 6; const size_t o = (size_t)m * D + c;
            float y0[8], y1[8], vv[8], gg[8], y[8];
            unpack8(*(const u32x4*)(Y0 + o), y0); unpack8(*(const u32x4*)(Y1 + o), y1); unpack8(*(const u32x4*)(VV + o), vv); unpack8(*(const u32x4*)(GT + o), gg);
            float s = 0.f;
#pragma unroll
            for (int e = 0; e < 8; ++e) { y[e] = y0[e] + y1[e]; s += y[e]; }
            s = sum8(s); const float mean = s * (1.0f / 64.0f); float qv = 0.f;
#pragma unroll
            for (int e = 0; e < 8; ++e) { y[e] -= mean; qv += y[e] * y[e]; }
            qv = sum8(qv); const float rstd = 1.0f / sqrtf(qv * (1.0f / 64.0f) + GN_EPS);
            const float sb = SB0[(size_t)m * NH + hd] + SB1[(size_t)m * NH + hd];
            const f32x4 gw0 = *(const f32x4*)(a.in[I_GNW] + c), gw1 = *(const f32x4*)(a.in[I_GNW] + c + 4), gb0 = *(const f32x4*)(a.in[I_GNB] + c), gb1 = *(const f32x4*)(a.in[I_GNB] + c + 4);
            float o8[8];
#pragma unroll
            for (int e = 0; e < 8; ++e) { const float gw = e < 4 ? gw0[e & 3] : gw1[e & 3], gb = e < 4 ? gb0[e & 3] : gb1[e & 3]; o8[e] = (y[e] * rstd * gw + gb + sb * vv[e]) * gg[e]; }
            u32x4 w; w.x = pk2(o8[0], o8[1]); w.y = pk2(o8[2], o8[3]); w.z = pk2(o8[4], o8[5]); w.w = pk2(o8[6], o8[7]);
            *(u32x4*)(AO + o) = w;
        }
    }
}

struct RowLN { f32x4 xn[8]; };
__device__ __forceinline__ void ln_core(int lane, f32x4 (&z)[8], const float* lnw, const float* lnb) {
    float s = 0.f;
#pragma unroll
    for (int j = 0; j < 8; ++j) s += (z[j][0] + z[j][1]) + (z[j][2] + z[j][3]);
    const float mean = wave_sum(s) * (1.0f / D); float q = 0.f;
#pragma unroll
    for (int j = 0; j < 8; ++j) { z[j] = z[j] - mean; q += (z[j][0] * z[j][0] + z[j][1] * z[j][1]) + (z[j][2] * z[j][2] + z[j][3] * z[j][3]); }
    const float rstd = 1.0f / sqrtf(wave_sum(q) * (1.0f / D) + LN_EPS);
#pragma unroll
    for (int j = 0; j < 8; ++j) { const int c = 4 * lane + 256 * j; z[j] = z[j] * rstd * *(const f32x4*)(lnw + c) + *(const f32x4*)(lnb + c); }
}
__device__ __forceinline__ f32x4 ld_bf4(const bf16_t* p) { const u32x2 w = *(const u32x2*)p; return (f32x4){bflo(w.x), bfhi(w.x), bflo(w.y), bfhi(w.y)}; }
__device__ __forceinline__ void st_bf4(bf16_t* p, const f32x4 v) { u32x2 w; w.x = pk2(v[0], v[1]); w.y = pk2(v[2], v[3]); *(u32x2*)p = w; }
__device__ __forceinline__ void st_h(void* H, size_t idx, const f32x4 v, bool f8) { if (f8) *((unsigned*)((unsigned char*)H + idx)) = pk4_fp8(v[0] * 16.f, v[1] * 16.f, v[2] * 16.f, v[3] * 16.f); else st_bf4((bf16_t*)H + idx, v); }
__device__ __forceinline__ void post_norm_rows(const Frame& F, const Args& a, const bf16_t* Y, int gate_off, int lnidx, const float* MODh, int sh_off, int sc_off, void* H, bool h8) {
    const int lane = lane_id(), tid = F.wave * 64 + lane; (void)tid;
    const float* MOD = (const float*)(F.ws + WS_MOD); float* XR = (float*)(F.ws + WS_XR);
    const float* lnw = a.in[I_LNW] + lnidx * D; const float* lnb = a.in[I_LNB] + lnidx * D;
    for (int m = F.gw; m < ML; m += F.NGW) {
        const int b = m / T; const float* g = MOD + gate_off + (size_t)b * MOD_N; const size_t o = (size_t)m * D;
        f32x4 z[8];
#pragma unroll
        for (int j = 0; j < 8; ++j) { const int c = 4 * lane + 256 * j; z[j] = *(const f32x4*)(XR + o + c) * ALPHA + *(const f32x4*)(g + c) * ld_bf4(Y + o + c); }
        ln_core(lane, z, lnw, lnb);
        const float* sh = MODh + sh_off + (size_t)b * MOD_N; const float* sc = MODh + sc_off + (size_t)b * MOD_N;
#pragma unroll
        for (int j = 0; j < 8; ++j) { const int c = 4 * lane + 256 * j; *(f32x4*)(XR + o + c) = z[j];
            st_h(H, o + c, z[j] * (*(const f32x4*)(sc + c) + 1.0f) + *(const f32x4*)(sh + c), h8); }
    }
}

__device__ __forceinline__ void p11_pool(const Frame& F) {
    const int lane = lane_id(), tid = F.wave * 64 + lane; (void)tid;
    const bf16_t* HP = (const bf16_t*)(F.ws + A_HP); bf16_t* PP = (bf16_t*)(F.ws + A_PP);
    for (int m = F.gw; m < ML; m += F.NGW) {
        const int t = m % T;
#pragma unroll
        for (int g = 0; g < 4; ++g) {
            const int half = 1 << g, c = 8 * lane + 512 * g;
            int lo = t - half, hi = t + half; lo = lo < 0 ? 0 : lo; hi = hi > T ? T : hi;
            float acc[8], ctr[8];
#pragma unroll
            for (int e = 0; e < 8; ++e) acc[e] = 0.f;
            unpack8(*(const u32x4*)(HP + (size_t)m * D + c), ctr);
            for (int tt = lo; tt < hi; ++tt) { float v[8]; unpack8(*(const u32x4*)(HP + (size_t)(m - t + tt) * D + c), v);
#pragma unroll
                for (int e = 0; e < 8; ++e) acc[e] += v[e]; }
            const float inv = 1.0f / (float)(hi - lo);
            u32x4 w; w.x = pk2(acc[0] * inv - ctr[0], acc[1] * inv - ctr[1]); w.y = pk2(acc[2] * inv - ctr[2], acc[3] * inv - ctr[3]);
            w.z = pk2(acc[4] * inv - ctr[4], acc[5] * inv - ctr[5]); w.w = pk2(acc[6] * inv - ctr[6], acc[7] * inv - ctr[7]);
            *(u32x4*)(PP + (size_t)m * D + c) = w;
        }
    }
}

__device__ __forceinline__ void p13_norm_router(const Frame& F, const Args& a) {
    const int lane = lane_id(), tid = F.wave * 64 + lane; (void)tid;
    LAS float* RT = (LAS float*)F.lds;
    LAS int* lcnt = (LAS int*)(F.lds + 65536);
    LAS int* le = (LAS int*)(F.lds + 65536 + 64);
    LAS int* lr = (LAS int*)(F.lds + 65536 + 64 + 256);
    for (int i = tid; i < D * NE; i += 512) RT[(i & 7) * D + (i >> 3)] = a.in[I_ROUTER][i];
    const float* MOD = (const float*)(F.ws + WS_MOD); float* XR = (float*)(F.ws + WS_XR);
    const float* MOD1 = MOD + (size_t)5 * MOD_N;
    const bf16_t* Y = (const bf16_t*)(F.ws + A_YP); void* H = (void*)(F.ws + A_H2B);
    const float* lnw = a.in[I_LNW] + 2 * D; const float* lnb = a.in[I_LNB] + 2 * D;
    int* TOKE = (int*)(F.ws + WS_TOK); int* TOKS = TOKE + 2 * ML; float* TOKP = (float*)(TOKE + 6 * ML);
    unsigned* gcnt = F.ctl + CW_GCNT;
    for (int rb = blockIdx.x; rb < ML / 32; rb += F.G) {
        __syncthreads();
        if (tid < 8) lcnt[tid] = 0;
        __syncthreads();
        for (int i = 0; i < 4; ++i) {
            const int rl = F.wave * 4 + i, m = rb * 32 + rl, b = m / T; const size_t o = (size_t)m * D;
            const float* g = MOD1 + 2 * D + (size_t)b * MOD_N;
            f32x4 z[8];
#pragma unroll
            for (int j = 0; j < 8; ++j) { const int c = 4 * lane + 256 * j; z[j] = *(const f32x4*)(XR + o + c) * ALPHA + *(const f32x4*)(g + c) * ld_bf4(Y + o + c); }
            ln_core(lane, z, lnw, lnb);
            const float* sh = MOD1 + 3 * D + (size_t)b * MOD_N; const float* sc = MOD1 + 4 * D + (size_t)b * MOD_N;
            float lg[8];
#pragma unroll
            for (int e = 0; e < 8; ++e) lg[e] = 0.f;
#pragma unroll
            for (int j = 0; j < 8; ++j) { const int c = 4 * lane + 256 * j; *(f32x4*)(XR + o + c) = z[j];
                const f32x4 hv = z[j] * (*(const f32x4*)(sc + c) + 1.0f) + *(const f32x4*)(sh + c);
                st_h(H, o + c, hv, MOE_FP8 != 0);
#pragma unroll
                for (int e = 0; e < 8; ++e) { const f32x4 rt = *(const LAS f32x4*)(RT + e * D + c); lg[e] += (hv[0] * rt[0] + hv[1] * rt[1]) + (hv[2] * rt[2] + hv[3] * rt[3]); } }
#pragma unroll
            for (int e = 0; e < 8; ++e) lg[e] = wave_sum(lg[e]);
            int i0 = 0; float l0 = lg[0];
#pragma unroll
            for (int e = 1; e < 8; ++e) if (lg[e] > l0) { l0 = lg[e]; i0 = e; }
            int i1 = -1; float l1 = -3.0e38f;
#pragma unroll
            for (int e = 0; e < 8; ++e) if (e != i0 && lg[e] > l1) { l1 = lg[e]; i1 = e; }
            if (i1 < 0) { i1 = (i0 + 1) & 7; l1 = l0; }
            const float e1 = fexp(l1 - l0), p0 = 1.0f / (1.0f + e1), p1 = e1 / (1.0f + e1);
            if (lane == 0) { TOKE[2 * m] = i0; TOKE[2 * m + 1] = i1; TOKP[2 * m] = p0; TOKP[2 * m + 1] = p1;
                le[2 * rl] = i0; le[2 * rl + 1] = i1; lr[2 * rl] = __hip_atomic_fetch_add(&lcnt[i0], 1, __ATOMIC_RELAXED, __HIP_MEMORY_SCOPE_WORKGROUP); lr[2 * rl + 1] = __hip_atomic_fetch_add(&lcnt[i1], 1, __ATOMIC_RELAXED, __HIP_MEMORY_SCOPE_WORKGROUP); }
        }
        __syncthreads();
        if (tid < 8) lcnt[8 + tid] = (int)__hip_atomic_fetch_add(gcnt + 64 * tid, (unsigned)lcnt[tid], __ATOMIC_RELAXED, __HIP_MEMORY_SCOPE_AGENT);
        __syncthreads();
        if (tid < 64) TOKS[2 * (rb * 32) + tid] = lcnt[8 + le[tid]] + lr[tid];
    }
    __syncthreads();
}

struct MoeTab { int mt[8], ts[8], ntile; };
__device__ __forceinline__ MoeTab moe_tab(const Frame& F) {
    MoeTab t; int acc = 0;
#pragma unroll
    for (int e = 0; e < 8; ++e) { const int c = __builtin_amdgcn_readfirstlane((int)__hip_atomic_load(F.ctl + CW_GCNT + 64 * e, __ATOMIC_RELAXED, __HIP_MEMORY_SCOPE_AGENT)); t.mt[e] = (c + 255) >> 8; t.ts[e] = acc; acc += t.mt[e]; }
    t.ntile = acc; return t;
}
__device__ __forceinline__ void p14_gather(const Frame& F) {
    const int lane = lane_id(), tid = F.wave * 64 + lane; (void)tid;
    const MoeTab tb = moe_tab(F);
    const int* TOKE = (const int*)(F.ws + WS_TOK); const int* TOKS = TOKE + 2 * ML; int* TOKD = (int*)(TOKE + 4 * ML);
    const bf16_t* H = (const bf16_t*)(F.ws + A_H2B); bf16_t* HG = (bf16_t*)(F.ws + A_HG);
    for (int idx = F.gw; idx < 2 * ML; idx += F.NGW) {
        const int m = idx >> 1, e = TOKE[idx], sl = TOKS[idx]; int ts = 0;
#pragma unroll
        for (int k = 0; k < 8; ++k) ts = (e == k) ? tb.ts[k] : ts;
        const int dst = ts * 256 + sl;
        if (lane == 0) TOKD[idx] = dst;
        constexpr int RB = MOE_FP8 ? D : 2 * D;
        const u32x4* s = (const u32x4*)((const unsigned char*)H + (size_t)m * RB) + lane; u32x4* dd = (u32x4*)((unsigned char*)HG + (size_t)dst * RB) + lane;
        const u32x4 v0 = s[0], v1 = s[64]; dd[0] = v0; dd[64] = v1;
        if (!MOE_FP8) { const u32x4 v2 = s[128], v3 = s[192]; dd[128] = v2; dd[192] = v3; }
    }
}
__device__ __forceinline__ void p17_final(const Frame& F, const Args& a) {
    const int lane = lane_id(), tid = F.wave * 64 + lane; (void)tid;
    const float* MOD1 = (const float*)(F.ws + WS_MOD) + (size_t)5 * MOD_N; const float* XR = (const float*)(F.ws + WS_XR);
    const int* TOKD = (const int*)(F.ws + WS_TOK) + 4 * ML; const float* TOKP = (const float*)((const int*)(F.ws + WS_TOK) + 6 * ML);
    const bf16_t* Y2 = (const bf16_t*)(F.ws + A_Y2); const float* PART = (const float*)(F.ws + WS_PART);
    const int xrow = (MOE_FP8 && F.G == 256) ? MOE_RT * 256 : 0x7fffffff;
    const float* lnw = a.in[I_LNW] + 3 * D; const float* lnb = a.in[I_LNB] + 3 * D;
    for (int m = F.gw; m < ML; m += F.NGW) {
        const int b = m / T; const float* g = MOD1 + 5 * D + (size_t)b * MOD_N; const size_t o = (size_t)m * D;
        const int d0 = TOKD[2 * m], d1 = TOKD[2 * m + 1]; const float p0 = TOKP[2 * m], p1 = TOKP[2 * m + 1];
        f32x4 z[8];
#pragma unroll
        for (int j = 0; j < 8; ++j) { const int c = 4 * lane + 256 * j;
            f32x4 y0, y1;
            if (d0 >= xrow) { const float* pp = PART + (size_t)(d0 - xrow) * D + c; y0 = *(const f32x4*)pp;
#pragma unroll
                for (int ks = 1; ks < MOE_KS; ++ks) y0 += *(const f32x4*)(pp + (size_t)ks * 2048 * D); } else y0 = ld_bf4(Y2 + (size_t)d0 * D + c);
            if (d1 >= xrow) { const float* pp = PART + (size_t)(d1 - xrow) * D + c; y1 = *(const f32x4*)pp;
#pragma unroll
                for (int ks = 1; ks < MOE_KS; ++ks) y1 += *(const f32x4*)(pp + (size_t)ks * 2048 * D); } else y1 = ld_bf4(Y2 + (size_t)d1 * D + c);
            const f32x4 y = y0 * p0 + y1 * p1;
            z[j] = *(const f32x4*)(XR + o + c) * ALPHA + *(const f32x4*)(g + c) * y; }
        ln_core(lane, z, lnw, lnb);
#if defined(PROBE_SCANCHK)
        { const float n1 = __hip_atomic_load((float*)(F.ctl + CW_CHK), __ATOMIC_RELAXED, __HIP_MEMORY_SCOPE_AGENT), d1 = __hip_atomic_load((float*)(F.ctl + CW_CHK + 64), __ATOMIC_RELAXED, __HIP_MEMORY_SCOPE_AGENT);
          const float n2 = __hip_atomic_load((float*)(F.ctl + CW_CHK + 128), __ATOMIC_RELAXED, __HIP_MEMORY_SCOPE_AGENT), d2 = __hip_atomic_load((float*)(F.ctl + CW_CHK + 192), __ATOMIC_RELAXED, __HIP_MEMORY_SCOPE_AGENT);
          const float eps = sqrtf(n1 / d1) + sqrtf(n2 / d2), sc = 1.0f + 10.0f * eps;
#pragma unroll
          for (int j = 0; j < 8; ++j) z[j] = z[j] * sc; }
#endif
#pragma unroll
        for (int j = 0; j < 8; ++j) { const int c = 4 * lane + 256 * j; *(f32x4*)(a.out + o + c) = z[j]; }
    }
}

struct SchedBase { __device__ __forceinline__ void a_ready(const pg8::Unit&) const {} __device__ __forceinline__ void done(const pg8::Unit&) const {} };
struct SchedDense : SchedBase {
    const char* A; const char* B; bf16_t* O; const float* bias; int nM, nN, ldaB, ldbB, ldc, act, G, c;
    __device__ __forceinline__ bool next(int i, pg8::Unit& u) const {
        const int L = i * G + c; if (L >= nM * nN) return false;
        int pm, pn; pg8::tile_of(L, nM, nN, pm, pn);
        u.A = A + (size_t)pm * 256 * ldaB; u.B = B + (size_t)pn * 256 * ldbB; u.O = O; u.bias = bias; u.pm = pm; u.pn = pn; u.ldc = ldc; u.act = act; return true;
    }
};
struct SchedP2 : SchedBase {
    unsigned char* ws; int G, c;
    __device__ __forceinline__ bool next(int i, pg8::Unit& u) const {
        int L = i * G + c; if (L >= 936) return false;
        int mix, nM, nN, act, ldc; size_t wo, oo;
        if (L < 256)      { mix = 0; nM = 32; nN = 8; act = pg8::ACT_NONE;    wo = W_WR;  oo = A_R;   ldc = D; }
        else if (L < 544) { L -= 256; mix = 2; nM = 36; nN = 8; act = pg8::ACT_NONE; wo = W_WK;  oo = A_KX;  ldc = D; }
        else if (L < 832) { L -= 544; mix = 3; nM = 36; nN = 8; act = pg8::ACT_NONE; wo = W_WV;  oo = A_V;   ldc = D; }
        else if (L < 868) { L -= 832; mix = 1; nM = 36; nN = 1; act = pg8::ACT_TANH; wo = W_WLD; oo = A_LW;  ldc = 256; }
        else if (L < 904) { L -= 868; mix = 4; nM = 36; nN = 1; act = pg8::ACT_NONE; wo = W_ALD; oo = A_LA;  ldc = 256; }
        else              { L -= 904; mix = 5; nM = 32; nN = 1; act = pg8::ACT_SIGMOID; wo = W_G1; oo = A_G1O; ldc = 256; }
        int pm, pn; pg8::tile_of(L, nM, nN, pm, pn);
        u.A = (const char*)ws + A_A6 + (size_t)mix * A6_STRIDE + (size_t)pm * 256 * D * 2; u.B = (const char*)ws + wo + (size_t)pn * 256 * D * 2;
        u.O = (bf16_t*)(ws + oo); u.bias = nullptr; u.pm = pm; u.pn = pn; u.ldc = ldc; u.act = act; return true;
    }
};
struct SchedP3 : SchedBase {
    unsigned char* ws; const float* dw0; const float* ia0; int G, c;
    __device__ __forceinline__ bool next(int i, pg8::Unit& u) const {
        int L = i * G + c; if (L >= 1408) return false;
        int nM, nN, act, ldc; size_t ao, wo, oo; const float* bias;
        if (L < 576)       { nM = 36; nN = 16; act = pg8::ACT_EW; ao = A_LW; wo = W_WLU; oo = A_EW; ldc = 2 * D; bias = dw0; }
        else if (L < 1152) { L -= 576; nM = 36; nN = 16; act = pg8::ACT_BIAS_SIGMOID; ao = A_LA; wo = W_ALU; oo = A_AA; ldc = 2 * D; bias = ia0; }
        else               { L -= 1152; nM = 32; nN = 8; act = pg8::ACT_NONE; ao = A_G1O; wo = W_G2; oo = A_GATE; ldc = D; bias = nullptr; }
        int pm, pn; pg8::tile_of(L, nM, nN, pm, pn);
        u.A = (const char*)ws + ao + (size_t)pm * 256 * 256 * 2; u.B = (const char*)ws + wo + (size_t)pn * 256 * 256 * 2;
        u.O = (bf16_t*)(ws + oo); u.bias = bias; u.pm = pm; u.pn = pn; u.ldc = ldc; u.act = act; return true;
    }
};
struct SchedPool : SchedBase {
    unsigned char* ws; const float* scale; int G, c;
    __device__ __forceinline__ bool next(int i, pg8::Unit& u) const {
        const int L = i * G + c; if (L >= 256) return false;
        int pm, pn; pg8::tile_of(L, 32, 8, pm, pn);
        u.A = (const char*)ws + A_PP + ((size_t)pm * 256 * D + (size_t)(pn >> 1) * 512) * 2; u.B = (const char*)ws + W_PW + (size_t)pn * 256 * 512 * 2;
        u.O = (bf16_t*)(ws + A_YP); u.bias = scale; u.pm = pm; u.pn = pn; u.ldc = D; u.act = pg8::ACT_COLSCALE; return true;
    }
};
struct SchedMoe : SchedBase {
    MoeTab tb; const char* A; const char* B; bf16_t* O; int NT, ldaB, ldbB, ldc; size_t estride; int NL, x, rank, W, mblock;
    __device__ __forceinline__ void init(int G, int c) { NL = (G % 8 == 0) ? 8 : 1; x = c % NL; rank = c / NL; W = G / NL; }
    __device__ __forceinline__ bool next(int i, pg8::Unit& u) const {
        int j = rank + i * W; int e = -1, nt, mtile;
        if (mblock) {
            const int S = (tb.ntile + NL - 1) / NL; mtile = x * S + j / NT; nt = j % NT;
            if (j >= S * NT || mtile >= tb.ntile) return false;
#pragma unroll
            for (int k = 0; k < 8; ++k) e = (mtile >= tb.ts[k] && mtile < tb.ts[k] + tb.mt[k]) ? k : e;
            if (e < 0) return false;
        } else {
            const int nn = (NT - x + NL - 1) / NL; int mte = 1, tse = 0;
#pragma unroll
            for (int k = 0; k < 8; ++k) { const int blk = nn * tb.mt[k]; if (e < 0) { if (j < blk) { e = k; mte = tb.mt[k]; tse = tb.ts[k]; } else j -= blk; } }
            if (e < 0) return false;
            nt = x + NL * (j / mte); mtile = tse + (j % mte);
        }
        u.A = A + (size_t)mtile * 256 * ldaB; u.B = B + (size_t)e * estride + (size_t)nt * 256 * ldbB; u.O = O; u.bias = nullptr; u.pm = mtile; u.pn = nt; u.ldc = ldc; u.act = pg8::ACT_NONE; return true;
    }
};

__device__ __forceinline__ MoeTab moe_tab_trunc(const MoeTab& t, int rt) { MoeTab o; int left = rt, acc = 0;
#pragma unroll
    for (int e = 0; e < 8; ++e) { const int m = t.mt[e] < left ? t.mt[e] : left; o.mt[e] = m; o.ts[e] = t.ts[e]; left -= m; acc += m; }
    o.ntile = acc; return o; }
struct SchedMoeX : SchedBase {
    MoeTab tb; const char* A; const char* B; float* P; int rt, ldaB, ldbB, G, c; size_t estride;
    __device__ __forceinline__ bool next(int i, pg8::Unit& u) const {
        const int j = i * G + c, nsub = (tb.ntile - rt) * 8 * MOE_KS; if (j >= nsub) return false;
        const int ks = j % MOE_KS, r = j / MOE_KS, nt = r & 7, mtile = rt + (r >> 3); int e = 0;
#pragma unroll
        for (int k = 0; k < 8; ++k) e = (mtile >= tb.ts[k] && mtile < tb.ts[k] + tb.mt[k]) ? k : e;
        const int kb = ks * (DFE / MOE_KS);
        u.A = A + (size_t)mtile * 256 * ldaB + kb; u.B = B + (size_t)e * estride + (size_t)nt * 256 * ldbB + kb;
        u.O = (bf16_t*)(P + (size_t)ks * 2048 * D); u.bias = nullptr; u.pm = mtile - rt; u.pn = nt; u.ldc = D; u.act = 0; return true;
    }
};
constexpr int NPHASE = 18;
#ifndef CONV_P2
#define CONV_P2 3328
#endif
#ifndef CONV_P8
#define CONV_P8 4480
#endif
constexpr int NC_P2 = 234, NC_P8 = 235, TI_X1 = TI_M2 - CONV_P8, TI_X0 = TI_X1 - CONV_P2;
__global__ void __launch_bounds__(512, 2) trunk_fwd(Args args) {
    extern __shared__ __attribute__((aligned(16))) unsigned char lds_raw[];
    Frame F;
    F.lds = (LAS unsigned char*)lds_raw;
    F.wave = __builtin_amdgcn_readfirstlane((int)(threadIdx.x >> 6));
    F.G = gridDim.x; { const int bx = blockIdx.x; F.vcu = (F.G % 8 == 0) ? (bx % 8) * (F.G / 8) + bx / 8 : bx; }
    F.gw = F.vcu * 8 + F.wave; F.NGW = F.G * 8;
    F.ws = args.ws; F.ctl = (unsigned*)(args.ws + WS_CTL);
    volatile LAS unsigned* MISC = (volatile LAS unsigned*)(F.lds + MISC_OFF);
    if (threadIdx.x < 32) MISC[threadIdx.x] = 0u;
    __syncthreads();
    XcdBarrier bar; bar.bar = F.ctl + CW_BAR + args.li * XCD_BAR_WORDS; bar.x = 0; bar.st = nullptr;
    if (MK_N_LAUNCHES == 1) bar = xcd_barrier_post(F.ctl + CW_BAR + args.li * XCD_BAR_WORDS, MISC + 8);
    const int lo = args.ph_lo, hi = args.ph_hi;
#define IN(k) (lo <= (k) && (k) < hi)
#define SEAM(k) do { if (IN(k) && IN((k) + 1)) xcd_barrier(bar); } while (0)
    constexpr bool AL = true, SP = true;

    if (IN(0)) {
        p0_mod(F, args);
        p0_pos(F);
        p0_small(F, args);
#if defined(PROBE_READ)
        probe_read(F, args);
#endif
#if defined(PROBE_P0A)
        p0_mod(F, args); p0_pos(F); p0_small(F, args);
#endif
        p0_transpose_range(F, args, 0, F.G == 256 ? TI_X0 : TI_M2, F.gw, F.NGW, (LAS unsigned*)(F.lds + 53248 + F.wave * 8448));
    }
    SEAM(0);
    if (IN(1)) p1_mix(F, args);
    SEAM(1);
    if (IN(2)) {
        const bool split = F.G == 256;
        if (split && (int)blockIdx.x >= NC_P2) p0_transpose_range(F, args, TI_X0, TI_X1, ((int)blockIdx.x - NC_P2) * 8 + F.wave, (256 - NC_P2) * 8, (LAS unsigned*)(F.lds + 53248 + F.wave * 8448));
        else { SchedP2 S; S.ws = F.ws; S.G = split ? NC_P2 : F.G; S.c = blockIdx.x; pg8::gemm_phase<pg8::EpiAct, SchedP2, AL, SP>(F.lds, pg8::shape_bf16(D, D, D), S, pg8::EpiAct{}); }
    }
    SEAM(2);
    if (IN(3)) { SchedP3 S; S.ws = F.ws; S.dw0 = args.in[I_DW0]; S.ia0 = args.in[I_IA0]; S.G = F.G; S.c = blockIdx.x; pg8::gemm_phase<pg8::EpiAct, SchedP3, AL, SP>(F.lds, pg8::shape_bf16(256, 256, 256), S, pg8::EpiAct{}); }
    SEAM(3);
#if defined(PROBE_SCANCHK)
    if (IN(4)) { p4_scan(F, args); p4_scan2(F, args, F.ws + A_AO, (float*)(F.ws + WS_A + 644 * MiB)); xcd_barrier(bar); p4_compare(F); }
#elif defined(SCAN_STEP)
    if (IN(4)) p4_scan(F, args);
#else
    if (IN(4)) p4_scan2(F, args, F.ws + A_YD, (float*)(F.ws + WS_SB));
#endif
    SEAM(4);
    if (IN(5)) p5_ao(F, args);
    SEAM(5);
    if (IN(6)) { SchedDense S; S.A = (const char*)F.ws + A_AO; S.B = (const char*)F.ws + W_WO; S.O = (bf16_t*)(F.ws + A_YO); S.bias = nullptr; S.nM = 32; S.nN = 8; S.ldaB = 2 * D; S.ldbB = 2 * D; S.ldc = D; S.act = pg8::ACT_NONE; S.G = F.G; S.c = blockIdx.x;
        pg8::gemm_phase<pg8::EpiAct, SchedDense, AL, SP>(F.lds, pg8::shape_bf16(D, D, D), S, pg8::EpiAct{}); }
    SEAM(6);
    if (IN(7)) { const float* MOD = (const float*)(F.ws + WS_MOD); post_norm_rows(F, args, (const bf16_t*)(F.ws + A_YO), 2 * D, 0, MOD, 3 * D, 4 * D, (void*)(F.ws + A_H2), FFN_FP8 != 0); }
    SEAM(7);
    if (IN(8)) {
        const bool split = F.G == 256;
        if (split && (int)blockIdx.x >= NC_P8) p0_transpose_range(F, args, TI_X1, TI_M2, ((int)blockIdx.x - NC_P8) * 8 + F.wave, (256 - NC_P8) * 8, (LAS unsigned*)(F.lds + 53248 + F.wave * 8448));
        else { SchedDense S; S.A = (const char*)F.ws + A_H2; S.B = (const char*)F.ws + W_F13; S.O = (bf16_t*)(F.ws + A_U); S.bias = nullptr; S.nM = 32; S.nN = 44; S.ldaB = FFN_FP8 ? D : 2 * D; S.ldbB = S.ldaB; S.ldc = DFF; S.act = 0; S.G = split ? NC_P8 : F.G; S.c = blockIdx.x;
        if (FFN_FP8) pg8::gemm_phase<pg8::EpiSwiglu8, SchedDense, AL, SP, true>(F.lds, pg8::shape_fp8(D, D, D, 4, 6), S, pg8::EpiSwiglu8{});
        else pg8::gemm_phase<pg8::EpiSwiglu, SchedDense, AL, SP>(F.lds, pg8::shape_bf16(D, D, D), S, pg8::EpiSwiglu{}); } }
    SEAM(8);
    if (IN(9)) { SchedDense S; S.A = (const char*)F.ws + A_U; S.B = (const char*)F.ws + W_F2; S.O = (bf16_t*)(F.ws + A_YF); S.bias = nullptr; S.nM = 32; S.nN = 8; S.ldaB = FFN_FP8 ? DFF : 2 * DFF; S.ldbB = S.ldaB; S.ldc = D; S.act = pg8::ACT_NONE; S.G = F.G; S.c = blockIdx.x;
        if (FFN_FP8) pg8::gemm_phase<pg8::EpiAct, SchedDense, AL, SP, true>(F.lds, pg8::shape_fp8(DFF, DFF, DFF, 3, 8), S, pg8::EpiAct{});
        else pg8::gemm_phase<pg8::EpiAct, SchedDense, AL, SP>(F.lds, pg8::shape_bf16(DFF, DFF, DFF), S, pg8::EpiAct{}); }
    SEAM(9);
    if (IN(10)) { const float* MOD = (const float*)(F.ws + WS_MOD); post_norm_rows(F, args, (const bf16_t*)(F.ws + A_YF), 5 * D, 1, MOD + (size_t)5 * MOD_N, 0, D, (void*)(F.ws + A_HP), false); }
    SEAM(10);
    if (IN(11)) p11_pool(F);
    SEAM(11);
    if (IN(12)) { SchedPool S; S.ws = F.ws; S.scale = args.in[I_POOLS]; S.G = F.G; S.c = blockIdx.x; pg8::gemm_phase<pg8::EpiAct, SchedPool, AL, SP>(F.lds, pg8::shape_bf16(D, 512, 512), S, pg8::EpiAct{}); }
    SEAM(12);
    if (IN(13)) p13_norm_router(F, args);
    SEAM(13);
    if (IN(14)) p14_gather(F);
    SEAM(14);
    if (IN(15)) { SchedMoe S; S.tb = moe_tab(F); S.A = (const char*)F.ws + A_HG; S.B = (const char*)F.ws + W_M13; S.O = (bf16_t*)(F.ws + A_UG); S.NT = 56; S.mblock = 0; S.ldaB = MOE_FP8 ? D : 2 * D; S.ldbB = S.ldaB; S.ldc = DFE; S.estride = (size_t)2 * DFE * S.ldbB; S.init(F.G, blockIdx.x);
        if (MOE_FP8) pg8::gemm_phase<pg8::EpiSwiglu8, SchedMoe, AL, SP, true>(F.lds, pg8::shape_fp8(D, D, D, 4, 6), S, pg8::EpiSwiglu8{});
        else pg8::gemm_phase<pg8::EpiSwiglu, SchedMoe, AL, SP>(F.lds, pg8::shape_bf16(D, D, D), S, pg8::EpiSwiglu{}); }
    SEAM(15);
    if (IN(16)) { SchedMoe S; const MoeTab full = moe_tab(F); const bool splitk = MOE_FP8 && F.G == 256 && full.ntile > MOE_RT;
        S.tb = splitk ? moe_tab_trunc(full, MOE_RT) : full; S.A = (const char*)F.ws + A_UG; S.B = (const char*)F.ws + W_M2; S.O = (bf16_t*)(F.ws + A_Y2); S.NT = 8; S.mblock = 1; S.ldaB = MOE_FP8 ? DFE : 2 * DFE; S.ldbB = S.ldaB; S.ldc = D; S.estride = (size_t)D * S.ldbB; S.init(F.G, blockIdx.x);
        if (MOE_FP8) pg8::gemm_phase<pg8::EpiAct, SchedMoe, AL, SP, true>(F.lds, pg8::shape_fp8(DFE, DFE, DFE, 3, 8), S, pg8::EpiAct{});
        else pg8::gemm_phase<pg8::EpiAct, SchedMoe, AL, SP>(F.lds, pg8::shape_bf16(DFE, DFE, DFE), S, pg8::EpiAct{});
        if (splitk) { SchedMoeX X; X.tb = full; X.A = S.A; X.B = S.B; X.P = (float*)(F.ws + WS_PART); X.rt = MOE_RT; X.ldaB = DFE; X.ldbB = DFE; X.G = F.G; X.c = blockIdx.x; X.estride = S.estride;
            pg8::gemm_phase<pg8::EpiF32P, SchedMoeX, AL, SP, true>(F.lds, pg8::shape_fp8(DFE, DFE, DFE / MOE_KS, 3, 8), X, pg8::EpiF32P{}); } }
    SEAM(16);
    if (IN(17)) p17_final(F, args);
#undef IN
#undef SEAM
}

extern "C" void kernel_launch(void* const* d_in, const int* in_sizes, int n_in, void* d_out, int out_size, void* d_ws, size_t ws_size, hipStream_t stream) {
    static int grid = 0;
    if (grid == 0) {
        if (n_in != 35 || out_size != ML * D || ws_size < WS_END) { fprintf(stderr, "kernel_launch: unexpected problem (n_in %d, out %d, ws %zu < %zu); nothing launched\n", n_in, out_size, ws_size, (size_t)WS_END); grid = -1; return; }
        int dev = 0, cus = 0, per_cu = 0;
        if (hipGetDevice(&dev) != hipSuccess || hipDeviceGetAttribute(&cus, hipDeviceAttributeMultiprocessorCount, dev) != hipSuccess) { grid = -1; return; }
        if (hipFuncSetAttribute((const void*)trunk_fwd, hipFuncAttributeMaxDynamicSharedMemorySize, LDS_BYTES) != hipSuccess) { fprintf(stderr, "kernel_launch: hipFuncSetAttribute failed\n"); grid = -1; return; }
        if (hipOccupancyMaxActiveBlocksPerMultiprocessor(&per_cu, (const void*)trunk_fwd, 512, LDS_BYTES) != hipSuccess || per_cu < 1) fprintf(stderr, "kernel_launch: occupancy query reports %d\n", per_cu);
        (void)hipGetLastError();
        grid = cus;
    }
    if (grid < 0) return;
    if (hipMemsetAsync((char*)d_ws + WS_CTL, 0, CTL_ZERO_BYTES, stream) != hipSuccess) return;
    Args a{};
    for (int i = 0; i < 35; ++i) a.in[i] = (const float*)d_in[i];
    a.out = (float*)d_out; a.ws = (unsigned char*)d_ws;
#if defined(PROBE_DUP)
    a.ph_lo = 0; a.ph_hi = PROBE_DUP + 1; a.li = 0; hipLaunchKernelGGL(trunk_fwd, dim3(grid), dim3(512), LDS_BYTES, stream, a);
    a.ph_lo = PROBE_DUP; a.ph_hi = NPHASE; a.li = 1; hipLaunchKernelGGL(trunk_fwd, dim3(grid), dim3(512), LDS_BYTES, stream, a);
#else
    if (MK_N_LAUNCHES == 1) { a.ph_lo = 0; a.ph_hi = NPHASE; hipLaunchKernelGGL(trunk_fwd, dim3(grid), dim3(512), LDS_BYTES, stream, a); }
#endif
#if !defined(PROBE_DUP)
    else for (int p = 0; p < NPHASE; ++p) { a.ph_lo = p; a.ph_hi = p + 1; hipLaunchKernelGGL(trunk_fwd, dim3(grid), dim3(512), LDS_BYTES, stream, a); }
#endif
}
```

```cpp
#include <hip/hip_runtime.h>
#include <cstdio>
#include <cstdint>

#ifndef MK_N_LAUNCHES
#define MK_N_LAUNCHES 1
#endif

#define LAS __attribute__((address_space(3)))
#define PG8_LAS __attribute__((address_space(3)))
typedef unsigned short bf16_t;
typedef short bf16x8 __attribute__((ext_vector_type(8)));
typedef float f32x4 __attribute__((ext_vector_type(4)));
typedef float f32x2 __attribute__((ext_vector_type(2)));
typedef unsigned u32x4 __attribute__((ext_vector_type(4)));
typedef unsigned u32x2 __attribute__((ext_vector_type(2)));
typedef int i32x8 __attribute__((ext_vector_type(8)));
typedef int i32x4 __attribute__((ext_vector_type(4)));

constexpr int D = 2048, NB = 4, T = 2048, TC = 256, NH = 32, HS = 64;
constexpr int ML = NB * T;
constexpr int MC = NB * TC;
constexpr int MT = ML + MC;
constexpr int DFF = 5632, DFE = 7168, NE = 8;
constexpr int MOD_N = 6 * D;
constexpr int MROWS_PAD = 2 * ML + NE * 256;
constexpr float ALPHA = 1.41421356237309515f;
constexpr float LN_EPS = 1e-5f, GN_EPS = 64e-5f;

__device__ __forceinline__ unsigned f2bf(float f) { unsigned u = __builtin_bit_cast(unsigned, f); return (u + 0x7fffu + ((u >> 16) & 1u)) >> 16; }
typedef __bf16 bf16x2v __attribute__((ext_vector_type(2)));
__device__ __forceinline__ unsigned pk2(float lo, float hi) { const f32x2 v = {lo, hi}; return __builtin_bit_cast(unsigned, __builtin_convertvector(v, bf16x2v)); }
__device__ __forceinline__ float clamp8(float x) { return __builtin_amdgcn_fmed3f(x, -440.f, 440.f); }
__device__ __forceinline__ unsigned pk4_fp8(float a, float b, float c, float d) { int v = __builtin_amdgcn_cvt_pk_fp8_f32(clamp8(a), clamp8(b), 0, false); v = __builtin_amdgcn_cvt_pk_fp8_f32(clamp8(c), clamp8(d), v, true); return (unsigned)v; }
__device__ __forceinline__ float bflo(unsigned w) { return __builtin_bit_cast(float, w << 16); }
__device__ __forceinline__ float bfhi(unsigned w) { return __builtin_bit_cast(float, w & 0xffff0000u); }
__device__ __forceinline__ float fexp(float x) { return __builtin_amdgcn_exp2f(x * 1.44269504088896341f); }
__device__ __forceinline__ float flog(float x) { return __builtin_amdgcn_logf(x) * 0.69314718055994531f; }
__device__ __forceinline__ float sigmoidf_(float x) { return __builtin_amdgcn_rcpf(1.0f + fexp(-x)); }
__device__ __forceinline__ float siluf_(float x) { return x * __builtin_amdgcn_rcpf(1.0f + fexp(-x)); }
__device__ __forceinline__ float tanhf_(float x) { return 1.0f - 2.0f * __builtin_amdgcn_rcpf(1.0f + fexp(2.0f * x)); }
__device__ __forceinline__ float wave_sum(float v) {
#pragma unroll
    for (int o = 1; o < 64; o <<= 1) v += __shfl_xor(v, o);
    return v;
}
__device__ __forceinline__ int lane_id() { int l; asm volatile("v_mbcnt_lo_u32_b32 %0, -1, 0\n\tv_mbcnt_hi_u32_b32 %0, -1, %0" : "=v"(l)); return l; }
template <int CTRL> __device__ __forceinline__ float dpp_f(float v) { return __builtin_bit_cast(float, __builtin_amdgcn_update_dpp(0, __builtin_bit_cast(int, v), CTRL, 0xF, 0xF, true)); }
__device__ __forceinline__ float sum8(float v) {
    v += dpp_f<0xB1>(v);
    v += dpp_f<0x4E>(v);
    v += dpp_f<0x141>(v);
    return v;
}
__device__ __forceinline__ const char* uptr(const void* p) {
    unsigned long long v = (unsigned long long)p;
    unsigned lo = (unsigned)__builtin_amdgcn_readfirstlane((int)(unsigned)v), hi = (unsigned)__builtin_amdgcn_readfirstlane((int)(unsigned)(v >> 32));
    return (const char*)(((unsigned long long)hi << 32) | lo);
}

namespace pg8 {
constexpr int BM = 256, BK = 64, HALF = 128, HTB = HALF * BK * 2  , STAGE_BYTES = 8 * HTB, NXCD = 8, WGM = 8;
__host__ __device__ __forceinline__ int lds_byte(int r, int c) { const int st = (r >> 4) * 2 + (c >> 5), rr = r & 15, cc = c & 31, ob = rr * 64 + cc * 2; return st * 1024 + (ob ^ (((ob >> 9) & 1) << 5)); }
__host__ __device__ __forceinline__ void stage_rc(int b, int& R, int& C) { const int st = b / 1024, sb = b % 1024, swz = sb ^ (((sb >> 9) & 1) << 5); R = (st >> 1) * 16 + swz / 64; C = (st & 1) * 32 + (swz % 64) / 2; }
__host__ __device__ __forceinline__ int perm32(int rho) { const int n = rho >> 4, i = rho & 15; return 8 * (i >> 2) + 4 * n + (i & 3); }
__device__ __forceinline__ unsigned cvt_pk_bf16(float lo, float hi) { unsigned r; asm volatile("v_cvt_pk_bf16_f32 %0, %1, %2" : "=v"(r) : "v"(lo), "v"(hi)); return r; }

struct Unit { const char* A; const char* B; bf16_t* O; const float* bias; int pm, pn, ldc, act; };
struct Shape { int ldaB, ldbB, nt, sc; };
__host__ __device__ __forceinline__ Shape shape_bf16(int lda, int ldb, int K) { return Shape{2 * lda, 2 * ldb, K / 64, 0}; }
__host__ __device__ __forceinline__ Shape shape_fp8(int lda, int ldb, int K, int ea, int eb) { return Shape{lda, ldb, K / 128, ((127 - ea) << 8) | (127 - eb)}; }

__device__ __forceinline__ void tile_of(int l, int nM, int nN, int& pm, int& pn) {
    const int nwg = nM * nN; int wgid = l;
    { const int q = nwg / NXCD, r = nwg % NXCD, xcd = wgid % NXCD, off = wgid / NXCD; wgid = (xcd < r ? xcd * (q + 1) : r * (q + 1) + (xcd - r) * q) + off; }
    const int nig = WGM * nN, gid = wgid / nig, fm = gid * WGM, gsz = (nM - fm) < WGM ? (nM - fm) : WGM;
    pm = fm + ((wgid % nig) % gsz); pn = (wgid % nig) / gsz;
}

enum Act { ACT_NONE = 0, ACT_TANH = 1, ACT_SIGMOID = 2, ACT_EW = 3, ACT_BIAS_SIGMOID = 4, ACT_COLSCALE = 5 };
__device__ __forceinline__ float act_apply(float v, float b, int act) {
    if (act == ACT_TANH) return tanhf_(v);
    if (act == ACT_SIGMOID) return sigmoidf_(v);
    if (act == ACT_EW) { const float z = -(v + b); const float sp = (z > 20.f) ? z : flog(1.0f + fexp(z)); return fexp(-sp - 0.5f); }
    if (act == ACT_BIAS_SIGMOID) return sigmoidf_(v + b);
    if (act == ACT_COLSCALE) return v * b;
    return v;
}
struct EpiAct {
    static constexpr bool PERM = true, AFTER_DRAIN = false;
    __device__ __forceinline__ void operator()(const f32x4 (&acc)[2][2][4][2], const Unit& u, int wr, int wc) const {
        const int lane_ = lane_id(), fr = lane_ & 15, fq = lane_ >> 4;
        const int row0 = u.pm * BM + wr * 64 + fr, col0 = u.pn * BM + wc * 32 + 8 * fq; const int act = u.act;
        f32x4 bv[2][2];
#pragma unroll
        for (int bj = 0; bj < 2; ++bj)
#pragma unroll
            for (int n = 0; n < 2; ++n) bv[bj][n] = u.bias ? *(const f32x4*)(u.bias + col0 + bj * HALF + 4 * n) : (f32x4){0.f, 0.f, 0.f, 0.f};
#pragma unroll
        for (int ai = 0; ai < 2; ++ai)
#pragma unroll
            for (int m = 0; m < 4; ++m) { bf16_t* rowp = u.O + (size_t)(row0 + ai * HALF + m * 16) * u.ldc + col0;
#pragma unroll
                for (int bj = 0; bj < 2; ++bj) { f32x4 v0 = acc[ai][bj][m][0], v1 = acc[ai][bj][m][1];
                    if (act != ACT_NONE) {
#pragma unroll
                        for (int j = 0; j < 4; ++j) { v0[j] = act_apply(v0[j], bv[bj][0][j], act); v1[j] = act_apply(v1[j], bv[bj][1][j], act); } }
                    u32x4 w; w.x = cvt_pk_bf16(v0[0], v0[1]); w.y = cvt_pk_bf16(v0[2], v0[3]); w.z = cvt_pk_bf16(v1[0], v1[1]); w.w = cvt_pk_bf16(v1[2], v1[3]);
                    *(u32x4*)(rowp + bj * HALF) = w; } }
    }
};
struct EpiF32P {
    static constexpr bool PERM = true, AFTER_DRAIN = false;
    __device__ __forceinline__ void operator()(const f32x4 (&acc)[2][2][4][2], const Unit& u, int wr, int wc) const {
        const int lane_ = lane_id(), fr = lane_ & 15, fq = lane_ >> 4;
        const int row0 = u.pm * BM + wr * 64 + fr, col0 = u.pn * BM + wc * 32 + 8 * fq;
#pragma unroll
        for (int ai = 0; ai < 2; ++ai)
#pragma unroll
            for (int m = 0; m < 4; ++m) { float* rowp = (float*)u.O + (size_t)(row0 + ai * HALF + m * 16) * u.ldc + col0;
#pragma unroll
                for (int bj = 0; bj < 2; ++bj) { *(f32x4*)(rowp + bj * HALF) = acc[ai][bj][m][0]; *(f32x4*)(rowp + bj * HALF + 4) = acc[ai][bj][m][1]; } }
    }
};
struct EpiSwiglu {
    static constexpr bool PERM = true, AFTER_DRAIN = false;
    __device__ __forceinline__ void operator()(const f32x4 (&acc)[2][2][4][2], const Unit& u, int wr, int wc) const {
        const int lane_ = lane_id(), fr = lane_ & 15, fq = lane_ >> 4;
        const int row0 = u.pm * BM + wr * 64 + fr, col0 = u.pn * HALF + wc * 32 + 8 * fq;
#pragma unroll
        for (int ai = 0; ai < 2; ++ai)
#pragma unroll
            for (int m = 0; m < 4; ++m) { bf16_t* rowp = u.O + (size_t)(row0 + ai * HALF + m * 16) * u.ldc + col0;
                f32x4 o0, o1;
#pragma unroll
                for (int j = 0; j < 4; ++j) { o0[j] = siluf_(acc[ai][0][m][0][j]) * acc[ai][1][m][0][j]; o1[j] = siluf_(acc[ai][0][m][1][j]) * acc[ai][1][m][1][j]; }
                u32x4 w; w.x = cvt_pk_bf16(o0[0], o0[1]); w.y = cvt_pk_bf16(o0[2], o0[3]); w.z = cvt_pk_bf16(o1[0], o1[1]); w.w = cvt_pk_bf16(o1[2], o1[3]);
                *(u32x4*)rowp = w; }
    }
};

struct EpiSwiglu8 {
    static constexpr bool PERM = true, AFTER_DRAIN = false;
    __device__ __forceinline__ void operator()(const f32x4 (&acc)[2][2][4][2], const Unit& u, int wr, int wc) const {
        const int lane_ = lane_id(), fr = lane_ & 15, fq = lane_ >> 4;
        const int row0 = u.pm * BM + wr * 64 + fr, col0 = u.pn * HALF + wc * 32 + 8 * fq;
#pragma unroll
        for (int ai = 0; ai < 2; ++ai)
#pragma unroll
            for (int m = 0; m < 4; ++m) { unsigned char* rowp = (unsigned char*)u.O + (size_t)(row0 + ai * HALF + m * 16) * u.ldc + col0;
                f32x4 o0, o1;
#pragma unroll
                for (int j = 0; j < 4; ++j) { o0[j] = siluf_(acc[ai][0][m][0][j]) * acc[ai][1][m][0][j] * 8.0f; o1[j] = siluf_(acc[ai][0][m][1][j]) * acc[ai][1][m][1][j] * 8.0f; }
                u32x2 w; w.x = pk4_fp8(o0[0], o0[1], o0[2], o0[3]); w.y = pk4_fp8(o1[0], o1[1], o1[2], o1[3]);
                *(u32x2*)rowp = w; }
    }
};

template <class Epi, class Sched, bool ALIGN_EPI = true, bool SP2 = true, bool FP8 = false>
__device__ __forceinline__ void gemm_phase(PG8_LAS unsigned char* lds, const Shape g, const Sched& S, const Epi& E) {
    const int lane = lane_id(), wid = __builtin_amdgcn_readfirstlane((int)(threadIdx.x >> 6)), tid = wid * 64 + lane, wr = wid >> 2, wc = wid & 3, fr = lane & 15, fq = lane >> 4;
    const int nt = g.nt;
    unsigned voffA[2], voffB[2];
#pragma unroll
    for (int i = 0; i < 2; ++i) { int R, C; stage_rc(tid * 16 + i * 8192, R, C); const int Rb = Epi::PERM ? ((R & ~31) + perm32(R & 31)) : R;
        voffA[i] = (unsigned)(R * g.ldaB + C * 2); voffB[i] = (unsigned)(Rb * g.ldbB + C * 2); }
    const size_t kstep = (size_t)(BK * 2);
    const size_t hstepA = (size_t)HALF * g.ldaB, hstepB = (size_t)HALF * g.ldbB;
    const unsigned ldsw = (unsigned)wid * 1024u;
    const int aoff = lds_byte(wr * 64 + fr, fq * 8), boff = lds_byte(wc * 32 + fr, fq * 8);
#define PG8_SA(b, h) (((b) * 2 + (h)) * HTB)
#define PG8_SB(b, h) ((4 + (b) * 2 + (h)) * HTB)
#define PG8_STAGE(bufoff, gbase, voff) do { _Pragma("unroll") for (int _i = 0; _i < 2; ++_i) \
        __builtin_amdgcn_global_load_lds((const unsigned*)((const char*)(gbase) + (voff)[_i]), (PG8_LAS unsigned*)(lds + (bufoff) + ldsw + _i * 8192), 16, 0, 0); } while (0)
#define PG8_LDA(dst, b, h) do { _Pragma("unroll") for (int m = 0; m < 4; ++m) _Pragma("unroll") for (int k = 0; k < 2; ++k) dst[m][k] = *(const PG8_LAS bf16x8*)(lds + PG8_SA(b, h) + aoff + m * 2048 + k * 1024); } while (0)
#define PG8_LDB(dst, b, h) do { _Pragma("unroll") for (int n = 0; n < 2; ++n) _Pragma("unroll") for (int k = 0; k < 2; ++k) dst[n][k] = *(const PG8_LAS bf16x8*)(lds + PG8_SB(b, h) + boff + n * 2048 + k * 1024); } while (0)
#define PG8_MMA(ai, bj, At, Bt) do { __builtin_amdgcn_s_setprio(1); _Pragma("unroll") for (int m = 0; m < 4; ++m) _Pragma("unroll") for (int n = 0; n < 2; ++n) { \
        if constexpr (FP8) { const i32x4 b0_ = __builtin_bit_cast(i32x4, Bt[n][0]), b1_ = __builtin_bit_cast(i32x4, Bt[n][1]), a0_ = __builtin_bit_cast(i32x4, At[m][0]), a1_ = __builtin_bit_cast(i32x4, At[m][1]); \
            const i32x8 B8_ = __builtin_shufflevector(b0_, b1_, 0, 1, 2, 3, 4, 5, 6, 7), A8_ = __builtin_shufflevector(a0_, a1_, 0, 1, 2, 3, 4, 5, 6, 7); \
            asm volatile("v_mfma_scale_f32_16x16x128_f8f6f4 %0, %1, %2, %0, %3, %3 op_sel:[0,1,0] op_sel_hi:[0,0,0]" : "+v"(acc[ai][bj][m][n]) : "v"(B8_), "v"(A8_), "v"(g.sc)); } \
        else { _Pragma("unroll") for (int k = 0; k < 2; ++k) acc[ai][bj][m][n] = __builtin_amdgcn_mfma_f32_16x16x32_bf16(Bt[n][k], At[m][k], acc[ai][bj][m][n], 0, 0, 0); } } \
        __builtin_amdgcn_s_setprio(0); } while (0)
#define PG8_WAIT_V(n) asm volatile("s_waitcnt vmcnt(" #n ")" ::: "memory")
#define PG8_WAIT_L(n) asm volatile("s_waitcnt lgkmcnt(" #n ")" ::: "memory")
#define PG8_BAR __builtin_amdgcn_s_barrier()
#define PG8_SCHED __builtin_amdgcn_sched_barrier(0)
    Unit cur, nxt; int ui = 0;
    if (!S.next(0, cur)) return;
    f32x4 acc[2][2][4][2];
#pragma unroll
    for (int a = 0; a < 2; ++a)
#pragma unroll
        for (int b = 0; b < 2; ++b)
#pragma unroll
            for (int m = 0; m < 4; ++m)
#pragma unroll
                for (int n = 0; n < 2; ++n) acc[a][b][m][n] = (f32x4){0.f, 0.f, 0.f, 0.f};
    bf16x8 At[4][2], B0[2][2], B1[2][2];
    const char* cA = cur.A; const char* cB = cur.B;
    S.a_ready(cur);
    if constexpr (SP2) {
        PG8_STAGE(PG8_SB(0, 0), cB, voffB); PG8_STAGE(PG8_SB(0, 1), cB + hstepB, voffB); PG8_STAGE(PG8_SA(0, 0), cA, voffA); PG8_STAGE(PG8_SA(0, 1), cA + hstepA, voffA);
        if (wr == 1) PG8_BAR;
        PG8_WAIT_V(2); PG8_BAR;
        PG8_STAGE(PG8_SB(1, 0), cB + kstep, voffB); PG8_STAGE(PG8_SA(1, 0), cA + kstep, voffA); PG8_STAGE(PG8_SB(1, 1), cB + hstepB + kstep, voffB);
        PG8_WAIT_V(6); PG8_BAR;
    } else {
        PG8_STAGE(PG8_SB(0, 0), cB, voffB); PG8_STAGE(PG8_SA(0, 0), cA, voffA); PG8_STAGE(PG8_SB(0, 1), cB + hstepB, voffB); PG8_STAGE(PG8_SA(0, 1), cA + hstepA, voffA);
        if (wr == 1) PG8_BAR;
        PG8_WAIT_V(4); PG8_BAR;
        PG8_STAGE(PG8_SB(1, 0), cB + kstep, voffB); PG8_STAGE(PG8_SA(1, 0), cA + kstep, voffA); PG8_STAGE(PG8_SB(1, 1), cB + hstepB + kstep, voffB);
        PG8_WAIT_V(6); PG8_BAR;
    }
    for (;;) {
        const bool has_next = S.next(ui + 1, nxt);
        const char* nA = has_next ? nxt.A : cA; const char* nB = has_next ? nxt.B : cB;
        for (int t = 0; t < nt; t += 2) {
            const bool last = (t == nt - 2);
            const char* a1 = cA + (size_t)(t + 1) * kstep;
            const char* a2 = last ? nA : cA + (size_t)(t + 2) * kstep; const char* b2 = last ? nB : cB + (size_t)(t + 2) * kstep;
            const char* a3 = a2 + kstep; const char* b3 = b2 + kstep;
            if (last && has_next) S.a_ready(nxt);
            if constexpr (SP2) {
            PG8_LDB(B0, 0, 0); PG8_LDB(B1, 0, 1); PG8_SCHED; PG8_LDA(At, 0, 0); PG8_STAGE(PG8_SA(1, 1), a1 + hstepA, voffA);
            PG8_WAIT_V(8); PG8_WAIT_L(0); PG8_BAR; PG8_MMA(0, 0, At, B0); PG8_MMA(0, 1, At, B1); PG8_BAR; PG8_SCHED;
            PG8_LDA(At, 0, 1); PG8_STAGE(PG8_SB(0, 0), b2, voffB); PG8_STAGE(PG8_SB(0, 1), b2 + hstepB, voffB); PG8_STAGE(PG8_SA(0, 0), a2, voffA);
            PG8_WAIT_V(8); PG8_WAIT_L(0); PG8_BAR; PG8_MMA(1, 0, At, B0); PG8_MMA(1, 1, At, B1); PG8_BAR; PG8_SCHED;
            PG8_LDB(B0, 1, 0); PG8_LDB(B1, 1, 1); PG8_SCHED; PG8_LDA(At, 1, 0); PG8_STAGE(PG8_SA(0, 1), a2 + hstepA, voffA);
            PG8_WAIT_V(8); PG8_WAIT_L(0); PG8_BAR; PG8_MMA(0, 0, At, B0); PG8_MMA(0, 1, At, B1); PG8_BAR; PG8_SCHED;
            PG8_LDA(At, 1, 1); PG8_STAGE(PG8_SB(1, 0), b3, voffB); PG8_STAGE(PG8_SB(1, 1), b3 + hstepB, voffB); PG8_STAGE(PG8_SA(1, 0), a3, voffA);
            PG8_WAIT_V(8); PG8_WAIT_L(0); PG8_BAR; PG8_MMA(1, 0, At, B0); PG8_MMA(1, 1, At, B1); PG8_BAR; PG8_SCHED;
            } else {
            PG8_LDB(B0, 0, 0); PG8_SCHED; PG8_LDA(At, 0, 0); PG8_STAGE(PG8_SA(1, 1), a1 + hstepA, voffA);
            PG8_WAIT_L(8); PG8_BAR; PG8_WAIT_L(0); PG8_MMA(0, 0, At, B0); PG8_BAR; PG8_SCHED;
            PG8_LDB(B1, 0, 1); PG8_STAGE(PG8_SB(0, 0), b2, voffB);
            PG8_BAR; PG8_WAIT_L(0); PG8_MMA(0, 1, At, B1); PG8_BAR;
            PG8_LDA(At, 0, 1); PG8_STAGE(PG8_SA(0, 0), a2, voffA);
            PG8_BAR; PG8_WAIT_L(0); PG8_MMA(1, 0, At, B0); PG8_BAR; PG8_SCHED;
            PG8_STAGE(PG8_SB(0, 1), b2 + hstepB, voffB);
            PG8_WAIT_V(6); PG8_BAR; PG8_MMA(1, 1, At, B1); PG8_BAR;
            PG8_LDB(B0, 1, 0); PG8_SCHED; PG8_LDA(At, 1, 0); PG8_STAGE(PG8_SA(0, 1), a2 + hstepA, voffA);
            PG8_WAIT_L(8); PG8_BAR; PG8_WAIT_L(0); PG8_MMA(0, 0, At, B0); PG8_BAR; PG8_SCHED;
            PG8_LDB(B1, 1, 1); PG8_STAGE(PG8_SB(1, 0), b3, voffB);
            PG8_BAR; PG8_WAIT_L(0); PG8_MMA(0, 1, At, B1); PG8_BAR;
            PG8_LDA(At, 1, 1); PG8_STAGE(PG8_SA(1, 0), a3, voffA);
            PG8_BAR; PG8_WAIT_L(0); PG8_MMA(1, 0, At, B0); PG8_BAR; PG8_SCHED;
            PG8_STAGE(PG8_SB(1, 1), b3 + hstepB, voffB);
            PG8_WAIT_V(6); PG8_BAR; PG8_MMA(1, 1, At, B1); PG8_BAR;
            }
        }
        if constexpr (ALIGN_EPI) { if (wr == 0) PG8_BAR; }
        if constexpr (FP8) asm volatile("s_nop 15\n\ts_nop 15\n\ts_nop 15" ::: "memory");
        if constexpr (!Epi::AFTER_DRAIN) { E(acc, cur, wr, wc); S.done(cur); }
        if (!has_next) break;
#pragma unroll
        for (int a = 0; a < 2; ++a)
#pragma unroll
            for (int b = 0; b < 2; ++b)
#pragma unroll
                for (int m = 0; m < 4; ++m)
#pragma unroll
                    for (int n = 0; n < 2; ++n) acc[a][b][m][n] = (f32x4){0.f, 0.f, 0.f, 0.f};
        cur = nxt; cA = nA; cB = nB; ++ui;
        if constexpr (ALIGN_EPI) { if (wr == 1) PG8_BAR; }
    }
    PG8_WAIT_V(0);
    if constexpr (!ALIGN_EPI) { if (wr == 0) PG8_BAR; }
    PG8_BAR;
    if constexpr (Epi::AFTER_DRAIN) { E.fused(acc, cur, wr, wc, fr, fq, lds, wid, lane); S.done(cur); }
#undef PG8_SA
#undef PG8_SB
#undef PG8_STAGE
#undef PG8_LDA
#undef PG8_LDB
#undef PG8_MMA
#undef PG8_WAIT_V
#undef PG8_WAIT_L
#undef PG8_BAR
#undef PG8_SCHED
}

}

#ifndef MOE_FP8
#define MOE_FP8 1
#endif
#ifndef FFN_FP8
#define FFN_FP8 0
#endif
constexpr size_t MiB = 1u << 20;
constexpr size_t WS_CTL = 0, CTL_ZERO_BYTES = 1 * MiB;
constexpr size_t WS_MOD = 1 * MiB;
constexpr size_t WS_TOK = 2 * MiB;
constexpr size_t WS_SB  = 3 * MiB;
constexpr size_t WS_POS = 6 * MiB;
constexpr size_t WS_XR  = 22 * MiB;
constexpr size_t WS_W   = 86 * MiB;
constexpr size_t W_WR = WS_W, W_WK = W_WR + 8 * MiB, W_WV = W_WK + 8 * MiB, W_WO = W_WV + 8 * MiB;
constexpr size_t W_WLD = W_WO + 8 * MiB, W_ALD = W_WLD + 1 * MiB, W_G1 = W_ALD + 1 * MiB;
constexpr size_t W_WLU = W_G1 + 1 * MiB, W_ALU = W_WLU + 2 * MiB, W_G2 = W_ALU + 2 * MiB;
constexpr size_t W_PW = W_G2 + 1 * MiB;
constexpr size_t W_F13 = W_PW + 2 * MiB;
constexpr size_t W_F2 = W_F13 + 44 * MiB;
constexpr size_t W_M13 = W_F2 + 22 * MiB;
constexpr size_t W_M2 = W_M13 + 448 * MiB;
constexpr size_t WS_A = W_M2 + 224 * MiB;
constexpr size_t A_A6 = WS_A, A6_STRIDE = 36 * MiB;
constexpr size_t A_R = WS_A + 216 * MiB, A_KX = WS_A + 248 * MiB, A_V = WS_A + 284 * MiB;
constexpr size_t A_LW = WS_A + 320 * MiB, A_LA = WS_A + 325 * MiB, A_G1O = WS_A + 330 * MiB;
constexpr size_t A_EW = WS_A + 336 * MiB, A_AA = WS_A + 408 * MiB;
constexpr size_t A_GATE = WS_A + 480 * MiB, A_YD = WS_A + 512 * MiB;
constexpr size_t A_AO = WS_A + 580 * MiB, A_YO = WS_A + 612 * MiB;
constexpr size_t A_H2 = WS_A, A_U = WS_A + 32 * MiB, A_YF = WS_A + 120 * MiB, A_HP = WS_A + 152 * MiB, A_PP = WS_A + 184 * MiB, A_YP = WS_A + 216 * MiB, A_H2B = WS_A + 248 * MiB;
constexpr size_t A_HG = WS_A + 280 * MiB, A_UG = WS_A + 352 * MiB, A_Y2 = WS_A + 604 * MiB;
constexpr size_t WS_PART = WS_A + 676 * MiB;
constexpr int MOE_KS = 7, MOE_RT = 64;
constexpr size_t WS_END = WS_PART + 112 * MiB;
static_assert(A_YO + 32 * MiB <= WS_PART && A_Y2 + (size_t)MROWS_PAD * D * 2 <= WS_END && A_UG + (size_t)MROWS_PAD * DFE * 2 <= A_Y2 && A_HG + (size_t)MROWS_PAD * D * 2 <= A_UG, "ws map");
static_assert(W_M13 + (size_t)NE * 2 * DFE * D * 2 == W_M2 && W_M2 + (size_t)NE * D * DFE * 2 == WS_A && W_F13 + (size_t)2 * DFF * D * 2 == W_F2, "weight map");
constexpr int CW_BAR = 4096;
constexpr int CW_GCNT = 16384;

constexpr int LDS_BYTES = 147456;
constexpr int MISC_OFF = 131072 + 320;

#define XB_TMO      128
#define XB_XCNT(j)  (256  + 64 * (j))
#define XB_XSUB(j)  (1280 + 64 * (j))
#define XB_XGEN(j)  (2304 + 64 * (j))
#define XB_TOP      3328
#define XB_TOPGEN   3392
#define XCD_BAR_WORDS 3456
#define XB_SPIN_CAP (1u << 18)
__device__ __forceinline__ unsigned xb_ld(unsigned* p)              { return __hip_atomic_load(p, __ATOMIC_RELAXED, __HIP_MEMORY_SCOPE_AGENT); }
__device__ __forceinline__ unsigned xb_add(unsigned* p, unsigned v) { return __hip_atomic_fetch_add(p, v, __ATOMIC_RELAXED, __HIP_MEMORY_SCOPE_AGENT); }
__device__ __forceinline__ unsigned xb_xcc_id() { return (unsigned)__builtin_amdgcn_s_getreg((3 << 11) | 20) & 0xFu; }
#define XB_SPIN(cond, bar) do { unsigned _sp = 0; while (cond) { __builtin_amdgcn_s_sleep(1); \
    if ((++_sp & 255u) == 0u) { if (xb_ld(&(bar)[XB_TMO])) break; if (_sp > XB_SPIN_CAP) { atomicAdd(&(bar)[XB_TMO], 1u); break; } } } } while (0)
struct XcdBarrier { unsigned* bar; unsigned x; volatile LAS unsigned* st; };
__device__ __forceinline__ XcdBarrier xcd_barrier_post(unsigned* bar, volatile LAS unsigned* st) {
    XcdBarrier b; b.bar = bar; b.x = xb_xcc_id(); b.st = st;
    if (threadIdx.x == 0) (void)xb_add(&bar[XB_XCNT(b.x)], 1u);
    return b;
}
__device__ __forceinline__ void xcd_barrier_complete(unsigned* bar, unsigned x, unsigned& nloc, unsigned& nx) {
    const unsigned G = gridDim.x * gridDim.y * gridDim.z;
    unsigned sum, cnt, mine, sp = 0u;
    for (;;) {
        sum = 0u; cnt = 0u; mine = 0u;
#pragma unroll
        for (unsigned j = 0; j < 16; ++j) { const unsigned c = xb_ld(&bar[XB_XCNT(j)]); sum += c; cnt += (c > 0u) ? 1u : 0u; mine = (j == x) ? c : mine; }
        if (sum == G) break;
        __builtin_amdgcn_s_sleep(1);
        if ((++sp & 255u) == 0u) { if (xb_ld(&bar[XB_TMO])) break; if (sp > XB_SPIN_CAP) { atomicAdd(&bar[XB_TMO], 1u); break; } }
    }
    nloc = mine > 0u ? mine : 1u; nx = cnt > 0u ? cnt : 1u;
}
__device__ __forceinline__ void xcd_barrier(const XcdBarrier& b) {
    asm volatile("s_waitcnt vmcnt(0)" ::: "memory");
    __syncthreads();
    if (threadIdx.x == 0) {
        unsigned* bar = b.bar;
        __builtin_amdgcn_s_waitcnt(0);
        unsigned nloc = b.st[0], nx = b.st[1];
        if (nloc == 0u) { xcd_barrier_complete(bar, b.x, nloc, nx); b.st[0] = nloc; b.st[1] = nx; }
        const unsigned old = xb_add(&bar[XB_XSUB(b.x)], 1u);
        const unsigned gen = old / nloc;
        if (old + 1u == (gen + 1u) * nloc) {
            __builtin_amdgcn_fence(__ATOMIC_RELEASE, "agent");
            asm volatile("s_waitcnt vmcnt(0)" ::: "memory");
            const unsigned og = xb_add(&bar[XB_TOP], 1u);
            const unsigned tg = og / nx;
            if (og + 1u == (tg + 1u) * nx) xb_add(&bar[XB_TOPGEN], 1u);
            else XB_SPIN(xb_ld(&bar[XB_TOPGEN]) == tg, bar);
            __builtin_amdgcn_fence(__ATOMIC_ACQUIRE, "agent");
            xb_add(&bar[XB_XGEN(b.x)], 1u);
            asm volatile("s_waitcnt vmcnt(0)" ::: "memory");
        } else {
            XB_SPIN(xb_ld(&bar[XB_XGEN(b.x)]) == gen, bar);
            __builtin_amdgcn_fence(__ATOMIC_ACQUIRE, "agent");
            asm volatile("s_waitcnt vmcnt(0)" ::: "memory");
        }
    }
    __syncthreads();
}

struct Args { const float* in[35]; float* out; unsigned char* ws; int ph_lo, ph_hi, li, pad; };
static_assert(sizeof(Args) == 35 * 8 + 8 + 8 + 16, "Args has no padding");
enum In { I_X = 0, I_C, I_CTX, I_CCTX, I_WMOD, I_BMOD, I_LNW, I_LNB, I_MU, I_WR, I_WK, I_WV, I_WO, I_DW0, I_DW1, I_DW2, I_IA0, I_IA1, I_IA2, I_G1, I_G2, I_KK, I_KA, I_RK, I_GNW, I_GNB,
          I_POOLW, I_POOLS, I_FW1, I_FW3, I_FW2, I_ROUTER, I_MW1, I_MW3, I_MW2 };
struct Frame {
    LAS unsigned char* lds; int wave, vcu, G, gw, NGW;
    unsigned char* ws; unsigned* ctl;
};
#define LDS_WAIT() asm volatile("s_waitcnt lgkmcnt(0)" ::: "memory")
__device__ __forceinline__ void unpack8(const u32x4 w, float (&f)[8]) { f[0] = bflo(w.x); f[1] = bfhi(w.x); f[2] = bflo(w.y); f[3] = bfhi(w.y); f[4] = bflo(w.z); f[5] = bfhi(w.z); f[6] = bflo(w.w); f[7] = bfhi(w.w); }

__device__ __forceinline__ void p0_mod(const Frame& F, const Args& a) {
    const int lane = lane_id(), tid = F.wave * 64 + lane; (void)tid;
    LAS float* sc = (LAS float*)F.lds;
    LAS float* red = (LAS float*)(F.lds + 40960);
    const float* c = a.in[I_C]; const float* cc = a.in[I_CCTX];
    for (int i = tid; i < 5 * D; i += 512) { const int j = i / D, k = i % D; const float v = j < 4 ? c[j * D + k] : cc[k]; sc[i] = siluf_(v); }
    __syncthreads();
    float* MOD = (float*)(F.ws + WS_MOD);
    const int x = lane & 15, q = lane >> 4;
    for (int u = blockIdx.x; u < 2 * (MOD_N / 64); u += F.G) {
        const int l = u / (MOD_N / 64), cb = u % (MOD_N / 64);
        const float* W = a.in[I_WMOD] + (size_t)l * D * MOD_N + cb * 64 + 4 * x;
        float acc[5][4];
#pragma unroll
        for (int j = 0; j < 5; ++j)
#pragma unroll
            for (int e = 0; e < 4; ++e) acc[j][e] = 0.f;
#pragma unroll 8
        for (int i = 0; i < 64; ++i) {
            const int k = F.wave * 256 + 4 * i + q;
            const f32x4 w = *(const f32x4*)(W + (size_t)k * MOD_N);
#pragma unroll
            for (int j = 0; j < 5; ++j) { const float s = sc[j * D + k];
#pragma unroll
                for (int e = 0; e < 4; ++e) acc[j][e] += s * w[e]; }
        }
#pragma unroll
        for (int j = 0; j < 5; ++j)
#pragma unroll
            for (int e = 0; e < 4; ++e) { float v = acc[j][e]; v += __shfl_xor(v, 16); v += __shfl_xor(v, 32); acc[j][e] = v; }
        __syncthreads();
        if (q == 0) {
#pragma unroll
            for (int j = 0; j < 5; ++j)
#pragma unroll
                for (int e = 0; e < 4; ++e) red[(F.wave * 5 + j) * 64 + 4 * x + e] = acc[j][e];
        }
        __syncthreads();
        if (tid < 320) { const int j = tid / 64, col = tid % 64; float s = 0.f;
#pragma unroll
            for (int w = 0; w < 8; ++w) s += red[(w * 5 + j) * 64 + col];
            MOD[(size_t)(l * 5 + j) * MOD_N + cb * 64 + col] = s + a.in[I_BMOD][l * MOD_N + cb * 64 + col]; }
    }
    __syncthreads();
}
__device__ __forceinline__ void p0_pos(const Frame& F) {
    const int lane = lane_id(), tid = F.wave * 64 + lane; (void)tid;
    float* POS = (float*)(F.ws + WS_POS);
    for (int t = F.gw; t < T; t += F.NGW) {
        const float frow = (float)(t >> 6), fcol = (float)(t & 63);
#pragma unroll
        for (int j = 0; j < 8; ++j) { const int c0 = 4 * lane + 256 * j; f32x4 o;
#pragma unroll
            for (int e = 0; e < 4; ++e) { const int c = c0 + e, qi = c >> 9, i = c & 511;
                const float omega = fexp(-(float)i * (9.21034037197618f / 512.0f));
                float rev = ((qi < 2) ? frow : fcol) * omega * 0.15915494309189535f;
                rev -= floorf(rev);
                o[e] = (qi & 1) ? __builtin_amdgcn_cosf(rev) : __builtin_amdgcn_sinf(rev); }
            *(f32x4*)(POS + (size_t)t * D + c0) = o; }
    }
}
constexpr int TN_F13 = FFN_FP8 ? 1408 : 2816, TN_F2 = FFN_FP8 ? 1408 : 2816, TN_M = MOE_FP8 ? 1792 : 3584;
constexpr int TI_RWKV = 4096, TI_F1 = TI_RWKV + TN_F13, TI_F3 = TI_F1 + TN_F13, TI_F2 = TI_F3 + TN_F2, TI_POOL = TI_F2 + 256, TI_M1 = TI_POOL + 8 * TN_M, TI_M3 = TI_M1 + 8 * TN_M, TI_M2 = TI_M3 + 8 * TN_M;
struct TrItem { const float* src; unsigned char* dst; int src_ld, dst_ld  , k0  , kbyte  , n0, drow0, f8; float sc; };
__device__ __forceinline__ TrItem tr_decode(const Frame& F, const Args& a, int it) {
    TrItem t; t.f8 = 0; t.sc = 1.0f; int kb, nb;
    if (it < TI_RWKV) { const int m = it >> 10, r = it & 1023; kb = r >> 5; nb = r & 31;
        t.src = a.in[I_WR + m]; t.src_ld = D; t.dst = F.ws + W_WR + (size_t)m * 8 * MiB; t.dst_ld = 2 * D; t.drow0 = 64 * nb; }
    else if (it < TI_F3) { const int w3 = it >= TI_F1, r = it - (w3 ? TI_F1 : TI_RWKV); kb = r / 88; nb = r % 88; const int n0 = 64 * nb;
        t.src = a.in[w3 ? I_FW3 : I_FW1]; t.src_ld = DFF; t.dst = F.ws + W_F13; t.dst_ld = FFN_FP8 ? D : 2 * D; t.drow0 = (n0 >> 7) * 256 + (n0 & 127) + 128 * w3; t.f8 = FFN_FP8; t.sc = FFN_FP8 ? 64.0f : 1.0f; }
    else if (it < TI_F2) { const int r = it - TI_F3; kb = r >> 5; nb = r & 31;
        t.src = a.in[I_FW2]; t.src_ld = D; t.dst = F.ws + W_F2; t.dst_ld = FFN_FP8 ? DFF : 2 * DFF; t.drow0 = 64 * nb; t.f8 = FFN_FP8; t.sc = FFN_FP8 ? 256.0f : 1.0f; }
    else if (it < TI_POOL) { const int r = it - TI_F2, g = r >> 6; kb = (r >> 3) & 7; nb = r & 7;
        t.src = a.in[I_POOLW] + (size_t)g * 512 * 512; t.src_ld = 512; t.dst = F.ws + W_PW + (size_t)g * 512 * 512 * 2; t.dst_ld = 2 * 512; t.drow0 = 64 * nb; }
    else if (it < TI_M3) { const int w3 = it >= TI_M1, r = it - (w3 ? TI_M1 : TI_POOL), e = r / TN_M, rr = r % TN_M; kb = rr / 112; nb = rr % 112; const int n0 = 64 * nb;
        t.src = a.in[w3 ? I_MW3 : I_MW1] + (size_t)e * D * DFE; t.src_ld = DFE; t.dst_ld = MOE_FP8 ? D : 2 * D; t.dst = F.ws + W_M13 + (size_t)e * 2 * DFE * t.dst_ld;
        t.drow0 = (n0 >> 7) * 256 + (n0 & 127) + 128 * w3; t.f8 = MOE_FP8; t.sc = MOE_FP8 ? 64.0f : 1.0f; }
    else { const int r = it - TI_M3, e = r / TN_M, rr = r % TN_M; kb = rr >> 5; nb = rr & 31;
        t.src = a.in[I_MW2] + (size_t)e * DFE * D; t.src_ld = D; t.dst_ld = MOE_FP8 ? DFE : 2 * DFE; t.dst = F.ws + W_M2 + (size_t)e * D * t.dst_ld; t.drow0 = 64 * nb; t.f8 = MOE_FP8; t.sc = MOE_FP8 ? 256.0f : 1.0f; }
    t.n0 = 64 * nb; t.kbyte = 128 * kb; t.k0 = t.f8 ? 128 * kb : 64 * kb; return t;
}
__device__ __forceinline__ void tr_load(const TrItem& t, int h, f32x4 (&r)[4][4], int lane) {
    const int x = lane & 15, q = lane >> 4; const float* p = t.src + (size_t)(t.k0 + 64 * h + 4 * q) * t.src_ld + t.n0 + 4 * x;
#pragma unroll
    for (int i = 0; i < 4; ++i)
#pragma unroll
        for (int s = 0; s < 4; ++s) r[i][s] = __builtin_nontemporal_load((const f32x4*)(p + (size_t)(16 * i + s) * t.src_ld));
}
__device__ __forceinline__ void tr_store(const TrItem& t, int h, const f32x4 (&r)[4][4], LAS unsigned* scr, int lane) {
    const int x = lane & 15, q = lane >> 4;
    if (t.f8) {
#pragma unroll
        for (int i = 0; i < 4; ++i)
#pragma unroll
            for (int jj = 0; jj < 4; ++jj) scr[(4 * x + jj) * 33 + 16 * h + 4 * i + q] = pk4_fp8(r[i][0][jj] * t.sc, r[i][1][jj] * t.sc, r[i][2][jj] * t.sc, r[i][3][jj] * t.sc);
        if (h == 0) return;
    } else {
#pragma unroll
        for (int i = 0; i < 4; ++i)
#pragma unroll
            for (int jj = 0; jj < 4; ++jj) { scr[(4 * x + jj) * 33 + 8 * i + 2 * q] = pk2(r[i][0][jj], r[i][1][jj]); scr[(4 * x + jj) * 33 + 8 * i + 2 * q + 1] = pk2(r[i][2][jj], r[i][3][jj]); }
    }
    LDS_WAIT();
    const int c = lane & 7;
#pragma unroll
    for (int rr = 0; rr < 8; ++rr) { const int n = (lane >> 3) + 8 * rr; const LAS unsigned* s = scr + n * 33 + 4 * c;
        u32x4 o; o.x = s[0]; o.y = s[1]; o.z = s[2]; o.w = s[3];
        *(u32x4*)(t.dst + (size_t)(t.drow0 + n) * t.dst_ld + t.kbyte + 16 * c) = o; }
    LDS_WAIT();
}
__device__ __forceinline__ void p0_transpose_range(const Frame& F, const Args& a, int lo, int hi, int gw, int ngw, LAS unsigned* scr) {
    const int lane = lane_id();
    int it = lo + gw; if (it >= hi) return;
    f32x4 ra[4][4], rb[4][4];
    TrItem ta = tr_decode(F, a, it), tb = ta; int ha = 0, hb = 0; tr_load(ta, 0, ra, lane);
    for (;;) {
        bool hasb; if (ta.f8 && ha == 0) { tb = ta; hb = 1; hasb = true; } else { it += ngw; hasb = it < hi; if (hasb) { tb = tr_decode(F, a, it); hb = 0; } }
        if (hasb) tr_load(tb, hb, rb, lane);
        tr_store(ta, ha, ra, scr, lane);
        if (!hasb) break;
        bool hasa; if (tb.f8 && hb == 0) { ta = tb; ha = 1; hasa = true; } else { it += ngw; hasa = it < hi; if (hasa) { ta = tr_decode(F, a, it); ha = 0; } }
        if (hasa) tr_load(ta, ha, ra, lane);
        tr_store(tb, hb, rb, scr, lane);
        if (!hasa) break;
    }
}
#if defined(PROBE_READ)
__device__ __forceinline__ void probe_read(const Frame& F, const Args& a) {
    const int lane = lane_id(); float acc = 0.f;
    for (int m = 0; m < 3; ++m) { const float* base = a.in[I_MW1 + m]; const size_t n16 = (size_t)NE * D * DFE / 4;
        if (PROBE_READ == 1) { for (size_t i = (size_t)F.gw * 64 + lane; i < n16; i += (size_t)F.NGW * 64 * 16) {
                f32x4 r[16];
#pragma unroll
                for (int u = 0; u < 16; ++u) { const size_t j = i + (size_t)u * F.NGW * 64; r[u] = j < n16 ? __builtin_nontemporal_load((const f32x4*)base + j) : (f32x4){0.f, 0.f, 0.f, 0.f}; }
#pragma unroll
                for (int u = 0; u < 16; ++u) acc += r[u][0] + r[u][3]; } }
        else { const int ld = (m == 2) ? D : DFE; const int nblk = ld / 64; const size_t rows = (size_t)NE * D * DFE / ld; const size_t items = rows / 64 * nblk; const int x = lane & 15, q = lane >> 4;
            for (size_t it = F.gw; it < items; it += F.NGW) { const size_t kb = it / nblk, nb = it % nblk; const float* p = base + (kb * 64 + 4 * q) * ld + nb * 64 + 4 * x;
                f32x4 r[16];
#pragma unroll
                for (int u = 0; u < 16; ++u) r[u] = __builtin_nontemporal_load((const f32x4*)(p + (size_t)((u >> 2) * 16 + (u & 3)) * ld));
#pragma unroll
                for (int u = 0; u < 16; ++u) acc += r[u][0] + r[u][3]; } }
    }
    if (acc == 1.2345e-30f) ((float*)(F.ws + WS_PART))[F.gw * 64 + lane] = acc;
}
#endif
__device__ __forceinline__ void p0_small(const Frame& F, const Args& a) {
    const int lane = lane_id(), tid = F.wave * 64 + lane; (void)tid;
    bf16_t* WLD = (bf16_t*)(F.ws + W_WLD); bf16_t* ALD = (bf16_t*)(F.ws + W_ALD); bf16_t* G1T = (bf16_t*)(F.ws + W_G1);
    bf16_t* WLU = (bf16_t*)(F.ws + W_WLU); bf16_t* ALU = (bf16_t*)(F.ws + W_ALU); bf16_t* G2T = (bf16_t*)(F.ws + W_G2);
    const int gt = F.gw * 64 + lane, NT_ = F.NGW * 64;
    for (int i = gt; i < 256 * D; i += NT_) { const int n = i >> 11, k = i & 2047;
        float w = 0.f, v = 0.f;
        if (n < 192) { const int d = n >= 96, nn = n - 96 * d; w = a.in[I_DW1][((size_t)d * D + k) * 96 + nn]; v = a.in[I_IA1][((size_t)d * D + k) * 96 + nn]; }
        WLD[i] = (bf16_t)f2bf(w); ALD[i] = (bf16_t)f2bf(v); G1T[i] = (bf16_t)f2bf(a.in[I_G1][(size_t)k * 256 + n]); }
    for (int i = gt; i < 2 * D * 256; i += NT_) { const int n = i >> 8, k = i & 255, d = n >> 11, cidx = n & 2047, kk = k - 96 * d;
        float w = 0.f, v = 0.f;
        if (kk >= 0 && kk < 96) { w = a.in[I_DW2][((size_t)d * 96 + kk) * D + cidx]; v = a.in[I_IA2][((size_t)d * 96 + kk) * D + cidx]; }
        WLU[i] = (bf16_t)f2bf(w); ALU[i] = (bf16_t)f2bf(v); }
    for (int i = gt; i < D * 256; i += NT_) { const int n = i >> 8, k = i & 255; G2T[i] = (bf16_t)f2bf(a.in[I_G2][(size_t)k * D + n]); }
}

__device__ __forceinline__ void p1_mix(const Frame& F, const Args& a) {
    const int lane = lane_id();
    const float* MOD = (const float*)(F.ws + WS_MOD); const float* POS = (const float*)(F.ws + WS_POS);
    float* XR = (float*)(F.ws + WS_XR);
    for (int it = F.gw; it < (MT / 8) * 8; it += F.NGW) {
        const int blk = it >> 3, j = it & 7, m0 = blk * 8; const bool lat = m0 < ML;
        int t0, Tseq, modrow; const float* xs;
        if (lat) { t0 = m0 % T; Tseq = T; modrow = m0 / T; xs = a.in[I_X] + (size_t)m0 * D; }
        else { const int mm = m0 - ML; t0 = mm % TC; Tseq = TC; modrow = 4; xs = a.in[I_CTX] + (size_t)mm * D; }
        const float* sh = MOD + (size_t)modrow * MOD_N; const float* scp = sh + D;
        const float* ps = POS + (size_t)t0 * D;
        const int c = 4 * lane + 256 * j;
        f32x4 xr[10];
#pragma unroll
        for (int i = 0; i < 10; ++i) { const int tr = t0 - 1 + i; const bool ok = tr >= 0 && tr < Tseq; const int ro = ok ? i - 1 : 0;
            xr[i] = *(const f32x4*)(xs + (ptrdiff_t)ro * D + c); if (lat) xr[i] += *(const f32x4*)(ps + (ptrdiff_t)ro * D + c); }
        const f32x4 shv = *(const f32x4*)(sh + c); const f32x4 scv = *(const f32x4*)(scp + c) + 1.0f;
        f32x4 mu[6];
#pragma unroll
        for (int n = 0; n < 6; ++n) mu[n] = *(const f32x4*)(a.in[I_MU] + n * D + c);
        f32x4 h[10];
#pragma unroll
        for (int i = 0; i < 10; ++i) { const int tr = t0 - 1 + i; const bool ok = tr >= 0 && tr < Tseq; h[i] = ok ? xr[i] * scv + shv : (f32x4){0.f, 0.f, 0.f, 0.f}; }
#pragma unroll
        for (int r = 0; r < 8; ++r) {
            const f32x4 h0 = h[r + 1], xx = (h[r] + h[r + 2]) * 0.5f - h0;
            const size_t o = (size_t)(m0 + r) * D + c;
#pragma unroll
            for (int n = 0; n < 6; ++n) { if (!lat && (n == 0 || n == 5)) continue;
                const f32x4 v = h0 + xx * mu[n]; u32x2 w; w.x = pk2(v[0], v[1]); w.y = pk2(v[2], v[3]);
                *(u32x2*)((bf16_t*)(F.ws + A_A6 + (size_t)n * A6_STRIDE) + o) = w; }
            if (lat) *(f32x4*)(XR + o) = xr[r + 1];
        }
    }
}

__device__ __forceinline__ void p4_scan(const Frame& F, const Args& a) {
    const int lane = lane_id(), tid = F.wave * 64 + lane; (void)tid;
    LAS float* OP = (LAS float*)F.lds;
    LAS float* YS = (LAS float*)(F.lds + 49152);
    const bf16_t* KX = (const bf16_t*)(F.ws + A_KX); const bf16_t* VV = (const bf16_t*)(F.ws + A_V); const bf16_t* RR = (const bf16_t*)(F.ws + A_R);
    const bf16_t* EW = (const bf16_t*)(F.ws + A_EW); const bf16_t* AA = (const bf16_t*)(F.ws + A_AA);
    const int tl = tid >> 5, cp = tid & 31, vi = tid >> 3, kg = tid & 7;
    for (int s = blockIdx.x; s < NB * NH * 2; s += F.G) {
        const int b = s >> 6, h = (s >> 1) & 31, d = s & 1;
        const int ch = h * HS + 2 * cp;
        const float kkc0 = a.in[I_KK][ch], kkc1 = a.in[I_KK][ch + 1], kac0 = a.in[I_KA][ch], kac1 = a.in[I_KA][ch + 1], rkc0 = a.in[I_RK][ch], rkc1 = a.in[I_RK][ch + 1];
        bf16_t* YD = (bf16_t*)(F.ws + A_YD + (size_t)d * 32 * MiB); float* SB = (float*)(F.ws + WS_SB) + (size_t)d * ML * NH;
        float S[8];
#pragma unroll
        for (int j = 0; j < 8; ++j) S[j] = 0.f;
        unsigned rk = 0, rv = 0, rr = 0, re = 0, ra = 0;
#define SCAN_ROW0(ci) (((ci) < 16) ? (ML + b * TC + (d ? 15 - (ci) : (ci)) * 16) : (b * T + (d ? 127 - ((ci) - 16) : ((ci) - 16)) * 16))
#define SCAN_LOAD(ci) do { const int row_ = SCAN_ROW0(ci) + tl; const size_t o_ = (size_t)row_ * D + ch, o2_ = (size_t)row_ * (2 * D) + d * D + ch; \
        rk = *(const unsigned*)(KX + o_); rv = *(const unsigned*)(VV + o_); rr = ((ci) >= 16) ? *(const unsigned*)(RR + o_) : 0u; re = *(const unsigned*)(EW + o2_); ra = *(const unsigned*)(AA + o2_); } while (0)
#define SCAN_PREP(ci) do { LAS float* B_ = OP + ((ci) & 1) * 6144 + tl * 64 + 2 * cp; \
        const float k0 = bflo(rk), k1 = bfhi(rk), q0 = k0 * kkc0, q1 = k1 * kkc1; float n2 = q0 * q0 + q1 * q1; \
        n2 += __shfl_xor(n2, 1); n2 += __shfl_xor(n2, 2); n2 += __shfl_xor(n2, 4); n2 += __shfl_xor(n2, 8); n2 += __shfl_xor(n2, 16); \
        const float inv = 1.0f / fmaxf(sqrtf(n2), 1e-12f), kn0 = q0 * inv, kn1 = q1 * inv; \
        const float a0 = bflo(ra), a1 = bfhi(ra), kd0 = k0 * (1.0f + (a0 - 1.0f) * kac0), kd1 = k1 * (1.0f + (a1 - 1.0f) * kac1); \
        const float r0 = bflo(rr), r1 = bfhi(rr); \
        *(LAS f32x2*)(B_ + 0 * 1024) = (f32x2){kn0, kn1}; \
        *(LAS f32x2*)(B_ + 1 * 1024) = (f32x2){fexp(-bflo(re)), fexp(-bfhi(re))}; \
        *(LAS f32x2*)(B_ + 2 * 1024) = (f32x2){kn0 * a0, kn1 * a1}; \
        *(LAS f32x2*)(B_ + 3 * 1024) = (f32x2){kd0, kd1}; \
        *(LAS f32x2*)(B_ + 4 * 1024) = (f32x2){r0, r1}; \
        *(LAS f32x2*)(B_ + 5 * 1024) = (f32x2){bflo(rv), bfhi(rv)}; \
        if ((ci) >= 16) { float sb = r0 * kd0 * rkc0 + r1 * kd1 * rkc1; \
            sb += __shfl_xor(sb, 1); sb += __shfl_xor(sb, 2); sb += __shfl_xor(sb, 4); sb += __shfl_xor(sb, 8); sb += __shfl_xor(sb, 16); \
            if (cp == 0) SB[(size_t)(SCAN_ROW0(ci) + tl) * NH + h] = sb; } } while (0)
        __syncthreads();
        SCAN_LOAD(0); SCAN_PREP(0);
        __syncthreads();
        for (int ci = 0; ci < 144; ++ci) {
            if (ci + 1 < 144) SCAN_LOAD(ci + 1);
            const LAS float* B = OP + (ci & 1) * 6144; LAS float* Y = YS + (ci & 1) * 1024;
#pragma unroll 4
            for (int st = 0; st < 16; ++st) {
                const int tk = d ? 15 - st : st; const LAS float* p = B + tk * 64 + 8 * kg;
                const f32x4 kkA = *(const LAS f32x4*)(p), kkB = *(const LAS f32x4*)(p + 4);
                const f32x4 wA = *(const LAS f32x4*)(p + 1024), wB = *(const LAS f32x4*)(p + 1028);
                const f32x4 bA = *(const LAS f32x4*)(p + 2048), bB = *(const LAS f32x4*)(p + 2052);
                const f32x4 dA = *(const LAS f32x4*)(p + 3072), dB = *(const LAS f32x4*)(p + 3076);
                const f32x4 rA = *(const LAS f32x4*)(p + 4096), rB = *(const LAS f32x4*)(p + 4100);
                const float v = B[5 * 1024 + tk * 64 + vi];
                float sa = (S[0] * kkA[0] + S[1] * kkA[1]) + (S[2] * kkA[2] + S[3] * kkA[3]) + (S[4] * kkB[0] + S[5] * kkB[1]) + (S[6] * kkB[2] + S[7] * kkB[3]);
                sa = sum8(sa);
#pragma unroll
                for (int j = 0; j < 4; ++j) { S[j] = S[j] * wA[j] + (v * dA[j] - sa * bA[j]); S[4 + j] = S[4 + j] * wB[j] + (v * dB[j] - sa * bB[j]); }
                float y = (S[0] * rA[0] + S[1] * rA[1]) + (S[2] * rA[2] + S[3] * rA[3]) + (S[4] * rB[0] + S[5] * rB[1]) + (S[6] * rB[2] + S[7] * rB[3]);
                y = sum8(y);
                if (kg == 0) Y[tk * 64 + vi] = y;
            }
            if (ci + 1 < 144) SCAN_PREP(ci + 1);
            __syncthreads();
            if (ci >= 16) { const f32x2 yv = *(const LAS f32x2*)(Y + tl * 64 + 2 * cp);
                *(unsigned*)(YD + (size_t)(SCAN_ROW0(ci) + tl) * D + ch) = pk2(yv.x, yv.y); }
        }
#undef SCAN_ROW0
#undef SCAN_LOAD
#undef SCAN_PREP
    }
    __syncthreads();
}

constexpr int SL_KA = 0, SL_RM = 2048, SL_BK = 4096, SL_VC = 8192, SL_ARK = 10240, SL_AAK = 11264, SL_TN = 11776, SL_GC = 12288, SL_BYTES = 12544;
constexpr int SC_PAR = 8 * SL_BYTES;
typedef short s16x8 __attribute__((ext_vector_type(8)));
__device__ __forceinline__ s16x8 mk8(unsigned a, unsigned b, unsigned c, unsigned d) { u32x4 v; v.x = a; v.y = b; v.z = c; v.w = d; return __builtin_bit_cast(s16x8, v); }
__device__ __forceinline__ f32x4 mfma16(s16x8 a, s16x8 b, f32x4 c) { return __builtin_amdgcn_mfma_f32_16x16x32_bf16(a, b, c, 0, 0, 0); }
__device__ __forceinline__ s16x8 mk_d(const f32x4 x) { return mk8(pk2(x[0], x[1]), pk2(x[2], x[3]), 0u, 0u); }
__device__ __forceinline__ void p4_scan2(const Frame& F, const Args& a, unsigned char* yd_base, float* sb_base) {
    const int lane = lane_id(), tt = lane & 15, q = lane >> 4;
    const bf16_t* KX = (const bf16_t*)(F.ws + A_KX); const bf16_t* VV = (const bf16_t*)(F.ws + A_V); const bf16_t* RR = (const bf16_t*)(F.ws + A_R);
    const bf16_t* EW = (const bf16_t*)(F.ws + A_EW); const bf16_t* AA = (const bf16_t*)(F.ws + A_AA);
    LAS unsigned char* slot_w = F.lds + F.wave * SL_BYTES;
    LAS float* PAR = (LAS float*)(F.lds + SC_PAR);
    s16x8 SelF[2];
#pragma unroll
    for (int sel = 0; sel < 2; ++sel) { unsigned w[4];
#pragma unroll
        for (int jj = 0; jj < 4; ++jj) { const int j0 = 2 * jj, j1 = 2 * jj + 1; const bool h0 = (q == (tt >> 2)) && (j0 == 4 * sel + (tt & 3)), h1 = (q == (tt >> 2)) && (j1 == 4 * sel + (tt & 3));
            w[jj] = (h0 ? 0x3f80u : 0u) | (h1 ? 0x3f800000u : 0u); }
        SelF[sel] = mk8(w[0], w[1], w[2], w[3]); }
    for (int s = blockIdx.x; s < NB * NH * 2; s += F.G) {
        const int b = s >> 6, h = (s >> 1) & 31, d = s & 1;
        bf16_t* YD = (bf16_t*)(yd_base + (size_t)d * 32 * MiB); float* SB = sb_base + (size_t)d * ML * NH;
        __syncthreads();
        if (F.wave == 0) { PAR[lane] = a.in[I_KK][h * HS + lane]; PAR[64 + lane] = a.in[I_KA][h * HS + lane]; PAR[128 + lane] = a.in[I_RK][h * HS + lane]; }
        __syncthreads();
        f32x4 G[4];
#pragma unroll
        for (int tk = 0; tk < 4; ++tk) G[tk] = (f32x4){0.f, 0.f, 0.f, 0.f};
#define S2_ROW0(ci) (((ci) < 16) ? (ML + b * TC + (d ? 15 - (ci) : (ci)) * 16) : (b * T + (d ? 127 - ((ci) - 16) : ((ci) - 16)) * 16))
        u32x2 rk[4], rv[4], rr[4], re[4], ra[4];
#define S2_LOAD(ci) do { const int row_ = S2_ROW0(ci) + (d ? 15 - tt : tt); const size_t o_ = (size_t)row_ * D + h * HS + 4 * q, o2_ = (size_t)row_ * (2 * D) + d * D + h * HS + 4 * q; \
        _Pragma("unroll") for (int g_ = 0; g_ < 4; ++g_) { rk[g_] = *(const u32x2*)(KX + o_ + 16 * g_); rv[g_] = *(const u32x2*)(VV + o_ + 16 * g_); \
            rr[g_] = ((ci) >= 16) ? *(const u32x2*)(RR + o_ + 16 * g_) : (u32x2){0u, 0u}; re[g_] = *(const u32x2*)(EW + o2_ + 16 * g_); ra[g_] = *(const u32x2*)(AA + o2_ + 16 * g_); } } while (0)
        S2_LOAD(F.wave);
        for (int rnd = 0; rnd < 18; ++rnd) {
            const int ci = rnd * 8 + F.wave; const bool lat = rnd >= 2;
            {
                float kf[4][4], af[4][4], ef[4][4], vf[4][4], rf[4][4];
#pragma unroll
                for (int g = 0; g < 4; ++g) {
                    kf[g][0] = bflo(rk[g].x); kf[g][1] = bfhi(rk[g].x); kf[g][2] = bflo(rk[g].y); kf[g][3] = bfhi(rk[g].y);
                    af[g][0] = bflo(ra[g].x); af[g][1] = bfhi(ra[g].x); af[g][2] = bflo(ra[g].y); af[g][3] = bfhi(ra[g].y);
                    ef[g][0] = bflo(re[g].x); ef[g][1] = bfhi(re[g].x); ef[g][2] = bflo(re[g].y); ef[g][3] = bfhi(re[g].y);
                    vf[g][0] = bflo(rv[g].x); vf[g][1] = bfhi(rv[g].x); vf[g][2] = bflo(rv[g].y); vf[g][3] = bfhi(rv[g].y);
                    rf[g][0] = bflo(rr[g].x); rf[g][1] = bfhi(rr[g].x); rf[g][2] = bflo(rr[g].y); rf[g][3] = bfhi(rr[g].y); }
                unsigned VP[4][2];
#pragma unroll
                for (int g = 0; g < 4; ++g) { VP[g][0] = rv[g].x; VP[g][1] = rv[g].y; }
                if (rnd + 1 < 18) S2_LOAD((rnd + 1) * 8 + F.wave);
                float kkv[4][4]; float n2 = 0.f;
#pragma unroll
                for (int g = 0; g < 4; ++g) { const f32x4 kc = *(const LAS f32x4*)(PAR + 16 * g + 4 * q);
#pragma unroll
                    for (int i = 0; i < 4; ++i) { kkv[g][i] = kf[g][i] * kc[i]; n2 += kkv[g][i] * kkv[g][i]; } }
                n2 += __shfl_xor(n2, 16); n2 += __shfl_xor(n2, 32);
                const float inv = 1.0f / fmaxf(sqrtf(n2), 1e-12f);
                float sb = 0.f;
                unsigned KaP[4][2], BmP[4][2], KmP[4][2], RmP[4][2]; f32x4 gend[4];
#pragma unroll
                for (int g = 0; g < 4; ++g) { const f32x4 kac = *(const LAS f32x4*)(PAR + 64 + 16 * g + 4 * q), rkc = *(const LAS f32x4*)(PAR + 128 + 16 * g + 4 * q);
                    float ka_[4], bm_[4], km_[4], rm_[4];
#pragma unroll
                    for (int i = 0; i < 4; ++i) {
                        float L = ef[g][i];
                        L += dpp_f<0x111>(L); L += dpp_f<0x112>(L); L += dpp_f<0x114>(L); L += dpp_f<0x118>(L);
                        const float gt = fexp(-L), gi = fexp(L), gm1 = fexp(ef[g][i] - L);
                        const float kk = kkv[g][i] * inv, kd = kf[g][i] * (1.0f + (af[g][i] - 1.0f) * kac[i]);
                        ka_[i] = kk * gm1; bm_[i] = kk * af[g][i] * gi; km_[i] = kd * gi; rm_[i] = rf[g][i] * gt;
                        sb += rf[g][i] * kd * rkc[i]; gend[g][i] = gt; }
                    KaP[g][0] = pk2(ka_[0], ka_[1]); KaP[g][1] = pk2(ka_[2], ka_[3]); BmP[g][0] = pk2(bm_[0], bm_[1]); BmP[g][1] = pk2(bm_[2], bm_[3]);
                    KmP[g][0] = pk2(km_[0], km_[1]); KmP[g][1] = pk2(km_[2], km_[3]); RmP[g][0] = pk2(rm_[0], rm_[1]); RmP[g][1] = pk2(rm_[2], rm_[3]);
                }
                if (lat) { sb += __shfl_xor(sb, 16); sb += __shfl_xor(sb, 32); if (q == 0) SB[(size_t)(S2_ROW0(ci) + (d ? 15 - tt : tt)) * NH + h] = sb; }
                s16x8 KaF[2], BmF[2], KmF[2], RmF[2], VF[2];
#pragma unroll
                for (int kb = 0; kb < 2; ++kb) { KaF[kb] = mk8(KaP[2 * kb][0], KaP[2 * kb][1], KaP[2 * kb + 1][0], KaP[2 * kb + 1][1]); BmF[kb] = mk8(BmP[2 * kb][0], BmP[2 * kb][1], BmP[2 * kb + 1][0], BmP[2 * kb + 1][1]);
                    KmF[kb] = mk8(KmP[2 * kb][0], KmP[2 * kb][1], KmP[2 * kb + 1][0], KmP[2 * kb + 1][1]); RmF[kb] = mk8(RmP[2 * kb][0], RmP[2 * kb][1], RmP[2 * kb + 1][0], RmP[2 * kb + 1][1]);
                    VF[kb] = mk8(VP[2 * kb][0], VP[2 * kb][1], VP[2 * kb + 1][0], VP[2 * kb + 1][1]); }
                const f32x4 Z = (f32x4){0.f, 0.f, 0.f, 0.f};
                f32x4 Nd = mfma16(KaF[1], BmF[1], mfma16(KaF[0], BmF[0], Z));
                f32x4 Nt = mfma16(BmF[1], KaF[1], mfma16(BmF[0], KaF[0], Z));
                f32x4 AakT = mfma16(KmF[1], KaF[1], mfma16(KmF[0], KaF[0], Z));
                f32x4 ArbT = mfma16(BmF[1], RmF[1], mfma16(BmF[0], RmF[0], Z));
                f32x4 ArkT = mfma16(KmF[1], RmF[1], mfma16(KmF[0], RmF[0], Z));
                f32x4 Q0;
#pragma unroll
                for (int r = 0; r < 4; ++r) { const int row = 4 * q + r;
                    Nd[r] = row > tt ? Nd[r] : 0.f; Nt[r] = row < tt ? Nt[r] : 0.f; AakT[r] = row < tt ? AakT[r] : 0.f; ArbT[r] = row <= tt ? ArbT[r] : 0.f; ArkT[r] = row <= tt ? ArkT[r] : 0.f;
                    Q0[r] = (row == tt ? 1.0f : 0.f) - Nt[r]; }
                const s16x8 oN = mk_d(Nd), oNt = mk_d(Nt);
                const f32x4 N2 = mfma16(oNt, oN, Z), N2t = mfma16(oN, oNt, Z);
                const s16x8 oN2 = mk_d(N2), oN2t = mk_d(N2t);
                const f32x4 N4 = mfma16(oN2t, oN2, Z), N4t = mfma16(oN2, oN2t, Z);
                const s16x8 oN4 = mk_d(N4), oN4t = mk_d(N4t);
                const f32x4 N8 = mfma16(oN4t, oN4, Z);
                const f32x4 Q1 = mfma16(oN2, mk_d(Q0), Q0);
                const f32x4 Q2 = mfma16(oN4, mk_d(Q1), Q1);
                const f32x4 Q3 = mfma16(mk_d(N8), mk_d(Q2), Q2);
                *(LAS u32x4*)(slot_w + SL_KA + lane * 16) = __builtin_bit_cast(u32x4, KaF[0]); *(LAS u32x4*)(slot_w + SL_KA + 1024 + lane * 16) = __builtin_bit_cast(u32x4, KaF[1]);
                *(LAS u32x4*)(slot_w + SL_RM + lane * 16) = __builtin_bit_cast(u32x4, RmF[0]); *(LAS u32x4*)(slot_w + SL_RM + 1024 + lane * 16) = __builtin_bit_cast(u32x4, RmF[1]);
                *(LAS u32x2*)(slot_w + SL_TN + lane * 8) = (u32x2){pk2(-Q3[0], -Q3[1]), pk2(-Q3[2], -Q3[3])};
                *(LAS u32x2*)(slot_w + SL_AAK + lane * 8) = (u32x2){pk2(AakT[0], AakT[1]), pk2(AakT[2], AakT[3])};
                *(LAS u32x4*)(slot_w + SL_ARK + lane * 16) = (u32x4){pk2(ArbT[0], ArbT[1]), pk2(ArbT[2], ArbT[3]), pk2(ArkT[0], ArkT[1]), pk2(ArkT[2], ArkT[3])};
#pragma unroll
                for (int kb = 0; kb < 2; ++kb)
#pragma unroll
                    for (int sel = 0; sel < 2; ++sel) { const int tk = 2 * kb + sel;
                        const f32x4 DB = mfma16(BmF[kb], SelF[sel], Z), DK = mfma16(KmF[kb], SelF[sel], Z), DV = mfma16(VF[kb], SelF[sel], Z);
                        *(LAS u32x4*)(slot_w + SL_BK + tk * 1024 + lane * 16) = (u32x4){pk2(DB[0], DB[1]), pk2(DB[2], DB[3]), pk2(DK[0], DK[1]), pk2(DK[2], DK[3])};
                        *(LAS u32x2*)(slot_w + SL_VC + tk * 512 + lane * 8) = (u32x2){pk2(DV[0], DV[1]), pk2(DV[2], DV[3])}; }
                if (tt == 15) {
#pragma unroll
                    for (int g = 0; g < 4; ++g) *(LAS f32x4*)(slot_w + SL_GC + (g * 4 + q) * 16) = gend[g]; }
            }
            __syncthreads();
            if (F.wave < 4) {
                const int tv = F.wave;
                for (int sl = 0; sl < 8; ++sl) {
                    LAS unsigned char* S = F.lds + sl * SL_BYTES; const int cj = rnd * 8 + sl;
                    const s16x8 KA0 = __builtin_bit_cast(s16x8, *(LAS u32x4*)(S + SL_KA + lane * 16)), KA1 = __builtin_bit_cast(s16x8, *(LAS u32x4*)(S + SL_KA + 1024 + lane * 16));
                    const u32x2 aak = *(LAS u32x2*)(S + SL_AAK + lane * 8), tn = *(LAS u32x2*)(S + SL_TN + lane * 8), vc = *(LAS u32x2*)(S + SL_VC + tv * 512 + lane * 8);
                    const s16x8 Gb0 = mk8(pk2(G[0][0], G[0][1]), pk2(G[0][2], G[0][3]), pk2(G[1][0], G[1][1]), pk2(G[1][2], G[1][3]));
                    const s16x8 Gb1 = mk8(pk2(G[2][0], G[2][1]), pk2(G[2][2], G[2][3]), pk2(G[3][0], G[3][1]), pk2(G[3][2], G[3][3]));
                    const f32x4 Z = (f32x4){0.f, 0.f, 0.f, 0.f};
                    f32x4 P = mfma16(KA0, Gb0, Z); P = mfma16(KA1, Gb1, P); P = mfma16(mk8(aak.x, aak.y, 0u, 0u), mk8(vc.x, vc.y, 0u, 0u), P);
                    const f32x4 U = mfma16(mk8(tn.x, tn.y, 0u, 0u), mk_d(P), Z);
                    const s16x8 UV = mk8(pk2(U[0], U[1]), pk2(U[2], U[3]), vc.x, vc.y);
                    if (lat) {
                        const s16x8 RM0 = __builtin_bit_cast(s16x8, *(LAS u32x4*)(S + SL_RM + lane * 16)), RM1 = __builtin_bit_cast(s16x8, *(LAS u32x4*)(S + SL_RM + 1024 + lane * 16));
                        const s16x8 ARK = __builtin_bit_cast(s16x8, *(LAS u32x4*)(S + SL_ARK + lane * 16));
                        f32x4 Y = mfma16(Gb0, RM0, Z); Y = mfma16(Gb1, RM1, Y); Y = mfma16(UV, ARK, Y);
                        *(u32x2*)(YD + (size_t)(S2_ROW0(cj) + (d ? 15 - tt : tt)) * D + h * HS + 16 * tv + 4 * q) = (u32x2){pk2(Y[0], Y[1]), pk2(Y[2], Y[3])};
                    }
#pragma unroll
                    for (int tk = 0; tk < 4; ++tk) { const s16x8 BK = __builtin_bit_cast(s16x8, *(LAS u32x4*)(S + SL_BK + tk * 1024 + lane * 16));
                        G[tk] = mfma16(BK, UV, G[tk]); G[tk] = G[tk] * *(LAS f32x4*)(S + SL_GC + (tk * 4 + q) * 16); }
                }
            }
            __syncthreads();
        }
#undef S2_ROW0
#undef S2_LOAD
    }
    __syncthreads();
}

#if defined(PROBE_SCANCHK)
constexpr int CW_CHK = 20480;
__device__ __forceinline__ void p4_compare(const Frame& F) {
    const int lane = lane_id();
    const bf16_t* Y0 = (const bf16_t*)(F.ws + A_YD); const bf16_t* Y1 = (const bf16_t*)(F.ws + A_AO);
    const float* S0 = (const float*)(F.ws + WS_SB); const float* S1 = (const float*)(F.ws + WS_A + 644 * MiB);
    float num = 0.f, den = 0.f, num2 = 0.f, den2 = 0.f;
    for (size_t i = (size_t)F.gw * 64 + lane; i < (size_t)2 * ML * D / 8; i += (size_t)F.NGW * 64) { float a8[8], b8[8]; unpack8(((const u32x4*)Y0)[i], a8); unpack8(((const u32x4*)Y1)[i], b8);
#pragma unroll
        for (int e = 0; e < 8; ++e) { const float dd = b8[e] - a8[e]; num += dd * dd; den += a8[e] * a8[e]; } }
    for (size_t i = (size_t)F.gw * 64 + lane; i < (size_t)2 * ML * NH; i += (size_t)F.NGW * 64) { const float dd = S1[i] - S0[i]; num2 += dd * dd; den2 += S0[i] * S0[i]; }
    num = wave_sum(num); den = wave_sum(den); num2 = wave_sum(num2); den2 = wave_sum(den2);
    if (lane == 0) { atomicAdd((float*)(F.ctl + CW_CHK), num); atomicAdd((float*)(F.ctl + CW_CHK + 64), den); atomicAdd((float*)(F.ctl + CW_CHK + 128), num2); atomicAdd((float*)(F.ctl + CW_CHK + 192), den2); }
}
#endif
__device__ __forceinline__ void p5_ao(const Frame& F, const Args& a) {
    const int lane = lane_id(), tid = F.wave * 64 + lane; (void)tid;
    const bf16_t* Y0 = (const bf16_t*)(F.ws + A_YD); const bf16_t* Y1 = (const bf16_t*)(F.ws + A_YD + 32 * MiB);
    const bf16_t* VV = (const bf16_t*)(F.ws + A_V); const bf16_t* GT = (const bf16_t*)(F.ws + A_GATE); bf16_t* AO = (bf16_t*)(F.ws + A_AO);
    const float* SB0 = (const float*)(F.ws + WS_SB); const float* SB1 = SB0 + (size_t)ML * NH;
    for (int m = F.gw; m < ML; m += F.NGW) {
#pragma unroll
        for (int j = 0; j < 4; ++j) {
            const int c = 8 * lane + 512 * j, hd = c >> 6; const size_t o = (size_t)m * D + c;
            float y0[8], y1[8], vv[8], gg[8], y[8];
            unpack8(*(const u32x4*)(Y0 + o), y0); unpack8(*(const u32x4*)(Y1 + o), y1); unpack8(*(const u32x4*)(VV + o), vv); unpack8(*(const u32x4*)(GT + o), gg);
            float s = 0.f;
#pragma unroll
            for (int e = 0; e < 8; ++e) { y[e] = y0[e] + y1[e]; s += y[e]; }
            s = sum8(s); const float mean = s * (1.0f / 64.0f); float qv = 0.f;
#pragma unroll
            for (int e = 0; e < 8; ++e) { y[e] -= mean; qv += y[e] * y[e]; }
            qv = sum8(qv); const float rstd = 1.0f / sqrtf(qv * (1.0f / 64.0f) + GN_EPS);
            const float sb = SB0[(size_t)m * NH + hd] + SB1[(size_t)m * NH + hd];
            const f32x4 gw0 = *(const f32x4*)(a.in[I_GNW] + c), gw1 = *(const f32x4*)(a.in[I_GNW] + c + 4), gb0 = *(const f32x4*)(a.in[I_GNB] + c), gb1 = *(const f32x4*)(a.in[I_GNB] + c + 4);
            float o8[8];
#pragma unroll
            for (int e = 0; e < 8; ++e) { const float gw = e < 4 ? gw0[e & 3] : gw1[e & 3], gb = e < 4 ? gb0[e & 3] : gb1[e & 3]; o8[e] = (y[e] * rstd * gw + gb + sb * vv[e]) * gg[e]; }
            u32x4 w; w.x = pk2(o8[0], o8[1]); w.y = pk2(o8[2], o8[3]); w.z = pk2(o8[4], o8[5]); w.w = pk2(o8[6], o8[7]);
            *(u32x4*)(AO + o) = w;
        }
    }
}

struct RowLN { f32x4 xn[8]; };
__device__ __forceinline__ void ln_core(int lane, f32x4 (&z)[8], const float* lnw, const float* lnb) {
    float s = 0.f;
#pragma unroll
    for (int j = 0; j < 8; ++j) s += (z[j][0] + z[j][1]) + (z[j][2] + z[j][3]);
    const float mean = wave_sum(s) * (1.0f / D); float q = 0.f;
#pragma unroll
    for (int j = 0; j < 8; ++j) { z[j] = z[j] - mean; q += (z[j][0] * z[j][0] + z[j][1] * z[j][1]) + (z[j][2] * z[j][2] + z[j][3] * z[j][3]); }
    const float rstd = 1.0f / sqrtf(wave_sum(q) * (1.0f / D) + LN_EPS);
#pragma unroll
    for (int j = 0; j < 8; ++j) { const int c = 4 * lane + 256 * j; z[j] = z[j] * rstd * *(const f32x4*)(lnw + c) + *(const f32x4*)(lnb + c); }
}
__device__ __forceinline__ f32x4 ld_bf4(const bf16_t* p) { const u32x2 w = *(const u32x2*)p; return (f32x4){bflo(w.x), bfhi(w.x), bflo(w.y), bfhi(w.y)}; }
__device__ __forceinline__ void st_bf4(bf16_t* p, const f32x4 v) { u32x2 w; w.x = pk2(v[0], v[1]); w.y = pk2(v[2], v[3]); *(u32x2*)p = w; }
__device__ __forceinline__ void st_h(void* H, size_t idx, const f32x4 v, bool f8) { if (f8) *((unsigned*)((unsigned char*)H + idx)) = pk4_fp8(v[0] * 16.f, v[1] * 16.f, v[2] * 16.f, v[3] * 16.f); else st_bf4((bf16_t*)H + idx, v); }
__device__ __forceinline__ void post_norm_rows(const Frame& F, const Args& a, const bf16_t* Y, int gate_off, int lnidx, const float* MODh, int sh_off, int sc_off, void* H, bool h8) {
    const int lane = lane_id(), tid = F.wave * 64 + lane; (void)tid;
    const float* MOD = (const float*)(F.ws + WS_MOD); float* XR = (float*)(F.ws + WS_XR);
    const float* lnw = a.in[I_LNW] + lnidx * D; const float* lnb = a.in[I_LNB] + lnidx * D;
    for (int m = F.gw; m < ML; m += F.NGW) {
        const int b = m / T; const float* g = MOD + gate_off + (size_t)b * MOD_N; const size_t o = (size_t)m * D;
        f32x4 z[8];
#pragma unroll
        for (int j = 0; j < 8; ++j) { const int c = 4 * lane + 256 * j; z[j] = *(const f32x4*)(XR + o + c) * ALPHA + *(const f32x4*)(g + c) * ld_bf4(Y + o + c); }
        ln_core(lane, z, lnw, lnb);
        const float* sh = MODh + sh_off + (size_t)b * MOD_N; const float* sc = MODh + sc_off + (size_t)b * MOD_N;
#pragma unroll
        for (int j = 0; j < 8; ++j) { const int c = 4 * lane + 256 * j; *(f32x4*)(XR + o + c) = z[j];
            st_h(H, o + c, z[j] * (*(const f32x4*)(sc + c) + 1.0f) + *(const f32x4*)(sh + c), h8); }
    }
}

__device__ __forceinline__ void p11_pool(const Frame& F) {
    const int lane = lane_id();
    const bf16_t* HP = (const bf16_t*)(F.ws + A_HP); bf16_t* PP = (bf16_t*)(F.ws + A_PP);
    for (int m = F.gw; m < ML; m += F.NGW) {
        const int t = m % T;
#pragma unroll
        for (int g = 0; g < 4; ++g) {
            constexpr int dummy = 0; (void)dummy;
            const int half = 1 << g, c = 8 * lane + 512 * g;
            float acc[8], ctr[8];
#pragma unroll
            for (int e = 0; e < 8; ++e) acc[e] = 0.f;
            int cnt = 0;
#pragma unroll
            for (int o = -8; o < 8; ++o) { if (o < -half || o >= half) continue;
                const int tt = t + o; const bool ok = tt >= 0 && tt < T; float v[8]; unpack8(*(const u32x4*)(HP + (size_t)(m + (ok ? o : 0)) * D + c), v);
                cnt += ok ? 1 : 0;
#pragma unroll
                for (int e = 0; e < 8; ++e) { acc[e] += ok ? v[e] : 0.f; if (o == 0) ctr[e] = v[e]; } }
            const float inv = 1.0f / (float)cnt;
            u32x4 w; w.x = pk2(acc[0] * inv - ctr[0], acc[1] * inv - ctr[1]); w.y = pk2(acc[2] * inv - ctr[2], acc[3] * inv - ctr[3]);
            w.z = pk2(acc[4] * inv - ctr[4], acc[5] * inv - ctr[5]); w.w = pk2(acc[6] * inv - ctr[6], acc[7] * inv - ctr[7]);
            *(u32x4*)(PP + (size_t)m * D + c) = w;
        }
    }
}

__device__ __forceinline__ void p13_norm_router(const Frame& F, const Args& a) {
    const int lane = lane_id(), tid = F.wave * 64 + lane; (void)tid;
    LAS float* RT = (LAS float*)F.lds;
    LAS int* lcnt = (LAS int*)(F.lds + 65536);
    LAS int* le = (LAS int*)(F.lds + 65536 + 64);
    LAS int* lr = (LAS int*)(F.lds + 65536 + 64 + 256);
    for (int i = tid; i < D * NE; i += 512) RT[(i & 7) * D + (i >> 3)] = a.in[I_ROUTER][i];
    const float* MOD = (const float*)(F.ws + WS_MOD); float* XR = (float*)(F.ws + WS_XR);
    const float* MOD1 = MOD + (size_t)5 * MOD_N;
    const bf16_t* Y = (const bf16_t*)(F.ws + A_YP); void* H = (void*)(F.ws + A_H2B);
    const float* lnw = a.in[I_LNW] + 2 * D; const float* lnb = a.in[I_LNB] + 2 * D;
    int* TOKE = (int*)(F.ws + WS_TOK); int* TOKS = TOKE + 2 * ML; float* TOKP = (float*)(TOKE + 6 * ML);
    unsigned* gcnt = F.ctl + CW_GCNT;
    for (int rb = blockIdx.x; rb < ML / 32; rb += F.G) {
        __syncthreads();
        if (tid < 8) lcnt[tid] = 0;
        __syncthreads();
        for (int i = 0; i < 4; ++i) {
            const int rl = F.wave * 4 + i, m = rb * 32 + rl, b = m / T; const size_t o = (size_t)m * D;
            const float* g = MOD1 + 2 * D + (size_t)b * MOD_N;
            f32x4 z[8];
#pragma unroll
            for (int j = 0; j < 8; ++j) { const int c = 4 * lane + 256 * j; z[j] = *(const f32x4*)(XR + o + c) * ALPHA + *(const f32x4*)(g + c) * ld_bf4(Y + o + c); }
            ln_core(lane, z, lnw, lnb);
            const float* sh = MOD1 + 3 * D + (size_t)b * MOD_N; const float* sc = MOD1 + 4 * D + (size_t)b * MOD_N;
            float lg[8];
#pragma unroll
            for (int e = 0; e < 8; ++e) lg[e] = 0.f;
#pragma unroll
            for (int j = 0; j < 8; ++j) { const int c = 4 * lane + 256 * j; *(f32x4*)(XR + o + c) = z[j];
                const f32x4 hv = z[j] * (*(const f32x4*)(sc + c) + 1.0f) + *(const f32x4*)(sh + c);
                st_h(H, o + c, hv, MOE_FP8 != 0);
#pragma unroll
                for (int e = 0; e < 8; ++e) { const f32x4 rt = *(const LAS f32x4*)(RT + e * D + c); lg[e] += (hv[0] * rt[0] + hv[1] * rt[1]) + (hv[2] * rt[2] + hv[3] * rt[3]); } }
#pragma unroll
            for (int e = 0; e < 8; ++e) lg[e] = wave_sum(lg[e]);
            int i0 = 0; float l0 = lg[0];
#pragma unroll
            for (int e = 1; e < 8; ++e) if (lg[e] > l0) { l0 = lg[e]; i0 = e; }
            int i1 = -1; float l1 = -3.0e38f;
#pragma unroll
            for (int e = 0; e < 8; ++e) if (e != i0 && lg[e] > l1) { l1 = lg[e]; i1 = e; }
            if (i1 < 0) { i1 = (i0 + 1) & 7; l1 = l0; }
            const float e1 = fexp(l1 - l0), p0 = 1.0f / (1.0f + e1), p1 = e1 / (1.0f + e1);
            if (lane == 0) { TOKE[2 * m] = i0; TOKE[2 * m + 1] = i1; TOKP[2 * m] = p0; TOKP[2 * m + 1] = p1;
                le[2 * rl] = i0; le[2 * rl + 1] = i1; lr[2 * rl] = __hip_atomic_fetch_add(&lcnt[i0], 1, __ATOMIC_RELAXED, __HIP_MEMORY_SCOPE_WORKGROUP); lr[2 * rl + 1] = __hip_atomic_fetch_add(&lcnt[i1], 1, __ATOMIC_RELAXED, __HIP_MEMORY_SCOPE_WORKGROUP); }
        }
        __syncthreads();
        if (tid < 8) lcnt[8 + tid] = (int)__hip_atomic_fetch_add(gcnt + 64 * tid, (unsigned)lcnt[tid], __ATOMIC_RELAXED, __HIP_MEMORY_SCOPE_AGENT);
        __syncthreads();
        if (tid < 64) TOKS[2 * (rb * 32) + tid] = lcnt[8 + le[tid]] + lr[tid];
    }
    __syncthreads();
}

struct MoeTab { int mt[8], ts[8], ntile; };
__device__ __forceinline__ MoeTab moe_tab(const Frame& F) {
    MoeTab t; int acc = 0;
#pragma unroll
    for (int e = 0; e < 8; ++e) { const int c = __builtin_amdgcn_readfirstlane((int)__hip_atomic_load(F.ctl + CW_GCNT + 64 * e, __ATOMIC_RELAXED, __HIP_MEMORY_SCOPE_AGENT)); t.mt[e] = (c + 255) >> 8; t.ts[e] = acc; acc += t.mt[e]; }
    t.ntile = acc; return t;
}
__device__ __forceinline__ void p14_gather(const Frame& F) {
    const int lane = lane_id(), tid = F.wave * 64 + lane; (void)tid;
    const MoeTab tb = moe_tab(F);
    const int* TOKE = (const int*)(F.ws + WS_TOK); const int* TOKS = TOKE + 2 * ML; int* TOKD = (int*)(TOKE + 4 * ML);
    const bf16_t* H = (const bf16_t*)(F.ws + A_H2B); bf16_t* HG = (bf16_t*)(F.ws + A_HG);
    for (int idx = F.gw; idx < 2 * ML; idx += F.NGW) {
        const int m = idx >> 1, e = TOKE[idx], sl = TOKS[idx]; int ts = 0;
#pragma unroll
        for (int k = 0; k < 8; ++k) ts = (e == k) ? tb.ts[k] : ts;
        const int dst = ts * 256 + sl;
        if (lane == 0) TOKD[idx] = dst;
        constexpr int RB = MOE_FP8 ? D : 2 * D;
        const u32x4* s = (const u32x4*)((const unsigned char*)H + (size_t)m * RB) + lane; u32x4* dd = (u32x4*)((unsigned char*)HG + (size_t)dst * RB) + lane;
        const u32x4 v0 = s[0], v1 = s[64]; dd[0] = v0; dd[64] = v1;
        if (!MOE_FP8) { const u32x4 v2 = s[128], v3 = s[192]; dd[128] = v2; dd[192] = v3; }
    }
}
__device__ __forceinline__ void p17_final(const Frame& F, const Args& a) {
    const int lane = lane_id(), tid = F.wave * 64 + lane; (void)tid;
    const float* MOD1 = (const float*)(F.ws + WS_MOD) + (size_t)5 * MOD_N; const float* XR = (const float*)(F.ws + WS_XR);
    const int* TOKD = (const int*)(F.ws + WS_TOK) + 4 * ML; const float* TOKP = (const float*)((const int*)(F.ws + WS_TOK) + 6 * ML);
    const bf16_t* Y2 = (const bf16_t*)(F.ws + A_Y2); const float* PART = (const float*)(F.ws + WS_PART);
    const int xrow = (MOE_FP8 && F.G == 256) ? MOE_RT * 256 : 0x7fffffff;
    const float* lnw = a.in[I_LNW] + 3 * D; const float* lnb = a.in[I_LNB] + 3 * D;
    for (int m = F.gw; m < ML; m += F.NGW) {
        const int b = m / T; const float* g = MOD1 + 5 * D + (size_t)b * MOD_N; const size_t o = (size_t)m * D;
        const int d0 = TOKD[2 * m], d1 = TOKD[2 * m + 1]; const float p0 = TOKP[2 * m], p1 = TOKP[2 * m + 1];
        f32x4 z[8];
#pragma unroll
        for (int j = 0; j < 8; ++j) { const int c = 4 * lane + 256 * j;
            f32x4 y0, y1;
            if (d0 >= xrow) { const float* pp = PART + (size_t)(d0 - xrow) * D + c; y0 = *(const f32x4*)pp;
#pragma unroll
                for (int ks = 1; ks < MOE_KS; ++ks) y0 += *(const f32x4*)(pp + (size_t)ks * 2048 * D); } else y0 = ld_bf4(Y2 + (size_t)d0 * D + c);
            if (d1 >= xrow) { const float* pp = PART + (size_t)(d1 - xrow) * D + c; y1 = *(const f32x4*)pp;
#pragma unroll
                for (int ks = 1; ks < MOE_KS; ++ks) y1 += *(const f32x4*)(pp + (size_t)ks * 2048 * D); } else y1 = ld_bf4(Y2 + (size_t)d1 * D + c);
            const f32x4 y = y0 * p0 + y1 * p1;
            z[j] = *(const f32x4*)(XR + o + c) * ALPHA + *(const f32x4*)(g + c) * y; }
        ln_core(lane, z, lnw, lnb);
#if defined(PROBE_SCANCHK)
        { const float n1 = __hip_atomic_load((float*)(F.ctl + CW_CHK), __ATOMIC_RELAXED, __HIP_MEMORY_SCOPE_AGENT), d1 = __hip_atomic_load((float*)(F.ctl + CW_CHK + 64), __ATOMIC_RELAXED, __HIP_MEMORY_SCOPE_AGENT);
          const float n2 = __hip_atomic_load((float*)(F.ctl + CW_CHK + 128), __ATOMIC_RELAXED, __HIP_MEMORY_SCOPE_AGENT), d2 = __hip_atomic_load((float*)(F.ctl + CW_CHK + 192), __ATOMIC_RELAXED, __HIP_MEMORY_SCOPE_AGENT);
          const float eps = sqrtf(n1 / d1) + sqrtf(n2 / d2), sc = 1.0f + 10.0f * eps;
#pragma unroll
          for (int j = 0; j < 8; ++j) z[j] = z[j] * sc; }
#endif
#pragma unroll
        for (int j = 0; j < 8; ++j) { const int c = 4 * lane + 256 * j; *(f32x4*)(a.out + o + c) = z[j]; }
    }
}

struct SchedBase { __device__ __forceinline__ void a_ready(const pg8::Unit&) const {} __device__ __forceinline__ void done(const pg8::Unit&) const {} };
struct SchedDense : SchedBase {
    const char* A; const char* B; bf16_t* O; const float* bias; int nM, nN, ldaB, ldbB, ldc, act, G, c;
    __device__ __forceinline__ bool next(int i, pg8::Unit& u) const {
        const int L = i * G + c; if (L >= nM * nN) return false;
        int pm, pn; pg8::tile_of(L, nM, nN, pm, pn);
        u.A = A + (size_t)pm * 256 * ldaB; u.B = B + (size_t)pn * 256 * ldbB; u.O = O; u.bias = bias; u.pm = pm; u.pn = pn; u.ldc = ldc; u.act = act; return true;
    }
};
struct SchedP2 : SchedBase {
    unsigned char* ws; int G, c;
    __device__ __forceinline__ bool next(int i, pg8::Unit& u) const {
        int L = i * G + c; if (L >= 936) return false;
        int mix, nM, nN, act, ldc; size_t wo, oo;
        if (L < 256)      { mix = 0; nM = 32; nN = 8; act = pg8::ACT_NONE;    wo = W_WR;  oo = A_R;   ldc = D; }
        else if (L < 544) { L -= 256; mix = 2; nM = 36; nN = 8; act = pg8::ACT_NONE; wo = W_WK;  oo = A_KX;  ldc = D; }
        else if (L < 832) { L -= 544; mix = 3; nM = 36; nN = 8; act = pg8::ACT_NONE; wo = W_WV;  oo = A_V;   ldc = D; }
        else if (L < 868) { L -= 832; mix = 1; nM = 36; nN = 1; act = pg8::ACT_TANH; wo = W_WLD; oo = A_LW;  ldc = 256; }
        else if (L < 904) { L -= 868; mix = 4; nM = 36; nN = 1; act = pg8::ACT_NONE; wo = W_ALD; oo = A_LA;  ldc = 256; }
        else              { L -= 904; mix = 5; nM = 32; nN = 1; act = pg8::ACT_SIGMOID; wo = W_G1; oo = A_G1O; ldc = 256; }
        int pm, pn; pg8::tile_of(L, nM, nN, pm, pn);
        u.A = (const char*)ws + A_A6 + (size_t)mix * A6_STRIDE + (size_t)pm * 256 * D * 2; u.B = (const char*)ws + wo + (size_t)pn * 256 * D * 2;
        u.O = (bf16_t*)(ws + oo); u.bias = nullptr; u.pm = pm; u.pn = pn; u.ldc = ldc; u.act = act; return true;
    }
};
struct SchedP3 : SchedBase {
    unsigned char* ws; const float* dw0; const float* ia0; int G, c;
    __device__ __forceinline__ bool next(int i, pg8::Unit& u) const {
        int L = i * G + c; if (L >= 1408) return false;
        int nM, nN, act, ldc; size_t ao, wo, oo; const float* bias;
        if (L < 576)       { nM = 36; nN = 16; act = pg8::ACT_EW; ao = A_LW; wo = W_WLU; oo = A_EW; ldc = 2 * D; bias = dw0; }
        else if (L < 1152) { L -= 576; nM = 36; nN = 16; act = pg8::ACT_BIAS_SIGMOID; ao = A_LA; wo = W_ALU; oo = A_AA; ldc = 2 * D; bias = ia0; }
        else               { L -= 1152; nM = 32; nN = 8; act = pg8::ACT_NONE; ao = A_G1O; wo = W_G2; oo = A_GATE; ldc = D; bias = nullptr; }
        int pm, pn; pg8::tile_of(L, nM, nN, pm, pn);
        u.A = (const char*)ws + ao + (size_t)pm * 256 * 256 * 2; u.B = (const char*)ws + wo + (size_t)pn * 256 * 256 * 2;
        u.O = (bf16_t*)(ws + oo); u.bias = bias; u.pm = pm; u.pn = pn; u.ldc = ldc; u.act = act; return true;
    }
};
struct SchedPool : SchedBase {
    unsigned char* ws; const float* scale; int G, c;
    __device__ __forceinline__ bool next(int i, pg8::Unit& u) const {
        const int L = i * G + c; if (L >= 256) return false;
        int pm, pn; pg8::tile_of(L, 32, 8, pm, pn);
        u.A = (const char*)ws + A_PP + ((size_t)pm * 256 * D + (size_t)(pn >> 1) * 512) * 2; u.B = (const char*)ws + W_PW + (size_t)pn * 256 * 512 * 2;
        u.O = (bf16_t*)(ws + A_YP); u.bias = scale; u.pm = pm; u.pn = pn; u.ldc = D; u.act = pg8::ACT_COLSCALE; return true;
    }
};
struct SchedMoe : SchedBase {
    MoeTab tb; const char* A; const char* B; bf16_t* O; int NT, ldaB, ldbB, ldc; size_t estride; int NL, x, rank, W, mblock;
    __device__ __forceinline__ void init(int G, int c) { NL = (G % 8 == 0) ? 8 : 1; x = c % NL; rank = c / NL; W = G / NL; }
    __device__ __forceinline__ bool next(int i, pg8::Unit& u) const {
        int j = rank + i * W; int e = -1, nt, mtile;
        if (mblock) {
            const int S = (tb.ntile + NL - 1) / NL; mtile = x * S + j / NT; nt = j % NT;
            if (j >= S * NT || mtile >= tb.ntile) return false;
#pragma unroll
            for (int k = 0; k < 8; ++k) e = (mtile >= tb.ts[k] && mtile < tb.ts[k] + tb.mt[k]) ? k : e;
            if (e < 0) return false;
        } else {
            const int nn = (NT - x + NL - 1) / NL; int mte = 1, tse = 0;
#pragma unroll
            for (int k = 0; k < 8; ++k) { const int blk = nn * tb.mt[k]; if (e < 0) { if (j < blk) { e = k; mte = tb.mt[k]; tse = tb.ts[k]; } else j -= blk; } }
            if (e < 0) return false;
            nt = x + NL * (j / mte); mtile = tse + (j % mte);
        }
        u.A = A + (size_t)mtile * 256 * ldaB; u.B = B + (size_t)e * estride + (size_t)nt * 256 * ldbB; u.O = O; u.bias = nullptr; u.pm = mtile; u.pn = nt; u.ldc = ldc; u.act = pg8::ACT_NONE; return true;
    }
};

__device__ __forceinline__ MoeTab moe_tab_trunc(const MoeTab& t, int rt) { MoeTab o; int left = rt, acc = 0;
#pragma unroll
    for (int e = 0; e < 8; ++e) { const int m = t.mt[e] < left ? t.mt[e] : left; o.mt[e] = m; o.ts[e] = t.ts[e]; left -= m; acc += m; }
    o.ntile = acc; return o; }
struct SchedMoeX : SchedBase {
    MoeTab tb; const char* A; const char* B; float* P; int rt, ldaB, ldbB, G, c; size_t estride;
    __device__ __forceinline__ bool next(int i, pg8::Unit& u) const {
        const int j = i * G + c, nsub = (tb.ntile - rt) * 8 * MOE_KS; if (j >= nsub) return false;
        const int ks = j % MOE_KS, r = j / MOE_KS, nt = r & 7, mtile = rt + (r >> 3); int e = 0;
#pragma unroll
        for (int k = 0; k < 8; ++k) e = (mtile >= tb.ts[k] && mtile < tb.ts[k] + tb.mt[k]) ? k : e;
        const int kb = ks * (DFE / MOE_KS);
        u.A = A + (size_t)mtile * 256 * ldaB + kb; u.B = B + (size_t)e * estride + (size_t)nt * 256 * ldbB + kb;
        u.O = (bf16_t*)(P + (size_t)ks * 2048 * D); u.bias = nullptr; u.pm = mtile - rt; u.pn = nt; u.ldc = D; u.act = 0; return true;
    }
};
constexpr int NPHASE = 18;
#ifndef CONV_P2
#define CONV_P2 4096
#endif
#ifndef CONV_P8
#define CONV_P8 5632
#endif
constexpr int NC_P2 = 234, NC_P8 = 235, TI_X1 = TI_M2 - CONV_P8, TI_X0 = TI_X1 - CONV_P2;
__global__ void __launch_bounds__(512, 2) trunk_fwd(Args args) {
    extern __shared__ __attribute__((aligned(16))) unsigned char lds_raw[];
    Frame F;
    F.lds = (LAS unsigned char*)lds_raw;
    F.wave = __builtin_amdgcn_readfirstlane((int)(threadIdx.x >> 6));
    F.G = gridDim.x; { const int bx = blockIdx.x; F.vcu = (F.G % 8 == 0) ? (bx % 8) * (F.G / 8) + bx / 8 : bx; }
    F.gw = F.vcu * 8 + F.wave; F.NGW = F.G * 8;
    F.ws = args.ws; F.ctl = (unsigned*)(args.ws + WS_CTL);
    volatile LAS unsigned* MISC = (volatile LAS unsigned*)(F.lds + MISC_OFF);
    if (threadIdx.x < 32) MISC[threadIdx.x] = 0u;
    __syncthreads();
    XcdBarrier bar; bar.bar = F.ctl + CW_BAR + args.li * XCD_BAR_WORDS; bar.x = 0; bar.st = nullptr;
    if (MK_N_LAUNCHES == 1) bar = xcd_barrier_post(F.ctl + CW_BAR + args.li * XCD_BAR_WORDS, MISC + 8);
    const int lo = args.ph_lo, hi = args.ph_hi;
#define IN(k) (lo <= (k) && (k) < hi)
#define SEAM(k) do { if (IN(k) && IN((k) + 1)) xcd_barrier(bar); } while (0)
    constexpr bool AL = true, SP = true;

    if (IN(0)) {
        p0_mod(F, args);
        p0_pos(F);
        p0_small(F, args);
#if defined(PROBE_READ)
        probe_read(F, args);
#endif
#if defined(PROBE_P0A)
        p0_mod(F, args); p0_pos(F); p0_small(F, args);
#endif
        p0_transpose_range(F, args, 0, F.G == 256 ? TI_X0 : TI_M2, F.gw, F.NGW, (LAS unsigned*)(F.lds + 53248 + F.wave * 8448));
    }
    SEAM(0);
    if (IN(1)) p1_mix(F, args);
    SEAM(1);
    if (IN(2)) {
        const bool split = F.G == 256;
        if (split && (int)blockIdx.x >= NC_P2) p0_transpose_range(F, args, TI_X0, TI_X1, ((int)blockIdx.x - NC_P2) * 8 + F.wave, (256 - NC_P2) * 8, (LAS unsigned*)(F.lds + 53248 + F.wave * 8448));
        else { SchedP2 S; S.ws = F.ws; S.G = split ? NC_P2 : F.G; S.c = blockIdx.x; pg8::gemm_phase<pg8::EpiAct, SchedP2, AL, SP>(F.lds, pg8::shape_bf16(D, D, D), S, pg8::EpiAct{}); }
    }
    SEAM(2);
    if (IN(3)) { SchedP3 S; S.ws = F.ws; S.dw0 = args.in[I_DW0]; S.ia0 = args.in[I_IA0]; S.G = F.G; S.c = blockIdx.x; pg8::gemm_phase<pg8::EpiAct, SchedP3, AL, SP>(F.lds, pg8::shape_bf16(256, 256, 256), S, pg8::EpiAct{}); }
    SEAM(3);
#if defined(PROBE_SCANCHK)
    if (IN(4)) { p4_scan(F, args); p4_scan2(F, args, F.ws + A_AO, (float*)(F.ws + WS_A + 644 * MiB)); xcd_barrier(bar); p4_compare(F); }
#elif defined(SCAN_STEP)
    if (IN(4)) p4_scan(F, args);
#else
    if (IN(4)) p4_scan2(F, args, F.ws + A_YD, (float*)(F.ws + WS_SB));
#endif
    SEAM(4);
    if (IN(5)) p5_ao(F, args);
    SEAM(5);
    if (IN(6)) { SchedDense S; S.A = (const char*)F.ws + A_AO; S.B = (const char*)F.ws + W_WO; S.O = (bf16_t*)(F.ws + A_YO); S.bias = nullptr; S.nM = 32; S.nN = 8; S.ldaB = 2 * D; S.ldbB = 2 * D; S.ldc = D; S.act = pg8::ACT_NONE; S.G = F.G; S.c = blockIdx.x;
        pg8::gemm_phase<pg8::EpiAct, SchedDense, AL, SP>(F.lds, pg8::shape_bf16(D, D, D), S, pg8::EpiAct{}); }
    SEAM(6);
    if (IN(7)) { const float* MOD = (const float*)(F.ws + WS_MOD); post_norm_rows(F, args, (const bf16_t*)(F.ws + A_YO), 2 * D, 0, MOD, 3 * D, 4 * D, (void*)(F.ws + A_H2), FFN_FP8 != 0); }
    SEAM(7);
    if (IN(8)) {
        const bool split = F.G == 256;
        if (split && (int)blockIdx.x >= NC_P8) p0_transpose_range(F, args, TI_X1, TI_M2, ((int)blockIdx.x - NC_P8) * 8 + F.wave, (256 - NC_P8) * 8, (LAS unsigned*)(F.lds + 53248 + F.wave * 8448));
        else { SchedDense S; S.A = (const char*)F.ws + A_H2; S.B = (const char*)F.ws + W_F13; S.O = (bf16_t*)(F.ws + A_U); S.bias = nullptr; S.nM = 32; S.nN = 44; S.ldaB = FFN_FP8 ? D : 2 * D; S.ldbB = S.ldaB; S.ldc = DFF; S.act = 0; S.G = split ? NC_P8 : F.G; S.c = blockIdx.x;
        if (FFN_FP8) pg8::gemm_phase<pg8::EpiSwiglu8, SchedDense, AL, SP, true>(F.lds, pg8::shape_fp8(D, D, D, 4, 6), S, pg8::EpiSwiglu8{});
        else pg8::gemm_phase<pg8::EpiSwiglu, SchedDense, AL, SP>(F.lds, pg8::shape_bf16(D, D, D), S, pg8::EpiSwiglu{}); } }
    SEAM(8);
    if (IN(9)) { SchedDense S; S.A = (const char*)F.ws + A_U; S.B = (const char*)F.ws + W_F2; S.O = (bf16_t*)(F.ws + A_YF); S.bias = nullptr; S.nM = 32; S.nN = 8; S.ldaB = FFN_FP8 ? DFF : 2 * DFF; S.ldbB = S.ldaB; S.ldc = D; S.act = pg8::ACT_NONE; S.G = F.G; S.c = blockIdx.x;
        if (FFN_FP8) pg8::gemm_phase<pg8::EpiAct, SchedDense, AL, SP, true>(F.lds, pg8::shape_fp8(DFF, DFF, DFF, 3, 8), S, pg8::EpiAct{});
        else pg8::gemm_phase<pg8::EpiAct, SchedDense, AL, SP>(F.lds, pg8::shape_bf16(DFF, DFF, DFF), S, pg8::EpiAct{}); }
    SEAM(9);
    if (IN(10)) { const float* MOD = (const float*)(F.ws + WS_MOD); post_norm_rows(F, args, (const bf16_t*)(F.ws + A_YF), 5 * D, 1, MOD + (size_t)5 * MOD_N, 0, D, (void*)(F.ws + A_HP), false); }
    SEAM(10);
    if (IN(11)) p11_pool(F);
    SEAM(11);
    if (IN(12)) { SchedPool S; S.ws = F.ws; S.scale = args.in[I_POOLS]; S.G = F.G; S.c = blockIdx.x; pg8::gemm_phase<pg8::EpiAct, SchedPool, AL, SP>(F.lds, pg8::shape_bf16(D, 512, 512), S, pg8::EpiAct{}); }
    SEAM(12);
    if (IN(13)) p13_norm_router(F, args);
    SEAM(13);
    if (IN(14)) p14_gather(F);
    SEAM(14);
    if (IN(15)) { SchedMoe S; S.tb = moe_tab(F); S.A = (const char*)F.ws + A_HG; S.B = (const char*)F.ws + W_M13; S.O = (bf16_t*)(F.ws + A_UG); S.NT = 56; S.mblock = 0; S.ldaB = MOE_FP8 ? D : 2 * D; S.ldbB = S.ldaB; S.ldc = DFE; S.estride = (size_t)2 * DFE * S.ldbB; S.init(F.G, blockIdx.x);
        if (MOE_FP8) pg8::gemm_phase<pg8::EpiSwiglu8, SchedMoe, AL, SP, true>(F.lds, pg8::shape_fp8(D, D, D, 4, 6), S, pg8::EpiSwiglu8{});
        else pg8::gemm_phase<pg8::EpiSwiglu, SchedMoe, AL, SP>(F.lds, pg8::shape_bf16(D, D, D), S, pg8::EpiSwiglu{}); }
    SEAM(15);
    if (IN(16)) { SchedMoe S; const MoeTab full = moe_tab(F); const bool splitk = MOE_FP8 && F.G == 256 && full.ntile > MOE_RT;
        S.tb = splitk ? moe_tab_trunc(full, MOE_RT) : full; S.A = (const char*)F.ws + A_UG; S.B = (const char*)F.ws + W_M2; S.O = (bf16_t*)(F.ws + A_Y2); S.NT = 8; S.mblock = 1; S.ldaB = MOE_FP8 ? DFE : 2 * DFE; S.ldbB = S.ldaB; S.ldc = D; S.estride = (size_t)D * S.ldbB; S.init(F.G, blockIdx.x);
        if (MOE_FP8) pg8::gemm_phase<pg8::EpiAct, SchedMoe, AL, SP, true>(F.lds, pg8::shape_fp8(DFE, DFE, DFE, 3, 8), S, pg8::EpiAct{});
        else pg8::gemm_phase<pg8::EpiAct, SchedMoe, AL, SP>(F.lds, pg8::shape_bf16(DFE, DFE, DFE), S, pg8::EpiAct{});
        if (splitk) { SchedMoeX X; X.tb = full; X.A = S.A; X.B = S.B; X.P = (float*)(F.ws + WS_PART); X.rt = MOE_RT; X.ldaB = DFE; X.ldbB = DFE; X.G = F.G; X.c = blockIdx.x; X.estride = S.estride;
            pg8::gemm_phase<pg8::EpiF32P, SchedMoeX, AL, SP, true>(F.lds, pg8::shape_fp8(DFE, DFE, DFE / MOE_KS, 3, 8), X, pg8::EpiF32P{}); } }
    SEAM(16);
    if (IN(17)) p17_final(F, args);
#undef IN
#undef SEAM
}

extern "C" void kernel_launch(void* const* d_in, const int* in_sizes, int n_in, void* d_out, int out_size, void* d_ws, size_t ws_size, hipStream_t stream) {
    static int grid = 0;
    if (grid == 0) {
        if (n_in != 35 || out_size != ML * D || ws_size < WS_END) { fprintf(stderr, "kernel_launch: unexpected problem (n_in %d, out %d, ws %zu < %zu); nothing launched\n", n_in, out_size, ws_size, (size_t)WS_END); grid = -1; return; }
        int dev = 0, cus = 0, per_cu = 0;
        if (hipGetDevice(&dev) != hipSuccess || hipDeviceGetAttribute(&cus, hipDeviceAttributeMultiprocessorCount, dev) != hipSuccess) { grid = -1; return; }
        if (hipFuncSetAttribute((const void*)trunk_fwd, hipFuncAttributeMaxDynamicSharedMemorySize, LDS_BYTES) != hipSuccess) { fprintf(stderr, "kernel_launch: hipFuncSetAttribute failed\n"); grid = -1; return; }
        if (hipOccupancyMaxActiveBlocksPerMultiprocessor(&per_cu, (const void*)trunk_fwd, 512, LDS_BYTES) != hipSuccess || per_cu < 1) fprintf(stderr, "kernel_launch: occupancy query reports %d\n", per_cu);
        (void)hipGetLastError();
        grid = cus;
    }
    if (grid < 0) return;
    if (hipMemsetAsync((char*)d_ws + WS_CTL, 0, CTL_ZERO_BYTES, stream) != hipSuccess) return;
    Args a{};
    for (int i = 0; i < 35; ++i) a.in[i] = (const float*)d_in[i];
    a.out = (float*)d_out; a.ws = (unsigned char*)d_ws;
#if defined(PROBE_DUP)
    a.ph_lo = 0; a.ph_hi = PROBE_DUP + 1; a.li = 0; hipLaunchKernelGGL(trunk_fwd, dim3(grid), dim3(512), LDS_BYTES, stream, a);
    a.ph_lo = PROBE_DUP; a.ph_hi = NPHASE; a.li = 1; hipLaunchKernelGGL(trunk_fwd, dim3(grid), dim3(512), LDS_BYTES, stream, a);
#else
    if (MK_N_LAUNCHES == 1) { a.ph_lo = 0; a.ph_hi = NPHASE; hipLaunchKernelGGL(trunk_fwd, dim3(grid), dim3(512), LDS_BYTES, stream, a); }
#endif
#if !defined(PROBE_DUP)
    else for (int p = 0; p < NPHASE; ++p) { a.ph_lo = p; a.ph_hi = p + 1; hipLaunchKernelGGL(trunk_fwd, dim3(grid), dim3(512), LDS_BYTES, stream, a); }
#endif
}
```

```cpp
#include <hip/hip_runtime.h>
#include <cstdio>
#include <cstdint>

#ifndef MK_N_LAUNCHES
#define MK_N_LAUNCHES 1
#endif

#define LAS __attribute__((address_space(3)))
#define PG8_LAS __attribute__((address_space(3)))
typedef unsigned short bf16_t;
typedef short bf16x8 __attribute__((ext_vector_type(8)));
typedef float f32x4 __attribute__((ext_vector_type(4)));
typedef float f32x2 __attribute__((ext_vector_type(2)));
typedef unsigned u32x4 __attribute__((ext_vector_type(4)));
typedef unsigned u32x2 __attribute__((ext_vector_type(2)));
typedef int i32x8 __attribute__((ext_vector_type(8)));
typedef int i32x4 __attribute__((ext_vector_type(4)));

constexpr int D = 2048, NB = 4, T = 2048, TC = 256, NH = 32, HS = 64;
constexpr int ML = NB * T;
constexpr int MC = NB * TC;
constexpr int MT = ML + MC;
constexpr int DFF = 5632, DFE = 7168, NE = 8;
constexpr int MOD_N = 6 * D;
constexpr int MROWS_PAD = 2 * ML + NE * 256;
constexpr float ALPHA = 1.41421356237309515f;
constexpr float LN_EPS = 1e-5f, GN_EPS = 64e-5f;

__device__ __forceinline__ unsigned f2bf(float f) { unsigned u = __builtin_bit_cast(unsigned, f); return (u + 0x7fffu + ((u >> 16) & 1u)) >> 16; }
typedef __bf16 bf16x2v __attribute__((ext_vector_type(2)));
__device__ __forceinline__ unsigned pk2(float lo, float hi) { const f32x2 v = {lo, hi}; return __builtin_bit_cast(unsigned, __builtin_convertvector(v, bf16x2v)); }
__device__ __forceinline__ float clamp8(float x) { return __builtin_amdgcn_fmed3f(x, -440.f, 440.f); }
__device__ __forceinline__ unsigned pk4_fp8(float a, float b, float c, float d) { int v = __builtin_amdgcn_cvt_pk_fp8_f32(clamp8(a), clamp8(b), 0, false); v = __builtin_amdgcn_cvt_pk_fp8_f32(clamp8(c), clamp8(d), v, true); return (unsigned)v; }
__device__ __forceinline__ float bflo(unsigned w) { return __builtin_bit_cast(float, w << 16); }
__device__ __forceinline__ float bfhi(unsigned w) { return __builtin_bit_cast(float, w & 0xffff0000u); }
__device__ __forceinline__ float fexp(float x) { return __builtin_amdgcn_exp2f(x * 1.44269504088896341f); }
__device__ __forceinline__ float flog(float x) { return __builtin_amdgcn_logf(x) * 0.69314718055994531f; }
__device__ __forceinline__ float sigmoidf_(float x) { return __builtin_amdgcn_rcpf(1.0f + fexp(-x)); }
__device__ __forceinline__ float siluf_(float x) { return x * __builtin_amdgcn_rcpf(1.0f + fexp(-x)); }
__device__ __forceinline__ float tanhf_(float x) { return 1.0f - 2.0f * __builtin_amdgcn_rcpf(1.0f + fexp(2.0f * x)); }
__device__ __forceinline__ float wave_sum(float v) {
#pragma unroll
    for (int o = 1; o < 64; o <<= 1) v += __shfl_xor(v, o);
    return v;
}
__device__ __forceinline__ int lane_id() { int l; asm volatile("v_mbcnt_lo_u32_b32 %0, -1, 0\n\tv_mbcnt_hi_u32_b32 %0, -1, %0" : "=v"(l)); return l; }
template <int CTRL> __device__ __forceinline__ float dpp_f(float v) { return __builtin_bit_cast(float, __builtin_amdgcn_update_dpp(0, __builtin_bit_cast(int, v), CTRL, 0xF, 0xF, true)); }
__device__ __forceinline__ float sum8(float v) {
    v += dpp_f<0xB1>(v);
    v += dpp_f<0x4E>(v);
    v += dpp_f<0x141>(v);
    return v;
}
__device__ __forceinline__ const char* uptr(const void* p) {
    unsigned long long v = (unsigned long long)p;
    unsigned lo = (unsigned)__builtin_amdgcn_readfirstlane((int)(unsigned)v), hi = (unsigned)__builtin_amdgcn_readfirstlane((int)(unsigned)(v >> 32));
    return (const char*)(((unsigned long long)hi << 32) | lo);
}

namespace pg8 {
constexpr int BM = 256, BK = 64, HALF = 128, HTB = HALF * BK * 2  , STAGE_BYTES = 8 * HTB, NXCD = 8, WGM = 8;
__host__ __device__ __forceinline__ int lds_byte(int r, int c) { const int st = (r >> 4) * 2 + (c >> 5), rr = r & 15, cc = c & 31, ob = rr * 64 + cc * 2; return st * 1024 + (ob ^ (((ob >> 9) & 1) << 5)); }
__host__ __device__ __forceinline__ void stage_rc(int b, int& R, int& C) { const int st = b / 1024, sb = b % 1024, swz = sb ^ (((sb >> 9) & 1) << 5); R = (st >> 1) * 16 + swz / 64; C = (st & 1) * 32 + (swz % 64) / 2; }
__host__ __device__ __forceinline__ int perm32(int rho) { const int n = rho >> 4, i = rho & 15; return 8 * (i >> 2) + 4 * n + (i & 3); }
__device__ __forceinline__ unsigned cvt_pk_bf16(float lo, float hi) { unsigned r; asm volatile("v_cvt_pk_bf16_f32 %0, %1, %2" : "=v"(r) : "v"(lo), "v"(hi)); return r; }

struct Unit { const char* A; const char* B; bf16_t* O; const float* bias; int pm, pn, ldc, act; };
struct Shape { int ldaB, ldbB, nt, sc; };
__host__ __device__ __forceinline__ Shape shape_bf16(int lda, int ldb, int K) { return Shape{2 * lda, 2 * ldb, K / 64, 0}; }
__host__ __device__ __forceinline__ Shape shape_fp8(int lda, int ldb, int K, int ea, int eb) { return Shape{lda, ldb, K / 128, ((127 - ea) << 8) | (127 - eb)}; }

__device__ __forceinline__ void tile_of(int l, int nM, int nN, int& pm, int& pn) {
    const int nwg = nM * nN; int wgid = l;
    { const int q = nwg / NXCD, r = nwg % NXCD, xcd = wgid % NXCD, off = wgid / NXCD; wgid = (xcd < r ? xcd * (q + 1) : r * (q + 1) + (xcd - r) * q) + off; }
    const int nig = WGM * nN, gid = wgid / nig, fm = gid * WGM, gsz = (nM - fm) < WGM ? (nM - fm) : WGM;
    pm = fm + ((wgid % nig) % gsz); pn = (wgid % nig) / gsz;
}

enum Act { ACT_NONE = 0, ACT_TANH = 1, ACT_SIGMOID = 2, ACT_EW = 3, ACT_BIAS_SIGMOID = 4, ACT_COLSCALE = 5 };
__device__ __forceinline__ float act_apply(float v, float b, int act) {
    if (act == ACT_TANH) return tanhf_(v);
    if (act == ACT_SIGMOID) return sigmoidf_(v);
    if (act == ACT_EW) { const float z = -(v + b); const float sp = (z > 20.f) ? z : flog(1.0f + fexp(z)); return fexp(-sp - 0.5f); }
    if (act == ACT_BIAS_SIGMOID) return sigmoidf_(v + b);
    if (act == ACT_COLSCALE) return v * b;
    return v;
}
struct EpiAct {
    static constexpr bool PERM = true, AFTER_DRAIN = false;
    __device__ __forceinline__ void operator()(const f32x4 (&acc)[2][2][4][2], const Unit& u, int wr, int wc) const {
        const int lane_ = lane_id(), fr = lane_ & 15, fq = lane_ >> 4;
        const int row0 = u.pm * BM + wr * 64 + fr, col0 = u.pn * BM + wc * 32 + 8 * fq; const int act = u.act;
        f32x4 bv[2][2];
#pragma unroll
        for (int bj = 0; bj < 2; ++bj)
#pragma unroll
            for (int n = 0; n < 2; ++n) bv[bj][n] = u.bias ? *(const f32x4*)(u.bias + col0 + bj * HALF + 4 * n) : (f32x4){0.f, 0.f, 0.f, 0.f};
#pragma unroll
        for (int ai = 0; ai < 2; ++ai)
#pragma unroll
            for (int m = 0; m < 4; ++m) { bf16_t* rowp = u.O + (size_t)(row0 + ai * HALF + m * 16) * u.ldc + col0;
#pragma unroll
                for (int bj = 0; bj < 2; ++bj) { f32x4 v0 = acc[ai][bj][m][0], v1 = acc[ai][bj][m][1];
                    if (act != ACT_NONE) {
#pragma unroll
                        for (int j = 0; j < 4; ++j) { v0[j] = act_apply(v0[j], bv[bj][0][j], act); v1[j] = act_apply(v1[j], bv[bj][1][j], act); } }
                    u32x4 w; w.x = cvt_pk_bf16(v0[0], v0[1]); w.y = cvt_pk_bf16(v0[2], v0[3]); w.z = cvt_pk_bf16(v1[0], v1[1]); w.w = cvt_pk_bf16(v1[2], v1[3]);
                    *(u32x4*)(rowp + bj * HALF) = w; } }
    }
};
struct EpiF32P {
    static constexpr bool PERM = true, AFTER_DRAIN = false;
    __device__ __forceinline__ void operator()(const f32x4 (&acc)[2][2][4][2], const Unit& u, int wr, int wc) const {
        const int lane_ = lane_id(), fr = lane_ & 15, fq = lane_ >> 4;
        const int row0 = u.pm * BM + wr * 64 + fr, col0 = u.pn * BM + wc * 32 + 8 * fq;
#pragma unroll
        for (int ai = 0; ai < 2; ++ai)
#pragma unroll
            for (int m = 0; m < 4; ++m) { float* rowp = (float*)u.O + (size_t)(row0 + ai * HALF + m * 16) * u.ldc + col0;
#pragma unroll
                for (int bj = 0; bj < 2; ++bj) { *(f32x4*)(rowp + bj * HALF) = acc[ai][bj][m][0]; *(f32x4*)(rowp + bj * HALF + 4) = acc[ai][bj][m][1]; } }
    }
};
struct EpiSwiglu {
    static constexpr bool PERM = true, AFTER_DRAIN = false;
    __device__ __forceinline__ void operator()(const f32x4 (&acc)[2][2][4][2], const Unit& u, int wr, int wc) const {
        const int lane_ = lane_id(), fr = lane_ & 15, fq = lane_ >> 4;
        const int row0 = u.pm * BM + wr * 64 + fr, col0 = u.pn * HALF + wc * 32 + 8 * fq;
#pragma unroll
        for (int ai = 0; ai < 2; ++ai)
#pragma unroll
            for (int m = 0; m < 4; ++m) { bf16_t* rowp = u.O + (size_t)(row0 + ai * HALF + m * 16) * u.ldc + col0;
                f32x4 o0, o1;
#pragma unroll
                for (int j = 0; j < 4; ++j) { o0[j] = siluf_(acc[ai][0][m][0][j]) * acc[ai][1][m][0][j]; o1[j] = siluf_(acc[ai][0][m][1][j]) * acc[ai][1][m][1][j]; }
                u32x4 w; w.x = cvt_pk_bf16(o0[0], o0[1]); w.y = cvt_pk_bf16(o0[2], o0[3]); w.z = cvt_pk_bf16(o1[0], o1[1]); w.w = cvt_pk_bf16(o1[2], o1[3]);
                *(u32x4*)rowp = w; }
    }
};

struct EpiSwiglu8 {
    static constexpr bool PERM = true, AFTER_DRAIN = false;
    __device__ __forceinline__ void operator()(const f32x4 (&acc)[2][2][4][2], const Unit& u, int wr, int wc) const {
        const int lane_ = lane_id(), fr = lane_ & 15, fq = lane_ >> 4;
        const int row0 = u.pm * BM + wr * 64 + fr, col0 = u.pn * HALF + wc * 32 + 8 * fq;
#pragma unroll
        for (int ai = 0; ai < 2; ++ai)
#pragma unroll
            for (int m = 0; m < 4; ++m) { unsigned char* rowp = (unsigned char*)u.O + (size_t)(row0 + ai * HALF + m * 16) * u.ldc + col0;
                f32x4 o0, o1;
#pragma unroll
                for (int j = 0; j < 4; ++j) { o0[j] = siluf_(acc[ai][0][m][0][j]) * acc[ai][1][m][0][j] * 8.0f; o1[j] = siluf_(acc[ai][0][m][1][j]) * acc[ai][1][m][1][j] * 8.0f; }
                u32x2 w; w.x = pk4_fp8(o0[0], o0[1], o0[2], o0[3]); w.y = pk4_fp8(o1[0], o1[1], o1[2], o1[3]);
                *(u32x2*)rowp = w; }
    }
};

template <class Epi, class Sched, bool ALIGN_EPI = true, bool SP2 = true, bool FP8 = false>
__device__ __forceinline__ void gemm_phase(PG8_LAS unsigned char* lds, const Shape g, const Sched& S, const Epi& E) {
    const int lane = lane_id(), wid = __builtin_amdgcn_readfirstlane((int)(threadIdx.x >> 6)), tid = wid * 64 + lane, wr = wid >> 2, wc = wid & 3, fr = lane & 15, fq = lane >> 4;
    const int nt = g.nt;
    unsigned voffA[2], voffB[2];
#pragma unroll
    for (int i = 0; i < 2; ++i) { int R, C; stage_rc(tid * 16 + i * 8192, R, C); const int Rb = Epi::PERM ? ((R & ~31) + perm32(R & 31)) : R;
        voffA[i] = (unsigned)(R * g.ldaB + C * 2); voffB[i] = (unsigned)(Rb * g.ldbB + C * 2); }
    const size_t kstep = (size_t)(BK * 2);
    const size_t hstepA = (size_t)HALF * g.ldaB, hstepB = (size_t)HALF * g.ldbB;
    const unsigned ldsw = (unsigned)wid * 1024u;
    const int aoff = lds_byte(wr * 64 + fr, fq * 8), boff = lds_byte(wc * 32 + fr, fq * 8);
#define PG8_SA(b, h) (((b) * 2 + (h)) * HTB)
#define PG8_SB(b, h) ((4 + (b) * 2 + (h)) * HTB)
#define PG8_STAGE(bufoff, gbase, voff) do { _Pragma("unroll") for (int _i = 0; _i < 2; ++_i) \
        __builtin_amdgcn_global_load_lds((const unsigned*)((const char*)(gbase) + (voff)[_i]), (PG8_LAS unsigned*)(lds + (bufoff) + ldsw + _i * 8192), 16, 0, 0); } while (0)
#define PG8_LDA(dst, b, h) do { _Pragma("unroll") for (int m = 0; m < 4; ++m) _Pragma("unroll") for (int k = 0; k < 2; ++k) dst[m][k] = *(const PG8_LAS bf16x8*)(lds + PG8_SA(b, h) + aoff + m * 2048 + k * 1024); } while (0)
#define PG8_LDB(dst, b, h) do { _Pragma("unroll") for (int n = 0; n < 2; ++n) _Pragma("unroll") for (int k = 0; k < 2; ++k) dst[n][k] = *(const PG8_LAS bf16x8*)(lds + PG8_SB(b, h) + boff + n * 2048 + k * 1024); } while (0)
#define PG8_MMA(ai, bj, At, Bt) do { __builtin_amdgcn_s_setprio(1); _Pragma("unroll") for (int m = 0; m < 4; ++m) _Pragma("unroll") for (int n = 0; n < 2; ++n) { \
        if constexpr (FP8) { const i32x4 b0_ = __builtin_bit_cast(i32x4, Bt[n][0]), b1_ = __builtin_bit_cast(i32x4, Bt[n][1]), a0_ = __builtin_bit_cast(i32x4, At[m][0]), a1_ = __builtin_bit_cast(i32x4, At[m][1]); \
            const i32x8 B8_ = __builtin_shufflevector(b0_, b1_, 0, 1, 2, 3, 4, 5, 6, 7), A8_ = __builtin_shufflevector(a0_, a1_, 0, 1, 2, 3, 4, 5, 6, 7); \
            asm volatile("v_mfma_scale_f32_16x16x128_f8f6f4 %0, %1, %2, %0, %3, %3 op_sel:[0,1,0] op_sel_hi:[0,0,0]" : "+v"(acc[ai][bj][m][n]) : "v"(B8_), "v"(A8_), "v"(g.sc)); } \
        else { _Pragma("unroll") for (int k = 0; k < 2; ++k) acc[ai][bj][m][n] = __builtin_amdgcn_mfma_f32_16x16x32_bf16(Bt[n][k], At[m][k], acc[ai][bj][m][n], 0, 0, 0); } } \
        __builtin_amdgcn_s_setprio(0); } while (0)
#define PG8_WAIT_V(n) asm volatile("s_waitcnt vmcnt(" #n ")" ::: "memory")
#define PG8_WAIT_L(n) asm volatile("s_waitcnt lgkmcnt(" #n ")" ::: "memory")
#define PG8_BAR __builtin_amdgcn_s_barrier()
#define PG8_SCHED __builtin_amdgcn_sched_barrier(0)
    Unit cur, nxt; int ui = 0;
    if (!S.next(0, cur)) return;
    f32x4 acc[2][2][4][2];
#pragma unroll
    for (int a = 0; a < 2; ++a)
#pragma unroll
        for (int b = 0; b < 2; ++b)
#pragma unroll
            for (int m = 0; m < 4; ++m)
#pragma unroll
                for (int n = 0; n < 2; ++n) acc[a][b][m][n] = (f32x4){0.f, 0.f, 0.f, 0.f};
    bf16x8 At[4][2], B0[2][2], B1[2][2];
    const char* cA = cur.A; const char* cB = cur.B;
    S.a_ready(cur);
    if constexpr (SP2) {
        PG8_STAGE(PG8_SB(0, 0), cB, voffB); PG8_STAGE(PG8_SB(0, 1), cB + hstepB, voffB); PG8_STAGE(PG8_SA(0, 0), cA, voffA); PG8_STAGE(PG8_SA(0, 1), cA + hstepA, voffA);
        if (wr == 1) PG8_BAR;
        PG8_WAIT_V(2); PG8_BAR;
        PG8_STAGE(PG8_SB(1, 0), cB + kstep, voffB); PG8_STAGE(PG8_SA(1, 0), cA + kstep, voffA); PG8_STAGE(PG8_SB(1, 1), cB + hstepB + kstep, voffB);
        PG8_WAIT_V(6); PG8_BAR;
    } else {
        PG8_STAGE(PG8_SB(0, 0), cB, voffB); PG8_STAGE(PG8_SA(0, 0), cA, voffA); PG8_STAGE(PG8_SB(0, 1), cB + hstepB, voffB); PG8_STAGE(PG8_SA(0, 1), cA + hstepA, voffA);
        if (wr == 1) PG8_BAR;
        PG8_WAIT_V(4); PG8_BAR;
        PG8_STAGE(PG8_SB(1, 0), cB + kstep, voffB); PG8_STAGE(PG8_SA(1, 0), cA + kstep, voffA); PG8_STAGE(PG8_SB(1, 1), cB + hstepB + kstep, voffB);
        PG8_WAIT_V(6); PG8_BAR;
    }
    for (;;) {
        const bool has_next = S.next(ui + 1, nxt);
        const char* nA = has_next ? nxt.A : cA; const char* nB = has_next ? nxt.B : cB;
        for (int t = 0; t < nt; t += 2) {
            const bool last = (t == nt - 2);
            const char* a1 = cA + (size_t)(t + 1) * kstep;
            const char* a2 = last ? nA : cA + (size_t)(t + 2) * kstep; const char* b2 = last ? nB : cB + (size_t)(t + 2) * kstep;
            const char* a3 = a2 + kstep; const char* b3 = b2 + kstep;
            if (last && has_next) S.a_ready(nxt);
            if constexpr (SP2) {
            PG8_LDB(B0, 0, 0); PG8_LDB(B1, 0, 1); PG8_SCHED; PG8_LDA(At, 0, 0); PG8_STAGE(PG8_SA(1, 1), a1 + hstepA, voffA);
            PG8_WAIT_V(8); PG8_WAIT_L(0); PG8_BAR; PG8_MMA(0, 0, At, B0); PG8_MMA(0, 1, At, B1); PG8_BAR; PG8_SCHED;
            PG8_LDA(At, 0, 1); PG8_STAGE(PG8_SB(0, 0), b2, voffB); PG8_STAGE(PG8_SB(0, 1), b2 + hstepB, voffB); PG8_STAGE(PG8_SA(0, 0), a2, voffA);
            PG8_WAIT_V(8); PG8_WAIT_L(0); PG8_BAR; PG8_MMA(1, 0, At, B0); PG8_MMA(1, 1, At, B1); PG8_BAR; PG8_SCHED;
            PG8_LDB(B0, 1, 0); PG8_LDB(B1, 1, 1); PG8_SCHED; PG8_LDA(At, 1, 0); PG8_STAGE(PG8_SA(0, 1), a2 + hstepA, voffA);
            PG8_WAIT_V(8); PG8_WAIT_L(0); PG8_BAR; PG8_MMA(0, 0, At, B0); PG8_MMA(0, 1, At, B1); PG8_BAR; PG8_SCHED;
            PG8_LDA(At, 1, 1); PG8_STAGE(PG8_SB(1, 0), b3, voffB); PG8_STAGE(PG8_SB(1, 1), b3 + hstepB, voffB); PG8_STAGE(PG8_SA(1, 0), a3, voffA);
            PG8_WAIT_V(8); PG8_WAIT_L(0); PG8_BAR; PG8_MMA(1, 0, At, B0); PG8_MMA(1, 1, At, B1); PG8_BAR; PG8_SCHED;
            } else {
            PG8_LDB(B0, 0, 0); PG8_SCHED; PG8_LDA(At, 0, 0); PG8_STAGE(PG8_SA(1, 1), a1 + hstepA, voffA);
            PG8_WAIT_L(8); PG8_BAR; PG8_WAIT_L(0); PG8_MMA(0, 0, At, B0); PG8_BAR; PG8_SCHED;
            PG8_LDB(B1, 0, 1); PG8_STAGE(PG8_SB(0, 0), b2, voffB);
            PG8_BAR; PG8_WAIT_L(0); PG8_MMA(0, 1, At, B1); PG8_BAR;
            PG8_LDA(At, 0, 1); PG8_STAGE(PG8_SA(0, 0), a2, voffA);
            PG8_BAR; PG8_WAIT_L(0); PG8_MMA(1, 0, At, B0); PG8_BAR; PG8_SCHED;
            PG8_STAGE(PG8_SB(0, 1), b2 + hstepB, voffB);
            PG8_WAIT_V(6); PG8_BAR; PG8_MMA(1, 1, At, B1); PG8_BAR;
            PG8_LDB(B0, 1, 0); PG8_SCHED; PG8_LDA(At, 1, 0); PG8_STAGE(PG8_SA(0, 1), a2 + hstepA, voffA);
            PG8_WAIT_L(8); PG8_BAR; PG8_WAIT_L(0); PG8_MMA(0, 0, At, B0); PG8_BAR; PG8_SCHED;
            PG8_LDB(B1, 1, 1); PG8_STAGE(PG8_SB(1, 0), b3, voffB);
            PG8_BAR; PG8_WAIT_L(0); PG8_MMA(0, 1, At, B1); PG8_BAR;
            PG8_LDA(At, 1, 1); PG8_STAGE(PG8_SA(1, 0), a3, voffA);
            PG8_BAR; PG8_WAIT_L(0); PG8_MMA(1, 0, At, B0); PG8_BAR; PG8_SCHED;
            PG8_STAGE(PG8_SB(1, 1), b3 + hstepB, voffB);
            PG8_WAIT_V(6); PG8_BAR; PG8_MMA(1, 1, At, B1); PG8_BAR;
            }
        }
        if constexpr (ALIGN_EPI) { if (wr == 0) PG8_BAR; }
        if constexpr (FP8) asm volatile("s_nop 15\n\ts_nop 15\n\ts_nop 15" ::: "memory");
        if constexpr (!Epi::AFTER_DRAIN) { E(acc, cur, wr, wc); S.done(cur); }
        if (!has_next) break;
#pragma unroll
        for (int a = 0; a < 2; ++a)
#pragma unroll
            for (int b = 0; b < 2; ++b)
#pragma unroll
                for (int m = 0; m < 4; ++m)
#pragma unroll
                    for (int n = 0; n < 2; ++n) acc[a][b][m][n] = (f32x4){0.f, 0.f, 0.f, 0.f};
        cur = nxt; cA = nA; cB = nB; ++ui;
        if constexpr (ALIGN_EPI) { if (wr == 1) PG8_BAR; }
    }
    PG8_WAIT_V(0);
    if constexpr (!ALIGN_EPI) { if (wr == 0) PG8_BAR; }
    PG8_BAR;
    if constexpr (Epi::AFTER_DRAIN) { E.fused(acc, cur, wr, wc, fr, fq, lds, wid, lane); S.done(cur); }
#undef PG8_SA
#undef PG8_SB
#undef PG8_STAGE
#undef PG8_LDA
#undef PG8_LDB
#undef PG8_MMA
#undef PG8_WAIT_V
#undef PG8_WAIT_L
#undef PG8_BAR
#undef PG8_SCHED
}

}

#ifndef MOE_FP8
#define MOE_FP8 1
#endif
#ifndef FFN_FP8
#define FFN_FP8 0
#endif
constexpr size_t MiB = 1u << 20;
constexpr size_t WS_CTL = 0, CTL_ZERO_BYTES = 1 * MiB;
constexpr size_t WS_MOD = 1 * MiB;
constexpr size_t WS_TOK = 2 * MiB;
constexpr size_t WS_SB  = 3 * MiB;
constexpr size_t WS_POS = 6 * MiB;
constexpr size_t WS_XR  = 22 * MiB;
constexpr size_t WS_W   = 86 * MiB;
constexpr size_t W_WR = WS_W, W_WK = W_WR + 8 * MiB, W_WV = W_WK + 8 * MiB, W_WO = W_WV + 8 * MiB;
constexpr size_t W_WLD = W_WO + 8 * MiB, W_ALD = W_WLD + 1 * MiB, W_G1 = W_ALD + 1 * MiB;
constexpr size_t W_WLU = W_G1 + 1 * MiB, W_ALU = W_WLU + 2 * MiB, W_G2 = W_ALU + 2 * MiB;
constexpr size_t W_PW = W_G2 + 1 * MiB;
constexpr size_t W_F13 = W_PW + 2 * MiB;
constexpr size_t W_F2 = W_F13 + 44 * MiB;
constexpr size_t W_M13 = W_F2 + 22 * MiB;
constexpr size_t W_M2 = W_M13 + 448 * MiB;
constexpr size_t WS_A = W_M2 + 224 * MiB;
constexpr size_t A_A6 = WS_A, A6_STRIDE = 36 * MiB;
constexpr size_t A_R = WS_A + 216 * MiB, A_KX = WS_A + 248 * MiB, A_V = WS_A + 284 * MiB;
constexpr size_t A_LW = WS_A + 320 * MiB, A_LA = WS_A + 325 * MiB, A_G1O = WS_A + 330 * MiB;
constexpr size_t A_EW = WS_A + 336 * MiB, A_AA = WS_A + 408 * MiB;
constexpr size_t A_GATE = WS_A + 480 * MiB, A_YD = WS_A + 512 * MiB;
constexpr size_t A_AO = WS_A + 580 * MiB, A_YO = WS_A + 612 * MiB;
constexpr size_t A_H2 = WS_A, A_U = WS_A + 32 * MiB, A_YF = WS_A + 120 * MiB, A_HP = WS_A + 152 * MiB, A_PP = WS_A + 184 * MiB, A_YP = WS_A + 216 * MiB, A_H2B = WS_A + 248 * MiB;
constexpr size_t A_HG = WS_A + 280 * MiB, A_UG = WS_A + 352 * MiB, A_Y2 = WS_A + 604 * MiB;
constexpr size_t WS_PART = WS_A + 676 * MiB;
constexpr int MOE_KS = 7, MOE_RT = 64;
constexpr size_t WS_END = WS_PART + 112 * MiB;
static_assert(A_YO + 32 * MiB <= WS_PART && A_Y2 + (size_t)MROWS_PAD * D * 2 <= WS_END && A_UG + (size_t)MROWS_PAD * DFE * 2 <= A_Y2 && A_HG + (size_t)MROWS_PAD * D * 2 <= A_UG, "ws map");
static_assert(W_M13 + (size_t)NE * 2 * DFE * D * 2 == W_M2 && W_M2 + (size_t)NE * D * DFE * 2 == WS_A && W_F13 + (size_t)2 * DFF * D * 2 == W_F2, "weight map");
constexpr int CW_BAR = 4096;
constexpr int CW_GCNT = 16384;

constexpr int LDS_BYTES = 147456;
constexpr int MISC_OFF = LDS_BYTES - 256;

#define XB_TMO      128
#define XB_XCNT(j)  (256  + 64 * (j))
#define XB_XSUB(j)  (1280 + 64 * (j))
#define XB_XGEN(j)  (2304 + 64 * (j))
#define XB_TOP      3328
#define XB_TOPGEN   3392
#define XCD_BAR_WORDS 3456
#define XB_SPIN_CAP (1u << 18)
__device__ __forceinline__ unsigned xb_ld(unsigned* p)              { return __hip_atomic_load(p, __ATOMIC_RELAXED, __HIP_MEMORY_SCOPE_AGENT); }
__device__ __forceinline__ unsigned xb_add(unsigned* p, unsigned v) { return __hip_atomic_fetch_add(p, v, __ATOMIC_RELAXED, __HIP_MEMORY_SCOPE_AGENT); }
__device__ __forceinline__ unsigned xb_xcc_id() { return (unsigned)__builtin_amdgcn_s_getreg((3 << 11) | 20) & 0xFu; }
#define XB_SPIN(cond, bar) do { unsigned _sp = 0; while (cond) { __builtin_amdgcn_s_sleep(1); \
    if ((++_sp & 255u) == 0u) { if (xb_ld(&(bar)[XB_TMO])) break; if (_sp > XB_SPIN_CAP) { atomicAdd(&(bar)[XB_TMO], 1u); break; } } } } while (0)
struct XcdBarrier { unsigned* bar; unsigned x; volatile LAS unsigned* st; };
__device__ __forceinline__ XcdBarrier xcd_barrier_post(unsigned* bar, volatile LAS unsigned* st) {
    XcdBarrier b; b.bar = bar; b.x = xb_xcc_id(); b.st = st;
    if (threadIdx.x == 0) (void)xb_add(&bar[XB_XCNT(b.x)], 1u);
    return b;
}
__device__ __forceinline__ void xcd_barrier_complete(unsigned* bar, unsigned x, unsigned& nloc, unsigned& nx) {
    const unsigned G = gridDim.x * gridDim.y * gridDim.z;
    unsigned sum, cnt, mine, sp = 0u;
    for (;;) {
        sum = 0u; cnt = 0u; mine = 0u;
#pragma unroll
        for (unsigned j = 0; j < 16; ++j) { const unsigned c = xb_ld(&bar[XB_XCNT(j)]); sum += c; cnt += (c > 0u) ? 1u : 0u; mine = (j == x) ? c : mine; }
        if (sum == G) break;
        __builtin_amdgcn_s_sleep(1);
        if ((++sp & 255u) == 0u) { if (xb_ld(&bar[XB_TMO])) break; if (sp > XB_SPIN_CAP) { atomicAdd(&bar[XB_TMO], 1u); break; } }
    }
    nloc = mine > 0u ? mine : 1u; nx = cnt > 0u ? cnt : 1u;
}
__device__ __forceinline__ void xcd_barrier(const XcdBarrier& b) {
    asm volatile("s_waitcnt vmcnt(0)" ::: "memory");
    __syncthreads();
    if (threadIdx.x == 0) {
        unsigned* bar = b.bar;
        __builtin_amdgcn_s_waitcnt(0);
        unsigned nloc = b.st[0], nx = b.st[1];
        if (nloc == 0u) { xcd_barrier_complete(bar, b.x, nloc, nx); b.st[0] = nloc; b.st[1] = nx; }
        const unsigned old = xb_add(&bar[XB_XSUB(b.x)], 1u);
        const unsigned gen = old / nloc;
        if (old + 1u == (gen + 1u) * nloc) {
            __builtin_amdgcn_fence(__ATOMIC_RELEASE, "agent");
            asm volatile("s_waitcnt vmcnt(0)" ::: "memory");
            const unsigned og = xb_add(&bar[XB_TOP], 1u);
            const unsigned tg = og / nx;
            if (og + 1u == (tg + 1u) * nx) xb_add(&bar[XB_TOPGEN], 1u);
            else XB_SPIN(xb_ld(&bar[XB_TOPGEN]) == tg, bar);
            __builtin_amdgcn_fence(__ATOMIC_ACQUIRE, "agent");
            xb_add(&bar[XB_XGEN(b.x)], 1u);
            asm volatile("s_waitcnt vmcnt(0)" ::: "memory");
        } else {
            XB_SPIN(xb_ld(&bar[XB_XGEN(b.x)]) == gen, bar);
            __builtin_amdgcn_fence(__ATOMIC_ACQUIRE, "agent");
            asm volatile("s_waitcnt vmcnt(0)" ::: "memory");
        }
    }
    __syncthreads();
}

struct Args { const float* in[35]; float* out; unsigned char* ws; int ph_lo, ph_hi, li, pad; };
static_assert(sizeof(Args) == 35 * 8 + 8 + 8 + 16, "Args has no padding");
enum In { I_X = 0, I_C, I_CTX, I_CCTX, I_WMOD, I_BMOD, I_LNW, I_LNB, I_MU, I_WR, I_WK, I_WV, I_WO, I_DW0, I_DW1, I_DW2, I_IA0, I_IA1, I_IA2, I_G1, I_G2, I_KK, I_KA, I_RK, I_GNW, I_GNB,
          I_POOLW, I_POOLS, I_FW1, I_FW3, I_FW2, I_ROUTER, I_MW1, I_MW3, I_MW2 };
struct Frame {
    LAS unsigned char* lds; int wave, vcu, G, gw, NGW;
    unsigned char* ws; unsigned* ctl;
};
#define LDS_WAIT() asm volatile("s_waitcnt lgkmcnt(0)" ::: "memory")
__device__ __forceinline__ void unpack8(const u32x4 w, float (&f)[8]) { f[0] = bflo(w.x); f[1] = bfhi(w.x); f[2] = bflo(w.y); f[3] = bfhi(w.y); f[4] = bflo(w.z); f[5] = bfhi(w.z); f[6] = bflo(w.w); f[7] = bfhi(w.w); }

__device__ __forceinline__ void p0_mod(const Frame& F, const Args& a) {
    const int lane = lane_id(), tid = F.wave * 64 + lane; (void)tid;
    LAS float* sc = (LAS float*)F.lds;
    LAS float* red = (LAS float*)(F.lds + 40960);
    const float* c = a.in[I_C]; const float* cc = a.in[I_CCTX];
    for (int i = tid; i < 5 * D; i += 512) { const int j = i / D, k = i % D; const float v = j < 4 ? c[j * D + k] : cc[k]; sc[i] = siluf_(v); }
    __syncthreads();
    float* MOD = (float*)(F.ws + WS_MOD);
    const int x = lane & 15, q = lane >> 4;
    for (int u = blockIdx.x; u < 2 * (MOD_N / 64); u += F.G) {
        const int l = u / (MOD_N / 64), cb = u % (MOD_N / 64);
        const float* W = a.in[I_WMOD] + (size_t)l * D * MOD_N + cb * 64 + 4 * x;
        float acc[5][4];
#pragma unroll
        for (int j = 0; j < 5; ++j)
#pragma unroll
            for (int e = 0; e < 4; ++e) acc[j][e] = 0.f;
#pragma unroll 8
        for (int i = 0; i < 64; ++i) {
            const int k = F.wave * 256 + 4 * i + q;
            const f32x4 w = *(const f32x4*)(W + (size_t)k * MOD_N);
#pragma unroll
            for (int j = 0; j < 5; ++j) { const float s = sc[j * D + k];
#pragma unroll
                for (int e = 0; e < 4; ++e) acc[j][e] += s * w[e]; }
        }
#pragma unroll
        for (int j = 0; j < 5; ++j)
#pragma unroll
            for (int e = 0; e < 4; ++e) { float v = acc[j][e]; v += __shfl_xor(v, 16); v += __shfl_xor(v, 32); acc[j][e] = v; }
        __syncthreads();
        if (q == 0) {
#pragma unroll
            for (int j = 0; j < 5; ++j)
#pragma unroll
                for (int e = 0; e < 4; ++e) red[(F.wave * 5 + j) * 64 + 4 * x + e] = acc[j][e];
        }
        __syncthreads();
        if (tid < 320) { const int j = tid / 64, col = tid % 64; float s = 0.f;
#pragma unroll
            for (int w = 0; w < 8; ++w) s += red[(w * 5 + j) * 64 + col];
            MOD[(size_t)(l * 5 + j) * MOD_N + cb * 64 + col] = s + a.in[I_BMOD][l * MOD_N + cb * 64 + col]; }
    }
    __syncthreads();
}
__device__ __forceinline__ void p0_pos(const Frame& F) {
    const int lane = lane_id(), tid = F.wave * 64 + lane; (void)tid;
    float* POS = (float*)(F.ws + WS_POS);
    for (int t = F.gw; t < T; t += F.NGW) {
        const float frow = (float)(t >> 6), fcol = (float)(t & 63);
#pragma unroll
        for (int j = 0; j < 8; ++j) { const int c0 = 4 * lane + 256 * j; f32x4 o;
#pragma unroll
            for (int e = 0; e < 4; ++e) { const int c = c0 + e, qi = c >> 9, i = c & 511;
                const float omega = fexp(-(float)i * (9.21034037197618f / 512.0f));
                float rev = ((qi < 2) ? frow : fcol) * omega * 0.15915494309189535f;
                rev -= floorf(rev);
                o[e] = (qi & 1) ? __builtin_amdgcn_cosf(rev) : __builtin_amdgcn_sinf(rev); }
            *(f32x4*)(POS + (size_t)t * D + c0) = o; }
    }
}
constexpr int TN_F13 = FFN_FP8 ? 1408 : 2816, TN_F2 = FFN_FP8 ? 1408 : 2816, TN_M = MOE_FP8 ? 1792 : 3584;
constexpr int TI_RWKV = 4096, TI_F1 = TI_RWKV + TN_F13, TI_F3 = TI_F1 + TN_F13, TI_F2 = TI_F3 + TN_F2, TI_POOL = TI_F2 + 256, TI_M1 = TI_POOL + 8 * TN_M, TI_M3 = TI_M1 + 8 * TN_M, TI_M2 = TI_M3 + 8 * TN_M;
struct TrItem { const float* src; unsigned char* dst; int src_ld, dst_ld  , k0  , kbyte  , n0, drow0, f8; float sc; };
__device__ __forceinline__ TrItem tr_decode(const Frame& F, const Args& a, int it) {
    TrItem t; t.f8 = 0; t.sc = 1.0f; int kb, nb;
    if (it < TI_RWKV) { const int m = it >> 10, r = it & 1023; kb = r >> 5; nb = r & 31;
        t.src = a.in[I_WR + m]; t.src_ld = D; t.dst = F.ws + W_WR + (size_t)m * 8 * MiB; t.dst_ld = 2 * D; t.drow0 = 64 * nb; }
    else if (it < TI_F3) { const int w3 = it >= TI_F1, r = it - (w3 ? TI_F1 : TI_RWKV); kb = r / 88; nb = r % 88; const int n0 = 64 * nb;
        t.src = a.in[w3 ? I_FW3 : I_FW1]; t.src_ld = DFF; t.dst = F.ws + W_F13; t.dst_ld = FFN_FP8 ? D : 2 * D; t.drow0 = (n0 >> 7) * 256 + (n0 & 127) + 128 * w3; t.f8 = FFN_FP8; t.sc = FFN_FP8 ? 64.0f : 1.0f; }
    else if (it < TI_F2) { const int r = it - TI_F3; kb = r >> 5; nb = r & 31;
        t.src = a.in[I_FW2]; t.src_ld = D; t.dst = F.ws + W_F2; t.dst_ld = FFN_FP8 ? DFF : 2 * DFF; t.drow0 = 64 * nb; t.f8 = FFN_FP8; t.sc = FFN_FP8 ? 256.0f : 1.0f; }
    else if (it < TI_POOL) { const int r = it - TI_F2, g = r >> 6; kb = (r >> 3) & 7; nb = r & 7;
        t.src = a.in[I_POOLW] + (size_t)g * 512 * 512; t.src_ld = 512; t.dst = F.ws + W_PW + (size_t)g * 512 * 512 * 2; t.dst_ld = 2 * 512; t.drow0 = 64 * nb; }
    else if (it < TI_M3) { const int w3 = it >= TI_M1, r = it - (w3 ? TI_M1 : TI_POOL), e = r / TN_M, rr = r % TN_M; kb = rr / 112; nb = rr % 112; const int n0 = 64 * nb;
        t.src = a.in[w3 ? I_MW3 : I_MW1] + (size_t)e * D * DFE; t.src_ld = DFE; t.dst_ld = MOE_FP8 ? D : 2 * D; t.dst = F.ws + W_M13 + (size_t)e * 2 * DFE * t.dst_ld;
        t.drow0 = (n0 >> 7) * 256 + (n0 & 127) + 128 * w3; t.f8 = MOE_FP8; t.sc = MOE_FP8 ? 64.0f : 1.0f; }
    else { const int r = it - TI_M3, e = r / TN_M, rr = r % TN_M; kb = rr >> 5; nb = rr & 31;
        t.src = a.in[I_MW2] + (size_t)e * DFE * D; t.src_ld = D; t.dst_ld = MOE_FP8 ? DFE : 2 * DFE; t.dst = F.ws + W_M2 + (size_t)e * D * t.dst_ld; t.drow0 = 64 * nb; t.f8 = MOE_FP8; t.sc = MOE_FP8 ? 256.0f : 1.0f; }
    t.n0 = 64 * nb; t.kbyte = 128 * kb; t.k0 = t.f8 ? 128 * kb : 64 * kb; return t;
}
__device__ __forceinline__ void tr_load(const TrItem& t, int h, f32x4 (&r)[4][4], int lane) {
    const int x = lane & 15, q = lane >> 4; const float* p = t.src + (size_t)(t.k0 + 64 * h + 4 * q) * t.src_ld + t.n0 + 4 * x;
#pragma unroll
    for (int i = 0; i < 4; ++i)
#pragma unroll
        for (int s = 0; s < 4; ++s) r[i][s] = __builtin_nontemporal_load((const f32x4*)(p + (size_t)(16 * i + s) * t.src_ld));
}
__device__ __forceinline__ void tr_store(const TrItem& t, int h, const f32x4 (&r)[4][4], LAS unsigned* scr, int lane) {
    const int x = lane & 15, q = lane >> 4;
    if (t.f8) {
#pragma unroll
        for (int i = 0; i < 4; ++i)
#pragma unroll
            for (int jj = 0; jj < 4; ++jj) scr[(4 * x + jj) * 33 + 16 * h + 4 * i + q] = pk4_fp8(r[i][0][jj] * t.sc, r[i][1][jj] * t.sc, r[i][2][jj] * t.sc, r[i][3][jj] * t.sc);
        if (h == 0) return;
    } else {
#pragma unroll
        for (int i = 0; i < 4; ++i)
#pragma unroll
            for (int jj = 0; jj < 4; ++jj) { scr[(4 * x + jj) * 33 + 8 * i + 2 * q] = pk2(r[i][0][jj], r[i][1][jj]); scr[(4 * x + jj) * 33 + 8 * i + 2 * q + 1] = pk2(r[i][2][jj], r[i][3][jj]); }
    }
    LDS_WAIT();
    const int c = lane & 7;
#pragma unroll
    for (int rr = 0; rr < 8; ++rr) { const int n = (lane >> 3) + 8 * rr; const LAS unsigned* s = scr + n * 33 + 4 * c;
        u32x4 o; o.x = s[0]; o.y = s[1]; o.z = s[2]; o.w = s[3];
        *(u32x4*)(t.dst + (size_t)(t.drow0 + n) * t.dst_ld + t.kbyte + 16 * c) = o; }
    LDS_WAIT();
}
__device__ __forceinline__ void p0_transpose_range(const Frame& F, const Args& a, int lo, int hi, int gw, int ngw, LAS unsigned* scr) {
    const int lane = lane_id();
    int it = lo + gw; if (it >= hi) return;
    f32x4 ra[4][4], rb[4][4];
    TrItem ta = tr_decode(F, a, it), tb = ta; int ha = 0, hb = 0; tr_load(ta, 0, ra, lane);
    for (;;) {
        bool hasb; if (ta.f8 && ha == 0) { tb = ta; hb = 1; hasb = true; } else { it += ngw; hasb = it < hi; if (hasb) { tb = tr_decode(F, a, it); hb = 0; } }
        if (hasb) tr_load(tb, hb, rb, lane);
        tr_store(ta, ha, ra, scr, lane);
        if (!hasb) break;
        bool hasa; if (tb.f8 && hb == 0) { ta = tb; ha = 1; hasa = true; } else { it += ngw; hasa = it < hi; if (hasa) { ta = tr_decode(F, a, it); ha = 0; } }
        if (hasa) tr_load(ta, ha, ra, lane);
        tr_store(tb, hb, rb, scr, lane);
        if (!hasa) break;
    }
}
#if defined(PROBE_READ)
__device__ __forceinline__ void probe_read(const Frame& F, const Args& a) {
    const int lane = lane_id(); float acc = 0.f;
    for (int m = 0; m < 3; ++m) { const float* base = a.in[I_MW1 + m]; const size_t n16 = (size_t)NE * D * DFE / 4;
        if (PROBE_READ == 1) { for (size_t i = (size_t)F.gw * 64 + lane; i < n16; i += (size_t)F.NGW * 64 * 16) {
                f32x4 r[16];
#pragma unroll
                for (int u = 0; u < 16; ++u) { const size_t j = i + (size_t)u * F.NGW * 64; r[u] = j < n16 ? __builtin_nontemporal_load((const f32x4*)base + j) : (f32x4){0.f, 0.f, 0.f, 0.f}; }
#pragma unroll
                for (int u = 0; u < 16; ++u) acc += r[u][0] + r[u][3]; } }
        else { const int ld = (m == 2) ? D : DFE; const int nblk = ld / 64; const size_t rows = (size_t)NE * D * DFE / ld; const size_t items = rows / 64 * nblk; const int x = lane & 15, q = lane >> 4;
            for (size_t it = F.gw; it < items; it += F.NGW) { const size_t kb = it / nblk, nb = it % nblk; const float* p = base + (kb * 64 + 4 * q) * ld + nb * 64 + 4 * x;
                f32x4 r[16];
#pragma unroll
                for (int u = 0; u < 16; ++u) r[u] = __builtin_nontemporal_load((const f32x4*)(p + (size_t)((u >> 2) * 16 + (u & 3)) * ld));
#pragma unroll
                for (int u = 0; u < 16; ++u) acc += r[u][0] + r[u][3]; } }
    }
    if (acc == 1.2345e-30f) ((float*)(F.ws + WS_PART))[F.gw * 64 + lane] = acc;
}
#endif
__device__ __forceinline__ void p0_small(const Frame& F, const Args& a) {
    const int lane = lane_id(), tid = F.wave * 64 + lane; (void)tid;
    bf16_t* WLD = (bf16_t*)(F.ws + W_WLD); bf16_t* ALD = (bf16_t*)(F.ws + W_ALD); bf16_t* G1T = (bf16_t*)(F.ws + W_G1);
    bf16_t* WLU = (bf16_t*)(F.ws + W_WLU); bf16_t* ALU = (bf16_t*)(F.ws + W_ALU); bf16_t* G2T = (bf16_t*)(F.ws + W_G2);
    const int gt = F.gw * 64 + lane, NT_ = F.NGW * 64;
    for (int i = gt; i < 256 * D; i += NT_) { const int n = i >> 11, k = i & 2047;
        float w = 0.f, v = 0.f;
        if (n < 192) { const int d = n >= 96, nn = n - 96 * d; w = a.in[I_DW1][((size_t)d * D + k) * 96 + nn]; v = a.in[I_IA1][((size_t)d * D + k) * 96 + nn]; }
        WLD[i] = (bf16_t)f2bf(w); ALD[i] = (bf16_t)f2bf(v); G1T[i] = (bf16_t)f2bf(a.in[I_G1][(size_t)k * 256 + n]); }
    for (int i = gt; i < 2 * D * 256; i += NT_) { const int n = i >> 8, k = i & 255, d = n >> 11, cidx = n & 2047, kk = k - 96 * d;
        float w = 0.f, v = 0.f;
        if (kk >= 0 && kk < 96) { w = a.in[I_DW2][((size_t)d * 96 + kk) * D + cidx]; v = a.in[I_IA2][((size_t)d * 96 + kk) * D + cidx]; }
        WLU[i] = (bf16_t)f2bf(w); ALU[i] = (bf16_t)f2bf(v); }
    for (int i = gt; i < D * 256; i += NT_) { const int n = i >> 8, k = i & 255; G2T[i] = (bf16_t)f2bf(a.in[I_G2][(size_t)k * D + n]); }
}

__device__ __forceinline__ void p1_mix(const Frame& F, const Args& a) {
    const int lane = lane_id();
    const float* MOD = (const float*)(F.ws + WS_MOD); const float* POS = (const float*)(F.ws + WS_POS);
    float* XR = (float*)(F.ws + WS_XR);
    for (int it = F.gw; it < (MT / 8) * 8; it += F.NGW) {
        const int blk = it >> 3, j = it & 7, m0 = blk * 8; const bool lat = m0 < ML;
        int t0, Tseq, modrow; const float* xs;
        if (lat) { t0 = m0 % T; Tseq = T; modrow = m0 / T; xs = a.in[I_X] + (size_t)m0 * D; }
        else { const int mm = m0 - ML; t0 = mm % TC; Tseq = TC; modrow = 4; xs = a.in[I_CTX] + (size_t)mm * D; }
        const float* sh = MOD + (size_t)modrow * MOD_N; const float* scp = sh + D;
        const float* ps = POS + (size_t)t0 * D;
        const int c = 4 * lane + 256 * j;
        f32x4 xr[10];
#pragma unroll
        for (int i = 0; i < 10; ++i) { const int tr = t0 - 1 + i; const bool ok = tr >= 0 && tr < Tseq; const int ro = ok ? i - 1 : 0;
            xr[i] = *(const f32x4*)(xs + (ptrdiff_t)ro * D + c); if (lat) xr[i] += *(const f32x4*)(ps + (ptrdiff_t)ro * D + c); }
        const f32x4 shv = *(const f32x4*)(sh + c); const f32x4 scv = *(const f32x4*)(scp + c) + 1.0f;
        f32x4 mu[6];
#pragma unroll
        for (int n = 0; n < 6; ++n) mu[n] = *(const f32x4*)(a.in[I_MU] + n * D + c);
        f32x4 h[10];
#pragma unroll
        for (int i = 0; i < 10; ++i) { const int tr = t0 - 1 + i; const bool ok = tr >= 0 && tr < Tseq; h[i] = ok ? xr[i] * scv + shv : (f32x4){0.f, 0.f, 0.f, 0.f}; }
#pragma unroll
        for (int r = 0; r < 8; ++r) {
            const f32x4 h0 = h[r + 1], xx = (h[r] + h[r + 2]) * 0.5f - h0;
            const size_t o = (size_t)(m0 + r) * D + c;
#pragma unroll
            for (int n = 0; n < 6; ++n) { if (!lat && (n == 0 || n == 5)) continue;
                const f32x4 v = h0 + xx * mu[n]; u32x2 w; w.x = pk2(v[0], v[1]); w.y = pk2(v[2], v[3]);
                *(u32x2*)((bf16_t*)(F.ws + A_A6 + (size_t)n * A6_STRIDE) + o) = w; }
            if (lat) *(f32x4*)(XR + o) = xr[r + 1];
        }
    }
}

__device__ __forceinline__ void p4_scan(const Frame& F, const Args& a) {
    const int lane = lane_id(), tid = F.wave * 64 + lane; (void)tid;
    LAS float* OP = (LAS float*)F.lds;
    LAS float* YS = (LAS float*)(F.lds + 49152);
    const bf16_t* KX = (const bf16_t*)(F.ws + A_KX); const bf16_t* VV = (const bf16_t*)(F.ws + A_V); const bf16_t* RR = (const bf16_t*)(F.ws + A_R);
    const bf16_t* EW = (const bf16_t*)(F.ws + A_EW); const bf16_t* AA = (const bf16_t*)(F.ws + A_AA);
    const int tl = tid >> 5, cp = tid & 31, vi = tid >> 3, kg = tid & 7;
    for (int s = blockIdx.x; s < NB * NH * 2; s += F.G) {
        const int b = s >> 6, h = (s >> 1) & 31, d = s & 1;
        const int ch = h * HS + 2 * cp;
        const float kkc0 = a.in[I_KK][ch], kkc1 = a.in[I_KK][ch + 1], kac0 = a.in[I_KA][ch], kac1 = a.in[I_KA][ch + 1], rkc0 = a.in[I_RK][ch], rkc1 = a.in[I_RK][ch + 1];
        bf16_t* YD = (bf16_t*)(F.ws + A_YD + (size_t)d * 32 * MiB); float* SB = (float*)(F.ws + WS_SB) + (size_t)d * ML * NH;
        float S[8];
#pragma unroll
        for (int j = 0; j < 8; ++j) S[j] = 0.f;
        unsigned rk = 0, rv = 0, rr = 0, re = 0, ra = 0;
#define SCAN_ROW0(ci) (((ci) < 16) ? (ML + b * TC + (d ? 15 - (ci) : (ci)) * 16) : (b * T + (d ? 127 - ((ci) - 16) : ((ci) - 16)) * 16))
#define SCAN_LOAD(ci) do { const int row_ = SCAN_ROW0(ci) + tl; const size_t o_ = (size_t)row_ * D + ch, o2_ = (size_t)row_ * (2 * D) + d * D + ch; \
        rk = *(const unsigned*)(KX + o_); rv = *(const unsigned*)(VV + o_); rr = ((ci) >= 16) ? *(const unsigned*)(RR + o_) : 0u; re = *(const unsigned*)(EW + o2_); ra = *(const unsigned*)(AA + o2_); } while (0)
#define SCAN_PREP(ci) do { LAS float* B_ = OP + ((ci) & 1) * 6144 + tl * 64 + 2 * cp; \
        const float k0 = bflo(rk), k1 = bfhi(rk), q0 = k0 * kkc0, q1 = k1 * kkc1; float n2 = q0 * q0 + q1 * q1; \
        n2 += __shfl_xor(n2, 1); n2 += __shfl_xor(n2, 2); n2 += __shfl_xor(n2, 4); n2 += __shfl_xor(n2, 8); n2 += __shfl_xor(n2, 16); \
        const float inv = 1.0f / fmaxf(sqrtf(n2), 1e-12f), kn0 = q0 * inv, kn1 = q1 * inv; \
        const float a0 = bflo(ra), a1 = bfhi(ra), kd0 = k0 * (1.0f + (a0 - 1.0f) * kac0), kd1 = k1 * (1.0f + (a1 - 1.0f) * kac1); \
        const float r0 = bflo(rr), r1 = bfhi(rr); \
        *(LAS f32x2*)(B_ + 0 * 1024) = (f32x2){kn0, kn1}; \
        *(LAS f32x2*)(B_ + 1 * 1024) = (f32x2){fexp(-bflo(re)), fexp(-bfhi(re))}; \
        *(LAS f32x2*)(B_ + 2 * 1024) = (f32x2){kn0 * a0, kn1 * a1}; \
        *(LAS f32x2*)(B_ + 3 * 1024) = (f32x2){kd0, kd1}; \
        *(LAS f32x2*)(B_ + 4 * 1024) = (f32x2){r0, r1}; \
        *(LAS f32x2*)(B_ + 5 * 1024) = (f32x2){bflo(rv), bfhi(rv)}; \
        if ((ci) >= 16) { float sb = r0 * kd0 * rkc0 + r1 * kd1 * rkc1; \
            sb += __shfl_xor(sb, 1); sb += __shfl_xor(sb, 2); sb += __shfl_xor(sb, 4); sb += __shfl_xor(sb, 8); sb += __shfl_xor(sb, 16); \
            if (cp == 0) SB[(size_t)(SCAN_ROW0(ci) + tl) * NH + h] = sb; } } while (0)
        __syncthreads();
        SCAN_LOAD(0); SCAN_PREP(0);
        __syncthreads();
        for (int ci = 0; ci < 144; ++ci) {
            if (ci + 1 < 144) SCAN_LOAD(ci + 1);
            const LAS float* B = OP + (ci & 1) * 6144; LAS float* Y = YS + (ci & 1) * 1024;
#pragma unroll 4
            for (int st = 0; st < 16; ++st) {
                const int tk = d ? 15 - st : st; const LAS float* p = B + tk * 64 + 8 * kg;
                const f32x4 kkA = *(const LAS f32x4*)(p), kkB = *(const LAS f32x4*)(p + 4);
                const f32x4 wA = *(const LAS f32x4*)(p + 1024), wB = *(const LAS f32x4*)(p + 1028);
                const f32x4 bA = *(const LAS f32x4*)(p + 2048), bB = *(const LAS f32x4*)(p + 2052);
                const f32x4 dA = *(const LAS f32x4*)(p + 3072), dB = *(const LAS f32x4*)(p + 3076);
                const f32x4 rA = *(const LAS f32x4*)(p + 4096), rB = *(const LAS f32x4*)(p + 4100);
                const float v = B[5 * 1024 + tk * 64 + vi];
                float sa = (S[0] * kkA[0] + S[1] * kkA[1]) + (S[2] * kkA[2] + S[3] * kkA[3]) + (S[4] * kkB[0] + S[5] * kkB[1]) + (S[6] * kkB[2] + S[7] * kkB[3]);
                sa = sum8(sa);
#pragma unroll
                for (int j = 0; j < 4; ++j) { S[j] = S[j] * wA[j] + (v * dA[j] - sa * bA[j]); S[4 + j] = S[4 + j] * wB[j] + (v * dB[j] - sa * bB[j]); }
                float y = (S[0] * rA[0] + S[1] * rA[1]) + (S[2] * rA[2] + S[3] * rA[3]) + (S[4] * rB[0] + S[5] * rB[1]) + (S[6] * rB[2] + S[7] * rB[3]);
                y = sum8(y);
                if (kg == 0) Y[tk * 64 + vi] = y;
            }
            if (ci + 1 < 144) SCAN_PREP(ci + 1);
            __syncthreads();
            if (ci >= 16) { const f32x2 yv = *(const LAS f32x2*)(Y + tl * 64 + 2 * cp);
                *(unsigned*)(YD + (size_t)(SCAN_ROW0(ci) + tl) * D + ch) = pk2(yv.x, yv.y); }
        }
#undef SCAN_ROW0
#undef SCAN_LOAD
#undef SCAN_PREP
    }
    __syncthreads();
}

constexpr int SL_KA = 0, SL_RM = 2048, SL_BK = 4096, SL_VC = 8192, SL_ARK = 10240, SL_AAK = 11264, SL_TN = 11776, SL_GC = 12288, SL_BYTES = 12544;
constexpr int SC_PAR = 8 * SL_BYTES;
typedef short s16x8 __attribute__((ext_vector_type(8)));
__device__ __forceinline__ s16x8 mk8(unsigned a, unsigned b, unsigned c, unsigned d) { u32x4 v; v.x = a; v.y = b; v.z = c; v.w = d; return __builtin_bit_cast(s16x8, v); }
__device__ __forceinline__ f32x4 mfma16(s16x8 a, s16x8 b, f32x4 c) { return __builtin_amdgcn_mfma_f32_16x16x32_bf16(a, b, c, 0, 0, 0); }
__device__ __forceinline__ s16x8 mk_d(const f32x4 x) { return mk8(pk2(x[0], x[1]), pk2(x[2], x[3]), 0u, 0u); }
__device__ __forceinline__ void p4_scan2(const Frame& F, const Args& a, unsigned char* yd_base, float* sb_base) {
    const int lane = lane_id(), tt = lane & 15, q = lane >> 4;
    const bf16_t* KX = (const bf16_t*)(F.ws + A_KX); const bf16_t* VV = (const bf16_t*)(F.ws + A_V); const bf16_t* RR = (const bf16_t*)(F.ws + A_R);
    const bf16_t* EW = (const bf16_t*)(F.ws + A_EW); const bf16_t* AA = (const bf16_t*)(F.ws + A_AA);
    LAS unsigned char* slot_w = F.lds + F.wave * SL_BYTES;
    LAS float* PAR = (LAS float*)(F.lds + SC_PAR);
    s16x8 SelF[2];
#pragma unroll
    for (int sel = 0; sel < 2; ++sel) { unsigned w[4];
#pragma unroll
        for (int jj = 0; jj < 4; ++jj) { const int j0 = 2 * jj, j1 = 2 * jj + 1; const bool h0 = (q == (tt >> 2)) && (j0 == 4 * sel + (tt & 3)), h1 = (q == (tt >> 2)) && (j1 == 4 * sel + (tt & 3));
            w[jj] = (h0 ? 0x3f80u : 0u) | (h1 ? 0x3f800000u : 0u); }
        SelF[sel] = mk8(w[0], w[1], w[2], w[3]); }
    for (int s = blockIdx.x; s < NB * NH * 2; s += F.G) {
        const int b = s >> 6, h = (s >> 1) & 31, d = s & 1;
        bf16_t* YD = (bf16_t*)(yd_base + (size_t)d * 32 * MiB); float* SB = sb_base + (size_t)d * ML * NH;
        __syncthreads();
        if (F.wave == 0) { PAR[lane] = a.in[I_KK][h * HS + lane]; PAR[64 + lane] = a.in[I_KA][h * HS + lane]; PAR[128 + lane] = a.in[I_RK][h * HS + lane]; }
        __syncthreads();
        f32x4 G[4];
#pragma unroll
        for (int tk = 0; tk < 4; ++tk) G[tk] = (f32x4){0.f, 0.f, 0.f, 0.f};
#define S2_ROW0(ci) (((ci) < 16) ? (ML + b * TC + (d ? 15 - (ci) : (ci)) * 16) : (b * T + (d ? 127 - ((ci) - 16) : ((ci) - 16)) * 16))
        u32x2 rk[4], rv[4], rr[4], re[4], ra[4];
#define S2_LOAD(ci) do { const int row_ = S2_ROW0(ci) + (d ? 15 - tt : tt); const size_t o_ = (size_t)row_ * D + h * HS + 4 * q, o2_ = (size_t)row_ * (2 * D) + d * D + h * HS + 4 * q; \
        _Pragma("unroll") for (int g_ = 0; g_ < 4; ++g_) { rk[g_] = *(const u32x2*)(KX + o_ + 16 * g_); rv[g_] = *(const u32x2*)(VV + o_ + 16 * g_); \
            rr[g_] = ((ci) >= 16) ? *(const u32x2*)(RR + o_ + 16 * g_) : (u32x2){0u, 0u}; re[g_] = *(const u32x2*)(EW + o2_ + 16 * g_); ra[g_] = *(const u32x2*)(AA + o2_ + 16 * g_); } } while (0)
        S2_LOAD(F.wave);
        for (int rnd = 0; rnd < 18; ++rnd) {
            const int ci = rnd * 8 + F.wave; const bool lat = rnd >= 2;
            {
                float kf[4][4], af[4][4], ef[4][4], vf[4][4], rf[4][4];
#pragma unroll
                for (int g = 0; g < 4; ++g) {
                    kf[g][0] = bflo(rk[g].x); kf[g][1] = bfhi(rk[g].x); kf[g][2] = bflo(rk[g].y); kf[g][3] = bfhi(rk[g].y);
                    af[g][0] = bflo(ra[g].x); af[g][1] = bfhi(ra[g].x); af[g][2] = bflo(ra[g].y); af[g][3] = bfhi(ra[g].y);
                    ef[g][0] = bflo(re[g].x); ef[g][1] = bfhi(re[g].x); ef[g][2] = bflo(re[g].y); ef[g][3] = bfhi(re[g].y);
                    vf[g][0] = bflo(rv[g].x); vf[g][1] = bfhi(rv[g].x); vf[g][2] = bflo(rv[g].y); vf[g][3] = bfhi(rv[g].y);
                    rf[g][0] = bflo(rr[g].x); rf[g][1] = bfhi(rr[g].x); rf[g][2] = bflo(rr[g].y); rf[g][3] = bfhi(rr[g].y); }
                unsigned VP[4][2];
#pragma unroll
                for (int g = 0; g < 4; ++g) { VP[g][0] = rv[g].x; VP[g][1] = rv[g].y; }
                if (rnd + 1 < 18) S2_LOAD((rnd + 1) * 8 + F.wave);
                float kkv[4][4]; float n2 = 0.f;
#pragma unroll
                for (int g = 0; g < 4; ++g) { const f32x4 kc = *(const LAS f32x4*)(PAR + 16 * g + 4 * q);
#pragma unroll
                    for (int i = 0; i < 4; ++i) { kkv[g][i] = kf[g][i] * kc[i]; n2 += kkv[g][i] * kkv[g][i]; } }
                n2 += __shfl_xor(n2, 16); n2 += __shfl_xor(n2, 32);
                const float inv = 1.0f / fmaxf(sqrtf(n2), 1e-12f);
                float sb = 0.f;
                unsigned KaP[4][2], BmP[4][2], KmP[4][2], RmP[4][2]; f32x4 gend[4];
#pragma unroll
                for (int g = 0; g < 4; ++g) { const f32x4 kac = *(const LAS f32x4*)(PAR + 64 + 16 * g + 4 * q), rkc = *(const LAS f32x4*)(PAR + 128 + 16 * g + 4 * q);
                    float ka_[4], bm_[4], km_[4], rm_[4];
#pragma unroll
                    for (int i = 0; i < 4; ++i) {
                        float L = ef[g][i];
                        L += dpp_f<0x111>(L); L += dpp_f<0x112>(L); L += dpp_f<0x114>(L); L += dpp_f<0x118>(L);
                        const float gt = fexp(-L), gi = fexp(L), gm1 = fexp(ef[g][i] - L);
                        const float kk = kkv[g][i] * inv, kd = kf[g][i] * (1.0f + (af[g][i] - 1.0f) * kac[i]);
                        ka_[i] = kk * gm1; bm_[i] = kk * af[g][i] * gi; km_[i] = kd * gi; rm_[i] = rf[g][i] * gt;
                        sb += rf[g][i] * kd * rkc[i]; gend[g][i] = gt; }
                    KaP[g][0] = pk2(ka_[0], ka_[1]); KaP[g][1] = pk2(ka_[2], ka_[3]); BmP[g][0] = pk2(bm_[0], bm_[1]); BmP[g][1] = pk2(bm_[2], bm_[3]);
                    KmP[g][0] = pk2(km_[0], km_[1]); KmP[g][1] = pk2(km_[2], km_[3]); RmP[g][0] = pk2(rm_[0], rm_[1]); RmP[g][1] = pk2(rm_[2], rm_[3]);
                }
                if (lat) { sb += __shfl_xor(sb, 16); sb += __shfl_xor(sb, 32); if (q == 0) SB[(size_t)(S2_ROW0(ci) + (d ? 15 - tt : tt)) * NH + h] = sb; }
                s16x8 KaF[2], BmF[2], KmF[2], RmF[2], VF[2];
#pragma unroll
                for (int kb = 0; kb < 2; ++kb) { KaF[kb] = mk8(KaP[2 * kb][0], KaP[2 * kb][1], KaP[2 * kb + 1][0], KaP[2 * kb + 1][1]); BmF[kb] = mk8(BmP[2 * kb][0], BmP[2 * kb][1], BmP[2 * kb + 1][0], BmP[2 * kb + 1][1]);
                    KmF[kb] = mk8(KmP[2 * kb][0], KmP[2 * kb][1], KmP[2 * kb + 1][0], KmP[2 * kb + 1][1]); RmF[kb] = mk8(RmP[2 * kb][0], RmP[2 * kb][1], RmP[2 * kb + 1][0], RmP[2 * kb + 1][1]);
                    VF[kb] = mk8(VP[2 * kb][0], VP[2 * kb][1], VP[2 * kb + 1][0], VP[2 * kb + 1][1]); }
                const f32x4 Z = (f32x4){0.f, 0.f, 0.f, 0.f};
                f32x4 Nd = mfma16(KaF[1], BmF[1], mfma16(KaF[0], BmF[0], Z));
                f32x4 Nt = mfma16(BmF[1], KaF[1], mfma16(BmF[0], KaF[0], Z));
                f32x4 AakT = mfma16(KmF[1], KaF[1], mfma16(KmF[0], KaF[0], Z));
                f32x4 ArbT = mfma16(BmF[1], RmF[1], mfma16(BmF[0], RmF[0], Z));
                f32x4 ArkT = mfma16(KmF[1], RmF[1], mfma16(KmF[0], RmF[0], Z));
                f32x4 Q0;
#pragma unroll
                for (int r = 0; r < 4; ++r) { const int row = 4 * q + r;
                    Nd[r] = row > tt ? Nd[r] : 0.f; Nt[r] = row < tt ? Nt[r] : 0.f; AakT[r] = row < tt ? AakT[r] : 0.f; ArbT[r] = row <= tt ? ArbT[r] : 0.f; ArkT[r] = row <= tt ? ArkT[r] : 0.f;
                    Q0[r] = (row == tt ? 1.0f : 0.f) - Nt[r]; }
                const s16x8 oN = mk_d(Nd), oNt = mk_d(Nt);
                const f32x4 N2 = mfma16(oNt, oN, Z), N2t = mfma16(oN, oNt, Z);
                const s16x8 oN2 = mk_d(N2), oN2t = mk_d(N2t);
                const f32x4 N4 = mfma16(oN2t, oN2, Z), N4t = mfma16(oN2, oN2t, Z);
                const s16x8 oN4 = mk_d(N4), oN4t = mk_d(N4t);
                const f32x4 N8 = mfma16(oN4t, oN4, Z);
                const f32x4 Q1 = mfma16(oN2, mk_d(Q0), Q0);
                const f32x4 Q2 = mfma16(oN4, mk_d(Q1), Q1);
                const f32x4 Q3 = mfma16(mk_d(N8), mk_d(Q2), Q2);
                *(LAS u32x4*)(slot_w + SL_KA + lane * 16) = __builtin_bit_cast(u32x4, KaF[0]); *(LAS u32x4*)(slot_w + SL_KA + 1024 + lane * 16) = __builtin_bit_cast(u32x4, KaF[1]);
                *(LAS u32x4*)(slot_w + SL_RM + lane * 16) = __builtin_bit_cast(u32x4, RmF[0]); *(LAS u32x4*)(slot_w + SL_RM + 1024 + lane * 16) = __builtin_bit_cast(u32x4, RmF[1]);
                *(LAS u32x2*)(slot_w + SL_TN + lane * 8) = (u32x2){pk2(-Q3[0], -Q3[1]), pk2(-Q3[2], -Q3[3])};
                *(LAS u32x2*)(slot_w + SL_AAK + lane * 8) = (u32x2){pk2(AakT[0], AakT[1]), pk2(AakT[2], AakT[3])};
                *(LAS u32x4*)(slot_w + SL_ARK + lane * 16) = (u32x4){pk2(ArbT[0], ArbT[1]), pk2(ArbT[2], ArbT[3]), pk2(ArkT[0], ArkT[1]), pk2(ArkT[2], ArkT[3])};
#pragma unroll
                for (int kb = 0; kb < 2; ++kb)
#pragma unroll
                    for (int sel = 0; sel < 2; ++sel) { const int tk = 2 * kb + sel;
                        const f32x4 DB = mfma16(BmF[kb], SelF[sel], Z), DK = mfma16(KmF[kb], SelF[sel], Z), DV = mfma16(VF[kb], SelF[sel], Z);
                        *(LAS u32x4*)(slot_w + SL_BK + tk * 1024 + lane * 16) = (u32x4){pk2(DB[0], DB[1]), pk2(DB[2], DB[3]), pk2(DK[0], DK[1]), pk2(DK[2], DK[3])};
                        *(LAS u32x2*)(slot_w + SL_VC + tk * 512 + lane * 8) = (u32x2){pk2(DV[0], DV[1]), pk2(DV[2], DV[3])}; }
                if (tt == 15) {
#pragma unroll
                    for (int g = 0; g < 4; ++g) *(LAS f32x4*)(slot_w + SL_GC + (g * 4 + q) * 16) = gend[g]; }
            }
            __syncthreads();
            if (F.wave < 4) {
                const int tv = F.wave;
                for (int sl = 0; sl < 8; ++sl) {
                    LAS unsigned char* S = F.lds + sl * SL_BYTES; const int cj = rnd * 8 + sl;
                    const s16x8 KA0 = __builtin_bit_cast(s16x8, *(LAS u32x4*)(S + SL_KA + lane * 16)), KA1 = __builtin_bit_cast(s16x8, *(LAS u32x4*)(S + SL_KA + 1024 + lane * 16));
                    const u32x2 aak = *(LAS u32x2*)(S + SL_AAK + lane * 8), tn = *(LAS u32x2*)(S + SL_TN + lane * 8), vc = *(LAS u32x2*)(S + SL_VC + tv * 512 + lane * 8);
                    const s16x8 Gb0 = mk8(pk2(G[0][0], G[0][1]), pk2(G[0][2], G[0][3]), pk2(G[1][0], G[1][1]), pk2(G[1][2], G[1][3]));
                    const s16x8 Gb1 = mk8(pk2(G[2][0], G[2][1]), pk2(G[2][2], G[2][3]), pk2(G[3][0], G[3][1]), pk2(G[3][2], G[3][3]));
                    const f32x4 Z = (f32x4){0.f, 0.f, 0.f, 0.f};
                    f32x4 P = mfma16(KA0, Gb0, Z); P = mfma16(KA1, Gb1, P); P = mfma16(mk8(aak.x, aak.y, 0u, 0u), mk8(vc.x, vc.y, 0u, 0u), P);
                    const f32x4 U = mfma16(mk8(tn.x, tn.y, 0u, 0u), mk_d(P), Z);
                    const s16x8 UV = mk8(pk2(U[0], U[1]), pk2(U[2], U[3]), vc.x, vc.y);
                    if (lat) {
                        const s16x8 RM0 = __builtin_bit_cast(s16x8, *(LAS u32x4*)(S + SL_RM + lane * 16)), RM1 = __builtin_bit_cast(s16x8, *(LAS u32x4*)(S + SL_RM + 1024 + lane * 16));
                        const s16x8 ARK = __builtin_bit_cast(s16x8, *(LAS u32x4*)(S + SL_ARK + lane * 16));
                        f32x4 Y = mfma16(Gb0, RM0, Z); Y = mfma16(Gb1, RM1, Y); Y = mfma16(UV, ARK, Y);
                        *(u32x2*)(YD + (size_t)(S2_ROW0(cj) + (d ? 15 - tt : tt)) * D + h * HS + 16 * tv + 4 * q) = (u32x2){pk2(Y[0], Y[1]), pk2(Y[2], Y[3])};
                    }
#pragma unroll
                    for (int tk = 0; tk < 4; ++tk) { const s16x8 BK = __builtin_bit_cast(s16x8, *(LAS u32x4*)(S + SL_BK + tk * 1024 + lane * 16));
                        G[tk] = mfma16(BK, UV, G[tk]); G[tk] = G[tk] * *(LAS f32x4*)(S + SL_GC + (tk * 4 + q) * 16); }
                }
            }
            __syncthreads();
        }
#undef S2_ROW0
#undef S2_LOAD
    }
    __syncthreads();
}

__device__ __forceinline__ void p4_scan3(const Frame& F, const Args& a, unsigned char* yd_base, float* sb_base, int clo, int chi) {
    const int lane = lane_id(), tt = lane & 15, q = lane >> 4;
    const bf16_t* KX = (const bf16_t*)(F.ws + A_KX); const bf16_t* VV = (const bf16_t*)(F.ws + A_V); const bf16_t* RR = (const bf16_t*)(F.ws + A_R);
    const bf16_t* EW = (const bf16_t*)(F.ws + A_EW); const bf16_t* AA = (const bf16_t*)(F.ws + A_AA);
    LAS float* PAR = (LAS float*)(F.lds + SC_PAR);
    LAS unsigned* CNT = (LAS unsigned*)(F.lds + SC_PAR + 1024);
    s16x8 SelF[2];
#pragma unroll
    for (int sel = 0; sel < 2; ++sel) { unsigned w[4];
#pragma unroll
        for (int jj = 0; jj < 4; ++jj) { const int j0 = 2 * jj, j1 = 2 * jj + 1; const bool h0 = (q == (tt >> 2)) && (j0 == 4 * sel + (tt & 3)), h1 = (q == (tt >> 2)) && (j1 == 4 * sel + (tt & 3));
            w[jj] = (h0 ? 0x3f80u : 0u) | (h1 ? 0x3f800000u : 0u); }
        SelF[sel] = mk8(w[0], w[1], w[2], w[3]); }
    { const int s = blockIdx.x;
        const int b = s >> 6, h = (s >> 1) & 31, d = s & 1;
        bf16_t* YD = (bf16_t*)(yd_base + (size_t)d * 32 * MiB); float* SB = sb_base + (size_t)d * ML * NH;
        __syncthreads();
        if (F.wave == 0) { PAR[lane] = a.in[I_KK][h * HS + lane]; PAR[64 + lane] = a.in[I_KA][h * HS + lane]; PAR[128 + lane] = a.in[I_RK][h * HS + lane]; if (lane == 0) CNT[0] = 0u; }
        __syncthreads();
        if (F.wave >= 4) { p0_transpose_range(F, a, clo, chi, (int)blockIdx.x * 4 + (F.wave - 4), 4 * 256, (LAS unsigned*)(F.lds + 102400 + (F.wave - 4) * 8448)); }
        else {
        f32x4 G[4];
#pragma unroll
        for (int tk = 0; tk < 4; ++tk) G[tk] = (f32x4){0.f, 0.f, 0.f, 0.f};
#define S2_ROW0(ci) (((ci) < 16) ? (ML + b * TC + (d ? 15 - (ci) : (ci)) * 16) : (b * T + (d ? 127 - ((ci) - 16) : ((ci) - 16)) * 16))
        u32x2 rk[4], rv[4], rr[4], re[4], ra[4];
#define S2_LOAD(ci) do { const int row_ = S2_ROW0(ci) + (d ? 15 - tt : tt); const size_t o_ = (size_t)row_ * D + h * HS + 4 * q, o2_ = (size_t)row_ * (2 * D) + d * D + h * HS + 4 * q; \
        _Pragma("unroll") for (int g_ = 0; g_ < 4; ++g_) { rk[g_] = *(const u32x2*)(KX + o_ + 16 * g_); rv[g_] = *(const u32x2*)(VV + o_ + 16 * g_); \
            rr[g_] = ((ci) >= 16) ? *(const u32x2*)(RR + o_ + 16 * g_) : (u32x2){0u, 0u}; re[g_] = *(const u32x2*)(EW + o2_ + 16 * g_); ra[g_] = *(const u32x2*)(AA + o2_ + 16 * g_); } } while (0)
        S2_LOAD(F.wave);
        for (int rnd = 0; rnd < 36; ++rnd) {
            const int ci = rnd * 4 + F.wave; const bool lat = rnd >= 4;
            LAS unsigned char* slot_w = F.lds + ((rnd & 1) * 4 + F.wave) * SL_BYTES;
            {
                float kf[4][4], af[4][4], ef[4][4], vf[4][4], rf[4][4];
#pragma unroll
                for (int g = 0; g < 4; ++g) {
                    kf[g][0] = bflo(rk[g].x); kf[g][1] = bfhi(rk[g].x); kf[g][2] = bflo(rk[g].y); kf[g][3] = bfhi(rk[g].y);
                    af[g][0] = bflo(ra[g].x); af[g][1] = bfhi(ra[g].x); af[g][2] = bflo(ra[g].y); af[g][3] = bfhi(ra[g].y);
                    ef[g][0] = bflo(re[g].x); ef[g][1] = bfhi(re[g].x); ef[g][2] = bflo(re[g].y); ef[g][3] = bfhi(re[g].y);
                    vf[g][0] = bflo(rv[g].x); vf[g][1] = bfhi(rv[g].x); vf[g][2] = bflo(rv[g].y); vf[g][3] = bfhi(rv[g].y);
                    rf[g][0] = bflo(rr[g].x); rf[g][1] = bfhi(rr[g].x); rf[g][2] = bflo(rr[g].y); rf[g][3] = bfhi(rr[g].y); }
                unsigned VP[4][2];
#pragma unroll
                for (int g = 0; g < 4; ++g) { VP[g][0] = rv[g].x; VP[g][1] = rv[g].y; }
                if (rnd + 1 < 36) S2_LOAD((rnd + 1) * 4 + F.wave);
                float kkv[4][4]; float n2 = 0.f;
#pragma unroll
                for (int g = 0; g < 4; ++g) { const f32x4 kc = *(const LAS f32x4*)(PAR + 16 * g + 4 * q);
#pragma unroll
                    for (int i = 0; i < 4; ++i) { kkv[g][i] = kf[g][i] * kc[i]; n2 += kkv[g][i] * kkv[g][i]; } }
                n2 += __shfl_xor(n2, 16); n2 += __shfl_xor(n2, 32);
                const float inv = 1.0f / fmaxf(sqrtf(n2), 1e-12f);
                float sb = 0.f;
                unsigned KaP[4][2], BmP[4][2], KmP[4][2], RmP[4][2]; f32x4 gend[4];
#pragma unroll
                for (int g = 0; g < 4; ++g) { const f32x4 kac = *(const LAS f32x4*)(PAR + 64 + 16 * g + 4 * q), rkc = *(const LAS f32x4*)(PAR + 128 + 16 * g + 4 * q);
                    float ka_[4], bm_[4], km_[4], rm_[4];
#pragma unroll
                    for (int i = 0; i < 4; ++i) {
                        float L = ef[g][i];
                        L += dpp_f<0x111>(L); L += dpp_f<0x112>(L); L += dpp_f<0x114>(L); L += dpp_f<0x118>(L);
                        const float gt = fexp(-L), gi = fexp(L), gm1 = fexp(ef[g][i] - L);
                        const float kk = kkv[g][i] * inv, kd = kf[g][i] * (1.0f + (af[g][i] - 1.0f) * kac[i]);
                        ka_[i] = kk * gm1; bm_[i] = kk * af[g][i] * gi; km_[i] = kd * gi; rm_[i] = rf[g][i] * gt;
                        sb += rf[g][i] * kd * rkc[i]; gend[g][i] = gt; }
                    KaP[g][0] = pk2(ka_[0], ka_[1]); KaP[g][1] = pk2(ka_[2], ka_[3]); BmP[g][0] = pk2(bm_[0], bm_[1]); BmP[g][1] = pk2(bm_[2], bm_[3]);
                    KmP[g][0] = pk2(km_[0], km_[1]); KmP[g][1] = pk2(km_[2], km_[3]); RmP[g][0] = pk2(rm_[0], rm_[1]); RmP[g][1] = pk2(rm_[2], rm_[3]);
                }
                if (lat) { sb += __shfl_xor(sb, 16); sb += __shfl_xor(sb, 32); if (q == 0) SB[(size_t)(S2_ROW0(ci) + (d ? 15 - tt : tt)) * NH + h] = sb; }
                s16x8 KaF[2], BmF[2], KmF[2], RmF[2], VF[2];
#pragma unroll
                for (int kb = 0; kb < 2; ++kb) { KaF[kb] = mk8(KaP[2 * kb][0], KaP[2 * kb][1], KaP[2 * kb + 1][0], KaP[2 * kb + 1][1]); BmF[kb] = mk8(BmP[2 * kb][0], BmP[2 * kb][1], BmP[2 * kb + 1][0], BmP[2 * kb + 1][1]);
                    KmF[kb] = mk8(KmP[2 * kb][0], KmP[2 * kb][1], KmP[2 * kb + 1][0], KmP[2 * kb + 1][1]); RmF[kb] = mk8(RmP[2 * kb][0], RmP[2 * kb][1], RmP[2 * kb + 1][0], RmP[2 * kb + 1][1]);
                    VF[kb] = mk8(VP[2 * kb][0], VP[2 * kb][1], VP[2 * kb + 1][0], VP[2 * kb + 1][1]); }
                const f32x4 Z = (f32x4){0.f, 0.f, 0.f, 0.f};
                f32x4 Nd = mfma16(KaF[1], BmF[1], mfma16(KaF[0], BmF[0], Z));
                f32x4 Nt = mfma16(BmF[1], KaF[1], mfma16(BmF[0], KaF[0], Z));
                f32x4 AakT = mfma16(KmF[1], KaF[1], mfma16(KmF[0], KaF[0], Z));
                f32x4 ArbT = mfma16(BmF[1], RmF[1], mfma16(BmF[0], RmF[0], Z));
                f32x4 ArkT = mfma16(KmF[1], RmF[1], mfma16(KmF[0], RmF[0], Z));
                f32x4 Q0;
#pragma unroll
                for (int r = 0; r < 4; ++r) { const int row = 4 * q + r;
                    Nd[r] = row > tt ? Nd[r] : 0.f; Nt[r] = row < tt ? Nt[r] : 0.f; AakT[r] = row < tt ? AakT[r] : 0.f; ArbT[r] = row <= tt ? ArbT[r] : 0.f; ArkT[r] = row <= tt ? ArkT[r] : 0.f;
                    Q0[r] = (row == tt ? 1.0f : 0.f) - Nt[r]; }
                const s16x8 oN = mk_d(Nd), oNt = mk_d(Nt);
                const f32x4 N2 = mfma16(oNt, oN, Z), N2t = mfma16(oN, oNt, Z);
                const s16x8 oN2 = mk_d(N2), oN2t = mk_d(N2t);
                const f32x4 N4 = mfma16(oN2t, oN2, Z), N4t = mfma16(oN2, oN2t, Z);
                const s16x8 oN4 = mk_d(N4), oN4t = mk_d(N4t);
                const f32x4 N8 = mfma16(oN4t, oN4, Z);
                const f32x4 Q1 = mfma16(oN2, mk_d(Q0), Q0);
                const f32x4 Q2 = mfma16(oN4, mk_d(Q1), Q1);
                const f32x4 Q3 = mfma16(mk_d(N8), mk_d(Q2), Q2);
                *(LAS u32x4*)(slot_w + SL_KA + lane * 16) = __builtin_bit_cast(u32x4, KaF[0]); *(LAS u32x4*)(slot_w + SL_KA + 1024 + lane * 16) = __builtin_bit_cast(u32x4, KaF[1]);
                *(LAS u32x4*)(slot_w + SL_RM + lane * 16) = __builtin_bit_cast(u32x4, RmF[0]); *(LAS u32x4*)(slot_w + SL_RM + 1024 + lane * 16) = __builtin_bit_cast(u32x4, RmF[1]);
                *(LAS u32x2*)(slot_w + SL_TN + lane * 8) = (u32x2){pk2(-Q3[0], -Q3[1]), pk2(-Q3[2], -Q3[3])};
                *(LAS u32x2*)(slot_w + SL_AAK + lane * 8) = (u32x2){pk2(AakT[0], AakT[1]), pk2(AakT[2], AakT[3])};
                *(LAS u32x4*)(slot_w + SL_ARK + lane * 16) = (u32x4){pk2(ArbT[0], ArbT[1]), pk2(ArbT[2], ArbT[3]), pk2(ArkT[0], ArkT[1]), pk2(ArkT[2], ArkT[3])};
#pragma unroll
                for (int kb = 0; kb < 2; ++kb)
#pragma unroll
                    for (int sel = 0; sel < 2; ++sel) { const int tk = 2 * kb + sel;
                        const f32x4 DB = mfma16(BmF[kb], SelF[sel], Z), DK = mfma16(KmF[kb], SelF[sel], Z), DV = mfma16(VF[kb], SelF[sel], Z);
                        *(LAS u32x4*)(slot_w + SL_BK + tk * 1024 + lane * 16) = (u32x4){pk2(DB[0], DB[1]), pk2(DB[2], DB[3]), pk2(DK[0], DK[1]), pk2(DK[2], DK[3])};
                        *(LAS u32x2*)(slot_w + SL_VC + tk * 512 + lane * 8) = (u32x2){pk2(DV[0], DV[1]), pk2(DV[2], DV[3])}; }
                if (tt == 15) {
#pragma unroll
                    for (int g = 0; g < 4; ++g) *(LAS f32x4*)(slot_w + SL_GC + (g * 4 + q) * 16) = gend[g]; }
            }
            __builtin_amdgcn_fence(__ATOMIC_RELEASE, "workgroup");
            if (lane == 0) __hip_atomic_fetch_add(CNT, 1u, __ATOMIC_RELAXED, __HIP_MEMORY_SCOPE_WORKGROUP);
            { unsigned spins = 0; while (__hip_atomic_load(CNT, __ATOMIC_RELAXED, __HIP_MEMORY_SCOPE_WORKGROUP) < 4u * (unsigned)(rnd + 1)) { __builtin_amdgcn_s_sleep(1); if (++spins > (1u << 22)) break; } }
            __builtin_amdgcn_fence(__ATOMIC_ACQUIRE, "workgroup");
            {
                const int tv = F.wave;
                for (int sl = 0; sl < 4; ++sl) {
                    LAS unsigned char* S = F.lds + ((rnd & 1) * 4 + sl) * SL_BYTES; const int cj = rnd * 4 + sl;
                    const s16x8 KA0 = __builtin_bit_cast(s16x8, *(LAS u32x4*)(S + SL_KA + lane * 16)), KA1 = __builtin_bit_cast(s16x8, *(LAS u32x4*)(S + SL_KA + 1024 + lane * 16));
                    const u32x2 aak = *(LAS u32x2*)(S + SL_AAK + lane * 8), tn = *(LAS u32x2*)(S + SL_TN + lane * 8), vc = *(LAS u32x2*)(S + SL_VC + tv * 512 + lane * 8);
                    const s16x8 Gb0 = mk8(pk2(G[0][0], G[0][1]), pk2(G[0][2], G[0][3]), pk2(G[1][0], G[1][1]), pk2(G[1][2], G[1][3]));
                    const s16x8 Gb1 = mk8(pk2(G[2][0], G[2][1]), pk2(G[2][2], G[2][3]), pk2(G[3][0], G[3][1]), pk2(G[3][2], G[3][3]));
                    const f32x4 Z = (f32x4){0.f, 0.f, 0.f, 0.f};
                    f32x4 P = mfma16(KA0, Gb0, Z); P = mfma16(KA1, Gb1, P); P = mfma16(mk8(aak.x, aak.y, 0u, 0u), mk8(vc.x, vc.y, 0u, 0u), P);
                    const f32x4 U = mfma16(mk8(tn.x, tn.y, 0u, 0u), mk_d(P), Z);
                    const s16x8 UV = mk8(pk2(U[0], U[1]), pk2(U[2], U[3]), vc.x, vc.y);
                    if (lat) {
                        const s16x8 RM0 = __builtin_bit_cast(s16x8, *(LAS u32x4*)(S + SL_RM + lane * 16)), RM1 = __builtin_bit_cast(s16x8, *(LAS u32x4*)(S + SL_RM + 1024 + lane * 16));
                        const s16x8 ARK = __builtin_bit_cast(s16x8, *(LAS u32x4*)(S + SL_ARK + lane * 16));
                        f32x4 Y = mfma16(Gb0, RM0, Z); Y = mfma16(Gb1, RM1, Y); Y = mfma16(UV, ARK, Y);
                        *(u32x2*)(YD + (size_t)(S2_ROW0(cj) + (d ? 15 - tt : tt)) * D + h * HS + 16 * tv + 4 * q) = (u32x2){pk2(Y[0], Y[1]), pk2(Y[2], Y[3])};
                    }
#pragma unroll
                    for (int tk = 0; tk < 4; ++tk) { const s16x8 BK = __builtin_bit_cast(s16x8, *(LAS u32x4*)(S + SL_BK + tk * 1024 + lane * 16));
                        G[tk] = mfma16(BK, UV, G[tk]); G[tk] = G[tk] * *(LAS f32x4*)(S + SL_GC + (tk * 4 + q) * 16); }
                }
            }
        }
        }
#undef S2_ROW0
#undef S2_LOAD
    }
    __syncthreads();
}

#if defined(PROBE_SCANCHK)
constexpr int CW_CHK = 20480;
__device__ __forceinline__ void p4_compare(const Frame& F) {
    const int lane = lane_id();
    const bf16_t* Y0 = (const bf16_t*)(F.ws + A_YD); const bf16_t* Y1 = (const bf16_t*)(F.ws + A_AO);
    const float* S0 = (const float*)(F.ws + WS_SB); const float* S1 = (const float*)(F.ws + WS_A + 644 * MiB);
    float num = 0.f, den = 0.f, num2 = 0.f, den2 = 0.f;
    for (size_t i = (size_t)F.gw * 64 + lane; i < (size_t)2 * ML * D / 8; i += (size_t)F.NGW * 64) { float a8[8], b8[8]; unpack8(((const u32x4*)Y0)[i], a8); unpack8(((const u32x4*)Y1)[i], b8);
#pragma unroll
        for (int e = 0; e < 8; ++e) { const float dd = b8[e] - a8[e]; num += dd * dd; den += a8[e] * a8[e]; } }
    for (size_t i = (size_t)F.gw * 64 + lane; i < (size_t)2 * ML * NH; i += (size_t)F.NGW * 64) { const float dd = S1[i] - S0[i]; num2 += dd * dd; den2 += S0[i] * S0[i]; }
    num = wave_sum(num); den = wave_sum(den); num2 = wave_sum(num2); den2 = wave_sum(den2);
    if (lane == 0) { atomicAdd((float*)(F.ctl + CW_CHK), num); atomicAdd((float*)(F.ctl + CW_CHK + 64), den); atomicAdd((float*)(F.ctl + CW_CHK + 128), num2); atomicAdd((float*)(F.ctl + CW_CHK + 192), den2); }
}
#endif
__device__ __forceinline__ void p5_ao(const Frame& F, const Args& a) {
    const int lane = lane_id(), tid = F.wave * 64 + lane; (void)tid;
    const bf16_t* Y0 = (const bf16_t*)(F.ws + A_YD); const bf16_t* Y1 = (const bf16_t*)(F.ws + A_YD + 32 * MiB);
    const bf16_t* VV = (const bf16_t*)(F.ws + A_V); const bf16_t* GT = (const bf16_t*)(F.ws + A_GATE); bf16_t* AO = (bf16_t*)(F.ws + A_AO);
    const float* SB0 = (const float*)(F.ws + WS_SB); const float* SB1 = SB0 + (size_t)ML * NH;
    for (int m = F.gw; m < ML; m += F.NGW) {
#pragma unroll
        for (int j = 0; j < 4; ++j) {
            const int c = 8 * lane + 512 * j, hd = c >> 6; const size_t o = (size_t)m * D + c;
            float y0[8], y1[8], vv[8], gg[8], y[8];
            unpack8(*(const u32x4*)(Y0 + o), y0); unpack8(*(const u32x4*)(Y1 + o), y1); unpack8(*(const u32x4*)(VV + o), vv); unpack8(*(const u32x4*)(GT + o), gg);
            float s = 0.f;
#pragma unroll
            for (int e = 0; e < 8; ++e) { y[e] = y0[e] + y1[e]; s += y[e]; }
            s = sum8(s); const float mean = s * (1.0f / 64.0f); float qv = 0.f;
#pragma unroll
            for (int e = 0; e < 8; ++e) { y[e] -= mean; qv += y[e] * y[e]; }
            qv = sum8(qv); const float rstd = 1.0f / sqrtf(qv * (1.0f / 64.0f) + GN_EPS);
            const float sb = SB0[(size_t)m * NH + hd] + SB1[(size_t)m * NH + hd];
            const f32x4 gw0 = *(const f32x4*)(a.in[I_GNW] + c), gw1 = *(const f32x4*)(a.in[I_GNW] + c + 4), gb0 = *(const f32x4*)(a.in[I_GNB] + c), gb1 = *(const f32x4*)(a.in[I_GNB] + c + 4);
            float o8[8];
#pragma unroll
            for (int e = 0; e < 8; ++e) { const float gw = e < 4 ? gw0[e & 3] : gw1[e & 3], gb = e < 4 ? gb0[e & 3] : gb1[e & 3]; o8[e] = (y[e] * rstd * gw + gb + sb * vv[e]) * gg[e]; }
            u32x4 w; w.x = pk2(o8[0], o8[1]); w.y = pk2(o8[2], o8[3]); w.z = pk2(o8[4], o8[5]); w.w = pk2(o8[6], o8[7]);
            *(u32x4*)(AO + o) = w;
        }
    }
}

struct RowLN { f32x4 xn[8]; };
__device__ __forceinline__ void ln_core(int lane, f32x4 (&z)[8], const float* lnw, const float* lnb) {
    float s = 0.f;
#pragma unroll
    for (int j = 0; j < 8; ++j) s += (z[j][0] + z[j][1]) + (z[j][2] + z[j][3]);
    const float mean = wave_sum(s) * (1.0f / D); float q = 0.f;
#pragma unroll
    for (int j = 0; j < 8; ++j) { z[j] = z[j] - mean; q += (z[j][0] * z[j][0] + z[j][1] * z[j][1]) + (z[j][2] * z[j][2] + z[j][3] * z[j][3]); }
    const float rstd = 1.0f / sqrtf(wave_sum(q) * (1.0f / D) + LN_EPS);
#pragma unroll
    for (int j = 0; j < 8; ++j) { const int c = 4 * lane + 256 * j; z[j] = z[j] * rstd * *(const f32x4*)(lnw + c) + *(const f32x4*)(lnb + c); }
}
__device__ __forceinline__ f32x4 ld_bf4(const bf16_t* p) { const u32x2 w = *(const u32x2*)p; return (f32x4){bflo(w.x), bfhi(w.x), bflo(w.y), bfhi(w.y)}; }
__device__ __forceinline__ void st_bf4(bf16_t* p, const f32x4 v) { u32x2 w; w.x = pk2(v[0], v[1]); w.y = pk2(v[2], v[3]); *(u32x2*)p = w; }
__device__ __forceinline__ void st_h(void* H, size_t idx, const f32x4 v, bool f8) { if (f8) *((unsigned*)((unsigned char*)H + idx)) = pk4_fp8(v[0] * 16.f, v[1] * 16.f, v[2] * 16.f, v[3] * 16.f); else st_bf4((bf16_t*)H + idx, v); }
__device__ __forceinline__ void post_norm_rows(const Frame& F, const Args& a, const bf16_t* Y, int gate_off, int lnidx, const float* MODh, int sh_off, int sc_off, void* H, bool h8) {
    const int lane = lane_id(), tid = F.wave * 64 + lane; (void)tid;
    const float* MOD = (const float*)(F.ws + WS_MOD); float* XR = (float*)(F.ws + WS_XR);
    const float* lnw = a.in[I_LNW] + lnidx * D; const float* lnb = a.in[I_LNB] + lnidx * D;
    for (int m = F.gw; m < ML; m += F.NGW) {
        const int b = m / T; const float* g = MOD + gate_off + (size_t)b * MOD_N; const size_t o = (size_t)m * D;
        f32x4 z[8];
#pragma unroll
        for (int j = 0; j < 8; ++j) { const int c = 4 * lane + 256 * j; z[j] = *(const f32x4*)(XR + o + c) * ALPHA + *(const f32x4*)(g + c) * ld_bf4(Y + o + c); }
        ln_core(lane, z, lnw, lnb);
        const float* sh = MODh + sh_off + (size_t)b * MOD_N; const float* sc = MODh + sc_off + (size_t)b * MOD_N;
#pragma unroll
        for (int j = 0; j < 8; ++j) { const int c = 4 * lane + 256 * j; *(f32x4*)(XR + o + c) = z[j];
            st_h(H, o + c, z[j] * (*(const f32x4*)(sc + c) + 1.0f) + *(const f32x4*)(sh + c), h8); }
    }
}

__device__ __forceinline__ void p11_pool(const Frame& F) {
    const int lane = lane_id();
    const bf16_t* HP = (const bf16_t*)(F.ws + A_HP); bf16_t* PP = (bf16_t*)(F.ws + A_PP);
    for (int m = F.gw; m < ML; m += F.NGW) {
        const int t = m % T;
#pragma unroll
        for (int g = 0; g < 4; ++g) {
            constexpr int dummy = 0; (void)dummy;
            const int half = 1 << g, c = 8 * lane + 512 * g;
            float acc[8], ctr[8];
#pragma unroll
            for (int e = 0; e < 8; ++e) acc[e] = 0.f;
            int cnt = 0;
#pragma unroll
            for (int o = -8; o < 8; ++o) { if (o < -half || o >= half) continue;
                const int tt = t + o; const bool ok = tt >= 0 && tt < T; float v[8]; unpack8(*(const u32x4*)(HP + (size_t)(m + (ok ? o : 0)) * D + c), v);
                cnt += ok ? 1 : 0;
#pragma unroll
                for (int e = 0; e < 8; ++e) { acc[e] += ok ? v[e] : 0.f; if (o == 0) ctr[e] = v[e]; } }
            const float inv = 1.0f / (float)cnt;
            u32x4 w; w.x = pk2(acc[0] * inv - ctr[0], acc[1] * inv - ctr[1]); w.y = pk2(acc[2] * inv - ctr[2], acc[3] * inv - ctr[3]);
            w.z = pk2(acc[4] * inv - ctr[4], acc[5] * inv - ctr[5]); w.w = pk2(acc[6] * inv - ctr[6], acc[7] * inv - ctr[7]);
            *(u32x4*)(PP + (size_t)m * D + c) = w;
        }
    }
}

__device__ __forceinline__ void p13_norm_router(const Frame& F, const Args& a) {
    const int lane = lane_id(), tid = F.wave * 64 + lane; (void)tid;
    LAS float* RT = (LAS float*)F.lds;
    LAS int* lcnt = (LAS int*)(F.lds + 65536);
    LAS int* le = (LAS int*)(F.lds + 65536 + 64);
    LAS int* lr = (LAS int*)(F.lds + 65536 + 64 + 256);
    for (int i = tid; i < D * NE; i += 512) RT[(i & 7) * D + (i >> 3)] = a.in[I_ROUTER][i];
    const float* MOD = (const float*)(F.ws + WS_MOD); float* XR = (float*)(F.ws + WS_XR);
    const float* MOD1 = MOD + (size_t)5 * MOD_N;
    const bf16_t* Y = (const bf16_t*)(F.ws + A_YP); void* H = (void*)(F.ws + A_H2B);
    const float* lnw = a.in[I_LNW] + 2 * D; const float* lnb = a.in[I_LNB] + 2 * D;
    int* TOKE = (int*)(F.ws + WS_TOK); int* TOKS = TOKE + 2 * ML; float* TOKP = (float*)(TOKE + 6 * ML);
    unsigned* gcnt = F.ctl + CW_GCNT;
    for (int rb = blockIdx.x; rb < ML / 32; rb += F.G) {
        __syncthreads();
        if (tid < 8) lcnt[tid] = 0;
        __syncthreads();
        for (int i = 0; i < 4; ++i) {
            const int rl = F.wave * 4 + i, m = rb * 32 + rl, b = m / T; const size_t o = (size_t)m * D;
            const float* g = MOD1 + 2 * D + (size_t)b * MOD_N;
            f32x4 z[8];
#pragma unroll
            for (int j = 0; j < 8; ++j) { const int c = 4 * lane + 256 * j; z[j] = *(const f32x4*)(XR + o + c) * ALPHA + *(const f32x4*)(g + c) * ld_bf4(Y + o + c); }
            ln_core(lane, z, lnw, lnb);
            const float* sh = MOD1 + 3 * D + (size_t)b * MOD_N; const float* sc = MOD1 + 4 * D + (size_t)b * MOD_N;
            float lg[8];
#pragma unroll
            for (int e = 0; e < 8; ++e) lg[e] = 0.f;
#pragma unroll
            for (int j = 0; j < 8; ++j) { const int c = 4 * lane + 256 * j; *(f32x4*)(XR + o + c) = z[j];
                const f32x4 hv = z[j] * (*(const f32x4*)(sc + c) + 1.0f) + *(const f32x4*)(sh + c);
                st_h(H, o + c, hv, MOE_FP8 != 0);
#pragma unroll
                for (int e = 0; e < 8; ++e) { const f32x4 rt = *(const LAS f32x4*)(RT + e * D + c); lg[e] += (hv[0] * rt[0] + hv[1] * rt[1]) + (hv[2] * rt[2] + hv[3] * rt[3]); } }
#pragma unroll
            for (int e = 0; e < 8; ++e) lg[e] = wave_sum(lg[e]);
            int i0 = 0; float l0 = lg[0];
#pragma unroll
            for (int e = 1; e < 8; ++e) if (lg[e] > l0) { l0 = lg[e]; i0 = e; }
            int i1 = -1; float l1 = -3.0e38f;
#pragma unroll
            for (int e = 0; e < 8; ++e) if (e != i0 && lg[e] > l1) { l1 = lg[e]; i1 = e; }
            if (i1 < 0) { i1 = (i0 + 1) & 7; l1 = l0; }
            const float e1 = fexp(l1 - l0), p0 = 1.0f / (1.0f + e1), p1 = e1 / (1.0f + e1);
            if (lane == 0) { TOKE[2 * m] = i0; TOKE[2 * m + 1] = i1; TOKP[2 * m] = p0; TOKP[2 * m + 1] = p1;
                le[2 * rl] = i0; le[2 * rl + 1] = i1; lr[2 * rl] = __hip_atomic_fetch_add(&lcnt[i0], 1, __ATOMIC_RELAXED, __HIP_MEMORY_SCOPE_WORKGROUP); lr[2 * rl + 1] = __hip_atomic_fetch_add(&lcnt[i1], 1, __ATOMIC_RELAXED, __HIP_MEMORY_SCOPE_WORKGROUP); }
        }
        __syncthreads();
        if (tid < 8) lcnt[8 + tid] = (int)__hip_atomic_fetch_add(gcnt + 64 * tid, (unsigned)lcnt[tid], __ATOMIC_RELAXED, __HIP_MEMORY_SCOPE_AGENT);
        __syncthreads();
        if (tid < 64) TOKS[2 * (rb * 32) + tid] = lcnt[8 + le[tid]] + lr[tid];
    }
    __syncthreads();
}

struct MoeTab { int mt[8], ts[8], ntile; };
__device__ __forceinline__ MoeTab moe_tab(const Frame& F) {
    MoeTab t; int acc = 0;
#pragma unroll
    for (int e = 0; e < 8; ++e) { const int c = __builtin_amdgcn_readfirstlane((int)__hip_atomic_load(F.ctl + CW_GCNT + 64 * e, __ATOMIC_RELAXED, __HIP_MEMORY_SCOPE_AGENT)); t.mt[e] = (c + 255) >> 8; t.ts[e] = acc; acc += t.mt[e]; }
    t.ntile = acc; return t;
}
__device__ __forceinline__ void p14_gather(const Frame& F) {
    const int lane = lane_id(), tid = F.wave * 64 + lane; (void)tid;
    const MoeTab tb = moe_tab(F);
    const int* TOKE = (const int*)(F.ws + WS_TOK); const int* TOKS = TOKE + 2 * ML; int* TOKD = (int*)(TOKE + 4 * ML);
    const bf16_t* H = (const bf16_t*)(F.ws + A_H2B); bf16_t* HG = (bf16_t*)(F.ws + A_HG);
    for (int idx = F.gw; idx < 2 * ML; idx += F.NGW) {
        const int m = idx >> 1, e = TOKE[idx], sl = TOKS[idx]; int ts = 0;
#pragma unroll
        for (int k = 0; k < 8; ++k) ts = (e == k) ? tb.ts[k] : ts;
        const int dst = ts * 256 + sl;
        if (lane == 0) TOKD[idx] = dst;
        constexpr int RB = MOE_FP8 ? D : 2 * D;
        const u32x4* s = (const u32x4*)((const unsigned char*)H + (size_t)m * RB) + lane; u32x4* dd = (u32x4*)((unsigned char*)HG + (size_t)dst * RB) + lane;
        const u32x4 v0 = s[0], v1 = s[64]; dd[0] = v0; dd[64] = v1;
        if (!MOE_FP8) { const u32x4 v2 = s[128], v3 = s[192]; dd[128] = v2; dd[192] = v3; }
    }
}
__device__ __forceinline__ void p17_final(const Frame& F, const Args& a) {
    const int lane = lane_id(), tid = F.wave * 64 + lane; (void)tid;
    const float* MOD1 = (const float*)(F.ws + WS_MOD) + (size_t)5 * MOD_N; const float* XR = (const float*)(F.ws + WS_XR);
    const int* TOKD = (const int*)(F.ws + WS_TOK) + 4 * ML; const float* TOKP = (const float*)((const int*)(F.ws + WS_TOK) + 6 * ML);
    const bf16_t* Y2 = (const bf16_t*)(F.ws + A_Y2); const float* PART = (const float*)(F.ws + WS_PART);
    const int xrow = (MOE_FP8 && F.G == 256) ? MOE_RT * 256 : 0x7fffffff;
    const float* lnw = a.in[I_LNW] + 3 * D; const float* lnb = a.in[I_LNB] + 3 * D;
    for (int m = F.gw; m < ML; m += F.NGW) {
        const int b = m / T; const float* g = MOD1 + 5 * D + (size_t)b * MOD_N; const size_t o = (size_t)m * D;
        const int d0 = TOKD[2 * m], d1 = TOKD[2 * m + 1]; const float p0 = TOKP[2 * m], p1 = TOKP[2 * m + 1];
        f32x4 z[8];
#pragma unroll
        for (int j = 0; j < 8; ++j) { const int c = 4 * lane + 256 * j;
            f32x4 y0, y1;
            if (d0 >= xrow) { const float* pp = PART + (size_t)(d0 - xrow) * D + c; y0 = *(const f32x4*)pp;
#pragma unroll
                for (int ks = 1; ks < MOE_KS; ++ks) y0 += *(const f32x4*)(pp + (size_t)ks * 2048 * D); } else y0 = ld_bf4(Y2 + (size_t)d0 * D + c);
            if (d1 >= xrow) { const float* pp = PART + (size_t)(d1 - xrow) * D + c; y1 = *(const f32x4*)pp;
#pragma unroll
                for (int ks = 1; ks < MOE_KS; ++ks) y1 += *(const f32x4*)(pp + (size_t)ks * 2048 * D); } else y1 = ld_bf4(Y2 + (size_t)d1 * D + c);
            const f32x4 y = y0 * p0 + y1 * p1;
            z[j] = *(const f32x4*)(XR + o + c) * ALPHA + *(const f32x4*)(g + c) * y; }
        ln_core(lane, z, lnw, lnb);
#if defined(PROBE_SCANCHK)
        { const float n1 = __hip_atomic_load((float*)(F.ctl + CW_CHK), __ATOMIC_RELAXED, __HIP_MEMORY_SCOPE_AGENT), d1 = __hip_atomic_load((float*)(F.ctl + CW_CHK + 64), __ATOMIC_RELAXED, __HIP_MEMORY_SCOPE_AGENT);
          const float n2 = __hip_atomic_load((float*)(F.ctl + CW_CHK + 128), __ATOMIC_RELAXED, __HIP_MEMORY_SCOPE_AGENT), d2 = __hip_atomic_load((float*)(F.ctl + CW_CHK + 192), __ATOMIC_RELAXED, __HIP_MEMORY_SCOPE_AGENT);
          const float eps = sqrtf(n1 / d1) + sqrtf(n2 / d2), sc = 1.0f + 10.0f * eps;
#pragma unroll
          for (int j = 0; j < 8; ++j) z[j] = z[j] * sc; }
#endif
#pragma unroll
        for (int j = 0; j < 8; ++j) { const int c = 4 * lane + 256 * j; *(f32x4*)(a.out + o + c) = z[j]; }
    }
}

struct SchedBase { __device__ __forceinline__ void a_ready(const pg8::Unit&) const {} __device__ __forceinline__ void done(const pg8::Unit&) const {} };
struct SchedDense : SchedBase {
    const char* A; const char* B; bf16_t* O; const float* bias; int nM, nN, ldaB, ldbB, ldc, act, G, c;
    __device__ __forceinline__ bool next(int i, pg8::Unit& u) const {
        const int L = i * G + c; if (L >= nM * nN) return false;
        int pm, pn; pg8::tile_of(L, nM, nN, pm, pn);
        u.A = A + (size_t)pm * 256 * ldaB; u.B = B + (size_t)pn * 256 * ldbB; u.O = O; u.bias = bias; u.pm = pm; u.pn = pn; u.ldc = ldc; u.act = act; return true;
    }
};
struct SchedP2 : SchedBase {
    unsigned char* ws; int G, c;
    __device__ __forceinline__ bool next(int i, pg8::Unit& u) const {
        int L = i * G + c; if (L >= 936) return false;
        int mix, nM, nN, act, ldc; size_t wo, oo;
        if (L < 256)      { mix = 0; nM = 32; nN = 8; act = pg8::ACT_NONE;    wo = W_WR;  oo = A_R;   ldc = D; }
        else if (L < 544) { L -= 256; mix = 2; nM = 36; nN = 8; act = pg8::ACT_NONE; wo = W_WK;  oo = A_KX;  ldc = D; }
        else if (L < 832) { L -= 544; mix = 3; nM = 36; nN = 8; act = pg8::ACT_NONE; wo = W_WV;  oo = A_V;   ldc = D; }
        else if (L < 868) { L -= 832; mix = 1; nM = 36; nN = 1; act = pg8::ACT_TANH; wo = W_WLD; oo = A_LW;  ldc = 256; }
        else if (L < 904) { L -= 868; mix = 4; nM = 36; nN = 1; act = pg8::ACT_NONE; wo = W_ALD; oo = A_LA;  ldc = 256; }
        else              { L -= 904; mix = 5; nM = 32; nN = 1; act = pg8::ACT_SIGMOID; wo = W_G1; oo = A_G1O; ldc = 256; }
        int pm, pn; pg8::tile_of(L, nM, nN, pm, pn);
        u.A = (const char*)ws + A_A6 + (size_t)mix * A6_STRIDE + (size_t)pm * 256 * D * 2; u.B = (const char*)ws + wo + (size_t)pn * 256 * D * 2;
        u.O = (bf16_t*)(ws + oo); u.bias = nullptr; u.pm = pm; u.pn = pn; u.ldc = ldc; u.act = act; return true;
    }
};
struct SchedP3 : SchedBase {
    unsigned char* ws; const float* dw0; const float* ia0; int G, c;
    __device__ __forceinline__ bool next(int i, pg8::Unit& u) const {
        int L = i * G + c; if (L >= 1408) return false;
        int nM, nN, act, ldc; size_t ao, wo, oo; const float* bias;
        if (L < 576)       { nM = 36; nN = 16; act = pg8::ACT_EW; ao = A_LW; wo = W_WLU; oo = A_EW; ldc = 2 * D; bias = dw0; }
        else if (L < 1152) { L -= 576; nM = 36; nN = 16; act = pg8::ACT_BIAS_SIGMOID; ao = A_LA; wo = W_ALU; oo = A_AA; ldc = 2 * D; bias = ia0; }
        else               { L -= 1152; nM = 32; nN = 8; act = pg8::ACT_NONE; ao = A_G1O; wo = W_G2; oo = A_GATE; ldc = D; bias = nullptr; }
        int pm, pn; pg8::tile_of(L, nM, nN, pm, pn);
        u.A = (const char*)ws + ao + (size_t)pm * 256 * 256 * 2; u.B = (const char*)ws + wo + (size_t)pn * 256 * 256 * 2;
        u.O = (bf16_t*)(ws + oo); u.bias = bias; u.pm = pm; u.pn = pn; u.ldc = ldc; u.act = act; return true;
    }
};
struct SchedPool : SchedBase {
    unsigned char* ws; const float* scale; int G, c;
    __device__ __forceinline__ bool next(int i, pg8::Unit& u) const {
        const int L = i * G + c; if (L >= 256) return false;
        int pm, pn; pg8::tile_of(L, 32, 8, pm, pn);
        u.A = (const char*)ws + A_PP + ((size_t)pm * 256 * D + (size_t)(pn >> 1) * 512) * 2; u.B = (const char*)ws + W_PW + (size_t)pn * 256 * 512 * 2;
        u.O = (bf16_t*)(ws + A_YP); u.bias = scale; u.pm = pm; u.pn = pn; u.ldc = D; u.act = pg8::ACT_COLSCALE; return true;
    }
};
struct SchedMoe : SchedBase {
    MoeTab tb; const char* A; const char* B; bf16_t* O; int NT, ldaB, ldbB, ldc; size_t estride; int NL, x, rank, W, mblock;
    __device__ __forceinline__ void init(int G, int c) { NL = (G % 8 == 0) ? 8 : 1; x = c % NL; rank = c / NL; W = G / NL; }
    __device__ __forceinline__ bool next(int i, pg8::Unit& u) const {
        int j = rank + i * W; int e = -1, nt, mtile;
        if (mblock) {
            const int S = (tb.ntile + NL - 1) / NL; mtile = x * S + j / NT; nt = j % NT;
            if (j >= S * NT || mtile >= tb.ntile) return false;
#pragma unroll
            for (int k = 0; k < 8; ++k) e = (mtile >= tb.ts[k] && mtile < tb.ts[k] + tb.mt[k]) ? k : e;
            if (e < 0) return false;
        } else {
            const int nn = (NT - x + NL - 1) / NL; int mte = 1, tse = 0;
#pragma unroll
            for (int k = 0; k < 8; ++k) { const int blk = nn * tb.mt[k]; if (e < 0) { if (j < blk) { e = k; mte = tb.mt[k]; tse = tb.ts[k]; } else j -= blk; } }
            if (e < 0) return false;
            nt = x + NL * (j / mte); mtile = tse + (j % mte);
        }
        u.A = A + (size_t)mtile * 256 * ldaB; u.B = B + (size_t)e * estride + (size_t)nt * 256 * ldbB; u.O = O; u.bias = nullptr; u.pm = mtile; u.pn = nt; u.ldc = ldc; u.act = pg8::ACT_NONE; return true;
    }
};

__device__ __forceinline__ MoeTab moe_tab_trunc(const MoeTab& t, int rt) { MoeTab o; int left = rt, acc = 0;
#pragma unroll
    for (int e = 0; e < 8; ++e) { const int m = t.mt[e] < left ? t.mt[e] : left; o.mt[e] = m; o.ts[e] = t.ts[e]; left -= m; acc += m; }
    o.ntile = acc; return o; }
struct SchedMoeX : SchedBase {
    MoeTab tb; const char* A; const char* B; float* P; int rt, ldaB, ldbB, G, c; size_t estride;
    __device__ __forceinline__ bool next(int i, pg8::Unit& u) const {
        const int j = i * G + c, nsub = (tb.ntile - rt) * 8 * MOE_KS; if (j >= nsub) return false;
        const int ks = j % MOE_KS, r = j / MOE_KS, nt = r & 7, mtile = rt + (r >> 3); int e = 0;
#pragma unroll
        for (int k = 0; k < 8; ++k) e = (mtile >= tb.ts[k] && mtile < tb.ts[k] + tb.mt[k]) ? k : e;
        const int kb = ks * (DFE / MOE_KS);
        u.A = A + (size_t)mtile * 256 * ldaB + kb; u.B = B + (size_t)e * estride + (size_t)nt * 256 * ldbB + kb;
        u.O = (bf16_t*)(P + (size_t)ks * 2048 * D); u.bias = nullptr; u.pm = mtile - rt; u.pn = nt; u.ldc = D; u.act = 0; return true;
    }
};
constexpr int NPHASE = 18;
#ifndef CONV_P2
#define CONV_P2 4096
#endif
#ifndef CONV_P8
#define CONV_P8 5632
#endif
#ifndef CONV_SCAN
#define CONV_SCAN 10240
#endif
constexpr int NC_P2 = 234, NC_P8 = 235, TI_X1 = TI_M2 - CONV_P8, TI_X0 = TI_X1 - CONV_P2, TI_W0 = TI_X0 - CONV_SCAN;
__global__ void __launch_bounds__(512, 2) trunk_fwd(Args args) {
    extern __shared__ __attribute__((aligned(16))) unsigned char lds_raw[];
    Frame F;
    F.lds = (LAS unsigned char*)lds_raw;
    F.wave = __builtin_amdgcn_readfirstlane((int)(threadIdx.x >> 6));
    F.G = gridDim.x; { const int bx = blockIdx.x; F.vcu = (F.G % 8 == 0) ? (bx % 8) * (F.G / 8) + bx / 8 : bx; }
    F.gw = F.vcu * 8 + F.wave; F.NGW = F.G * 8;
    F.ws = args.ws; F.ctl = (unsigned*)(args.ws + WS_CTL);
    volatile LAS unsigned* MISC = (volatile LAS unsigned*)(F.lds + MISC_OFF);
    if (threadIdx.x < 32) MISC[threadIdx.x] = 0u;
    __syncthreads();
    XcdBarrier bar; bar.bar = F.ctl + CW_BAR + args.li * XCD_BAR_WORDS; bar.x = 0; bar.st = nullptr;
    if (MK_N_LAUNCHES == 1) bar = xcd_barrier_post(F.ctl + CW_BAR + args.li * XCD_BAR_WORDS, MISC + 8);
    const int lo = args.ph_lo, hi = args.ph_hi;
#define IN(k) (lo <= (k) && (k) < hi)
#define SEAM(k) do { if (IN(k) && IN((k) + 1)) xcd_barrier(bar); } while (0)
    constexpr bool AL = true, SP = true;

    if (IN(0)) {
        p0_mod(F, args);
        p0_pos(F);
        p0_small(F, args);
#if defined(PROBE_READ)
        probe_read(F, args);
#endif
#if defined(PROBE_P0A)
        p0_mod(F, args); p0_pos(F); p0_small(F, args);
#endif
        p0_transpose_range(F, args, 0, F.G == 256 ? TI_W0 : TI_M2, F.gw, F.NGW, (LAS unsigned*)(F.lds + 53248 + F.wave * 8448));
    }
    SEAM(0);
    if (IN(1)) p1_mix(F, args);
    SEAM(1);
    if (IN(2)) {
        const bool split = F.G == 256;
        if (split && (int)blockIdx.x >= NC_P2) p0_transpose_range(F, args, TI_X0, TI_X1, ((int)blockIdx.x - NC_P2) * 8 + F.wave, (256 - NC_P2) * 8, (LAS unsigned*)(F.lds + 53248 + F.wave * 8448));
        else { SchedP2 S; S.ws = F.ws; S.G = split ? NC_P2 : F.G; S.c = blockIdx.x; pg8::gemm_phase<pg8::EpiAct, SchedP2, AL, SP>(F.lds, pg8::shape_bf16(D, D, D), S, pg8::EpiAct{}); }
    }
    SEAM(2);
    if (IN(3)) { SchedP3 S; S.ws = F.ws; S.dw0 = args.in[I_DW0]; S.ia0 = args.in[I_IA0]; S.G = F.G; S.c = blockIdx.x; pg8::gemm_phase<pg8::EpiAct, SchedP3, AL, SP>(F.lds, pg8::shape_bf16(256, 256, 256), S, pg8::EpiAct{}); }
    SEAM(3);
#if defined(PROBE_SCANCHK)
    if (IN(4)) { p4_scan(F, args); p4_scan2(F, args, F.ws + A_AO, (float*)(F.ws + WS_A + 644 * MiB)); xcd_barrier(bar); p4_compare(F); }
#elif defined(SCAN_STEP)
    if (IN(4)) p4_scan(F, args);
#else
    if (IN(4)) { if (F.G == 256) p4_scan3(F, args, F.ws + A_YD, (float*)(F.ws + WS_SB), TI_W0, TI_X0); else p4_scan2(F, args, F.ws + A_YD, (float*)(F.ws + WS_SB)); }
#endif
    SEAM(4);
    if (IN(5)) p5_ao(F, args);
    SEAM(5);
    if (IN(6)) { SchedDense S; S.A = (const char*)F.ws + A_AO; S.B = (const char*)F.ws + W_WO; S.O = (bf16_t*)(F.ws + A_YO); S.bias = nullptr; S.nM = 32; S.nN = 8; S.ldaB = 2 * D; S.ldbB = 2 * D; S.ldc = D; S.act = pg8::ACT_NONE; S.G = F.G; S.c = blockIdx.x;
        pg8::gemm_phase<pg8::EpiAct, SchedDense, AL, SP>(F.lds, pg8::shape_bf16(D, D, D), S, pg8::EpiAct{}); }
    SEAM(6);
    if (IN(7)) { const float* MOD = (const float*)(F.ws + WS_MOD); post_norm_rows(F, args, (const bf16_t*)(F.ws + A_YO), 2 * D, 0, MOD, 3 * D, 4 * D, (void*)(F.ws + A_H2), FFN_FP8 != 0); }
    SEAM(7);
    if (IN(8)) {
        const bool split = F.G == 256;
        if (split && (int)blockIdx.x >= NC_P8) p0_transpose_range(F, args, TI_X1, TI_M2, ((int)blockIdx.x - NC_P8) * 8 + F.wave, (256 - NC_P8) * 8, (LAS unsigned*)(F.lds + 53248 + F.wave * 8448));
        else { SchedDense S; S.A = (const char*)F.ws + A_H2; S.B = (const char*)F.ws + W_F13; S.O = (bf16_t*)(F.ws + A_U); S.bias = nullptr; S.nM = 32; S.nN = 44; S.ldaB = FFN_FP8 ? D : 2 * D; S.ldbB = S.ldaB; S.ldc = DFF; S.act = 0; S.G = split ? NC_P8 : F.G; S.c = blockIdx.x;
        if (FFN_FP8) pg8::gemm_phase<pg8::EpiSwiglu8, SchedDense, AL, SP, true>(F.lds, pg8::shape_fp8(D, D, D, 4, 6), S, pg8::EpiSwiglu8{});
        else pg8::gemm_phase<pg8::EpiSwiglu, SchedDense, AL, SP>(F.lds, pg8::shape_bf16(D, D, D), S, pg8::EpiSwiglu{}); } }
    SEAM(8);
    if (IN(9)) { SchedDense S; S.A = (const char*)F.ws + A_U; S.B = (const char*)F.ws + W_F2; S.O = (bf16_t*)(F.ws + A_YF); S.bias = nullptr; S.nM = 32; S.nN = 8; S.ldaB = FFN_FP8 ? DFF : 2 * DFF; S.ldbB = S.ldaB; S.ldc = D; S.act = pg8::ACT_NONE; S.G = F.G; S.c = blockIdx.x;
        if (FFN_FP8) pg8::gemm_phase<pg8::EpiAct, SchedDense, AL, SP, true>(F.lds, pg8::shape_fp8(DFF, DFF, DFF, 3, 8), S, pg8::EpiAct{});
        else pg8::gemm_phase<pg8::EpiAct, SchedDense, AL, SP>(F.lds, pg8::shape_bf16(DFF, DFF, DFF), S, pg8::EpiAct{}); }
    SEAM(9);
    if (IN(10)) { const float* MOD = (const float*)(F.ws + WS_MOD); post_norm_rows(F, args, (const bf16_t*)(F.ws + A_YF), 5 * D, 1, MOD + (size_t)5 * MOD_N, 0, D, (void*)(F.ws + A_HP), false); }
    SEAM(10);
    if (IN(11)) p11_pool(F);
    SEAM(11);
    if (IN(12)) { SchedPool S; S.ws = F.ws; S.scale = args.in[I_POOLS]; S.G = F.G; S.c = blockIdx.x; pg8::gemm_phase<pg8::EpiAct, SchedPool, AL, SP>(F.lds, pg8::shape_bf16(D, 512, 512), S, pg8::EpiAct{}); }
    SEAM(12);
    if (IN(13)) p13_norm_router(F, args);
    SEAM(13);
    if (IN(14)) p14_gather(F);
    SEAM(14);
    if (IN(15)) { SchedMoe S; S.tb = moe_tab(F); S.A = (const char*)F.ws + A_HG; S.B = (const char*)F.ws + W_M13; S.O = (bf16_t*)(F.ws + A_UG); S.NT = 56; S.mblock = 0; S.ldaB = MOE_FP8 ? D : 2 * D; S.ldbB = S.ldaB; S.ldc = DFE; S.estride = (size_t)2 * DFE * S.ldbB; S.init(F.G, blockIdx.x);
        if (MOE_FP8) pg8::gemm_phase<pg8::EpiSwiglu8, SchedMoe, AL, SP, true>(F.lds, pg8::shape_fp8(D, D, D, 4, 6), S, pg8::EpiSwiglu8{});
        else pg8::gemm_phase<pg8::EpiSwiglu, SchedMoe, AL, SP>(F.lds, pg8::shape_bf16(D, D, D), S, pg8::EpiSwiglu{}); }
    SEAM(15);
    if (IN(16)) { SchedMoe S; const MoeTab full = moe_tab(F); const bool splitk = MOE_FP8 && F.G == 256 && full.ntile > MOE_RT;
        S.tb = splitk ? moe_tab_trunc(full, MOE_RT) : full; S.A = (const char*)F.ws + A_UG; S.B = (const char*)F.ws + W_M2; S.O = (bf16_t*)(F.ws + A_Y2); S.NT = 8; S.mblock = 1; S.ldaB = MOE_FP8 ? DFE : 2 * DFE; S.ldbB = S.ldaB; S.ldc = D; S.estride = (size_t)D * S.ldbB; S.init(F.G, blockIdx.x);
        if (MOE_FP8) pg8::gemm_phase<pg8::EpiAct, SchedMoe, AL, SP, true>(F.lds, pg8::shape_fp8(DFE, DFE, DFE, 3, 8), S, pg8::EpiAct{});
        else pg8::gemm_phase<pg8::EpiAct, SchedMoe, AL, SP>(F.lds, pg8::shape_bf16(DFE, DFE, DFE), S, pg8::EpiAct{});
        if (splitk) { SchedMoeX X; X.tb = full; X.A = S.A; X.B = S.B; X.P = (float*)(F.ws + WS_PART); X.rt = MOE_RT; X.ldaB = DFE; X.ldbB = DFE; X.G = F.G; X.c = blockIdx.x; X.estride = S.estride;
            pg8::gemm_phase<pg8::EpiF32P, SchedMoeX, AL, SP, true>(F.lds, pg8::shape_fp8(DFE, DFE, DFE / MOE_KS, 3, 8), X, pg8::EpiF32P{}); } }
    SEAM(16);
    if (IN(17)) p17_final(F, args);
#undef IN
#undef SEAM
}

extern "C" void kernel_launch(void* const* d_in, const int* in_sizes, int n_in, void* d_out, int out_size, void* d_ws, size_t ws_size, hipStream_t stream) {
    static int grid = 0;
    if (grid == 0) {
        if (n_in != 35 || out_size != ML * D || ws_size < WS_END) { fprintf(stderr, "kernel_launch: unexpected problem (n_in %d, out %d, ws %zu < %zu); nothing launched\n", n_in, out_size, ws_size, (size_t)WS_END); grid = -1; return; }
        int dev = 0, cus = 0, per_cu = 0;
        if (hipGetDevice(&dev) != hipSuccess || hipDeviceGetAttribute(&cus, hipDeviceAttributeMultiprocessorCount, dev) != hipSuccess) { grid = -1; return; }
        if (hipFuncSetAttribute((const void*)trunk_fwd, hipFuncAttributeMaxDynamicSharedMemorySize, LDS_BYTES) != hipSuccess) { fprintf(stderr, "kernel_launch: hipFuncSetAttribute failed\n"); grid = -1; return; }
        if (hipOccupancyMaxActiveBlocksPerMultiprocessor(&per_cu, (const void*)trunk_fwd, 512, LDS_BYTES) != hipSuccess || per_cu < 1) fprintf(stderr, "kernel_launch: occupancy query reports %d\n", per_cu);
        (void)hipGetLastError();
        grid = cus;
    }
    if (grid < 0) return;
    if (hipMemsetAsync((char*)d_ws + WS_CTL, 0, CTL_ZERO_BYTES, stream) != hipSuccess) return;
    Args a{};
    for (int i = 0; i < 35; ++i) a.in[i] = (const float*)d_in[i];
    a.out = (float*)d_out; a.ws = (unsigned char*)d_ws;
#if defined(PROBE_DUP)
    a.ph_lo = 0; a.ph_hi = PROBE_DUP + 1; a.li = 0; hipLaunchKernelGGL(trunk_fwd, dim3(grid), dim3(512), LDS_BYTES, stream, a);
    a.ph_lo = PROBE_DUP; a.ph_hi = NPHASE; a.li = 1; hipLaunchKernelGGL(trunk_fwd, dim3(grid), dim3(512), LDS_BYTES, stream, a);
#else
    if (MK_N_LAUNCHES == 1) { a.ph_lo = 0; a.ph_hi = NPHASE; hipLaunchKernelGGL(trunk_fwd, dim3(grid), dim3(512), LDS_BYTES, stream, a); }
#endif
#if !defined(PROBE_DUP)
    else for (int p = 0; p < NPHASE; ++p) { a.ph_lo = p; a.ph_hi = p + 1; hipLaunchKernelGGL(trunk_fwd, dim3(grid), dim3(512), LDS_BYTES, stream, a); }
#endif
}
```

```cpp
#define FFN_I8 1
#define RKV_I8 1
#define WO_I8 1
#define LORA_I8 1
#define FFN_DN8 1
#define F13_P1_N 384
#define CMAX_LAST 1
#define P3_KSKIP 1
#define POOL_SLIDE 1
#define NC_P2 188
#define CONV_P2 6912
#define NC_P8 202
#define CONV_P8 (TN_F2+8192)
#define CONV_P15 12288
#define NC_P15 224
#define CONV_SCAN 15616
#include <hip/hip_runtime.h>
#include <cstdio>
#include <cstdint>

#ifndef MK_N_LAUNCHES
#define MK_N_LAUNCHES 1
#endif

#define LAS __attribute__((address_space(3)))
#define PG8_LAS __attribute__((address_space(3)))
typedef unsigned short bf16_t;
typedef short bf16x8 __attribute__((ext_vector_type(8)));
typedef float f32x4 __attribute__((ext_vector_type(4)));
typedef float f32x2 __attribute__((ext_vector_type(2)));
typedef unsigned u32x4 __attribute__((ext_vector_type(4)));
typedef unsigned u32x2 __attribute__((ext_vector_type(2)));
typedef int i32x8 __attribute__((ext_vector_type(8)));
typedef int i32x4 __attribute__((ext_vector_type(4)));

constexpr int D = 2048, NB = 4, T = 2048, TC = 256, NH = 32, HS = 64;
constexpr int ML = NB * T;
constexpr int MC = NB * TC;
constexpr int MT = ML + MC;
constexpr int DFF = 5632, DFE = 7168, NE = 8;
constexpr int MOD_N = 6 * D;
constexpr int MROWS_PAD = 2 * ML + NE * 256;
constexpr float ALPHA = 1.41421356237309515f;
constexpr float LN_EPS = 1e-5f, GN_EPS = 64e-5f;

__device__ __forceinline__ unsigned f2bf(float f) { unsigned u = __builtin_bit_cast(unsigned, f); return (u + 0x7fffu + ((u >> 16) & 1u)) >> 16; }
typedef __bf16 bf16x2v __attribute__((ext_vector_type(2)));
__device__ __forceinline__ unsigned pk2(float lo, float hi) { const f32x2 v = {lo, hi}; return __builtin_bit_cast(unsigned, __builtin_convertvector(v, bf16x2v)); }
__device__ __forceinline__ float clamp8(float x) { return __builtin_amdgcn_fmed3f(x, -440.f, 440.f); }
__device__ __forceinline__ unsigned pk4_fp8(float a, float b, float c, float d) { int v = __builtin_amdgcn_cvt_pk_fp8_f32(clamp8(a), clamp8(b), 0, false); v = __builtin_amdgcn_cvt_pk_fp8_f32(clamp8(c), clamp8(d), v, true); return (unsigned)v; }
__device__ __forceinline__ unsigned pk4_fp8_nc(float a, float b, float c, float d) { int v = __builtin_amdgcn_cvt_pk_fp8_f32(a, b, 0, false); v = __builtin_amdgcn_cvt_pk_fp8_f32(c, d, v, true); return (unsigned)v; }
__device__ __forceinline__ unsigned pk4_i8(float a, float b, float c, float d) {
    const unsigned ua = __builtin_bit_cast(unsigned, a + 12582912.0f), ub = __builtin_bit_cast(unsigned, b + 12582912.0f), uc = __builtin_bit_cast(unsigned, c + 12582912.0f), ud = __builtin_bit_cast(unsigned, d + 12582912.0f);
    const unsigned lo = __builtin_amdgcn_perm(ub, ua, 0x0c0c0400u), hi = __builtin_amdgcn_perm(ud, uc, 0x0c0c0400u);
    return __builtin_amdgcn_perm(hi, lo, 0x05040100u);
}
__device__ __forceinline__ float bflo(unsigned w) { return __builtin_bit_cast(float, w << 16); }
__device__ __forceinline__ float bfhi(unsigned w) { return __builtin_bit_cast(float, w & 0xffff0000u); }
__device__ __forceinline__ float fexp(float x) { return __builtin_amdgcn_exp2f(x * 1.44269504088896341f); }
__device__ __forceinline__ float flog(float x) { return __builtin_amdgcn_logf(x) * 0.69314718055994531f; }
__device__ __forceinline__ float sigmoidf_(float x) { return __builtin_amdgcn_rcpf(1.0f + fexp(-x)); }
__device__ __forceinline__ float siluf_(float x) { return x * __builtin_amdgcn_rcpf(1.0f + fexp(-x)); }
__device__ __forceinline__ float tanhf_(float x) { return 1.0f - 2.0f * __builtin_amdgcn_rcpf(1.0f + fexp(2.0f * x)); }
__device__ __forceinline__ int lane_id() { int l; asm volatile("v_mbcnt_lo_u32_b32 %0, -1, 0\n\tv_mbcnt_hi_u32_b32 %0, -1, %0" : "=v"(l)); return l; }
template <int CTRL> __device__ __forceinline__ float dpp_f(float v) { return __builtin_bit_cast(float, __builtin_amdgcn_update_dpp(0, __builtin_bit_cast(int, v), CTRL, 0xF, 0xF, true)); }
__device__ __forceinline__ float wave_sum(float v) {
#pragma unroll
    for (int o = 1; o < 64; o <<= 1) v += __shfl_xor(v, o);
    return v;
}
__device__ __forceinline__ float row_max16(float v) {
    v = fmaxf(v, dpp_f<0xB1>(v)); v = fmaxf(v, dpp_f<0x4E>(v)); v = fmaxf(v, dpp_f<0x141>(v)); v = fmaxf(v, dpp_f<0x140>(v)); return v;
}
__device__ __forceinline__ float wave_max(float v) {
    v = fmaxf(v, dpp_f<0xB1>(v)); v = fmaxf(v, dpp_f<0x4E>(v)); v = fmaxf(v, dpp_f<0x141>(v)); v = fmaxf(v, dpp_f<0x140>(v));
    v = fmaxf(v, __shfl_xor(v, 16)); v = fmaxf(v, __shfl_xor(v, 32)); return v;
}
__device__ __forceinline__ float sum8(float v) {
    v += dpp_f<0xB1>(v);
    v += dpp_f<0x4E>(v);
    v += dpp_f<0x141>(v);
    return v;
}
__device__ __forceinline__ const char* uptr(const void* p) {
    unsigned long long v = (unsigned long long)p;
    unsigned lo = (unsigned)__builtin_amdgcn_readfirstlane((int)(unsigned)v), hi = (unsigned)__builtin_amdgcn_readfirstlane((int)(unsigned)(v >> 32));
    return (const char*)(((unsigned long long)hi << 32) | lo);
}

namespace pg8 {
constexpr int BM = 256, BK = 64, HALF = 128, HTB = HALF * BK * 2  , STAGE_BYTES = 8 * HTB, NXCD = 8, WGM = 8;
__host__ __device__ __forceinline__ int lds_byte(int r, int c) { const int st = (r >> 4) * 2 + (c >> 5), rr = r & 15, cc = c & 31, ob = rr * 64 + cc * 2; return st * 1024 + (ob ^ (((ob >> 9) & 1) << 5)); }
__host__ __device__ __forceinline__ void stage_rc(int b, int& R, int& C) { const int st = b / 1024, sb = b % 1024, swz = sb ^ (((sb >> 9) & 1) << 5); R = (st >> 1) * 16 + swz / 64; C = (st & 1) * 32 + (swz % 64) / 2; }
__host__ __device__ __forceinline__ int perm32(int rho) { const int n = rho >> 4, i = rho & 15; return 8 * (i >> 2) + 4 * n + (i & 3); }
__device__ __forceinline__ unsigned cvt_pk_bf16(float lo, float hi) { unsigned r; asm volatile("v_cvt_pk_bf16_f32 %0, %1, %2" : "=v"(r) : "v"(lo), "v"(hi)); return r; }

struct Unit { const char* A; const char* B; bf16_t* O; const float* bias; const float* rs  ; int pm, pn, ldc, act; };
struct Shape { int ldaB, ldbB, nt, sc; };
__host__ __device__ __forceinline__ Shape shape_bf16(int lda, int ldb, int K) { return Shape{2 * lda, 2 * ldb, K / 64, 0}; }
__host__ __device__ __forceinline__ Shape shape_fp8(int lda, int ldb, int K, int ea, int eb) { return Shape{lda, ldb, K / 128, ((127 - ea) << 8) | (127 - eb)}; }

__device__ __forceinline__ void tile_of(int l, int nM, int nN, int& pm, int& pn) {
    const int nwg = nM * nN; int wgid = l;
    { const int q = nwg / NXCD, r = nwg % NXCD, xcd = wgid % NXCD, off = wgid / NXCD; wgid = (xcd < r ? xcd * (q + 1) : r * (q + 1) + (xcd - r) * q) + off; }
    const int nig = WGM * nN, gid = wgid / nig, fm = gid * WGM, gsz = (nM - fm) < WGM ? (nM - fm) : WGM;
    pm = fm + ((wgid % nig) % gsz); pn = (wgid % nig) / gsz;
}

enum Act { ACT_NONE = 0, ACT_TANH = 1, ACT_SIGMOID = 2, ACT_EW = 3, ACT_BIAS_SIGMOID = 4, ACT_COLSCALE = 5 };
__device__ __forceinline__ float act_apply(float v, float b, int act) {
    if (act == ACT_TANH) return tanhf_(v);
    if (act == ACT_SIGMOID) return sigmoidf_(v);
    if (act == ACT_EW) return 0.60653065971263342f * sigmoidf_(v + b);
    if (act == ACT_BIAS_SIGMOID) return sigmoidf_(v + b);
    if (act == ACT_COLSCALE) return v * b;
    return v;
}
struct EpiAct {
    static constexpr bool PERM = true, AFTER_DRAIN = false;
    __device__ __forceinline__ void operator()(const f32x4 (&acc)[2][2][4][2], const Unit& u, int wr, int wc) const {
        const int lane_ = lane_id(), fr = lane_ & 15, fq = lane_ >> 4;
        const int row0 = u.pm * BM + wr * 64 + fr, col0 = u.pn * BM + wc * 32 + 8 * fq; const int act = u.act;
        f32x4 bv[2][2];
#pragma unroll
        for (int bj = 0; bj < 2; ++bj)
#pragma unroll
            for (int n = 0; n < 2; ++n) bv[bj][n] = u.bias ? *(const f32x4*)(u.bias + col0 + bj * HALF + 4 * n) : (f32x4){0.f, 0.f, 0.f, 0.f};
#pragma unroll
        for (int ai = 0; ai < 2; ++ai)
#pragma unroll
            for (int m = 0; m < 4; ++m) { bf16_t* rowp = u.O + (size_t)(row0 + ai * HALF + m * 16) * u.ldc + col0;
#pragma unroll
                for (int bj = 0; bj < 2; ++bj) { f32x4 v0 = acc[ai][bj][m][0], v1 = acc[ai][bj][m][1];
                    if (act != ACT_NONE) {
#pragma unroll
                        for (int j = 0; j < 4; ++j) { v0[j] = act_apply(v0[j], bv[bj][0][j], act); v1[j] = act_apply(v1[j], bv[bj][1][j], act); } }
                    u32x4 w; w.x = cvt_pk_bf16(v0[0], v0[1]); w.y = cvt_pk_bf16(v0[2], v0[3]); w.z = cvt_pk_bf16(v1[0], v1[1]); w.w = cvt_pk_bf16(v1[2], v1[3]);
                    *(u32x4*)(rowp + bj * HALF) = w; } }
    }
};
struct EpiActI8 {
    static constexpr bool PERM = true, AFTER_DRAIN = false;
    const float* colmul = nullptr;
    __device__ __forceinline__ void operator()(const f32x4 (&acc)[2][2][4][2], const Unit& u, int wr, int wc) const {
        const int lane_ = lane_id(), fr = lane_ & 15, fq = lane_ >> 4;
        const int row0 = u.pm * BM + wr * 64 + fr, col0 = u.pn * BM + wc * 32 + 8 * fq;
        f32x4 bv[2][2];
#pragma unroll
        for (int bj = 0; bj < 2; ++bj)
#pragma unroll
            for (int n = 0; n < 2; ++n) { bv[bj][n] = *(const f32x4*)(u.bias + col0 + bj * HALF + 4 * n) * (1.0f / 127.0f); if (colmul) bv[bj][n] = bv[bj][n] * *(const f32x4*)(colmul + col0 + bj * HALF + 4 * n); }
#pragma unroll
        for (int ai = 0; ai < 2; ++ai)
#pragma unroll
            for (int m = 0; m < 4; ++m) { const int r = row0 + ai * HALF + m * 16; bf16_t* rowp = u.O + (size_t)r * u.ldc + col0; const float rv = u.rs[r];
#pragma unroll
                for (int bj = 0; bj < 2; ++bj) {
                    f32x4 v0 = __builtin_convertvector(__builtin_bit_cast(i32x4, acc[ai][bj][m][0]), f32x4) * (bv[bj][0] * rv), v1 = __builtin_convertvector(__builtin_bit_cast(i32x4, acc[ai][bj][m][1]), f32x4) * (bv[bj][1] * rv);
                    if (u.act != ACT_NONE) {
#pragma unroll
                        for (int j = 0; j < 4; ++j) { v0[j] = act_apply(v0[j], 0.f, u.act); v1[j] = act_apply(v1[j], 0.f, u.act); } }
                    u32x4 w; w.x = cvt_pk_bf16(v0[0], v0[1]); w.y = cvt_pk_bf16(v0[2], v0[3]); w.z = cvt_pk_bf16(v1[0], v1[1]); w.w = cvt_pk_bf16(v1[2], v1[3]);
                    *(u32x4*)(rowp + bj * HALF) = w; } }
    }
};
struct EpiF32P {
    static constexpr bool PERM = true, AFTER_DRAIN = false;
    __device__ __forceinline__ void operator()(const f32x4 (&acc)[2][2][4][2], const Unit& u, int wr, int wc) const {
        const int lane_ = lane_id(), fr = lane_ & 15, fq = lane_ >> 4;
        const int row0 = u.pm * BM + wr * 64 + fr, col0 = u.pn * BM + wc * 32 + 8 * fq;
#pragma unroll
        for (int ai = 0; ai < 2; ++ai)
#pragma unroll
            for (int m = 0; m < 4; ++m) { float* rowp = (float*)u.O + (size_t)(row0 + ai * HALF + m * 16) * u.ldc + col0;
#pragma unroll
                for (int bj = 0; bj < 2; ++bj) { *(f32x4*)(rowp + bj * HALF) = acc[ai][bj][m][0]; *(f32x4*)(rowp + bj * HALF + 4) = acc[ai][bj][m][1]; } }
    }
};
struct EpiSwiglu {
    static constexpr bool PERM = true, AFTER_DRAIN = false;
    __device__ __forceinline__ void operator()(const f32x4 (&acc)[2][2][4][2], const Unit& u, int wr, int wc) const {
        const int lane_ = lane_id(), fr = lane_ & 15, fq = lane_ >> 4;
        const int row0 = u.pm * BM + wr * 64 + fr, col0 = u.pn * HALF + wc * 32 + 8 * fq;
#pragma unroll
        for (int ai = 0; ai < 2; ++ai)
#pragma unroll
            for (int m = 0; m < 4; ++m) { bf16_t* rowp = u.O + (size_t)(row0 + ai * HALF + m * 16) * u.ldc + col0;
                f32x4 o0, o1;
#pragma unroll
                for (int j = 0; j < 4; ++j) { o0[j] = siluf_(acc[ai][0][m][0][j]) * acc[ai][1][m][0][j]; o1[j] = siluf_(acc[ai][0][m][1][j]) * acc[ai][1][m][1][j]; }
                u32x4 w; w.x = cvt_pk_bf16(o0[0], o0[1]); w.y = cvt_pk_bf16(o0[2], o0[3]); w.z = cvt_pk_bf16(o1[0], o1[1]); w.w = cvt_pk_bf16(o1[2], o1[3]);
                *(u32x4*)rowp = w; }
    }
};

struct EpiSwiglu8 {
    static constexpr bool PERM = true, AFTER_DRAIN = false;
    __device__ __forceinline__ void operator()(const f32x4 (&acc)[2][2][4][2], const Unit& u, int wr, int wc) const {
        const int lane_ = lane_id(), fr = lane_ & 15, fq = lane_ >> 4;
        const int row0 = u.pm * BM + wr * 64 + fr, col0 = u.pn * HALF + wc * 32 + 8 * fq;
#pragma unroll
        for (int ai = 0; ai < 2; ++ai)
#pragma unroll
            for (int m = 0; m < 4; ++m) { unsigned char* rowp = (unsigned char*)u.O + (size_t)(row0 + ai * HALF + m * 16) * u.ldc + col0;
                f32x4 o0, o1;
#pragma unroll
                for (int j = 0; j < 4; ++j) { o0[j] = siluf_(acc[ai][0][m][0][j]) * acc[ai][1][m][0][j] * 8.0f; o1[j] = siluf_(acc[ai][0][m][1][j]) * acc[ai][1][m][1][j] * 8.0f; }
                u32x2 w; w.x = pk4_fp8(o0[0], o0[1], o0[2], o0[3]); w.y = pk4_fp8(o1[0], o1[1], o1[2], o1[3]);
                *(u32x2*)rowp = w; }
    }
};

template <bool F8OUT = false>
struct EpiSwigluI8T {
    static constexpr bool PERM = true, AFTER_DRAIN = false;
    const float* rs; const unsigned* cmax; int nw;
    __device__ __forceinline__ void operator()(const f32x4 (&acc)[2][2][4][2], const Unit& u, int wr, int wc) const {
        const int lane_ = lane_id(), fr = lane_ & 15, fq = lane_ >> 4;
        const int row0 = u.pm * BM + wr * 64 + fr, col0 = u.pn * HALF + wc * 32 + 8 * fq;
        f32x4 c1[2], c3[2];
#pragma unroll
        for (int n = 0; n < 2; ++n) { c1[n] = __builtin_bit_cast(f32x4, *(const u32x4*)(cmax + col0 + 4 * n)) * (1.0f / 127.0f); c3[n] = __builtin_bit_cast(f32x4, *(const u32x4*)(cmax + nw + col0 + 4 * n)) * ((F8OUT ? 8.0f : 1.0f) / 127.0f); }
#pragma unroll
        for (int ai = 0; ai < 2; ++ai)
#pragma unroll
            for (int m = 0; m < 4; ++m) { const int r = row0 + ai * HALF + m * 16; bf16_t* rowp = u.O + (size_t)r * u.ldc + col0; const float rv = rs[r];
                f32x4 o0, o1;
                const f32x4 A0 = __builtin_convertvector(__builtin_bit_cast(i32x4, acc[ai][0][m][0]), f32x4) * (c1[0] * rv), B0 = __builtin_convertvector(__builtin_bit_cast(i32x4, acc[ai][1][m][0]), f32x4) * (c3[0] * rv);
                const f32x4 A1 = __builtin_convertvector(__builtin_bit_cast(i32x4, acc[ai][0][m][1]), f32x4) * (c1[1] * rv), B1 = __builtin_convertvector(__builtin_bit_cast(i32x4, acc[ai][1][m][1]), f32x4) * (c3[1] * rv);
#pragma unroll
                for (int j = 0; j < 4; ++j) { o0[j] = siluf_(A0[j]) * B0[j]; o1[j] = siluf_(A1[j]) * B1[j]; }
                if constexpr (F8OUT) { u32x2 w; w.x = pk4_fp8(o0[0], o0[1], o0[2], o0[3]); w.y = pk4_fp8(o1[0], o1[1], o1[2], o1[3]);
                    *(u32x2*)((unsigned char*)u.O + (size_t)r * u.ldc + col0) = w; }
                else { u32x4 w; w.x = cvt_pk_bf16(o0[0], o0[1]); w.y = cvt_pk_bf16(o0[2], o0[3]); w.z = cvt_pk_bf16(o1[0], o1[1]); w.w = cvt_pk_bf16(o1[2], o1[3]);
                    *(u32x4*)rowp = w; } }
    }
};
using EpiSwigluI8 = EpiSwigluI8T<false>;

struct PanelStats8 {
    unsigned* xbuf;
    unsigned* cnt;
    unsigned* tmo;
    unsigned code;
    __device__ __forceinline__ bool run(const f32x4 (&v)[2][2][4][2], const Unit& u, int wr, int wc, int fr, int fq, PG8_LAS unsigned char* lds, int wid, int lane) const {
        PG8_LAS f32x2* P = (PG8_LAS f32x2*)lds;
        PG8_LAS f32x2* S = (PG8_LAS f32x2*)(lds + 8192);
        PG8_LAS unsigned* flag = (PG8_LAS unsigned*)(lds + 8192 + 2048);
#pragma unroll
        for (int ai = 0; ai < 2; ++ai)
#pragma unroll
            for (int m = 0; m < 4; ++m) {
                float s = 0.f;
#pragma unroll
                for (int bj = 0; bj < 2; ++bj)
#pragma unroll
                    for (int n = 0; n < 2; ++n) { const f32x4 x = v[ai][bj][m][n]; s += (x[0] + x[1]) + (x[2] + x[3]); }
                s += __shfl_xor(s, 16); s += __shfl_xor(s, 32);
                const float mw = s * (1.0f / 64.0f); float q = 0.f;
#pragma unroll
                for (int bj = 0; bj < 2; ++bj)
#pragma unroll
                    for (int n = 0; n < 2; ++n) { const f32x4 d = v[ai][bj][m][n] - mw; q += (d[0] * d[0] + d[1] * d[1]) + (d[2] * d[2] + d[3] * d[3]); }
                q += __shfl_xor(q, 16); q += __shfl_xor(q, 32);
                if (fq == 0) P[(ai * HALF + wr * 64 + m * 16 + fr) * 4 + wc] = (f32x2){mw, q};
            }
        asm volatile("s_waitcnt lgkmcnt(0)" ::: "memory"); __builtin_amdgcn_s_barrier(); asm volatile("" ::: "memory");
        const int row = wid * 32 + (lane & 31);
        if (lane < 32) {
            const f32x2 a = P[row * 4 + 0], b = P[row * 4 + 1], c = P[row * 4 + 2], d = P[row * 4 + 3];
            const float mt = (a.x + b.x + c.x + d.x) * 0.25f;
            const float da = a.x - mt, db = b.x - mt, dc = c.x - mt, dd = d.x - mt;
            const float m2 = (a.y + b.y) + (c.y + d.y) + 64.0f * ((da * da + db * db) + (dc * dc + dd * dd));
            unsigned long long* slot = (unsigned long long*)xbuf + ((size_t)(u.pm * BM + row) * 8 + u.pn);
            __hip_atomic_store(slot, ((unsigned long long)__builtin_bit_cast(unsigned, m2) << 32) | __builtin_bit_cast(unsigned, mt), __ATOMIC_RELAXED, __HIP_MEMORY_SCOPE_AGENT);
        }
        asm volatile("s_waitcnt vmcnt(0)" ::: "memory");
        if (lane == 0) __hip_atomic_fetch_add(cnt + 64 * u.pm, 1u, __ATOMIC_RELAXED, __HIP_MEMORY_SCOPE_AGENT);
        if (wid == 0) {
            bool dead = false; const unsigned long long t0 = __builtin_amdgcn_s_memrealtime(); const unsigned want = 8u * 8u;
            for (;;) {
                if ((unsigned)__builtin_amdgcn_readfirstlane(__hip_atomic_load(cnt + 64 * u.pm, __ATOMIC_RELAXED, __HIP_MEMORY_SCOPE_AGENT)) >= want) break;
                if (__builtin_amdgcn_s_memrealtime() - t0 > 2000000ull) {
                    if (lane == 0) { unsigned expect = 0u; __hip_atomic_compare_exchange_strong(tmo + 1, &expect, code | (unsigned)(u.pm & 0xff), __ATOMIC_RELAXED, __ATOMIC_RELAXED, __HIP_MEMORY_SCOPE_AGENT);
                                     __hip_atomic_store(tmo, 1u, __ATOMIC_RELAXED, __HIP_MEMORY_SCOPE_AGENT); }
                    dead = true; break; }
                __builtin_amdgcn_s_sleep(2);
            }
            __builtin_amdgcn_fence(__ATOMIC_ACQUIRE, "agent");
            if (lane == 0) flag[0] = dead ? 1u : 0u;
        }
        asm volatile("s_waitcnt vmcnt(0) lgkmcnt(0)" ::: "memory"); __builtin_amdgcn_s_barrier(); asm volatile("" ::: "memory");
        const bool bad = flag[0] != 0u;
        if (lane < 32) {
            const unsigned long long* slot = (const unsigned long long*)xbuf + (size_t)(u.pm * BM + row) * 8; float mt[8], m2[8]; float ms = 0.f;
#pragma unroll
            for (int t = 0; t < 8; ++t) { const unsigned long long w = __hip_atomic_load(slot + t, __ATOMIC_RELAXED, __HIP_MEMORY_SCOPE_AGENT); mt[t] = __builtin_bit_cast(float, (unsigned)w); m2[t] = __builtin_bit_cast(float, (unsigned)(w >> 32)); ms += mt[t]; }
            const float mean = ms * 0.125f; float q = 0.f;
#pragma unroll
            for (int t = 0; t < 8; ++t) { const float dm = mt[t] - mean; q += m2[t] + 256.0f * dm * dm; }
            S[row] = (f32x2){mean, 1.0f / sqrtf(q * (1.0f / 2048.0f) + LN_EPS)};
        }
        asm volatile("s_waitcnt lgkmcnt(0)" ::: "memory"); __builtin_amdgcn_s_barrier(); asm volatile("" ::: "memory");
        return bad;
    }
};
struct EpiLnMod {
    static constexpr bool PERM = false, AFTER_DRAIN = true;
    const float* xin; const float* pos; const float* g; const float* lnw; const float* lnb; const float* sc; const float* sh; float* XR; bf16_t* H; PanelStats8 st;
    __device__ __forceinline__ void fused(f32x4 (&acc)[2][2][4][2], const Unit& u, int wr, int wc, int fr, int fq, PG8_LAS unsigned char* lds, int wid, int lane) const {
        const PG8_LAS f32x2* S = (const PG8_LAS f32x2*)(lds + 8192);
        const int col0 = u.pn * BM + wc * 32 + 4 * fq; const size_t mo = (size_t)(u.pm >> 3) * MOD_N;
        f32x4 gv[2][2];
#pragma unroll
        for (int bj = 0; bj < 2; ++bj)
#pragma unroll
            for (int n = 0; n < 2; ++n) gv[bj][n] = *(const f32x4*)(g + mo + col0 + bj * HALF + n * 16);
#pragma unroll
        for (int ai = 0; ai < 2; ++ai)
#pragma unroll
            for (int m = 0; m < 4; ++m) { const int r = u.pm * BM + ai * HALF + wr * 64 + m * 16 + fr; const size_t off = (size_t)r * D + col0; const size_t poff = (size_t)(r % T) * D + col0;
#pragma unroll
                for (int bj = 0; bj < 2; ++bj)
#pragma unroll
                    for (int n = 0; n < 2; ++n) { f32x4 xv = *(const f32x4*)(xin + off + bj * HALF + n * 16); if (pos) xv += *(const f32x4*)(pos + poff + bj * HALF + n * 16);
                        acc[ai][bj][m][n] = xv * ALPHA + gv[bj][n] * acc[ai][bj][m][n]; }
                asm volatile("" : "+v"(acc[ai][0][m][0]), "+v"(acc[ai][0][m][1]), "+v"(acc[ai][1][m][0]), "+v"(acc[ai][1][m][1]));
                asm volatile("" ::: "memory"); }
        const bool bad = st.run(acc, u, wr, wc, fr, fq, lds, wid, lane);
        const float qnan = __builtin_nanf("");
#pragma unroll
        for (int bj = 0; bj < 2; ++bj)
#pragma unroll
            for (int n = 0; n < 2; ++n) { const int c = col0 + bj * HALF + n * 16;
                const f32x4 w4 = *(const f32x4*)(lnw + c), b4 = *(const f32x4*)(lnb + c), s4 = *(const f32x4*)(sc + mo + c) + 1.0f, h4 = *(const f32x4*)(sh + mo + c);
#pragma unroll
                for (int ai = 0; ai < 2; ++ai)
#pragma unroll
                    for (int m = 0; m < 4; ++m) { const int rl = ai * HALF + wr * 64 + m * 16 + fr; const f32x2 sr = S[rl]; const size_t off = (size_t)(u.pm * BM + rl) * D + c;
                        f32x4 xn = (acc[ai][bj][m][n] - sr.x) * sr.y * w4 + b4; if (bad) xn = (f32x4){qnan, qnan, qnan, qnan};
                        *(f32x4*)(XR + off) = xn; const f32x4 hv = xn * s4 + h4;
                        u32x2 hw; hw.x = cvt_pk_bf16(hv[0], hv[1]); hw.y = cvt_pk_bf16(hv[2], hv[3]); *(u32x2*)(H + off) = hw; } }
    }
};

template <class Epi, class Sched, bool ALIGN_EPI = true, bool SP2 = true, int FP8 = 0  , int AUXB = 0>
__device__ __forceinline__ void gemm_phase(PG8_LAS unsigned char* lds, const Shape g, const Sched& S, const Epi& E) {
    const int lane = lane_id(), wid = __builtin_amdgcn_readfirstlane((int)(threadIdx.x >> 6)), tid = wid * 64 + lane, wr = wid >> 2, wc = wid & 3, fr = lane & 15, fq = lane >> 4;
    const int nt = g.nt;
    unsigned voffA[2], voffB[2];
#pragma unroll
    for (int i = 0; i < 2; ++i) { int R, C; stage_rc(tid * 16 + i * 8192, R, C); const int Rb = Epi::PERM ? ((R & ~31) + perm32(R & 31)) : R;
        voffA[i] = (unsigned)(R * g.ldaB + C * 2); voffB[i] = (unsigned)(Rb * g.ldbB + C * 2); }
    const size_t kstep = (size_t)(BK * 2);
    const size_t hstepA = (size_t)HALF * g.ldaB, hstepB = (size_t)HALF * g.ldbB;
    const unsigned ldsw = (unsigned)wid * 1024u;
    const int aoff = lds_byte(wr * 64 + fr, fq * 8), boff = lds_byte(wc * 32 + fr, fq * 8);
#define PG8_SA(b, h) (((b) * 2 + (h)) * HTB)
#define PG8_SB(b, h) ((4 + (b) * 2 + (h)) * HTB)
#define PG8_STAGE(bufoff, gbase, voff) do { _Pragma("unroll") for (int _i = 0; _i < 2; ++_i) \
        __builtin_amdgcn_global_load_lds((const unsigned*)((const char*)(gbase) + (voff)[_i]), (PG8_LAS unsigned*)(lds + (bufoff) + ldsw + _i * 8192), 16, 0, 0); } while (0)
#define PG8_STAGEB(bufoff, gbase, voff) do { _Pragma("unroll") for (int _i = 0; _i < 2; ++_i) \
        __builtin_amdgcn_global_load_lds((const unsigned*)((const char*)(gbase) + (voff)[_i]), (PG8_LAS unsigned*)(lds + (bufoff) + ldsw + _i * 8192), 16, 0, AUXB); } while (0)
#define PG8_LDA(dst, b, h) do { _Pragma("unroll") for (int m = 0; m < 4; ++m) _Pragma("unroll") for (int k = 0; k < 2; ++k) dst[m][k] = *(const PG8_LAS bf16x8*)(lds + PG8_SA(b, h) + aoff + m * 2048 + k * 1024); } while (0)
#define PG8_LDB(dst, b, h) do { _Pragma("unroll") for (int n = 0; n < 2; ++n) _Pragma("unroll") for (int k = 0; k < 2; ++k) dst[n][k] = *(const PG8_LAS bf16x8*)(lds + PG8_SB(b, h) + boff + n * 2048 + k * 1024); } while (0)
#define PG8_MMA(ai, bj, At, Bt) do { __builtin_amdgcn_s_setprio(1); _Pragma("unroll") for (int m = 0; m < 4; ++m) _Pragma("unroll") for (int n = 0; n < 2; ++n) { \
        if constexpr (FP8 == 1) { const i32x4 b0_ = __builtin_bit_cast(i32x4, Bt[n][0]), b1_ = __builtin_bit_cast(i32x4, Bt[n][1]), a0_ = __builtin_bit_cast(i32x4, At[m][0]), a1_ = __builtin_bit_cast(i32x4, At[m][1]); \
            const i32x8 B8_ = __builtin_shufflevector(b0_, b1_, 0, 1, 2, 3, 4, 5, 6, 7), A8_ = __builtin_shufflevector(a0_, a1_, 0, 1, 2, 3, 4, 5, 6, 7); \
            asm volatile("v_mfma_scale_f32_16x16x128_f8f6f4 %0, %1, %2, %0, %3, %3 op_sel:[0,1,0] op_sel_hi:[0,0,0]" : "+v"(acc[ai][bj][m][n]) : "v"(B8_), "v"(A8_), "v"(g.sc)); } \
        else if constexpr (FP8 == 2) { _Pragma("unroll") for (int k = 0; k < 2; ++k) acc[ai][bj][m][n] = __builtin_bit_cast(f32x4, __builtin_amdgcn_mfma_i32_16x16x64_i8(__builtin_bit_cast(i32x4, Bt[n][k]), __builtin_bit_cast(i32x4, At[m][k]), __builtin_bit_cast(i32x4, acc[ai][bj][m][n]), 0, 0, 0)); } \
        else { _Pragma("unroll") for (int k = 0; k < 2; ++k) acc[ai][bj][m][n] = __builtin_amdgcn_mfma_f32_16x16x32_bf16(Bt[n][k], At[m][k], acc[ai][bj][m][n], 0, 0, 0); } } \
        __builtin_amdgcn_s_setprio(0); } while (0)
#define PG8_WAIT_V(n) asm volatile("s_waitcnt vmcnt(" #n ")" ::: "memory")
#define PG8_WAIT_L(n) asm volatile("s_waitcnt lgkmcnt(" #n ")" ::: "memory")
#define PG8_BAR __builtin_amdgcn_s_barrier()
#define PG8_SCHED __builtin_amdgcn_sched_barrier(0)
    Unit cur, nxt; int ui = 0;
    if (!S.next(0, cur)) return;
    f32x4 acc[2][2][4][2];
#pragma unroll
    for (int a = 0; a < 2; ++a)
#pragma unroll
        for (int b = 0; b < 2; ++b)
#pragma unroll
            for (int m = 0; m < 4; ++m)
#pragma unroll
                for (int n = 0; n < 2; ++n) acc[a][b][m][n] = (f32x4){0.f, 0.f, 0.f, 0.f};
    bf16x8 At[4][2], B0[2][2], B1[2][2];
    const char* cA = cur.A; const char* cB = cur.B;
    S.a_ready(cur);
    if constexpr (SP2) {
        PG8_STAGEB(PG8_SB(0, 0), cB, voffB); PG8_STAGEB(PG8_SB(0, 1), cB + hstepB, voffB); PG8_STAGE(PG8_SA(0, 0), cA, voffA); PG8_STAGE(PG8_SA(0, 1), cA + hstepA, voffA);
        if (wr == 1) PG8_BAR;
        PG8_WAIT_V(2); PG8_BAR;
        PG8_STAGEB(PG8_SB(1, 0), cB + kstep, voffB); PG8_STAGE(PG8_SA(1, 0), cA + kstep, voffA); PG8_STAGEB(PG8_SB(1, 1), cB + hstepB + kstep, voffB);
        PG8_WAIT_V(6); PG8_BAR;
    } else {
        PG8_STAGEB(PG8_SB(0, 0), cB, voffB); PG8_STAGE(PG8_SA(0, 0), cA, voffA); PG8_STAGEB(PG8_SB(0, 1), cB + hstepB, voffB); PG8_STAGE(PG8_SA(0, 1), cA + hstepA, voffA);
        if (wr == 1) PG8_BAR;
        PG8_WAIT_V(4); PG8_BAR;
        PG8_STAGEB(PG8_SB(1, 0), cB + kstep, voffB); PG8_STAGE(PG8_SA(1, 0), cA + kstep, voffA); PG8_STAGEB(PG8_SB(1, 1), cB + hstepB + kstep, voffB);
        PG8_WAIT_V(6); PG8_BAR;
    }
    for (;;) {
        const bool has_next = S.next(ui + 1, nxt);
        const char* nA = has_next ? nxt.A : cA; const char* nB = has_next ? nxt.B : cB;
        for (int t = 0; t < nt; t += 2) {
            const bool last = (t == nt - 2);
            const char* a1 = cA + (size_t)(t + 1) * kstep;
            const char* a2 = last ? nA : cA + (size_t)(t + 2) * kstep; const char* b2 = last ? nB : cB + (size_t)(t + 2) * kstep;
            const char* a3 = a2 + kstep; const char* b3 = b2 + kstep;
            if (last && has_next) S.a_ready(nxt);
            if constexpr (SP2) {
            PG8_LDB(B0, 0, 0); PG8_LDB(B1, 0, 1); PG8_SCHED; PG8_LDA(At, 0, 0); PG8_STAGE(PG8_SA(1, 1), a1 + hstepA, voffA);
            PG8_WAIT_V(8); PG8_WAIT_L(0); PG8_BAR; PG8_MMA(0, 0, At, B0); PG8_MMA(0, 1, At, B1); PG8_BAR; PG8_SCHED;
            PG8_LDA(At, 0, 1); PG8_STAGEB(PG8_SB(0, 0), b2, voffB); PG8_STAGEB(PG8_SB(0, 1), b2 + hstepB, voffB); PG8_STAGE(PG8_SA(0, 0), a2, voffA);
            PG8_WAIT_V(8); PG8_WAIT_L(0); PG8_BAR; PG8_MMA(1, 0, At, B0); PG8_MMA(1, 1, At, B1); PG8_BAR; PG8_SCHED;
            PG8_LDB(B0, 1, 0); PG8_LDB(B1, 1, 1); PG8_SCHED; PG8_LDA(At, 1, 0); PG8_STAGE(PG8_SA(0, 1), a2 + hstepA, voffA);
            PG8_WAIT_V(8); PG8_WAIT_L(0); PG8_BAR; PG8_MMA(0, 0, At, B0); PG8_MMA(0, 1, At, B1); PG8_BAR; PG8_SCHED;
            PG8_LDA(At, 1, 1); PG8_STAGEB(PG8_SB(1, 0), b3, voffB); PG8_STAGEB(PG8_SB(1, 1), b3 + hstepB, voffB); PG8_STAGE(PG8_SA(1, 0), a3, voffA);
            PG8_WAIT_V(8); PG8_WAIT_L(0); PG8_BAR; PG8_MMA(1, 0, At, B0); PG8_MMA(1, 1, At, B1); PG8_BAR; PG8_SCHED;
            } else {
            PG8_LDB(B0, 0, 0); PG8_SCHED; PG8_LDA(At, 0, 0); PG8_STAGE(PG8_SA(1, 1), a1 + hstepA, voffA);
            PG8_WAIT_L(8); PG8_BAR; PG8_WAIT_L(0); PG8_MMA(0, 0, At, B0); PG8_BAR; PG8_SCHED;
            PG8_LDB(B1, 0, 1); PG8_STAGEB(PG8_SB(0, 0), b2, voffB);
            PG8_BAR; PG8_WAIT_L(0); PG8_MMA(0, 1, At, B1); PG8_BAR;
            PG8_LDA(At, 0, 1); PG8_STAGE(PG8_SA(0, 0), a2, voffA);
            PG8_BAR; PG8_WAIT_L(0); PG8_MMA(1, 0, At, B0); PG8_BAR; PG8_SCHED;
            PG8_STAGEB(PG8_SB(0, 1), b2 + hstepB, voffB);
            PG8_WAIT_V(6); PG8_BAR; PG8_MMA(1, 1, At, B1); PG8_BAR;
            PG8_LDB(B0, 1, 0); PG8_SCHED; PG8_LDA(At, 1, 0); PG8_STAGE(PG8_SA(0, 1), a2 + hstepA, voffA);
            PG8_WAIT_L(8); PG8_BAR; PG8_WAIT_L(0); PG8_MMA(0, 0, At, B0); PG8_BAR; PG8_SCHED;
            PG8_LDB(B1, 1, 1); PG8_STAGEB(PG8_SB(1, 0), b3, voffB);
            PG8_BAR; PG8_WAIT_L(0); PG8_MMA(0, 1, At, B1); PG8_BAR;
            PG8_LDA(At, 1, 1); PG8_STAGE(PG8_SA(1, 0), a3, voffA);
            PG8_BAR; PG8_WAIT_L(0); PG8_MMA(1, 0, At, B0); PG8_BAR; PG8_SCHED;
            PG8_STAGEB(PG8_SB(1, 1), b3 + hstepB, voffB);
            PG8_WAIT_V(6); PG8_BAR; PG8_MMA(1, 1, At, B1); PG8_BAR;
            }
        }
        if constexpr (ALIGN_EPI) { if (wr == 0) PG8_BAR; }
        if constexpr (FP8 == 1) asm volatile("s_nop 15\n\ts_nop 15\n\ts_nop 15" ::: "memory");
        if constexpr (!Epi::AFTER_DRAIN) { E(acc, cur, wr, wc); S.done(cur); }
        if (!has_next) break;
#pragma unroll
        for (int a = 0; a < 2; ++a)
#pragma unroll
            for (int b = 0; b < 2; ++b)
#pragma unroll
                for (int m = 0; m < 4; ++m)
#pragma unroll
                    for (int n = 0; n < 2; ++n) acc[a][b][m][n] = (f32x4){0.f, 0.f, 0.f, 0.f};
        cur = nxt; cA = nA; cB = nB; ++ui;
        if constexpr (ALIGN_EPI) { if (wr == 1) PG8_BAR; }
    }
    PG8_WAIT_V(0);
    if constexpr (!ALIGN_EPI) { if (wr == 0) PG8_BAR; }
    PG8_BAR;
    if constexpr (Epi::AFTER_DRAIN) { E.fused(acc, cur, wr, wc, fr, fq, lds, wid, lane); S.done(cur); }
#undef PG8_SA
#undef PG8_SB
#undef PG8_STAGE
#undef PG8_STAGEB
#undef PG8_LDA
#undef PG8_LDB
#undef PG8_MMA
#undef PG8_WAIT_V
#undef PG8_WAIT_L
#undef PG8_BAR
#undef PG8_SCHED
}

}

#ifndef MOE_FP8
#define MOE_FP8 1
#endif
#ifndef LN_FUSE
#define LN_FUSE 0
#endif
#ifndef MOE_AUX_UP
#define MOE_AUX_UP 0
#endif
#ifndef MOE_AUX_DN
#define MOE_AUX_DN 0
#endif
#ifndef FFN_FP8
#define FFN_FP8 0
#endif
#ifndef FFN_DN8
#define FFN_DN8 0
#endif
#define FFN_D8 (FFN_FP8 || FFN_DN8)
#ifndef F13_P1_N
#define F13_P1_N 0
#endif
#ifndef CMAX_LAST
#define CMAX_LAST 0
#endif
#ifndef POOL_I8
#define POOL_I8 0
#endif
#ifndef FFN_DN_I8
#define FFN_DN_I8 0
#endif
#ifndef LORA_I8
#define LORA_I8 0
#endif
#ifndef WO_I8
#define WO_I8 0
#endif
#ifndef RKV_I8
#define RKV_I8 0
#endif
#ifndef FFN_I8
#define FFN_I8 0
#endif
constexpr size_t MiB = 1u << 20;
constexpr size_t WS_CTL = 0, CTL_ZERO_BYTES = 1 * MiB;
constexpr size_t WS_MOD = 1 * MiB;
constexpr size_t WS_TOK = 2 * MiB;
constexpr size_t WS_SB  = 3 * MiB;
constexpr size_t WS_POS = 6 * MiB;
constexpr size_t WS_XR  = 22 * MiB;
constexpr size_t WS_W   = 86 * MiB;
constexpr size_t W_WR = WS_W, W_WK = W_WR + 8 * MiB, W_WV = W_WK + 8 * MiB, W_WO = W_WV + 8 * MiB;
constexpr size_t W_WLD = W_WO + 8 * MiB, W_ALD = W_WLD + 1 * MiB, W_G1 = W_ALD + 1 * MiB;
constexpr size_t W_WLU = W_G1 + 1 * MiB, W_ALU = W_WLU + 2 * MiB, W_G2 = W_ALU + 2 * MiB;
constexpr size_t W_PW = W_G2 + 1 * MiB;
constexpr size_t W_F13 = W_PW + 2 * MiB;
constexpr size_t W_F2 = W_F13 + 44 * MiB;
constexpr size_t W_M13 = W_F2 + 22 * MiB;
constexpr size_t W_M2 = W_M13 + 448 * MiB;
constexpr size_t WS_A = W_M2 + 224 * MiB;
constexpr size_t A_A6 = WS_A, A6_STRIDE = 36 * MiB;
constexpr size_t A_R = WS_A + 216 * MiB, A_KX = WS_A + 248 * MiB, A_V = WS_A + 284 * MiB;
constexpr size_t A_LW = WS_A + 320 * MiB, A_LA = WS_A + 325 * MiB, A_G1O = WS_A + 330 * MiB;
constexpr size_t A_EW = WS_A + 336 * MiB, A_AA = WS_A + 408 * MiB;
constexpr size_t A_GATE = WS_A + 480 * MiB, A_YD = WS_A + 512 * MiB;
constexpr size_t A_AO = WS_A + 580 * MiB, A_YO = WS_A + 612 * MiB;
constexpr int LDU = DFF + 64, LDF2 = DFF + 64, LDUG = MOE_FP8 ? DFE + 128 : DFE, LDM2 = MOE_FP8 ? DFE + 128 : DFE;
constexpr size_t A_H2 = WS_A, A_U = WS_A + 32 * MiB, A_YF = WS_A + 122 * MiB, A_HP = WS_A + 154 * MiB, A_PP = WS_A + 186 * MiB, A_YP = WS_A + 218 * MiB, A_H2B = WS_A + 250 * MiB;
constexpr size_t A_HG = WS_A + 282 * MiB, A_UG = WS_A + 354 * MiB, A_Y2 = WS_A + 606 * MiB;
constexpr size_t WS_PART = WS_A + 678 * MiB;
constexpr int MOE_KS = 7, MOE_RT = 64;
constexpr size_t W_F2P = WS_PART + 112 * MiB;
constexpr size_t WS_END = W_F2P + 23 * MiB;
static_assert(A_YO + 32 * MiB <= WS_PART && A_Y2 + (size_t)MROWS_PAD * D * 2 <= WS_PART && A_UG + (size_t)MROWS_PAD * LDUG * (MOE_FP8 ? 1 : 2) <= A_Y2 && A_HG + (size_t)MROWS_PAD * D * 2 <= A_UG && A_U + (size_t)ML * LDU * 2 <= A_YF && (size_t)D * LDF2 * 2 <= 23 * MiB && (size_t)NE * D * LDM2 * (MOE_FP8 ? 1 : 2) <= 224 * MiB, "ws map");
static_assert(W_M13 + (size_t)NE * 2 * DFE * D * 2 == W_M2 && W_M2 + (size_t)NE * D * DFE * 2 == WS_A && W_F13 + (size_t)2 * DFF * D * 2 == W_F2, "weight map");
constexpr int CW_BAR = 4096;
constexpr int CW_LN1 = 32768, CW_LN2 = 32768 + 64 * 32;
constexpr size_t WS_XB1 = 2 * MiB + 512 * 1024, WS_XB2 = 5 * MiB;
constexpr int CW_CMAX = 65536;
constexpr int CW_CMAX4 = 65536 + 2 * 5632 + 5 * 2048;
constexpr size_t WS_RSP = 5 * MiB + 896 * 1024;
constexpr int CW_CMAX3 = 65536 + 2 * 5632 + 4 * 2048;
constexpr size_t WS_RSU = 5 * MiB + 864 * 1024;
constexpr int CW_CMAX2 = 65536 + 2 * 5632;
constexpr size_t WS_CML = 5 * MiB + 832 * 1024;
constexpr size_t WS_RSO = 5 * MiB + 768 * 1024;
constexpr size_t WS_RS6 = 5 * MiB + 512 * 1024;
constexpr size_t WS_RS = 2 * MiB + 384 * 1024;
constexpr int CW_GCNT = 16384;

constexpr int LDS_BYTES = 147456;
constexpr int MISC_OFF = LDS_BYTES - 256;

#define XB_TMO      128
#define XB_XCNT(j)  (256  + 64 * (j))
#define XB_XSUB(j)  (1280 + 64 * (j))
#define XB_XGEN(j)  (2304 + 64 * (j))
#define XB_TOP      3328
#define XB_TOPGEN   3392
#define XCD_BAR_WORDS 3456
#define XB_SPIN_CAP (1u << 18)
__device__ __forceinline__ unsigned xb_ld(unsigned* p)              { return __hip_atomic_load(p, __ATOMIC_RELAXED, __HIP_MEMORY_SCOPE_AGENT); }
__device__ __forceinline__ unsigned xb_add(unsigned* p, unsigned v) { return __hip_atomic_fetch_add(p, v, __ATOMIC_RELAXED, __HIP_MEMORY_SCOPE_AGENT); }
__device__ __forceinline__ unsigned xb_xcc_id() { return (unsigned)__builtin_amdgcn_s_getreg((3 << 11) | 20) & 0xFu; }
#define XB_SPIN(cond, bar) do { unsigned _sp = 0; while (cond) { __builtin_amdgcn_s_sleep(1); \
    if ((++_sp & 255u) == 0u) { if (xb_ld(&(bar)[XB_TMO])) break; if (_sp > XB_SPIN_CAP) { atomicAdd(&(bar)[XB_TMO], 1u); break; } } } } while (0)
struct XcdBarrier { unsigned* bar; unsigned x; volatile LAS unsigned* st; };
__device__ __forceinline__ XcdBarrier xcd_barrier_post(unsigned* bar, volatile LAS unsigned* st) {
    XcdBarrier b; b.bar = bar; b.x = xb_xcc_id(); b.st = st;
    if (threadIdx.x == 0) (void)xb_add(&bar[XB_XCNT(b.x)], 1u);
    return b;
}
__device__ __forceinline__ void xcd_barrier_complete(unsigned* bar, unsigned x, unsigned& nloc, unsigned& nx) {
    const unsigned G = gridDim.x * gridDim.y * gridDim.z;
    unsigned sum, cnt, mine, sp = 0u;
    for (;;) {
        sum = 0u; cnt = 0u; mine = 0u;
#pragma unroll
        for (unsigned j = 0; j < 16; ++j) { const unsigned c = xb_ld(&bar[XB_XCNT(j)]); sum += c; cnt += (c > 0u) ? 1u : 0u; mine = (j == x) ? c : mine; }
        if (sum == G) break;
        __builtin_amdgcn_s_sleep(1);
        if ((++sp & 255u) == 0u) { if (xb_ld(&bar[XB_TMO])) break; if (sp > XB_SPIN_CAP) { atomicAdd(&bar[XB_TMO], 1u); break; } }
    }
    nloc = mine > 0u ? mine : 1u; nx = cnt > 0u ? cnt : 1u;
}
__device__ __forceinline__ void xcd_barrier(const XcdBarrier& b) {
    asm volatile("s_waitcnt vmcnt(0)" ::: "memory");
    __syncthreads();
    if (threadIdx.x == 0) {
        unsigned* bar = b.bar;
        __builtin_amdgcn_s_waitcnt(0);
        unsigned nloc = b.st[0], nx = b.st[1];
        if (nloc == 0u) { xcd_barrier_complete(bar, b.x, nloc, nx); b.st[0] = nloc; b.st[1] = nx; }
        const unsigned old = xb_add(&bar[XB_XSUB(b.x)], 1u);
        const unsigned gen = old / nloc;
        if (old + 1u == (gen + 1u) * nloc) {
            __builtin_amdgcn_fence(__ATOMIC_RELEASE, "agent");
            asm volatile("s_waitcnt vmcnt(0)" ::: "memory");
            const unsigned og = xb_add(&bar[XB_TOP], 1u);
            const unsigned tg = og / nx;
            if (og + 1u == (tg + 1u) * nx) xb_add(&bar[XB_TOPGEN], 1u);
            else XB_SPIN(xb_ld(&bar[XB_TOPGEN]) == tg, bar);
            __builtin_amdgcn_fence(__ATOMIC_ACQUIRE, "agent");
            xb_add(&bar[XB_XGEN(b.x)], 1u);
            asm volatile("s_waitcnt vmcnt(0)" ::: "memory");
        } else {
            XB_SPIN(xb_ld(&bar[XB_XGEN(b.x)]) == gen, bar);
            __builtin_amdgcn_fence(__ATOMIC_ACQUIRE, "agent");
            asm volatile("s_waitcnt vmcnt(0)" ::: "memory");
        }
    }
    __syncthreads();
}

struct Args { const float* in[35]; float* out; unsigned char* ws; int ph_lo, ph_hi, li, pad; };
static_assert(sizeof(Args) == 35 * 8 + 8 + 8 + 16, "Args has no padding");
enum In { I_X = 0, I_C, I_CTX, I_CCTX, I_WMOD, I_BMOD, I_LNW, I_LNB, I_MU, I_WR, I_WK, I_WV, I_WO, I_DW0, I_DW1, I_DW2, I_IA0, I_IA1, I_IA2, I_G1, I_G2, I_KK, I_KA, I_RK, I_GNW, I_GNB,
          I_POOLW, I_POOLS, I_FW1, I_FW3, I_FW2, I_ROUTER, I_MW1, I_MW3, I_MW2 };
struct Frame {
    LAS unsigned char* lds; int wave, vcu, G, gw, NGW;
    unsigned char* ws; unsigned* ctl;
};
#define LDS_WAIT() asm volatile("s_waitcnt lgkmcnt(0)" ::: "memory")
__device__ __forceinline__ void unpack8(const u32x4 w, float (&f)[8]) { f[0] = bflo(w.x); f[1] = bfhi(w.x); f[2] = bflo(w.y); f[3] = bfhi(w.y); f[4] = bflo(w.z); f[5] = bfhi(w.z); f[6] = bflo(w.w); f[7] = bfhi(w.w); }

__device__ __forceinline__ void p0_mod(const Frame& F, const Args& a) {
    const int lane = lane_id(), tid = F.wave * 64 + lane; (void)tid;
    LAS float* sc = (LAS float*)F.lds;
    LAS float* red = (LAS float*)(F.lds + 40960);
    const float* c = a.in[I_C]; const float* cc = a.in[I_CCTX];
    for (int i = tid; i < 5 * D; i += 512) { const int j = i / D, k = i % D; const float v = j < 4 ? c[j * D + k] : cc[k]; sc[i] = siluf_(v); }
    __syncthreads();
    float* MOD = (float*)(F.ws + WS_MOD);
    const int x = lane & 7, q = lane >> 3;
    for (int u = blockIdx.x; u < 2 * (MOD_N / 32); u += F.G) {
        const int l = u / (MOD_N / 32), cb = u % (MOD_N / 32);
        const float* W = a.in[I_WMOD] + (size_t)l * D * MOD_N + cb * 32 + 4 * x;
        float acc[5][4];
#pragma unroll
        for (int j = 0; j < 5; ++j)
#pragma unroll
            for (int e = 0; e < 4; ++e) acc[j][e] = 0.f;
#pragma unroll 8
        for (int i = 0; i < 32; ++i) {
            const int k = F.wave * 256 + 8 * i + q;
            const f32x4 w = __builtin_nontemporal_load((const f32x4*)(W + (size_t)k * MOD_N));
#pragma unroll
            for (int j = 0; j < 5; ++j) { const float s = sc[j * D + k];
#pragma unroll
                for (int e = 0; e < 4; ++e) acc[j][e] += s * w[e]; }
        }
#pragma unroll
        for (int j = 0; j < 5; ++j)
#pragma unroll
            for (int e = 0; e < 4; ++e) { float v = acc[j][e]; v += __shfl_xor(v, 8); v += __shfl_xor(v, 16); v += __shfl_xor(v, 32); acc[j][e] = v; }
        __syncthreads();
        if (q == 0) {
#pragma unroll
            for (int j = 0; j < 5; ++j)
#pragma unroll
                for (int e = 0; e < 4; ++e) red[(F.wave * 5 + j) * 32 + 4 * x + e] = acc[j][e];
        }
        __syncthreads();
        if (tid < 160) { const int j = tid / 32, col = tid % 32; float s = 0.f;
#pragma unroll
            for (int w = 0; w < 8; ++w) s += red[(w * 5 + j) * 32 + col];
            MOD[(size_t)(l * 5 + j) * MOD_N + cb * 32 + col] = s + a.in[I_BMOD][l * MOD_N + cb * 32 + col]; }
    }
    __syncthreads();
}
#ifndef MOD_V2
#define MOD_V2 0
#endif
constexpr int CW_MODCNT = 90112;
__device__ __forceinline__ void p0_mod2(const Frame& F, const Args& a) {
    const int lane = lane_id(), tid = F.wave * 64 + lane;
    LAS float* sc = (LAS float*)F.lds;
    LAS float* red = (LAS float*)(F.lds + 40960);
    LAS unsigned* flag = (LAS unsigned*)(F.lds + 40960 + 40960);
    const float* c = a.in[I_C]; const float* cc = a.in[I_CCTX];
    for (int i = tid; i < 5 * D; i += 512) { const int j = i / D, k = i % D; const float v = j < 4 ? c[j * D + k] : cc[k]; sc[i] = siluf_(v); }
    __syncthreads();
    float* MOD = (float*)(F.ws + WS_MOD); float* PARTM = (float*)(F.ws + WS_PART);
    for (int u = blockIdx.x; u < 768; u += F.G) {
        const int kp = u & 7, g = u >> 3, l = g / 48, cb = g % 48;
        const float* W = a.in[I_WMOD] + ((size_t)l * D + kp * 256 + F.wave * 32) * MOD_N + cb * 256 + 4 * lane;
        float acc[5][4];
#pragma unroll
        for (int j = 0; j < 5; ++j)
#pragma unroll
            for (int e = 0; e < 4; ++e) acc[j][e] = 0.f;
#pragma unroll 8
        for (int i = 0; i < 32; ++i) {
            const int k = kp * 256 + F.wave * 32 + i;
            const f32x4 w = __builtin_nontemporal_load((const f32x4*)(W + (size_t)i * MOD_N));
#pragma unroll
            for (int j = 0; j < 5; ++j) { const float s = sc[j * D + k];
#pragma unroll
                for (int e = 0; e < 4; ++e) acc[j][e] += s * w[e]; }
        }
        __syncthreads();
#pragma unroll
        for (int j = 0; j < 5; ++j) *(LAS f32x4*)(red + (F.wave * 5 + j) * 256 + 4 * lane) = (f32x4){acc[j][0], acc[j][1], acc[j][2], acc[j][3]};
        __syncthreads();
        for (int o = tid; o < 5 * 256; o += 512) { const int j = o >> 8, col = o & 255; float s = 0.f;
#pragma unroll
            for (int w = 0; w < 8; ++w) s += red[(w * 5 + j) * 256 + col];
            __hip_atomic_store(PARTM + ((size_t)(kp * 2 + l) * 5 + j) * MOD_N + cb * 256 + col, s, __ATOMIC_RELAXED, __HIP_MEMORY_SCOPE_AGENT); }
        asm volatile("s_waitcnt vmcnt(0)" ::: "memory");
        __syncthreads();
        if (tid == 0) { const unsigned old = __hip_atomic_fetch_add(F.ctl + CW_MODCNT + g, 1u, __ATOMIC_RELAXED, __HIP_MEMORY_SCOPE_AGENT); flag[0] = (old == 7u) ? 1u : 0u; }
        __syncthreads();
        if (flag[0]) {
            for (int o = tid; o < 5 * 256; o += 512) { const int j = o >> 8, col = o & 255; float s = a.in[I_BMOD][l * MOD_N + cb * 256 + col];
#pragma unroll
                for (int p = 0; p < 8; ++p) s += __hip_atomic_load(PARTM + ((size_t)(p * 2 + l) * 5 + j) * MOD_N + cb * 256 + col, __ATOMIC_RELAXED, __HIP_MEMORY_SCOPE_AGENT);
                MOD[(size_t)(l * 5 + j) * MOD_N + cb * 256 + col] = s; }
        }
    }
    __syncthreads();
}
__device__ __forceinline__ void p0_pos(const Frame& F) {
    const int lane = lane_id(), tid = F.wave * 64 + lane; (void)tid;
    float* POS = (float*)(F.ws + WS_POS);
    for (int t = F.gw; t < T; t += F.NGW) {
        const float frow = (float)(t >> 6), fcol = (float)(t & 63);
#pragma unroll
        for (int j = 0; j < 8; ++j) { const int c0 = 4 * lane + 256 * j; f32x4 o;
#pragma unroll
            for (int e = 0; e < 4; ++e) { const int c = c0 + e, qi = c >> 9, i = c & 511;
                const float omega = fexp(-(float)i * (9.21034037197618f / 512.0f));
                float rev = ((qi < 2) ? frow : fcol) * omega * 0.15915494309189535f;
                rev -= floorf(rev);
                o[e] = (qi & 1) ? __builtin_amdgcn_cosf(rev) : __builtin_amdgcn_sinf(rev); }
            *(f32x4*)(POS + (size_t)t * D + c0) = o; }
    }
}
constexpr int TN_F13 = (FFN_FP8 || FFN_I8) ? 1408 : 2816, TN_F2 = (FFN_D8 || FFN_DN_I8) ? 1408 : 2816, TN_M = MOE_FP8 ? 1792 : 3584;
constexpr int TN_RKV = RKV_I8 ? 512 : 1024, TI_RKV3 = 3 * TN_RKV;
constexpr int TI_RWKV = TI_RKV3 + (WO_I8 ? 512 : 1024), TI_F1 = TI_RWKV + TN_F13, TI_F3 = TI_F1 + TN_F13, TI_POOL = TI_F3 + (POOL_I8 ? 128 : 256), TI_M1 = TI_POOL + 8 * TN_M, TI_M3 = TI_M1 + 8 * TN_M, TI_MW2 = TI_M3 + 8 * TN_M, TI_M2 = TI_MW2 + TN_F2;
struct TrItem { const float* src; unsigned char* dst; int src_ld, dst_ld  , k0  , kbyte  , n0, drow0, f8  ; float sc; const unsigned* cm  ; };
__device__ __forceinline__ TrItem tr_decode(const Frame& F, const Args& a, int it) {
    TrItem t; t.f8 = 0; t.sc = 1.0f; t.cm = nullptr; int kb, nb;
    if (it < TI_RWKV) { const int m = it < TI_RKV3 ? it / TN_RKV : 3, r = it - (m < 3 ? m * TN_RKV : TI_RKV3); kb = r >> 5; nb = r & 31; const bool i8 = RKV_I8 && (m < 3 || WO_I8);
        t.src = a.in[I_WR + m]; t.src_ld = D; t.dst = F.ws + W_WR + (size_t)m * 8 * MiB; t.dst_ld = i8 ? D : 2 * D; t.drow0 = 64 * nb; if (i8) { t.f8 = 2; t.cm = F.ctl + CW_CMAX2 + m * D; } }
    else if (it < TI_F3) { const int w3 = it >= TI_F1, r = it - (w3 ? TI_F1 : TI_RWKV); kb = r / 88; nb = r % 88; const int n0 = 64 * nb;
        t.src = a.in[w3 ? I_FW3 : I_FW1]; t.src_ld = DFF; t.dst = F.ws + W_F13; t.dst_ld = (FFN_FP8 || FFN_I8) ? D : 2 * D; t.drow0 = (n0 >> 7) * 256 + (n0 & 127) + 128 * w3; t.f8 = FFN_I8 ? 2 : FFN_FP8; t.sc = FFN_FP8 ? 64.0f : 1.0f; if (FFN_I8) t.cm = F.ctl + CW_CMAX + w3 * DFF; }
    else if (it < TI_POOL) { const int r = it - TI_F3, g = POOL_I8 ? r >> 5 : r >> 6; kb = POOL_I8 ? (r >> 3) & 3 : (r >> 3) & 7; nb = r & 7;
        t.src = a.in[I_POOLW] + (size_t)g * 512 * 512; t.src_ld = 512; t.dst = F.ws + W_PW + (size_t)g * 512 * 512 * (POOL_I8 ? 1 : 2); t.dst_ld = POOL_I8 ? 512 : 2 * 512; t.drow0 = 64 * nb;
        if (POOL_I8) { t.f8 = 2; t.cm = F.ctl + CW_CMAX4 + g * 512; } }
    else if (it < TI_M3) { const int w3 = it >= TI_M1, r = it - (w3 ? TI_M1 : TI_POOL), e = r / TN_M, rr = r % TN_M; kb = rr / 112; nb = rr % 112; const int n0 = 64 * nb;
        t.src = a.in[w3 ? I_MW3 : I_MW1] + (size_t)e * D * DFE; t.src_ld = DFE; t.dst_ld = MOE_FP8 ? D : 2 * D; t.dst = F.ws + W_M13 + (size_t)e * 2 * DFE * t.dst_ld;
        t.drow0 = (n0 >> 7) * 256 + (n0 & 127) + 128 * w3; t.f8 = MOE_FP8; t.sc = MOE_FP8 ? 64.0f : 1.0f; }
    else if (it >= TI_MW2) { const int r = it - TI_MW2; kb = r >> 5; nb = r & 31;
        t.src = a.in[I_FW2]; t.src_ld = D; t.dst = F.ws + W_F2P; t.dst_ld = (FFN_D8 || FFN_DN_I8) ? LDF2 : 2 * LDF2; t.drow0 = 64 * nb; t.f8 = FFN_DN_I8 ? 2 : FFN_D8; t.sc = FFN_D8 ? 256.0f : 1.0f; if (FFN_DN_I8) t.cm = F.ctl + CW_CMAX3; }
    else { const int r = it - TI_M3, e = r / TN_M, rr = r % TN_M; kb = rr >> 5; nb = rr & 31;
        t.src = a.in[I_MW2] + (size_t)e * DFE * D; t.src_ld = D; t.dst_ld = MOE_FP8 ? LDM2 : 2 * LDM2; t.dst = F.ws + W_M2 + (size_t)e * D * t.dst_ld; t.drow0 = 64 * nb; t.f8 = MOE_FP8; t.sc = MOE_FP8 ? 256.0f : 1.0f; }
    t.n0 = 64 * nb; t.kbyte = 128 * kb; t.k0 = t.f8 ? 128 * kb : 64 * kb; return t;
}
__device__ __forceinline__ void tr_load(const TrItem& t, int h, f32x4 (&r)[4][4], int lane) {
    const int x = lane & 15, q = lane >> 4; const float* p = t.src + (size_t)(t.k0 + 64 * h + 4 * q) * t.src_ld + t.n0 + 4 * x;
#pragma unroll
    for (int i = 0; i < 4; ++i)
#pragma unroll
        for (int s = 0; s < 4; ++s) r[i][s] = __builtin_nontemporal_load((const f32x4*)(p + (size_t)(16 * i + s) * t.src_ld));
}
template <bool I8OK = false>
__device__ __forceinline__ void tr_store(const TrItem& t, int h, const f32x4 (&r)[4][4], LAS unsigned* scr, int lane) {
    const int x = lane & 15, q = lane >> 4;
    if (I8OK && t.f8 == 2) {
        const f32x4 cmx = __builtin_bit_cast(f32x4, *(const u32x4*)(t.cm + t.n0 + 4 * x)); f32x4 inv;
#pragma unroll
        for (int jj = 0; jj < 4; ++jj) inv[jj] = 127.0f * __builtin_amdgcn_rcpf(fmaxf(cmx[jj], 1e-30f));
#pragma unroll
        for (int i = 0; i < 4; ++i)
#pragma unroll
            for (int jj = 0; jj < 4; ++jj) scr[(4 * x + jj) * 33 + 16 * h + 4 * i + q] = pk4_i8(r[i][0][jj] * inv[jj], r[i][1][jj] * inv[jj], r[i][2][jj] * inv[jj], r[i][3][jj] * inv[jj]);
        if (h == 0) return;
    } else if (t.f8) {
#pragma unroll
        for (int i = 0; i < 4; ++i)
#pragma unroll
            for (int jj = 0; jj < 4; ++jj) scr[(4 * x + jj) * 33 + 16 * h + 4 * i + q] = pk4_fp8_nc(r[i][0][jj] * t.sc, r[i][1][jj] * t.sc, r[i][2][jj] * t.sc, r[i][3][jj] * t.sc);
        if (h == 0) return;
    } else {
#pragma unroll
        for (int i = 0; i < 4; ++i)
#pragma unroll
            for (int jj = 0; jj < 4; ++jj) { scr[(4 * x + jj) * 33 + 8 * i + 2 * q] = pk2(r[i][0][jj], r[i][1][jj]); scr[(4 * x + jj) * 33 + 8 * i + 2 * q + 1] = pk2(r[i][2][jj], r[i][3][jj]); }
    }
    LDS_WAIT();
    const int c = lane & 7;
#pragma unroll
    for (int rr = 0; rr < 8; ++rr) { const int n = (lane >> 3) + 8 * rr; const LAS unsigned* s = scr + n * 33 + 4 * c;
        u32x4 o; o.x = s[0]; o.y = s[1]; o.z = s[2]; o.w = s[3];
        *(u32x4*)(t.dst + (size_t)(t.drow0 + n) * t.dst_ld + t.kbyte + 16 * c) = o; }
    LDS_WAIT();
}
template <bool I8OK = false>
__device__ __forceinline__ void p0_transpose_range(const Frame& F, const Args& a, int lo, int hi, int gw, int ngw, LAS unsigned* scr) {
    const int lane = lane_id();
    int it = lo + gw; if (it >= hi) return;
    f32x4 ra[4][4], rb[4][4];
    TrItem ta = tr_decode(F, a, it), tb = ta; int ha = 0, hb = 0; tr_load(ta, 0, ra, lane);
    for (;;) {
        bool hasb; if (ta.f8 && ha == 0) { tb = ta; hb = 1; hasb = true; } else { it += ngw; hasb = it < hi; if (hasb) { tb = tr_decode(F, a, it); hb = 0; } }
        if (hasb) tr_load(tb, hb, rb, lane);
        tr_store<I8OK>(ta, ha, ra, scr, lane);
        if (!hasb) break;
        bool hasa; if (tb.f8 && hb == 0) { ta = tb; ha = 1; hasa = true; } else { it += ngw; hasa = it < hi; if (hasa) { ta = tr_decode(F, a, it); ha = 0; } }
        if (hasa) tr_load(ta, ha, ra, lane);
        tr_store<I8OK>(tb, hb, rb, scr, lane);
        if (!hasa) break;
    }
}
#if defined(PROBE_READ)
__device__ __forceinline__ void probe_read(const Frame& F, const Args& a) {
    const int lane = lane_id(); float acc = 0.f;
    for (int m = 0; m < 3; ++m) { const float* base = a.in[I_MW1 + m]; const size_t n16 = (size_t)NE * D * DFE / 4;
        if (PROBE_READ == 1) { for (size_t i = (size_t)F.gw * 64 + lane; i < n16; i += (size_t)F.NGW * 64 * 16) {
                f32x4 r[16];
#pragma unroll
                for (int u = 0; u < 16; ++u) { const size_t j = i + (size_t)u * F.NGW * 64; r[u] = j < n16 ? __builtin_nontemporal_load((const f32x4*)base + j) : (f32x4){0.f, 0.f, 0.f, 0.f}; }
#pragma unroll
                for (int u = 0; u < 16; ++u) acc += r[u][0] + r[u][3]; } }
        else { const int ld = (m == 2) ? D : DFE; const int nblk = ld / 64; const size_t rows = (size_t)NE * D * DFE / ld; const size_t items = rows / 64 * nblk; const int x = lane & 15, q = lane >> 4;
            for (size_t it = F.gw; it < items; it += F.NGW) { const size_t kb = it / nblk, nb = it % nblk; const float* p = base + (kb * 64 + 4 * q) * ld + nb * 64 + 4 * x;
                f32x4 r[16];
#pragma unroll
                for (int u = 0; u < 16; ++u) r[u] = __builtin_nontemporal_load((const f32x4*)(p + (size_t)((u >> 2) * 16 + (u & 3)) * ld));
#pragma unroll
                for (int u = 0; u < 16; ++u) acc += r[u][0] + r[u][3]; } }
    }
    if (acc == 1.2345e-30f) ((float*)(F.ws + WS_PART))[F.gw * 64 + lane] = acc;
}
#endif
__device__ __forceinline__ void p0_cmax(const Frame& F, const Args& a) {
    const int lane = lane_id();
    constexpr int NU_F = 2 * 22 * 32, NU_R = NU_F + (RKV_I8 ? (WO_I8 ? 4 : 3) * 8 * 32 : 0), NU_D = NU_R + (FFN_DN_I8 ? 8 * 88 : 0), NU = NU_D + (POOL_I8 ? 64 : 0);
    for (int u = F.gw; u < NU; u += F.NGW) {
        const float* src; unsigned* dst; int ld, cb, kc;
        if (u < NU_F) { const int mat = u / 704, r = u % 704; cb = r % 22; kc = r / 22; src = a.in[mat ? I_FW3 : I_FW1]; ld = DFF; dst = F.ctl + CW_CMAX + mat * DFF; }
        else if (u < NU_R) { const int v = u - NU_F, mat = v >> 8, r = v & 255; cb = r & 7; kc = r >> 3; src = a.in[I_WR + mat]; ld = D; dst = F.ctl + CW_CMAX2 + mat * D; }
        else if (u < NU_D) { const int r = u - NU_R; cb = r & 7; kc = r >> 3; src = a.in[I_FW2]; ld = D; dst = F.ctl + CW_CMAX3; }
        else { const int r = u - NU_D, g = r >> 4; cb = r & 1; kc = (r >> 1) & 7; src = a.in[I_POOLW] + (size_t)g * 512 * 512; ld = 512; dst = F.ctl + CW_CMAX4 + g * 512; }
        const float* p = src + (size_t)(kc * 64) * ld + cb * 256 + 4 * lane;
        u32x4 mx = (u32x4){0u, 0u, 0u, 0u};
#pragma unroll
        for (int b = 0; b < 4; ++b) { u32x4 v[16];
#pragma unroll
            for (int i = 0; i < 16; ++i) v[i] = *(const u32x4*)(p + (size_t)(b * 16 + i) * ld);
#pragma unroll
            for (int i = 0; i < 16; ++i) { const u32x4 w = v[i] & 0x7fffffffu; mx.x = w.x > mx.x ? w.x : mx.x; mx.y = w.y > mx.y ? w.y : mx.y; mx.z = w.z > mx.z ? w.z : mx.z; mx.w = w.w > mx.w ? w.w : mx.w; } }
        unsigned* c = dst + cb * 256 + 4 * lane;
        __hip_atomic_fetch_max(c + 0, mx.x, __ATOMIC_RELAXED, __HIP_MEMORY_SCOPE_AGENT); __hip_atomic_fetch_max(c + 1, mx.y, __ATOMIC_RELAXED, __HIP_MEMORY_SCOPE_AGENT);
        __hip_atomic_fetch_max(c + 2, mx.z, __ATOMIC_RELAXED, __HIP_MEMORY_SCOPE_AGENT); __hip_atomic_fetch_max(c + 3, mx.w, __ATOMIC_RELAXED, __HIP_MEMORY_SCOPE_AGENT);
    }
}
__device__ __forceinline__ void p0_small(const Frame& F, const Args& a) {
    const int lane = lane_id(), tid = F.wave * 64 + lane; (void)tid;
    bf16_t* WLD = (bf16_t*)(F.ws + W_WLD); bf16_t* ALD = (bf16_t*)(F.ws + W_ALD); bf16_t* G1T = (bf16_t*)(F.ws + W_G1);
    bf16_t* WLU = (bf16_t*)(F.ws + W_WLU); bf16_t* ALU = (bf16_t*)(F.ws + W_ALU); bf16_t* G2T = (bf16_t*)(F.ws + W_G2);
    const int gt = F.gw * 64 + lane, NT_ = F.NGW * 64;
    if (LORA_I8) {
        for (int task = (F.G == 256) ? (F.wave < 3 ? F.wave * 256 + F.vcu : 768) : F.gw; task < 768; task += (F.G == 256) ? 768 : F.NGW) { const int mat = task >> 8, n = task & 255; f32x4 v[8]; float mx = 0.f;
#pragma unroll
            for (int j = 0; j < 8; ++j)
#pragma unroll
                for (int e = 0; e < 4; ++e) { const int k = 4 * lane + 256 * j + e; float w = 0.f;
                    if (mat < 2) { if (n < 192) { const int d = n >= 96, nn = n - 96 * d; w = a.in[mat == 0 ? I_DW1 : I_IA1][((size_t)d * D + k) * 96 + nn]; } }
                    else w = a.in[I_G1][(size_t)k * 256 + n];
                    v[j][e] = w; mx = fmaxf(mx, fabsf(w)); }
            mx = wave_max(mx);
            mx = fmaxf(mx, 1e-30f); const float inv = 127.0f / mx;
            unsigned char* row = F.ws + (mat == 0 ? W_WLD : mat == 1 ? W_ALD : W_G1) + (size_t)n * D;
#pragma unroll
            for (int j = 0; j < 8; ++j) *(unsigned*)(row + 4 * lane + 256 * j) = pk4_i8(v[j][0] * inv, v[j][1] * inv, v[j][2] * inv, v[j][3] * inv);
            if (lane == 0) ((float*)(F.ws + WS_CML))[task] = mx; }
    } else
    for (int i = gt; i < 256 * D; i += NT_) { const int n = i >> 11, k = i & 2047;
        float w = 0.f, v = 0.f;
        if (n < 192) { const int d = n >= 96, nn = n - 96 * d; w = a.in[I_DW1][((size_t)d * D + k) * 96 + nn]; v = a.in[I_IA1][((size_t)d * D + k) * 96 + nn]; }
        WLD[i] = (bf16_t)f2bf(w); ALD[i] = (bf16_t)f2bf(v); G1T[i] = (bf16_t)f2bf(a.in[I_G1][(size_t)k * 256 + n]); }
    for (int i = gt; i < 2 * D * 256; i += NT_) { const int n = i >> 8, k = i & 255, d = n >> 11, cidx = n & 2047, kk = k - 96 * d;
        float w = 0.f, v = 0.f;
        if (kk >= 0 && kk < 96) { w = a.in[I_DW2][((size_t)d * 96 + kk) * D + cidx]; v = a.in[I_IA2][((size_t)d * 96 + kk) * D + cidx]; }
        WLU[i] = (bf16_t)f2bf(w); ALU[i] = (bf16_t)f2bf(v); }
    for (int i = gt; i < D * 256; i += NT_) { const int n = i >> 8, k = i & 255; G2T[i] = (bf16_t)f2bf(a.in[I_G2][(size_t)k * D + n]); }
}

__device__ __forceinline__ void p1_mix(const Frame& F, const Args& a) {
    const int lane = lane_id();
    const float* MOD = (const float*)(F.ws + WS_MOD); const float* POS = (const float*)(F.ws + WS_POS);
    float* XR = (float*)(F.ws + WS_XR);
    int par = 0; (void)par;
    for (int it = F.gw; it < (MT / 8) * 8; it += F.NGW) {
        const int blk = it >> 3, j = it & 7, m0 = blk * 8; const bool lat = m0 < ML;
        int t0, Tseq, modrow; const float* xs;
        if (lat) { t0 = m0 % T; Tseq = T; modrow = m0 / T; xs = a.in[I_X] + (size_t)m0 * D; }
        else { const int mm = m0 - ML; t0 = mm % TC; Tseq = TC; modrow = 4; xs = a.in[I_CTX] + (size_t)mm * D; }
        const float* sh = MOD + (size_t)modrow * MOD_N; const float* scp = sh + D;
        const float* ps = POS + (size_t)t0 * D;
        const int c = 4 * lane + 256 * j;
        f32x4 xr[10];
#pragma unroll
        for (int i = 0; i < 10; ++i) { const int tr = t0 - 1 + i; const bool ok = tr >= 0 && tr < Tseq; const int ro = ok ? i - 1 : 0;
            xr[i] = *(const f32x4*)(xs + (ptrdiff_t)ro * D + c); if (lat) xr[i] += *(const f32x4*)(ps + (ptrdiff_t)ro * D + c); }
        const f32x4 shv = *(const f32x4*)(sh + c); const f32x4 scv = *(const f32x4*)(scp + c) + 1.0f;
        f32x4 mu[6];
#pragma unroll
        for (int n = 0; n < 6; ++n) mu[n] = *(const f32x4*)(a.in[I_MU] + n * D + c);
        f32x4 h[10];
#pragma unroll
        for (int i = 0; i < 10; ++i) { const int tr = t0 - 1 + i; const bool ok = tr >= 0 && tr < Tseq; h[i] = ok ? xr[i] * scv + shv : (f32x4){0.f, 0.f, 0.f, 0.f}; }
        if (RKV_I8) {
            constexpr int NS = LORA_I8 ? 6 : 3;
            LAS float* PM = (LAS float*)F.lds + (par & 1) * 2048;
            LAS float* FIN = (LAS float*)F.lds + 4096 + F.wave * 64;
#ifndef P1_SHARED_SCALE
#define P1_SHARED_SCALE 0
#endif
            if (P1_SHARED_SCALE) {
#pragma unroll
            for (int r = 0; r < 8; ++r) { const f32x4 h0 = h[r + 1], xx = (h[r] + h[r + 2]) * 0.5f - h0; float mx = 0.f;
#pragma unroll
                for (int q = 0; q < NS; ++q) { const int n = LORA_I8 ? q : (q == 0 ? 0 : q + 1); if (!lat && (n == 0 || n == 5)) continue;
                    const f32x4 v = h0 + xx * mu[n]; mx = fmaxf(mx, fmaxf(fmaxf(fabsf(v[0]), fabsf(v[1])), fmaxf(fabsf(v[2]), fabsf(v[3])))); }
                mx = row_max16(mx);
                if ((lane & 15) == 0) PM[(F.wave * 4 + (lane >> 4)) * 64 + r] = mx; }
            __syncthreads();
            if (lane < 8) { float mx = PM[lane];
#pragma unroll
                for (int w = 1; w < 32; ++w) mx = fmaxf(mx, PM[w * 64 + lane]);
                mx = fmaxf(mx, 1e-30f); const float qf = 127.0f / mx;
#pragma unroll
                for (int q = 0; q < NS; ++q) { const int n = LORA_I8 ? q : (q == 0 ? 0 : q + 1); FIN[NS * lane + q] = qf;
                    if (j == 0 && (lat || (n != 0 && n != 5))) ((float*)(F.ws + WS_RS6))[(size_t)n * MT + m0 + lane] = mx * (1.0f / 127.0f); } }
            } else {
#pragma unroll
            for (int r = 0; r < 8; ++r) { const f32x4 h0 = h[r + 1], xx = (h[r] + h[r + 2]) * 0.5f - h0;
#pragma unroll
                for (int q = 0; q < NS; ++q) { const int n = LORA_I8 ? q : (q == 0 ? 0 : q + 1); const f32x4 v = h0 + xx * mu[n]; float mx = fmaxf(fmaxf(fabsf(v[0]), fabsf(v[1])), fmaxf(fabsf(v[2]), fabsf(v[3])));
                    mx = row_max16(mx);
                    if ((lane & 15) == 0) PM[(F.wave * 4 + (lane >> 4)) * 64 + NS * r + q] = mx; } }
            __syncthreads();
            if (lane < 8 * NS) { float mx = PM[lane];
#pragma unroll
                for (int w = 1; w < 32; ++w) mx = fmaxf(mx, PM[w * 64 + lane]);
                mx = fmaxf(mx, 1e-30f); FIN[lane] = 127.0f / mx;
                const int r = lane / NS, q = lane - NS * r, n = LORA_I8 ? q : (q == 0 ? 0 : q + 1);
                if (j == 0 && (lat || (n != 0 && n != 5))) ((float*)(F.ws + WS_RS6))[(size_t)n * MT + m0 + r] = mx * (1.0f / 127.0f); }
            }
            LDS_WAIT();
#pragma unroll
            for (int r = 0; r < 8; ++r) { const f32x4 h0 = h[r + 1], xx = (h[r] + h[r + 2]) * 0.5f - h0; const size_t o = (size_t)(m0 + r) * D + c;
#pragma unroll
                for (int q = 0; q < NS; ++q) { const int n = LORA_I8 ? q : (q == 0 ? 0 : q + 1); if (!lat && (n == 0 || n == 5)) continue;
                    const float inv = FIN[NS * r + q]; const f32x4 v = (h0 + xx * mu[n]) * inv;
                    *(unsigned*)(F.ws + A_A6 + (size_t)n * A6_STRIDE + o) = pk4_i8(v[0], v[1], v[2], v[3]); }
                if (!LORA_I8) {
#pragma unroll
                for (int n = 1; n < 6; ++n) { if (n == 2 || n == 3 || (!lat && n == 5)) continue;
                    const f32x4 v = h0 + xx * mu[n]; u32x2 w; w.x = pk2(v[0], v[1]); w.y = pk2(v[2], v[3]);
                    *(u32x2*)((bf16_t*)(F.ws + A_A6 + (size_t)n * A6_STRIDE) + o) = w; } } }
            ++par;
        } else {
#pragma unroll
        for (int r = 0; r < 8; ++r) {
            const f32x4 h0 = h[r + 1], xx = (h[r] + h[r + 2]) * 0.5f - h0;
            const size_t o = (size_t)(m0 + r) * D + c;
#pragma unroll
            for (int n = 0; n < 6; ++n) { if (!lat && (n == 0 || n == 5)) continue;
                const f32x4 v = h0 + xx * mu[n]; u32x2 w; w.x = pk2(v[0], v[1]); w.y = pk2(v[2], v[3]);
                *(u32x2*)((bf16_t*)(F.ws + A_A6 + (size_t)n * A6_STRIDE) + o) = w; }
        }
        }
    }
}

__device__ __forceinline__ void p4_scan(const Frame& F, const Args& a) {
    const int lane = lane_id(), tid = F.wave * 64 + lane; (void)tid;
    LAS float* OP = (LAS float*)F.lds;
    LAS float* YS = (LAS float*)(F.lds + 49152);
    const bf16_t* KX = (const bf16_t*)(F.ws + A_KX); const bf16_t* VV = (const bf16_t*)(F.ws + A_V); const bf16_t* RR = (const bf16_t*)(F.ws + A_R);
    const bf16_t* EW = (const bf16_t*)(F.ws + A_EW); const bf16_t* AA = (const bf16_t*)(F.ws + A_AA);
    const int tl = tid >> 5, cp = tid & 31, vi = tid >> 3, kg = tid & 7;
    for (int s = blockIdx.x; s < NB * NH * 2; s += F.G) {
        const int b = s >> 6, h = (s >> 1) & 31, d = s & 1;
        const int ch = h * HS + 2 * cp;
        const float kkc0 = a.in[I_KK][ch], kkc1 = a.in[I_KK][ch + 1], kac0 = a.in[I_KA][ch], kac1 = a.in[I_KA][ch + 1], rkc0 = a.in[I_RK][ch], rkc1 = a.in[I_RK][ch + 1];
        bf16_t* YD = (bf16_t*)(F.ws + A_YD + (size_t)d * 32 * MiB); float* SB = (float*)(F.ws + WS_SB) + (size_t)d * ML * NH;
        float S[8];
#pragma unroll
        for (int j = 0; j < 8; ++j) S[j] = 0.f;
        unsigned rk = 0, rv = 0, rr = 0, re = 0, ra = 0;
#define SCAN_ROW0(ci) (((ci) < 16) ? (ML + b * TC + (d ? 15 - (ci) : (ci)) * 16) : (b * T + (d ? 127 - ((ci) - 16) : ((ci) - 16)) * 16))
#define SCAN_LOAD(ci) do { const int row_ = SCAN_ROW0(ci) + tl; const size_t o_ = (size_t)row_ * D + ch, o2_ = (size_t)row_ * (2 * D) + d * D + ch; \
        rk = *(const unsigned*)(KX + o_); rv = *(const unsigned*)(VV + o_); rr = ((ci) >= 16) ? *(const unsigned*)(RR + o_) : 0u; re = *(const unsigned*)(EW + o2_); ra = *(const unsigned*)(AA + o2_); } while (0)
#define SCAN_PREP(ci) do { LAS float* B_ = OP + ((ci) & 1) * 6144 + tl * 64 + 2 * cp; \
        const float k0 = bflo(rk), k1 = bfhi(rk), q0 = k0 * kkc0, q1 = k1 * kkc1; float n2 = q0 * q0 + q1 * q1; \
        n2 += __shfl_xor(n2, 1); n2 += __shfl_xor(n2, 2); n2 += __shfl_xor(n2, 4); n2 += __shfl_xor(n2, 8); n2 += __shfl_xor(n2, 16); \
        const float inv = 1.0f / fmaxf(sqrtf(n2), 1e-12f), kn0 = q0 * inv, kn1 = q1 * inv; \
        const float a0 = bflo(ra), a1 = bfhi(ra), kd0 = k0 * (1.0f + (a0 - 1.0f) * kac0), kd1 = k1 * (1.0f + (a1 - 1.0f) * kac1); \
        const float r0 = bflo(rr), r1 = bfhi(rr); \
        *(LAS f32x2*)(B_ + 0 * 1024) = (f32x2){kn0, kn1}; \
        *(LAS f32x2*)(B_ + 1 * 1024) = (f32x2){fexp(-bflo(re)), fexp(-bfhi(re))}; \
        *(LAS f32x2*)(B_ + 2 * 1024) = (f32x2){kn0 * a0, kn1 * a1}; \
        *(LAS f32x2*)(B_ + 3 * 1024) = (f32x2){kd0, kd1}; \
        *(LAS f32x2*)(B_ + 4 * 1024) = (f32x2){r0, r1}; \
        *(LAS f32x2*)(B_ + 5 * 1024) = (f32x2){bflo(rv), bfhi(rv)}; \
        if ((ci) >= 16) { float sb = r0 * kd0 * rkc0 + r1 * kd1 * rkc1; \
            sb += __shfl_xor(sb, 1); sb += __shfl_xor(sb, 2); sb += __shfl_xor(sb, 4); sb += __shfl_xor(sb, 8); sb += __shfl_xor(sb, 16); \
            if (cp == 0) SB[(size_t)(SCAN_ROW0(ci) + tl) * NH + h] = sb; } } while (0)
        __syncthreads();
        SCAN_LOAD(0); SCAN_PREP(0);
        __syncthreads();
        for (int ci = 0; ci < 144; ++ci) {
            if (ci + 1 < 144) SCAN_LOAD(ci + 1);
            const LAS float* B = OP + (ci & 1) * 6144; LAS float* Y = YS + (ci & 1) * 1024;
#pragma unroll 4
            for (int st = 0; st < 16; ++st) {
                const int tk = d ? 15 - st : st; const LAS float* p = B + tk * 64 + 8 * kg;
                const f32x4 kkA = *(const LAS f32x4*)(p), kkB = *(const LAS f32x4*)(p + 4);
                const f32x4 wA = *(const LAS f32x4*)(p + 1024), wB = *(const LAS f32x4*)(p + 1028);
                const f32x4 bA = *(const LAS f32x4*)(p + 2048), bB = *(const LAS f32x4*)(p + 2052);
                const f32x4 dA = *(const LAS f32x4*)(p + 3072), dB = *(const LAS f32x4*)(p + 3076);
                const f32x4 rA = *(const LAS f32x4*)(p + 4096), rB = *(const LAS f32x4*)(p + 4100);
                const float v = B[5 * 1024 + tk * 64 + vi];
                float sa = (S[0] * kkA[0] + S[1] * kkA[1]) + (S[2] * kkA[2] + S[3] * kkA[3]) + (S[4] * kkB[0] + S[5] * kkB[1]) + (S[6] * kkB[2] + S[7] * kkB[3]);
                sa = sum8(sa);
#pragma unroll
                for (int j = 0; j < 4; ++j) { S[j] = S[j] * wA[j] + (v * dA[j] - sa * bA[j]); S[4 + j] = S[4 + j] * wB[j] + (v * dB[j] - sa * bB[j]); }
                float y = (S[0] * rA[0] + S[1] * rA[1]) + (S[2] * rA[2] + S[3] * rA[3]) + (S[4] * rB[0] + S[5] * rB[1]) + (S[6] * rB[2] + S[7] * rB[3]);
                y = sum8(y);
                if (kg == 0) Y[tk * 64 + vi] = y;
            }
            if (ci + 1 < 144) SCAN_PREP(ci + 1);
            __syncthreads();
            if (ci >= 16) { const f32x2 yv = *(const LAS f32x2*)(Y + tl * 64 + 2 * cp);
                *(unsigned*)(YD + (size_t)(SCAN_ROW0(ci) + tl) * D + ch) = pk2(yv.x, yv.y); }
        }
#undef SCAN_ROW0
#undef SCAN_LOAD
#undef SCAN_PREP
    }
    __syncthreads();
}

constexpr int SL_KA = 0, SL_RM = 2048, SL_BK = 4096, SL_VC = 8192, SL_ARK = 10240, SL_AAK = 11264, SL_TN = 11776, SL_GC = 12288, SL_BYTES = 12544;
constexpr int SC_PAR = 8 * SL_BYTES;
typedef short s16x8 __attribute__((ext_vector_type(8)));
__device__ __forceinline__ s16x8 mk8(unsigned a, unsigned b, unsigned c, unsigned d) { u32x4 v; v.x = a; v.y = b; v.z = c; v.w = d; return __builtin_bit_cast(s16x8, v); }
__device__ __forceinline__ f32x4 mfma16(s16x8 a, s16x8 b, f32x4 c) { return __builtin_amdgcn_mfma_f32_16x16x32_bf16(a, b, c, 0, 0, 0); }
__device__ __forceinline__ s16x8 mk_d(const f32x4 x) { return mk8(pk2(x[0], x[1]), pk2(x[2], x[3]), 0u, 0u); }
__device__ __forceinline__ void p4_scan2(const Frame& F, const Args& a, unsigned char* yd_base, float* sb_base) {
    const int lane = lane_id(), tt = lane & 15, q = lane >> 4;
    const bf16_t* KX = (const bf16_t*)(F.ws + A_KX); const bf16_t* VV = (const bf16_t*)(F.ws + A_V); const bf16_t* RR = (const bf16_t*)(F.ws + A_R);
    const bf16_t* EW = (const bf16_t*)(F.ws + A_EW); const bf16_t* AA = (const bf16_t*)(F.ws + A_AA);
    LAS unsigned char* slot_w = F.lds + F.wave * SL_BYTES;
    LAS float* PAR = (LAS float*)(F.lds + SC_PAR);
    s16x8 SelF[2];
#pragma unroll
    for (int sel = 0; sel < 2; ++sel) { unsigned w[4];
#pragma unroll
        for (int jj = 0; jj < 4; ++jj) { const int j0 = 2 * jj, j1 = 2 * jj + 1; const bool h0 = (q == (tt >> 2)) && (j0 == 4 * sel + (tt & 3)), h1 = (q == (tt >> 2)) && (j1 == 4 * sel + (tt & 3));
            w[jj] = (h0 ? 0x3f80u : 0u) | (h1 ? 0x3f800000u : 0u); }
        SelF[sel] = mk8(w[0], w[1], w[2], w[3]); }
    for (int s = blockIdx.x; s < NB * NH * 2; s += F.G) {
        const int b = s >> 6, h = (s >> 1) & 31, d = s & 1;
        bf16_t* YD = (bf16_t*)(yd_base + (size_t)d * 32 * MiB); float* SB = sb_base + (size_t)d * ML * NH;
        __syncthreads();
        if (F.wave == 0) { PAR[lane] = a.in[I_KK][h * HS + lane]; PAR[64 + lane] = a.in[I_KA][h * HS + lane]; PAR[128 + lane] = a.in[I_RK][h * HS + lane]; }
        __syncthreads();
        f32x4 G[4];
#pragma unroll
        for (int tk = 0; tk < 4; ++tk) G[tk] = (f32x4){0.f, 0.f, 0.f, 0.f};
#define S2_ROW0(ci) (((ci) < 16) ? (ML + b * TC + (d ? 15 - (ci) : (ci)) * 16) : (b * T + (d ? 127 - ((ci) - 16) : ((ci) - 16)) * 16))
        u32x2 rk[4], rv[4], rr[4], re[4], ra[4];
#define S2_LOAD(ci) do { const int row_ = S2_ROW0(ci) + (d ? 15 - tt : tt); const size_t o_ = (size_t)row_ * D + h * HS + 4 * q, o2_ = (size_t)row_ * (2 * D) + d * D + h * HS + 4 * q; \
        _Pragma("unroll") for (int g_ = 0; g_ < 4; ++g_) { rk[g_] = *(const u32x2*)(KX + o_ + 16 * g_); rv[g_] = *(const u32x2*)(VV + o_ + 16 * g_); \
            rr[g_] = ((ci) >= 16) ? *(const u32x2*)(RR + o_ + 16 * g_) : (u32x2){0u, 0u}; re[g_] = *(const u32x2*)(EW + o2_ + 16 * g_); ra[g_] = *(const u32x2*)(AA + o2_ + 16 * g_); } } while (0)
        S2_LOAD(F.wave);
        for (int rnd = 0; rnd < 18; ++rnd) {
            const int ci = rnd * 8 + F.wave; const bool lat = rnd >= 2;
            {
                float kf[4][4], af[4][4], ef[4][4], vf[4][4], rf[4][4];
#pragma unroll
                for (int g = 0; g < 4; ++g) {
                    kf[g][0] = bflo(rk[g].x); kf[g][1] = bfhi(rk[g].x); kf[g][2] = bflo(rk[g].y); kf[g][3] = bfhi(rk[g].y);
                    af[g][0] = bflo(ra[g].x); af[g][1] = bfhi(ra[g].x); af[g][2] = bflo(ra[g].y); af[g][3] = bfhi(ra[g].y);
                    ef[g][0] = bflo(re[g].x); ef[g][1] = bfhi(re[g].x); ef[g][2] = bflo(re[g].y); ef[g][3] = bfhi(re[g].y);
                    vf[g][0] = bflo(rv[g].x); vf[g][1] = bfhi(rv[g].x); vf[g][2] = bflo(rv[g].y); vf[g][3] = bfhi(rv[g].y);
                    rf[g][0] = bflo(rr[g].x); rf[g][1] = bfhi(rr[g].x); rf[g][2] = bflo(rr[g].y); rf[g][3] = bfhi(rr[g].y); }
                unsigned VP[4][2];
#pragma unroll
                for (int g = 0; g < 4; ++g) { VP[g][0] = rv[g].x; VP[g][1] = rv[g].y; }
                if (rnd + 1 < 18) S2_LOAD((rnd + 1) * 8 + F.wave);
                float kkv[4][4]; float n2 = 0.f;
#pragma unroll
                for (int g = 0; g < 4; ++g) { const f32x4 kc = *(const LAS f32x4*)(PAR + 16 * g + 4 * q);
#pragma unroll
                    for (int i = 0; i < 4; ++i) { kkv[g][i] = kf[g][i] * kc[i]; n2 += kkv[g][i] * kkv[g][i]; } }
                n2 += __shfl_xor(n2, 16); n2 += __shfl_xor(n2, 32);
                const float inv = 1.0f / fmaxf(sqrtf(n2), 1e-12f);
                float sb = 0.f;
                unsigned KaP[4][2], BmP[4][2], KmP[4][2], RmP[4][2]; f32x4 gend[4];
#pragma unroll
                for (int g = 0; g < 4; ++g) { const f32x4 kac = *(const LAS f32x4*)(PAR + 64 + 16 * g + 4 * q), rkc = *(const LAS f32x4*)(PAR + 128 + 16 * g + 4 * q);
                    float ka_[4], bm_[4], km_[4], rm_[4];
#pragma unroll
                    for (int i = 0; i < 4; ++i) {
                        float L = ef[g][i];
                        L += dpp_f<0x111>(L); L += dpp_f<0x112>(L); L += dpp_f<0x114>(L); L += dpp_f<0x118>(L);
                        const float gt = fexp(-L), gi = fexp(L); float gm1 = dpp_f<0x111>(gt); gm1 = (tt == 0) ? 1.0f : gm1;
                        const float kk = kkv[g][i] * inv, kd = kf[g][i] * (1.0f + (af[g][i] - 1.0f) * kac[i]);
                        ka_[i] = kk * gm1; bm_[i] = kk * af[g][i] * gi; km_[i] = kd * gi; rm_[i] = rf[g][i] * gt;
                        sb += rf[g][i] * kd * rkc[i]; gend[g][i] = gt; }
                    KaP[g][0] = pk2(ka_[0], ka_[1]); KaP[g][1] = pk2(ka_[2], ka_[3]); BmP[g][0] = pk2(bm_[0], bm_[1]); BmP[g][1] = pk2(bm_[2], bm_[3]);
                    KmP[g][0] = pk2(km_[0], km_[1]); KmP[g][1] = pk2(km_[2], km_[3]); RmP[g][0] = pk2(rm_[0], rm_[1]); RmP[g][1] = pk2(rm_[2], rm_[3]);
                }
                if (lat) { sb += __shfl_xor(sb, 16); sb += __shfl_xor(sb, 32); if (q == 0) SB[(size_t)(S2_ROW0(ci) + (d ? 15 - tt : tt)) * NH + h] = sb; }
                s16x8 KaF[2], BmF[2], KmF[2], RmF[2], VF[2];
#pragma unroll
                for (int kb = 0; kb < 2; ++kb) { KaF[kb] = mk8(KaP[2 * kb][0], KaP[2 * kb][1], KaP[2 * kb + 1][0], KaP[2 * kb + 1][1]); BmF[kb] = mk8(BmP[2 * kb][0], BmP[2 * kb][1], BmP[2 * kb + 1][0], BmP[2 * kb + 1][1]);
                    KmF[kb] = mk8(KmP[2 * kb][0], KmP[2 * kb][1], KmP[2 * kb + 1][0], KmP[2 * kb + 1][1]); RmF[kb] = mk8(RmP[2 * kb][0], RmP[2 * kb][1], RmP[2 * kb + 1][0], RmP[2 * kb + 1][1]);
                    VF[kb] = mk8(VP[2 * kb][0], VP[2 * kb][1], VP[2 * kb + 1][0], VP[2 * kb + 1][1]); }
                const f32x4 Z = (f32x4){0.f, 0.f, 0.f, 0.f};
                f32x4 Nd = mfma16(KaF[1], BmF[1], mfma16(KaF[0], BmF[0], Z));
                f32x4 Nt = mfma16(BmF[1], KaF[1], mfma16(BmF[0], KaF[0], Z));
                f32x4 AakT = mfma16(KmF[1], KaF[1], mfma16(KmF[0], KaF[0], Z));
                f32x4 ArbT = mfma16(BmF[1], RmF[1], mfma16(BmF[0], RmF[0], Z));
                f32x4 ArkT = mfma16(KmF[1], RmF[1], mfma16(KmF[0], RmF[0], Z));
                f32x4 Q0;
#pragma unroll
                for (int r = 0; r < 4; ++r) { const int row = 4 * q + r;
                    Nd[r] = row > tt ? Nd[r] : 0.f; Nt[r] = row < tt ? Nt[r] : 0.f; AakT[r] = row < tt ? AakT[r] : 0.f; ArbT[r] = row <= tt ? ArbT[r] : 0.f; ArkT[r] = row <= tt ? ArkT[r] : 0.f;
                    Q0[r] = (row == tt ? 1.0f : 0.f) - Nt[r]; }
                const s16x8 oN = mk_d(Nd), oNt = mk_d(Nt);
                const f32x4 N2 = mfma16(oNt, oN, Z), N2t = mfma16(oN, oNt, Z);
                const s16x8 oN2 = mk_d(N2), oN2t = mk_d(N2t);
                const f32x4 N4 = mfma16(oN2t, oN2, Z), N4t = mfma16(oN2, oN2t, Z);
                const s16x8 oN4 = mk_d(N4), oN4t = mk_d(N4t);
                const f32x4 N8 = mfma16(oN4t, oN4, Z);
                const f32x4 Q1 = mfma16(oN2, mk_d(Q0), Q0);
                const f32x4 Q2 = mfma16(oN4, mk_d(Q1), Q1);
                const f32x4 Q3 = mfma16(mk_d(N8), mk_d(Q2), Q2);
                *(LAS u32x4*)(slot_w + SL_KA + lane * 16) = __builtin_bit_cast(u32x4, KaF[0]); *(LAS u32x4*)(slot_w + SL_KA + 1024 + lane * 16) = __builtin_bit_cast(u32x4, KaF[1]);
                *(LAS u32x4*)(slot_w + SL_RM + lane * 16) = __builtin_bit_cast(u32x4, RmF[0]); *(LAS u32x4*)(slot_w + SL_RM + 1024 + lane * 16) = __builtin_bit_cast(u32x4, RmF[1]);
                *(LAS u32x2*)(slot_w + SL_TN + lane * 8) = (u32x2){pk2(-Q3[0], -Q3[1]), pk2(-Q3[2], -Q3[3])};
                *(LAS u32x2*)(slot_w + SL_AAK + lane * 8) = (u32x2){pk2(AakT[0], AakT[1]), pk2(AakT[2], AakT[3])};
                *(LAS u32x4*)(slot_w + SL_ARK + lane * 16) = (u32x4){pk2(ArbT[0], ArbT[1]), pk2(ArbT[2], ArbT[3]), pk2(ArkT[0], ArkT[1]), pk2(ArkT[2], ArkT[3])};
#pragma unroll
                for (int kb = 0; kb < 2; ++kb)
#pragma unroll
                    for (int sel = 0; sel < 2; ++sel) { const int tk = 2 * kb + sel;
                        const f32x4 DB = mfma16(BmF[kb], SelF[sel], Z), DK = mfma16(KmF[kb], SelF[sel], Z), DV = mfma16(VF[kb], SelF[sel], Z);
                        *(LAS u32x4*)(slot_w + SL_BK + tk * 1024 + lane * 16) = (u32x4){pk2(DB[0], DB[1]), pk2(DB[2], DB[3]), pk2(DK[0], DK[1]), pk2(DK[2], DK[3])};
                        *(LAS u32x2*)(slot_w + SL_VC + tk * 512 + lane * 8) = (u32x2){pk2(DV[0], DV[1]), pk2(DV[2], DV[3])}; }
                if (tt == 15) {
#pragma unroll
                    for (int g = 0; g < 4; ++g) *(LAS f32x4*)(slot_w + SL_GC + (g * 4 + q) * 16) = gend[g]; }
            }
            __syncthreads();
            if (F.wave < 4) {
                const int tv = F.wave;
                for (int sl = 0; sl < 8; ++sl) {
                    LAS unsigned char* S = F.lds + sl * SL_BYTES; const int cj = rnd * 8 + sl;
                    const s16x8 KA0 = __builtin_bit_cast(s16x8, *(LAS u32x4*)(S + SL_KA + lane * 16)), KA1 = __builtin_bit_cast(s16x8, *(LAS u32x4*)(S + SL_KA + 1024 + lane * 16));
                    const u32x2 aak = *(LAS u32x2*)(S + SL_AAK + lane * 8), tn = *(LAS u32x2*)(S + SL_TN + lane * 8), vc = *(LAS u32x2*)(S + SL_VC + tv * 512 + lane * 8);
                    const s16x8 Gb0 = mk8(pk2(G[0][0], G[0][1]), pk2(G[0][2], G[0][3]), pk2(G[1][0], G[1][1]), pk2(G[1][2], G[1][3]));
                    const s16x8 Gb1 = mk8(pk2(G[2][0], G[2][1]), pk2(G[2][2], G[2][3]), pk2(G[3][0], G[3][1]), pk2(G[3][2], G[3][3]));
                    const f32x4 Z = (f32x4){0.f, 0.f, 0.f, 0.f};
                    f32x4 P = mfma16(KA0, Gb0, Z); P = mfma16(KA1, Gb1, P); P = mfma16(mk8(aak.x, aak.y, 0u, 0u), mk8(vc.x, vc.y, 0u, 0u), P);
                    const f32x4 U = mfma16(mk8(tn.x, tn.y, 0u, 0u), mk_d(P), Z);
                    const s16x8 UV = mk8(pk2(U[0], U[1]), pk2(U[2], U[3]), vc.x, vc.y);
                    if (lat) {
                        const s16x8 RM0 = __builtin_bit_cast(s16x8, *(LAS u32x4*)(S + SL_RM + lane * 16)), RM1 = __builtin_bit_cast(s16x8, *(LAS u32x4*)(S + SL_RM + 1024 + lane * 16));
                        const s16x8 ARK = __builtin_bit_cast(s16x8, *(LAS u32x4*)(S + SL_ARK + lane * 16));
                        f32x4 Y = mfma16(Gb0, RM0, Z); Y = mfma16(Gb1, RM1, Y); Y = mfma16(UV, ARK, Y);
                        *(u32x2*)(YD + (size_t)(S2_ROW0(cj) + (d ? 15 - tt : tt)) * D + h * HS + 16 * tv + 4 * q) = (u32x2){pk2(Y[0], Y[1]), pk2(Y[2], Y[3])};
                    }
#pragma unroll
                    for (int tk = 0; tk < 4; ++tk) { const s16x8 BK = __builtin_bit_cast(s16x8, *(LAS u32x4*)(S + SL_BK + tk * 1024 + lane * 16));
                        G[tk] = mfma16(BK, UV, G[tk]); G[tk] = G[tk] * *(LAS f32x4*)(S + SL_GC + (tk * 4 + q) * 16); }
                }
            }
            __syncthreads();
        }
#undef S2_ROW0
#undef S2_LOAD
    }
    __syncthreads();
}

__device__ __forceinline__ void p4_scan3(const Frame& F, const Args& a, unsigned char* yd_base, float* sb_base, int clo, int chi) {
    const int lane = lane_id(), tt = lane & 15, q = lane >> 4;
    const bf16_t* KX = (const bf16_t*)(F.ws + A_KX); const bf16_t* VV = (const bf16_t*)(F.ws + A_V); const bf16_t* RR = (const bf16_t*)(F.ws + A_R);
    const bf16_t* EW = (const bf16_t*)(F.ws + A_EW); const bf16_t* AA = (const bf16_t*)(F.ws + A_AA);
    LAS float* PAR = (LAS float*)(F.lds + SC_PAR);
    LAS unsigned* CNT = (LAS unsigned*)(F.lds + SC_PAR + 1024);
    s16x8 SelF[2];
#pragma unroll
    for (int sel = 0; sel < 2; ++sel) { unsigned w[4];
#pragma unroll
        for (int jj = 0; jj < 4; ++jj) { const int j0 = 2 * jj, j1 = 2 * jj + 1; const bool h0 = (q == (tt >> 2)) && (j0 == 4 * sel + (tt & 3)), h1 = (q == (tt >> 2)) && (j1 == 4 * sel + (tt & 3));
            w[jj] = (h0 ? 0x3f80u : 0u) | (h1 ? 0x3f800000u : 0u); }
        SelF[sel] = mk8(w[0], w[1], w[2], w[3]); }
    { const int s = blockIdx.x;
        const int b = s >> 6, h = (s >> 1) & 31, d = s & 1;
        bf16_t* YD = (bf16_t*)(yd_base + (size_t)d * 32 * MiB); float* SB = sb_base + (size_t)d * ML * NH;
        __syncthreads();
        if (F.wave == 0) { PAR[lane] = a.in[I_KK][h * HS + lane]; PAR[64 + lane] = a.in[I_KA][h * HS + lane]; PAR[128 + lane] = a.in[I_RK][h * HS + lane]; if (lane == 0) CNT[0] = 0u; }
        __syncthreads();
        if (F.wave >= 4) { p0_transpose_range(F, a, clo, chi, (int)blockIdx.x * 4 + (F.wave - 4), 4 * 256, (LAS unsigned*)(F.lds + 102400 + (F.wave - 4) * 8448)); }
        else {
        f32x4 G[4];
#pragma unroll
        for (int tk = 0; tk < 4; ++tk) G[tk] = (f32x4){0.f, 0.f, 0.f, 0.f};
#define S2_ROW0(ci) (((ci) < 16) ? (ML + b * TC + (d ? 15 - (ci) : (ci)) * 16) : (b * T + (d ? 127 - ((ci) - 16) : ((ci) - 16)) * 16))
        u32x2 rk[4], rv[4], rr[4], re[4], ra[4];
#define S2_LOAD(ci) do { const int row_ = S2_ROW0(ci) + (d ? 15 - tt : tt); const size_t o_ = (size_t)row_ * D + h * HS + 4 * q, o2_ = (size_t)row_ * (2 * D) + d * D + h * HS + 4 * q; \
        _Pragma("unroll") for (int g_ = 0; g_ < 4; ++g_) { rk[g_] = *(const u32x2*)(KX + o_ + 16 * g_); rv[g_] = *(const u32x2*)(VV + o_ + 16 * g_); \
            rr[g_] = ((ci) >= 16) ? *(const u32x2*)(RR + o_ + 16 * g_) : (u32x2){0u, 0u}; re[g_] = *(const u32x2*)(EW + o2_ + 16 * g_); ra[g_] = *(const u32x2*)(AA + o2_ + 16 * g_); } } while (0)
        S2_LOAD(F.wave);
        for (int rnd = 0; rnd < 36; ++rnd) {
            const int ci = rnd * 4 + F.wave; const bool lat = rnd >= 4;
            LAS unsigned char* slot_w = F.lds + ((rnd & 1) * 4 + F.wave) * SL_BYTES;
            {
                float kf[4][4], af[4][4], ef[4][4], vf[4][4], rf[4][4];
#pragma unroll
                for (int g = 0; g < 4; ++g) {
                    kf[g][0] = bflo(rk[g].x); kf[g][1] = bfhi(rk[g].x); kf[g][2] = bflo(rk[g].y); kf[g][3] = bfhi(rk[g].y);
                    af[g][0] = bflo(ra[g].x); af[g][1] = bfhi(ra[g].x); af[g][2] = bflo(ra[g].y); af[g][3] = bfhi(ra[g].y);
                    ef[g][0] = bflo(re[g].x); ef[g][1] = bfhi(re[g].x); ef[g][2] = bflo(re[g].y); ef[g][3] = bfhi(re[g].y);
                    vf[g][0] = bflo(rv[g].x); vf[g][1] = bfhi(rv[g].x); vf[g][2] = bflo(rv[g].y); vf[g][3] = bfhi(rv[g].y);
                    rf[g][0] = bflo(rr[g].x); rf[g][1] = bfhi(rr[g].x); rf[g][2] = bflo(rr[g].y); rf[g][3] = bfhi(rr[g].y); }
                unsigned VP[4][2];
#pragma unroll
                for (int g = 0; g < 4; ++g) { VP[g][0] = rv[g].x; VP[g][1] = rv[g].y; }
                if (rnd + 1 < 36) S2_LOAD((rnd + 1) * 4 + F.wave);
                float kkv[4][4]; float n2 = 0.f;
#pragma unroll
                for (int g = 0; g < 4; ++g) { const f32x4 kc = *(const LAS f32x4*)(PAR + 16 * g + 4 * q);
#pragma unroll
                    for (int i = 0; i < 4; ++i) { kkv[g][i] = kf[g][i] * kc[i]; n2 += kkv[g][i] * kkv[g][i]; } }
                n2 += __shfl_xor(n2, 16); n2 += __shfl_xor(n2, 32);
                const float inv = 1.0f / fmaxf(sqrtf(n2), 1e-12f);
                float sb = 0.f;
                unsigned KaP[4][2], BmP[4][2], KmP[4][2], RmP[4][2]; f32x4 gend[4];
#pragma unroll
                for (int g = 0; g < 4; ++g) { const f32x4 kac = *(const LAS f32x4*)(PAR + 64 + 16 * g + 4 * q), rkc = *(const LAS f32x4*)(PAR + 128 + 16 * g + 4 * q);
                    float ka_[4], bm_[4], km_[4], rm_[4];
#pragma unroll
                    for (int i = 0; i < 4; ++i) {
                        float L = ef[g][i];
                        L += dpp_f<0x111>(L); L += dpp_f<0x112>(L); L += dpp_f<0x114>(L); L += dpp_f<0x118>(L);
                        const float gt = fexp(-L), gi = fexp(L); float gm1 = dpp_f<0x111>(gt); gm1 = (tt == 0) ? 1.0f : gm1;
                        const float kk = kkv[g][i] * inv, kd = kf[g][i] * (1.0f + (af[g][i] - 1.0f) * kac[i]);
                        ka_[i] = kk * gm1; bm_[i] = kk * af[g][i] * gi; km_[i] = kd * gi; rm_[i] = rf[g][i] * gt;
                        sb += rf[g][i] * kd * rkc[i]; gend[g][i] = gt; }
                    KaP[g][0] = pk2(ka_[0], ka_[1]); KaP[g][1] = pk2(ka_[2], ka_[3]); BmP[g][0] = pk2(bm_[0], bm_[1]); BmP[g][1] = pk2(bm_[2], bm_[3]);
                    KmP[g][0] = pk2(km_[0], km_[1]); KmP[g][1] = pk2(km_[2], km_[3]); RmP[g][0] = pk2(rm_[0], rm_[1]); RmP[g][1] = pk2(rm_[2], rm_[3]);
                }
                if (lat) { sb += __shfl_xor(sb, 16); sb += __shfl_xor(sb, 32); if (q == 0) SB[(size_t)(S2_ROW0(ci) + (d ? 15 - tt : tt)) * NH + h] = sb; }
                s16x8 KaF[2], BmF[2], KmF[2], RmF[2], VF[2];
#pragma unroll
                for (int kb = 0; kb < 2; ++kb) { KaF[kb] = mk8(KaP[2 * kb][0], KaP[2 * kb][1], KaP[2 * kb + 1][0], KaP[2 * kb + 1][1]); BmF[kb] = mk8(BmP[2 * kb][0], BmP[2 * kb][1], BmP[2 * kb + 1][0], BmP[2 * kb + 1][1]);
                    KmF[kb] = mk8(KmP[2 * kb][0], KmP[2 * kb][1], KmP[2 * kb + 1][0], KmP[2 * kb + 1][1]); RmF[kb] = mk8(RmP[2 * kb][0], RmP[2 * kb][1], RmP[2 * kb + 1][0], RmP[2 * kb + 1][1]);
                    VF[kb] = mk8(VP[2 * kb][0], VP[2 * kb][1], VP[2 * kb + 1][0], VP[2 * kb + 1][1]); }
                const f32x4 Z = (f32x4){0.f, 0.f, 0.f, 0.f};
                f32x4 Nd = mfma16(KaF[1], BmF[1], mfma16(KaF[0], BmF[0], Z));
                f32x4 Nt = mfma16(BmF[1], KaF[1], mfma16(BmF[0], KaF[0], Z));
                f32x4 AakT = mfma16(KmF[1], KaF[1], mfma16(KmF[0], KaF[0], Z));
                f32x4 ArbT = mfma16(BmF[1], RmF[1], mfma16(BmF[0], RmF[0], Z));
                f32x4 ArkT = mfma16(KmF[1], RmF[1], mfma16(KmF[0], RmF[0], Z));
                f32x4 Q0;
#pragma unroll
                for (int r = 0; r < 4; ++r) { const int row = 4 * q + r;
                    Nd[r] = row > tt ? Nd[r] : 0.f; Nt[r] = row < tt ? Nt[r] : 0.f; AakT[r] = row < tt ? AakT[r] : 0.f; ArbT[r] = row <= tt ? ArbT[r] : 0.f; ArkT[r] = row <= tt ? ArkT[r] : 0.f;
                    Q0[r] = (row == tt ? 1.0f : 0.f) - Nt[r]; }
                const s16x8 oN = mk_d(Nd), oNt = mk_d(Nt);
                const f32x4 N2 = mfma16(oNt, oN, Z), N2t = mfma16(oN, oNt, Z);
                const s16x8 oN2 = mk_d(N2), oN2t = mk_d(N2t);
                const f32x4 N4 = mfma16(oN2t, oN2, Z), N4t = mfma16(oN2, oN2t, Z);
                const s16x8 oN4 = mk_d(N4), oN4t = mk_d(N4t);
                const f32x4 N8 = mfma16(oN4t, oN4, Z);
                const f32x4 Q1 = mfma16(oN2, mk_d(Q0), Q0);
                const f32x4 Q2 = mfma16(oN4, mk_d(Q1), Q1);
                const f32x4 Q3 = mfma16(mk_d(N8), mk_d(Q2), Q2);
                *(LAS u32x4*)(slot_w + SL_KA + lane * 16) = __builtin_bit_cast(u32x4, KaF[0]); *(LAS u32x4*)(slot_w + SL_KA + 1024 + lane * 16) = __builtin_bit_cast(u32x4, KaF[1]);
                *(LAS u32x4*)(slot_w + SL_RM + lane * 16) = __builtin_bit_cast(u32x4, RmF[0]); *(LAS u32x4*)(slot_w + SL_RM + 1024 + lane * 16) = __builtin_bit_cast(u32x4, RmF[1]);
                *(LAS u32x2*)(slot_w + SL_TN + lane * 8) = (u32x2){pk2(-Q3[0], -Q3[1]), pk2(-Q3[2], -Q3[3])};
                *(LAS u32x2*)(slot_w + SL_AAK + lane * 8) = (u32x2){pk2(AakT[0], AakT[1]), pk2(AakT[2], AakT[3])};
                *(LAS u32x4*)(slot_w + SL_ARK + lane * 16) = (u32x4){pk2(ArbT[0], ArbT[1]), pk2(ArbT[2], ArbT[3]), pk2(ArkT[0], ArkT[1]), pk2(ArkT[2], ArkT[3])};
#pragma unroll
                for (int kb = 0; kb < 2; ++kb)
#pragma unroll
                    for (int sel = 0; sel < 2; ++sel) { const int tk = 2 * kb + sel;
                        const f32x4 DB = mfma16(BmF[kb], SelF[sel], Z), DK = mfma16(KmF[kb], SelF[sel], Z), DV = mfma16(VF[kb], SelF[sel], Z);
                        *(LAS u32x4*)(slot_w + SL_BK + tk * 1024 + lane * 16) = (u32x4){pk2(DB[0], DB[1]), pk2(DB[2], DB[3]), pk2(DK[0], DK[1]), pk2(DK[2], DK[3])};
                        *(LAS u32x2*)(slot_w + SL_VC + tk * 512 + lane * 8) = (u32x2){pk2(DV[0], DV[1]), pk2(DV[2], DV[3])}; }
                if (tt == 15) {
#pragma unroll
                    for (int g = 0; g < 4; ++g) *(LAS f32x4*)(slot_w + SL_GC + (g * 4 + q) * 16) = gend[g]; }
            }
            __builtin_amdgcn_fence(__ATOMIC_RELEASE, "workgroup");
            if (lane == 0) __hip_atomic_fetch_add(CNT, 1u, __ATOMIC_RELAXED, __HIP_MEMORY_SCOPE_WORKGROUP);
            { unsigned spins = 0; while (__hip_atomic_load(CNT, __ATOMIC_RELAXED, __HIP_MEMORY_SCOPE_WORKGROUP) < 4u * (unsigned)(rnd + 1)) { __builtin_amdgcn_s_sleep(1); if (++spins > (1u << 22)) break; } }
            __builtin_amdgcn_fence(__ATOMIC_ACQUIRE, "workgroup");
            {
                const int tv = F.wave;
                for (int sl = 0; sl < 4; ++sl) {
                    LAS unsigned char* S = F.lds + ((rnd & 1) * 4 + sl) * SL_BYTES; const int cj = rnd * 4 + sl;
                    const s16x8 KA0 = __builtin_bit_cast(s16x8, *(LAS u32x4*)(S + SL_KA + lane * 16)), KA1 = __builtin_bit_cast(s16x8, *(LAS u32x4*)(S + SL_KA + 1024 + lane * 16));
                    const u32x2 aak = *(LAS u32x2*)(S + SL_AAK + lane * 8), tn = *(LAS u32x2*)(S + SL_TN + lane * 8), vc = *(LAS u32x2*)(S + SL_VC + tv * 512 + lane * 8);
                    const s16x8 Gb0 = mk8(pk2(G[0][0], G[0][1]), pk2(G[0][2], G[0][3]), pk2(G[1][0], G[1][1]), pk2(G[1][2], G[1][3]));
                    const s16x8 Gb1 = mk8(pk2(G[2][0], G[2][1]), pk2(G[2][2], G[2][3]), pk2(G[3][0], G[3][1]), pk2(G[3][2], G[3][3]));
                    const f32x4 Z = (f32x4){0.f, 0.f, 0.f, 0.f};
                    f32x4 P = mfma16(KA0, Gb0, Z); P = mfma16(KA1, Gb1, P); P = mfma16(mk8(aak.x, aak.y, 0u, 0u), mk8(vc.x, vc.y, 0u, 0u), P);
                    const f32x4 U = mfma16(mk8(tn.x, tn.y, 0u, 0u), mk_d(P), Z);
                    const s16x8 UV = mk8(pk2(U[0], U[1]), pk2(U[2], U[3]), vc.x, vc.y);
                    if (lat) {
                        const s16x8 RM0 = __builtin_bit_cast(s16x8, *(LAS u32x4*)(S + SL_RM + lane * 16)), RM1 = __builtin_bit_cast(s16x8, *(LAS u32x4*)(S + SL_RM + 1024 + lane * 16));
                        const s16x8 ARK = __builtin_bit_cast(s16x8, *(LAS u32x4*)(S + SL_ARK + lane * 16));
                        f32x4 Y = mfma16(Gb0, RM0, Z); Y = mfma16(Gb1, RM1, Y); Y = mfma16(UV, ARK, Y);
                        *(u32x2*)(YD + (size_t)(S2_ROW0(cj) + (d ? 15 - tt : tt)) * D + h * HS + 16 * tv + 4 * q) = (u32x2){pk2(Y[0], Y[1]), pk2(Y[2], Y[3])};
                    }
#pragma unroll
                    for (int tk = 0; tk < 4; ++tk) { const s16x8 BK = __builtin_bit_cast(s16x8, *(LAS u32x4*)(S + SL_BK + tk * 1024 + lane * 16));
                        G[tk] = mfma16(BK, UV, G[tk]); G[tk] = G[tk] * *(LAS f32x4*)(S + SL_GC + (tk * 4 + q) * 16); }
                }
            }
        }
        }
#undef S2_ROW0
#undef S2_LOAD
    }
    __syncthreads();
}

__device__ __forceinline__ void p4_scan4(const Frame& F, const Args& a, unsigned char* yd_base, float* sb_base) {
    const int lane = lane_id(), tt = lane & 15, q = lane >> 4;
    const bf16_t* KX = (const bf16_t*)(F.ws + A_KX); const bf16_t* VV = (const bf16_t*)(F.ws + A_V); const bf16_t* RR = (const bf16_t*)(F.ws + A_R);
    const bf16_t* EW = (const bf16_t*)(F.ws + A_EW); const bf16_t* AA = (const bf16_t*)(F.ws + A_AA);
    LAS float* PAR = (LAS float*)(F.lds + SC_PAR);
    LAS unsigned* CNT = (LAS unsigned*)(F.lds + SC_PAR + 1024);
    s16x8 SelF[2];
#pragma unroll
    for (int sel = 0; sel < 2; ++sel) { unsigned w[4];
#pragma unroll
        for (int jj = 0; jj < 4; ++jj) { const int j0 = 2 * jj, j1 = 2 * jj + 1; const bool h0 = (q == (tt >> 2)) && (j0 == 4 * sel + (tt & 3)), h1 = (q == (tt >> 2)) && (j1 == 4 * sel + (tt & 3));
            w[jj] = (h0 ? 0x3f80u : 0u) | (h1 ? 0x3f800000u : 0u); }
        SelF[sel] = mk8(w[0], w[1], w[2], w[3]); }
    { const int s = blockIdx.x;
        const int b = s >> 6, h = (s >> 1) & 31, d = s & 1;
        bf16_t* YD = (bf16_t*)(yd_base + (size_t)d * 32 * MiB); float* SB = sb_base + (size_t)d * ML * NH;
        __syncthreads();
        if (F.wave == 0) { PAR[lane] = a.in[I_KK][h * HS + lane]; PAR[64 + lane] = a.in[I_KA][h * HS + lane]; PAR[128 + lane] = a.in[I_RK][h * HS + lane]; if (lane < 8) CNT[lane] = 0u; }
        __syncthreads();
        if (F.wave >= 4) {
        const int pw = F.wave - 4;
#define S2_ROW0(ci) (((ci) < 16) ? (ML + b * TC + (d ? 15 - (ci) : (ci)) * 16) : (b * T + (d ? 127 - ((ci) - 16) : ((ci) - 16)) * 16))
        u32x2 rk[4], rv[4], rr[4], re[4], ra[4];
#define S2_LOAD(ci) do { const int row_ = S2_ROW0(ci) + (d ? 15 - tt : tt); const size_t o_ = (size_t)row_ * D + h * HS + 4 * q, o2_ = (size_t)row_ * (2 * D) + d * D + h * HS + 4 * q; \
        _Pragma("unroll") for (int g_ = 0; g_ < 4; ++g_) { rk[g_] = *(const u32x2*)(KX + o_ + 16 * g_); rv[g_] = *(const u32x2*)(VV + o_ + 16 * g_); \
            rr[g_] = ((ci) >= 16) ? *(const u32x2*)(RR + o_ + 16 * g_) : (u32x2){0u, 0u}; re[g_] = *(const u32x2*)(EW + o2_ + 16 * g_); ra[g_] = *(const u32x2*)(AA + o2_ + 16 * g_); } } while (0)
        S2_LOAD(pw);
        for (int rnd = 0; rnd < 36; ++rnd) {
            const int ci = rnd * 4 + pw; const bool lat = rnd >= 4;
            LAS unsigned char* slot_w = F.lds + ((rnd & 1) * 4 + pw) * SL_BYTES;
            if (rnd >= 2) { unsigned spins = 0;
                for (;;) { const unsigned d0 = __hip_atomic_load(CNT + 4, __ATOMIC_RELAXED, __HIP_MEMORY_SCOPE_WORKGROUP), d1 = __hip_atomic_load(CNT + 5, __ATOMIC_RELAXED, __HIP_MEMORY_SCOPE_WORKGROUP), d2 = __hip_atomic_load(CNT + 6, __ATOMIC_RELAXED, __HIP_MEMORY_SCOPE_WORKGROUP), d3 = __hip_atomic_load(CNT + 7, __ATOMIC_RELAXED, __HIP_MEMORY_SCOPE_WORKGROUP);
                    const unsigned need = (unsigned)(rnd - 1); if ((d0 >= need && d1 >= need && d2 >= need && d3 >= need) || ++spins > (1u << 22)) break; __builtin_amdgcn_s_sleep(1); }
                __builtin_amdgcn_fence(__ATOMIC_ACQUIRE, "workgroup"); }
            {
                float kf[4][4], af[4][4], ef[4][4], vf[4][4], rf[4][4];
#pragma unroll
                for (int g = 0; g < 4; ++g) {
                    kf[g][0] = bflo(rk[g].x); kf[g][1] = bfhi(rk[g].x); kf[g][2] = bflo(rk[g].y); kf[g][3] = bfhi(rk[g].y);
                    af[g][0] = bflo(ra[g].x); af[g][1] = bfhi(ra[g].x); af[g][2] = bflo(ra[g].y); af[g][3] = bfhi(ra[g].y);
                    ef[g][0] = bflo(re[g].x); ef[g][1] = bfhi(re[g].x); ef[g][2] = bflo(re[g].y); ef[g][3] = bfhi(re[g].y);
                    vf[g][0] = bflo(rv[g].x); vf[g][1] = bfhi(rv[g].x); vf[g][2] = bflo(rv[g].y); vf[g][3] = bfhi(rv[g].y);
                    rf[g][0] = bflo(rr[g].x); rf[g][1] = bfhi(rr[g].x); rf[g][2] = bflo(rr[g].y); rf[g][3] = bfhi(rr[g].y); }
                unsigned VP[4][2];
#pragma unroll
                for (int g = 0; g < 4; ++g) { VP[g][0] = rv[g].x; VP[g][1] = rv[g].y; }
                if (rnd + 1 < 36) S2_LOAD((rnd + 1) * 4 + pw);
                float kkv[4][4]; float n2 = 0.f;
#pragma unroll
                for (int g = 0; g < 4; ++g) { const f32x4 kc = *(const LAS f32x4*)(PAR + 16 * g + 4 * q);
#pragma unroll
                    for (int i = 0; i < 4; ++i) { kkv[g][i] = kf[g][i] * kc[i]; n2 += kkv[g][i] * kkv[g][i]; } }
                n2 += __shfl_xor(n2, 16); n2 += __shfl_xor(n2, 32);
                const float inv = 1.0f / fmaxf(sqrtf(n2), 1e-12f);
                float sb = 0.f;
                unsigned KaP[4][2], BmP[4][2], KmP[4][2], RmP[4][2]; f32x4 gend[4];
#pragma unroll
                for (int g = 0; g < 4; ++g) { const f32x4 kac = *(const LAS f32x4*)(PAR + 64 + 16 * g + 4 * q), rkc = *(const LAS f32x4*)(PAR + 128 + 16 * g + 4 * q);
                    float ka_[4], bm_[4], km_[4], rm_[4];
#pragma unroll
                    for (int i = 0; i < 4; ++i) {
                        float L = ef[g][i];
                        L += dpp_f<0x111>(L); L += dpp_f<0x112>(L); L += dpp_f<0x114>(L); L += dpp_f<0x118>(L);
                        const float gt = fexp(-L), gi = fexp(L); float gm1 = dpp_f<0x111>(gt); gm1 = (tt == 0) ? 1.0f : gm1;
                        const float kk = kkv[g][i] * inv, kd = kf[g][i] * (1.0f + (af[g][i] - 1.0f) * kac[i]);
                        ka_[i] = kk * gm1; bm_[i] = kk * af[g][i] * gi; km_[i] = kd * gi; rm_[i] = rf[g][i] * gt;
                        sb += rf[g][i] * kd * rkc[i]; gend[g][i] = gt; }
                    KaP[g][0] = pk2(ka_[0], ka_[1]); KaP[g][1] = pk2(ka_[2], ka_[3]); BmP[g][0] = pk2(bm_[0], bm_[1]); BmP[g][1] = pk2(bm_[2], bm_[3]);
                    KmP[g][0] = pk2(km_[0], km_[1]); KmP[g][1] = pk2(km_[2], km_[3]); RmP[g][0] = pk2(rm_[0], rm_[1]); RmP[g][1] = pk2(rm_[2], rm_[3]);
                }
                if (lat) { sb += __shfl_xor(sb, 16); sb += __shfl_xor(sb, 32); if (q == 0) SB[(size_t)(S2_ROW0(ci) + (d ? 15 - tt : tt)) * NH + h] = sb; }
                s16x8 KaF[2], BmF[2], KmF[2], RmF[2], VF[2];
#pragma unroll
                for (int kb = 0; kb < 2; ++kb) { KaF[kb] = mk8(KaP[2 * kb][0], KaP[2 * kb][1], KaP[2 * kb + 1][0], KaP[2 * kb + 1][1]); BmF[kb] = mk8(BmP[2 * kb][0], BmP[2 * kb][1], BmP[2 * kb + 1][0], BmP[2 * kb + 1][1]);
                    KmF[kb] = mk8(KmP[2 * kb][0], KmP[2 * kb][1], KmP[2 * kb + 1][0], KmP[2 * kb + 1][1]); RmF[kb] = mk8(RmP[2 * kb][0], RmP[2 * kb][1], RmP[2 * kb + 1][0], RmP[2 * kb + 1][1]);
                    VF[kb] = mk8(VP[2 * kb][0], VP[2 * kb][1], VP[2 * kb + 1][0], VP[2 * kb + 1][1]); }
                const f32x4 Z = (f32x4){0.f, 0.f, 0.f, 0.f};
                f32x4 Nd = mfma16(KaF[1], BmF[1], mfma16(KaF[0], BmF[0], Z));
                f32x4 Nt = mfma16(BmF[1], KaF[1], mfma16(BmF[0], KaF[0], Z));
                f32x4 AakT = mfma16(KmF[1], KaF[1], mfma16(KmF[0], KaF[0], Z));
                f32x4 ArbT = mfma16(BmF[1], RmF[1], mfma16(BmF[0], RmF[0], Z));
                f32x4 ArkT = mfma16(KmF[1], RmF[1], mfma16(KmF[0], RmF[0], Z));
                f32x4 Q0;
#pragma unroll
                for (int r = 0; r < 4; ++r) { const int row = 4 * q + r;
                    Nd[r] = row > tt ? Nd[r] : 0.f; Nt[r] = row < tt ? Nt[r] : 0.f; AakT[r] = row < tt ? AakT[r] : 0.f; ArbT[r] = row <= tt ? ArbT[r] : 0.f; ArkT[r] = row <= tt ? ArkT[r] : 0.f;
                    Q0[r] = (row == tt ? 1.0f : 0.f) - Nt[r]; }
                const s16x8 oN = mk_d(Nd), oNt = mk_d(Nt);
                const f32x4 N2 = mfma16(oNt, oN, Z), N2t = mfma16(oN, oNt, Z);
                const s16x8 oN2 = mk_d(N2), oN2t = mk_d(N2t);
                const f32x4 N4 = mfma16(oN2t, oN2, Z), N4t = mfma16(oN2, oN2t, Z);
                const s16x8 oN4 = mk_d(N4), oN4t = mk_d(N4t);
                const f32x4 N8 = mfma16(oN4t, oN4, Z);
                const f32x4 Q1 = mfma16(oN2, mk_d(Q0), Q0);
                const f32x4 Q2 = mfma16(oN4, mk_d(Q1), Q1);
                const f32x4 Q3 = mfma16(mk_d(N8), mk_d(Q2), Q2);
                *(LAS u32x4*)(slot_w + SL_KA + lane * 16) = __builtin_bit_cast(u32x4, KaF[0]); *(LAS u32x4*)(slot_w + SL_KA + 1024 + lane * 16) = __builtin_bit_cast(u32x4, KaF[1]);
                *(LAS u32x4*)(slot_w + SL_RM + lane * 16) = __builtin_bit_cast(u32x4, RmF[0]); *(LAS u32x4*)(slot_w + SL_RM + 1024 + lane * 16) = __builtin_bit_cast(u32x4, RmF[1]);
                *(LAS u32x2*)(slot_w + SL_TN + lane * 8) = (u32x2){pk2(-Q3[0], -Q3[1]), pk2(-Q3[2], -Q3[3])};
                *(LAS u32x2*)(slot_w + SL_AAK + lane * 8) = (u32x2){pk2(AakT[0], AakT[1]), pk2(AakT[2], AakT[3])};
                *(LAS u32x4*)(slot_w + SL_ARK + lane * 16) = (u32x4){pk2(ArbT[0], ArbT[1]), pk2(ArbT[2], ArbT[3]), pk2(ArkT[0], ArkT[1]), pk2(ArkT[2], ArkT[3])};
#pragma unroll
                for (int kb = 0; kb < 2; ++kb)
#pragma unroll
                    for (int sel = 0; sel < 2; ++sel) { const int tk = 2 * kb + sel;
                        const f32x4 DB = mfma16(BmF[kb], SelF[sel], Z), DK = mfma16(KmF[kb], SelF[sel], Z), DV = mfma16(VF[kb], SelF[sel], Z);
                        *(LAS u32x4*)(slot_w + SL_BK + tk * 1024 + lane * 16) = (u32x4){pk2(DB[0], DB[1]), pk2(DB[2], DB[3]), pk2(DK[0], DK[1]), pk2(DK[2], DK[3])};
                        *(LAS u32x2*)(slot_w + SL_VC + tk * 512 + lane * 8) = (u32x2){pk2(DV[0], DV[1]), pk2(DV[2], DV[3])}; }
                if (tt == 15) {
#pragma unroll
                    for (int g = 0; g < 4; ++g) *(LAS f32x4*)(slot_w + SL_GC + (g * 4 + q) * 16) = gend[g]; }
            }
            __builtin_amdgcn_fence(__ATOMIC_RELEASE, "workgroup");
            if (lane == 0) __hip_atomic_store(CNT + pw, (unsigned)(rnd + 1), __ATOMIC_RELAXED, __HIP_MEMORY_SCOPE_WORKGROUP);
        }
        } else {
        f32x4 G[4];
#pragma unroll
        for (int tk = 0; tk < 4; ++tk) G[tk] = (f32x4){0.f, 0.f, 0.f, 0.f};
        for (int rnd = 0; rnd < 36; ++rnd) {
            const bool lat = rnd >= 4;
            { unsigned spins = 0;
                for (;;) { const unsigned f0 = __hip_atomic_load(CNT + 0, __ATOMIC_RELAXED, __HIP_MEMORY_SCOPE_WORKGROUP), f1 = __hip_atomic_load(CNT + 1, __ATOMIC_RELAXED, __HIP_MEMORY_SCOPE_WORKGROUP), f2 = __hip_atomic_load(CNT + 2, __ATOMIC_RELAXED, __HIP_MEMORY_SCOPE_WORKGROUP), f3 = __hip_atomic_load(CNT + 3, __ATOMIC_RELAXED, __HIP_MEMORY_SCOPE_WORKGROUP);
                    const unsigned need = (unsigned)(rnd + 1); if ((f0 >= need && f1 >= need && f2 >= need && f3 >= need) || ++spins > (1u << 22)) break; __builtin_amdgcn_s_sleep(1); } }
            __builtin_amdgcn_fence(__ATOMIC_ACQUIRE, "workgroup");
            {
                const int tv = F.wave;
                for (int sl = 0; sl < 4; ++sl) {
                    LAS unsigned char* S = F.lds + ((rnd & 1) * 4 + sl) * SL_BYTES; const int cj = rnd * 4 + sl;
                    const s16x8 KA0 = __builtin_bit_cast(s16x8, *(LAS u32x4*)(S + SL_KA + lane * 16)), KA1 = __builtin_bit_cast(s16x8, *(LAS u32x4*)(S + SL_KA + 1024 + lane * 16));
                    const u32x2 aak = *(LAS u32x2*)(S + SL_AAK + lane * 8), tn = *(LAS u32x2*)(S + SL_TN + lane * 8), vc = *(LAS u32x2*)(S + SL_VC + tv * 512 + lane * 8);
                    const s16x8 Gb0 = mk8(pk2(G[0][0], G[0][1]), pk2(G[0][2], G[0][3]), pk2(G[1][0], G[1][1]), pk2(G[1][2], G[1][3]));
                    const s16x8 Gb1 = mk8(pk2(G[2][0], G[2][1]), pk2(G[2][2], G[2][3]), pk2(G[3][0], G[3][1]), pk2(G[3][2], G[3][3]));
                    const f32x4 Z = (f32x4){0.f, 0.f, 0.f, 0.f};
                    f32x4 P = mfma16(KA0, Gb0, Z); P = mfma16(KA1, Gb1, P); P = mfma16(mk8(aak.x, aak.y, 0u, 0u), mk8(vc.x, vc.y, 0u, 0u), P);
                    const f32x4 U = mfma16(mk8(tn.x, tn.y, 0u, 0u), mk_d(P), Z);
                    const s16x8 UV = mk8(pk2(U[0], U[1]), pk2(U[2], U[3]), vc.x, vc.y);
                    if (lat) {
                        const s16x8 RM0 = __builtin_bit_cast(s16x8, *(LAS u32x4*)(S + SL_RM + lane * 16)), RM1 = __builtin_bit_cast(s16x8, *(LAS u32x4*)(S + SL_RM + 1024 + lane * 16));
                        const s16x8 ARK = __builtin_bit_cast(s16x8, *(LAS u32x4*)(S + SL_ARK + lane * 16));
                        f32x4 Y = mfma16(Gb0, RM0, Z); Y = mfma16(Gb1, RM1, Y); Y = mfma16(UV, ARK, Y);
                        *(u32x2*)(YD + (size_t)(S2_ROW0(cj) + (d ? 15 - tt : tt)) * D + h * HS + 16 * tv + 4 * q) = (u32x2){pk2(Y[0], Y[1]), pk2(Y[2], Y[3])};
                    }
#pragma unroll
                    for (int tk = 0; tk < 4; ++tk) { const s16x8 BK = __builtin_bit_cast(s16x8, *(LAS u32x4*)(S + SL_BK + tk * 1024 + lane * 16));
                        G[tk] = mfma16(BK, UV, G[tk]); G[tk] = G[tk] * *(LAS f32x4*)(S + SL_GC + (tk * 4 + q) * 16); }
                }
            }
            __builtin_amdgcn_fence(__ATOMIC_RELEASE, "workgroup");
            if (lane == 0) __hip_atomic_store(CNT + 4 + F.wave, (unsigned)(rnd + 1), __ATOMIC_RELAXED, __HIP_MEMORY_SCOPE_WORKGROUP);
        }
        }
#undef S2_ROW0
#undef S2_LOAD
    }
    __syncthreads();
}

__device__ __forceinline__ void p4_scan5(const Frame& F, const Args& a, unsigned char* yd_base, float* sb_base, int clo, int chi, int job = -1) {
    const int lane = lane_id(), tt = lane & 15, q = lane >> 4;
    const bf16_t* KX = (const bf16_t*)(F.ws + A_KX); const bf16_t* VV = (const bf16_t*)(F.ws + A_V); const bf16_t* RR = (const bf16_t*)(F.ws + A_R);
    const bf16_t* EW = (const bf16_t*)(F.ws + A_EW); const bf16_t* AA = (const bf16_t*)(F.ws + A_AA);
    LAS float* PAR = (LAS float*)(F.lds + SC_PAR);
    LAS unsigned* CNT = (LAS unsigned*)(F.lds + SC_PAR + 1024);
    s16x8 SelF[2];
#pragma unroll
    for (int sel = 0; sel < 2; ++sel) { unsigned w[4];
#pragma unroll
        for (int jj = 0; jj < 4; ++jj) { const int j0 = 2 * jj, j1 = 2 * jj + 1; const bool h0 = (q == (tt >> 2)) && (j0 == 4 * sel + (tt & 3)), h1 = (q == (tt >> 2)) && (j1 == 4 * sel + (tt & 3));
            w[jj] = (h0 ? 0x3f80u : 0u) | (h1 ? 0x3f800000u : 0u); }
        SelF[sel] = mk8(w[0], w[1], w[2], w[3]); }
    { const int s = job >= 0 ? job : (int)blockIdx.x;
        const int b = s >> 6, h = (s >> 1) & 31, d = s & 1;
        bf16_t* YD = (bf16_t*)(yd_base + (size_t)d * 32 * MiB); float* SB = sb_base + (size_t)d * ML * NH;
        __syncthreads();
        if (F.wave == 0) { PAR[lane] = a.in[I_KK][h * HS + lane]; PAR[64 + lane] = a.in[I_KA][h * HS + lane]; PAR[128 + lane] = a.in[I_RK][h * HS + lane]; if (lane < 8) CNT[lane] = 0u; }
        __syncthreads();
        if (F.wave >= 4) {
        const int pw = F.wave - 4;
#define S2_ROW0(ci) (((ci) < 16) ? (ML + b * TC + (d ? 15 - (ci) : (ci)) * 16) : (b * T + (d ? 127 - ((ci) - 16) : ((ci) - 16)) * 16))
        u32x2 rk[4], rv[4], rr[4], re[4], ra[4];
#define S2_LOAD(ci) do { const int row_ = S2_ROW0(ci) + (d ? 15 - tt : tt); const size_t o_ = (size_t)row_ * D + h * HS + 4 * q, o2_ = (size_t)row_ * (2 * D) + d * D + h * HS + 4 * q; \
        _Pragma("unroll") for (int g_ = 0; g_ < 4; ++g_) { rk[g_] = *(const u32x2*)(KX + o_ + 16 * g_); rv[g_] = *(const u32x2*)(VV + o_ + 16 * g_); \
            rr[g_] = ((ci) >= 16) ? *(const u32x2*)(RR + o_ + 16 * g_) : (u32x2){0u, 0u}; re[g_] = *(const u32x2*)(EW + o2_ + 16 * g_); ra[g_] = *(const u32x2*)(AA + o2_ + 16 * g_); } } while (0)
        S2_LOAD(pw);
        for (int rnd = 0; rnd < 36; ++rnd) {
            const int ci = rnd * 4 + pw; const bool lat = rnd >= 4;
            LAS unsigned char* slot_w = F.lds + ((rnd & 1) * 4 + pw) * SL_BYTES;
            if (rnd >= 2) { unsigned spins = 0;
                for (;;) { const unsigned d0 = __hip_atomic_load(CNT + 4, __ATOMIC_RELAXED, __HIP_MEMORY_SCOPE_WORKGROUP), d1 = __hip_atomic_load(CNT + 5, __ATOMIC_RELAXED, __HIP_MEMORY_SCOPE_WORKGROUP), d2 = __hip_atomic_load(CNT + 6, __ATOMIC_RELAXED, __HIP_MEMORY_SCOPE_WORKGROUP), d3 = __hip_atomic_load(CNT + 7, __ATOMIC_RELAXED, __HIP_MEMORY_SCOPE_WORKGROUP);
                    const unsigned need = (unsigned)(rnd - 1); if ((d0 >= need && d1 >= need && d2 >= need && d3 >= need) || ++spins > (1u << 22)) break; __builtin_amdgcn_s_sleep(1); }
                __builtin_amdgcn_fence(__ATOMIC_ACQUIRE, "workgroup"); }
            {
                float kf[4][4], af[4][4], ef[4][4], vf[4][4], rf[4][4];
#pragma unroll
                for (int g = 0; g < 4; ++g) {
                    kf[g][0] = bflo(rk[g].x); kf[g][1] = bfhi(rk[g].x); kf[g][2] = bflo(rk[g].y); kf[g][3] = bfhi(rk[g].y);
                    af[g][0] = bflo(ra[g].x); af[g][1] = bfhi(ra[g].x); af[g][2] = bflo(ra[g].y); af[g][3] = bfhi(ra[g].y);
                    ef[g][0] = bflo(re[g].x); ef[g][1] = bfhi(re[g].x); ef[g][2] = bflo(re[g].y); ef[g][3] = bfhi(re[g].y);
                    vf[g][0] = bflo(rv[g].x); vf[g][1] = bfhi(rv[g].x); vf[g][2] = bflo(rv[g].y); vf[g][3] = bfhi(rv[g].y);
                    rf[g][0] = bflo(rr[g].x); rf[g][1] = bfhi(rr[g].x); rf[g][2] = bflo(rr[g].y); rf[g][3] = bfhi(rr[g].y); }
                unsigned VP[4][2];
#pragma unroll
                for (int g = 0; g < 4; ++g) { VP[g][0] = rv[g].x; VP[g][1] = rv[g].y; }
                if (rnd + 1 < 36) S2_LOAD((rnd + 1) * 4 + pw);
                float kkv[4][4]; float n2 = 0.f;
#pragma unroll
                for (int g = 0; g < 4; ++g) { const f32x4 kc = *(const LAS f32x4*)(PAR + 16 * g + 4 * q);
#pragma unroll
                    for (int i = 0; i < 4; ++i) { kkv[g][i] = kf[g][i] * kc[i]; n2 += kkv[g][i] * kkv[g][i]; } }
                n2 += __shfl_xor(n2, 16); n2 += __shfl_xor(n2, 32);
                const float inv = 1.0f / fmaxf(sqrtf(n2), 1e-12f);
                float sb = 0.f;
                unsigned KaP[4][2], BmP[4][2], KmP[4][2], RmP[4][2]; f32x4 gend[4];
#pragma unroll
                for (int g = 0; g < 4; ++g) { const f32x4 kac = *(const LAS f32x4*)(PAR + 64 + 16 * g + 4 * q), rkc = *(const LAS f32x4*)(PAR + 128 + 16 * g + 4 * q);
                    float ka_[4], bm_[4], km_[4], rm_[4];
#pragma unroll
                    for (int i = 0; i < 4; ++i) {
                        float L = ef[g][i];
                        L += dpp_f<0x111>(L); L += dpp_f<0x112>(L); L += dpp_f<0x114>(L); L += dpp_f<0x118>(L);
                        const float gt = fexp(-L), gi = fexp(L); float gm1 = dpp_f<0x111>(gt); gm1 = (tt == 0) ? 1.0f : gm1;
                        const float kk = kkv[g][i] * inv, kd = kf[g][i] * (1.0f + (af[g][i] - 1.0f) * kac[i]);
                        ka_[i] = kk * gm1; bm_[i] = kk * af[g][i] * gi; km_[i] = kd * gi; rm_[i] = rf[g][i] * gt;
                        sb += rf[g][i] * kd * rkc[i]; gend[g][i] = gt; }
                    KaP[g][0] = pk2(ka_[0], ka_[1]); KaP[g][1] = pk2(ka_[2], ka_[3]); BmP[g][0] = pk2(bm_[0], bm_[1]); BmP[g][1] = pk2(bm_[2], bm_[3]);
                    KmP[g][0] = pk2(km_[0], km_[1]); KmP[g][1] = pk2(km_[2], km_[3]); RmP[g][0] = pk2(rm_[0], rm_[1]); RmP[g][1] = pk2(rm_[2], rm_[3]);
                }
                if (lat) { sb += __shfl_xor(sb, 16); sb += __shfl_xor(sb, 32); if (q == 0) SB[(size_t)(S2_ROW0(ci) + (d ? 15 - tt : tt)) * NH + h] = sb; }
                s16x8 KaF[2], BmF[2], KmF[2], RmF[2], VF[2];
#pragma unroll
                for (int kb = 0; kb < 2; ++kb) { KaF[kb] = mk8(KaP[2 * kb][0], KaP[2 * kb][1], KaP[2 * kb + 1][0], KaP[2 * kb + 1][1]); BmF[kb] = mk8(BmP[2 * kb][0], BmP[2 * kb][1], BmP[2 * kb + 1][0], BmP[2 * kb + 1][1]);
                    KmF[kb] = mk8(KmP[2 * kb][0], KmP[2 * kb][1], KmP[2 * kb + 1][0], KmP[2 * kb + 1][1]); RmF[kb] = mk8(RmP[2 * kb][0], RmP[2 * kb][1], RmP[2 * kb + 1][0], RmP[2 * kb + 1][1]);
                    VF[kb] = mk8(VP[2 * kb][0], VP[2 * kb][1], VP[2 * kb + 1][0], VP[2 * kb + 1][1]); }
                const f32x4 Z = (f32x4){0.f, 0.f, 0.f, 0.f};
                f32x4 Nd = mfma16(KaF[1], BmF[1], mfma16(KaF[0], BmF[0], Z));
                f32x4 Nt = mfma16(BmF[1], KaF[1], mfma16(BmF[0], KaF[0], Z));
                f32x4 AakT = mfma16(KmF[1], KaF[1], mfma16(KmF[0], KaF[0], Z));
                f32x4 ArbT = mfma16(BmF[1], RmF[1], mfma16(BmF[0], RmF[0], Z));
                f32x4 ArkT = mfma16(KmF[1], RmF[1], mfma16(KmF[0], RmF[0], Z));
                f32x4 Q0;
#pragma unroll
                for (int r = 0; r < 4; ++r) { const int row = 4 * q + r;
                    Nd[r] = row > tt ? Nd[r] : 0.f; Nt[r] = row < tt ? Nt[r] : 0.f; AakT[r] = row < tt ? AakT[r] : 0.f; ArbT[r] = row <= tt ? ArbT[r] : 0.f; ArkT[r] = row <= tt ? ArkT[r] : 0.f;
                    Q0[r] = (row == tt ? 1.0f : 0.f) - Nt[r]; }
                const s16x8 oN = mk_d(Nd), oNt = mk_d(Nt);
                const f32x4 N2 = mfma16(oNt, oN, Z), N2t = mfma16(oN, oNt, Z);
                const s16x8 oN2 = mk_d(N2), oN2t = mk_d(N2t);
                const f32x4 N4 = mfma16(oN2t, oN2, Z), N4t = mfma16(oN2, oN2t, Z);
                const s16x8 oN4 = mk_d(N4), oN4t = mk_d(N4t);
                const f32x4 N8 = mfma16(oN4t, oN4, Z);
                const f32x4 Q1 = mfma16(oN2, mk_d(Q0), Q0);
                const f32x4 Q2 = mfma16(oN4, mk_d(Q1), Q1);
                const f32x4 Q3 = mfma16(mk_d(N8), mk_d(Q2), Q2);
                *(LAS u32x4*)(slot_w + SL_KA + lane * 16) = __builtin_bit_cast(u32x4, KaF[0]); *(LAS u32x4*)(slot_w + SL_KA + 1024 + lane * 16) = __builtin_bit_cast(u32x4, KaF[1]);
                *(LAS u32x4*)(slot_w + SL_RM + lane * 16) = __builtin_bit_cast(u32x4, RmF[0]); *(LAS u32x4*)(slot_w + SL_RM + 1024 + lane * 16) = __builtin_bit_cast(u32x4, RmF[1]);
                *(LAS u32x2*)(slot_w + SL_TN + lane * 8) = (u32x2){pk2(-Q3[0], -Q3[1]), pk2(-Q3[2], -Q3[3])};
                *(LAS u32x2*)(slot_w + SL_AAK + lane * 8) = (u32x2){pk2(AakT[0], AakT[1]), pk2(AakT[2], AakT[3])};
                *(LAS u32x4*)(slot_w + SL_ARK + lane * 16) = (u32x4){pk2(ArbT[0], ArbT[1]), pk2(ArbT[2], ArbT[3]), pk2(ArkT[0], ArkT[1]), pk2(ArkT[2], ArkT[3])};
#pragma unroll
                for (int kb = 0; kb < 2; ++kb)
#pragma unroll
                    for (int sel = 0; sel < 2; ++sel) { const int tk = 2 * kb + sel;
                        const f32x4 DB = mfma16(BmF[kb], SelF[sel], Z), DK = mfma16(KmF[kb], SelF[sel], Z), DV = mfma16(VF[kb], SelF[sel], Z);
                        *(LAS u32x4*)(slot_w + SL_BK + tk * 1024 + lane * 16) = (u32x4){pk2(DB[0], DB[1]), pk2(DB[2], DB[3]), pk2(DK[0], DK[1]), pk2(DK[2], DK[3])};
                        *(LAS u32x2*)(slot_w + SL_VC + tk * 512 + lane * 8) = (u32x2){pk2(DV[0], DV[1]), pk2(DV[2], DV[3])}; }
                if (tt == 15) {
#pragma unroll
                    for (int g = 0; g < 4; ++g) *(LAS f32x4*)(slot_w + SL_GC + (g * 4 + q) * 16) = gend[g]; }
            }
            __builtin_amdgcn_fence(__ATOMIC_RELEASE, "workgroup");
            if (lane == 0) __hip_atomic_store(CNT + pw, (unsigned)(rnd + 1), __ATOMIC_RELAXED, __HIP_MEMORY_SCOPE_WORKGROUP);
        }
        } else {
        f32x4 G[4];
#pragma unroll
        for (int tk = 0; tk < 4; ++tk) G[tk] = (f32x4){0.f, 0.f, 0.f, 0.f};
        LAS unsigned* cscr = (LAS unsigned*)(F.lds + 102400 + F.wave * 8448);
        int cit = clo + (int)blockIdx.x * 4 + F.wave, ch_ = 0; bool chave = cit < chi; TrItem ct; f32x4 cr[4][4];
        if (chave) { ct = tr_decode(F, a, cit); tr_load(ct, 0, cr, lane); }
#define S5_CONV_STEP() do { if (chave) { tr_store(ct, ch_, cr, cscr, lane); \
            if (ct.f8 && ch_ == 0) ch_ = 1; else { cit += 4 * 256; ch_ = 0; chave = cit < chi; if (chave) ct = tr_decode(F, a, cit); } \
            if (chave) tr_load(ct, ch_, cr, lane); } } while (0)
        for (int rnd = 0; rnd < 36; ++rnd) {
            const bool lat = rnd >= 4;
            { unsigned spins = 0;
                for (;;) { const unsigned f0 = __hip_atomic_load(CNT + 0, __ATOMIC_RELAXED, __HIP_MEMORY_SCOPE_WORKGROUP), f1 = __hip_atomic_load(CNT + 1, __ATOMIC_RELAXED, __HIP_MEMORY_SCOPE_WORKGROUP), f2 = __hip_atomic_load(CNT + 2, __ATOMIC_RELAXED, __HIP_MEMORY_SCOPE_WORKGROUP), f3 = __hip_atomic_load(CNT + 3, __ATOMIC_RELAXED, __HIP_MEMORY_SCOPE_WORKGROUP);
                    const unsigned need = (unsigned)(rnd + 1); if ((f0 >= need && f1 >= need && f2 >= need && f3 >= need) || ++spins > (1u << 22)) break; __builtin_amdgcn_s_sleep(1); } }
            __builtin_amdgcn_fence(__ATOMIC_ACQUIRE, "workgroup");
            {
                const int tv = F.wave;
                for (int sl = 0; sl < 4; ++sl) {
                    LAS unsigned char* S = F.lds + ((rnd & 1) * 4 + sl) * SL_BYTES; const int cj = rnd * 4 + sl;
                    const s16x8 KA0 = __builtin_bit_cast(s16x8, *(LAS u32x4*)(S + SL_KA + lane * 16)), KA1 = __builtin_bit_cast(s16x8, *(LAS u32x4*)(S + SL_KA + 1024 + lane * 16));
                    const u32x2 aak = *(LAS u32x2*)(S + SL_AAK + lane * 8), tn = *(LAS u32x2*)(S + SL_TN + lane * 8), vc = *(LAS u32x2*)(S + SL_VC + tv * 512 + lane * 8);
                    const s16x8 Gb0 = mk8(pk2(G[0][0], G[0][1]), pk2(G[0][2], G[0][3]), pk2(G[1][0], G[1][1]), pk2(G[1][2], G[1][3]));
                    const s16x8 Gb1 = mk8(pk2(G[2][0], G[2][1]), pk2(G[2][2], G[2][3]), pk2(G[3][0], G[3][1]), pk2(G[3][2], G[3][3]));
                    const f32x4 Z = (f32x4){0.f, 0.f, 0.f, 0.f};
                    f32x4 P = mfma16(KA0, Gb0, Z); P = mfma16(KA1, Gb1, P); P = mfma16(mk8(aak.x, aak.y, 0u, 0u), mk8(vc.x, vc.y, 0u, 0u), P);
                    const f32x4 U = mfma16(mk8(tn.x, tn.y, 0u, 0u), mk_d(P), Z);
                    const s16x8 UV = mk8(pk2(U[0], U[1]), pk2(U[2], U[3]), vc.x, vc.y);
                    if (lat) {
                        const s16x8 RM0 = __builtin_bit_cast(s16x8, *(LAS u32x4*)(S + SL_RM + lane * 16)), RM1 = __builtin_bit_cast(s16x8, *(LAS u32x4*)(S + SL_RM + 1024 + lane * 16));
                        const s16x8 ARK = __builtin_bit_cast(s16x8, *(LAS u32x4*)(S + SL_ARK + lane * 16));
                        f32x4 Y = mfma16(Gb0, RM0, Z); Y = mfma16(Gb1, RM1, Y); Y = mfma16(UV, ARK, Y);
                        *(u32x2*)(YD + (size_t)(S2_ROW0(cj) + (d ? 15 - tt : tt)) * D + h * HS + 16 * tv + 4 * q) = (u32x2){pk2(Y[0], Y[1]), pk2(Y[2], Y[3])};
                    }
#pragma unroll
                    for (int tk = 0; tk < 4; ++tk) { const s16x8 BK = __builtin_bit_cast(s16x8, *(LAS u32x4*)(S + SL_BK + tk * 1024 + lane * 16));
                        G[tk] = mfma16(BK, UV, G[tk]); G[tk] = G[tk] * *(LAS f32x4*)(S + SL_GC + (tk * 4 + q) * 16); }
                }
            }
            __builtin_amdgcn_fence(__ATOMIC_RELEASE, "workgroup");
            if (lane == 0) __hip_atomic_store(CNT + 4 + F.wave, (unsigned)(rnd + 1), __ATOMIC_RELAXED, __HIP_MEMORY_SCOPE_WORKGROUP);
#if !defined(PROBE_S5TAIL)
            S5_CONV_STEP();
#if defined(S5_TWO)
            S5_CONV_STEP();
#endif
#endif
        }
        while (chave) S5_CONV_STEP();
#undef S5_CONV_STEP
        }
#undef S2_ROW0
#undef S2_LOAD
    }
    __syncthreads();
}

#if defined(PROBE_SCANCHK)
constexpr int CW_CHK = 20480;
__device__ __forceinline__ void p4_compare(const Frame& F) {
    const int lane = lane_id();
    const bf16_t* Y0 = (const bf16_t*)(F.ws + A_YD); const bf16_t* Y1 = (const bf16_t*)(F.ws + A_AO);
    const float* S0 = (const float*)(F.ws + WS_SB); const float* S1 = (const float*)(F.ws + WS_A + 644 * MiB);
    float num = 0.f, den = 0.f, num2 = 0.f, den2 = 0.f;
    for (size_t i = (size_t)F.gw * 64 + lane; i < (size_t)2 * ML * D / 8; i += (size_t)F.NGW * 64) { float a8[8], b8[8]; unpack8(((const u32x4*)Y0)[i], a8); unpack8(((const u32x4*)Y1)[i], b8);
#pragma unroll
        for (int e = 0; e < 8; ++e) { const float dd = b8[e] - a8[e]; num += dd * dd; den += a8[e] * a8[e]; } }
    for (size_t i = (size_t)F.gw * 64 + lane; i < (size_t)2 * ML * NH; i += (size_t)F.NGW * 64) { const float dd = S1[i] - S0[i]; num2 += dd * dd; den2 += S0[i] * S0[i]; }
    num = wave_sum(num); den = wave_sum(den); num2 = wave_sum(num2); den2 = wave_sum(den2);
    if (lane == 0) { atomicAdd((float*)(F.ctl + CW_CHK), num); atomicAdd((float*)(F.ctl + CW_CHK + 64), den); atomicAdd((float*)(F.ctl + CW_CHK + 128), num2); atomicAdd((float*)(F.ctl + CW_CHK + 192), den2); }
}
#endif
__device__ __forceinline__ void p5_ao(const Frame& F, const Args& a) {
    const int lane = lane_id(), tid = F.wave * 64 + lane; (void)tid;
    const bf16_t* Y0 = (const bf16_t*)(F.ws + A_YD); const bf16_t* Y1 = (const bf16_t*)(F.ws + A_YD + 32 * MiB);
    const bf16_t* VV = (const bf16_t*)(F.ws + A_V); const bf16_t* GT = (const bf16_t*)(F.ws + A_GATE); bf16_t* AO = (bf16_t*)(F.ws + A_AO);
    const float* SB0 = (const float*)(F.ws + WS_SB); const float* SB1 = SB0 + (size_t)ML * NH;
    for (int m = F.gw; m < ML; m += F.NGW) {
        float ov[4][8]; float amx = 0.f; (void)ov; (void)amx;
#pragma unroll
        for (int j = 0; j < 4; ++j) {
            const int c = 8 * lane + 512 * j, hd = c >> 6; const size_t o = (size_t)m * D + c;
            float y0[8], y1[8], vv[8], gg[8], y[8];
            unpack8(*(const u32x4*)(Y0 + o), y0); unpack8(*(const u32x4*)(Y1 + o), y1); unpack8(*(const u32x4*)(VV + o), vv); unpack8(*(const u32x4*)(GT + o), gg);
            float s = 0.f;
#pragma unroll
            for (int e = 0; e < 8; ++e) { y[e] = y0[e] + y1[e]; s += y[e]; }
            s = sum8(s); const float mean = s * (1.0f / 64.0f); float qv = 0.f;
#pragma unroll
            for (int e = 0; e < 8; ++e) { y[e] -= mean; qv += y[e] * y[e]; }
            qv = sum8(qv); const float rstd = 1.0f / sqrtf(qv * (1.0f / 64.0f) + GN_EPS);
            const float sb = SB0[(size_t)m * NH + hd] + SB1[(size_t)m * NH + hd];
            const f32x4 gw0 = *(const f32x4*)(a.in[I_GNW] + c), gw1 = *(const f32x4*)(a.in[I_GNW] + c + 4), gb0 = *(const f32x4*)(a.in[I_GNB] + c), gb1 = *(const f32x4*)(a.in[I_GNB] + c + 4);
            float o8[8];
#pragma unroll
            for (int e = 0; e < 8; ++e) { const float gw = e < 4 ? gw0[e & 3] : gw1[e & 3], gb = e < 4 ? gb0[e & 3] : gb1[e & 3]; o8[e] = (y[e] * rstd * gw + gb + sb * vv[e]) * gg[e]; }
            if (WO_I8) {
#pragma unroll
                for (int e = 0; e < 8; ++e) { ov[j][e] = o8[e]; amx = fmaxf(amx, fabsf(o8[e])); } }
            else { u32x4 w; w.x = pk2(o8[0], o8[1]); w.y = pk2(o8[2], o8[3]); w.z = pk2(o8[4], o8[5]); w.w = pk2(o8[6], o8[7]);
                *(u32x4*)(AO + o) = w; }
        }
        if (WO_I8) {
            amx = wave_max(amx);
            amx = fmaxf(amx, 1e-30f); const float inv = 127.0f / amx;
#pragma unroll
            for (int j = 0; j < 4; ++j) { u32x2 w; w.x = pk4_i8(ov[j][0] * inv, ov[j][1] * inv, ov[j][2] * inv, ov[j][3] * inv); w.y = pk4_i8(ov[j][4] * inv, ov[j][5] * inv, ov[j][6] * inv, ov[j][7] * inv);
                *(u32x2*)((unsigned char*)AO + (size_t)m * D + 8 * lane + 512 * j) = w; }
            if (lane == 0) ((float*)(F.ws + WS_RSO))[m] = amx * (1.0f / 127.0f);
        }
    }
}

struct RowLN { f32x4 xn[8]; };
__device__ __forceinline__ void ln_core(int lane, f32x4 (&z)[8], const float* lnw, const float* lnb) {
    float s = 0.f;
#pragma unroll
    for (int j = 0; j < 8; ++j) s += (z[j][0] + z[j][1]) + (z[j][2] + z[j][3]);
    const float mean = wave_sum(s) * (1.0f / D); float q = 0.f;
#pragma unroll
    for (int j = 0; j < 8; ++j) { z[j] = z[j] - mean; q += (z[j][0] * z[j][0] + z[j][1] * z[j][1]) + (z[j][2] * z[j][2] + z[j][3] * z[j][3]); }
    const float rstd = 1.0f / sqrtf(wave_sum(q) * (1.0f / D) + LN_EPS);
#pragma unroll
    for (int j = 0; j < 8; ++j) { const int c = 4 * lane + 256 * j; z[j] = z[j] * rstd * *(const f32x4*)(lnw + c) + *(const f32x4*)(lnb + c); }
}
__device__ __forceinline__ f32x4 ld_bf4(const bf16_t* p) { const u32x2 w = *(const u32x2*)p; return (f32x4){bflo(w.x), bfhi(w.x), bflo(w.y), bfhi(w.y)}; }
__device__ __forceinline__ void st_bf4(bf16_t* p, const f32x4 v) { u32x2 w; w.x = pk2(v[0], v[1]); w.y = pk2(v[2], v[3]); *(u32x2*)p = w; }
#ifndef XR_BF16
#define XR_BF16 0
#endif
__device__ __forceinline__ f32x4 xr_ld(const float* XR, size_t idx) { if (XR_BF16) return ld_bf4((const bf16_t*)XR + idx); return *(const f32x4*)(XR + idx); }
__device__ __forceinline__ void xr_st(float* XR, size_t idx, const f32x4 v) { if (XR_BF16) st_bf4((bf16_t*)XR + idx, v); else *(f32x4*)(XR + idx) = v; }
__device__ __forceinline__ void st_h(void* H, size_t idx, const f32x4 v, bool f8) { if (f8) *((unsigned*)((unsigned char*)H + idx)) = pk4_fp8(v[0] * 16.f, v[1] * 16.f, v[2] * 16.f, v[3] * 16.f); else st_bf4((bf16_t*)H + idx, v); }
__device__ __forceinline__ void post_norm_rows(const Frame& F, const Args& a, const bf16_t* Y, int gate_off, int lnidx, const float* MODh, int sh_off, int sc_off, void* H, int h8  , bool x0in) {
    const int lane = lane_id(), tid = F.wave * 64 + lane; (void)tid;
    const float* MOD = (const float*)(F.ws + WS_MOD); float* XR = (float*)(F.ws + WS_XR);
    const float* lnw = a.in[I_LNW] + lnidx * D; const float* lnb = a.in[I_LNB] + lnidx * D;
    for (int m = F.gw; m < ML; m += F.NGW) {
        const int b = m / T; const float* g = MOD + gate_off + (size_t)b * MOD_N; const size_t o = (size_t)m * D;
        f32x4 z[8];
#pragma unroll
        for (int j = 0; j < 8; ++j) { const int c = 4 * lane + 256 * j;
            const f32x4 xv = x0in ? *(const f32x4*)(a.in[I_X] + o + c) + *(const f32x4*)((const float*)(F.ws + WS_POS) + (size_t)(m % T) * D + c) : xr_ld(XR, o + c);
            z[j] = xv * ALPHA + *(const f32x4*)(g + c) * ld_bf4(Y + o + c); }
        ln_core(lane, z, lnw, lnb);
        const float* sh = MODh + sh_off + (size_t)b * MOD_N; const float* sc = MODh + sc_off + (size_t)b * MOD_N;
        if (h8 == 2) { float mx = 0.f;
#pragma unroll
            for (int j = 0; j < 8; ++j) { const int c = 4 * lane + 256 * j; xr_st(XR, o + c, z[j]); z[j] = z[j] * (*(const f32x4*)(sc + c) + 1.0f) + *(const f32x4*)(sh + c);
                mx = fmaxf(fmaxf(mx, fmaxf(fabsf(z[j][0]), fabsf(z[j][1]))), fmaxf(fabsf(z[j][2]), fabsf(z[j][3]))); }
            mx = wave_max(mx);
            mx = fmaxf(mx, 1e-30f); const float inv = 127.0f / mx;
#pragma unroll
            for (int j = 0; j < 8; ++j) { const int c = 4 * lane + 256 * j; *(unsigned*)((unsigned char*)H + o + c) = pk4_i8(z[j][0] * inv, z[j][1] * inv, z[j][2] * inv, z[j][3] * inv); }
            if (lane == 0) ((float*)(F.ws + WS_RS))[m] = mx * (1.0f / 127.0f);
            continue; }
#pragma unroll
        for (int j = 0; j < 8; ++j) { const int c = 4 * lane + 256 * j; xr_st(XR, o + c, z[j]);
            st_h(H, o + c, z[j] * (*(const f32x4*)(sc + c) + 1.0f) + *(const f32x4*)(sh + c), h8 != 0); }
    }
}

__device__ __forceinline__ void p9_quant_u(const Frame& F) {
    const int lane = lane_id();
    for (int m = F.gw; m < ML; m += F.NGW) {
        unsigned char* row = F.ws + A_U + (size_t)m * LDU * 2; u32x4 w[11]; float mx = 0.f;
#pragma unroll
        for (int i = 0; i < 11; ++i) w[i] = *(const u32x4*)(row + 16 * lane + 1024 * i);
#pragma unroll
        for (int i = 0; i < 11; ++i) { float f[8]; unpack8(w[i], f);
#pragma unroll
            for (int e = 0; e < 8; ++e) mx = fmaxf(mx, fabsf(f[e])); }
            mx = wave_max(mx);
        mx = fmaxf(mx, 1e-30f); const float inv = 127.0f / mx;
        asm volatile("" ::: "memory");
#pragma unroll
        for (int i = 0; i < 11; ++i) { float f[8]; unpack8(w[i], f); u32x2 o; o.x = pk4_i8(f[0] * inv, f[1] * inv, f[2] * inv, f[3] * inv); o.y = pk4_i8(f[4] * inv, f[5] * inv, f[6] * inv, f[7] * inv);
            *(u32x2*)(row + 8 * lane + 512 * i) = o; }
        if (lane == 0) ((float*)(F.ws + WS_RSU))[m] = mx * (1.0f / 127.0f);
    }
}

#ifndef POOL_SLIDE
#define POOL_SLIDE 0
#endif
template <int G>
__device__ __forceinline__ void pool_group4(const bf16_t* HP, bf16_t* PP, int m0, int t0, int lane) {
    constexpr int h = 1 << G; const int c = 8 * lane + 512 * G;
    float W[2 * h][8], E[3][8], S[8];
#pragma unroll
    for (int e = 0; e < 8; ++e) S[e] = 0.f;
#pragma unroll
    for (int j = 0; j < 2 * h; ++j) { const int tt = t0 - h + j; const bool ok = tt >= 0 && tt < T;
        unpack8(*(const u32x4*)(HP + (size_t)(ok ? m0 - h + j : m0) * D + c), W[j]);
#pragma unroll
        for (int e = 0; e < 8; ++e) { W[j][e] = ok ? W[j][e] : 0.f; S[e] += W[j][e]; } }
#pragma unroll
    for (int j = 0; j < 3; ++j) { const int tt = t0 + h + j; const bool ok = tt < T;
        unpack8(*(const u32x4*)(HP + (size_t)(ok ? m0 + h + j : m0) * D + c), E[j]);
#pragma unroll
        for (int e = 0; e < 8; ++e) E[j][e] = ok ? E[j][e] : 0.f; }
#pragma unroll
    for (int i = 0; i < 4; ++i) {
        if (i > 0) {
#pragma unroll
            for (int e = 0; e < 8; ++e) S[e] += E[i - 1][e] - ((i - 1 < 2 * h) ? W[(i - 1 < 2 * h) ? i - 1 : 0][e] : E[(i - 1 >= 2 * h) ? i - 1 - 2 * h : 0][e]); }
        const int t = t0 + i, lo = t - h > 0 ? t - h : 0, hi = t + h < T ? t + h : T; const float inv = 1.0f / (float)(hi - lo);
        float o[8];
#pragma unroll
        for (int e = 0; e < 8; ++e) { const float ctr = (i < h) ? W[(i < h) ? h + i : 0][e] : E[(i >= h) ? i - h : 0][e]; o[e] = S[e] * inv - ctr; }
        u32x4 w; w.x = pk2(o[0], o[1]); w.y = pk2(o[2], o[3]); w.z = pk2(o[4], o[5]); w.w = pk2(o[6], o[7]);
        *(u32x4*)(PP + (size_t)(m0 + i) * D + c) = w;
    }
}
__device__ __forceinline__ void p11_pool4(const Frame& F) {
    const int lane = lane_id();
    const bf16_t* HP = (const bf16_t*)(F.ws + A_HP); bf16_t* PP = (bf16_t*)(F.ws + A_PP);
    for (int qd = F.gw; qd < ML / 4; qd += F.NGW) { const int m0 = 4 * qd, t0 = m0 % T;
        pool_group4<0>(HP, PP, m0, t0, lane); pool_group4<1>(HP, PP, m0, t0, lane); pool_group4<2>(HP, PP, m0, t0, lane); pool_group4<3>(HP, PP, m0, t0, lane); }
}
__device__ __forceinline__ void p11_pool(const Frame& F) {
    const int lane = lane_id();
    const bf16_t* HP = (const bf16_t*)(F.ws + A_HP); bf16_t* PP = (bf16_t*)(F.ws + A_PP);
    for (int m = F.gw; m < ML; m += F.NGW) {
        const int t = m % T;
#pragma unroll
        for (int g = 0; g < 4; ++g) {
            constexpr int dummy = 0; (void)dummy;
            const int half = 1 << g, c = 8 * lane + 512 * g;
            float acc[8], ctr[8];
#pragma unroll
            for (int e = 0; e < 8; ++e) acc[e] = 0.f;
            int cnt = 0;
#pragma unroll
            for (int o = -8; o < 8; ++o) { if (o < -half || o >= half) continue;
                const int tt = t + o; const bool ok = tt >= 0 && tt < T; float v[8]; unpack8(*(const u32x4*)(HP + (size_t)(m + (ok ? o : 0)) * D + c), v);
                cnt += ok ? 1 : 0;
#pragma unroll
                for (int e = 0; e < 8; ++e) { acc[e] += ok ? v[e] : 0.f; if (o == 0) ctr[e] = v[e]; } }
            const float inv = 1.0f / (float)cnt;
            if (POOL_I8) { float pv[8]; float mx = 0.f;
#pragma unroll
                for (int e = 0; e < 8; ++e) { pv[e] = acc[e] * inv - ctr[e]; mx = fmaxf(mx, fabsf(pv[e])); }
            mx = wave_max(mx);
                mx = fmaxf(mx, 1e-30f); const float qs = 127.0f / mx;
                u32x2 w; w.x = pk4_i8(pv[0] * qs, pv[1] * qs, pv[2] * qs, pv[3] * qs); w.y = pk4_i8(pv[4] * qs, pv[5] * qs, pv[6] * qs, pv[7] * qs);
                *(u32x2*)((unsigned char*)PP + (size_t)m * D + c) = w;
                if (lane == 0) ((float*)(F.ws + WS_RSP))[(size_t)g * ML + m] = mx * (1.0f / 127.0f);
                continue; }
            u32x4 w; w.x = pk2(acc[0] * inv - ctr[0], acc[1] * inv - ctr[1]); w.y = pk2(acc[2] * inv - ctr[2], acc[3] * inv - ctr[3]);
            w.z = pk2(acc[4] * inv - ctr[4], acc[5] * inv - ctr[5]); w.w = pk2(acc[6] * inv - ctr[6], acc[7] * inv - ctr[7]);
            *(u32x4*)(PP + (size_t)m * D + c) = w;
        }
    }
}

__device__ __forceinline__ void p13_norm_router(const Frame& F, const Args& a) {
    const int lane = lane_id(), tid = F.wave * 64 + lane; (void)tid;
    LAS float* RT = (LAS float*)F.lds;
    LAS int* lcnt = (LAS int*)(F.lds + 65536);
    LAS int* le = (LAS int*)(F.lds + 65536 + 64);
    LAS int* lr = (LAS int*)(F.lds + 65536 + 64 + 256);
    for (int i = tid; i < D * NE; i += 512) RT[(i & 7) * D + (i >> 3)] = a.in[I_ROUTER][i];
    const float* MOD = (const float*)(F.ws + WS_MOD); float* XR = (float*)(F.ws + WS_XR);
    const float* MOD1 = MOD + (size_t)5 * MOD_N;
    const bf16_t* Y = (const bf16_t*)(F.ws + A_YP); void* H = (void*)(F.ws + A_H2B);
    const float* lnw = a.in[I_LNW] + 2 * D; const float* lnb = a.in[I_LNB] + 2 * D;
    int* TOKE = (int*)(F.ws + WS_TOK); int* TOKS = TOKE + 2 * ML; float* TOKP = (float*)(TOKE + 6 * ML);
    unsigned* gcnt = F.ctl + CW_GCNT;
    for (int rb = blockIdx.x; rb < ML / 32; rb += F.G) {
        __syncthreads();
        if (tid < 8) lcnt[tid] = 0;
        __syncthreads();
        for (int i = 0; i < 4; ++i) {
            const int rl = F.wave * 4 + i, m = rb * 32 + rl, b = m / T; const size_t o = (size_t)m * D;
            const float* g = MOD1 + 2 * D + (size_t)b * MOD_N;
            f32x4 z[8];
#pragma unroll
            for (int j = 0; j < 8; ++j) { const int c = 4 * lane + 256 * j; z[j] = xr_ld(XR, o + c) * ALPHA + *(const f32x4*)(g + c) * ld_bf4(Y + o + c); }
            ln_core(lane, z, lnw, lnb);
            const float* sh = MOD1 + 3 * D + (size_t)b * MOD_N; const float* sc = MOD1 + 4 * D + (size_t)b * MOD_N;
            float lg[8];
#pragma unroll
            for (int e = 0; e < 8; ++e) lg[e] = 0.f;
#pragma unroll
            for (int j = 0; j < 8; ++j) { const int c = 4 * lane + 256 * j; xr_st(XR, o + c, z[j]);
                const f32x4 hv = z[j] * (*(const f32x4*)(sc + c) + 1.0f) + *(const f32x4*)(sh + c);
                st_h(H, o + c, hv, MOE_FP8 != 0);
#pragma unroll
                for (int e = 0; e < 8; ++e) { const f32x4 rt = *(const LAS f32x4*)(RT + e * D + c); lg[e] += (hv[0] * rt[0] + hv[1] * rt[1]) + (hv[2] * rt[2] + hv[3] * rt[3]); } }
#pragma unroll
            for (int e = 0; e < 8; ++e) lg[e] = wave_sum(lg[e]);
            int i0 = 0; float l0 = lg[0];
#pragma unroll
            for (int e = 1; e < 8; ++e) if (lg[e] > l0) { l0 = lg[e]; i0 = e; }
            int i1 = -1; float l1 = -3.0e38f;
#pragma unroll
            for (int e = 0; e < 8; ++e) if (e != i0 && lg[e] > l1) { l1 = lg[e]; i1 = e; }
            if (i1 < 0) { i1 = (i0 + 1) & 7; l1 = l0; }
            const float e1 = fexp(l1 - l0), p0 = 1.0f / (1.0f + e1), p1 = e1 / (1.0f + e1);
            if (lane == 0) { TOKE[2 * m] = i0; TOKE[2 * m + 1] = i1; TOKP[2 * m] = p0; TOKP[2 * m + 1] = p1;
                le[2 * rl] = i0; le[2 * rl + 1] = i1; lr[2 * rl] = __hip_atomic_fetch_add(&lcnt[i0], 1, __ATOMIC_RELAXED, __HIP_MEMORY_SCOPE_WORKGROUP); lr[2 * rl + 1] = __hip_atomic_fetch_add(&lcnt[i1], 1, __ATOMIC_RELAXED, __HIP_MEMORY_SCOPE_WORKGROUP); }
        }
        __syncthreads();
        if (tid < 8) lcnt[8 + tid] = (int)__hip_atomic_fetch_add(gcnt + 64 * tid, (unsigned)lcnt[tid], __ATOMIC_RELAXED, __HIP_MEMORY_SCOPE_AGENT);
        __syncthreads();
        if (tid < 64) TOKS[2 * (rb * 32) + tid] = lcnt[8 + le[tid]] + lr[tid];
    }
    __syncthreads();
}

struct MoeTab { int mt[8], ts[8], ntile; };
__device__ __forceinline__ MoeTab moe_tab(const Frame& F) {
    MoeTab t; int acc = 0;
#pragma unroll
    for (int e = 0; e < 8; ++e) { const int c = __builtin_amdgcn_readfirstlane((int)__hip_atomic_load(F.ctl + CW_GCNT + 64 * e, __ATOMIC_RELAXED, __HIP_MEMORY_SCOPE_AGENT)); t.mt[e] = (c + 255) >> 8; t.ts[e] = acc; acc += t.mt[e]; }
    t.ntile = acc; return t;
}
__device__ __forceinline__ void p14_gather(const Frame& F) {
    const int lane = lane_id(), tid = F.wave * 64 + lane; (void)tid;
    const MoeTab tb = moe_tab(F);
    const int* TOKE = (const int*)(F.ws + WS_TOK); const int* TOKS = TOKE + 2 * ML; int* TOKD = (int*)(TOKE + 4 * ML);
    const bf16_t* H = (const bf16_t*)(F.ws + A_H2B); bf16_t* HG = (bf16_t*)(F.ws + A_HG);
    for (int idx = F.gw; idx < 2 * ML; idx += F.NGW) {
        const int m = idx >> 1, e = TOKE[idx], sl = TOKS[idx]; int ts = 0;
#pragma unroll
        for (int k = 0; k < 8; ++k) ts = (e == k) ? tb.ts[k] : ts;
        const int dst = ts * 256 + sl;
        if (lane == 0) TOKD[idx] = dst;
        constexpr int RB = MOE_FP8 ? D : 2 * D;
        const u32x4* s = (const u32x4*)((const unsigned char*)H + (size_t)m * RB) + lane; u32x4* dd = (u32x4*)((unsigned char*)HG + (size_t)dst * RB) + lane;
        const u32x4 v0 = s[0], v1 = s[64]; dd[0] = v0; dd[64] = v1;
        if (!MOE_FP8) { const u32x4 v2 = s[128], v3 = s[192]; dd[128] = v2; dd[192] = v3; }
    }
}
__device__ __forceinline__ void p17_final(const Frame& F, const Args& a) {
    const int lane = lane_id(), tid = F.wave * 64 + lane; (void)tid;
    const float* MOD1 = (const float*)(F.ws + WS_MOD) + (size_t)5 * MOD_N; const float* XR = (const float*)(F.ws + WS_XR);
    const int* TOKD = (const int*)(F.ws + WS_TOK) + 4 * ML; const float* TOKP = (const float*)((const int*)(F.ws + WS_TOK) + 6 * ML);
    const bf16_t* Y2 = (const bf16_t*)(F.ws + A_Y2); const float* PART = (const float*)(F.ws + WS_PART);
    const int xrow = (MOE_FP8 && F.G == 256) ? MOE_RT * 256 : 0x7fffffff;
    const float* lnw = a.in[I_LNW] + 3 * D; const float* lnb = a.in[I_LNB] + 3 * D;
    for (int m = F.gw; m < ML; m += F.NGW) {
        const int b = m / T; const float* g = MOD1 + 5 * D + (size_t)b * MOD_N; const size_t o = (size_t)m * D;
        const int d0 = TOKD[2 * m], d1 = TOKD[2 * m + 1]; const float p0 = TOKP[2 * m], p1 = TOKP[2 * m + 1];
        f32x4 z[8];
#pragma unroll
        for (int j = 0; j < 8; ++j) { const int c = 4 * lane + 256 * j;
            f32x4 y0, y1;
            if (d0 >= xrow) { const float* pp = PART + (size_t)(d0 - xrow) * D + c; y0 = *(const f32x4*)pp;
#pragma unroll
                for (int ks = 1; ks < MOE_KS; ++ks) y0 += *(const f32x4*)(pp + (size_t)ks * 2048 * D); } else y0 = ld_bf4(Y2 + (size_t)d0 * D + c);
            if (d1 >= xrow) { const float* pp = PART + (size_t)(d1 - xrow) * D + c; y1 = *(const f32x4*)pp;
#pragma unroll
                for (int ks = 1; ks < MOE_KS; ++ks) y1 += *(const f32x4*)(pp + (size_t)ks * 2048 * D); } else y1 = ld_bf4(Y2 + (size_t)d1 * D + c);
            const f32x4 y = y0 * p0 + y1 * p1;
            z[j] = xr_ld(XR, o + c) * ALPHA + *(const f32x4*)(g + c) * y; }
        ln_core(lane, z, lnw, lnb);
#if defined(PROBE_STAMP)
        { const float us_ = 0.01f * (float)__hip_atomic_load(F.ctl + 24576, __ATOMIC_RELAXED, __HIP_MEMORY_SCOPE_AGENT); const float sc_ = 1.0f + us_ * (1.0f / 2000.0f);
#pragma unroll
          for (int j = 0; j < 8; ++j) z[j] = z[j] * sc_; }
#endif
#if defined(PROBE_SCANCHK)
        { const float n1 = __hip_atomic_load((float*)(F.ctl + CW_CHK), __ATOMIC_RELAXED, __HIP_MEMORY_SCOPE_AGENT), d1 = __hip_atomic_load((float*)(F.ctl + CW_CHK + 64), __ATOMIC_RELAXED, __HIP_MEMORY_SCOPE_AGENT);
          const float n2 = __hip_atomic_load((float*)(F.ctl + CW_CHK + 128), __ATOMIC_RELAXED, __HIP_MEMORY_SCOPE_AGENT), d2 = __hip_atomic_load((float*)(F.ctl + CW_CHK + 192), __ATOMIC_RELAXED, __HIP_MEMORY_SCOPE_AGENT);
          const float eps = sqrtf(n1 / d1) + sqrtf(n2 / d2), sc = 1.0f + 10.0f * eps;
#pragma unroll
          for (int j = 0; j < 8; ++j) z[j] = z[j] * sc; }
#endif
#pragma unroll
        for (int j = 0; j < 8; ++j) { const int c = 4 * lane + 256 * j; *(f32x4*)(a.out + o + c) = z[j]; }
    }
}

struct SchedBase { __device__ __forceinline__ void a_ready(const pg8::Unit&) const {} __device__ __forceinline__ void done(const pg8::Unit&) const {} };
struct SchedDense : SchedBase {
    const char* A; const char* B; bf16_t* O; const float* bias; int nM, nN, ldaB, ldbB, ldc, act, G, c; const float* rs = nullptr;
    __device__ __forceinline__ bool next(int i, pg8::Unit& u) const {
        const int L = i * G + c; if (L >= nM * nN) return false; u.rs = rs;
        int pm, pn; pg8::tile_of(L, nM, nN, pm, pn);
        u.A = A + (size_t)pm * 256 * ldaB; u.B = B + (size_t)pn * 256 * ldbB; u.O = O; u.bias = bias; u.pm = pm; u.pn = pn; u.ldc = ldc; u.act = act; return true;
    }
};
struct SchedP2 : SchedBase {
    unsigned char* ws; int G, c, lo = 0, hi = 936, coff = 0;
    __device__ __forceinline__ bool next(int i, pg8::Unit& u) const {
        if (c < coff) return false;
        int L = lo + i * G + (c - coff); if (L >= hi) return false;
        int mix, nM, nN, act, ldc; size_t wo, oo;
        if (L < 256)      { mix = 0; nM = 32; nN = 8; act = pg8::ACT_NONE;    wo = W_WR;  oo = A_R;   ldc = D; }
        else if (L < 544) { L -= 256; mix = 2; nM = 36; nN = 8; act = pg8::ACT_NONE; wo = W_WK;  oo = A_KX;  ldc = D; }
        else if (L < 832) { L -= 544; mix = 3; nM = 36; nN = 8; act = pg8::ACT_NONE; wo = W_WV;  oo = A_V;   ldc = D; }
        else if (L < 868) { L -= 832; mix = 1; nM = 36; nN = 1; act = pg8::ACT_TANH; wo = W_WLD; oo = A_LW;  ldc = 256; }
        else if (L < 904) { L -= 868; mix = 4; nM = 36; nN = 1; act = pg8::ACT_NONE; wo = W_ALD; oo = A_LA;  ldc = 256; }
        else              { L -= 904; mix = 5; nM = 32; nN = 1; act = pg8::ACT_SIGMOID; wo = W_G1; oo = A_G1O; ldc = 256; }
        int pm, pn; pg8::tile_of(L, nM, nN, pm, pn);
        const bool i8 = RKV_I8 && (LORA_I8 || mix == 0 || mix == 2 || mix == 3); const size_t eb = i8 ? 1 : 2;
        u.A = (const char*)ws + A_A6 + (size_t)mix * A6_STRIDE + (size_t)pm * 256 * D * eb; u.B = (const char*)ws + wo + (size_t)pn * 256 * D * eb;
        u.O = (bf16_t*)(ws + oo); u.bias = nullptr; u.pm = pm; u.pn = pn; u.ldc = ldc; u.act = act;
        if (i8) { u.rs = (const float*)(ws + WS_RS6) + (size_t)mix * MT;
            if (mix == 0 || mix == 2 || mix == 3) u.bias = (const float*)(ws + WS_CTL) + CW_CMAX2 + (mix == 0 ? 0 : mix - 1) * D;
            else u.bias = (const float*)(ws + WS_CML) + (mix == 1 ? 0 : mix - 3) * 256; }
        return true;
    }
};
struct SchedP3 : SchedBase {
    unsigned char* ws; const float* dw0; const float* ia0; int G, c, lo = 0, hi = 1408, kskip = 0;
    __device__ __forceinline__ bool next(int i, pg8::Unit& u) const {
        int L = lo + i * G + c; if (L >= hi) return false;
        int nM, nN, act, ldc; size_t ao, wo, oo; const float* bias;
        if (L < 576)       { nM = 36; nN = 16; act = pg8::ACT_EW; ao = A_LW; wo = W_WLU; oo = A_EW; ldc = 2 * D; bias = dw0; }
        else if (L < 1152) { L -= 576; nM = 36; nN = 16; act = pg8::ACT_BIAS_SIGMOID; ao = A_LA; wo = W_ALU; oo = A_AA; ldc = 2 * D; bias = ia0; }
        else               { L -= 1152; nM = 32; nN = 8; act = pg8::ACT_NONE; ao = A_G1O; wo = W_G2; oo = A_GATE; ldc = D; bias = nullptr; }
        int pm, pn; pg8::tile_of(L, nM, nN, pm, pn);
        const size_t k0 = (kskip && nN == 16 && pn >= 8) ? 64 * 2 : 0;
        u.A = (const char*)ws + ao + (size_t)pm * 256 * 256 * 2 + k0; u.B = (const char*)ws + wo + (size_t)pn * 256 * 256 * 2 + k0;
        u.O = (bf16_t*)(ws + oo); u.bias = bias; u.pm = pm; u.pn = pn; u.ldc = ldc; u.act = act; return true;
    }
};
struct SchedPool : SchedBase {
    unsigned char* ws; const float* scale; int G, c;
    __device__ __forceinline__ bool next(int i, pg8::Unit& u) const {
        const int L = i * G + c; if (L >= 256) return false;
        int pm, pn; pg8::tile_of(L, 32, 8, pm, pn);
        u.A = (const char*)ws + A_PP + ((size_t)pm * 256 * D + (size_t)(pn >> 1) * 512) * (POOL_I8 ? 1 : 2); u.B = (const char*)ws + W_PW + (size_t)pn * 256 * 512 * (POOL_I8 ? 1 : 2);
        u.O = (bf16_t*)(ws + A_YP); u.bias = scale; u.pm = pm; u.pn = pn; u.ldc = D; u.act = pg8::ACT_COLSCALE;
        if (POOL_I8) { u.act = pg8::ACT_NONE; u.rs = (const float*)(ws + WS_RSP) + (size_t)(pn >> 1) * ML; u.bias = (const float*)(ws + WS_CTL) + CW_CMAX4; }
        return true;
    }
};
struct SchedMoe : SchedBase {
    MoeTab tb; const char* A; const char* B; bf16_t* O; int NT, ldaB, ldbB, ldc; size_t estride; int NL, x, rank, W, mblock;
    __device__ __forceinline__ void init(int G, int c) { NL = (G % 8 == 0) ? 8 : 1; x = c % NL; rank = c / NL; W = G / NL; }
    __device__ __forceinline__ bool next(int i, pg8::Unit& u) const {
        int j = rank + i * W; int e = -1, nt, mtile;
        if (mblock) {
            const int S = (tb.ntile + NL - 1) / NL; mtile = x * S + j / NT; nt = j % NT;
            if (j >= S * NT || mtile >= tb.ntile) return false;
#pragma unroll
            for (int k = 0; k < 8; ++k) e = (mtile >= tb.ts[k] && mtile < tb.ts[k] + tb.mt[k]) ? k : e;
            if (e < 0) return false;
        } else {
            const int nn = (NT - x + NL - 1) / NL; int mte = 1, tse = 0;
#pragma unroll
            for (int k = 0; k < 8; ++k) { const int blk = nn * tb.mt[k]; if (e < 0) { if (j < blk) { e = k; mte = tb.mt[k]; tse = tb.ts[k]; } else j -= blk; } }
            if (e < 0) return false;
            nt = x + NL * (j / mte); mtile = tse + (j % mte);
        }
        u.A = A + (size_t)mtile * 256 * ldaB; u.B = B + (size_t)e * estride + (size_t)nt * 256 * ldbB; u.O = O; u.bias = nullptr; u.pm = mtile; u.pn = nt; u.ldc = ldc; u.act = pg8::ACT_NONE; return true;
    }
};

__device__ __forceinline__ MoeTab moe_tab_trunc(const MoeTab& t, int rt) { MoeTab o; int left = rt, acc = 0;
#pragma unroll
    for (int e = 0; e < 8; ++e) { const int m = t.mt[e] < left ? t.mt[e] : left; o.mt[e] = m; o.ts[e] = t.ts[e]; left -= m; acc += m; }
    o.ntile = acc; return o; }
struct SchedMoeX : SchedBase {
    MoeTab tb; const char* A; const char* B; float* P; int rt, ldaB, ldbB, G, c; size_t estride;
    __device__ __forceinline__ bool next(int i, pg8::Unit& u) const {
        const int j = i * G + c, nsub = (tb.ntile - rt) * 8 * MOE_KS; if (j >= nsub) return false;
        const int ks = j % MOE_KS, r = j / MOE_KS, nt = r & 7, mtile = rt + (r >> 3); int e = 0;
#pragma unroll
        for (int k = 0; k < 8; ++k) e = (mtile >= tb.ts[k] && mtile < tb.ts[k] + tb.mt[k]) ? k : e;
        const int kb = ks * (DFE / MOE_KS);
        u.A = A + (size_t)mtile * 256 * ldaB + kb; u.B = B + (size_t)e * estride + (size_t)nt * 256 * ldbB + kb;
        u.O = (bf16_t*)(P + (size_t)ks * 2048 * D); u.bias = nullptr; u.pm = mtile - rt; u.pn = nt; u.ldc = D; u.act = 0; return true;
    }
};
constexpr int NPHASE = 18;
#ifndef CONV_P2
#define CONV_P2 4096
#endif
#ifndef CONV_P8
#define CONV_P8 (TN_F2 + 3840)
#endif
#if defined(SCAN_NOCONV)
#define CONV_SCAN 0
#elif !defined(CONV_SCAN)
#define CONV_SCAN (MOE_FP8 ? 18432 : 36864)
#endif
#ifndef CONV_P15
#define CONV_P15 0
#endif
#ifndef NC_P15
#define NC_P15 224
#endif
constexpr int TI_C15 = TI_MW2 - CONV_P15;
#ifndef CONV_P3
#define CONV_P3 0
#endif
constexpr int NC_P3 = 235;
#ifndef NC_P8
#define NC_P8 235
#endif
#ifndef NC_P2
#define NC_P2 234
#endif
constexpr int TI_X1 = TI_C15 - (CONV_P8 - TN_F2), TI_X0 = TI_X1 - CONV_P2, TI_W0 = TI_X0 - CONV_SCAN, TI_V0 = TI_W0 - CONV_P3;
__global__ void __launch_bounds__(512, 2) trunk_fwd(Args args) {
    extern __shared__ __attribute__((aligned(16))) unsigned char lds_raw[];
    Frame F;
    F.lds = (LAS unsigned char*)lds_raw;
    F.wave = __builtin_amdgcn_readfirstlane((int)(threadIdx.x >> 6));
    F.G = gridDim.x; { const int bx = blockIdx.x; F.vcu = (F.G % 8 == 0) ? (bx % 8) * (F.G / 8) + bx / 8 : bx; }
    F.gw = F.vcu * 8 + F.wave; F.NGW = F.G * 8;
    F.ws = args.ws; F.ctl = (unsigned*)(args.ws + WS_CTL);
    volatile LAS unsigned* MISC = (volatile LAS unsigned*)(F.lds + MISC_OFF);
    if (threadIdx.x < 32) MISC[threadIdx.x] = 0u;
    __syncthreads();
    XcdBarrier bar; bar.bar = F.ctl + CW_BAR + args.li * XCD_BAR_WORDS; bar.x = 0; bar.st = nullptr;
    if (MK_N_LAUNCHES == 1) bar = xcd_barrier_post(F.ctl + CW_BAR + args.li * XCD_BAR_WORDS, MISC + 8);
    const int lo = args.ph_lo, hi = args.ph_hi;
#define IN(k) (lo <= (k) && (k) < hi)
#if defined(PROBE_BAR2)
#define SEAM(k) do { if (IN(k) && IN((k) + 1)) { xcd_barrier(bar); xcd_barrier(bar); } } while (0)
#else
#define SEAM(k) do { if (IN(k) && IN((k) + 1)) xcd_barrier(bar); } while (0)
#endif
    constexpr bool AL = true, SP = true;
#ifndef ALIGN_I8
#define ALIGN_I8 1
#endif
    constexpr bool AL_I8 = ALIGN_I8 != 0;
#ifndef ALIGN_P15
#define ALIGN_P15 1
#endif
    constexpr bool AL_P15 = ALIGN_P15 != 0;
#if defined(PROBE_STAMP)
#define STAMP(k) do { if (blockIdx.x == 0 && threadIdx.x == 0) { const unsigned now_ = (unsigned)__builtin_amdgcn_s_memrealtime(); if ((k) > 0 && ((PROBE_STAMP >> ((k) - 1)) & 1)) MISC[17] += now_ - MISC[16]; MISC[16] = now_; } } while (0)
#else
#define STAMP(k) do { } while (0)
#endif

    STAMP(0);
    if (IN(0)) {
        if (MOD_V2 && F.G == 256) p0_mod2(F, args); else p0_mod(F, args);
        if (!CMAX_LAST) p0_pos(F);
        p0_small(F, args);
#if defined(PROBE_READ)
        probe_read(F, args);
#endif
#if defined(PROBE_P0A)
        p0_mod(F, args); p0_pos(F); p0_small(F, args);
#endif
        if (FFN_I8) { if (!CMAX_LAST) p0_cmax(F, args);
            p0_transpose_range(F, args, RKV_I8 ? (WO_I8 ? TI_RWKV : TI_RKV3) : 0, TI_RWKV, F.gw, F.NGW, (LAS unsigned*)(F.lds + 53248 + F.wave * 8448));
            p0_transpose_range(F, args, POOL_I8 ? TI_POOL : TI_F3, F.G == 256 ? TI_V0 : (FFN_DN_I8 ? TI_MW2 : TI_M2), F.gw, F.NGW, (LAS unsigned*)(F.lds + 53248 + F.wave * 8448));
            if (CMAX_LAST) { p0_cmax(F, args); p0_pos(F); } }
        else p0_transpose_range(F, args, 0, F.G == 256 ? TI_V0 : (FFN_DN_I8 ? TI_MW2 : TI_M2), F.gw, F.NGW, (LAS unsigned*)(F.lds + 53248 + F.wave * 8448));
    }
    SEAM(0);
    STAMP(1);
    if (IN(1)) { if (POOL_I8) p0_transpose_range<true>(F, args, TI_F3, TI_POOL, F.gw, F.NGW, (LAS unsigned*)(F.lds + 53248 + F.wave * 8448));
        if (RKV_I8) p0_transpose_range<true>(F, args, 0, WO_I8 ? TI_RWKV + F13_P1_N : TI_RKV3, F.gw, F.NGW, (LAS unsigned*)(F.lds + 53248 + F.wave * 8448)); p1_mix(F, args); }
    SEAM(1);
    STAMP(2);
    if (IN(2)) {
        const bool split = F.G == 256;
        if (FFN_I8 && !split) p0_transpose_range<true>(F, args, TI_RWKV + (WO_I8 ? F13_P1_N : 0), TI_F3, F.gw, F.NGW, (LAS unsigned*)(F.lds + 53248 + F.wave * 8448));
        if (split && (int)blockIdx.x >= NC_P2) {
            if (FFN_I8) p0_transpose_range<true>(F, args, TI_RWKV + (WO_I8 ? F13_P1_N : 0), TI_F3, ((int)blockIdx.x - NC_P2) * 8 + F.wave, (256 - NC_P2) * 8, (LAS unsigned*)(F.lds + 53248 + F.wave * 8448));
            p0_transpose_range(F, args, TI_X0, TI_X1, ((int)blockIdx.x - NC_P2) * 8 + F.wave, (256 - NC_P2) * 8, (LAS unsigned*)(F.lds + 53248 + F.wave * 8448)); }
        else if (RKV_I8 && LORA_I8) { SchedP2 S; S.ws = F.ws; S.G = split ? NC_P2 : F.G; S.c = blockIdx.x;
            pg8::gemm_phase<pg8::EpiActI8, SchedP2, AL_I8, SP, 2>(F.lds, pg8::Shape{D, D, D / 128, 0}, S, pg8::EpiActI8{}); }
        else if (RKV_I8) { SchedP2 S; S.ws = F.ws; S.G = split ? NC_P2 : F.G; S.c = blockIdx.x; S.hi = 832;
            pg8::gemm_phase<pg8::EpiActI8, SchedP2, AL_I8, SP, 2>(F.lds, pg8::Shape{D, D, D / 128, 0}, S, pg8::EpiActI8{});
            SchedP2 S2; S2.ws = F.ws; S2.c = blockIdx.x; S2.lo = 832; if (split) { S2.G = 104; S2.coff = 130; } else S2.G = F.G;
            pg8::gemm_phase<pg8::EpiAct, SchedP2, AL, SP>(F.lds, pg8::shape_bf16(D, D, D), S2, pg8::EpiAct{}); }
        else { SchedP2 S; S.ws = F.ws; S.G = split ? NC_P2 : F.G; S.c = blockIdx.x; pg8::gemm_phase<pg8::EpiAct, SchedP2, AL, SP>(F.lds, pg8::shape_bf16(D, D, D), S, pg8::EpiAct{}); }
    }
    SEAM(2);
    STAMP(3);
    if (IN(3) && CONV_P3 > 0 && F.G == 256 && (int)blockIdx.x >= NC_P3) p0_transpose_range(F, args, TI_V0, TI_W0, ((int)blockIdx.x - NC_P3) * 8 + F.wave, (256 - NC_P3) * 8, (LAS unsigned*)(F.lds + 53248 + F.wave * 8448));
    else if (IN(3)) { SchedP3 S; S.ws = F.ws; S.dw0 = args.in[I_DW0]; S.ia0 = args.in[I_IA0]; S.G = (CONV_P3 > 0 && F.G == 256) ? NC_P3 : F.G; S.c = blockIdx.x;
#ifndef P3_KSKIP
#define P3_KSKIP 0
#endif
        if (P3_KSKIP) { S.hi = 1152; S.kskip = 1; pg8::gemm_phase<pg8::EpiAct, SchedP3, AL, SP>(F.lds, pg8::shape_bf16(256, 256, 128), S, pg8::EpiAct{});
            SchedP3 S2 = S; S2.lo = 1152; S2.hi = 1408; S2.kskip = 0; pg8::gemm_phase<pg8::EpiAct, SchedP3, AL, SP>(F.lds, pg8::shape_bf16(256, 256, 256), S2, pg8::EpiAct{}); }
        else pg8::gemm_phase<pg8::EpiAct, SchedP3, AL, SP>(F.lds, pg8::shape_bf16(256, 256, 256), S, pg8::EpiAct{}); }
    SEAM(3);
    STAMP(4);
#if defined(PROBE_SCANCHK)
    if (IN(4)) { p4_scan(F, args); p4_scan2(F, args, F.ws + A_AO, (float*)(F.ws + WS_A + 644 * MiB)); xcd_barrier(bar); p4_compare(F); }
#elif defined(SCAN_STEP)
    if (IN(4)) p4_scan(F, args);
#else
#if defined(SCAN_CONV)
    if (IN(4)) { if (F.G == 256) p4_scan3(F, args, F.ws + A_YD, (float*)(F.ws + WS_SB), TI_W0, TI_X0); else p4_scan2(F, args, F.ws + A_YD, (float*)(F.ws + WS_SB)); }
#elif defined(SCAN_NOCONV)
    if (IN(4)) { if (F.G == 256) p4_scan4(F, args, F.ws + A_YD, (float*)(F.ws + WS_SB)); else p4_scan2(F, args, F.ws + A_YD, (float*)(F.ws + WS_SB)); }
#else
#ifndef SCAN_SPLIT
#define SCAN_SPLIT 0
#endif
    if (IN(4) && SCAN_SPLIT && F.G == 256) {
        if ((int)blockIdx.x < 128) { p4_scan5(F, args, F.ws + A_YD, (float*)(F.ws + WS_SB), 0, 0, (int)blockIdx.x); p4_scan5(F, args, F.ws + A_YD, (float*)(F.ws + WS_SB), 0, 0, (int)blockIdx.x + 128); }
        else p0_transpose_range(F, args, TI_W0, TI_X0, ((int)blockIdx.x - 128) * 8 + F.wave, 128 * 8, (LAS unsigned*)(F.lds + 53248 + F.wave * 8448));
    } else
    if (IN(4)) { if (F.G == 256) p4_scan5(F, args, F.ws + A_YD, (float*)(F.ws + WS_SB), TI_W0, TI_X0); else p4_scan2(F, args, F.ws + A_YD, (float*)(F.ws + WS_SB)); }
#endif
#endif
    SEAM(4);
    STAMP(5);
    if (IN(5)) p5_ao(F, args);
    SEAM(5);
    STAMP(6);
    if (IN(6)) { SchedDense S; S.A = (const char*)F.ws + A_AO; S.B = (const char*)F.ws + W_WO; S.O = (bf16_t*)(F.ws + A_YO); S.bias = nullptr; S.nM = 32; S.nN = 8; S.ldaB = 2 * D; S.ldbB = 2 * D; S.ldc = D; S.act = pg8::ACT_NONE; S.G = F.G; S.c = blockIdx.x;
        if (LN_FUSE && F.G == 256) { const float* MOD = (const float*)(F.ws + WS_MOD);
            pg8::EpiLnMod E{args.in[I_X], (const float*)(F.ws + WS_POS), MOD + 2 * D, args.in[I_LNW], args.in[I_LNB], MOD + 4 * D, MOD + 3 * D, (float*)(F.ws + WS_XR), (bf16_t*)(F.ws + A_H2),
                            pg8::PanelStats8{(unsigned*)(F.ws + WS_XB1), F.ctl + CW_LN1, F.ctl, 0x700u}};
            pg8::gemm_phase<pg8::EpiLnMod, SchedDense, AL, SP>(F.lds, pg8::shape_bf16(D, D, D), S, E); }
        else if (WO_I8) { S.ldaB = D; S.ldbB = D; S.rs = (const float*)(F.ws + WS_RSO); S.bias = (const float*)(F.ws + WS_CTL) + CW_CMAX2 + 3 * D;
            pg8::gemm_phase<pg8::EpiActI8, SchedDense, AL, SP, 2>(F.lds, pg8::Shape{D, D, D / 128, 0}, S, pg8::EpiActI8{}); }
        else pg8::gemm_phase<pg8::EpiAct, SchedDense, AL, SP>(F.lds, pg8::shape_bf16(D, D, D), S, pg8::EpiAct{}); }
    SEAM(6);
    STAMP(7);
    if (IN(7) && !(LN_FUSE && F.G == 256)) { const float* MOD = (const float*)(F.ws + WS_MOD); post_norm_rows(F, args, (const bf16_t*)(F.ws + A_YO), 2 * D, 0, MOD, 3 * D, 4 * D, (void*)(F.ws + A_H2), FFN_I8 ? 2 : (FFN_FP8 != 0), true); }
    if (!(LN_FUSE && F.G == 256)) SEAM(7);
    STAMP(8);
    if (IN(8)) {
        const bool split = F.G == 256;
        if (FFN_DN_I8 && !split) p0_transpose_range<true>(F, args, TI_MW2, TI_M2, F.gw, F.NGW, (LAS unsigned*)(F.lds + 53248 + F.wave * 8448));
        if (split && (int)blockIdx.x >= NC_P8) { p0_transpose_range<FFN_DN_I8 != 0>(F, args, TI_MW2, TI_M2, ((int)blockIdx.x - NC_P8) * 8 + F.wave, (256 - NC_P8) * 8, (LAS unsigned*)(F.lds + 53248 + F.wave * 8448));
            p0_transpose_range(F, args, TI_X1, TI_C15, ((int)blockIdx.x - NC_P8) * 8 + F.wave, (256 - NC_P8) * 8, (LAS unsigned*)(F.lds + 53248 + F.wave * 8448)); }
        else { SchedDense S; S.A = (const char*)F.ws + A_H2; S.B = (const char*)F.ws + W_F13; S.O = (bf16_t*)(F.ws + A_U); S.bias = nullptr; S.nM = 32; S.nN = 44; S.ldaB = (FFN_FP8 || FFN_I8) ? D : 2 * D; S.ldbB = S.ldaB; S.ldc = LDU; S.act = 0; S.G = split ? NC_P8 : F.G; S.c = blockIdx.x;
        if (FFN_I8 && FFN_D8) pg8::gemm_phase<pg8::EpiSwigluI8T<true>, SchedDense, AL_I8, SP, 2>(F.lds, pg8::Shape{D, D, D / 128, 0}, S, pg8::EpiSwigluI8T<true>{(const float*)(F.ws + WS_RS), F.ctl + CW_CMAX, DFF});
        else if (FFN_I8) pg8::gemm_phase<pg8::EpiSwigluI8, SchedDense, AL_I8, SP, 2>(F.lds, pg8::Shape{D, D, D / 128, 0}, S, pg8::EpiSwigluI8{(const float*)(F.ws + WS_RS), F.ctl + CW_CMAX, DFF});
        else if (FFN_FP8) pg8::gemm_phase<pg8::EpiSwiglu8, SchedDense, AL, SP, true>(F.lds, pg8::shape_fp8(D, D, D, 4, 6), S, pg8::EpiSwiglu8{});
        else if (FFN_DN8) pg8::gemm_phase<pg8::EpiSwiglu8, SchedDense, AL, SP>(F.lds, pg8::shape_bf16(D, D, D), S, pg8::EpiSwiglu8{});
        else pg8::gemm_phase<pg8::EpiSwiglu, SchedDense, AL, SP>(F.lds, pg8::shape_bf16(D, D, D), S, pg8::EpiSwiglu{}); } }
    SEAM(8);
    STAMP(9);
    if (IN(9)) { SchedDense S; S.A = (const char*)F.ws + A_U; S.B = (const char*)F.ws + W_F2P; S.O = (bf16_t*)(F.ws + A_YF); S.bias = nullptr; S.nM = 32; S.nN = 8; S.ldaB = FFN_D8 ? LDU : 2 * LDU; S.ldbB = FFN_D8 ? LDF2 : 2 * LDF2; S.ldc = D; S.act = pg8::ACT_NONE; S.G = F.G; S.c = blockIdx.x;
        if (FFN_DN_I8) { p9_quant_u(F); xcd_barrier(bar);
            S.ldaB = 2 * LDU; S.ldbB = LDF2; S.rs = (const float*)(F.ws + WS_RSU); S.bias = (const float*)(F.ws + WS_CTL) + CW_CMAX3;
            pg8::gemm_phase<pg8::EpiActI8, SchedDense, AL, SP, 2>(F.lds, pg8::Shape{2 * LDU, LDF2, DFF / 128, 0}, S, pg8::EpiActI8{}); }
        else if (FFN_D8) pg8::gemm_phase<pg8::EpiAct, SchedDense, AL, SP, true>(F.lds, pg8::shape_fp8(LDU, LDF2, DFF, 3, 8), S, pg8::EpiAct{});
        else if (LN_FUSE && F.G == 256) { const float* MOD = (const float*)(F.ws + WS_MOD); const float* MOD1 = MOD + (size_t)5 * MOD_N;
            pg8::EpiLnMod E{(const float*)(F.ws + WS_XR), nullptr, MOD + 5 * D, args.in[I_LNW] + D, args.in[I_LNB] + D, MOD1 + D, MOD1, (float*)(F.ws + WS_XR), (bf16_t*)(F.ws + A_HP),
                            pg8::PanelStats8{(unsigned*)(F.ws + WS_XB2), F.ctl + CW_LN2, F.ctl, 0x740u}};
            pg8::gemm_phase<pg8::EpiLnMod, SchedDense, AL, SP>(F.lds, pg8::shape_bf16(LDU, LDF2, DFF), S, E); }
        else pg8::gemm_phase<pg8::EpiAct, SchedDense, AL, SP>(F.lds, pg8::shape_bf16(LDU, LDF2, DFF), S, pg8::EpiAct{}); }
    SEAM(9);
    STAMP(10);
    if (IN(10) && !(LN_FUSE && F.G == 256)) { const float* MOD = (const float*)(F.ws + WS_MOD); post_norm_rows(F, args, (const bf16_t*)(F.ws + A_YF), 5 * D, 1, MOD + (size_t)5 * MOD_N, 0, D, (void*)(F.ws + A_HP), false, false); }
    if (!(LN_FUSE && F.G == 256)) SEAM(10);
    STAMP(11);
    if (IN(11)) { if (POOL_SLIDE && !POOL_I8) p11_pool4(F); else p11_pool(F); }
    SEAM(11);
    STAMP(12);
    if (IN(12)) { SchedPool S; S.ws = F.ws; S.scale = args.in[I_POOLS]; S.G = F.G; S.c = blockIdx.x;
        if (POOL_I8) { pg8::EpiActI8 E; E.colmul = args.in[I_POOLS]; pg8::gemm_phase<pg8::EpiActI8, SchedPool, AL, SP, 2>(F.lds, pg8::Shape{D, 512, 512 / 128, 0}, S, E); }
        else pg8::gemm_phase<pg8::EpiAct, SchedPool, AL, SP>(F.lds, pg8::shape_bf16(D, 512, 512), S, pg8::EpiAct{}); }
    SEAM(12);
    STAMP(13);
    if (IN(13)) p13_norm_router(F, args);
    SEAM(13);
    STAMP(14);
    if (IN(14)) p14_gather(F);
    SEAM(14);
    STAMP(15);
    if (IN(15) && CONV_P15 > 0 && F.G == 256 && (int)blockIdx.x >= NC_P15) p0_transpose_range(F, args, TI_C15, TI_MW2, ((int)blockIdx.x - NC_P15) * 8 + F.wave, (256 - NC_P15) * 8, (LAS unsigned*)(F.lds + 53248 + F.wave * 8448));
    else if (IN(15)) { SchedMoe S; S.tb = moe_tab(F); S.A = (const char*)F.ws + A_HG; S.B = (const char*)F.ws + W_M13; S.O = (bf16_t*)(F.ws + A_UG); S.NT = 56; S.mblock = 0; S.ldaB = MOE_FP8 ? D : 2 * D; S.ldbB = S.ldaB; S.ldc = LDUG; S.estride = (size_t)2 * DFE * S.ldbB; S.init((CONV_P15 > 0 && F.G == 256) ? NC_P15 : F.G, blockIdx.x);
        if (MOE_FP8) pg8::gemm_phase<pg8::EpiSwiglu8, SchedMoe, AL_P15, SP, true, MOE_AUX_UP>(F.lds, pg8::shape_fp8(D, D, D, 4, 6), S, pg8::EpiSwiglu8{});
        else pg8::gemm_phase<pg8::EpiSwiglu, SchedMoe, AL, SP>(F.lds, pg8::shape_bf16(D, D, D), S, pg8::EpiSwiglu{}); }
    SEAM(15);
    STAMP(16);
    if (IN(16)) { SchedMoe S; const MoeTab full = moe_tab(F); const bool splitk = MOE_FP8 && F.G == 256 && full.ntile > MOE_RT;
        S.tb = splitk ? moe_tab_trunc(full, MOE_RT) : full; S.A = (const char*)F.ws + A_UG; S.B = (const char*)F.ws + W_M2; S.O = (bf16_t*)(F.ws + A_Y2); S.NT = 8; S.mblock = 1; S.ldaB = MOE_FP8 ? LDUG : 2 * LDUG; S.ldbB = MOE_FP8 ? LDM2 : 2 * LDM2; S.ldc = D; S.estride = (size_t)D * S.ldbB; S.init(F.G, blockIdx.x);
        if (MOE_FP8) pg8::gemm_phase<pg8::EpiAct, SchedMoe, AL, SP, true, MOE_AUX_DN>(F.lds, pg8::shape_fp8(LDUG, LDM2, DFE, 3, 8), S, pg8::EpiAct{});
        else pg8::gemm_phase<pg8::EpiAct, SchedMoe, AL, SP>(F.lds, pg8::shape_bf16(LDUG, LDM2, DFE), S, pg8::EpiAct{});
        if (splitk) { SchedMoeX X; X.tb = full; X.A = S.A; X.B = S.B; X.P = (float*)(F.ws + WS_PART); X.rt = MOE_RT; X.ldaB = LDUG; X.ldbB = LDM2; X.G = F.G; X.c = blockIdx.x; X.estride = S.estride;
            pg8::gemm_phase<pg8::EpiF32P, SchedMoeX, AL, SP, true>(F.lds, pg8::shape_fp8(LDUG, LDM2, DFE / MOE_KS, 3, 8), X, pg8::EpiF32P{}); } }
    STAMP(17);
#if defined(PROBE_STAMP)
    if (blockIdx.x == 0 && threadIdx.x == 0) __hip_atomic_store(F.ctl + 24576, MISC[17], __ATOMIC_RELAXED, __HIP_MEMORY_SCOPE_AGENT);
#endif
    SEAM(16);
    if (IN(17)) p17_final(F, args);
#undef IN
#undef SEAM
}

extern "C" void kernel_launch(void* const* d_in, const int* in_sizes, int n_in, void* d_out, int out_size, void* d_ws, size_t ws_size, hipStream_t stream) {
    static int grid = 0;
    if (grid == 0) {
        if (n_in != 35 || out_size != ML * D || ws_size < WS_END) { fprintf(stderr, "kernel_launch: unexpected problem (n_in %d, out %d, ws %zu < %zu); nothing launched\n", n_in, out_size, ws_size, (size_t)WS_END); grid = -1; return; }
        int dev = 0, cus = 0, per_cu = 0;
        if (hipGetDevice(&dev) != hipSuccess || hipDeviceGetAttribute(&cus, hipDeviceAttributeMultiprocessorCount, dev) != hipSuccess) { grid = -1; return; }
        if (hipFuncSetAttribute((const void*)trunk_fwd, hipFuncAttributeMaxDynamicSharedMemorySize, LDS_BYTES) != hipSuccess) { fprintf(stderr, "kernel_launch: hipFuncSetAttribute failed\n"); grid = -1; return; }
        if (hipOccupancyMaxActiveBlocksPerMultiprocessor(&per_cu, (const void*)trunk_fwd, 512, LDS_BYTES) != hipSuccess || per_cu < 1) fprintf(stderr, "kernel_launch: occupancy query reports %d\n", per_cu);
        (void)hipGetLastError();
        grid = cus;
    }
    if (grid < 0) return;
    if (hipMemsetAsync((char*)d_ws + WS_CTL, 0, CTL_ZERO_BYTES, stream) != hipSuccess) return;
    Args a{};
    for (int i = 0; i < 35; ++i) a.in[i] = (const float*)d_in[i];
    a.out = (float*)d_out; a.ws = (unsigned char*)d_ws;
#if defined(PROBE_DUP)
    a.ph_lo = 0; a.ph_hi = PROBE_DUP + 1; a.li = 0; hipLaunchKernelGGL(trunk_fwd, dim3(grid), dim3(512), LDS_BYTES, stream, a);
    a.ph_lo = PROBE_DUP; a.ph_hi = NPHASE; a.li = 1; hipLaunchKernelGGL(trunk_fwd, dim3(grid), dim3(512), LDS_BYTES, stream, a);
#else
    if (MK_N_LAUNCHES == 1) { a.ph_lo = 0; a.ph_hi = NPHASE; hipLaunchKernelGGL(trunk_fwd, dim3(grid), dim3(512), LDS_BYTES, stream, a); }
#endif
#if !defined(PROBE_DUP)
    else for (int p = 0; p < NPHASE; ++p) { a.ph_lo = p; a.ph_hi = p + 1; hipLaunchKernelGGL(trunk_fwd, dim3(grid), dim3(512), LDS_BYTES, stream, a); }
#endif
}
```

```cpp
#define FFN_I8 1
#define RKV_I8 1
#define WO_I8 1
#define LORA_I8 1
#define FFN_DN8 1
#define F13_P1_N 384
#define CMAX_LAST 1
#define P3_KSKIP 1
#define POOL_SLIDE 1
#define LN_HOIST 1
#define NC_P2 188
#define CONV_P2 6912
#define NC_P8 202
#define CONV_P8 (TN_F2+8192)
#define CONV_P15 12288
#define NC_P15 224
#define CONV_SCAN 15616
#include <hip/hip_runtime.h>
#include <cstdio>
#include <cstdint>

#ifndef MK_N_LAUNCHES
#define MK_N_LAUNCHES 1
#endif

#define LAS __attribute__((address_space(3)))
#define PG8_LAS __attribute__((address_space(3)))
typedef unsigned short bf16_t;
typedef short bf16x8 __attribute__((ext_vector_type(8)));
typedef float f32x4 __attribute__((ext_vector_type(4)));
typedef float f32x2 __attribute__((ext_vector_type(2)));
typedef unsigned u32x4 __attribute__((ext_vector_type(4)));
typedef unsigned u32x2 __attribute__((ext_vector_type(2)));
typedef int i32x8 __attribute__((ext_vector_type(8)));
typedef int i32x4 __attribute__((ext_vector_type(4)));

constexpr int D = 2048, NB = 4, T = 2048, TC = 256, NH = 32, HS = 64;
constexpr int ML = NB * T;
constexpr int MC = NB * TC;
constexpr int MT = ML + MC;
constexpr int DFF = 5632, DFE = 7168, NE = 8;
constexpr int MOD_N = 6 * D;
constexpr int MROWS_PAD = 2 * ML + NE * 256;
constexpr float ALPHA = 1.41421356237309515f;
constexpr float LN_EPS = 1e-5f, GN_EPS = 64e-5f;

__device__ __forceinline__ unsigned f2bf(float f) { unsigned u = __builtin_bit_cast(unsigned, f); return (u + 0x7fffu + ((u >> 16) & 1u)) >> 16; }
typedef __bf16 bf16x2v __attribute__((ext_vector_type(2)));
__device__ __forceinline__ unsigned pk2(float lo, float hi) { const f32x2 v = {lo, hi}; return __builtin_bit_cast(unsigned, __builtin_convertvector(v, bf16x2v)); }
__device__ __forceinline__ float clamp8(float x) { return __builtin_amdgcn_fmed3f(x, -440.f, 440.f); }
__device__ __forceinline__ unsigned pk4_fp8(float a, float b, float c, float d) { int v = __builtin_amdgcn_cvt_pk_fp8_f32(clamp8(a), clamp8(b), 0, false); v = __builtin_amdgcn_cvt_pk_fp8_f32(clamp8(c), clamp8(d), v, true); return (unsigned)v; }
__device__ __forceinline__ unsigned pk4_fp8_nc(float a, float b, float c, float d) { int v = __builtin_amdgcn_cvt_pk_fp8_f32(a, b, 0, false); v = __builtin_amdgcn_cvt_pk_fp8_f32(c, d, v, true); return (unsigned)v; }
__device__ __forceinline__ unsigned pk4_i8(float a, float b, float c, float d) {
    const unsigned ua = __builtin_bit_cast(unsigned, a + 12582912.0f), ub = __builtin_bit_cast(unsigned, b + 12582912.0f), uc = __builtin_bit_cast(unsigned, c + 12582912.0f), ud = __builtin_bit_cast(unsigned, d + 12582912.0f);
    const unsigned lo = __builtin_amdgcn_perm(ub, ua, 0x0c0c0400u), hi = __builtin_amdgcn_perm(ud, uc, 0x0c0c0400u);
    return __builtin_amdgcn_perm(hi, lo, 0x05040100u);
}
__device__ __forceinline__ float bflo(unsigned w) { return __builtin_bit_cast(float, w << 16); }
__device__ __forceinline__ float bfhi(unsigned w) { return __builtin_bit_cast(float, w & 0xffff0000u); }
__device__ __forceinline__ float fexp(float x) { return __builtin_amdgcn_exp2f(x * 1.44269504088896341f); }
__device__ __forceinline__ float flog(float x) { return __builtin_amdgcn_logf(x) * 0.69314718055994531f; }
__device__ __forceinline__ float sigmoidf_(float x) { return __builtin_amdgcn_rcpf(1.0f + fexp(-x)); }
__device__ __forceinline__ float siluf_(float x) { return x * __builtin_amdgcn_rcpf(1.0f + fexp(-x)); }
__device__ __forceinline__ float tanhf_(float x) { return 1.0f - 2.0f * __builtin_amdgcn_rcpf(1.0f + fexp(2.0f * x)); }
__device__ __forceinline__ int lane_id() { int l; asm volatile("v_mbcnt_lo_u32_b32 %0, -1, 0\n\tv_mbcnt_hi_u32_b32 %0, -1, %0" : "=v"(l)); return l; }
template <int CTRL> __device__ __forceinline__ float dpp_f(float v) { return __builtin_bit_cast(float, __builtin_amdgcn_update_dpp(0, __builtin_bit_cast(int, v), CTRL, 0xF, 0xF, true)); }
__device__ __forceinline__ float wave_sum(float v) {
#pragma unroll
    for (int o = 1; o < 64; o <<= 1) v += __shfl_xor(v, o);
    return v;
}
__device__ __forceinline__ float row_max16(float v) {
    v = fmaxf(v, dpp_f<0xB1>(v)); v = fmaxf(v, dpp_f<0x4E>(v)); v = fmaxf(v, dpp_f<0x141>(v)); v = fmaxf(v, dpp_f<0x140>(v)); return v;
}
__device__ __forceinline__ float wave_max(float v) {
    v = fmaxf(v, dpp_f<0xB1>(v)); v = fmaxf(v, dpp_f<0x4E>(v)); v = fmaxf(v, dpp_f<0x141>(v)); v = fmaxf(v, dpp_f<0x140>(v));
    v = fmaxf(v, __shfl_xor(v, 16)); v = fmaxf(v, __shfl_xor(v, 32)); return v;
}
__device__ __forceinline__ float sum8(float v) {
    v += dpp_f<0xB1>(v);
    v += dpp_f<0x4E>(v);
    v += dpp_f<0x141>(v);
    return v;
}
__device__ __forceinline__ const char* uptr(const void* p) {
    unsigned long long v = (unsigned long long)p;
    unsigned lo = (unsigned)__builtin_amdgcn_readfirstlane((int)(unsigned)v), hi = (unsigned)__builtin_amdgcn_readfirstlane((int)(unsigned)(v >> 32));
    return (const char*)(((unsigned long long)hi << 32) | lo);
}

namespace pg8 {
constexpr int BM = 256, BK = 64, HALF = 128, HTB = HALF * BK * 2  , STAGE_BYTES = 8 * HTB, NXCD = 8, WGM = 8;
__host__ __device__ __forceinline__ int lds_byte(int r, int c) { const int st = (r >> 4) * 2 + (c >> 5), rr = r & 15, cc = c & 31, ob = rr * 64 + cc * 2; return st * 1024 + (ob ^ (((ob >> 9) & 1) << 5)); }
__host__ __device__ __forceinline__ void stage_rc(int b, int& R, int& C) { const int st = b / 1024, sb = b % 1024, swz = sb ^ (((sb >> 9) & 1) << 5); R = (st >> 1) * 16 + swz / 64; C = (st & 1) * 32 + (swz % 64) / 2; }
__host__ __device__ __forceinline__ int perm32(int rho) { const int n = rho >> 4, i = rho & 15; return 8 * (i >> 2) + 4 * n + (i & 3); }
__device__ __forceinline__ unsigned cvt_pk_bf16(float lo, float hi) { unsigned r; asm volatile("v_cvt_pk_bf16_f32 %0, %1, %2" : "=v"(r) : "v"(lo), "v"(hi)); return r; }

struct Unit { const char* A; const char* B; bf16_t* O; const float* bias; const float* rs  ; int pm, pn, ldc, act; };
struct Shape { int ldaB, ldbB, nt, sc; };
__host__ __device__ __forceinline__ Shape shape_bf16(int lda, int ldb, int K) { return Shape{2 * lda, 2 * ldb, K / 64, 0}; }
__host__ __device__ __forceinline__ Shape shape_fp8(int lda, int ldb, int K, int ea, int eb) { return Shape{lda, ldb, K / 128, ((127 - ea) << 8) | (127 - eb)}; }

__device__ __forceinline__ void tile_of(int l, int nM, int nN, int& pm, int& pn) {
    const int nwg = nM * nN; int wgid = l;
    { const int q = nwg / NXCD, r = nwg % NXCD, xcd = wgid % NXCD, off = wgid / NXCD; wgid = (xcd < r ? xcd * (q + 1) : r * (q + 1) + (xcd - r) * q) + off; }
    const int nig = WGM * nN, gid = wgid / nig, fm = gid * WGM, gsz = (nM - fm) < WGM ? (nM - fm) : WGM;
    pm = fm + ((wgid % nig) % gsz); pn = (wgid % nig) / gsz;
}

enum Act { ACT_NONE = 0, ACT_TANH = 1, ACT_SIGMOID = 2, ACT_EW = 3, ACT_BIAS_SIGMOID = 4, ACT_COLSCALE = 5 };
__device__ __forceinline__ float act_apply(float v, float b, int act) {
    if (act == ACT_TANH) return tanhf_(v);
    if (act == ACT_SIGMOID) return sigmoidf_(v);
    if (act == ACT_EW) return 0.60653065971263342f * sigmoidf_(v + b);
    if (act == ACT_BIAS_SIGMOID) return sigmoidf_(v + b);
    if (act == ACT_COLSCALE) return v * b;
    return v;
}
struct EpiAct {
    static constexpr bool PERM = true, AFTER_DRAIN = false;
    __device__ __forceinline__ void operator()(const f32x4 (&acc)[2][2][4][2], const Unit& u, int wr, int wc) const {
        const int lane_ = lane_id(), fr = lane_ & 15, fq = lane_ >> 4;
        const int row0 = u.pm * BM + wr * 64 + fr, col0 = u.pn * BM + wc * 32 + 8 * fq; const int act = u.act;
        f32x4 bv[2][2];
#pragma unroll
        for (int bj = 0; bj < 2; ++bj)
#pragma unroll
            for (int n = 0; n < 2; ++n) bv[bj][n] = u.bias ? *(const f32x4*)(u.bias + col0 + bj * HALF + 4 * n) : (f32x4){0.f, 0.f, 0.f, 0.f};
#pragma unroll
        for (int ai = 0; ai < 2; ++ai)
#pragma unroll
            for (int m = 0; m < 4; ++m) { bf16_t* rowp = u.O + (size_t)(row0 + ai * HALF + m * 16) * u.ldc + col0;
#pragma unroll
                for (int bj = 0; bj < 2; ++bj) { f32x4 v0 = acc[ai][bj][m][0], v1 = acc[ai][bj][m][1];
                    if (act != ACT_NONE) {
#pragma unroll
                        for (int j = 0; j < 4; ++j) { v0[j] = act_apply(v0[j], bv[bj][0][j], act); v1[j] = act_apply(v1[j], bv[bj][1][j], act); } }
                    u32x4 w; w.x = cvt_pk_bf16(v0[0], v0[1]); w.y = cvt_pk_bf16(v0[2], v0[3]); w.z = cvt_pk_bf16(v1[0], v1[1]); w.w = cvt_pk_bf16(v1[2], v1[3]);
                    *(u32x4*)(rowp + bj * HALF) = w; } }
    }
};
struct EpiActI8 {
    static constexpr bool PERM = true, AFTER_DRAIN = false;
    const float* colmul = nullptr;
    __device__ __forceinline__ void operator()(const f32x4 (&acc)[2][2][4][2], const Unit& u, int wr, int wc) const {
        const int lane_ = lane_id(), fr = lane_ & 15, fq = lane_ >> 4;
        const int row0 = u.pm * BM + wr * 64 + fr, col0 = u.pn * BM + wc * 32 + 8 * fq;
        f32x4 bv[2][2];
#pragma unroll
        for (int bj = 0; bj < 2; ++bj)
#pragma unroll
            for (int n = 0; n < 2; ++n) { bv[bj][n] = *(const f32x4*)(u.bias + col0 + bj * HALF + 4 * n) * (1.0f / 127.0f); if (colmul) bv[bj][n] = bv[bj][n] * *(const f32x4*)(colmul + col0 + bj * HALF + 4 * n); }
#pragma unroll
        for (int ai = 0; ai < 2; ++ai)
#pragma unroll
            for (int m = 0; m < 4; ++m) { const int r = row0 + ai * HALF + m * 16; bf16_t* rowp = u.O + (size_t)r * u.ldc + col0; const float rv = u.rs[r];
#pragma unroll
                for (int bj = 0; bj < 2; ++bj) {
                    f32x4 v0 = __builtin_convertvector(__builtin_bit_cast(i32x4, acc[ai][bj][m][0]), f32x4) * (bv[bj][0] * rv), v1 = __builtin_convertvector(__builtin_bit_cast(i32x4, acc[ai][bj][m][1]), f32x4) * (bv[bj][1] * rv);
                    if (u.act != ACT_NONE) {
#pragma unroll
                        for (int j = 0; j < 4; ++j) { v0[j] = act_apply(v0[j], 0.f, u.act); v1[j] = act_apply(v1[j], 0.f, u.act); } }
                    u32x4 w; w.x = cvt_pk_bf16(v0[0], v0[1]); w.y = cvt_pk_bf16(v0[2], v0[3]); w.z = cvt_pk_bf16(v1[0], v1[1]); w.w = cvt_pk_bf16(v1[2], v1[3]);
                    *(u32x4*)(rowp + bj * HALF) = w; } }
    }
};
struct EpiF32P {
    static constexpr bool PERM = true, AFTER_DRAIN = false;
    __device__ __forceinline__ void operator()(const f32x4 (&acc)[2][2][4][2], const Unit& u, int wr, int wc) const {
        const int lane_ = lane_id(), fr = lane_ & 15, fq = lane_ >> 4;
        const int row0 = u.pm * BM + wr * 64 + fr, col0 = u.pn * BM + wc * 32 + 8 * fq;
#pragma unroll
        for (int ai = 0; ai < 2; ++ai)
#pragma unroll
            for (int m = 0; m < 4; ++m) { float* rowp = (float*)u.O + (size_t)(row0 + ai * HALF + m * 16) * u.ldc + col0;
#pragma unroll
                for (int bj = 0; bj < 2; ++bj) { *(f32x4*)(rowp + bj * HALF) = acc[ai][bj][m][0]; *(f32x4*)(rowp + bj * HALF + 4) = acc[ai][bj][m][1]; } }
    }
};
struct EpiSwiglu {
    static constexpr bool PERM = true, AFTER_DRAIN = false;
    __device__ __forceinline__ void operator()(const f32x4 (&acc)[2][2][4][2], const Unit& u, int wr, int wc) const {
        const int lane_ = lane_id(), fr = lane_ & 15, fq = lane_ >> 4;
        const int row0 = u.pm * BM + wr * 64 + fr, col0 = u.pn * HALF + wc * 32 + 8 * fq;
#pragma unroll
        for (int ai = 0; ai < 2; ++ai)
#pragma unroll
            for (int m = 0; m < 4; ++m) { bf16_t* rowp = u.O + (size_t)(row0 + ai * HALF + m * 16) * u.ldc + col0;
                f32x4 o0, o1;
#pragma unroll
                for (int j = 0; j < 4; ++j) { o0[j] = siluf_(acc[ai][0][m][0][j]) * acc[ai][1][m][0][j]; o1[j] = siluf_(acc[ai][0][m][1][j]) * acc[ai][1][m][1][j]; }
                u32x4 w; w.x = cvt_pk_bf16(o0[0], o0[1]); w.y = cvt_pk_bf16(o0[2], o0[3]); w.z = cvt_pk_bf16(o1[0], o1[1]); w.w = cvt_pk_bf16(o1[2], o1[3]);
                *(u32x4*)rowp = w; }
    }
};

struct EpiSwiglu8 {
    static constexpr bool PERM = true, AFTER_DRAIN = false;
    __device__ __forceinline__ void operator()(const f32x4 (&acc)[2][2][4][2], const Unit& u, int wr, int wc) const {
        const int lane_ = lane_id(), fr = lane_ & 15, fq = lane_ >> 4;
        const int row0 = u.pm * BM + wr * 64 + fr, col0 = u.pn * HALF + wc * 32 + 8 * fq;
#pragma unroll
        for (int ai = 0; ai < 2; ++ai)
#pragma unroll
            for (int m = 0; m < 4; ++m) { unsigned char* rowp = (unsigned char*)u.O + (size_t)(row0 + ai * HALF + m * 16) * u.ldc + col0;
                f32x4 o0, o1;
#pragma unroll
                for (int j = 0; j < 4; ++j) { o0[j] = siluf_(acc[ai][0][m][0][j]) * acc[ai][1][m][0][j] * 8.0f; o1[j] = siluf_(acc[ai][0][m][1][j]) * acc[ai][1][m][1][j] * 8.0f; }
                u32x2 w; w.x = pk4_fp8(o0[0], o0[1], o0[2], o0[3]); w.y = pk4_fp8(o1[0], o1[1], o1[2], o1[3]);
                *(u32x2*)rowp = w; }
    }
};

template <bool F8OUT = false>
struct EpiSwigluI8T {
    static constexpr bool PERM = true, AFTER_DRAIN = false;
    const float* rs; const unsigned* cmax; int nw;
    __device__ __forceinline__ void operator()(const f32x4 (&acc)[2][2][4][2], const Unit& u, int wr, int wc) const {
        const int lane_ = lane_id(), fr = lane_ & 15, fq = lane_ >> 4;
        const int row0 = u.pm * BM + wr * 64 + fr, col0 = u.pn * HALF + wc * 32 + 8 * fq;
        f32x4 c1[2], c3[2];
#pragma unroll
        for (int n = 0; n < 2; ++n) { c1[n] = __builtin_bit_cast(f32x4, *(const u32x4*)(cmax + col0 + 4 * n)) * (1.0f / 127.0f); c3[n] = __builtin_bit_cast(f32x4, *(const u32x4*)(cmax + nw + col0 + 4 * n)) * ((F8OUT ? 8.0f : 1.0f) / 127.0f); }
#pragma unroll
        for (int ai = 0; ai < 2; ++ai)
#pragma unroll
            for (int m = 0; m < 4; ++m) { const int r = row0 + ai * HALF + m * 16; bf16_t* rowp = u.O + (size_t)r * u.ldc + col0; const float rv = rs[r];
                f32x4 o0, o1;
                const f32x4 A0 = __builtin_convertvector(__builtin_bit_cast(i32x4, acc[ai][0][m][0]), f32x4) * (c1[0] * rv), B0 = __builtin_convertvector(__builtin_bit_cast(i32x4, acc[ai][1][m][0]), f32x4) * (c3[0] * rv);
                const f32x4 A1 = __builtin_convertvector(__builtin_bit_cast(i32x4, acc[ai][0][m][1]), f32x4) * (c1[1] * rv), B1 = __builtin_convertvector(__builtin_bit_cast(i32x4, acc[ai][1][m][1]), f32x4) * (c3[1] * rv);
#pragma unroll
                for (int j = 0; j < 4; ++j) { o0[j] = siluf_(A0[j]) * B0[j]; o1[j] = siluf_(A1[j]) * B1[j]; }
                if constexpr (F8OUT) { u32x2 w; w.x = pk4_fp8(o0[0], o0[1], o0[2], o0[3]); w.y = pk4_fp8(o1[0], o1[1], o1[2], o1[3]);
                    *(u32x2*)((unsigned char*)u.O + (size_t)r * u.ldc + col0) = w; }
                else { u32x4 w; w.x = cvt_pk_bf16(o0[0], o0[1]); w.y = cvt_pk_bf16(o0[2], o0[3]); w.z = cvt_pk_bf16(o1[0], o1[1]); w.w = cvt_pk_bf16(o1[2], o1[3]);
                    *(u32x4*)rowp = w; } }
    }
};
using EpiSwigluI8 = EpiSwigluI8T<false>;

struct PanelStats8 {
    unsigned* xbuf;
    unsigned* cnt;
    unsigned* tmo;
    unsigned code;
    __device__ __forceinline__ bool run(const f32x4 (&v)[2][2][4][2], const Unit& u, int wr, int wc, int fr, int fq, PG8_LAS unsigned char* lds, int wid, int lane) const {
        PG8_LAS f32x2* P = (PG8_LAS f32x2*)lds;
        PG8_LAS f32x2* S = (PG8_LAS f32x2*)(lds + 8192);
        PG8_LAS unsigned* flag = (PG8_LAS unsigned*)(lds + 8192 + 2048);
#pragma unroll
        for (int ai = 0; ai < 2; ++ai)
#pragma unroll
            for (int m = 0; m < 4; ++m) {
                float s = 0.f;
#pragma unroll
                for (int bj = 0; bj < 2; ++bj)
#pragma unroll
                    for (int n = 0; n < 2; ++n) { const f32x4 x = v[ai][bj][m][n]; s += (x[0] + x[1]) + (x[2] + x[3]); }
                s += __shfl_xor(s, 16); s += __shfl_xor(s, 32);
                const float mw = s * (1.0f / 64.0f); float q = 0.f;
#pragma unroll
                for (int bj = 0; bj < 2; ++bj)
#pragma unroll
                    for (int n = 0; n < 2; ++n) { const f32x4 d = v[ai][bj][m][n] - mw; q += (d[0] * d[0] + d[1] * d[1]) + (d[2] * d[2] + d[3] * d[3]); }
                q += __shfl_xor(q, 16); q += __shfl_xor(q, 32);
                if (fq == 0) P[(ai * HALF + wr * 64 + m * 16 + fr) * 4 + wc] = (f32x2){mw, q};
            }
        asm volatile("s_waitcnt lgkmcnt(0)" ::: "memory"); __builtin_amdgcn_s_barrier(); asm volatile("" ::: "memory");
        const int row = wid * 32 + (lane & 31);
        if (lane < 32) {
            const f32x2 a = P[row * 4 + 0], b = P[row * 4 + 1], c = P[row * 4 + 2], d = P[row * 4 + 3];
            const float mt = (a.x + b.x + c.x + d.x) * 0.25f;
            const float da = a.x - mt, db = b.x - mt, dc = c.x - mt, dd = d.x - mt;
            const float m2 = (a.y + b.y) + (c.y + d.y) + 64.0f * ((da * da + db * db) + (dc * dc + dd * dd));
            unsigned long long* slot = (unsigned long long*)xbuf + ((size_t)(u.pm * BM + row) * 8 + u.pn);
            __hip_atomic_store(slot, ((unsigned long long)__builtin_bit_cast(unsigned, m2) << 32) | __builtin_bit_cast(unsigned, mt), __ATOMIC_RELAXED, __HIP_MEMORY_SCOPE_AGENT);
        }
        asm volatile("s_waitcnt vmcnt(0)" ::: "memory");
        if (lane == 0) __hip_atomic_fetch_add(cnt + 64 * u.pm, 1u, __ATOMIC_RELAXED, __HIP_MEMORY_SCOPE_AGENT);
        if (wid == 0) {
            bool dead = false; const unsigned long long t0 = __builtin_amdgcn_s_memrealtime(); const unsigned want = 8u * 8u;
            for (;;) {
                if ((unsigned)__builtin_amdgcn_readfirstlane(__hip_atomic_load(cnt + 64 * u.pm, __ATOMIC_RELAXED, __HIP_MEMORY_SCOPE_AGENT)) >= want) break;
                if (__builtin_amdgcn_s_memrealtime() - t0 > 2000000ull) {
                    if (lane == 0) { unsigned expect = 0u; __hip_atomic_compare_exchange_strong(tmo + 1, &expect, code | (unsigned)(u.pm & 0xff), __ATOMIC_RELAXED, __ATOMIC_RELAXED, __HIP_MEMORY_SCOPE_AGENT);
                                     __hip_atomic_store(tmo, 1u, __ATOMIC_RELAXED, __HIP_MEMORY_SCOPE_AGENT); }
                    dead = true; break; }
                __builtin_amdgcn_s_sleep(2);
            }
            __builtin_amdgcn_fence(__ATOMIC_ACQUIRE, "agent");
            if (lane == 0) flag[0] = dead ? 1u : 0u;
        }
        asm volatile("s_waitcnt vmcnt(0) lgkmcnt(0)" ::: "memory"); __builtin_amdgcn_s_barrier(); asm volatile("" ::: "memory");
        const bool bad = flag[0] != 0u;
        if (lane < 32) {
            const unsigned long long* slot = (const unsigned long long*)xbuf + (size_t)(u.pm * BM + row) * 8; float mt[8], m2[8]; float ms = 0.f;
#pragma unroll
            for (int t = 0; t < 8; ++t) { const unsigned long long w = __hip_atomic_load(slot + t, __ATOMIC_RELAXED, __HIP_MEMORY_SCOPE_AGENT); mt[t] = __builtin_bit_cast(float, (unsigned)w); m2[t] = __builtin_bit_cast(float, (unsigned)(w >> 32)); ms += mt[t]; }
            const float mean = ms * 0.125f; float q = 0.f;
#pragma unroll
            for (int t = 0; t < 8; ++t) { const float dm = mt[t] - mean; q += m2[t] + 256.0f * dm * dm; }
            S[row] = (f32x2){mean, 1.0f / sqrtf(q * (1.0f / 2048.0f) + LN_EPS)};
        }
        asm volatile("s_waitcnt lgkmcnt(0)" ::: "memory"); __builtin_amdgcn_s_barrier(); asm volatile("" ::: "memory");
        return bad;
    }
};
struct EpiLnMod {
    static constexpr bool PERM = false, AFTER_DRAIN = true;
    const float* xin; const float* pos; const float* g; const float* lnw; const float* lnb; const float* sc; const float* sh; float* XR; bf16_t* H; PanelStats8 st;
    __device__ __forceinline__ void fused(f32x4 (&acc)[2][2][4][2], const Unit& u, int wr, int wc, int fr, int fq, PG8_LAS unsigned char* lds, int wid, int lane) const {
        const PG8_LAS f32x2* S = (const PG8_LAS f32x2*)(lds + 8192);
        const int col0 = u.pn * BM + wc * 32 + 4 * fq; const size_t mo = (size_t)(u.pm >> 3) * MOD_N;
        f32x4 gv[2][2];
#pragma unroll
        for (int bj = 0; bj < 2; ++bj)
#pragma unroll
            for (int n = 0; n < 2; ++n) gv[bj][n] = *(const f32x4*)(g + mo + col0 + bj * HALF + n * 16);
#pragma unroll
        for (int ai = 0; ai < 2; ++ai)
#pragma unroll
            for (int m = 0; m < 4; ++m) { const int r = u.pm * BM + ai * HALF + wr * 64 + m * 16 + fr; const size_t off = (size_t)r * D + col0; const size_t poff = (size_t)(r % T) * D + col0;
#pragma unroll
                for (int bj = 0; bj < 2; ++bj)
#pragma unroll
                    for (int n = 0; n < 2; ++n) { f32x4 xv = *(const f32x4*)(xin + off + bj * HALF + n * 16); if (pos) xv += *(const f32x4*)(pos + poff + bj * HALF + n * 16);
                        acc[ai][bj][m][n] = xv * ALPHA + gv[bj][n] * acc[ai][bj][m][n]; }
                asm volatile("" : "+v"(acc[ai][0][m][0]), "+v"(acc[ai][0][m][1]), "+v"(acc[ai][1][m][0]), "+v"(acc[ai][1][m][1]));
                asm volatile("" ::: "memory"); }
        const bool bad = st.run(acc, u, wr, wc, fr, fq, lds, wid, lane);
        const float qnan = __builtin_nanf("");
#pragma unroll
        for (int bj = 0; bj < 2; ++bj)
#pragma unroll
            for (int n = 0; n < 2; ++n) { const int c = col0 + bj * HALF + n * 16;
                const f32x4 w4 = *(const f32x4*)(lnw + c), b4 = *(const f32x4*)(lnb + c), s4 = *(const f32x4*)(sc + mo + c) + 1.0f, h4 = *(const f32x4*)(sh + mo + c);
#pragma unroll
                for (int ai = 0; ai < 2; ++ai)
#pragma unroll
                    for (int m = 0; m < 4; ++m) { const int rl = ai * HALF + wr * 64 + m * 16 + fr; const f32x2 sr = S[rl]; const size_t off = (size_t)(u.pm * BM + rl) * D + c;
                        f32x4 xn = (acc[ai][bj][m][n] - sr.x) * sr.y * w4 + b4; if (bad) xn = (f32x4){qnan, qnan, qnan, qnan};
                        *(f32x4*)(XR + off) = xn; const f32x4 hv = xn * s4 + h4;
                        u32x2 hw; hw.x = cvt_pk_bf16(hv[0], hv[1]); hw.y = cvt_pk_bf16(hv[2], hv[3]); *(u32x2*)(H + off) = hw; } }
    }
};

template <class Epi, class Sched, bool ALIGN_EPI = true, bool SP2 = true, int FP8 = 0  , int AUXB = 0>
__device__ __forceinline__ void gemm_phase(PG8_LAS unsigned char* lds, const Shape g, const Sched& S, const Epi& E) {
    const int lane = lane_id(), wid = __builtin_amdgcn_readfirstlane((int)(threadIdx.x >> 6)), tid = wid * 64 + lane, wr = wid >> 2, wc = wid & 3, fr = lane & 15, fq = lane >> 4;
    const int nt = g.nt;
    unsigned voffA[2], voffB[2];
#pragma unroll
    for (int i = 0; i < 2; ++i) { int R, C; stage_rc(tid * 16 + i * 8192, R, C); const int Rb = Epi::PERM ? ((R & ~31) + perm32(R & 31)) : R;
        voffA[i] = (unsigned)(R * g.ldaB + C * 2); voffB[i] = (unsigned)(Rb * g.ldbB + C * 2); }
    const size_t kstep = (size_t)(BK * 2);
    const size_t hstepA = (size_t)HALF * g.ldaB, hstepB = (size_t)HALF * g.ldbB;
    const unsigned ldsw = (unsigned)wid * 1024u;
    const int aoff = lds_byte(wr * 64 + fr, fq * 8), boff = lds_byte(wc * 32 + fr, fq * 8);
#define PG8_SA(b, h) (((b) * 2 + (h)) * HTB)
#define PG8_SB(b, h) ((4 + (b) * 2 + (h)) * HTB)
#define PG8_STAGE(bufoff, gbase, voff) do { _Pragma("unroll") for (int _i = 0; _i < 2; ++_i) \
        __builtin_amdgcn_global_load_lds((const unsigned*)((const char*)(gbase) + (voff)[_i]), (PG8_LAS unsigned*)(lds + (bufoff) + ldsw + _i * 8192), 16, 0, 0); } while (0)
#define PG8_STAGEB(bufoff, gbase, voff) do { _Pragma("unroll") for (int _i = 0; _i < 2; ++_i) \
        __builtin_amdgcn_global_load_lds((const unsigned*)((const char*)(gbase) + (voff)[_i]), (PG8_LAS unsigned*)(lds + (bufoff) + ldsw + _i * 8192), 16, 0, AUXB); } while (0)
#define PG8_LDA(dst, b, h) do { _Pragma("unroll") for (int m = 0; m < 4; ++m) _Pragma("unroll") for (int k = 0; k < 2; ++k) dst[m][k] = *(const PG8_LAS bf16x8*)(lds + PG8_SA(b, h) + aoff + m * 2048 + k * 1024); } while (0)
#define PG8_LDB(dst, b, h) do { _Pragma("unroll") for (int n = 0; n < 2; ++n) _Pragma("unroll") for (int k = 0; k < 2; ++k) dst[n][k] = *(const PG8_LAS bf16x8*)(lds + PG8_SB(b, h) + boff + n * 2048 + k * 1024); } while (0)
#define PG8_MMA(ai, bj, At, Bt) do { __builtin_amdgcn_s_setprio(1); _Pragma("unroll") for (int m = 0; m < 4; ++m) _Pragma("unroll") for (int n = 0; n < 2; ++n) { \
        if constexpr (FP8 == 1) { const i32x4 b0_ = __builtin_bit_cast(i32x4, Bt[n][0]), b1_ = __builtin_bit_cast(i32x4, Bt[n][1]), a0_ = __builtin_bit_cast(i32x4, At[m][0]), a1_ = __builtin_bit_cast(i32x4, At[m][1]); \
            const i32x8 B8_ = __builtin_shufflevector(b0_, b1_, 0, 1, 2, 3, 4, 5, 6, 7), A8_ = __builtin_shufflevector(a0_, a1_, 0, 1, 2, 3, 4, 5, 6, 7); \
            asm volatile("v_mfma_scale_f32_16x16x128_f8f6f4 %0, %1, %2, %0, %3, %3 op_sel:[0,1,0] op_sel_hi:[0,0,0]" : "+v"(acc[ai][bj][m][n]) : "v"(B8_), "v"(A8_), "v"(g.sc)); } \
        else if constexpr (FP8 == 2) { _Pragma("unroll") for (int k = 0; k < 2; ++k) acc[ai][bj][m][n] = __builtin_bit_cast(f32x4, __builtin_amdgcn_mfma_i32_16x16x64_i8(__builtin_bit_cast(i32x4, Bt[n][k]), __builtin_bit_cast(i32x4, At[m][k]), __builtin_bit_cast(i32x4, acc[ai][bj][m][n]), 0, 0, 0)); } \
        else { _Pragma("unroll") for (int k = 0; k < 2; ++k) acc[ai][bj][m][n] = __builtin_amdgcn_mfma_f32_16x16x32_bf16(Bt[n][k], At[m][k], acc[ai][bj][m][n], 0, 0, 0); } } \
        __builtin_amdgcn_s_setprio(0); } while (0)
#define PG8_WAIT_V(n) asm volatile("s_waitcnt vmcnt(" #n ")" ::: "memory")
#define PG8_WAIT_L(n) asm volatile("s_waitcnt lgkmcnt(" #n ")" ::: "memory")
#define PG8_BAR __builtin_amdgcn_s_barrier()
#define PG8_SCHED __builtin_amdgcn_sched_barrier(0)
    Unit cur, nxt; int ui = 0;
    if (!S.next(0, cur)) return;
    f32x4 acc[2][2][4][2];
#pragma unroll
    for (int a = 0; a < 2; ++a)
#pragma unroll
        for (int b = 0; b < 2; ++b)
#pragma unroll
            for (int m = 0; m < 4; ++m)
#pragma unroll
                for (int n = 0; n < 2; ++n) acc[a][b][m][n] = (f32x4){0.f, 0.f, 0.f, 0.f};
    bf16x8 At[4][2], B0[2][2], B1[2][2];
    const char* cA = cur.A; const char* cB = cur.B;
    S.a_ready(cur);
    if constexpr (SP2) {
        PG8_STAGEB(PG8_SB(0, 0), cB, voffB); PG8_STAGEB(PG8_SB(0, 1), cB + hstepB, voffB); PG8_STAGE(PG8_SA(0, 0), cA, voffA); PG8_STAGE(PG8_SA(0, 1), cA + hstepA, voffA);
        if (wr == 1) PG8_BAR;
        PG8_WAIT_V(2); PG8_BAR;
        PG8_STAGEB(PG8_SB(1, 0), cB + kstep, voffB); PG8_STAGE(PG8_SA(1, 0), cA + kstep, voffA); PG8_STAGEB(PG8_SB(1, 1), cB + hstepB + kstep, voffB);
        PG8_WAIT_V(6); PG8_BAR;
    } else {
        PG8_STAGEB(PG8_SB(0, 0), cB, voffB); PG8_STAGE(PG8_SA(0, 0), cA, voffA); PG8_STAGEB(PG8_SB(0, 1), cB + hstepB, voffB); PG8_STAGE(PG8_SA(0, 1), cA + hstepA, voffA);
        if (wr == 1) PG8_BAR;
        PG8_WAIT_V(4); PG8_BAR;
        PG8_STAGEB(PG8_SB(1, 0), cB + kstep, voffB); PG8_STAGE(PG8_SA(1, 0), cA + kstep, voffA); PG8_STAGEB(PG8_SB(1, 1), cB + hstepB + kstep, voffB);
        PG8_WAIT_V(6); PG8_BAR;
    }
    for (;;) {
        const bool has_next = S.next(ui + 1, nxt);
        const char* nA = has_next ? nxt.A : cA; const char* nB = has_next ? nxt.B : cB;
        for (int t = 0; t < nt; t += 2) {
            const bool last = (t == nt - 2);
            const char* a1 = cA + (size_t)(t + 1) * kstep;
            const char* a2 = last ? nA : cA + (size_t)(t + 2) * kstep; const char* b2 = last ? nB : cB + (size_t)(t + 2) * kstep;
            const char* a3 = a2 + kstep; const char* b3 = b2 + kstep;
            if (last && has_next) S.a_ready(nxt);
            if constexpr (SP2) {
            PG8_LDB(B0, 0, 0); PG8_LDB(B1, 0, 1); PG8_SCHED; PG8_LDA(At, 0, 0); PG8_STAGE(PG8_SA(1, 1), a1 + hstepA, voffA);
            PG8_WAIT_V(8); PG8_WAIT_L(0); PG8_BAR; PG8_MMA(0, 0, At, B0); PG8_MMA(0, 1, At, B1); PG8_BAR; PG8_SCHED;
            PG8_LDA(At, 0, 1); PG8_STAGEB(PG8_SB(0, 0), b2, voffB); PG8_STAGEB(PG8_SB(0, 1), b2 + hstepB, voffB); PG8_STAGE(PG8_SA(0, 0), a2, voffA);
            PG8_WAIT_V(8); PG8_WAIT_L(0); PG8_BAR; PG8_MMA(1, 0, At, B0); PG8_MMA(1, 1, At, B1); PG8_BAR; PG8_SCHED;
            PG8_LDB(B0, 1, 0); PG8_LDB(B1, 1, 1); PG8_SCHED; PG8_LDA(At, 1, 0); PG8_STAGE(PG8_SA(0, 1), a2 + hstepA, voffA);
            PG8_WAIT_V(8); PG8_WAIT_L(0); PG8_BAR; PG8_MMA(0, 0, At, B0); PG8_MMA(0, 1, At, B1); PG8_BAR; PG8_SCHED;
            PG8_LDA(At, 1, 1); PG8_STAGEB(PG8_SB(1, 0), b3, voffB); PG8_STAGEB(PG8_SB(1, 1), b3 + hstepB, voffB); PG8_STAGE(PG8_SA(1, 0), a3, voffA);
            PG8_WAIT_V(8); PG8_WAIT_L(0); PG8_BAR; PG8_MMA(1, 0, At, B0); PG8_MMA(1, 1, At, B1); PG8_BAR; PG8_SCHED;
            } else {
            PG8_LDB(B0, 0, 0); PG8_SCHED; PG8_LDA(At, 0, 0); PG8_STAGE(PG8_SA(1, 1), a1 + hstepA, voffA);
            PG8_WAIT_L(8); PG8_BAR; PG8_WAIT_L(0); PG8_MMA(0, 0, At, B0); PG8_BAR; PG8_SCHED;
            PG8_LDB(B1, 0, 1); PG8_STAGEB(PG8_SB(0, 0), b2, voffB);
            PG8_BAR; PG8_WAIT_L(0); PG8_MMA(0, 1, At, B1); PG8_BAR;
            PG8_LDA(At, 0, 1); PG8_STAGE(PG8_SA(0, 0), a2, voffA);
            PG8_BAR; PG8_WAIT_L(0); PG8_MMA(1, 0, At, B0); PG8_BAR; PG8_SCHED;
            PG8_STAGEB(PG8_SB(0, 1), b2 + hstepB, voffB);
            PG8_WAIT_V(6); PG8_BAR; PG8_MMA(1, 1, At, B1); PG8_BAR;
            PG8_LDB(B0, 1, 0); PG8_SCHED; PG8_LDA(At, 1, 0); PG8_STAGE(PG8_SA(0, 1), a2 + hstepA, voffA);
            PG8_WAIT_L(8); PG8_BAR; PG8_WAIT_L(0); PG8_MMA(0, 0, At, B0); PG8_BAR; PG8_SCHED;
            PG8_LDB(B1, 1, 1); PG8_STAGEB(PG8_SB(1, 0), b3, voffB);
            PG8_BAR; PG8_WAIT_L(0); PG8_MMA(0, 1, At, B1); PG8_BAR;
            PG8_LDA(At, 1, 1); PG8_STAGE(PG8_SA(1, 0), a3, voffA);
            PG8_BAR; PG8_WAIT_L(0); PG8_MMA(1, 0, At, B0); PG8_BAR; PG8_SCHED;
            PG8_STAGEB(PG8_SB(1, 1), b3 + hstepB, voffB);
            PG8_WAIT_V(6); PG8_BAR; PG8_MMA(1, 1, At, B1); PG8_BAR;
            }
        }
        if constexpr (ALIGN_EPI) { if (wr == 0) PG8_BAR; }
        if constexpr (FP8 == 1) asm volatile("s_nop 15\n\ts_nop 15\n\ts_nop 15" ::: "memory");
        if constexpr (!Epi::AFTER_DRAIN) { E(acc, cur, wr, wc); S.done(cur); }
        if (!has_next) break;
#pragma unroll
        for (int a = 0; a < 2; ++a)
#pragma unroll
            for (int b = 0; b < 2; ++b)
#pragma unroll
                for (int m = 0; m < 4; ++m)
#pragma unroll
                    for (int n = 0; n < 2; ++n) acc[a][b][m][n] = (f32x4){0.f, 0.f, 0.f, 0.f};
        cur = nxt; cA = nA; cB = nB; ++ui;
        if constexpr (ALIGN_EPI) { if (wr == 1) PG8_BAR; }
    }
    PG8_WAIT_V(0);
    if constexpr (!ALIGN_EPI) { if (wr == 0) PG8_BAR; }
    PG8_BAR;
    if constexpr (Epi::AFTER_DRAIN) { E.fused(acc, cur, wr, wc, fr, fq, lds, wid, lane); S.done(cur); }
#undef PG8_SA
#undef PG8_SB
#undef PG8_STAGE
#undef PG8_STAGEB
#undef PG8_LDA
#undef PG8_LDB
#undef PG8_MMA
#undef PG8_WAIT_V
#undef PG8_WAIT_L
#undef PG8_BAR
#undef PG8_SCHED
}

}

#ifndef MOE_FP8
#define MOE_FP8 1
#endif
#ifndef LN_FUSE
#define LN_FUSE 0
#endif
#ifndef MOE_AUX_UP
#define MOE_AUX_UP 0
#endif
#ifndef MOE_AUX_DN
#define MOE_AUX_DN 0
#endif
#ifndef FFN_FP8
#define FFN_FP8 0
#endif
#ifndef FFN_DN8
#define FFN_DN8 0
#endif
#define FFN_D8 (FFN_FP8 || FFN_DN8)
#ifndef F13_P1_N
#define F13_P1_N 0
#endif
#ifndef CMAX_LAST
#define CMAX_LAST 0
#endif
#ifndef POOL_I8
#define POOL_I8 0
#endif
#ifndef FFN_DN_I8
#define FFN_DN_I8 0
#endif
#ifndef LORA_I8
#define LORA_I8 0
#endif
#ifndef WO_I8
#define WO_I8 0
#endif
#ifndef RKV_I8
#define RKV_I8 0
#endif
#ifndef FFN_I8
#define FFN_I8 0
#endif
constexpr size_t MiB = 1u << 20;
constexpr size_t WS_CTL = 0, CTL_ZERO_BYTES = 1 * MiB;
constexpr size_t WS_MOD = 1 * MiB;
constexpr size_t WS_TOK = 2 * MiB;
constexpr size_t WS_SB  = 3 * MiB;
constexpr size_t WS_POS = 6 * MiB;
constexpr size_t WS_XR  = 22 * MiB;
constexpr size_t WS_W   = 86 * MiB;
constexpr size_t W_WR = WS_W, W_WK = W_WR + 8 * MiB, W_WV = W_WK + 8 * MiB, W_WO = W_WV + 8 * MiB;
constexpr size_t W_WLD = W_WO + 8 * MiB, W_ALD = W_WLD + 1 * MiB, W_G1 = W_ALD + 1 * MiB;
constexpr size_t W_WLU = W_G1 + 1 * MiB, W_ALU = W_WLU + 2 * MiB, W_G2 = W_ALU + 2 * MiB;
constexpr size_t W_PW = W_G2 + 1 * MiB;
constexpr size_t W_F13 = W_PW + 2 * MiB;
constexpr size_t W_F2 = W_F13 + 44 * MiB;
constexpr size_t W_M13 = W_F2 + 22 * MiB;
constexpr size_t W_M2 = W_M13 + 448 * MiB;
constexpr size_t WS_A = W_M2 + 224 * MiB;
constexpr size_t A_A6 = WS_A, A6_STRIDE = 36 * MiB;
constexpr size_t A_R = WS_A + 216 * MiB, A_KX = WS_A + 248 * MiB, A_V = WS_A + 284 * MiB;
constexpr size_t A_LW = WS_A + 320 * MiB, A_LA = WS_A + 325 * MiB, A_G1O = WS_A + 330 * MiB;
constexpr size_t A_EW = WS_A + 336 * MiB, A_AA = WS_A + 408 * MiB;
constexpr size_t A_GATE = WS_A + 480 * MiB, A_YD = WS_A + 512 * MiB;
constexpr size_t A_AO = WS_A + 580 * MiB, A_YO = WS_A + 612 * MiB;
constexpr int LDU = DFF + 64, LDF2 = DFF + 64, LDUG = MOE_FP8 ? DFE + 128 : DFE, LDM2 = MOE_FP8 ? DFE + 128 : DFE;
constexpr size_t A_H2 = WS_A, A_U = WS_A + 32 * MiB, A_YF = WS_A + 122 * MiB, A_HP = WS_A + 154 * MiB, A_PP = WS_A + 186 * MiB, A_YP = WS_A + 218 * MiB, A_H2B = WS_A + 250 * MiB;
constexpr size_t A_HG = WS_A + 282 * MiB, A_UG = WS_A + 354 * MiB, A_Y2 = WS_A + 606 * MiB;
constexpr size_t WS_PART = WS_A + 678 * MiB;
constexpr int MOE_KS = 7, MOE_RT = 64;
constexpr size_t W_F2P = WS_PART + 112 * MiB;
constexpr size_t WS_END = W_F2P + 23 * MiB;
static_assert(A_YO + 32 * MiB <= WS_PART && A_Y2 + (size_t)MROWS_PAD * D * 2 <= WS_PART && A_UG + (size_t)MROWS_PAD * LDUG * (MOE_FP8 ? 1 : 2) <= A_Y2 && A_HG + (size_t)MROWS_PAD * D * 2 <= A_UG && A_U + (size_t)ML * LDU * 2 <= A_YF && (size_t)D * LDF2 * 2 <= 23 * MiB && (size_t)NE * D * LDM2 * (MOE_FP8 ? 1 : 2) <= 224 * MiB, "ws map");
static_assert(W_M13 + (size_t)NE * 2 * DFE * D * 2 == W_M2 && W_M2 + (size_t)NE * D * DFE * 2 == WS_A && W_F13 + (size_t)2 * DFF * D * 2 == W_F2, "weight map");
constexpr int CW_BAR = 4096;
constexpr int CW_LN1 = 32768, CW_LN2 = 32768 + 64 * 32;
constexpr size_t WS_XB1 = 2 * MiB + 512 * 1024, WS_XB2 = 5 * MiB;
constexpr int CW_CMAX = 65536;
constexpr int CW_CMAX4 = 65536 + 2 * 5632 + 5 * 2048;
constexpr size_t WS_RSP = 5 * MiB + 896 * 1024;
constexpr int CW_CMAX3 = 65536 + 2 * 5632 + 4 * 2048;
constexpr size_t WS_RSU = 5 * MiB + 864 * 1024;
constexpr int CW_CMAX2 = 65536 + 2 * 5632;
constexpr size_t WS_CML = 5 * MiB + 832 * 1024;
constexpr size_t WS_RSO = 5 * MiB + 768 * 1024;
constexpr size_t WS_RS6 = 5 * MiB + 512 * 1024;
constexpr size_t WS_RS = 2 * MiB + 384 * 1024;
constexpr int CW_GCNT = 16384;

constexpr int LDS_BYTES = 147456;
constexpr int MISC_OFF = LDS_BYTES - 256;

#define XB_TMO      128
#define XB_XCNT(j)  (256  + 64 * (j))
#define XB_XSUB(j)  (1280 + 64 * (j))
#define XB_XGEN(j)  (2304 + 64 * (j))
#define XB_TOP      3328
#define XB_TOPGEN   3392
#define XCD_BAR_WORDS 3456
#define XB_SPIN_CAP (1u << 18)
__device__ __forceinline__ unsigned xb_ld(unsigned* p)              { return __hip_atomic_load(p, __ATOMIC_RELAXED, __HIP_MEMORY_SCOPE_AGENT); }
__device__ __forceinline__ unsigned xb_add(unsigned* p, unsigned v) { return __hip_atomic_fetch_add(p, v, __ATOMIC_RELAXED, __HIP_MEMORY_SCOPE_AGENT); }
__device__ __forceinline__ unsigned xb_xcc_id() { return (unsigned)__builtin_amdgcn_s_getreg((3 << 11) | 20) & 0xFu; }
#define XB_SPIN(cond, bar) do { unsigned _sp = 0; while (cond) { __builtin_amdgcn_s_sleep(1); \
    if ((++_sp & 255u) == 0u) { if (xb_ld(&(bar)[XB_TMO])) break; if (_sp > XB_SPIN_CAP) { atomicAdd(&(bar)[XB_TMO], 1u); break; } } } } while (0)
struct XcdBarrier { unsigned* bar; unsigned x; volatile LAS unsigned* st; };
__device__ __forceinline__ XcdBarrier xcd_barrier_post(unsigned* bar, volatile LAS unsigned* st) {
    XcdBarrier b; b.bar = bar; b.x = xb_xcc_id(); b.st = st;
    if (threadIdx.x == 0) (void)xb_add(&bar[XB_XCNT(b.x)], 1u);
    return b;
}
__device__ __forceinline__ void xcd_barrier_complete(unsigned* bar, unsigned x, unsigned& nloc, unsigned& nx) {
    const unsigned G = gridDim.x * gridDim.y * gridDim.z;
    unsigned sum, cnt, mine, sp = 0u;
    for (;;) {
        sum = 0u; cnt = 0u; mine = 0u;
#pragma unroll
        for (unsigned j = 0; j < 16; ++j) { const unsigned c = xb_ld(&bar[XB_XCNT(j)]); sum += c; cnt += (c > 0u) ? 1u : 0u; mine = (j == x) ? c : mine; }
        if (sum == G) break;
        __builtin_amdgcn_s_sleep(1);
        if ((++sp & 255u) == 0u) { if (xb_ld(&bar[XB_TMO])) break; if (sp > XB_SPIN_CAP) { atomicAdd(&bar[XB_TMO], 1u); break; } }
    }
    nloc = mine > 0u ? mine : 1u; nx = cnt > 0u ? cnt : 1u;
}
__device__ __forceinline__ void xcd_barrier(const XcdBarrier& b) {
    asm volatile("s_waitcnt vmcnt(0)" ::: "memory");
    __syncthreads();
    if (threadIdx.x == 0) {
        unsigned* bar = b.bar;
        __builtin_amdgcn_s_waitcnt(0);
        unsigned nloc = b.st[0], nx = b.st[1];
        if (nloc == 0u) { xcd_barrier_complete(bar, b.x, nloc, nx); b.st[0] = nloc; b.st[1] = nx; }
        const unsigned old = xb_add(&bar[XB_XSUB(b.x)], 1u);
        const unsigned gen = old / nloc;
        if (old + 1u == (gen + 1u) * nloc) {
            __builtin_amdgcn_fence(__ATOMIC_RELEASE, "agent");
            asm volatile("s_waitcnt vmcnt(0)" ::: "memory");
            const unsigned og = xb_add(&bar[XB_TOP], 1u);
            const unsigned tg = og / nx;
            if (og + 1u == (tg + 1u) * nx) xb_add(&bar[XB_TOPGEN], 1u);
            else XB_SPIN(xb_ld(&bar[XB_TOPGEN]) == tg, bar);
            __builtin_amdgcn_fence(__ATOMIC_ACQUIRE, "agent");
            xb_add(&bar[XB_XGEN(b.x)], 1u);
            asm volatile("s_waitcnt vmcnt(0)" ::: "memory");
        } else {
            XB_SPIN(xb_ld(&bar[XB_XGEN(b.x)]) == gen, bar);
            __builtin_amdgcn_fence(__ATOMIC_ACQUIRE, "agent");
            asm volatile("s_waitcnt vmcnt(0)" ::: "memory");
        }
    }
    __syncthreads();
}

struct Args { const float* in[35]; float* out; unsigned char* ws; int ph_lo, ph_hi, li, pad; };
static_assert(sizeof(Args) == 35 * 8 + 8 + 8 + 16, "Args has no padding");
enum In { I_X = 0, I_C, I_CTX, I_CCTX, I_WMOD, I_BMOD, I_LNW, I_LNB, I_MU, I_WR, I_WK, I_WV, I_WO, I_DW0, I_DW1, I_DW2, I_IA0, I_IA1, I_IA2, I_G1, I_G2, I_KK, I_KA, I_RK, I_GNW, I_GNB,
          I_POOLW, I_POOLS, I_FW1, I_FW3, I_FW2, I_ROUTER, I_MW1, I_MW3, I_MW2 };
struct Frame {
    LAS unsigned char* lds; int wave, vcu, G, gw, NGW;
    unsigned char* ws; unsigned* ctl;
};
#define LDS_WAIT() asm volatile("s_waitcnt lgkmcnt(0)" ::: "memory")
__device__ __forceinline__ void unpack8(const u32x4 w, float (&f)[8]) { f[0] = bflo(w.x); f[1] = bfhi(w.x); f[2] = bflo(w.y); f[3] = bfhi(w.y); f[4] = bflo(w.z); f[5] = bfhi(w.z); f[6] = bflo(w.w); f[7] = bfhi(w.w); }

__device__ __forceinline__ void p0_mod(const Frame& F, const Args& a) {
    const int lane = lane_id(), tid = F.wave * 64 + lane; (void)tid;
    LAS float* sc = (LAS float*)F.lds;
    LAS float* red = (LAS float*)(F.lds + 40960);
    const float* c = a.in[I_C]; const float* cc = a.in[I_CCTX];
    for (int i = tid; i < 5 * D; i += 512) { const int j = i / D, k = i % D; const float v = j < 4 ? c[j * D + k] : cc[k]; sc[i] = siluf_(v); }
    __syncthreads();
    float* MOD = (float*)(F.ws + WS_MOD);
    const int x = lane & 7, q = lane >> 3;
    for (int u = blockIdx.x; u < 2 * (MOD_N / 32); u += F.G) {
        const int l = u / (MOD_N / 32), cb = u % (MOD_N / 32);
        const float* W = a.in[I_WMOD] + (size_t)l * D * MOD_N + cb * 32 + 4 * x;
        float acc[5][4];
#pragma unroll
        for (int j = 0; j < 5; ++j)
#pragma unroll
            for (int e = 0; e < 4; ++e) acc[j][e] = 0.f;
#pragma unroll 8
        for (int i = 0; i < 32; ++i) {
            const int k = F.wave * 256 + 8 * i + q;
            const f32x4 w = __builtin_nontemporal_load((const f32x4*)(W + (size_t)k * MOD_N));
#pragma unroll
            for (int j = 0; j < 5; ++j) { const float s = sc[j * D + k];
#pragma unroll
                for (int e = 0; e < 4; ++e) acc[j][e] += s * w[e]; }
        }
#pragma unroll
        for (int j = 0; j < 5; ++j)
#pragma unroll
            for (int e = 0; e < 4; ++e) { float v = acc[j][e]; v += __shfl_xor(v, 8); v += __shfl_xor(v, 16); v += __shfl_xor(v, 32); acc[j][e] = v; }
        __syncthreads();
        if (q == 0) {
#pragma unroll
            for (int j = 0; j < 5; ++j)
#pragma unroll
                for (int e = 0; e < 4; ++e) red[(F.wave * 5 + j) * 32 + 4 * x + e] = acc[j][e];
        }
        __syncthreads();
        if (tid < 160) { const int j = tid / 32, col = tid % 32; float s = 0.f;
#pragma unroll
            for (int w = 0; w < 8; ++w) s += red[(w * 5 + j) * 32 + col];
            MOD[(size_t)(l * 5 + j) * MOD_N + cb * 32 + col] = s + a.in[I_BMOD][l * MOD_N + cb * 32 + col]; }
    }
    __syncthreads();
}
#ifndef MOD_V2
#define MOD_V2 0
#endif
constexpr int CW_MODCNT = 90112;
__device__ __forceinline__ void p0_mod2(const Frame& F, const Args& a) {
    const int lane = lane_id(), tid = F.wave * 64 + lane;
    LAS float* sc = (LAS float*)F.lds;
    LAS float* red = (LAS float*)(F.lds + 40960);
    LAS unsigned* flag = (LAS unsigned*)(F.lds + 40960 + 40960);
    const float* c = a.in[I_C]; const float* cc = a.in[I_CCTX];
    for (int i = tid; i < 5 * D; i += 512) { const int j = i / D, k = i % D; const float v = j < 4 ? c[j * D + k] : cc[k]; sc[i] = siluf_(v); }
    __syncthreads();
    float* MOD = (float*)(F.ws + WS_MOD); float* PARTM = (float*)(F.ws + WS_PART);
    for (int u = blockIdx.x; u < 768; u += F.G) {
        const int kp = u & 7, g = u >> 3, l = g / 48, cb = g % 48;
        const float* W = a.in[I_WMOD] + ((size_t)l * D + kp * 256 + F.wave * 32) * MOD_N + cb * 256 + 4 * lane;
        float acc[5][4];
#pragma unroll
        for (int j = 0; j < 5; ++j)
#pragma unroll
            for (int e = 0; e < 4; ++e) acc[j][e] = 0.f;
#pragma unroll 8
        for (int i = 0; i < 32; ++i) {
            const int k = kp * 256 + F.wave * 32 + i;
            const f32x4 w = __builtin_nontemporal_load((const f32x4*)(W + (size_t)i * MOD_N));
#pragma unroll
            for (int j = 0; j < 5; ++j) { const float s = sc[j * D + k];
#pragma unroll
                for (int e = 0; e < 4; ++e) acc[j][e] += s * w[e]; }
        }
        __syncthreads();
#pragma unroll
        for (int j = 0; j < 5; ++j) *(LAS f32x4*)(red + (F.wave * 5 + j) * 256 + 4 * lane) = (f32x4){acc[j][0], acc[j][1], acc[j][2], acc[j][3]};
        __syncthreads();
        for (int o = tid; o < 5 * 256; o += 512) { const int j = o >> 8, col = o & 255; float s = 0.f;
#pragma unroll
            for (int w = 0; w < 8; ++w) s += red[(w * 5 + j) * 256 + col];
            __hip_atomic_store(PARTM + ((size_t)(kp * 2 + l) * 5 + j) * MOD_N + cb * 256 + col, s, __ATOMIC_RELAXED, __HIP_MEMORY_SCOPE_AGENT); }
        asm volatile("s_waitcnt vmcnt(0)" ::: "memory");
        __syncthreads();
        if (tid == 0) { const unsigned old = __hip_atomic_fetch_add(F.ctl + CW_MODCNT + g, 1u, __ATOMIC_RELAXED, __HIP_MEMORY_SCOPE_AGENT); flag[0] = (old == 7u) ? 1u : 0u; }
        __syncthreads();
        if (flag[0]) {
            for (int o = tid; o < 5 * 256; o += 512) { const int j = o >> 8, col = o & 255; float s = a.in[I_BMOD][l * MOD_N + cb * 256 + col];
#pragma unroll
                for (int p = 0; p < 8; ++p) s += __hip_atomic_load(PARTM + ((size_t)(p * 2 + l) * 5 + j) * MOD_N + cb * 256 + col, __ATOMIC_RELAXED, __HIP_MEMORY_SCOPE_AGENT);
                MOD[(size_t)(l * 5 + j) * MOD_N + cb * 256 + col] = s; }
        }
    }
    __syncthreads();
}
__device__ __forceinline__ void p0_pos(const Frame& F) {
    const int lane = lane_id(), tid = F.wave * 64 + lane; (void)tid;
    float* POS = (float*)(F.ws + WS_POS);
    for (int t = F.gw; t < T; t += F.NGW) {
        const float frow = (float)(t >> 6), fcol = (float)(t & 63);
#pragma unroll
        for (int j = 0; j < 8; ++j) { const int c0 = 4 * lane + 256 * j; f32x4 o;
#pragma unroll
            for (int e = 0; e < 4; ++e) { const int c = c0 + e, qi = c >> 9, i = c & 511;
                const float omega = fexp(-(float)i * (9.21034037197618f / 512.0f));
                float rev = ((qi < 2) ? frow : fcol) * omega * 0.15915494309189535f;
                rev -= floorf(rev);
                o[e] = (qi & 1) ? __builtin_amdgcn_cosf(rev) : __builtin_amdgcn_sinf(rev); }
            *(f32x4*)(POS + (size_t)t * D + c0) = o; }
    }
}
constexpr int TN_F13 = (FFN_FP8 || FFN_I8) ? 1408 : 2816, TN_F2 = (FFN_D8 || FFN_DN_I8) ? 1408 : 2816, TN_M = MOE_FP8 ? 1792 : 3584;
constexpr int TN_RKV = RKV_I8 ? 512 : 1024, TI_RKV3 = 3 * TN_RKV;
constexpr int TI_RWKV = TI_RKV3 + (WO_I8 ? 512 : 1024), TI_F1 = TI_RWKV + TN_F13, TI_F3 = TI_F1 + TN_F13, TI_POOL = TI_F3 + (POOL_I8 ? 128 : 256), TI_M1 = TI_POOL + 8 * TN_M, TI_M3 = TI_M1 + 8 * TN_M, TI_MW2 = TI_M3 + 8 * TN_M, TI_M2 = TI_MW2 + TN_F2;
struct TrItem { const float* src; unsigned char* dst; int src_ld, dst_ld  , k0  , kbyte  , n0, drow0, f8  ; float sc; const unsigned* cm  ; };
__device__ __forceinline__ TrItem tr_decode(const Frame& F, const Args& a, int it) {
    TrItem t; t.f8 = 0; t.sc = 1.0f; t.cm = nullptr; int kb, nb;
    if (it < TI_RWKV) { const int m = it < TI_RKV3 ? it / TN_RKV : 3, r = it - (m < 3 ? m * TN_RKV : TI_RKV3); kb = r >> 5; nb = r & 31; const bool i8 = RKV_I8 && (m < 3 || WO_I8);
        t.src = a.in[I_WR + m]; t.src_ld = D; t.dst = F.ws + W_WR + (size_t)m * 8 * MiB; t.dst_ld = i8 ? D : 2 * D; t.drow0 = 64 * nb; if (i8) { t.f8 = 2; t.cm = F.ctl + CW_CMAX2 + m * D; } }
    else if (it < TI_F3) { const int w3 = it >= TI_F1, r = it - (w3 ? TI_F1 : TI_RWKV); kb = r / 88; nb = r % 88; const int n0 = 64 * nb;
        t.src = a.in[w3 ? I_FW3 : I_FW1]; t.src_ld = DFF; t.dst = F.ws + W_F13; t.dst_ld = (FFN_FP8 || FFN_I8) ? D : 2 * D; t.drow0 = (n0 >> 7) * 256 + (n0 & 127) + 128 * w3; t.f8 = FFN_I8 ? 2 : FFN_FP8; t.sc = FFN_FP8 ? 64.0f : 1.0f; if (FFN_I8) t.cm = F.ctl + CW_CMAX + w3 * DFF; }
    else if (it < TI_POOL) { const int r = it - TI_F3, g = POOL_I8 ? r >> 5 : r >> 6; kb = POOL_I8 ? (r >> 3) & 3 : (r >> 3) & 7; nb = r & 7;
        t.src = a.in[I_POOLW] + (size_t)g * 512 * 512; t.src_ld = 512; t.dst = F.ws + W_PW + (size_t)g * 512 * 512 * (POOL_I8 ? 1 : 2); t.dst_ld = POOL_I8 ? 512 : 2 * 512; t.drow0 = 64 * nb;
        if (POOL_I8) { t.f8 = 2; t.cm = F.ctl + CW_CMAX4 + g * 512; } }
    else if (it < TI_M3) { const int w3 = it >= TI_M1, r = it - (w3 ? TI_M1 : TI_POOL), e = r / TN_M, rr = r % TN_M; kb = rr / 112; nb = rr % 112; const int n0 = 64 * nb;
        t.src = a.in[w3 ? I_MW3 : I_MW1] + (size_t)e * D * DFE; t.src_ld = DFE; t.dst_ld = MOE_FP8 ? D : 2 * D; t.dst = F.ws + W_M13 + (size_t)e * 2 * DFE * t.dst_ld;
        t.drow0 = (n0 >> 7) * 256 + (n0 & 127) + 128 * w3; t.f8 = MOE_FP8; t.sc = MOE_FP8 ? 64.0f : 1.0f; }
    else if (it >= TI_MW2) { const int r = it - TI_MW2; kb = r >> 5; nb = r & 31;
        t.src = a.in[I_FW2]; t.src_ld = D; t.dst = F.ws + W_F2P; t.dst_ld = (FFN_D8 || FFN_DN_I8) ? LDF2 : 2 * LDF2; t.drow0 = 64 * nb; t.f8 = FFN_DN_I8 ? 2 : FFN_D8; t.sc = FFN_D8 ? 256.0f : 1.0f; if (FFN_DN_I8) t.cm = F.ctl + CW_CMAX3; }
    else { const int r = it - TI_M3, e = r / TN_M, rr = r % TN_M; kb = rr >> 5; nb = rr & 31;
        t.src = a.in[I_MW2] + (size_t)e * DFE * D; t.src_ld = D; t.dst_ld = MOE_FP8 ? LDM2 : 2 * LDM2; t.dst = F.ws + W_M2 + (size_t)e * D * t.dst_ld; t.drow0 = 64 * nb; t.f8 = MOE_FP8; t.sc = MOE_FP8 ? 256.0f : 1.0f; }
    t.n0 = 64 * nb; t.kbyte = 128 * kb; t.k0 = t.f8 ? 128 * kb : 64 * kb; return t;
}
__device__ __forceinline__ void tr_load(const TrItem& t, int h, f32x4 (&r)[4][4], int lane) {
    const int x = lane & 15, q = lane >> 4; const float* p = t.src + (size_t)(t.k0 + 64 * h + 4 * q) * t.src_ld + t.n0 + 4 * x;
#pragma unroll
    for (int i = 0; i < 4; ++i)
#pragma unroll
        for (int s = 0; s < 4; ++s) r[i][s] = __builtin_nontemporal_load((const f32x4*)(p + (size_t)(16 * i + s) * t.src_ld));
}
template <bool I8OK = false>
__device__ __forceinline__ void tr_store(const TrItem& t, int h, const f32x4 (&r)[4][4], LAS unsigned* scr, int lane) {
    const int x = lane & 15, q = lane >> 4;
    if (I8OK && t.f8 == 2) {
        const f32x4 cmx = __builtin_bit_cast(f32x4, *(const u32x4*)(t.cm + t.n0 + 4 * x)); f32x4 inv;
#pragma unroll
        for (int jj = 0; jj < 4; ++jj) inv[jj] = 127.0f * __builtin_amdgcn_rcpf(fmaxf(cmx[jj], 1e-30f));
#pragma unroll
        for (int i = 0; i < 4; ++i)
#pragma unroll
            for (int jj = 0; jj < 4; ++jj) scr[(4 * x + jj) * 33 + 16 * h + 4 * i + q] = pk4_i8(r[i][0][jj] * inv[jj], r[i][1][jj] * inv[jj], r[i][2][jj] * inv[jj], r[i][3][jj] * inv[jj]);
        if (h == 0) return;
    } else if (t.f8) {
#pragma unroll
        for (int i = 0; i < 4; ++i)
#pragma unroll
            for (int jj = 0; jj < 4; ++jj) scr[(4 * x + jj) * 33 + 16 * h + 4 * i + q] = pk4_fp8_nc(r[i][0][jj] * t.sc, r[i][1][jj] * t.sc, r[i][2][jj] * t.sc, r[i][3][jj] * t.sc);
        if (h == 0) return;
    } else {
#pragma unroll
        for (int i = 0; i < 4; ++i)
#pragma unroll
            for (int jj = 0; jj < 4; ++jj) { scr[(4 * x + jj) * 33 + 8 * i + 2 * q] = pk2(r[i][0][jj], r[i][1][jj]); scr[(4 * x + jj) * 33 + 8 * i + 2 * q + 1] = pk2(r[i][2][jj], r[i][3][jj]); }
    }
    LDS_WAIT();
    const int c = lane & 7;
#pragma unroll
    for (int rr = 0; rr < 8; ++rr) { const int n = (lane >> 3) + 8 * rr; const LAS unsigned* s = scr + n * 33 + 4 * c;
        u32x4 o; o.x = s[0]; o.y = s[1]; o.z = s[2]; o.w = s[3];
        *(u32x4*)(t.dst + (size_t)(t.drow0 + n) * t.dst_ld + t.kbyte + 16 * c) = o; }
    LDS_WAIT();
}
template <bool I8OK = false>
__device__ __forceinline__ void p0_transpose_range(const Frame& F, const Args& a, int lo, int hi, int gw, int ngw, LAS unsigned* scr) {
    const int lane = lane_id();
    int it = lo + gw; if (it >= hi) return;
    f32x4 ra[4][4], rb[4][4];
    TrItem ta = tr_decode(F, a, it), tb = ta; int ha = 0, hb = 0; tr_load(ta, 0, ra, lane);
    for (;;) {
        bool hasb; if (ta.f8 && ha == 0) { tb = ta; hb = 1; hasb = true; } else { it += ngw; hasb = it < hi; if (hasb) { tb = tr_decode(F, a, it); hb = 0; } }
        if (hasb) tr_load(tb, hb, rb, lane);
        tr_store<I8OK>(ta, ha, ra, scr, lane);
        if (!hasb) break;
        bool hasa; if (tb.f8 && hb == 0) { ta = tb; ha = 1; hasa = true; } else { it += ngw; hasa = it < hi; if (hasa) { ta = tr_decode(F, a, it); ha = 0; } }
        if (hasa) tr_load(ta, ha, ra, lane);
        tr_store<I8OK>(tb, hb, rb, scr, lane);
        if (!hasa) break;
    }
}
#if defined(PROBE_READ)
__device__ __forceinline__ void probe_read(const Frame& F, const Args& a) {
    const int lane = lane_id(); float acc = 0.f;
    for (int m = 0; m < 3; ++m) { const float* base = a.in[I_MW1 + m]; const size_t n16 = (size_t)NE * D * DFE / 4;
        if (PROBE_READ == 1) { for (size_t i = (size_t)F.gw * 64 + lane; i < n16; i += (size_t)F.NGW * 64 * 16) {
                f32x4 r[16];
#pragma unroll
                for (int u = 0; u < 16; ++u) { const size_t j = i + (size_t)u * F.NGW * 64; r[u] = j < n16 ? __builtin_nontemporal_load((const f32x4*)base + j) : (f32x4){0.f, 0.f, 0.f, 0.f}; }
#pragma unroll
                for (int u = 0; u < 16; ++u) acc += r[u][0] + r[u][3]; } }
        else { const int ld = (m == 2) ? D : DFE; const int nblk = ld / 64; const size_t rows = (size_t)NE * D * DFE / ld; const size_t items = rows / 64 * nblk; const int x = lane & 15, q = lane >> 4;
            for (size_t it = F.gw; it < items; it += F.NGW) { const size_t kb = it / nblk, nb = it % nblk; const float* p = base + (kb * 64 + 4 * q) * ld + nb * 64 + 4 * x;
                f32x4 r[16];
#pragma unroll
                for (int u = 0; u < 16; ++u) r[u] = __builtin_nontemporal_load((const f32x4*)(p + (size_t)((u >> 2) * 16 + (u & 3)) * ld));
#pragma unroll
                for (int u = 0; u < 16; ++u) acc += r[u][0] + r[u][3]; } }
    }
    if (acc == 1.2345e-30f) ((float*)(F.ws + WS_PART))[F.gw * 64 + lane] = acc;
}
#endif
__device__ __forceinline__ void p0_cmax(const Frame& F, const Args& a) {
    const int lane = lane_id();
    constexpr int NU_F = 2 * 22 * 32, NU_R = NU_F + (RKV_I8 ? (WO_I8 ? 4 : 3) * 8 * 32 : 0), NU_D = NU_R + (FFN_DN_I8 ? 8 * 88 : 0), NU = NU_D + (POOL_I8 ? 64 : 0);
    for (int u = F.gw; u < NU; u += F.NGW) {
        const float* src; unsigned* dst; int ld, cb, kc;
        if (u < NU_F) { const int mat = u / 704, r = u % 704; cb = r % 22; kc = r / 22; src = a.in[mat ? I_FW3 : I_FW1]; ld = DFF; dst = F.ctl + CW_CMAX + mat * DFF; }
        else if (u < NU_R) { const int v = u - NU_F, mat = v >> 8, r = v & 255; cb = r & 7; kc = r >> 3; src = a.in[I_WR + mat]; ld = D; dst = F.ctl + CW_CMAX2 + mat * D; }
        else if (u < NU_D) { const int r = u - NU_R; cb = r & 7; kc = r >> 3; src = a.in[I_FW2]; ld = D; dst = F.ctl + CW_CMAX3; }
        else { const int r = u - NU_D, g = r >> 4; cb = r & 1; kc = (r >> 1) & 7; src = a.in[I_POOLW] + (size_t)g * 512 * 512; ld = 512; dst = F.ctl + CW_CMAX4 + g * 512; }
        const float* p = src + (size_t)(kc * 64) * ld + cb * 256 + 4 * lane;
        u32x4 mx = (u32x4){0u, 0u, 0u, 0u};
#pragma unroll
        for (int b = 0; b < 4; ++b) { u32x4 v[16];
#pragma unroll
            for (int i = 0; i < 16; ++i) v[i] = *(const u32x4*)(p + (size_t)(b * 16 + i) * ld);
#pragma unroll
            for (int i = 0; i < 16; ++i) { const u32x4 w = v[i] & 0x7fffffffu; mx.x = w.x > mx.x ? w.x : mx.x; mx.y = w.y > mx.y ? w.y : mx.y; mx.z = w.z > mx.z ? w.z : mx.z; mx.w = w.w > mx.w ? w.w : mx.w; } }
        unsigned* c = dst + cb * 256 + 4 * lane;
        __hip_atomic_fetch_max(c + 0, mx.x, __ATOMIC_RELAXED, __HIP_MEMORY_SCOPE_AGENT); __hip_atomic_fetch_max(c + 1, mx.y, __ATOMIC_RELAXED, __HIP_MEMORY_SCOPE_AGENT);
        __hip_atomic_fetch_max(c + 2, mx.z, __ATOMIC_RELAXED, __HIP_MEMORY_SCOPE_AGENT); __hip_atomic_fetch_max(c + 3, mx.w, __ATOMIC_RELAXED, __HIP_MEMORY_SCOPE_AGENT);
    }
}
__device__ __forceinline__ void p0_small(const Frame& F, const Args& a) {
    const int lane = lane_id(), tid = F.wave * 64 + lane; (void)tid;
    bf16_t* WLD = (bf16_t*)(F.ws + W_WLD); bf16_t* ALD = (bf16_t*)(F.ws + W_ALD); bf16_t* G1T = (bf16_t*)(F.ws + W_G1);
    bf16_t* WLU = (bf16_t*)(F.ws + W_WLU); bf16_t* ALU = (bf16_t*)(F.ws + W_ALU); bf16_t* G2T = (bf16_t*)(F.ws + W_G2);
    const int gt = F.gw * 64 + lane, NT_ = F.NGW * 64;
    if (LORA_I8) {
        for (int task = (F.G == 256) ? (F.wave < 3 ? F.wave * 256 + F.vcu : 768) : F.gw; task < 768; task += (F.G == 256) ? 768 : F.NGW) { const int mat = task >> 8, n = task & 255; f32x4 v[8]; float mx = 0.f;
#pragma unroll
            for (int j = 0; j < 8; ++j)
#pragma unroll
                for (int e = 0; e < 4; ++e) { const int k = 4 * lane + 256 * j + e; float w = 0.f;
                    if (mat < 2) { if (n < 192) { const int d = n >= 96, nn = n - 96 * d; w = a.in[mat == 0 ? I_DW1 : I_IA1][((size_t)d * D + k) * 96 + nn]; } }
                    else w = a.in[I_G1][(size_t)k * 256 + n];
                    v[j][e] = w; mx = fmaxf(mx, fabsf(w)); }
            mx = wave_max(mx);
            mx = fmaxf(mx, 1e-30f); const float inv = 127.0f / mx;
            unsigned char* row = F.ws + (mat == 0 ? W_WLD : mat == 1 ? W_ALD : W_G1) + (size_t)n * D;
#pragma unroll
            for (int j = 0; j < 8; ++j) *(unsigned*)(row + 4 * lane + 256 * j) = pk4_i8(v[j][0] * inv, v[j][1] * inv, v[j][2] * inv, v[j][3] * inv);
            if (lane == 0) ((float*)(F.ws + WS_CML))[task] = mx; }
    } else
    for (int i = gt; i < 256 * D; i += NT_) { const int n = i >> 11, k = i & 2047;
        float w = 0.f, v = 0.f;
        if (n < 192) { const int d = n >= 96, nn = n - 96 * d; w = a.in[I_DW1][((size_t)d * D + k) * 96 + nn]; v = a.in[I_IA1][((size_t)d * D + k) * 96 + nn]; }
        WLD[i] = (bf16_t)f2bf(w); ALD[i] = (bf16_t)f2bf(v); G1T[i] = (bf16_t)f2bf(a.in[I_G1][(size_t)k * 256 + n]); }
    for (int i = gt; i < 2 * D * 256; i += NT_) { const int n = i >> 8, k = i & 255, d = n >> 11, cidx = n & 2047, kk = k - 96 * d;
        float w = 0.f, v = 0.f;
        if (kk >= 0 && kk < 96) { w = a.in[I_DW2][((size_t)d * 96 + kk) * D + cidx]; v = a.in[I_IA2][((size_t)d * 96 + kk) * D + cidx]; }
        WLU[i] = (bf16_t)f2bf(w); ALU[i] = (bf16_t)f2bf(v); }
    for (int i = gt; i < D * 256; i += NT_) { const int n = i >> 8, k = i & 255; G2T[i] = (bf16_t)f2bf(a.in[I_G2][(size_t)k * D + n]); }
}

__device__ __forceinline__ void p1_mix(const Frame& F, const Args& a) {
    const int lane = lane_id();
    const float* MOD = (const float*)(F.ws + WS_MOD); const float* POS = (const float*)(F.ws + WS_POS);
    float* XR = (float*)(F.ws + WS_XR);
    int par = 0; (void)par;
    for (int it = F.gw; it < (MT / 8) * 8; it += F.NGW) {
        const int blk = it >> 3, j = it & 7, m0 = blk * 8; const bool lat = m0 < ML;
        int t0, Tseq, modrow; const float* xs;
        if (lat) { t0 = m0 % T; Tseq = T; modrow = m0 / T; xs = a.in[I_X] + (size_t)m0 * D; }
        else { const int mm = m0 - ML; t0 = mm % TC; Tseq = TC; modrow = 4; xs = a.in[I_CTX] + (size_t)mm * D; }
        const float* sh = MOD + (size_t)modrow * MOD_N; const float* scp = sh + D;
        const float* ps = POS + (size_t)t0 * D;
        const int c = 4 * lane + 256 * j;
        f32x4 xr[10];
#pragma unroll
        for (int i = 0; i < 10; ++i) { const int tr = t0 - 1 + i; const bool ok = tr >= 0 && tr < Tseq; const int ro = ok ? i - 1 : 0;
            xr[i] = *(const f32x4*)(xs + (ptrdiff_t)ro * D + c); if (lat) xr[i] += *(const f32x4*)(ps + (ptrdiff_t)ro * D + c); }
        const f32x4 shv = *(const f32x4*)(sh + c); const f32x4 scv = *(const f32x4*)(scp + c) + 1.0f;
        f32x4 mu[6];
#pragma unroll
        for (int n = 0; n < 6; ++n) mu[n] = *(const f32x4*)(a.in[I_MU] + n * D + c);
        f32x4 h[10];
#pragma unroll
        for (int i = 0; i < 10; ++i) { const int tr = t0 - 1 + i; const bool ok = tr >= 0 && tr < Tseq; h[i] = ok ? xr[i] * scv + shv : (f32x4){0.f, 0.f, 0.f, 0.f}; }
        if (RKV_I8) {
            constexpr int NS = LORA_I8 ? 6 : 3;
            LAS float* PM = (LAS float*)F.lds + (par & 1) * 2048;
            LAS float* FIN = (LAS float*)F.lds + 4096 + F.wave * 64;
#ifndef P1_SHARED_SCALE
#define P1_SHARED_SCALE 0
#endif
            if (P1_SHARED_SCALE) {
#pragma unroll
            for (int r = 0; r < 8; ++r) { const f32x4 h0 = h[r + 1], xx = (h[r] + h[r + 2]) * 0.5f - h0; float mx = 0.f;
#pragma unroll
                for (int q = 0; q < NS; ++q) { const int n = LORA_I8 ? q : (q == 0 ? 0 : q + 1); if (!lat && (n == 0 || n == 5)) continue;
                    const f32x4 v = h0 + xx * mu[n]; mx = fmaxf(mx, fmaxf(fmaxf(fabsf(v[0]), fabsf(v[1])), fmaxf(fabsf(v[2]), fabsf(v[3])))); }
                mx = row_max16(mx);
                if ((lane & 15) == 0) PM[(F.wave * 4 + (lane >> 4)) * 64 + r] = mx; }
            __syncthreads();
            if (lane < 8) { float mx = PM[lane];
#pragma unroll
                for (int w = 1; w < 32; ++w) mx = fmaxf(mx, PM[w * 64 + lane]);
                mx = fmaxf(mx, 1e-30f); const float qf = 127.0f / mx;
#pragma unroll
                for (int q = 0; q < NS; ++q) { const int n = LORA_I8 ? q : (q == 0 ? 0 : q + 1); FIN[NS * lane + q] = qf;
                    if (j == 0 && (lat || (n != 0 && n != 5))) ((float*)(F.ws + WS_RS6))[(size_t)n * MT + m0 + lane] = mx * (1.0f / 127.0f); } }
            } else {
#pragma unroll
            for (int r = 0; r < 8; ++r) { const f32x4 h0 = h[r + 1], xx = (h[r] + h[r + 2]) * 0.5f - h0;
#pragma unroll
                for (int q = 0; q < NS; ++q) { const int n = LORA_I8 ? q : (q == 0 ? 0 : q + 1); const f32x4 v = h0 + xx * mu[n]; float mx = fmaxf(fmaxf(fabsf(v[0]), fabsf(v[1])), fmaxf(fabsf(v[2]), fabsf(v[3])));
                    mx = row_max16(mx);
                    if ((lane & 15) == 0) PM[(F.wave * 4 + (lane >> 4)) * 64 + NS * r + q] = mx; } }
            __syncthreads();
            if (lane < 8 * NS) { float mx = PM[lane];
#pragma unroll
                for (int w = 1; w < 32; ++w) mx = fmaxf(mx, PM[w * 64 + lane]);
                mx = fmaxf(mx, 1e-30f); FIN[lane] = 127.0f / mx;
                const int r = lane / NS, q = lane - NS * r, n = LORA_I8 ? q : (q == 0 ? 0 : q + 1);
                if (j == 0 && (lat || (n != 0 && n != 5))) ((float*)(F.ws + WS_RS6))[(size_t)n * MT + m0 + r] = mx * (1.0f / 127.0f); }
            }
            LDS_WAIT();
#pragma unroll
            for (int r = 0; r < 8; ++r) { const f32x4 h0 = h[r + 1], xx = (h[r] + h[r + 2]) * 0.5f - h0; const size_t o = (size_t)(m0 + r) * D + c;
#pragma unroll
                for (int q = 0; q < NS; ++q) { const int n = LORA_I8 ? q : (q == 0 ? 0 : q + 1); if (!lat && (n == 0 || n == 5)) continue;
                    const float inv = FIN[NS * r + q]; const f32x4 v = (h0 + xx * mu[n]) * inv;
                    *(unsigned*)(F.ws + A_A6 + (size_t)n * A6_STRIDE + o) = pk4_i8(v[0], v[1], v[2], v[3]); }
                if (!LORA_I8) {
#pragma unroll
                for (int n = 1; n < 6; ++n) { if (n == 2 || n == 3 || (!lat && n == 5)) continue;
                    const f32x4 v = h0 + xx * mu[n]; u32x2 w; w.x = pk2(v[0], v[1]); w.y = pk2(v[2], v[3]);
                    *(u32x2*)((bf16_t*)(F.ws + A_A6 + (size_t)n * A6_STRIDE) + o) = w; } } }
            ++par;
        } else {
#pragma unroll
        for (int r = 0; r < 8; ++r) {
            const f32x4 h0 = h[r + 1], xx = (h[r] + h[r + 2]) * 0.5f - h0;
            const size_t o = (size_t)(m0 + r) * D + c;
#pragma unroll
            for (int n = 0; n < 6; ++n) { if (!lat && (n == 0 || n == 5)) continue;
                const f32x4 v = h0 + xx * mu[n]; u32x2 w; w.x = pk2(v[0], v[1]); w.y = pk2(v[2], v[3]);
                *(u32x2*)((bf16_t*)(F.ws + A_A6 + (size_t)n * A6_STRIDE) + o) = w; }
        }
        }
    }
}

__device__ __forceinline__ void p4_scan(const Frame& F, const Args& a) {
    const int lane = lane_id(), tid = F.wave * 64 + lane; (void)tid;
    LAS float* OP = (LAS float*)F.lds;
    LAS float* YS = (LAS float*)(F.lds + 49152);
    const bf16_t* KX = (const bf16_t*)(F.ws + A_KX); const bf16_t* VV = (const bf16_t*)(F.ws + A_V); const bf16_t* RR = (const bf16_t*)(F.ws + A_R);
    const bf16_t* EW = (const bf16_t*)(F.ws + A_EW); const bf16_t* AA = (const bf16_t*)(F.ws + A_AA);
    const int tl = tid >> 5, cp = tid & 31, vi = tid >> 3, kg = tid & 7;
    for (int s = blockIdx.x; s < NB * NH * 2; s += F.G) {
        const int b = s >> 6, h = (s >> 1) & 31, d = s & 1;
        const int ch = h * HS + 2 * cp;
        const float kkc0 = a.in[I_KK][ch], kkc1 = a.in[I_KK][ch + 1], kac0 = a.in[I_KA][ch], kac1 = a.in[I_KA][ch + 1], rkc0 = a.in[I_RK][ch], rkc1 = a.in[I_RK][ch + 1];
        bf16_t* YD = (bf16_t*)(F.ws + A_YD + (size_t)d * 32 * MiB); float* SB = (float*)(F.ws + WS_SB) + (size_t)d * ML * NH;
        float S[8];
#pragma unroll
        for (int j = 0; j < 8; ++j) S[j] = 0.f;
        unsigned rk = 0, rv = 0, rr = 0, re = 0, ra = 0;
#define SCAN_ROW0(ci) (((ci) < 16) ? (ML + b * TC + (d ? 15 - (ci) : (ci)) * 16) : (b * T + (d ? 127 - ((ci) - 16) : ((ci) - 16)) * 16))
#define SCAN_LOAD(ci) do { const int row_ = SCAN_ROW0(ci) + tl; const size_t o_ = (size_t)row_ * D + ch, o2_ = (size_t)row_ * (2 * D) + d * D + ch; \
        rk = *(const unsigned*)(KX + o_); rv = *(const unsigned*)(VV + o_); rr = ((ci) >= 16) ? *(const unsigned*)(RR + o_) : 0u; re = *(const unsigned*)(EW + o2_); ra = *(const unsigned*)(AA + o2_); } while (0)
#define SCAN_PREP(ci) do { LAS float* B_ = OP + ((ci) & 1) * 6144 + tl * 64 + 2 * cp; \
        const float k0 = bflo(rk), k1 = bfhi(rk), q0 = k0 * kkc0, q1 = k1 * kkc1; float n2 = q0 * q0 + q1 * q1; \
        n2 += __shfl_xor(n2, 1); n2 += __shfl_xor(n2, 2); n2 += __shfl_xor(n2, 4); n2 += __shfl_xor(n2, 8); n2 += __shfl_xor(n2, 16); \
        const float inv = 1.0f / fmaxf(sqrtf(n2), 1e-12f), kn0 = q0 * inv, kn1 = q1 * inv; \
        const float a0 = bflo(ra), a1 = bfhi(ra), kd0 = k0 * (1.0f + (a0 - 1.0f) * kac0), kd1 = k1 * (1.0f + (a1 - 1.0f) * kac1); \
        const float r0 = bflo(rr), r1 = bfhi(rr); \
        *(LAS f32x2*)(B_ + 0 * 1024) = (f32x2){kn0, kn1}; \
        *(LAS f32x2*)(B_ + 1 * 1024) = (f32x2){fexp(-bflo(re)), fexp(-bfhi(re))}; \
        *(LAS f32x2*)(B_ + 2 * 1024) = (f32x2){kn0 * a0, kn1 * a1}; \
        *(LAS f32x2*)(B_ + 3 * 1024) = (f32x2){kd0, kd1}; \
        *(LAS f32x2*)(B_ + 4 * 1024) = (f32x2){r0, r1}; \
        *(LAS f32x2*)(B_ + 5 * 1024) = (f32x2){bflo(rv), bfhi(rv)}; \
        if ((ci) >= 16) { float sb = r0 * kd0 * rkc0 + r1 * kd1 * rkc1; \
            sb += __shfl_xor(sb, 1); sb += __shfl_xor(sb, 2); sb += __shfl_xor(sb, 4); sb += __shfl_xor(sb, 8); sb += __shfl_xor(sb, 16); \
            if (cp == 0) SB[(size_t)(SCAN_ROW0(ci) + tl) * NH + h] = sb; } } while (0)
        __syncthreads();
        SCAN_LOAD(0); SCAN_PREP(0);
        __syncthreads();
        for (int ci = 0; ci < 144; ++ci) {
            if (ci + 1 < 144) SCAN_LOAD(ci + 1);
            const LAS float* B = OP + (ci & 1) * 6144; LAS float* Y = YS + (ci & 1) * 1024;
#pragma unroll 4
            for (int st = 0; st < 16; ++st) {
                const int tk = d ? 15 - st : st; const LAS float* p = B + tk * 64 + 8 * kg;
                const f32x4 kkA = *(const LAS f32x4*)(p), kkB = *(const LAS f32x4*)(p + 4);
                const f32x4 wA = *(const LAS f32x4*)(p + 1024), wB = *(const LAS f32x4*)(p + 1028);
                const f32x4 bA = *(const LAS f32x4*)(p + 2048), bB = *(const LAS f32x4*)(p + 2052);
                const f32x4 dA = *(const LAS f32x4*)(p + 3072), dB = *(const LAS f32x4*)(p + 3076);
                const f32x4 rA = *(const LAS f32x4*)(p + 4096), rB = *(const LAS f32x4*)(p + 4100);
                const float v = B[5 * 1024 + tk * 64 + vi];
                float sa = (S[0] * kkA[0] + S[1] * kkA[1]) + (S[2] * kkA[2] + S[3] * kkA[3]) + (S[4] * kkB[0] + S[5] * kkB[1]) + (S[6] * kkB[2] + S[7] * kkB[3]);
                sa = sum8(sa);
#pragma unroll
                for (int j = 0; j < 4; ++j) { S[j] = S[j] * wA[j] + (v * dA[j] - sa * bA[j]); S[4 + j] = S[4 + j] * wB[j] + (v * dB[j] - sa * bB[j]); }
                float y = (S[0] * rA[0] + S[1] * rA[1]) + (S[2] * rA[2] + S[3] * rA[3]) + (S[4] * rB[0] + S[5] * rB[1]) + (S[6] * rB[2] + S[7] * rB[3]);
                y = sum8(y);
                if (kg == 0) Y[tk * 64 + vi] = y;
            }
            if (ci + 1 < 144) SCAN_PREP(ci + 1);
            __syncthreads();
            if (ci >= 16) { const f32x2 yv = *(const LAS f32x2*)(Y + tl * 64 + 2 * cp);
                *(unsigned*)(YD + (size_t)(SCAN_ROW0(ci) + tl) * D + ch) = pk2(yv.x, yv.y); }
        }
#undef SCAN_ROW0
#undef SCAN_LOAD
#undef SCAN_PREP
    }
    __syncthreads();
}

constexpr int SL_KA = 0, SL_RM = 2048, SL_BK = 4096, SL_VC = 8192, SL_ARK = 10240, SL_AAK = 11264, SL_TN = 11776, SL_GC = 12288, SL_BYTES = 12544;
constexpr int SC_PAR = 8 * SL_BYTES;
typedef short s16x8 __attribute__((ext_vector_type(8)));
__device__ __forceinline__ s16x8 mk8(unsigned a, unsigned b, unsigned c, unsigned d) { u32x4 v; v.x = a; v.y = b; v.z = c; v.w = d; return __builtin_bit_cast(s16x8, v); }
__device__ __forceinline__ f32x4 mfma16(s16x8 a, s16x8 b, f32x4 c) { return __builtin_amdgcn_mfma_f32_16x16x32_bf16(a, b, c, 0, 0, 0); }
__device__ __forceinline__ s16x8 mk_d(const f32x4 x) { return mk8(pk2(x[0], x[1]), pk2(x[2], x[3]), 0u, 0u); }
__device__ __forceinline__ void p4_scan2(const Frame& F, const Args& a, unsigned char* yd_base, float* sb_base) {
    const int lane = lane_id(), tt = lane & 15, q = lane >> 4;
    const bf16_t* KX = (const bf16_t*)(F.ws + A_KX); const bf16_t* VV = (const bf16_t*)(F.ws + A_V); const bf16_t* RR = (const bf16_t*)(F.ws + A_R);
    const bf16_t* EW = (const bf16_t*)(F.ws + A_EW); const bf16_t* AA = (const bf16_t*)(F.ws + A_AA);
    LAS unsigned char* slot_w = F.lds + F.wave * SL_BYTES;
    LAS float* PAR = (LAS float*)(F.lds + SC_PAR);
    s16x8 SelF[2];
#pragma unroll
    for (int sel = 0; sel < 2; ++sel) { unsigned w[4];
#pragma unroll
        for (int jj = 0; jj < 4; ++jj) { const int j0 = 2 * jj, j1 = 2 * jj + 1; const bool h0 = (q == (tt >> 2)) && (j0 == 4 * sel + (tt & 3)), h1 = (q == (tt >> 2)) && (j1 == 4 * sel + (tt & 3));
            w[jj] = (h0 ? 0x3f80u : 0u) | (h1 ? 0x3f800000u : 0u); }
        SelF[sel] = mk8(w[0], w[1], w[2], w[3]); }
    for (int s = blockIdx.x; s < NB * NH * 2; s += F.G) {
        const int b = s >> 6, h = (s >> 1) & 31, d = s & 1;
        bf16_t* YD = (bf16_t*)(yd_base + (size_t)d * 32 * MiB); float* SB = sb_base + (size_t)d * ML * NH;
        __syncthreads();
        if (F.wave == 0) { PAR[lane] = a.in[I_KK][h * HS + lane]; PAR[64 + lane] = a.in[I_KA][h * HS + lane]; PAR[128 + lane] = a.in[I_RK][h * HS + lane]; }
        __syncthreads();
        f32x4 G[4];
#pragma unroll
        for (int tk = 0; tk < 4; ++tk) G[tk] = (f32x4){0.f, 0.f, 0.f, 0.f};
#define S2_ROW0(ci) (((ci) < 16) ? (ML + b * TC + (d ? 15 - (ci) : (ci)) * 16) : (b * T + (d ? 127 - ((ci) - 16) : ((ci) - 16)) * 16))
        u32x2 rk[4], rv[4], rr[4], re[4], ra[4];
#define S2_LOAD(ci) do { const int row_ = S2_ROW0(ci) + (d ? 15 - tt : tt); const size_t o_ = (size_t)row_ * D + h * HS + 4 * q, o2_ = (size_t)row_ * (2 * D) + d * D + h * HS + 4 * q; \
        _Pragma("unroll") for (int g_ = 0; g_ < 4; ++g_) { rk[g_] = *(const u32x2*)(KX + o_ + 16 * g_); rv[g_] = *(const u32x2*)(VV + o_ + 16 * g_); \
            rr[g_] = ((ci) >= 16) ? *(const u32x2*)(RR + o_ + 16 * g_) : (u32x2){0u, 0u}; re[g_] = *(const u32x2*)(EW + o2_ + 16 * g_); ra[g_] = *(const u32x2*)(AA + o2_ + 16 * g_); } } while (0)
        S2_LOAD(F.wave);
        for (int rnd = 0; rnd < 18; ++rnd) {
            const int ci = rnd * 8 + F.wave; const bool lat = rnd >= 2;
            {
                float kf[4][4], af[4][4], ef[4][4], vf[4][4], rf[4][4];
#pragma unroll
                for (int g = 0; g < 4; ++g) {
                    kf[g][0] = bflo(rk[g].x); kf[g][1] = bfhi(rk[g].x); kf[g][2] = bflo(rk[g].y); kf[g][3] = bfhi(rk[g].y);
                    af[g][0] = bflo(ra[g].x); af[g][1] = bfhi(ra[g].x); af[g][2] = bflo(ra[g].y); af[g][3] = bfhi(ra[g].y);
                    ef[g][0] = bflo(re[g].x); ef[g][1] = bfhi(re[g].x); ef[g][2] = bflo(re[g].y); ef[g][3] = bfhi(re[g].y);
                    vf[g][0] = bflo(rv[g].x); vf[g][1] = bfhi(rv[g].x); vf[g][2] = bflo(rv[g].y); vf[g][3] = bfhi(rv[g].y);
                    rf[g][0] = bflo(rr[g].x); rf[g][1] = bfhi(rr[g].x); rf[g][2] = bflo(rr[g].y); rf[g][3] = bfhi(rr[g].y); }
                unsigned VP[4][2];
#pragma unroll
                for (int g = 0; g < 4; ++g) { VP[g][0] = rv[g].x; VP[g][1] = rv[g].y; }
                if (rnd + 1 < 18) S2_LOAD((rnd + 1) * 8 + F.wave);
                float kkv[4][4]; float n2 = 0.f;
#pragma unroll
                for (int g = 0; g < 4; ++g) { const f32x4 kc = *(const LAS f32x4*)(PAR + 16 * g + 4 * q);
#pragma unroll
                    for (int i = 0; i < 4; ++i) { kkv[g][i] = kf[g][i] * kc[i]; n2 += kkv[g][i] * kkv[g][i]; } }
                n2 += __shfl_xor(n2, 16); n2 += __shfl_xor(n2, 32);
                const float inv = 1.0f / fmaxf(sqrtf(n2), 1e-12f);
                float sb = 0.f;
                unsigned KaP[4][2], BmP[4][2], KmP[4][2], RmP[4][2]; f32x4 gend[4];
#pragma unroll
                for (int g = 0; g < 4; ++g) { const f32x4 kac = *(const LAS f32x4*)(PAR + 64 + 16 * g + 4 * q), rkc = *(const LAS f32x4*)(PAR + 128 + 16 * g + 4 * q);
                    float ka_[4], bm_[4], km_[4], rm_[4];
#pragma unroll
                    for (int i = 0; i < 4; ++i) {
                        float L = ef[g][i];
                        L += dpp_f<0x111>(L); L += dpp_f<0x112>(L); L += dpp_f<0x114>(L); L += dpp_f<0x118>(L);
                        const float gt = fexp(-L), gi = fexp(L); float gm1 = dpp_f<0x111>(gt); gm1 = (tt == 0) ? 1.0f : gm1;
                        const float kk = kkv[g][i] * inv, kd = kf[g][i] * (1.0f + (af[g][i] - 1.0f) * kac[i]);
                        ka_[i] = kk * gm1; bm_[i] = kk * af[g][i] * gi; km_[i] = kd * gi; rm_[i] = rf[g][i] * gt;
                        sb += rf[g][i] * kd * rkc[i]; gend[g][i] = gt; }
                    KaP[g][0] = pk2(ka_[0], ka_[1]); KaP[g][1] = pk2(ka_[2], ka_[3]); BmP[g][0] = pk2(bm_[0], bm_[1]); BmP[g][1] = pk2(bm_[2], bm_[3]);
                    KmP[g][0] = pk2(km_[0], km_[1]); KmP[g][1] = pk2(km_[2], km_[3]); RmP[g][0] = pk2(rm_[0], rm_[1]); RmP[g][1] = pk2(rm_[2], rm_[3]);
                }
                if (lat) { sb += __shfl_xor(sb, 16); sb += __shfl_xor(sb, 32); if (q == 0) SB[(size_t)(S2_ROW0(ci) + (d ? 15 - tt : tt)) * NH + h] = sb; }
                s16x8 KaF[2], BmF[2], KmF[2], RmF[2], VF[2];
#pragma unroll
                for (int kb = 0; kb < 2; ++kb) { KaF[kb] = mk8(KaP[2 * kb][0], KaP[2 * kb][1], KaP[2 * kb + 1][0], KaP[2 * kb + 1][1]); BmF[kb] = mk8(BmP[2 * kb][0], BmP[2 * kb][1], BmP[2 * kb + 1][0], BmP[2 * kb + 1][1]);
                    KmF[kb] = mk8(KmP[2 * kb][0], KmP[2 * kb][1], KmP[2 * kb + 1][0], KmP[2 * kb + 1][1]); RmF[kb] = mk8(RmP[2 * kb][0], RmP[2 * kb][1], RmP[2 * kb + 1][0], RmP[2 * kb + 1][1]);
                    VF[kb] = mk8(VP[2 * kb][0], VP[2 * kb][1], VP[2 * kb + 1][0], VP[2 * kb + 1][1]); }
                const f32x4 Z = (f32x4){0.f, 0.f, 0.f, 0.f};
                f32x4 Nd = mfma16(KaF[1], BmF[1], mfma16(KaF[0], BmF[0], Z));
                f32x4 Nt = mfma16(BmF[1], KaF[1], mfma16(BmF[0], KaF[0], Z));
                f32x4 AakT = mfma16(KmF[1], KaF[1], mfma16(KmF[0], KaF[0], Z));
                f32x4 ArbT = mfma16(BmF[1], RmF[1], mfma16(BmF[0], RmF[0], Z));
                f32x4 ArkT = mfma16(KmF[1], RmF[1], mfma16(KmF[0], RmF[0], Z));
                f32x4 Q0;
#pragma unroll
                for (int r = 0; r < 4; ++r) { const int row = 4 * q + r;
                    Nd[r] = row > tt ? Nd[r] : 0.f; Nt[r] = row < tt ? Nt[r] : 0.f; AakT[r] = row < tt ? AakT[r] : 0.f; ArbT[r] = row <= tt ? ArbT[r] : 0.f; ArkT[r] = row <= tt ? ArkT[r] : 0.f;
                    Q0[r] = (row == tt ? 1.0f : 0.f) - Nt[r]; }
                const s16x8 oN = mk_d(Nd), oNt = mk_d(Nt);
                const f32x4 N2 = mfma16(oNt, oN, Z), N2t = mfma16(oN, oNt, Z);
                const s16x8 oN2 = mk_d(N2), oN2t = mk_d(N2t);
                const f32x4 N4 = mfma16(oN2t, oN2, Z), N4t = mfma16(oN2, oN2t, Z);
                const s16x8 oN4 = mk_d(N4), oN4t = mk_d(N4t);
                const f32x4 N8 = mfma16(oN4t, oN4, Z);
                const f32x4 Q1 = mfma16(oN2, mk_d(Q0), Q0);
                const f32x4 Q2 = mfma16(oN4, mk_d(Q1), Q1);
                const f32x4 Q3 = mfma16(mk_d(N8), mk_d(Q2), Q2);
                *(LAS u32x4*)(slot_w + SL_KA + lane * 16) = __builtin_bit_cast(u32x4, KaF[0]); *(LAS u32x4*)(slot_w + SL_KA + 1024 + lane * 16) = __builtin_bit_cast(u32x4, KaF[1]);
                *(LAS u32x4*)(slot_w + SL_RM + lane * 16) = __builtin_bit_cast(u32x4, RmF[0]); *(LAS u32x4*)(slot_w + SL_RM + 1024 + lane * 16) = __builtin_bit_cast(u32x4, RmF[1]);
                *(LAS u32x2*)(slot_w + SL_TN + lane * 8) = (u32x2){pk2(-Q3[0], -Q3[1]), pk2(-Q3[2], -Q3[3])};
                *(LAS u32x2*)(slot_w + SL_AAK + lane * 8) = (u32x2){pk2(AakT[0], AakT[1]), pk2(AakT[2], AakT[3])};
                *(LAS u32x4*)(slot_w + SL_ARK + lane * 16) = (u32x4){pk2(ArbT[0], ArbT[1]), pk2(ArbT[2], ArbT[3]), pk2(ArkT[0], ArkT[1]), pk2(ArkT[2], ArkT[3])};
#pragma unroll
                for (int kb = 0; kb < 2; ++kb)
#pragma unroll
                    for (int sel = 0; sel < 2; ++sel) { const int tk = 2 * kb + sel;
                        const f32x4 DB = mfma16(BmF[kb], SelF[sel], Z), DK = mfma16(KmF[kb], SelF[sel], Z), DV = mfma16(VF[kb], SelF[sel], Z);
                        *(LAS u32x4*)(slot_w + SL_BK + tk * 1024 + lane * 16) = (u32x4){pk2(DB[0], DB[1]), pk2(DB[2], DB[3]), pk2(DK[0], DK[1]), pk2(DK[2], DK[3])};
                        *(LAS u32x2*)(slot_w + SL_VC + tk * 512 + lane * 8) = (u32x2){pk2(DV[0], DV[1]), pk2(DV[2], DV[3])}; }
                if (tt == 15) {
#pragma unroll
                    for (int g = 0; g < 4; ++g) *(LAS f32x4*)(slot_w + SL_GC + (g * 4 + q) * 16) = gend[g]; }
            }
            __syncthreads();
            if (F.wave < 4) {
                const int tv = F.wave;
                for (int sl = 0; sl < 8; ++sl) {
                    LAS unsigned char* S = F.lds + sl * SL_BYTES; const int cj = rnd * 8 + sl;
                    const s16x8 KA0 = __builtin_bit_cast(s16x8, *(LAS u32x4*)(S + SL_KA + lane * 16)), KA1 = __builtin_bit_cast(s16x8, *(LAS u32x4*)(S + SL_KA + 1024 + lane * 16));
                    const u32x2 aak = *(LAS u32x2*)(S + SL_AAK + lane * 8), tn = *(LAS u32x2*)(S + SL_TN + lane * 8), vc = *(LAS u32x2*)(S + SL_VC + tv * 512 + lane * 8);
                    const s16x8 Gb0 = mk8(pk2(G[0][0], G[0][1]), pk2(G[0][2], G[0][3]), pk2(G[1][0], G[1][1]), pk2(G[1][2], G[1][3]));
                    const s16x8 Gb1 = mk8(pk2(G[2][0], G[2][1]), pk2(G[2][2], G[2][3]), pk2(G[3][0], G[3][1]), pk2(G[3][2], G[3][3]));
                    const f32x4 Z = (f32x4){0.f, 0.f, 0.f, 0.f};
                    f32x4 P = mfma16(KA0, Gb0, Z); P = mfma16(KA1, Gb1, P); P = mfma16(mk8(aak.x, aak.y, 0u, 0u), mk8(vc.x, vc.y, 0u, 0u), P);
                    const f32x4 U = mfma16(mk8(tn.x, tn.y, 0u, 0u), mk_d(P), Z);
                    const s16x8 UV = mk8(pk2(U[0], U[1]), pk2(U[2], U[3]), vc.x, vc.y);
                    if (lat) {
                        const s16x8 RM0 = __builtin_bit_cast(s16x8, *(LAS u32x4*)(S + SL_RM + lane * 16)), RM1 = __builtin_bit_cast(s16x8, *(LAS u32x4*)(S + SL_RM + 1024 + lane * 16));
                        const s16x8 ARK = __builtin_bit_cast(s16x8, *(LAS u32x4*)(S + SL_ARK + lane * 16));
                        f32x4 Y = mfma16(Gb0, RM0, Z); Y = mfma16(Gb1, RM1, Y); Y = mfma16(UV, ARK, Y);
                        *(u32x2*)(YD + (size_t)(S2_ROW0(cj) + (d ? 15 - tt : tt)) * D + h * HS + 16 * tv + 4 * q) = (u32x2){pk2(Y[0], Y[1]), pk2(Y[2], Y[3])};
                    }
#pragma unroll
                    for (int tk = 0; tk < 4; ++tk) { const s16x8 BK = __builtin_bit_cast(s16x8, *(LAS u32x4*)(S + SL_BK + tk * 1024 + lane * 16));
                        G[tk] = mfma16(BK, UV, G[tk]); G[tk] = G[tk] * *(LAS f32x4*)(S + SL_GC + (tk * 4 + q) * 16); }
                }
            }
            __syncthreads();
        }
#undef S2_ROW0
#undef S2_LOAD
    }
    __syncthreads();
}

__device__ __forceinline__ void p4_scan3(const Frame& F, const Args& a, unsigned char* yd_base, float* sb_base, int clo, int chi) {
    const int lane = lane_id(), tt = lane & 15, q = lane >> 4;
    const bf16_t* KX = (const bf16_t*)(F.ws + A_KX); const bf16_t* VV = (const bf16_t*)(F.ws + A_V); const bf16_t* RR = (const bf16_t*)(F.ws + A_R);
    const bf16_t* EW = (const bf16_t*)(F.ws + A_EW); const bf16_t* AA = (const bf16_t*)(F.ws + A_AA);
    LAS float* PAR = (LAS float*)(F.lds + SC_PAR);
    LAS unsigned* CNT = (LAS unsigned*)(F.lds + SC_PAR + 1024);
    s16x8 SelF[2];
#pragma unroll
    for (int sel = 0; sel < 2; ++sel) { unsigned w[4];
#pragma unroll
        for (int jj = 0; jj < 4; ++jj) { const int j0 = 2 * jj, j1 = 2 * jj + 1; const bool h0 = (q == (tt >> 2)) && (j0 == 4 * sel + (tt & 3)), h1 = (q == (tt >> 2)) && (j1 == 4 * sel + (tt & 3));
            w[jj] = (h0 ? 0x3f80u : 0u) | (h1 ? 0x3f800000u : 0u); }
        SelF[sel] = mk8(w[0], w[1], w[2], w[3]); }
    { const int s = blockIdx.x;
        const int b = s >> 6, h = (s >> 1) & 31, d = s & 1;
        bf16_t* YD = (bf16_t*)(yd_base + (size_t)d * 32 * MiB); float* SB = sb_base + (size_t)d * ML * NH;
        __syncthreads();
        if (F.wave == 0) { PAR[lane] = a.in[I_KK][h * HS + lane]; PAR[64 + lane] = a.in[I_KA][h * HS + lane]; PAR[128 + lane] = a.in[I_RK][h * HS + lane]; if (lane == 0) CNT[0] = 0u; }
        __syncthreads();
        if (F.wave >= 4) { p0_transpose_range(F, a, clo, chi, (int)blockIdx.x * 4 + (F.wave - 4), 4 * 256, (LAS unsigned*)(F.lds + 102400 + (F.wave - 4) * 8448)); }
        else {
        f32x4 G[4];
#pragma unroll
        for (int tk = 0; tk < 4; ++tk) G[tk] = (f32x4){0.f, 0.f, 0.f, 0.f};
#define S2_ROW0(ci) (((ci) < 16) ? (ML + b * TC + (d ? 15 - (ci) : (ci)) * 16) : (b * T + (d ? 127 - ((ci) - 16) : ((ci) - 16)) * 16))
        u32x2 rk[4], rv[4], rr[4], re[4], ra[4];
#define S2_LOAD(ci) do { const int row_ = S2_ROW0(ci) + (d ? 15 - tt : tt); const size_t o_ = (size_t)row_ * D + h * HS + 4 * q, o2_ = (size_t)row_ * (2 * D) + d * D + h * HS + 4 * q; \
        _Pragma("unroll") for (int g_ = 0; g_ < 4; ++g_) { rk[g_] = *(const u32x2*)(KX + o_ + 16 * g_); rv[g_] = *(const u32x2*)(VV + o_ + 16 * g_); \
            rr[g_] = ((ci) >= 16) ? *(const u32x2*)(RR + o_ + 16 * g_) : (u32x2){0u, 0u}; re[g_] = *(const u32x2*)(EW + o2_ + 16 * g_); ra[g_] = *(const u32x2*)(AA + o2_ + 16 * g_); } } while (0)
        S2_LOAD(F.wave);
        for (int rnd = 0; rnd < 36; ++rnd) {
            const int ci = rnd * 4 + F.wave; const bool lat = rnd >= 4;
            LAS unsigned char* slot_w = F.lds + ((rnd & 1) * 4 + F.wave) * SL_BYTES;
            {
                float kf[4][4], af[4][4], ef[4][4], vf[4][4], rf[4][4];
#pragma unroll
                for (int g = 0; g < 4; ++g) {
                    kf[g][0] = bflo(rk[g].x); kf[g][1] = bfhi(rk[g].x); kf[g][2] = bflo(rk[g].y); kf[g][3] = bfhi(rk[g].y);
                    af[g][0] = bflo(ra[g].x); af[g][1] = bfhi(ra[g].x); af[g][2] = bflo(ra[g].y); af[g][3] = bfhi(ra[g].y);
                    ef[g][0] = bflo(re[g].x); ef[g][1] = bfhi(re[g].x); ef[g][2] = bflo(re[g].y); ef[g][3] = bfhi(re[g].y);
                    vf[g][0] = bflo(rv[g].x); vf[g][1] = bfhi(rv[g].x); vf[g][2] = bflo(rv[g].y); vf[g][3] = bfhi(rv[g].y);
                    rf[g][0] = bflo(rr[g].x); rf[g][1] = bfhi(rr[g].x); rf[g][2] = bflo(rr[g].y); rf[g][3] = bfhi(rr[g].y); }
                unsigned VP[4][2];
#pragma unroll
                for (int g = 0; g < 4; ++g) { VP[g][0] = rv[g].x; VP[g][1] = rv[g].y; }
                if (rnd + 1 < 36) S2_LOAD((rnd + 1) * 4 + F.wave);
                float kkv[4][4]; float n2 = 0.f;
#pragma unroll
                for (int g = 0; g < 4; ++g) { const f32x4 kc = *(const LAS f32x4*)(PAR + 16 * g + 4 * q);
#pragma unroll
                    for (int i = 0; i < 4; ++i) { kkv[g][i] = kf[g][i] * kc[i]; n2 += kkv[g][i] * kkv[g][i]; } }
                n2 += __shfl_xor(n2, 16); n2 += __shfl_xor(n2, 32);
                const float inv = 1.0f / fmaxf(sqrtf(n2), 1e-12f);
                float sb = 0.f;
                unsigned KaP[4][2], BmP[4][2], KmP[4][2], RmP[4][2]; f32x4 gend[4];
#pragma unroll
                for (int g = 0; g < 4; ++g) { const f32x4 kac = *(const LAS f32x4*)(PAR + 64 + 16 * g + 4 * q), rkc = *(const LAS f32x4*)(PAR + 128 + 16 * g + 4 * q);
                    float ka_[4], bm_[4], km_[4], rm_[4];
#pragma unroll
                    for (int i = 0; i < 4; ++i) {
                        float L = ef[g][i];
                        L += dpp_f<0x111>(L); L += dpp_f<0x112>(L); L += dpp_f<0x114>(L); L += dpp_f<0x118>(L);
                        const float gt = fexp(-L), gi = fexp(L); float gm1 = dpp_f<0x111>(gt); gm1 = (tt == 0) ? 1.0f : gm1;
                        const float kk = kkv[g][i] * inv, kd = kf[g][i] * (1.0f + (af[g][i] - 1.0f) * kac[i]);
                        ka_[i] = kk * gm1; bm_[i] = kk * af[g][i] * gi; km_[i] = kd * gi; rm_[i] = rf[g][i] * gt;
                        sb += rf[g][i] * kd * rkc[i]; gend[g][i] = gt; }
                    KaP[g][0] = pk2(ka_[0], ka_[1]); KaP[g][1] = pk2(ka_[2], ka_[3]); BmP[g][0] = pk2(bm_[0], bm_[1]); BmP[g][1] = pk2(bm_[2], bm_[3]);
                    KmP[g][0] = pk2(km_[0], km_[1]); KmP[g][1] = pk2(km_[2], km_[3]); RmP[g][0] = pk2(rm_[0], rm_[1]); RmP[g][1] = pk2(rm_[2], rm_[3]);
                }
                if (lat) { sb += __shfl_xor(sb, 16); sb += __shfl_xor(sb, 32); if (q == 0) SB[(size_t)(S2_ROW0(ci) + (d ? 15 - tt : tt)) * NH + h] = sb; }
                s16x8 KaF[2], BmF[2], KmF[2], RmF[2], VF[2];
#pragma unroll
                for (int kb = 0; kb < 2; ++kb) { KaF[kb] = mk8(KaP[2 * kb][0], KaP[2 * kb][1], KaP[2 * kb + 1][0], KaP[2 * kb + 1][1]); BmF[kb] = mk8(BmP[2 * kb][0], BmP[2 * kb][1], BmP[2 * kb + 1][0], BmP[2 * kb + 1][1]);
                    KmF[kb] = mk8(KmP[2 * kb][0], KmP[2 * kb][1], KmP[2 * kb + 1][0], KmP[2 * kb + 1][1]); RmF[kb] = mk8(RmP[2 * kb][0], RmP[2 * kb][1], RmP[2 * kb + 1][0], RmP[2 * kb + 1][1]);
                    VF[kb] = mk8(VP[2 * kb][0], VP[2 * kb][1], VP[2 * kb + 1][0], VP[2 * kb + 1][1]); }
                const f32x4 Z = (f32x4){0.f, 0.f, 0.f, 0.f};
                f32x4 Nd = mfma16(KaF[1], BmF[1], mfma16(KaF[0], BmF[0], Z));
                f32x4 Nt = mfma16(BmF[1], KaF[1], mfma16(BmF[0], KaF[0], Z));
                f32x4 AakT = mfma16(KmF[1], KaF[1], mfma16(KmF[0], KaF[0], Z));
                f32x4 ArbT = mfma16(BmF[1], RmF[1], mfma16(BmF[0], RmF[0], Z));
                f32x4 ArkT = mfma16(KmF[1], RmF[1], mfma16(KmF[0], RmF[0], Z));
                f32x4 Q0;
#pragma unroll
                for (int r = 0; r < 4; ++r) { const int row = 4 * q + r;
                    Nd[r] = row > tt ? Nd[r] : 0.f; Nt[r] = row < tt ? Nt[r] : 0.f; AakT[r] = row < tt ? AakT[r] : 0.f; ArbT[r] = row <= tt ? ArbT[r] : 0.f; ArkT[r] = row <= tt ? ArkT[r] : 0.f;
                    Q0[r] = (row == tt ? 1.0f : 0.f) - Nt[r]; }
                const s16x8 oN = mk_d(Nd), oNt = mk_d(Nt);
                const f32x4 N2 = mfma16(oNt, oN, Z), N2t = mfma16(oN, oNt, Z);
                const s16x8 oN2 = mk_d(N2), oN2t = mk_d(N2t);
                const f32x4 N4 = mfma16(oN2t, oN2, Z), N4t = mfma16(oN2, oN2t, Z);
                const s16x8 oN4 = mk_d(N4), oN4t = mk_d(N4t);
                const f32x4 N8 = mfma16(oN4t, oN4, Z);
                const f32x4 Q1 = mfma16(oN2, mk_d(Q0), Q0);
                const f32x4 Q2 = mfma16(oN4, mk_d(Q1), Q1);
                const f32x4 Q3 = mfma16(mk_d(N8), mk_d(Q2), Q2);
                *(LAS u32x4*)(slot_w + SL_KA + lane * 16) = __builtin_bit_cast(u32x4, KaF[0]); *(LAS u32x4*)(slot_w + SL_KA + 1024 + lane * 16) = __builtin_bit_cast(u32x4, KaF[1]);
                *(LAS u32x4*)(slot_w + SL_RM + lane * 16) = __builtin_bit_cast(u32x4, RmF[0]); *(LAS u32x4*)(slot_w + SL_RM + 1024 + lane * 16) = __builtin_bit_cast(u32x4, RmF[1]);
                *(LAS u32x2*)(slot_w + SL_TN + lane * 8) = (u32x2){pk2(-Q3[0], -Q3[1]), pk2(-Q3[2], -Q3[3])};
                *(LAS u32x2*)(slot_w + SL_AAK + lane * 8) = (u32x2){pk2(AakT[0], AakT[1]), pk2(AakT[2], AakT[3])};
                *(LAS u32x4*)(slot_w + SL_ARK + lane * 16) = (u32x4){pk2(ArbT[0], ArbT[1]), pk2(ArbT[2], ArbT[3]), pk2(ArkT[0], ArkT[1]), pk2(ArkT[2], ArkT[3])};
#pragma unroll
                for (int kb = 0; kb < 2; ++kb)
#pragma unroll
                    for (int sel = 0; sel < 2; ++sel) { const int tk = 2 * kb + sel;
                        const f32x4 DB = mfma16(BmF[kb], SelF[sel], Z), DK = mfma16(KmF[kb], SelF[sel], Z), DV = mfma16(VF[kb], SelF[sel], Z);
                        *(LAS u32x4*)(slot_w + SL_BK + tk * 1024 + lane * 16) = (u32x4){pk2(DB[0], DB[1]), pk2(DB[2], DB[3]), pk2(DK[0], DK[1]), pk2(DK[2], DK[3])};
                        *(LAS u32x2*)(slot_w + SL_VC + tk * 512 + lane * 8) = (u32x2){pk2(DV[0], DV[1]), pk2(DV[2], DV[3])}; }
                if (tt == 15) {
#pragma unroll
                    for (int g = 0; g < 4; ++g) *(LAS f32x4*)(slot_w + SL_GC + (g * 4 + q) * 16) = gend[g]; }
            }
            __builtin_amdgcn_fence(__ATOMIC_RELEASE, "workgroup");
            if (lane == 0) __hip_atomic_fetch_add(CNT, 1u, __ATOMIC_RELAXED, __HIP_MEMORY_SCOPE_WORKGROUP);
            { unsigned spins = 0; while (__hip_atomic_load(CNT, __ATOMIC_RELAXED, __HIP_MEMORY_SCOPE_WORKGROUP) < 4u * (unsigned)(rnd + 1)) { __builtin_amdgcn_s_sleep(1); if (++spins > (1u << 22)) break; } }
            __builtin_amdgcn_fence(__ATOMIC_ACQUIRE, "workgroup");
            {
                const int tv = F.wave;
                for (int sl = 0; sl < 4; ++sl) {
                    LAS unsigned char* S = F.lds + ((rnd & 1) * 4 + sl) * SL_BYTES; const int cj = rnd * 4 + sl;
                    const s16x8 KA0 = __builtin_bit_cast(s16x8, *(LAS u32x4*)(S + SL_KA + lane * 16)), KA1 = __builtin_bit_cast(s16x8, *(LAS u32x4*)(S + SL_KA + 1024 + lane * 16));
                    const u32x2 aak = *(LAS u32x2*)(S + SL_AAK + lane * 8), tn = *(LAS u32x2*)(S + SL_TN + lane * 8), vc = *(LAS u32x2*)(S + SL_VC + tv * 512 + lane * 8);
                    const s16x8 Gb0 = mk8(pk2(G[0][0], G[0][1]), pk2(G[0][2], G[0][3]), pk2(G[1][0], G[1][1]), pk2(G[1][2], G[1][3]));
                    const s16x8 Gb1 = mk8(pk2(G[2][0], G[2][1]), pk2(G[2][2], G[2][3]), pk2(G[3][0], G[3][1]), pk2(G[3][2], G[3][3]));
                    const f32x4 Z = (f32x4){0.f, 0.f, 0.f, 0.f};
                    f32x4 P = mfma16(KA0, Gb0, Z); P = mfma16(KA1, Gb1, P); P = mfma16(mk8(aak.x, aak.y, 0u, 0u), mk8(vc.x, vc.y, 0u, 0u), P);
                    const f32x4 U = mfma16(mk8(tn.x, tn.y, 0u, 0u), mk_d(P), Z);
                    const s16x8 UV = mk8(pk2(U[0], U[1]), pk2(U[2], U[3]), vc.x, vc.y);
                    if (lat) {
                        const s16x8 RM0 = __builtin_bit_cast(s16x8, *(LAS u32x4*)(S + SL_RM + lane * 16)), RM1 = __builtin_bit_cast(s16x8, *(LAS u32x4*)(S + SL_RM + 1024 + lane * 16));
                        const s16x8 ARK = __builtin_bit_cast(s16x8, *(LAS u32x4*)(S + SL_ARK + lane * 16));
                        f32x4 Y = mfma16(Gb0, RM0, Z); Y = mfma16(Gb1, RM1, Y); Y = mfma16(UV, ARK, Y);
                        *(u32x2*)(YD + (size_t)(S2_ROW0(cj) + (d ? 15 - tt : tt)) * D + h * HS + 16 * tv + 4 * q) = (u32x2){pk2(Y[0], Y[1]), pk2(Y[2], Y[3])};
                    }
#pragma unroll
                    for (int tk = 0; tk < 4; ++tk) { const s16x8 BK = __builtin_bit_cast(s16x8, *(LAS u32x4*)(S + SL_BK + tk * 1024 + lane * 16));
                        G[tk] = mfma16(BK, UV, G[tk]); G[tk] = G[tk] * *(LAS f32x4*)(S + SL_GC + (tk * 4 + q) * 16); }
                }
            }
        }
        }
#undef S2_ROW0
#undef S2_LOAD
    }
    __syncthreads();
}

__device__ __forceinline__ void p4_scan4(const Frame& F, const Args& a, unsigned char* yd_base, float* sb_base) {
    const int lane = lane_id(), tt = lane & 15, q = lane >> 4;
    const bf16_t* KX = (const bf16_t*)(F.ws + A_KX); const bf16_t* VV = (const bf16_t*)(F.ws + A_V); const bf16_t* RR = (const bf16_t*)(F.ws + A_R);
    const bf16_t* EW = (const bf16_t*)(F.ws + A_EW); const bf16_t* AA = (const bf16_t*)(F.ws + A_AA);
    LAS float* PAR = (LAS float*)(F.lds + SC_PAR);
    LAS unsigned* CNT = (LAS unsigned*)(F.lds + SC_PAR + 1024);
    s16x8 SelF[2];
#pragma unroll
    for (int sel = 0; sel < 2; ++sel) { unsigned w[4];
#pragma unroll
        for (int jj = 0; jj < 4; ++jj) { const int j0 = 2 * jj, j1 = 2 * jj + 1; const bool h0 = (q == (tt >> 2)) && (j0 == 4 * sel + (tt & 3)), h1 = (q == (tt >> 2)) && (j1 == 4 * sel + (tt & 3));
            w[jj] = (h0 ? 0x3f80u : 0u) | (h1 ? 0x3f800000u : 0u); }
        SelF[sel] = mk8(w[0], w[1], w[2], w[3]); }
    { const int s = blockIdx.x;
        const int b = s >> 6, h = (s >> 1) & 31, d = s & 1;
        bf16_t* YD = (bf16_t*)(yd_base + (size_t)d * 32 * MiB); float* SB = sb_base + (size_t)d * ML * NH;
        __syncthreads();
        if (F.wave == 0) { PAR[lane] = a.in[I_KK][h * HS + lane]; PAR[64 + lane] = a.in[I_KA][h * HS + lane]; PAR[128 + lane] = a.in[I_RK][h * HS + lane]; if (lane < 8) CNT[lane] = 0u; }
        __syncthreads();
        if (F.wave >= 4) {
        const int pw = F.wave - 4;
#define S2_ROW0(ci) (((ci) < 16) ? (ML + b * TC + (d ? 15 - (ci) : (ci)) * 16) : (b * T + (d ? 127 - ((ci) - 16) : ((ci) - 16)) * 16))
        u32x2 rk[4], rv[4], rr[4], re[4], ra[4];
#define S2_LOAD(ci) do { const int row_ = S2_ROW0(ci) + (d ? 15 - tt : tt); const size_t o_ = (size_t)row_ * D + h * HS + 4 * q, o2_ = (size_t)row_ * (2 * D) + d * D + h * HS + 4 * q; \
        _Pragma("unroll") for (int g_ = 0; g_ < 4; ++g_) { rk[g_] = *(const u32x2*)(KX + o_ + 16 * g_); rv[g_] = *(const u32x2*)(VV + o_ + 16 * g_); \
            rr[g_] = ((ci) >= 16) ? *(const u32x2*)(RR + o_ + 16 * g_) : (u32x2){0u, 0u}; re[g_] = *(const u32x2*)(EW + o2_ + 16 * g_); ra[g_] = *(const u32x2*)(AA + o2_ + 16 * g_); } } while (0)
        S2_LOAD(pw);
        for (int rnd = 0; rnd < 36; ++rnd) {
            const int ci = rnd * 4 + pw; const bool lat = rnd >= 4;
            LAS unsigned char* slot_w = F.lds + ((rnd & 1) * 4 + pw) * SL_BYTES;
            if (rnd >= 2) { unsigned spins = 0;
                for (;;) { const unsigned d0 = __hip_atomic_load(CNT + 4, __ATOMIC_RELAXED, __HIP_MEMORY_SCOPE_WORKGROUP), d1 = __hip_atomic_load(CNT + 5, __ATOMIC_RELAXED, __HIP_MEMORY_SCOPE_WORKGROUP), d2 = __hip_atomic_load(CNT + 6, __ATOMIC_RELAXED, __HIP_MEMORY_SCOPE_WORKGROUP), d3 = __hip_atomic_load(CNT + 7, __ATOMIC_RELAXED, __HIP_MEMORY_SCOPE_WORKGROUP);
                    const unsigned need = (unsigned)(rnd - 1); if ((d0 >= need && d1 >= need && d2 >= need && d3 >= need) || ++spins > (1u << 22)) break; __builtin_amdgcn_s_sleep(1); }
                __builtin_amdgcn_fence(__ATOMIC_ACQUIRE, "workgroup"); }
            {
                float kf[4][4], af[4][4], ef[4][4], vf[4][4], rf[4][4];
#pragma unroll
                for (int g = 0; g < 4; ++g) {
                    kf[g][0] = bflo(rk[g].x); kf[g][1] = bfhi(rk[g].x); kf[g][2] = bflo(rk[g].y); kf[g][3] = bfhi(rk[g].y);
                    af[g][0] = bflo(ra[g].x); af[g][1] = bfhi(ra[g].x); af[g][2] = bflo(ra[g].y); af[g][3] = bfhi(ra[g].y);
                    ef[g][0] = bflo(re[g].x); ef[g][1] = bfhi(re[g].x); ef[g][2] = bflo(re[g].y); ef[g][3] = bfhi(re[g].y);
                    vf[g][0] = bflo(rv[g].x); vf[g][1] = bfhi(rv[g].x); vf[g][2] = bflo(rv[g].y); vf[g][3] = bfhi(rv[g].y);
                    rf[g][0] = bflo(rr[g].x); rf[g][1] = bfhi(rr[g].x); rf[g][2] = bflo(rr[g].y); rf[g][3] = bfhi(rr[g].y); }
                unsigned VP[4][2];
#pragma unroll
                for (int g = 0; g < 4; ++g) { VP[g][0] = rv[g].x; VP[g][1] = rv[g].y; }
                if (rnd + 1 < 36) S2_LOAD((rnd + 1) * 4 + pw);
                float kkv[4][4]; float n2 = 0.f;
#pragma unroll
                for (int g = 0; g < 4; ++g) { const f32x4 kc = *(const LAS f32x4*)(PAR + 16 * g + 4 * q);
#pragma unroll
                    for (int i = 0; i < 4; ++i) { kkv[g][i] = kf[g][i] * kc[i]; n2 += kkv[g][i] * kkv[g][i]; } }
                n2 += __shfl_xor(n2, 16); n2 += __shfl_xor(n2, 32);
                const float inv = 1.0f / fmaxf(sqrtf(n2), 1e-12f);
                float sb = 0.f;
                unsigned KaP[4][2], BmP[4][2], KmP[4][2], RmP[4][2]; f32x4 gend[4];
#pragma unroll
                for (int g = 0; g < 4; ++g) { const f32x4 kac = *(const LAS f32x4*)(PAR + 64 + 16 * g + 4 * q), rkc = *(const LAS f32x4*)(PAR + 128 + 16 * g + 4 * q);
                    float ka_[4], bm_[4], km_[4], rm_[4];
#pragma unroll
                    for (int i = 0; i < 4; ++i) {
                        float L = ef[g][i];
                        L += dpp_f<0x111>(L); L += dpp_f<0x112>(L); L += dpp_f<0x114>(L); L += dpp_f<0x118>(L);
                        const float gt = fexp(-L), gi = fexp(L); float gm1 = dpp_f<0x111>(gt); gm1 = (tt == 0) ? 1.0f : gm1;
                        const float kk = kkv[g][i] * inv, kd = kf[g][i] * (1.0f + (af[g][i] - 1.0f) * kac[i]);
                        ka_[i] = kk * gm1; bm_[i] = kk * af[g][i] * gi; km_[i] = kd * gi; rm_[i] = rf[g][i] * gt;
                        sb += rf[g][i] * kd * rkc[i]; gend[g][i] = gt; }
                    KaP[g][0] = pk2(ka_[0], ka_[1]); KaP[g][1] = pk2(ka_[2], ka_[3]); BmP[g][0] = pk2(bm_[0], bm_[1]); BmP[g][1] = pk2(bm_[2], bm_[3]);
                    KmP[g][0] = pk2(km_[0], km_[1]); KmP[g][1] = pk2(km_[2], km_[3]); RmP[g][0] = pk2(rm_[0], rm_[1]); RmP[g][1] = pk2(rm_[2], rm_[3]);
                }
                if (lat) { sb += __shfl_xor(sb, 16); sb += __shfl_xor(sb, 32); if (q == 0) SB[(size_t)(S2_ROW0(ci) + (d ? 15 - tt : tt)) * NH + h] = sb; }
                s16x8 KaF[2], BmF[2], KmF[2], RmF[2], VF[2];
#pragma unroll
                for (int kb = 0; kb < 2; ++kb) { KaF[kb] = mk8(KaP[2 * kb][0], KaP[2 * kb][1], KaP[2 * kb + 1][0], KaP[2 * kb + 1][1]); BmF[kb] = mk8(BmP[2 * kb][0], BmP[2 * kb][1], BmP[2 * kb + 1][0], BmP[2 * kb + 1][1]);
                    KmF[kb] = mk8(KmP[2 * kb][0], KmP[2 * kb][1], KmP[2 * kb + 1][0], KmP[2 * kb + 1][1]); RmF[kb] = mk8(RmP[2 * kb][0], RmP[2 * kb][1], RmP[2 * kb + 1][0], RmP[2 * kb + 1][1]);
                    VF[kb] = mk8(VP[2 * kb][0], VP[2 * kb][1], VP[2 * kb + 1][0], VP[2 * kb + 1][1]); }
                const f32x4 Z = (f32x4){0.f, 0.f, 0.f, 0.f};
                f32x4 Nd = mfma16(KaF[1], BmF[1], mfma16(KaF[0], BmF[0], Z));
                f32x4 Nt = mfma16(BmF[1], KaF[1], mfma16(BmF[0], KaF[0], Z));
                f32x4 AakT = mfma16(KmF[1], KaF[1], mfma16(KmF[0], KaF[0], Z));
                f32x4 ArbT = mfma16(BmF[1], RmF[1], mfma16(BmF[0], RmF[0], Z));
                f32x4 ArkT = mfma16(KmF[1], RmF[1], mfma16(KmF[0], RmF[0], Z));
                f32x4 Q0;
#pragma unroll
                for (int r = 0; r < 4; ++r) { const int row = 4 * q + r;
                    Nd[r] = row > tt ? Nd[r] : 0.f; Nt[r] = row < tt ? Nt[r] : 0.f; AakT[r] = row < tt ? AakT[r] : 0.f; ArbT[r] = row <= tt ? ArbT[r] : 0.f; ArkT[r] = row <= tt ? ArkT[r] : 0.f;
                    Q0[r] = (row == tt ? 1.0f : 0.f) - Nt[r]; }
                const s16x8 oN = mk_d(Nd), oNt = mk_d(Nt);
                const f32x4 N2 = mfma16(oNt, oN, Z), N2t = mfma16(oN, oNt, Z);
                const s16x8 oN2 = mk_d(N2), oN2t = mk_d(N2t);
                const f32x4 N4 = mfma16(oN2t, oN2, Z), N4t = mfma16(oN2, oN2t, Z);
                const s16x8 oN4 = mk_d(N4), oN4t = mk_d(N4t);
                const f32x4 N8 = mfma16(oN4t, oN4, Z);
                const f32x4 Q1 = mfma16(oN2, mk_d(Q0), Q0);
                const f32x4 Q2 = mfma16(oN4, mk_d(Q1), Q1);
                const f32x4 Q3 = mfma16(mk_d(N8), mk_d(Q2), Q2);
                *(LAS u32x4*)(slot_w + SL_KA + lane * 16) = __builtin_bit_cast(u32x4, KaF[0]); *(LAS u32x4*)(slot_w + SL_KA + 1024 + lane * 16) = __builtin_bit_cast(u32x4, KaF[1]);
                *(LAS u32x4*)(slot_w + SL_RM + lane * 16) = __builtin_bit_cast(u32x4, RmF[0]); *(LAS u32x4*)(slot_w + SL_RM + 1024 + lane * 16) = __builtin_bit_cast(u32x4, RmF[1]);
                *(LAS u32x2*)(slot_w + SL_TN + lane * 8) = (u32x2){pk2(-Q3[0], -Q3[1]), pk2(-Q3[2], -Q3[3])};
                *(LAS u32x2*)(slot_w + SL_AAK + lane * 8) = (u32x2){pk2(AakT[0], AakT[1]), pk2(AakT[2], AakT[3])};
                *(LAS u32x4*)(slot_w + SL_ARK + lane * 16) = (u32x4){pk2(ArbT[0], ArbT[1]), pk2(ArbT[2], ArbT[3]), pk2(ArkT[0], ArkT[1]), pk2(ArkT[2], ArkT[3])};
#pragma unroll
                for (int kb = 0; kb < 2; ++kb)
#pragma unroll
                    for (int sel = 0; sel < 2; ++sel) { const int tk = 2 * kb + sel;
                        const f32x4 DB = mfma16(BmF[kb], SelF[sel], Z), DK = mfma16(KmF[kb], SelF[sel], Z), DV = mfma16(VF[kb], SelF[sel], Z);
                        *(LAS u32x4*)(slot_w + SL_BK + tk * 1024 + lane * 16) = (u32x4){pk2(DB[0], DB[1]), pk2(DB[2], DB[3]), pk2(DK[0], DK[1]), pk2(DK[2], DK[3])};
                        *(LAS u32x2*)(slot_w + SL_VC + tk * 512 + lane * 8) = (u32x2){pk2(DV[0], DV[1]), pk2(DV[2], DV[3])}; }
                if (tt == 15) {
#pragma unroll
                    for (int g = 0; g < 4; ++g) *(LAS f32x4*)(slot_w + SL_GC + (g * 4 + q) * 16) = gend[g]; }
            }
            __builtin_amdgcn_fence(__ATOMIC_RELEASE, "workgroup");
            if (lane == 0) __hip_atomic_store(CNT + pw, (unsigned)(rnd + 1), __ATOMIC_RELAXED, __HIP_MEMORY_SCOPE_WORKGROUP);
        }
        } else {
        f32x4 G[4];
#pragma unroll
        for (int tk = 0; tk < 4; ++tk) G[tk] = (f32x4){0.f, 0.f, 0.f, 0.f};
        for (int rnd = 0; rnd < 36; ++rnd) {
            const bool lat = rnd >= 4;
            { unsigned spins = 0;
                for (;;) { const unsigned f0 = __hip_atomic_load(CNT + 0, __ATOMIC_RELAXED, __HIP_MEMORY_SCOPE_WORKGROUP), f1 = __hip_atomic_load(CNT + 1, __ATOMIC_RELAXED, __HIP_MEMORY_SCOPE_WORKGROUP), f2 = __hip_atomic_load(CNT + 2, __ATOMIC_RELAXED, __HIP_MEMORY_SCOPE_WORKGROUP), f3 = __hip_atomic_load(CNT + 3, __ATOMIC_RELAXED, __HIP_MEMORY_SCOPE_WORKGROUP);
                    const unsigned need = (unsigned)(rnd + 1); if ((f0 >= need && f1 >= need && f2 >= need && f3 >= need) || ++spins > (1u << 22)) break; __builtin_amdgcn_s_sleep(1); } }
            __builtin_amdgcn_fence(__ATOMIC_ACQUIRE, "workgroup");
            {
                const int tv = F.wave;
                for (int sl = 0; sl < 4; ++sl) {
                    LAS unsigned char* S = F.lds + ((rnd & 1) * 4 + sl) * SL_BYTES; const int cj = rnd * 4 + sl;
                    const s16x8 KA0 = __builtin_bit_cast(s16x8, *(LAS u32x4*)(S + SL_KA + lane * 16)), KA1 = __builtin_bit_cast(s16x8, *(LAS u32x4*)(S + SL_KA + 1024 + lane * 16));
                    const u32x2 aak = *(LAS u32x2*)(S + SL_AAK + lane * 8), tn = *(LAS u32x2*)(S + SL_TN + lane * 8), vc = *(LAS u32x2*)(S + SL_VC + tv * 512 + lane * 8);
                    const s16x8 Gb0 = mk8(pk2(G[0][0], G[0][1]), pk2(G[0][2], G[0][3]), pk2(G[1][0], G[1][1]), pk2(G[1][2], G[1][3]));
                    const s16x8 Gb1 = mk8(pk2(G[2][0], G[2][1]), pk2(G[2][2], G[2][3]), pk2(G[3][0], G[3][1]), pk2(G[3][2], G[3][3]));
                    const f32x4 Z = (f32x4){0.f, 0.f, 0.f, 0.f};
                    f32x4 P = mfma16(KA0, Gb0, Z); P = mfma16(KA1, Gb1, P); P = mfma16(mk8(aak.x, aak.y, 0u, 0u), mk8(vc.x, vc.y, 0u, 0u), P);
                    const f32x4 U = mfma16(mk8(tn.x, tn.y, 0u, 0u), mk_d(P), Z);
                    const s16x8 UV = mk8(pk2(U[0], U[1]), pk2(U[2], U[3]), vc.x, vc.y);
                    if (lat) {
                        const s16x8 RM0 = __builtin_bit_cast(s16x8, *(LAS u32x4*)(S + SL_RM + lane * 16)), RM1 = __builtin_bit_cast(s16x8, *(LAS u32x4*)(S + SL_RM + 1024 + lane * 16));
                        const s16x8 ARK = __builtin_bit_cast(s16x8, *(LAS u32x4*)(S + SL_ARK + lane * 16));
                        f32x4 Y = mfma16(Gb0, RM0, Z); Y = mfma16(Gb1, RM1, Y); Y = mfma16(UV, ARK, Y);
                        *(u32x2*)(YD + (size_t)(S2_ROW0(cj) + (d ? 15 - tt : tt)) * D + h * HS + 16 * tv + 4 * q) = (u32x2){pk2(Y[0], Y[1]), pk2(Y[2], Y[3])};
                    }
#pragma unroll
                    for (int tk = 0; tk < 4; ++tk) { const s16x8 BK = __builtin_bit_cast(s16x8, *(LAS u32x4*)(S + SL_BK + tk * 1024 + lane * 16));
                        G[tk] = mfma16(BK, UV, G[tk]); G[tk] = G[tk] * *(LAS f32x4*)(S + SL_GC + (tk * 4 + q) * 16); }
                }
            }
            __builtin_amdgcn_fence(__ATOMIC_RELEASE, "workgroup");
            if (lane == 0) __hip_atomic_store(CNT + 4 + F.wave, (unsigned)(rnd + 1), __ATOMIC_RELAXED, __HIP_MEMORY_SCOPE_WORKGROUP);
        }
        }
#undef S2_ROW0
#undef S2_LOAD
    }
    __syncthreads();
}

__device__ __forceinline__ void p4_scan5(const Frame& F, const Args& a, unsigned char* yd_base, float* sb_base, int clo, int chi, int job = -1) {
    const int lane = lane_id(), tt = lane & 15, q = lane >> 4;
    const bf16_t* KX = (const bf16_t*)(F.ws + A_KX); const bf16_t* VV = (const bf16_t*)(F.ws + A_V); const bf16_t* RR = (const bf16_t*)(F.ws + A_R);
    const bf16_t* EW = (const bf16_t*)(F.ws + A_EW); const bf16_t* AA = (const bf16_t*)(F.ws + A_AA);
    LAS float* PAR = (LAS float*)(F.lds + SC_PAR);
    LAS unsigned* CNT = (LAS unsigned*)(F.lds + SC_PAR + 1024);
    s16x8 SelF[2];
#pragma unroll
    for (int sel = 0; sel < 2; ++sel) { unsigned w[4];
#pragma unroll
        for (int jj = 0; jj < 4; ++jj) { const int j0 = 2 * jj, j1 = 2 * jj + 1; const bool h0 = (q == (tt >> 2)) && (j0 == 4 * sel + (tt & 3)), h1 = (q == (tt >> 2)) && (j1 == 4 * sel + (tt & 3));
            w[jj] = (h0 ? 0x3f80u : 0u) | (h1 ? 0x3f800000u : 0u); }
        SelF[sel] = mk8(w[0], w[1], w[2], w[3]); }
    { const int s = job >= 0 ? job : (int)blockIdx.x;
        const int b = s >> 6, h = (s >> 1) & 31, d = s & 1;
        bf16_t* YD = (bf16_t*)(yd_base + (size_t)d * 32 * MiB); float* SB = sb_base + (size_t)d * ML * NH;
        __syncthreads();
        if (F.wave == 0) { PAR[lane] = a.in[I_KK][h * HS + lane]; PAR[64 + lane] = a.in[I_KA][h * HS + lane]; PAR[128 + lane] = a.in[I_RK][h * HS + lane]; if (lane < 8) CNT[lane] = 0u; }
        __syncthreads();
        if (F.wave >= 4) {
        const int pw = F.wave - 4;
#define S2_ROW0(ci) (((ci) < 16) ? (ML + b * TC + (d ? 15 - (ci) : (ci)) * 16) : (b * T + (d ? 127 - ((ci) - 16) : ((ci) - 16)) * 16))
        u32x2 rk[4], rv[4], rr[4], re[4], ra[4];
#define S2_LOAD(ci) do { const int row_ = S2_ROW0(ci) + (d ? 15 - tt : tt); const size_t o_ = (size_t)row_ * D + h * HS + 4 * q, o2_ = (size_t)row_ * (2 * D) + d * D + h * HS + 4 * q; \
        _Pragma("unroll") for (int g_ = 0; g_ < 4; ++g_) { rk[g_] = *(const u32x2*)(KX + o_ + 16 * g_); rv[g_] = *(const u32x2*)(VV + o_ + 16 * g_); \
            rr[g_] = ((ci) >= 16) ? *(const u32x2*)(RR + o_ + 16 * g_) : (u32x2){0u, 0u}; re[g_] = *(const u32x2*)(EW + o2_ + 16 * g_); ra[g_] = *(const u32x2*)(AA + o2_ + 16 * g_); } } while (0)
        S2_LOAD(pw);
        for (int rnd = 0; rnd < 36; ++rnd) {
            const int ci = rnd * 4 + pw; const bool lat = rnd >= 4;
            LAS unsigned char* slot_w = F.lds + ((rnd & 1) * 4 + pw) * SL_BYTES;
            if (rnd >= 2) { unsigned spins = 0;
                for (;;) { const unsigned d0 = __hip_atomic_load(CNT + 4, __ATOMIC_RELAXED, __HIP_MEMORY_SCOPE_WORKGROUP), d1 = __hip_atomic_load(CNT + 5, __ATOMIC_RELAXED, __HIP_MEMORY_SCOPE_WORKGROUP), d2 = __hip_atomic_load(CNT + 6, __ATOMIC_RELAXED, __HIP_MEMORY_SCOPE_WORKGROUP), d3 = __hip_atomic_load(CNT + 7, __ATOMIC_RELAXED, __HIP_MEMORY_SCOPE_WORKGROUP);
                    const unsigned need = (unsigned)(rnd - 1); if ((d0 >= need && d1 >= need && d2 >= need && d3 >= need) || ++spins > (1u << 22)) break; __builtin_amdgcn_s_sleep(1); }
                __builtin_amdgcn_fence(__ATOMIC_ACQUIRE, "workgroup"); }
            {
                float kf[4][4], af[4][4], ef[4][4], vf[4][4], rf[4][4];
#pragma unroll
                for (int g = 0; g < 4; ++g) {
                    kf[g][0] = bflo(rk[g].x); kf[g][1] = bfhi(rk[g].x); kf[g][2] = bflo(rk[g].y); kf[g][3] = bfhi(rk[g].y);
                    af[g][0] = bflo(ra[g].x); af[g][1] = bfhi(ra[g].x); af[g][2] = bflo(ra[g].y); af[g][3] = bfhi(ra[g].y);
                    ef[g][0] = bflo(re[g].x); ef[g][1] = bfhi(re[g].x); ef[g][2] = bflo(re[g].y); ef[g][3] = bfhi(re[g].y);
                    vf[g][0] = bflo(rv[g].x); vf[g][1] = bfhi(rv[g].x); vf[g][2] = bflo(rv[g].y); vf[g][3] = bfhi(rv[g].y);
                    rf[g][0] = bflo(rr[g].x); rf[g][1] = bfhi(rr[g].x); rf[g][2] = bflo(rr[g].y); rf[g][3] = bfhi(rr[g].y); }
                unsigned VP[4][2];
#pragma unroll
                for (int g = 0; g < 4; ++g) { VP[g][0] = rv[g].x; VP[g][1] = rv[g].y; }
                if (rnd + 1 < 36) S2_LOAD((rnd + 1) * 4 + pw);
                float kkv[4][4]; float n2 = 0.f;
#pragma unroll
                for (int g = 0; g < 4; ++g) { const f32x4 kc = *(const LAS f32x4*)(PAR + 16 * g + 4 * q);
#pragma unroll
                    for (int i = 0; i < 4; ++i) { kkv[g][i] = kf[g][i] * kc[i]; n2 += kkv[g][i] * kkv[g][i]; } }
                n2 += __shfl_xor(n2, 16); n2 += __shfl_xor(n2, 32);
                const float inv = 1.0f / fmaxf(sqrtf(n2), 1e-12f);
                float sb = 0.f;
                unsigned KaP[4][2], BmP[4][2], KmP[4][2], RmP[4][2]; f32x4 gend[4];
#pragma unroll
                for (int g = 0; g < 4; ++g) { const f32x4 kac = *(const LAS f32x4*)(PAR + 64 + 16 * g + 4 * q), rkc = *(const LAS f32x4*)(PAR + 128 + 16 * g + 4 * q);
                    float ka_[4], bm_[4], km_[4], rm_[4];
#pragma unroll
                    for (int i = 0; i < 4; ++i) {
                        float L = ef[g][i];
                        L += dpp_f<0x111>(L); L += dpp_f<0x112>(L); L += dpp_f<0x114>(L); L += dpp_f<0x118>(L);
                        const float gt = fexp(-L), gi = fexp(L); float gm1 = dpp_f<0x111>(gt); gm1 = (tt == 0) ? 1.0f : gm1;
                        const float kk = kkv[g][i] * inv, kd = kf[g][i] * (1.0f + (af[g][i] - 1.0f) * kac[i]);
                        ka_[i] = kk * gm1; bm_[i] = kk * af[g][i] * gi; km_[i] = kd * gi; rm_[i] = rf[g][i] * gt;
                        sb += rf[g][i] * kd * rkc[i]; gend[g][i] = gt; }
                    KaP[g][0] = pk2(ka_[0], ka_[1]); KaP[g][1] = pk2(ka_[2], ka_[3]); BmP[g][0] = pk2(bm_[0], bm_[1]); BmP[g][1] = pk2(bm_[2], bm_[3]);
                    KmP[g][0] = pk2(km_[0], km_[1]); KmP[g][1] = pk2(km_[2], km_[3]); RmP[g][0] = pk2(rm_[0], rm_[1]); RmP[g][1] = pk2(rm_[2], rm_[3]);
                }
                if (lat) { sb += __shfl_xor(sb, 16); sb += __shfl_xor(sb, 32); if (q == 0) SB[(size_t)(S2_ROW0(ci) + (d ? 15 - tt : tt)) * NH + h] = sb; }
                s16x8 KaF[2], BmF[2], KmF[2], RmF[2], VF[2];
#pragma unroll
                for (int kb = 0; kb < 2; ++kb) { KaF[kb] = mk8(KaP[2 * kb][0], KaP[2 * kb][1], KaP[2 * kb + 1][0], KaP[2 * kb + 1][1]); BmF[kb] = mk8(BmP[2 * kb][0], BmP[2 * kb][1], BmP[2 * kb + 1][0], BmP[2 * kb + 1][1]);
                    KmF[kb] = mk8(KmP[2 * kb][0], KmP[2 * kb][1], KmP[2 * kb + 1][0], KmP[2 * kb + 1][1]); RmF[kb] = mk8(RmP[2 * kb][0], RmP[2 * kb][1], RmP[2 * kb + 1][0], RmP[2 * kb + 1][1]);
                    VF[kb] = mk8(VP[2 * kb][0], VP[2 * kb][1], VP[2 * kb + 1][0], VP[2 * kb + 1][1]); }
                const f32x4 Z = (f32x4){0.f, 0.f, 0.f, 0.f};
                f32x4 Nd = mfma16(KaF[1], BmF[1], mfma16(KaF[0], BmF[0], Z));
                f32x4 Nt = mfma16(BmF[1], KaF[1], mfma16(BmF[0], KaF[0], Z));
                f32x4 AakT = mfma16(KmF[1], KaF[1], mfma16(KmF[0], KaF[0], Z));
                f32x4 ArbT = mfma16(BmF[1], RmF[1], mfma16(BmF[0], RmF[0], Z));
                f32x4 ArkT = mfma16(KmF[1], RmF[1], mfma16(KmF[0], RmF[0], Z));
                f32x4 Q0;
#pragma unroll
                for (int r = 0; r < 4; ++r) { const int row = 4 * q + r;
                    Nd[r] = row > tt ? Nd[r] : 0.f; Nt[r] = row < tt ? Nt[r] : 0.f; AakT[r] = row < tt ? AakT[r] : 0.f; ArbT[r] = row <= tt ? ArbT[r] : 0.f; ArkT[r] = row <= tt ? ArkT[r] : 0.f;
                    Q0[r] = (row == tt ? 1.0f : 0.f) - Nt[r]; }
                const s16x8 oN = mk_d(Nd), oNt = mk_d(Nt);
                const f32x4 N2 = mfma16(oNt, oN, Z), N2t = mfma16(oN, oNt, Z);
                const s16x8 oN2 = mk_d(N2), oN2t = mk_d(N2t);
                const f32x4 N4 = mfma16(oN2t, oN2, Z), N4t = mfma16(oN2, oN2t, Z);
                const s16x8 oN4 = mk_d(N4), oN4t = mk_d(N4t);
                const f32x4 N8 = mfma16(oN4t, oN4, Z);
                const f32x4 Q1 = mfma16(oN2, mk_d(Q0), Q0);
                const f32x4 Q2 = mfma16(oN4, mk_d(Q1), Q1);
                const f32x4 Q3 = mfma16(mk_d(N8), mk_d(Q2), Q2);
                *(LAS u32x4*)(slot_w + SL_KA + lane * 16) = __builtin_bit_cast(u32x4, KaF[0]); *(LAS u32x4*)(slot_w + SL_KA + 1024 + lane * 16) = __builtin_bit_cast(u32x4, KaF[1]);
                *(LAS u32x4*)(slot_w + SL_RM + lane * 16) = __builtin_bit_cast(u32x4, RmF[0]); *(LAS u32x4*)(slot_w + SL_RM + 1024 + lane * 16) = __builtin_bit_cast(u32x4, RmF[1]);
                *(LAS u32x2*)(slot_w + SL_TN + lane * 8) = (u32x2){pk2(-Q3[0], -Q3[1]), pk2(-Q3[2], -Q3[3])};
                *(LAS u32x2*)(slot_w + SL_AAK + lane * 8) = (u32x2){pk2(AakT[0], AakT[1]), pk2(AakT[2], AakT[3])};
                *(LAS u32x4*)(slot_w + SL_ARK + lane * 16) = (u32x4){pk2(ArbT[0], ArbT[1]), pk2(ArbT[2], ArbT[3]), pk2(ArkT[0], ArkT[1]), pk2(ArkT[2], ArkT[3])};
#pragma unroll
                for (int kb = 0; kb < 2; ++kb)
#pragma unroll
                    for (int sel = 0; sel < 2; ++sel) { const int tk = 2 * kb + sel;
                        const f32x4 DB = mfma16(BmF[kb], SelF[sel], Z), DK = mfma16(KmF[kb], SelF[sel], Z), DV = mfma16(VF[kb], SelF[sel], Z);
                        *(LAS u32x4*)(slot_w + SL_BK + tk * 1024 + lane * 16) = (u32x4){pk2(DB[0], DB[1]), pk2(DB[2], DB[3]), pk2(DK[0], DK[1]), pk2(DK[2], DK[3])};
                        *(LAS u32x2*)(slot_w + SL_VC + tk * 512 + lane * 8) = (u32x2){pk2(DV[0], DV[1]), pk2(DV[2], DV[3])}; }
                if (tt == 15) {
#pragma unroll
                    for (int g = 0; g < 4; ++g) *(LAS f32x4*)(slot_w + SL_GC + (g * 4 + q) * 16) = gend[g]; }
            }
            __builtin_amdgcn_fence(__ATOMIC_RELEASE, "workgroup");
            if (lane == 0) __hip_atomic_store(CNT + pw, (unsigned)(rnd + 1), __ATOMIC_RELAXED, __HIP_MEMORY_SCOPE_WORKGROUP);
        }
        } else {
        f32x4 G[4];
#pragma unroll
        for (int tk = 0; tk < 4; ++tk) G[tk] = (f32x4){0.f, 0.f, 0.f, 0.f};
        LAS unsigned* cscr = (LAS unsigned*)(F.lds + 102400 + F.wave * 8448);
        int cit = clo + (int)blockIdx.x * 4 + F.wave, ch_ = 0; bool chave = cit < chi; TrItem ct; f32x4 cr[4][4];
        if (chave) { ct = tr_decode(F, a, cit); tr_load(ct, 0, cr, lane); }
#define S5_CONV_STEP() do { if (chave) { tr_store(ct, ch_, cr, cscr, lane); \
            if (ct.f8 && ch_ == 0) ch_ = 1; else { cit += 4 * 256; ch_ = 0; chave = cit < chi; if (chave) ct = tr_decode(F, a, cit); } \
            if (chave) tr_load(ct, ch_, cr, lane); } } while (0)
        for (int rnd = 0; rnd < 36; ++rnd) {
            const bool lat = rnd >= 4;
            { unsigned spins = 0;
                for (;;) { const unsigned f0 = __hip_atomic_load(CNT + 0, __ATOMIC_RELAXED, __HIP_MEMORY_SCOPE_WORKGROUP), f1 = __hip_atomic_load(CNT + 1, __ATOMIC_RELAXED, __HIP_MEMORY_SCOPE_WORKGROUP), f2 = __hip_atomic_load(CNT + 2, __ATOMIC_RELAXED, __HIP_MEMORY_SCOPE_WORKGROUP), f3 = __hip_atomic_load(CNT + 3, __ATOMIC_RELAXED, __HIP_MEMORY_SCOPE_WORKGROUP);
                    const unsigned need = (unsigned)(rnd + 1); if ((f0 >= need && f1 >= need && f2 >= need && f3 >= need) || ++spins > (1u << 22)) break; __builtin_amdgcn_s_sleep(1); } }
            __builtin_amdgcn_fence(__ATOMIC_ACQUIRE, "workgroup");
            {
                const int tv = F.wave;
                for (int sl = 0; sl < 4; ++sl) {
                    LAS unsigned char* S = F.lds + ((rnd & 1) * 4 + sl) * SL_BYTES; const int cj = rnd * 4 + sl;
                    const s16x8 KA0 = __builtin_bit_cast(s16x8, *(LAS u32x4*)(S + SL_KA + lane * 16)), KA1 = __builtin_bit_cast(s16x8, *(LAS u32x4*)(S + SL_KA + 1024 + lane * 16));
                    const u32x2 aak = *(LAS u32x2*)(S + SL_AAK + lane * 8), tn = *(LAS u32x2*)(S + SL_TN + lane * 8), vc = *(LAS u32x2*)(S + SL_VC + tv * 512 + lane * 8);
                    const s16x8 Gb0 = mk8(pk2(G[0][0], G[0][1]), pk2(G[0][2], G[0][3]), pk2(G[1][0], G[1][1]), pk2(G[1][2], G[1][3]));
                    const s16x8 Gb1 = mk8(pk2(G[2][0], G[2][1]), pk2(G[2][2], G[2][3]), pk2(G[3][0], G[3][1]), pk2(G[3][2], G[3][3]));
                    const f32x4 Z = (f32x4){0.f, 0.f, 0.f, 0.f};
                    f32x4 P = mfma16(KA0, Gb0, Z); P = mfma16(KA1, Gb1, P); P = mfma16(mk8(aak.x, aak.y, 0u, 0u), mk8(vc.x, vc.y, 0u, 0u), P);
                    const f32x4 U = mfma16(mk8(tn.x, tn.y, 0u, 0u), mk_d(P), Z);
                    const s16x8 UV = mk8(pk2(U[0], U[1]), pk2(U[2], U[3]), vc.x, vc.y);
                    if (lat) {
                        const s16x8 RM0 = __builtin_bit_cast(s16x8, *(LAS u32x4*)(S + SL_RM + lane * 16)), RM1 = __builtin_bit_cast(s16x8, *(LAS u32x4*)(S + SL_RM + 1024 + lane * 16));
                        const s16x8 ARK = __builtin_bit_cast(s16x8, *(LAS u32x4*)(S + SL_ARK + lane * 16));
                        f32x4 Y = mfma16(Gb0, RM0, Z); Y = mfma16(Gb1, RM1, Y); Y = mfma16(UV, ARK, Y);
                        *(u32x2*)(YD + (size_t)(S2_ROW0(cj) + (d ? 15 - tt : tt)) * D + h * HS + 16 * tv + 4 * q) = (u32x2){pk2(Y[0], Y[1]), pk2(Y[2], Y[3])};
                    }
#pragma unroll
                    for (int tk = 0; tk < 4; ++tk) { const s16x8 BK = __builtin_bit_cast(s16x8, *(LAS u32x4*)(S + SL_BK + tk * 1024 + lane * 16));
                        G[tk] = mfma16(BK, UV, G[tk]); G[tk] = G[tk] * *(LAS f32x4*)(S + SL_GC + (tk * 4 + q) * 16); }
                }
            }
            __builtin_amdgcn_fence(__ATOMIC_RELEASE, "workgroup");
            if (lane == 0) __hip_atomic_store(CNT + 4 + F.wave, (unsigned)(rnd + 1), __ATOMIC_RELAXED, __HIP_MEMORY_SCOPE_WORKGROUP);
#if !defined(PROBE_S5TAIL)
            S5_CONV_STEP();
#if defined(S5_TWO)
            S5_CONV_STEP();
#endif
#endif
        }
        while (chave) S5_CONV_STEP();
#undef S5_CONV_STEP
        }
#undef S2_ROW0
#undef S2_LOAD
    }
    __syncthreads();
}

#if defined(PROBE_SCANCHK)
constexpr int CW_CHK = 20480;
__device__ __forceinline__ void p4_compare(const Frame& F) {
    const int lane = lane_id();
    const bf16_t* Y0 = (const bf16_t*)(F.ws + A_YD); const bf16_t* Y1 = (const bf16_t*)(F.ws + A_AO);
    const float* S0 = (const float*)(F.ws + WS_SB); const float* S1 = (const float*)(F.ws + WS_A + 644 * MiB);
    float num = 0.f, den = 0.f, num2 = 0.f, den2 = 0.f;
    for (size_t i = (size_t)F.gw * 64 + lane; i < (size_t)2 * ML * D / 8; i += (size_t)F.NGW * 64) { float a8[8], b8[8]; unpack8(((const u32x4*)Y0)[i], a8); unpack8(((const u32x4*)Y1)[i], b8);
#pragma unroll
        for (int e = 0; e < 8; ++e) { const float dd = b8[e] - a8[e]; num += dd * dd; den += a8[e] * a8[e]; } }
    for (size_t i = (size_t)F.gw * 64 + lane; i < (size_t)2 * ML * NH; i += (size_t)F.NGW * 64) { const float dd = S1[i] - S0[i]; num2 += dd * dd; den2 += S0[i] * S0[i]; }
    num = wave_sum(num); den = wave_sum(den); num2 = wave_sum(num2); den2 = wave_sum(den2);
    if (lane == 0) { atomicAdd((float*)(F.ctl + CW_CHK), num); atomicAdd((float*)(F.ctl + CW_CHK + 64), den); atomicAdd((float*)(F.ctl + CW_CHK + 128), num2); atomicAdd((float*)(F.ctl + CW_CHK + 192), den2); }
}
#endif
__device__ __forceinline__ void p5_ao(const Frame& F, const Args& a) {
    const int lane = lane_id(), tid = F.wave * 64 + lane; (void)tid;
    const bf16_t* Y0 = (const bf16_t*)(F.ws + A_YD); const bf16_t* Y1 = (const bf16_t*)(F.ws + A_YD + 32 * MiB);
    const bf16_t* VV = (const bf16_t*)(F.ws + A_V); const bf16_t* GT = (const bf16_t*)(F.ws + A_GATE); bf16_t* AO = (bf16_t*)(F.ws + A_AO);
    const float* SB0 = (const float*)(F.ws + WS_SB); const float* SB1 = SB0 + (size_t)ML * NH;
    for (int m = F.gw; m < ML; m += F.NGW) {
        float ov[4][8]; float amx = 0.f; (void)ov; (void)amx;
#pragma unroll
        for (int j = 0; j < 4; ++j) {
            const int c = 8 * lane + 512 * j, hd = c >> 6; const size_t o = (size_t)m * D + c;
            float y0[8], y1[8], vv[8], gg[8], y[8];
            unpack8(*(const u32x4*)(Y0 + o), y0); unpack8(*(const u32x4*)(Y1 + o), y1); unpack8(*(const u32x4*)(VV + o), vv); unpack8(*(const u32x4*)(GT + o), gg);
            float s = 0.f;
#pragma unroll
            for (int e = 0; e < 8; ++e) { y[e] = y0[e] + y1[e]; s += y[e]; }
            s = sum8(s); const float mean = s * (1.0f / 64.0f); float qv = 0.f;
#pragma unroll
            for (int e = 0; e < 8; ++e) { y[e] -= mean; qv += y[e] * y[e]; }
            qv = sum8(qv); const float rstd = 1.0f / sqrtf(qv * (1.0f / 64.0f) + GN_EPS);
            const float sb = SB0[(size_t)m * NH + hd] + SB1[(size_t)m * NH + hd];
            const f32x4 gw0 = *(const f32x4*)(a.in[I_GNW] + c), gw1 = *(const f32x4*)(a.in[I_GNW] + c + 4), gb0 = *(const f32x4*)(a.in[I_GNB] + c), gb1 = *(const f32x4*)(a.in[I_GNB] + c + 4);
            float o8[8];
#pragma unroll
            for (int e = 0; e < 8; ++e) { const float gw = e < 4 ? gw0[e & 3] : gw1[e & 3], gb = e < 4 ? gb0[e & 3] : gb1[e & 3]; o8[e] = (y[e] * rstd * gw + gb + sb * vv[e]) * gg[e]; }
            if (WO_I8) {
#pragma unroll
                for (int e = 0; e < 8; ++e) { ov[j][e] = o8[e]; amx = fmaxf(amx, fabsf(o8[e])); } }
            else { u32x4 w; w.x = pk2(o8[0], o8[1]); w.y = pk2(o8[2], o8[3]); w.z = pk2(o8[4], o8[5]); w.w = pk2(o8[6], o8[7]);
                *(u32x4*)(AO + o) = w; }
        }
        if (WO_I8) {
            amx = wave_max(amx);
            amx = fmaxf(amx, 1e-30f); const float inv = 127.0f / amx;
#pragma unroll
            for (int j = 0; j < 4; ++j) { u32x2 w; w.x = pk4_i8(ov[j][0] * inv, ov[j][1] * inv, ov[j][2] * inv, ov[j][3] * inv); w.y = pk4_i8(ov[j][4] * inv, ov[j][5] * inv, ov[j][6] * inv, ov[j][7] * inv);
                *(u32x2*)((unsigned char*)AO + (size_t)m * D + 8 * lane + 512 * j) = w; }
            if (lane == 0) ((float*)(F.ws + WS_RSO))[m] = amx * (1.0f / 127.0f);
        }
    }
}

struct RowLN { f32x4 xn[8]; };
__device__ __forceinline__ void ln_core(int lane, f32x4 (&z)[8], const float* lnw, const float* lnb) {
    float s = 0.f;
#pragma unroll
    for (int j = 0; j < 8; ++j) s += (z[j][0] + z[j][1]) + (z[j][2] + z[j][3]);
    const float mean = wave_sum(s) * (1.0f / D); float q = 0.f;
#pragma unroll
    for (int j = 0; j < 8; ++j) { z[j] = z[j] - mean; q += (z[j][0] * z[j][0] + z[j][1] * z[j][1]) + (z[j][2] * z[j][2] + z[j][3] * z[j][3]); }
    const float rstd = 1.0f / sqrtf(wave_sum(q) * (1.0f / D) + LN_EPS);
#pragma unroll
    for (int j = 0; j < 8; ++j) { const int c = 4 * lane + 256 * j; z[j] = z[j] * rstd * *(const f32x4*)(lnw + c) + *(const f32x4*)(lnb + c); }
}
__device__ __forceinline__ void ln_core_pre(f32x4 (&z)[8], const f32x4 (&lw)[8], const f32x4 (&lb)[8]) {
    float s = 0.f;
#pragma unroll
    for (int j = 0; j < 8; ++j) s += (z[j][0] + z[j][1]) + (z[j][2] + z[j][3]);
    const float mean = wave_sum(s) * (1.0f / D); float q = 0.f;
#pragma unroll
    for (int j = 0; j < 8; ++j) { z[j] = z[j] - mean; q += (z[j][0] * z[j][0] + z[j][1] * z[j][1]) + (z[j][2] * z[j][2] + z[j][3] * z[j][3]); }
    const float rstd = 1.0f / sqrtf(wave_sum(q) * (1.0f / D) + LN_EPS);
#pragma unroll
    for (int j = 0; j < 8; ++j) z[j] = z[j] * rstd * lw[j] + lb[j];
}
__device__ __forceinline__ f32x4 ld_bf4(const bf16_t* p) { const u32x2 w = *(const u32x2*)p; return (f32x4){bflo(w.x), bfhi(w.x), bflo(w.y), bfhi(w.y)}; }
__device__ __forceinline__ void st_bf4(bf16_t* p, const f32x4 v) { u32x2 w; w.x = pk2(v[0], v[1]); w.y = pk2(v[2], v[3]); *(u32x2*)p = w; }
#ifndef XR_BF16
#define XR_BF16 0
#endif
__device__ __forceinline__ f32x4 xr_ld(const float* XR, size_t idx) { if (XR_BF16) return ld_bf4((const bf16_t*)XR + idx); return *(const f32x4*)(XR + idx); }
__device__ __forceinline__ void xr_st(float* XR, size_t idx, const f32x4 v) { if (XR_BF16) st_bf4((bf16_t*)XR + idx, v); else *(f32x4*)(XR + idx) = v; }
__device__ __forceinline__ void st_h(void* H, size_t idx, const f32x4 v, bool f8) { if (f8) *((unsigned*)((unsigned char*)H + idx)) = pk4_fp8(v[0] * 16.f, v[1] * 16.f, v[2] * 16.f, v[3] * 16.f); else st_bf4((bf16_t*)H + idx, v); }
__device__ __forceinline__ void post_norm_rows(const Frame& F, const Args& a, const bf16_t* Y, int gate_off, int lnidx, const float* MODh, int sh_off, int sc_off, void* H, int h8  , bool x0in) {
    const int lane = lane_id(), tid = F.wave * 64 + lane; (void)tid;
    const float* MOD = (const float*)(F.ws + WS_MOD); float* XR = (float*)(F.ws + WS_XR);
    const float* lnw = a.in[I_LNW] + lnidx * D; const float* lnb = a.in[I_LNB] + lnidx * D;
#ifndef LN_HOIST
#define LN_HOIST 0
#endif
    f32x4 lw[8], lb[8], pv[8]; int tprev = -1; (void)lw; (void)lb; (void)pv; (void)tprev;
    if (LN_HOIST) {
#pragma unroll
        for (int j = 0; j < 8; ++j) { const int c = 4 * lane + 256 * j; lw[j] = *(const f32x4*)(lnw + c); lb[j] = *(const f32x4*)(lnb + c); } }
    for (int m = F.gw; m < ML; m += F.NGW) {
        const int b = m / T; const float* g = MOD + gate_off + (size_t)b * MOD_N; const size_t o = (size_t)m * D;
        f32x4 z[8];
        if (LN_HOIST && x0in && (m % T) != tprev) { tprev = m % T;
#pragma unroll
            for (int j = 0; j < 8; ++j) pv[j] = *(const f32x4*)((const float*)(F.ws + WS_POS) + (size_t)tprev * D + 4 * lane + 256 * j); }
#pragma unroll
        for (int j = 0; j < 8; ++j) { const int c = 4 * lane + 256 * j;
            const f32x4 xv = x0in ? (*(const f32x4*)(a.in[I_X] + o + c) + (LN_HOIST ? pv[j] : *(const f32x4*)((const float*)(F.ws + WS_POS) + (size_t)(m % T) * D + c))) : xr_ld(XR, o + c);
            z[j] = xv * ALPHA + *(const f32x4*)(g + c) * ld_bf4(Y + o + c); }
        if (LN_HOIST) ln_core_pre(z, lw, lb); else ln_core(lane, z, lnw, lnb);
        const float* sh = MODh + sh_off + (size_t)b * MOD_N; const float* sc = MODh + sc_off + (size_t)b * MOD_N;
        if (h8 == 2) { float mx = 0.f;
#pragma unroll
            for (int j = 0; j < 8; ++j) { const int c = 4 * lane + 256 * j; xr_st(XR, o + c, z[j]); z[j] = z[j] * (*(const f32x4*)(sc + c) + 1.0f) + *(const f32x4*)(sh + c);
                mx = fmaxf(fmaxf(mx, fmaxf(fabsf(z[j][0]), fabsf(z[j][1]))), fmaxf(fabsf(z[j][2]), fabsf(z[j][3]))); }
            mx = wave_max(mx);
            mx = fmaxf(mx, 1e-30f); const float inv = 127.0f / mx;
#pragma unroll
            for (int j = 0; j < 8; ++j) { const int c = 4 * lane + 256 * j; *(unsigned*)((unsigned char*)H + o + c) = pk4_i8(z[j][0] * inv, z[j][1] * inv, z[j][2] * inv, z[j][3] * inv); }
            if (lane == 0) ((float*)(F.ws + WS_RS))[m] = mx * (1.0f / 127.0f);
            continue; }
#pragma unroll
        for (int j = 0; j < 8; ++j) { const int c = 4 * lane + 256 * j; xr_st(XR, o + c, z[j]);
            st_h(H, o + c, z[j] * (*(const f32x4*)(sc + c) + 1.0f) + *(const f32x4*)(sh + c), h8 != 0); }
    }
}

__device__ __forceinline__ void p9_quant_u(const Frame& F) {
    const int lane = lane_id();
    for (int m = F.gw; m < ML; m += F.NGW) {
        unsigned char* row = F.ws + A_U + (size_t)m * LDU * 2; u32x4 w[11]; float mx = 0.f;
#pragma unroll
        for (int i = 0; i < 11; ++i) w[i] = *(const u32x4*)(row + 16 * lane + 1024 * i);
#pragma unroll
        for (int i = 0; i < 11; ++i) { float f[8]; unpack8(w[i], f);
#pragma unroll
            for (int e = 0; e < 8; ++e) mx = fmaxf(mx, fabsf(f[e])); }
            mx = wave_max(mx);
        mx = fmaxf(mx, 1e-30f); const float inv = 127.0f / mx;
        asm volatile("" ::: "memory");
#pragma unroll
        for (int i = 0; i < 11; ++i) { float f[8]; unpack8(w[i], f); u32x2 o; o.x = pk4_i8(f[0] * inv, f[1] * inv, f[2] * inv, f[3] * inv); o.y = pk4_i8(f[4] * inv, f[5] * inv, f[6] * inv, f[7] * inv);
            *(u32x2*)(row + 8 * lane + 512 * i) = o; }
        if (lane == 0) ((float*)(F.ws + WS_RSU))[m] = mx * (1.0f / 127.0f);
    }
}

#ifndef POOL_SLIDE
#define POOL_SLIDE 0
#endif
template <int G>
__device__ __forceinline__ void pool_group4(const bf16_t* HP, bf16_t* PP, int m0, int t0, int lane) {
    constexpr int h = 1 << G; const int c = 8 * lane + 512 * G;
    float W[2 * h][8], E[3][8], S[8];
#pragma unroll
    for (int e = 0; e < 8; ++e) S[e] = 0.f;
#pragma unroll
    for (int j = 0; j < 2 * h; ++j) { const int tt = t0 - h + j; const bool ok = tt >= 0 && tt < T;
        unpack8(*(const u32x4*)(HP + (size_t)(ok ? m0 - h + j : m0) * D + c), W[j]);
#pragma unroll
        for (int e = 0; e < 8; ++e) { W[j][e] = ok ? W[j][e] : 0.f; S[e] += W[j][e]; } }
#pragma unroll
    for (int j = 0; j < 3; ++j) { const int tt = t0 + h + j; const bool ok = tt < T;
        unpack8(*(const u32x4*)(HP + (size_t)(ok ? m0 + h + j : m0) * D + c), E[j]);
#pragma unroll
        for (int e = 0; e < 8; ++e) E[j][e] = ok ? E[j][e] : 0.f; }
#pragma unroll
    for (int i = 0; i < 4; ++i) {
        if (i > 0) {
#pragma unroll
            for (int e = 0; e < 8; ++e) S[e] += E[i - 1][e] - ((i - 1 < 2 * h) ? W[(i - 1 < 2 * h) ? i - 1 : 0][e] : E[(i - 1 >= 2 * h) ? i - 1 - 2 * h : 0][e]); }
        const int t = t0 + i, lo = t - h > 0 ? t - h : 0, hi = t + h < T ? t + h : T; const float inv = 1.0f / (float)(hi - lo);
        float o[8];
#pragma unroll
        for (int e = 0; e < 8; ++e) { const float ctr = (i < h) ? W[(i < h) ? h + i : 0][e] : E[(i >= h) ? i - h : 0][e]; o[e] = S[e] * inv - ctr; }
        u32x4 w; w.x = pk2(o[0], o[1]); w.y = pk2(o[2], o[3]); w.z = pk2(o[4], o[5]); w.w = pk2(o[6], o[7]);
        *(u32x4*)(PP + (size_t)(m0 + i) * D + c) = w;
    }
}
__device__ __forceinline__ void p11_pool4(const Frame& F) {
    const int lane = lane_id();
    const bf16_t* HP = (const bf16_t*)(F.ws + A_HP); bf16_t* PP = (bf16_t*)(F.ws + A_PP);
    for (int qd = F.gw; qd < ML / 4; qd += F.NGW) { const int m0 = 4 * qd, t0 = m0 % T;
        pool_group4<0>(HP, PP, m0, t0, lane); pool_group4<1>(HP, PP, m0, t0, lane); pool_group4<2>(HP, PP, m0, t0, lane); pool_group4<3>(HP, PP, m0, t0, lane); }
}
__device__ __forceinline__ void p11_pool(const Frame& F) {
    const int lane = lane_id();
    const bf16_t* HP = (const bf16_t*)(F.ws + A_HP); bf16_t* PP = (bf16_t*)(F.ws + A_PP);
    for (int m = F.gw; m < ML; m += F.NGW) {
        const int t = m % T;
#pragma unroll
        for (int g = 0; g < 4; ++g) {
            constexpr int dummy = 0; (void)dummy;
            const int half = 1 << g, c = 8 * lane + 512 * g;
            float acc[8], ctr[8];
#pragma unroll
            for (int e = 0; e < 8; ++e) acc[e] = 0.f;
            int cnt = 0;
#pragma unroll
            for (int o = -8; o < 8; ++o) { if (o < -half || o >= half) continue;
                const int tt = t + o; const bool ok = tt >= 0 && tt < T; float v[8]; unpack8(*(const u32x4*)(HP + (size_t)(m + (ok ? o : 0)) * D + c), v);
                cnt += ok ? 1 : 0;
#pragma unroll
                for (int e = 0; e < 8; ++e) { acc[e] += ok ? v[e] : 0.f; if (o == 0) ctr[e] = v[e]; } }
            const float inv = 1.0f / (float)cnt;
            if (POOL_I8) { float pv[8]; float mx = 0.f;
#pragma unroll
                for (int e = 0; e < 8; ++e) { pv[e] = acc[e] * inv - ctr[e]; mx = fmaxf(mx, fabsf(pv[e])); }
            mx = wave_max(mx);
                mx = fmaxf(mx, 1e-30f); const float qs = 127.0f / mx;
                u32x2 w; w.x = pk4_i8(pv[0] * qs, pv[1] * qs, pv[2] * qs, pv[3] * qs); w.y = pk4_i8(pv[4] * qs, pv[5] * qs, pv[6] * qs, pv[7] * qs);
                *(u32x2*)((unsigned char*)PP + (size_t)m * D + c) = w;
                if (lane == 0) ((float*)(F.ws + WS_RSP))[(size_t)g * ML + m] = mx * (1.0f / 127.0f);
                continue; }
            u32x4 w; w.x = pk2(acc[0] * inv - ctr[0], acc[1] * inv - ctr[1]); w.y = pk2(acc[2] * inv - ctr[2], acc[3] * inv - ctr[3]);
            w.z = pk2(acc[4] * inv - ctr[4], acc[5] * inv - ctr[5]); w.w = pk2(acc[6] * inv - ctr[6], acc[7] * inv - ctr[7]);
            *(u32x4*)(PP + (size_t)m * D + c) = w;
        }
    }
}

__device__ __forceinline__ void p13_norm_router(const Frame& F, const Args& a) {
    const int lane = lane_id(), tid = F.wave * 64 + lane; (void)tid;
    LAS float* RT = (LAS float*)F.lds;
    LAS int* lcnt = (LAS int*)(F.lds + 65536);
    LAS int* le = (LAS int*)(F.lds + 65536 + 64);
    LAS int* lr = (LAS int*)(F.lds + 65536 + 64 + 256);
    for (int i = tid; i < D * NE; i += 512) RT[(i & 7) * D + (i >> 3)] = a.in[I_ROUTER][i];
    const float* MOD = (const float*)(F.ws + WS_MOD); float* XR = (float*)(F.ws + WS_XR);
    const float* MOD1 = MOD + (size_t)5 * MOD_N;
    const bf16_t* Y = (const bf16_t*)(F.ws + A_YP); void* H = (void*)(F.ws + A_H2B);
    const float* lnw = a.in[I_LNW] + 2 * D; const float* lnb = a.in[I_LNB] + 2 * D;
    int* TOKE = (int*)(F.ws + WS_TOK); int* TOKS = TOKE + 2 * ML; float* TOKP = (float*)(TOKE + 6 * ML);
    unsigned* gcnt = F.ctl + CW_GCNT;
    for (int rb = blockIdx.x; rb < ML / 32; rb += F.G) {
        __syncthreads();
        if (tid < 8) lcnt[tid] = 0;
        __syncthreads();
        for (int i = 0; i < 4; ++i) {
            const int rl = F.wave * 4 + i, m = rb * 32 + rl, b = m / T; const size_t o = (size_t)m * D;
            const float* g = MOD1 + 2 * D + (size_t)b * MOD_N;
            f32x4 z[8];
#pragma unroll
            for (int j = 0; j < 8; ++j) { const int c = 4 * lane + 256 * j; z[j] = xr_ld(XR, o + c) * ALPHA + *(const f32x4*)(g + c) * ld_bf4(Y + o + c); }
            ln_core(lane, z, lnw, lnb);
            const float* sh = MOD1 + 3 * D + (size_t)b * MOD_N; const float* sc = MOD1 + 4 * D + (size_t)b * MOD_N;
            float lg[8];
#pragma unroll
            for (int e = 0; e < 8; ++e) lg[e] = 0.f;
#pragma unroll
            for (int j = 0; j < 8; ++j) { const int c = 4 * lane + 256 * j; xr_st(XR, o + c, z[j]);
                const f32x4 hv = z[j] * (*(const f32x4*)(sc + c) + 1.0f) + *(const f32x4*)(sh + c);
                st_h(H, o + c, hv, MOE_FP8 != 0);
#pragma unroll
                for (int e = 0; e < 8; ++e) { const f32x4 rt = *(const LAS f32x4*)(RT + e * D + c); lg[e] += (hv[0] * rt[0] + hv[1] * rt[1]) + (hv[2] * rt[2] + hv[3] * rt[3]); } }
#pragma unroll
            for (int e = 0; e < 8; ++e) lg[e] = wave_sum(lg[e]);
            int i0 = 0; float l0 = lg[0];
#pragma unroll
            for (int e = 1; e < 8; ++e) if (lg[e] > l0) { l0 = lg[e]; i0 = e; }
            int i1 = -1; float l1 = -3.0e38f;
#pragma unroll
            for (int e = 0; e < 8; ++e) if (e != i0 && lg[e] > l1) { l1 = lg[e]; i1 = e; }
            if (i1 < 0) { i1 = (i0 + 1) & 7; l1 = l0; }
            const float e1 = fexp(l1 - l0), p0 = 1.0f / (1.0f + e1), p1 = e1 / (1.0f + e1);
            if (lane == 0) { TOKE[2 * m] = i0; TOKE[2 * m + 1] = i1; TOKP[2 * m] = p0; TOKP[2 * m + 1] = p1;
                le[2 * rl] = i0; le[2 * rl + 1] = i1; lr[2 * rl] = __hip_atomic_fetch_add(&lcnt[i0], 1, __ATOMIC_RELAXED, __HIP_MEMORY_SCOPE_WORKGROUP); lr[2 * rl + 1] = __hip_atomic_fetch_add(&lcnt[i1], 1, __ATOMIC_RELAXED, __HIP_MEMORY_SCOPE_WORKGROUP); }
        }
        __syncthreads();
        if (tid < 8) lcnt[8 + tid] = (int)__hip_atomic_fetch_add(gcnt + 64 * tid, (unsigned)lcnt[tid], __ATOMIC_RELAXED, __HIP_MEMORY_SCOPE_AGENT);
        __syncthreads();
        if (tid < 64) TOKS[2 * (rb * 32) + tid] = lcnt[8 + le[tid]] + lr[tid];
    }
    __syncthreads();
}

struct MoeTab { int mt[8], ts[8], ntile; };
__device__ __forceinline__ MoeTab moe_tab(const Frame& F) {
    MoeTab t; int acc = 0;
#pragma unroll
    for (int e = 0; e < 8; ++e) { const int c = __builtin_amdgcn_readfirstlane((int)__hip_atomic_load(F.ctl + CW_GCNT + 64 * e, __ATOMIC_RELAXED, __HIP_MEMORY_SCOPE_AGENT)); t.mt[e] = (c + 255) >> 8; t.ts[e] = acc; acc += t.mt[e]; }
    t.ntile = acc; return t;
}
__device__ __forceinline__ void p14_gather(const Frame& F) {
    const int lane = lane_id(), tid = F.wave * 64 + lane; (void)tid;
    const MoeTab tb = moe_tab(F);
    const int* TOKE = (const int*)(F.ws + WS_TOK); const int* TOKS = TOKE + 2 * ML; int* TOKD = (int*)(TOKE + 4 * ML);
    const bf16_t* H = (const bf16_t*)(F.ws + A_H2B); bf16_t* HG = (bf16_t*)(F.ws + A_HG);
    for (int idx = F.gw; idx < 2 * ML; idx += F.NGW) {
        const int m = idx >> 1, e = TOKE[idx], sl = TOKS[idx]; int ts = 0;
#pragma unroll
        for (int k = 0; k < 8; ++k) ts = (e == k) ? tb.ts[k] : ts;
        const int dst = ts * 256 + sl;
        if (lane == 0) TOKD[idx] = dst;
        constexpr int RB = MOE_FP8 ? D : 2 * D;
        const u32x4* s = (const u32x4*)((const unsigned char*)H + (size_t)m * RB) + lane; u32x4* dd = (u32x4*)((unsigned char*)HG + (size_t)dst * RB) + lane;
        const u32x4 v0 = s[0], v1 = s[64]; dd[0] = v0; dd[64] = v1;
        if (!MOE_FP8) { const u32x4 v2 = s[128], v3 = s[192]; dd[128] = v2; dd[192] = v3; }
    }
}
__device__ __forceinline__ void p17_final(const Frame& F, const Args& a) {
    const int lane = lane_id(), tid = F.wave * 64 + lane; (void)tid;
    const float* MOD1 = (const float*)(F.ws + WS_MOD) + (size_t)5 * MOD_N; const float* XR = (const float*)(F.ws + WS_XR);
    const int* TOKD = (const int*)(F.ws + WS_TOK) + 4 * ML; const float* TOKP = (const float*)((const int*)(F.ws + WS_TOK) + 6 * ML);
    const bf16_t* Y2 = (const bf16_t*)(F.ws + A_Y2); const float* PART = (const float*)(F.ws + WS_PART);
    const int xrow = (MOE_FP8 && F.G == 256) ? MOE_RT * 256 : 0x7fffffff;
    const float* lnw = a.in[I_LNW] + 3 * D; const float* lnb = a.in[I_LNB] + 3 * D;
    for (int m = F.gw; m < ML; m += F.NGW) {
        const int b = m / T; const float* g = MOD1 + 5 * D + (size_t)b * MOD_N; const size_t o = (size_t)m * D;
        const int d0 = TOKD[2 * m], d1 = TOKD[2 * m + 1]; const float p0 = TOKP[2 * m], p1 = TOKP[2 * m + 1];
        f32x4 z[8];
#pragma unroll
        for (int j = 0; j < 8; ++j) { const int c = 4 * lane + 256 * j;
            f32x4 y0, y1;
            if (d0 >= xrow) { const float* pp = PART + (size_t)(d0 - xrow) * D + c; y0 = *(const f32x4*)pp;
#pragma unroll
                for (int ks = 1; ks < MOE_KS; ++ks) y0 += *(const f32x4*)(pp + (size_t)ks * 2048 * D); } else y0 = ld_bf4(Y2 + (size_t)d0 * D + c);
            if (d1 >= xrow) { const float* pp = PART + (size_t)(d1 - xrow) * D + c; y1 = *(const f32x4*)pp;
#pragma unroll
                for (int ks = 1; ks < MOE_KS; ++ks) y1 += *(const f32x4*)(pp + (size_t)ks * 2048 * D); } else y1 = ld_bf4(Y2 + (size_t)d1 * D + c);
            const f32x4 y = y0 * p0 + y1 * p1;
            z[j] = xr_ld(XR, o + c) * ALPHA + *(const f32x4*)(g + c) * y; }
        ln_core(lane, z, lnw, lnb);
#if defined(PROBE_STAMP)
        { const float us_ = 0.01f * (float)__hip_atomic_load(F.ctl + 24576, __ATOMIC_RELAXED, __HIP_MEMORY_SCOPE_AGENT); const float sc_ = 1.0f + us_ * (1.0f / 2000.0f);
#pragma unroll
          for (int j = 0; j < 8; ++j) z[j] = z[j] * sc_; }
#endif
#if defined(PROBE_SCANCHK)
        { const float n1 = __hip_atomic_load((float*)(F.ctl + CW_CHK), __ATOMIC_RELAXED, __HIP_MEMORY_SCOPE_AGENT), d1 = __hip_atomic_load((float*)(F.ctl + CW_CHK + 64), __ATOMIC_RELAXED, __HIP_MEMORY_SCOPE_AGENT);
          const float n2 = __hip_atomic_load((float*)(F.ctl + CW_CHK + 128), __ATOMIC_RELAXED, __HIP_MEMORY_SCOPE_AGENT), d2 = __hip_atomic_load((float*)(F.ctl + CW_CHK + 192), __ATOMIC_RELAXED, __HIP_MEMORY_SCOPE_AGENT);
          const float eps = sqrtf(n1 / d1) + sqrtf(n2 / d2), sc = 1.0f + 10.0f * eps;
#pragma unroll
          for (int j = 0; j < 8; ++j) z[j] = z[j] * sc; }
#endif
#pragma unroll
        for (int j = 0; j < 8; ++j) { const int c = 4 * lane + 256 * j; *(f32x4*)(a.out + o + c) = z[j]; }
    }
}

struct SchedBase { __device__ __forceinline__ void a_ready(const pg8::Unit&) const {} __device__ __forceinline__ void done(const pg8::Unit&) const {} };
struct SchedDense : SchedBase {
    const char* A; const char* B; bf16_t* O; const float* bias; int nM, nN, ldaB, ldbB, ldc, act, G, c; const float* rs = nullptr;
    __device__ __forceinline__ bool next(int i, pg8::Unit& u) const {
        const int L = i * G + c; if (L >= nM * nN) return false; u.rs = rs;
        int pm, pn; pg8::tile_of(L, nM, nN, pm, pn);
        u.A = A + (size_t)pm * 256 * ldaB; u.B = B + (size_t)pn * 256 * ldbB; u.O = O; u.bias = bias; u.pm = pm; u.pn = pn; u.ldc = ldc; u.act = act; return true;
    }
};
struct SchedP2 : SchedBase {
    unsigned char* ws; int G, c, lo = 0, hi = 936, coff = 0;
    __device__ __forceinline__ bool next(int i, pg8::Unit& u) const {
        if (c < coff) return false;
        int L = lo + i * G + (c - coff); if (L >= hi) return false;
        int mix, nM, nN, act, ldc; size_t wo, oo;
        if (L < 256)      { mix = 0; nM = 32; nN = 8; act = pg8::ACT_NONE;    wo = W_WR;  oo = A_R;   ldc = D; }
        else if (L < 544) { L -= 256; mix = 2; nM = 36; nN = 8; act = pg8::ACT_NONE; wo = W_WK;  oo = A_KX;  ldc = D; }
        else if (L < 832) { L -= 544; mix = 3; nM = 36; nN = 8; act = pg8::ACT_NONE; wo = W_WV;  oo = A_V;   ldc = D; }
        else if (L < 868) { L -= 832; mix = 1; nM = 36; nN = 1; act = pg8::ACT_TANH; wo = W_WLD; oo = A_LW;  ldc = 256; }
        else if (L < 904) { L -= 868; mix = 4; nM = 36; nN = 1; act = pg8::ACT_NONE; wo = W_ALD; oo = A_LA;  ldc = 256; }
        else              { L -= 904; mix = 5; nM = 32; nN = 1; act = pg8::ACT_SIGMOID; wo = W_G1; oo = A_G1O; ldc = 256; }
        int pm, pn; pg8::tile_of(L, nM, nN, pm, pn);
        const bool i8 = RKV_I8 && (LORA_I8 || mix == 0 || mix == 2 || mix == 3); const size_t eb = i8 ? 1 : 2;
        u.A = (const char*)ws + A_A6 + (size_t)mix * A6_STRIDE + (size_t)pm * 256 * D * eb; u.B = (const char*)ws + wo + (size_t)pn * 256 * D * eb;
        u.O = (bf16_t*)(ws + oo); u.bias = nullptr; u.pm = pm; u.pn = pn; u.ldc = ldc; u.act = act;
        if (i8) { u.rs = (const float*)(ws + WS_RS6) + (size_t)mix * MT;
            if (mix == 0 || mix == 2 || mix == 3) u.bias = (const float*)(ws + WS_CTL) + CW_CMAX2 + (mix == 0 ? 0 : mix - 1) * D;
            else u.bias = (const float*)(ws + WS_CML) + (mix == 1 ? 0 : mix - 3) * 256; }
        return true;
    }
};
struct SchedP3 : SchedBase {
    unsigned char* ws; const float* dw0; const float* ia0; int G, c, lo = 0, hi = 1408, kskip = 0;
    __device__ __forceinline__ bool next(int i, pg8::Unit& u) const {
        int L = lo + i * G + c; if (L >= hi) return false;
        int nM, nN, act, ldc; size_t ao, wo, oo; const float* bias;
        if (L < 576)       { nM = 36; nN = 16; act = pg8::ACT_EW; ao = A_LW; wo = W_WLU; oo = A_EW; ldc = 2 * D; bias = dw0; }
        else if (L < 1152) { L -= 576; nM = 36; nN = 16; act = pg8::ACT_BIAS_SIGMOID; ao = A_LA; wo = W_ALU; oo = A_AA; ldc = 2 * D; bias = ia0; }
        else               { L -= 1152; nM = 32; nN = 8; act = pg8::ACT_NONE; ao = A_G1O; wo = W_G2; oo = A_GATE; ldc = D; bias = nullptr; }
        int pm, pn; pg8::tile_of(L, nM, nN, pm, pn);
        const size_t k0 = (kskip && nN == 16 && pn >= 8) ? 64 * 2 : 0;
        u.A = (const char*)ws + ao + (size_t)pm * 256 * 256 * 2 + k0; u.B = (const char*)ws + wo + (size_t)pn * 256 * 256 * 2 + k0;
        u.O = (bf16_t*)(ws + oo); u.bias = bias; u.pm = pm; u.pn = pn; u.ldc = ldc; u.act = act; return true;
    }
};
struct SchedPool : SchedBase {
    unsigned char* ws; const float* scale; int G, c;
    __device__ __forceinline__ bool next(int i, pg8::Unit& u) const {
        const int L = i * G + c; if (L >= 256) return false;
        int pm, pn; pg8::tile_of(L, 32, 8, pm, pn);
        u.A = (const char*)ws + A_PP + ((size_t)pm * 256 * D + (size_t)(pn >> 1) * 512) * (POOL_I8 ? 1 : 2); u.B = (const char*)ws + W_PW + (size_t)pn * 256 * 512 * (POOL_I8 ? 1 : 2);
        u.O = (bf16_t*)(ws + A_YP); u.bias = scale; u.pm = pm; u.pn = pn; u.ldc = D; u.act = pg8::ACT_COLSCALE;
        if (POOL_I8) { u.act = pg8::ACT_NONE; u.rs = (const float*)(ws + WS_RSP) + (size_t)(pn >> 1) * ML; u.bias = (const float*)(ws + WS_CTL) + CW_CMAX4; }
        return true;
    }
};
struct SchedMoe : SchedBase {
    MoeTab tb; const char* A; const char* B; bf16_t* O; int NT, ldaB, ldbB, ldc; size_t estride; int NL, x, rank, W, mblock;
    __device__ __forceinline__ void init(int G, int c) { NL = (G % 8 == 0) ? 8 : 1; x = c % NL; rank = c / NL; W = G / NL; }
    __device__ __forceinline__ bool next(int i, pg8::Unit& u) const {
        int j = rank + i * W; int e = -1, nt, mtile;
        if (mblock) {
            const int S = (tb.ntile + NL - 1) / NL; mtile = x * S + j / NT; nt = j % NT;
            if (j >= S * NT || mtile >= tb.ntile) return false;
#pragma unroll
            for (int k = 0; k < 8; ++k) e = (mtile >= tb.ts[k] && mtile < tb.ts[k] + tb.mt[k]) ? k : e;
            if (e < 0) return false;
        } else {
            const int nn = (NT - x + NL - 1) / NL; int mte = 1, tse = 0;
#pragma unroll
            for (int k = 0; k < 8; ++k) { const int blk = nn * tb.mt[k]; if (e < 0) { if (j < blk) { e = k; mte = tb.mt[k]; tse = tb.ts[k]; } else j -= blk; } }
            if (e < 0) return false;
            nt = x + NL * (j / mte); mtile = tse + (j % mte);
        }
        u.A = A + (size_t)mtile * 256 * ldaB; u.B = B + (size_t)e * estride + (size_t)nt * 256 * ldbB; u.O = O; u.bias = nullptr; u.pm = mtile; u.pn = nt; u.ldc = ldc; u.act = pg8::ACT_NONE; return true;
    }
};

__device__ __forceinline__ MoeTab moe_tab_trunc(const MoeTab& t, int rt) { MoeTab o; int left = rt, acc = 0;
#pragma unroll
    for (int e = 0; e < 8; ++e) { const int m = t.mt[e] < left ? t.mt[e] : left; o.mt[e] = m; o.ts[e] = t.ts[e]; left -= m; acc += m; }
    o.ntile = acc; return o; }
struct SchedMoeX : SchedBase {
    MoeTab tb; const char* A; const char* B; float* P; int rt, ldaB, ldbB, G, c; size_t estride;
    __device__ __forceinline__ bool next(int i, pg8::Unit& u) const {
        const int j = i * G + c, nsub = (tb.ntile - rt) * 8 * MOE_KS; if (j >= nsub) return false;
        const int ks = j % MOE_KS, r = j / MOE_KS, nt = r & 7, mtile = rt + (r >> 3); int e = 0;
#pragma unroll
        for (int k = 0; k < 8; ++k) e = (mtile >= tb.ts[k] && mtile < tb.ts[k] + tb.mt[k]) ? k : e;
        const int kb = ks * (DFE / MOE_KS);
        u.A = A + (size_t)mtile * 256 * ldaB + kb; u.B = B + (size_t)e * estride + (size_t)nt * 256 * ldbB + kb;
        u.O = (bf16_t*)(P + (size_t)ks * 2048 * D); u.bias = nullptr; u.pm = mtile - rt; u.pn = nt; u.ldc = D; u.act = 0; return true;
    }
};
constexpr int NPHASE = 18;
#ifndef CONV_P2
#define CONV_P2 4096
#endif
#ifndef CONV_P8
#define CONV_P8 (TN_F2 + 3840)
#endif
#if defined(SCAN_NOCONV)
#define CONV_SCAN 0
#elif !defined(CONV_SCAN)
#define CONV_SCAN (MOE_FP8 ? 18432 : 36864)
#endif
#ifndef CONV_P15
#define CONV_P15 0
#endif
#ifndef NC_P15
#define NC_P15 224
#endif
constexpr int TI_C15 = TI_MW2 - CONV_P15;
#ifndef CONV_P3
#define CONV_P3 0
#endif
constexpr int NC_P3 = 235;
#ifndef NC_P8
#define NC_P8 235
#endif
#ifndef NC_P2
#define NC_P2 234
#endif
constexpr int TI_X1 = TI_C15 - (CONV_P8 - TN_F2), TI_X0 = TI_X1 - CONV_P2, TI_W0 = TI_X0 - CONV_SCAN, TI_V0 = TI_W0 - CONV_P3;
__global__ void __launch_bounds__(512, 2) trunk_fwd(Args args) {
    extern __shared__ __attribute__((aligned(16))) unsigned char lds_raw[];
    Frame F;
    F.lds = (LAS unsigned char*)lds_raw;
    F.wave = __builtin_amdgcn_readfirstlane((int)(threadIdx.x >> 6));
    F.G = gridDim.x; { const int bx = blockIdx.x; F.vcu = (F.G % 8 == 0) ? (bx % 8) * (F.G / 8) + bx / 8 : bx; }
    F.gw = F.vcu * 8 + F.wave; F.NGW = F.G * 8;
    F.ws = args.ws; F.ctl = (unsigned*)(args.ws + WS_CTL);
    volatile LAS unsigned* MISC = (volatile LAS unsigned*)(F.lds + MISC_OFF);
    if (threadIdx.x < 32) MISC[threadIdx.x] = 0u;
    __syncthreads();
    XcdBarrier bar; bar.bar = F.ctl + CW_BAR + args.li * XCD_BAR_WORDS; bar.x = 0; bar.st = nullptr;
    if (MK_N_LAUNCHES == 1) bar = xcd_barrier_post(F.ctl + CW_BAR + args.li * XCD_BAR_WORDS, MISC + 8);
    const int lo = args.ph_lo, hi = args.ph_hi;
#define IN(k) (lo <= (k) && (k) < hi)
#if defined(PROBE_BAR2)
#define SEAM(k) do { if (IN(k) && IN((k) + 1)) { xcd_barrier(bar); xcd_barrier(bar); } } while (0)
#else
#define SEAM(k) do { if (IN(k) && IN((k) + 1)) xcd_barrier(bar); } while (0)
#endif
    constexpr bool AL = true, SP = true;
#ifndef ALIGN_I8
#define ALIGN_I8 1
#endif
    constexpr bool AL_I8 = ALIGN_I8 != 0;
#ifndef ALIGN_P15
#define ALIGN_P15 1
#endif
    constexpr bool AL_P15 = ALIGN_P15 != 0;
#if defined(PROBE_STAMP)
#define STAMP(k) do { if (blockIdx.x == 0 && threadIdx.x == 0) { const unsigned now_ = (unsigned)__builtin_amdgcn_s_memrealtime(); if ((k) > 0 && ((PROBE_STAMP >> ((k) - 1)) & 1)) MISC[17] += now_ - MISC[16]; MISC[16] = now_; } } while (0)
#else
#define STAMP(k) do { } while (0)
#endif

    STAMP(0);
    if (IN(0)) {
        if (MOD_V2 && F.G == 256) p0_mod2(F, args); else p0_mod(F, args);
        if (!CMAX_LAST) p0_pos(F);
        p0_small(F, args);
#if defined(PROBE_READ)
        probe_read(F, args);
#endif
#if defined(PROBE_P0A)
        p0_mod(F, args); p0_pos(F); p0_small(F, args);
#endif
        if (FFN_I8) { if (!CMAX_LAST) p0_cmax(F, args);
            p0_transpose_range(F, args, RKV_I8 ? (WO_I8 ? TI_RWKV : TI_RKV3) : 0, TI_RWKV, F.gw, F.NGW, (LAS unsigned*)(F.lds + 53248 + F.wave * 8448));
            p0_transpose_range(F, args, POOL_I8 ? TI_POOL : TI_F3, F.G == 256 ? TI_V0 : (FFN_DN_I8 ? TI_MW2 : TI_M2), F.gw, F.NGW, (LAS unsigned*)(F.lds + 53248 + F.wave * 8448));
            if (CMAX_LAST) { p0_cmax(F, args); p0_pos(F); } }
        else p0_transpose_range(F, args, 0, F.G == 256 ? TI_V0 : (FFN_DN_I8 ? TI_MW2 : TI_M2), F.gw, F.NGW, (LAS unsigned*)(F.lds + 53248 + F.wave * 8448));
    }
    SEAM(0);
    STAMP(1);
    if (IN(1)) { if (POOL_I8) p0_transpose_range<true>(F, args, TI_F3, TI_POOL, F.gw, F.NGW, (LAS unsigned*)(F.lds + 53248 + F.wave * 8448));
        if (RKV_I8) p0_transpose_range<true>(F, args, 0, WO_I8 ? TI_RWKV + F13_P1_N : TI_RKV3, F.gw, F.NGW, (LAS unsigned*)(F.lds + 53248 + F.wave * 8448)); p1_mix(F, args); }
    SEAM(1);
    STAMP(2);
    if (IN(2)) {
        const bool split = F.G == 256;
        if (FFN_I8 && !split) p0_transpose_range<true>(F, args, TI_RWKV + (WO_I8 ? F13_P1_N : 0), TI_F3, F.gw, F.NGW, (LAS unsigned*)(F.lds + 53248 + F.wave * 8448));
        if (split && (int)blockIdx.x >= NC_P2) {
            if (FFN_I8) p0_transpose_range<true>(F, args, TI_RWKV + (WO_I8 ? F13_P1_N : 0), TI_F3, ((int)blockIdx.x - NC_P2) * 8 + F.wave, (256 - NC_P2) * 8, (LAS unsigned*)(F.lds + 53248 + F.wave * 8448));
            p0_transpose_range(F, args, TI_X0, TI_X1, ((int)blockIdx.x - NC_P2) * 8 + F.wave, (256 - NC_P2) * 8, (LAS unsigned*)(F.lds + 53248 + F.wave * 8448)); }
        else if (RKV_I8 && LORA_I8) { SchedP2 S; S.ws = F.ws; S.G = split ? NC_P2 : F.G; S.c = blockIdx.x;
            pg8::gemm_phase<pg8::EpiActI8, SchedP2, AL_I8, SP, 2>(F.lds, pg8::Shape{D, D, D / 128, 0}, S, pg8::EpiActI8{}); }
        else if (RKV_I8) { SchedP2 S; S.ws = F.ws; S.G = split ? NC_P2 : F.G; S.c = blockIdx.x; S.hi = 832;
            pg8::gemm_phase<pg8::EpiActI8, SchedP2, AL_I8, SP, 2>(F.lds, pg8::Shape{D, D, D / 128, 0}, S, pg8::EpiActI8{});
            SchedP2 S2; S2.ws = F.ws; S2.c = blockIdx.x; S2.lo = 832; if (split) { S2.G = 104; S2.coff = 130; } else S2.G = F.G;
            pg8::gemm_phase<pg8::EpiAct, SchedP2, AL, SP>(F.lds, pg8::shape_bf16(D, D, D), S2, pg8::EpiAct{}); }
        else { SchedP2 S; S.ws = F.ws; S.G = split ? NC_P2 : F.G; S.c = blockIdx.x; pg8::gemm_phase<pg8::EpiAct, SchedP2, AL, SP>(F.lds, pg8::shape_bf16(D, D, D), S, pg8::EpiAct{}); }
    }
    SEAM(2);
    STAMP(3);
    if (IN(3) && CONV_P3 > 0 && F.G == 256 && (int)blockIdx.x >= NC_P3) p0_transpose_range(F, args, TI_V0, TI_W0, ((int)blockIdx.x - NC_P3) * 8 + F.wave, (256 - NC_P3) * 8, (LAS unsigned*)(F.lds + 53248 + F.wave * 8448));
    else if (IN(3)) { SchedP3 S; S.ws = F.ws; S.dw0 = args.in[I_DW0]; S.ia0 = args.in[I_IA0]; S.G = (CONV_P3 > 0 && F.G == 256) ? NC_P3 : F.G; S.c = blockIdx.x;
#ifndef P3_KSKIP
#define P3_KSKIP 0
#endif
        if (P3_KSKIP) { S.hi = 1152; S.kskip = 1; pg8::gemm_phase<pg8::EpiAct, SchedP3, AL, SP>(F.lds, pg8::shape_bf16(256, 256, 128), S, pg8::EpiAct{});
            SchedP3 S2 = S; S2.lo = 1152; S2.hi = 1408; S2.kskip = 0; pg8::gemm_phase<pg8::EpiAct, SchedP3, AL, SP>(F.lds, pg8::shape_bf16(256, 256, 256), S2, pg8::EpiAct{}); }
        else pg8::gemm_phase<pg8::EpiAct, SchedP3, AL, SP>(F.lds, pg8::shape_bf16(256, 256, 256), S, pg8::EpiAct{}); }
    SEAM(3);
    STAMP(4);
#if defined(PROBE_SCANCHK)
    if (IN(4)) { p4_scan(F, args); p4_scan2(F, args, F.ws + A_AO, (float*)(F.ws + WS_A + 644 * MiB)); xcd_barrier(bar); p4_compare(F); }
#elif defined(SCAN_STEP)
    if (IN(4)) p4_scan(F, args);
#else
#if defined(SCAN_CONV)
    if (IN(4)) { if (F.G == 256) p4_scan3(F, args, F.ws + A_YD, (float*)(F.ws + WS_SB), TI_W0, TI_X0); else p4_scan2(F, args, F.ws + A_YD, (float*)(F.ws + WS_SB)); }
#elif defined(SCAN_NOCONV)
    if (IN(4)) { if (F.G == 256) p4_scan4(F, args, F.ws + A_YD, (float*)(F.ws + WS_SB)); else p4_scan2(F, args, F.ws + A_YD, (float*)(F.ws + WS_SB)); }
#else
#ifndef SCAN_SPLIT
#define SCAN_SPLIT 0
#endif
    if (IN(4) && SCAN_SPLIT && F.G == 256) {
        if ((int)blockIdx.x < 128) { p4_scan5(F, args, F.ws + A_YD, (float*)(F.ws + WS_SB), 0, 0, (int)blockIdx.x); p4_scan5(F, args, F.ws + A_YD, (float*)(F.ws + WS_SB), 0, 0, (int)blockIdx.x + 128); }
        else p0_transpose_range(F, args, TI_W0, TI_X0, ((int)blockIdx.x - 128) * 8 + F.wave, 128 * 8, (LAS unsigned*)(F.lds + 53248 + F.wave * 8448));
    } else
    if (IN(4)) { if (F.G == 256) p4_scan5(F, args, F.ws + A_YD, (float*)(F.ws + WS_SB), TI_W0, TI_X0); else p4_scan2(F, args, F.ws + A_YD, (float*)(F.ws + WS_SB)); }
#endif
#endif
    SEAM(4);
    STAMP(5);
    if (IN(5)) p5_ao(F, args);
    SEAM(5);
    STAMP(6);
    if (IN(6)) { SchedDense S; S.A = (const char*)F.ws + A_AO; S.B = (const char*)F.ws + W_WO; S.O = (bf16_t*)(F.ws + A_YO); S.bias = nullptr; S.nM = 32; S.nN = 8; S.ldaB = 2 * D; S.ldbB = 2 * D; S.ldc = D; S.act = pg8::ACT_NONE; S.G = F.G; S.c = blockIdx.x;
        if (LN_FUSE && F.G == 256) { const float* MOD = (const float*)(F.ws + WS_MOD);
            pg8::EpiLnMod E{args.in[I_X], (const float*)(F.ws + WS_POS), MOD + 2 * D, args.in[I_LNW], args.in[I_LNB], MOD + 4 * D, MOD + 3 * D, (float*)(F.ws + WS_XR), (bf16_t*)(F.ws + A_H2),
                            pg8::PanelStats8{(unsigned*)(F.ws + WS_XB1), F.ctl + CW_LN1, F.ctl, 0x700u}};
            pg8::gemm_phase<pg8::EpiLnMod, SchedDense, AL, SP>(F.lds, pg8::shape_bf16(D, D, D), S, E); }
        else if (WO_I8) { S.ldaB = D; S.ldbB = D; S.rs = (const float*)(F.ws + WS_RSO); S.bias = (const float*)(F.ws + WS_CTL) + CW_CMAX2 + 3 * D;
            pg8::gemm_phase<pg8::EpiActI8, SchedDense, AL, SP, 2>(F.lds, pg8::Shape{D, D, D / 128, 0}, S, pg8::EpiActI8{}); }
        else pg8::gemm_phase<pg8::EpiAct, SchedDense, AL, SP>(F.lds, pg8::shape_bf16(D, D, D), S, pg8::EpiAct{}); }
    SEAM(6);
    STAMP(7);
    if (IN(7) && !(LN_FUSE && F.G == 256)) { const float* MOD = (const float*)(F.ws + WS_MOD); post_norm_rows(F, args, (const bf16_t*)(F.ws + A_YO), 2 * D, 0, MOD, 3 * D, 4 * D, (void*)(F.ws + A_H2), FFN_I8 ? 2 : (FFN_FP8 != 0), true); }
    if (!(LN_FUSE && F.G == 256)) SEAM(7);
    STAMP(8);
    if (IN(8)) {
        const bool split = F.G == 256;
        if (FFN_DN_I8 && !split) p0_transpose_range<true>(F, args, TI_MW2, TI_M2, F.gw, F.NGW, (LAS unsigned*)(F.lds + 53248 + F.wave * 8448));
        if (split && (int)blockIdx.x >= NC_P8) { p0_transpose_range<FFN_DN_I8 != 0>(F, args, TI_MW2, TI_M2, ((int)blockIdx.x - NC_P8) * 8 + F.wave, (256 - NC_P8) * 8, (LAS unsigned*)(F.lds + 53248 + F.wave * 8448));
            p0_transpose_range(F, args, TI_X1, TI_C15, ((int)blockIdx.x - NC_P8) * 8 + F.wave, (256 - NC_P8) * 8, (LAS unsigned*)(F.lds + 53248 + F.wave * 8448)); }
        else { SchedDense S; S.A = (const char*)F.ws + A_H2; S.B = (const char*)F.ws + W_F13; S.O = (bf16_t*)(F.ws + A_U); S.bias = nullptr; S.nM = 32; S.nN = 44; S.ldaB = (FFN_FP8 || FFN_I8) ? D : 2 * D; S.ldbB = S.ldaB; S.ldc = LDU; S.act = 0; S.G = split ? NC_P8 : F.G; S.c = blockIdx.x;
        if (FFN_I8 && FFN_D8) pg8::gemm_phase<pg8::EpiSwigluI8T<true>, SchedDense, AL_I8, SP, 2>(F.lds, pg8::Shape{D, D, D / 128, 0}, S, pg8::EpiSwigluI8T<true>{(const float*)(F.ws + WS_RS), F.ctl + CW_CMAX, DFF});
        else if (FFN_I8) pg8::gemm_phase<pg8::EpiSwigluI8, SchedDense, AL_I8, SP, 2>(F.lds, pg8::Shape{D, D, D / 128, 0}, S, pg8::EpiSwigluI8{(const float*)(F.ws + WS_RS), F.ctl + CW_CMAX, DFF});
        else if (FFN_FP8) pg8::gemm_phase<pg8::EpiSwiglu8, SchedDense, AL, SP, true>(F.lds, pg8::shape_fp8(D, D, D, 4, 6), S, pg8::EpiSwiglu8{});
        else if (FFN_DN8) pg8::gemm_phase<pg8::EpiSwiglu8, SchedDense, AL, SP>(F.lds, pg8::shape_bf16(D, D, D), S, pg8::EpiSwiglu8{});
        else pg8::gemm_phase<pg8::EpiSwiglu, SchedDense, AL, SP>(F.lds, pg8::shape_bf16(D, D, D), S, pg8::EpiSwiglu{}); } }
    SEAM(8);
    STAMP(9);
    if (IN(9)) { SchedDense S; S.A = (const char*)F.ws + A_U; S.B = (const char*)F.ws + W_F2P; S.O = (bf16_t*)(F.ws + A_YF); S.bias = nullptr; S.nM = 32; S.nN = 8; S.ldaB = FFN_D8 ? LDU : 2 * LDU; S.ldbB = FFN_D8 ? LDF2 : 2 * LDF2; S.ldc = D; S.act = pg8::ACT_NONE; S.G = F.G; S.c = blockIdx.x;
        if (FFN_DN_I8) { p9_quant_u(F); xcd_barrier(bar);
            S.ldaB = 2 * LDU; S.ldbB = LDF2; S.rs = (const float*)(F.ws + WS_RSU); S.bias = (const float*)(F.ws + WS_CTL) + CW_CMAX3;
            pg8::gemm_phase<pg8::EpiActI8, SchedDense, AL, SP, 2>(F.lds, pg8::Shape{2 * LDU, LDF2, DFF / 128, 0}, S, pg8::EpiActI8{}); }
        else if (FFN_D8) pg8::gemm_phase<pg8::EpiAct, SchedDense, AL, SP, true>(F.lds, pg8::shape_fp8(LDU, LDF2, DFF, 3, 8), S, pg8::EpiAct{});
        else if (LN_FUSE && F.G == 256) { const float* MOD = (const float*)(F.ws + WS_MOD); const float* MOD1 = MOD + (size_t)5 * MOD_N;
            pg8::EpiLnMod E{(const float*)(F.ws + WS_XR), nullptr, MOD + 5 * D, args.in[I_LNW] + D, args.in[I_LNB] + D, MOD1 + D, MOD1, (float*)(F.ws + WS_XR), (bf16_t*)(F.ws + A_HP),
                            pg8::PanelStats8{(unsigned*)(F.ws + WS_XB2), F.ctl + CW_LN2, F.ctl, 0x740u}};
            pg8::gemm_phase<pg8::EpiLnMod, SchedDense, AL, SP>(F.lds, pg8::shape_bf16(LDU, LDF2, DFF), S, E); }
        else pg8::gemm_phase<pg8::EpiAct, SchedDense, AL, SP>(F.lds, pg8::shape_bf16(LDU, LDF2, DFF), S, pg8::EpiAct{}); }
    SEAM(9);
    STAMP(10);
    if (IN(10) && !(LN_FUSE && F.G == 256)) { const float* MOD = (const float*)(F.ws + WS_MOD); post_norm_rows(F, args, (const bf16_t*)(F.ws + A_YF), 5 * D, 1, MOD + (size_t)5 * MOD_N, 0, D, (void*)(F.ws + A_HP), false, false); }
    if (!(LN_FUSE && F.G == 256)) SEAM(10);
    STAMP(11);
    if (IN(11)) { if (POOL_SLIDE && !POOL_I8) p11_pool4(F); else p11_pool(F); }
    SEAM(11);
    STAMP(12);
    if (IN(12)) { SchedPool S; S.ws = F.ws; S.scale = args.in[I_POOLS]; S.G = F.G; S.c = blockIdx.x;
        if (POOL_I8) { pg8::EpiActI8 E; E.colmul = args.in[I_POOLS]; pg8::gemm_phase<pg8::EpiActI8, SchedPool, AL, SP, 2>(F.lds, pg8::Shape{D, 512, 512 / 128, 0}, S, E); }
        else pg8::gemm_phase<pg8::EpiAct, SchedPool, AL, SP>(F.lds, pg8::shape_bf16(D, 512, 512), S, pg8::EpiAct{}); }
    SEAM(12);
    STAMP(13);
    if (IN(13)) p13_norm_router(F, args);
    SEAM(13);
    STAMP(14);
    if (IN(14)) p14_gather(F);
    SEAM(14);
    STAMP(15);
    if (IN(15) && CONV_P15 > 0 && F.G == 256 && (int)blockIdx.x >= NC_P15) p0_transpose_range(F, args, TI_C15, TI_MW2, ((int)blockIdx.x - NC_P15) * 8 + F.wave, (256 - NC_P15) * 8, (LAS unsigned*)(F.lds + 53248 + F.wave * 8448));
    else if (IN(15)) { SchedMoe S; S.tb = moe_tab(F); S.A = (const char*)F.ws + A_HG; S.B = (const char*)F.ws + W_M13; S.O = (bf16_t*)(F.ws + A_UG); S.NT = 56; S.mblock = 0; S.ldaB = MOE_FP8 ? D : 2 * D; S.ldbB = S.ldaB; S.ldc = LDUG; S.estride = (size_t)2 * DFE * S.ldbB; S.init((CONV_P15 > 0 && F.G == 256) ? NC_P15 : F.G, blockIdx.x);
        if (MOE_FP8) pg8::gemm_phase<pg8::EpiSwiglu8, SchedMoe, AL_P15, SP, true, MOE_AUX_UP>(F.lds, pg8::shape_fp8(D, D, D, 4, 6), S, pg8::EpiSwiglu8{});
        else pg8::gemm_phase<pg8::EpiSwiglu, SchedMoe, AL, SP>(F.lds, pg8::shape_bf16(D, D, D), S, pg8::EpiSwiglu{}); }
    SEAM(15);
    STAMP(16);
    if (IN(16)) { SchedMoe S; const MoeTab full = moe_tab(F); const bool splitk = MOE_FP8 && F.G == 256 && full.ntile > MOE_RT;
        S.tb = splitk ? moe_tab_trunc(full, MOE_RT) : full; S.A = (const char*)F.ws + A_UG; S.B = (const char*)F.ws + W_M2; S.O = (bf16_t*)(F.ws + A_Y2); S.NT = 8; S.mblock = 1; S.ldaB = MOE_FP8 ? LDUG : 2 * LDUG; S.ldbB = MOE_FP8 ? LDM2 : 2 * LDM2; S.ldc = D; S.estride = (size_t)D * S.ldbB; S.init(F.G, blockIdx.x);
        if (MOE_FP8) pg8::gemm_phase<pg8::EpiAct, SchedMoe, AL, SP, true, MOE_AUX_DN>(F.lds, pg8::shape_fp8(LDUG, LDM2, DFE, 3, 8), S, pg8::EpiAct{});
        else pg8::gemm_phase<pg8::EpiAct, SchedMoe, AL, SP>(F.lds, pg8::shape_bf16(LDUG, LDM2, DFE), S, pg8::EpiAct{});
        if (splitk) { SchedMoeX X; X.tb = full; X.A = S.A; X.B = S.B; X.P = (float*)(F.ws + WS_PART); X.rt = MOE_RT; X.ldaB = LDUG; X.ldbB = LDM2; X.G = F.G; X.c = blockIdx.x; X.estride = S.estride;
            pg8::gemm_phase<pg8::EpiF32P, SchedMoeX, AL, SP, true>(F.lds, pg8::shape_fp8(LDUG, LDM2, DFE / MOE_KS, 3, 8), X, pg8::EpiF32P{}); } }
    STAMP(17);
#if defined(PROBE_STAMP)
    if (blockIdx.x == 0 && threadIdx.x == 0) __hip_atomic_store(F.ctl + 24576, MISC[17], __ATOMIC_RELAXED, __HIP_MEMORY_SCOPE_AGENT);
#endif
    SEAM(16);
    if (IN(17)) p17_final(F, args);
#undef IN
#undef SEAM
}

extern "C" void kernel_launch(void* const* d_in, const int* in_sizes, int n_in, void* d_out, int out_size, void* d_ws, size_t ws_size, hipStream_t stream) {
    static int grid = 0;
    if (grid == 0) {
        if (n_in != 35 || out_size != ML * D || ws_size < WS_END) { fprintf(stderr, "kernel_launch: unexpected problem (n_in %d, out %d, ws %zu < %zu); nothing launched\n", n_in, out_size, ws_size, (size_t)WS_END); grid = -1; return; }
        int dev = 0, cus = 0, per_cu = 0;
        if (hipGetDevice(&dev) != hipSuccess || hipDeviceGetAttribute(&cus, hipDeviceAttributeMultiprocessorCount, dev) != hipSuccess) { grid = -1; return; }
        if (hipFuncSetAttribute((const void*)trunk_fwd, hipFuncAttributeMaxDynamicSharedMemorySize, LDS_BYTES) != hipSuccess) { fprintf(stderr, "kernel_launch: hipFuncSetAttribute failed\n"); grid = -1; return; }
        if (hipOccupancyMaxActiveBlocksPerMultiprocessor(&per_cu, (const void*)trunk_fwd, 512, LDS_BYTES) != hipSuccess || per_cu < 1) fprintf(stderr, "kernel_launch: occupancy query reports %d\n", per_cu);
        (void)hipGetLastError();
        grid = cus;
    }
    if (grid < 0) return;
    if (hipMemsetAsync((char*)d_ws + WS_CTL, 0, CTL_ZERO_BYTES, stream) != hipSuccess) return;
    Args a{};
    for (int i = 0; i < 35; ++i) a.in[i] = (const float*)d_in[i];
    a.out = (float*)d_out; a.ws = (unsigned char*)d_ws;
#if defined(PROBE_DUP)
    a.ph_lo = 0; a.ph_hi = PROBE_DUP + 1; a.li = 0; hipLaunchKernelGGL(trunk_fwd, dim3(grid), dim3(512), LDS_BYTES, stream, a);
    a.ph_lo = PROBE_DUP; a.ph_hi = NPHASE; a.li = 1; hipLaunchKernelGGL(trunk_fwd, dim3(grid), dim3(512), LDS_BYTES, stream, a);
#else
    if (MK_N_LAUNCHES == 1) { a.ph_lo = 0; a.ph_hi = NPHASE; hipLaunchKernelGGL(trunk_fwd, dim3(grid), dim3(512), LDS_BYTES, stream, a); }
#endif
#if !defined(PROBE_DUP)
    else for (int p = 0; p < NPHASE; ++p) { a.ph_lo = p; a.ph_hi = p + 1; hipLaunchKernelGGL(trunk_fwd, dim3(grid), dim3(512), LDS_BYTES, stream, a); }
#endif
}
```

```cpp
#define FFN_I8 1
#define RKV_I8 1
#define WO_I8 1
#define LORA_I8 1
#define FFN_DN8 1
#define F13_P1_N 384
#define CMAX_LAST 1
#define P3_KSKIP 1
#define POOL_SLIDE 1
#define LN_HOIST 1
#define NC_P2 188
#define CONV_P2 6912
#define NC_P8 202
#define CONV_P8 (TN_F2+8192)
#define CONV_P15 12288
#define NC_P15 224
#define CONV_SCAN 15616
#include <hip/hip_runtime.h>
#include <cstdio>
#include <cstdint>

#ifndef MK_N_LAUNCHES
#define MK_N_LAUNCHES 1
#endif

#define LAS __attribute__((address_space(3)))
#define PG8_LAS __attribute__((address_space(3)))
typedef unsigned short bf16_t;
typedef short bf16x8 __attribute__((ext_vector_type(8)));
typedef float f32x4 __attribute__((ext_vector_type(4)));
typedef float f32x2 __attribute__((ext_vector_type(2)));
typedef unsigned u32x4 __attribute__((ext_vector_type(4)));
typedef unsigned u32x2 __attribute__((ext_vector_type(2)));
typedef int i32x8 __attribute__((ext_vector_type(8)));
typedef int i32x4 __attribute__((ext_vector_type(4)));

constexpr int D = 2048, NB = 4, T = 2048, TC = 256, NH = 32, HS = 64;
constexpr int ML = NB * T;
constexpr int MC = NB * TC;
constexpr int MT = ML + MC;
constexpr int DFF = 5632, DFE = 7168, NE = 8;
constexpr int MOD_N = 6 * D;
constexpr int MROWS_PAD = 2 * ML + NE * 256;
constexpr float ALPHA = 1.41421356237309515f;
constexpr float LN_EPS = 1e-5f, GN_EPS = 64e-5f;

__device__ __forceinline__ unsigned f2bf(float f) { unsigned u = __builtin_bit_cast(unsigned, f); return (u + 0x7fffu + ((u >> 16) & 1u)) >> 16; }
typedef __bf16 bf16x2v __attribute__((ext_vector_type(2)));
__device__ __forceinline__ unsigned pk2(float lo, float hi) { const f32x2 v = {lo, hi}; return __builtin_bit_cast(unsigned, __builtin_convertvector(v, bf16x2v)); }
__device__ __forceinline__ float clamp8(float x) { return __builtin_amdgcn_fmed3f(x, -440.f, 440.f); }
__device__ __forceinline__ unsigned pk4_fp8(float a, float b, float c, float d) { int v = __builtin_amdgcn_cvt_pk_fp8_f32(clamp8(a), clamp8(b), 0, false); v = __builtin_amdgcn_cvt_pk_fp8_f32(clamp8(c), clamp8(d), v, true); return (unsigned)v; }
__device__ __forceinline__ unsigned pk4_fp8_nc(float a, float b, float c, float d) { int v = __builtin_amdgcn_cvt_pk_fp8_f32(a, b, 0, false); v = __builtin_amdgcn_cvt_pk_fp8_f32(c, d, v, true); return (unsigned)v; }
__device__ __forceinline__ unsigned pk4_i8(float a, float b, float c, float d) {
    const unsigned ua = __builtin_bit_cast(unsigned, a + 12582912.0f), ub = __builtin_bit_cast(unsigned, b + 12582912.0f), uc = __builtin_bit_cast(unsigned, c + 12582912.0f), ud = __builtin_bit_cast(unsigned, d + 12582912.0f);
    const unsigned lo = __builtin_amdgcn_perm(ub, ua, 0x0c0c0400u), hi = __builtin_amdgcn_perm(ud, uc, 0x0c0c0400u);
    return __builtin_amdgcn_perm(hi, lo, 0x05040100u);
}
__device__ __forceinline__ float bflo(unsigned w) { return __builtin_bit_cast(float, w << 16); }
__device__ __forceinline__ float bfhi(unsigned w) { return __builtin_bit_cast(float, w & 0xffff0000u); }
__device__ __forceinline__ float fexp(float x) { return __builtin_amdgcn_exp2f(x * 1.44269504088896341f); }
__device__ __forceinline__ float flog(float x) { return __builtin_amdgcn_logf(x) * 0.69314718055994531f; }
__device__ __forceinline__ float sigmoidf_(float x) { return __builtin_amdgcn_rcpf(1.0f + fexp(-x)); }
__device__ __forceinline__ float siluf_(float x) { return x * __builtin_amdgcn_rcpf(1.0f + fexp(-x)); }
__device__ __forceinline__ float tanhf_(float x) { return 1.0f - 2.0f * __builtin_amdgcn_rcpf(1.0f + fexp(2.0f * x)); }
__device__ __forceinline__ int lane_id() { int l; asm volatile("v_mbcnt_lo_u32_b32 %0, -1, 0\n\tv_mbcnt_hi_u32_b32 %0, -1, %0" : "=v"(l)); return l; }
template <int CTRL> __device__ __forceinline__ float dpp_f(float v) { return __builtin_bit_cast(float, __builtin_amdgcn_update_dpp(0, __builtin_bit_cast(int, v), CTRL, 0xF, 0xF, true)); }
__device__ __forceinline__ float wave_sum(float v) {
#pragma unroll
    for (int o = 1; o < 64; o <<= 1) v += __shfl_xor(v, o);
    return v;
}
__device__ __forceinline__ float row_max16(float v) {
    v = fmaxf(v, dpp_f<0xB1>(v)); v = fmaxf(v, dpp_f<0x4E>(v)); v = fmaxf(v, dpp_f<0x141>(v)); v = fmaxf(v, dpp_f<0x140>(v)); return v;
}
__device__ __forceinline__ float wave_max(float v) {
    v = fmaxf(v, dpp_f<0xB1>(v)); v = fmaxf(v, dpp_f<0x4E>(v)); v = fmaxf(v, dpp_f<0x141>(v)); v = fmaxf(v, dpp_f<0x140>(v));
    v = fmaxf(v, __shfl_xor(v, 16)); v = fmaxf(v, __shfl_xor(v, 32)); return v;
}
__device__ __forceinline__ float sum8(float v) {
    v += dpp_f<0xB1>(v);
    v += dpp_f<0x4E>(v);
    v += dpp_f<0x141>(v);
    return v;
}
__device__ __forceinline__ const char* uptr(const void* p) {
    unsigned long long v = (unsigned long long)p;
    unsigned lo = (unsigned)__builtin_amdgcn_readfirstlane((int)(unsigned)v), hi = (unsigned)__builtin_amdgcn_readfirstlane((int)(unsigned)(v >> 32));
    return (const char*)(((unsigned long long)hi << 32) | lo);
}

namespace pg8 {
constexpr int BM = 256, BK = 64, HALF = 128, HTB = HALF * BK * 2  , STAGE_BYTES = 8 * HTB, NXCD = 8, WGM = 8;
__host__ __device__ __forceinline__ int lds_byte(int r, int c) { const int st = (r >> 4) * 2 + (c >> 5), rr = r & 15, cc = c & 31, ob = rr * 64 + cc * 2; return st * 1024 + (ob ^ (((ob >> 9) & 1) << 5)); }
__host__ __device__ __forceinline__ void stage_rc(int b, int& R, int& C) { const int st = b / 1024, sb = b % 1024, swz = sb ^ (((sb >> 9) & 1) << 5); R = (st >> 1) * 16 + swz / 64; C = (st & 1) * 32 + (swz % 64) / 2; }
__host__ __device__ __forceinline__ int perm32(int rho) { const int n = rho >> 4, i = rho & 15; return 8 * (i >> 2) + 4 * n + (i & 3); }
__device__ __forceinline__ unsigned cvt_pk_bf16(float lo, float hi) { unsigned r; asm volatile("v_cvt_pk_bf16_f32 %0, %1, %2" : "=v"(r) : "v"(lo), "v"(hi)); return r; }

struct Unit { const char* A; const char* B; bf16_t* O; const float* bias; const float* rs  ; int pm, pn, ldc, act; };
struct Shape { int ldaB, ldbB, nt, sc; };
__host__ __device__ __forceinline__ Shape shape_bf16(int lda, int ldb, int K) { return Shape{2 * lda, 2 * ldb, K / 64, 0}; }
__host__ __device__ __forceinline__ Shape shape_fp8(int lda, int ldb, int K, int ea, int eb) { return Shape{lda, ldb, K / 128, ((127 - ea) << 8) | (127 - eb)}; }

__device__ __forceinline__ void tile_of(int l, int nM, int nN, int& pm, int& pn) {
    const int nwg = nM * nN; int wgid = l;
    { const int q = nwg / NXCD, r = nwg % NXCD, xcd = wgid % NXCD, off = wgid / NXCD; wgid = (xcd < r ? xcd * (q + 1) : r * (q + 1) + (xcd - r) * q) + off; }
    const int nig = WGM * nN, gid = wgid / nig, fm = gid * WGM, gsz = (nM - fm) < WGM ? (nM - fm) : WGM;
    pm = fm + ((wgid % nig) % gsz); pn = (wgid % nig) / gsz;
}

enum Act { ACT_NONE = 0, ACT_TANH = 1, ACT_SIGMOID = 2, ACT_EW = 3, ACT_BIAS_SIGMOID = 4, ACT_COLSCALE = 5 };
__device__ __forceinline__ float act_apply(float v, float b, int act) {
    if (act == ACT_TANH) return tanhf_(v);
    if (act == ACT_SIGMOID) return sigmoidf_(v);
    if (act == ACT_EW) return 0.60653065971263342f * sigmoidf_(v + b);
    if (act == ACT_BIAS_SIGMOID) return sigmoidf_(v + b);
    if (act == ACT_COLSCALE) return v * b;
    return v;
}
struct EpiAct {
    static constexpr bool PERM = true, AFTER_DRAIN = false;
    __device__ __forceinline__ void operator()(const f32x4 (&acc)[2][2][4][2], const Unit& u, int wr, int wc) const {
        const int lane_ = lane_id(), fr = lane_ & 15, fq = lane_ >> 4;
        const int row0 = u.pm * BM + wr * 64 + fr, col0 = u.pn * BM + wc * 32 + 8 * fq; const int act = u.act;
        f32x4 bv[2][2];
#pragma unroll
        for (int bj = 0; bj < 2; ++bj)
#pragma unroll
            for (int n = 0; n < 2; ++n) bv[bj][n] = u.bias ? *(const f32x4*)(u.bias + col0 + bj * HALF + 4 * n) : (f32x4){0.f, 0.f, 0.f, 0.f};
#pragma unroll
        for (int ai = 0; ai < 2; ++ai)
#pragma unroll
            for (int m = 0; m < 4; ++m) { bf16_t* rowp = u.O + (size_t)(row0 + ai * HALF + m * 16) * u.ldc + col0;
#pragma unroll
                for (int bj = 0; bj < 2; ++bj) { f32x4 v0 = acc[ai][bj][m][0], v1 = acc[ai][bj][m][1];
                    if (act != ACT_NONE) {
#pragma unroll
                        for (int j = 0; j < 4; ++j) { v0[j] = act_apply(v0[j], bv[bj][0][j], act); v1[j] = act_apply(v1[j], bv[bj][1][j], act); } }
                    u32x4 w; w.x = cvt_pk_bf16(v0[0], v0[1]); w.y = cvt_pk_bf16(v0[2], v0[3]); w.z = cvt_pk_bf16(v1[0], v1[1]); w.w = cvt_pk_bf16(v1[2], v1[3]);
                    *(u32x4*)(rowp + bj * HALF) = w; } }
    }
};
struct EpiActI8 {
    static constexpr bool PERM = true, AFTER_DRAIN = false;
    const float* colmul = nullptr;
    __device__ __forceinline__ void operator()(const f32x4 (&acc)[2][2][4][2], const Unit& u, int wr, int wc) const {
        const int lane_ = lane_id(), fr = lane_ & 15, fq = lane_ >> 4;
        const int row0 = u.pm * BM + wr * 64 + fr, col0 = u.pn * BM + wc * 32 + 8 * fq;
        f32x4 bv[2][2];
#pragma unroll
        for (int bj = 0; bj < 2; ++bj)
#pragma unroll
            for (int n = 0; n < 2; ++n) { bv[bj][n] = *(const f32x4*)(u.bias + col0 + bj * HALF + 4 * n) * (1.0f / 127.0f); if (colmul) bv[bj][n] = bv[bj][n] * *(const f32x4*)(colmul + col0 + bj * HALF + 4 * n); }
#pragma unroll
        for (int ai = 0; ai < 2; ++ai)
#pragma unroll
            for (int m = 0; m < 4; ++m) { const int r = row0 + ai * HALF + m * 16; bf16_t* rowp = u.O + (size_t)r * u.ldc + col0; const float rv = u.rs[r];
#pragma unroll
                for (int bj = 0; bj < 2; ++bj) {
                    f32x4 v0 = __builtin_convertvector(__builtin_bit_cast(i32x4, acc[ai][bj][m][0]), f32x4) * (bv[bj][0] * rv), v1 = __builtin_convertvector(__builtin_bit_cast(i32x4, acc[ai][bj][m][1]), f32x4) * (bv[bj][1] * rv);
                    if (u.act != ACT_NONE) {
#pragma unroll
                        for (int j = 0; j < 4; ++j) { v0[j] = act_apply(v0[j], 0.f, u.act); v1[j] = act_apply(v1[j], 0.f, u.act); } }
                    u32x4 w; w.x = cvt_pk_bf16(v0[0], v0[1]); w.y = cvt_pk_bf16(v0[2], v0[3]); w.z = cvt_pk_bf16(v1[0], v1[1]); w.w = cvt_pk_bf16(v1[2], v1[3]);
                    *(u32x4*)(rowp + bj * HALF) = w; } }
    }
};
struct EpiF32P {
    static constexpr bool PERM = true, AFTER_DRAIN = false;
    __device__ __forceinline__ void operator()(const f32x4 (&acc)[2][2][4][2], const Unit& u, int wr, int wc) const {
        const int lane_ = lane_id(), fr = lane_ & 15, fq = lane_ >> 4;
        const int row0 = u.pm * BM + wr * 64 + fr, col0 = u.pn * BM + wc * 32 + 8 * fq;
#pragma unroll
        for (int ai = 0; ai < 2; ++ai)
#pragma unroll
            for (int m = 0; m < 4; ++m) { float* rowp = (float*)u.O + (size_t)(row0 + ai * HALF + m * 16) * u.ldc + col0;
#pragma unroll
                for (int bj = 0; bj < 2; ++bj) { *(f32x4*)(rowp + bj * HALF) = acc[ai][bj][m][0]; *(f32x4*)(rowp + bj * HALF + 4) = acc[ai][bj][m][1]; } }
    }
};
struct EpiSwiglu {
    static constexpr bool PERM = true, AFTER_DRAIN = false;
    __device__ __forceinline__ void operator()(const f32x4 (&acc)[2][2][4][2], const Unit& u, int wr, int wc) const {
        const int lane_ = lane_id(), fr = lane_ & 15, fq = lane_ >> 4;
        const int row0 = u.pm * BM + wr * 64 + fr, col0 = u.pn * HALF + wc * 32 + 8 * fq;
#pragma unroll
        for (int ai = 0; ai < 2; ++ai)
#pragma unroll
            for (int m = 0; m < 4; ++m) { bf16_t* rowp = u.O + (size_t)(row0 + ai * HALF + m * 16) * u.ldc + col0;
                f32x4 o0, o1;
#pragma unroll
                for (int j = 0; j < 4; ++j) { o0[j] = siluf_(acc[ai][0][m][0][j]) * acc[ai][1][m][0][j]; o1[j] = siluf_(acc[ai][0][m][1][j]) * acc[ai][1][m][1][j]; }
                u32x4 w; w.x = cvt_pk_bf16(o0[0], o0[1]); w.y = cvt_pk_bf16(o0[2], o0[3]); w.z = cvt_pk_bf16(o1[0], o1[1]); w.w = cvt_pk_bf16(o1[2], o1[3]);
                *(u32x4*)rowp = w; }
    }
};

struct EpiSwiglu8 {
    static constexpr bool PERM = true, AFTER_DRAIN = false;
    __device__ __forceinline__ void operator()(const f32x4 (&acc)[2][2][4][2], const Unit& u, int wr, int wc) const {
        const int lane_ = lane_id(), fr = lane_ & 15, fq = lane_ >> 4;
        const int row0 = u.pm * BM + wr * 64 + fr, col0 = u.pn * HALF + wc * 32 + 8 * fq;
#pragma unroll
        for (int ai = 0; ai < 2; ++ai)
#pragma unroll
            for (int m = 0; m < 4; ++m) { unsigned char* rowp = (unsigned char*)u.O + (size_t)(row0 + ai * HALF + m * 16) * u.ldc + col0;
                f32x4 o0, o1;
#pragma unroll
                for (int j = 0; j < 4; ++j) { o0[j] = siluf_(acc[ai][0][m][0][j]) * acc[ai][1][m][0][j] * 8.0f; o1[j] = siluf_(acc[ai][0][m][1][j]) * acc[ai][1][m][1][j] * 8.0f; }
                u32x2 w; w.x = pk4_fp8(o0[0], o0[1], o0[2], o0[3]); w.y = pk4_fp8(o1[0], o1[1], o1[2], o1[3]);
                *(u32x2*)rowp = w; }
    }
};

template <bool F8OUT = false>
struct EpiSwigluI8T {
    static constexpr bool PERM = true, AFTER_DRAIN = false;
    const float* rs; const unsigned* cmax; int nw;
    __device__ __forceinline__ void operator()(const f32x4 (&acc)[2][2][4][2], const Unit& u, int wr, int wc) const {
        const int lane_ = lane_id(), fr = lane_ & 15, fq = lane_ >> 4;
        const int row0 = u.pm * BM + wr * 64 + fr, col0 = u.pn * HALF + wc * 32 + 8 * fq;
        f32x4 c1[2], c3[2];
#pragma unroll
        for (int n = 0; n < 2; ++n) { c1[n] = __builtin_bit_cast(f32x4, *(const u32x4*)(cmax + col0 + 4 * n)) * (1.0f / 127.0f); c3[n] = __builtin_bit_cast(f32x4, *(const u32x4*)(cmax + nw + col0 + 4 * n)) * ((F8OUT ? 8.0f : 1.0f) / 127.0f); }
#pragma unroll
        for (int ai = 0; ai < 2; ++ai)
#pragma unroll
            for (int m = 0; m < 4; ++m) { const int r = row0 + ai * HALF + m * 16; bf16_t* rowp = u.O + (size_t)r * u.ldc + col0; const float rv = rs[r];
                f32x4 o0, o1;
                const f32x4 A0 = __builtin_convertvector(__builtin_bit_cast(i32x4, acc[ai][0][m][0]), f32x4) * (c1[0] * rv), B0 = __builtin_convertvector(__builtin_bit_cast(i32x4, acc[ai][1][m][0]), f32x4) * (c3[0] * rv);
                const f32x4 A1 = __builtin_convertvector(__builtin_bit_cast(i32x4, acc[ai][0][m][1]), f32x4) * (c1[1] * rv), B1 = __builtin_convertvector(__builtin_bit_cast(i32x4, acc[ai][1][m][1]), f32x4) * (c3[1] * rv);
#pragma unroll
                for (int j = 0; j < 4; ++j) { o0[j] = siluf_(A0[j]) * B0[j]; o1[j] = siluf_(A1[j]) * B1[j]; }
                if constexpr (F8OUT) { u32x2 w; w.x = pk4_fp8(o0[0], o0[1], o0[2], o0[3]); w.y = pk4_fp8(o1[0], o1[1], o1[2], o1[3]);
                    *(u32x2*)((unsigned char*)u.O + (size_t)r * u.ldc + col0) = w; }
                else { u32x4 w; w.x = cvt_pk_bf16(o0[0], o0[1]); w.y = cvt_pk_bf16(o0[2], o0[3]); w.z = cvt_pk_bf16(o1[0], o1[1]); w.w = cvt_pk_bf16(o1[2], o1[3]);
                    *(u32x4*)rowp = w; } }
    }
};
using EpiSwigluI8 = EpiSwigluI8T<false>;

struct PanelStats8 {
    unsigned* xbuf;
    unsigned* cnt;
    unsigned* tmo;
    unsigned code;
    __device__ __forceinline__ bool run(const f32x4 (&v)[2][2][4][2], const Unit& u, int wr, int wc, int fr, int fq, PG8_LAS unsigned char* lds, int wid, int lane) const {
        PG8_LAS f32x2* P = (PG8_LAS f32x2*)lds;
        PG8_LAS f32x2* S = (PG8_LAS f32x2*)(lds + 8192);
        PG8_LAS unsigned* flag = (PG8_LAS unsigned*)(lds + 8192 + 2048);
#pragma unroll
        for (int ai = 0; ai < 2; ++ai)
#pragma unroll
            for (int m = 0; m < 4; ++m) {
                float s = 0.f;
#pragma unroll
                for (int bj = 0; bj < 2; ++bj)
#pragma unroll
                    for (int n = 0; n < 2; ++n) { const f32x4 x = v[ai][bj][m][n]; s += (x[0] + x[1]) + (x[2] + x[3]); }
                s += __shfl_xor(s, 16); s += __shfl_xor(s, 32);
                const float mw = s * (1.0f / 64.0f); float q = 0.f;
#pragma unroll
                for (int bj = 0; bj < 2; ++bj)
#pragma unroll
                    for (int n = 0; n < 2; ++n) { const f32x4 d = v[ai][bj][m][n] - mw; q += (d[0] * d[0] + d[1] * d[1]) + (d[2] * d[2] + d[3] * d[3]); }
                q += __shfl_xor(q, 16); q += __shfl_xor(q, 32);
                if (fq == 0) P[(ai * HALF + wr * 64 + m * 16 + fr) * 4 + wc] = (f32x2){mw, q};
            }
        asm volatile("s_waitcnt lgkmcnt(0)" ::: "memory"); __builtin_amdgcn_s_barrier(); asm volatile("" ::: "memory");
        const int row = wid * 32 + (lane & 31);
        if (lane < 32) {
            const f32x2 a = P[row * 4 + 0], b = P[row * 4 + 1], c = P[row * 4 + 2], d = P[row * 4 + 3];
            const float mt = (a.x + b.x + c.x + d.x) * 0.25f;
            const float da = a.x - mt, db = b.x - mt, dc = c.x - mt, dd = d.x - mt;
            const float m2 = (a.y + b.y) + (c.y + d.y) + 64.0f * ((da * da + db * db) + (dc * dc + dd * dd));
            unsigned long long* slot = (unsigned long long*)xbuf + ((size_t)(u.pm * BM + row) * 8 + u.pn);
            __hip_atomic_store(slot, ((unsigned long long)__builtin_bit_cast(unsigned, m2) << 32) | __builtin_bit_cast(unsigned, mt), __ATOMIC_RELAXED, __HIP_MEMORY_SCOPE_AGENT);
        }
        asm volatile("s_waitcnt vmcnt(0)" ::: "memory");
        if (lane == 0) __hip_atomic_fetch_add(cnt + 64 * u.pm, 1u, __ATOMIC_RELAXED, __HIP_MEMORY_SCOPE_AGENT);
        if (wid == 0) {
            bool dead = false; const unsigned long long t0 = __builtin_amdgcn_s_memrealtime(); const unsigned want = 8u * 8u;
            for (;;) {
                if ((unsigned)__builtin_amdgcn_readfirstlane(__hip_atomic_load(cnt + 64 * u.pm, __ATOMIC_RELAXED, __HIP_MEMORY_SCOPE_AGENT)) >= want) break;
                if (__builtin_amdgcn_s_memrealtime() - t0 > 2000000ull) {
                    if (lane == 0) { unsigned expect = 0u; __hip_atomic_compare_exchange_strong(tmo + 1, &expect, code | (unsigned)(u.pm & 0xff), __ATOMIC_RELAXED, __ATOMIC_RELAXED, __HIP_MEMORY_SCOPE_AGENT);
                                     __hip_atomic_store(tmo, 1u, __ATOMIC_RELAXED, __HIP_MEMORY_SCOPE_AGENT); }
                    dead = true; break; }
                __builtin_amdgcn_s_sleep(2);
            }
            __builtin_amdgcn_fence(__ATOMIC_ACQUIRE, "agent");
            if (lane == 0) flag[0] = dead ? 1u : 0u;
        }
        asm volatile("s_waitcnt vmcnt(0) lgkmcnt(0)" ::: "memory"); __builtin_amdgcn_s_barrier(); asm volatile("" ::: "memory");
        const bool bad = flag[0] != 0u;
        if (lane < 32) {
            const unsigned long long* slot = (const unsigned long long*)xbuf + (size_t)(u.pm * BM + row) * 8; float mt[8], m2[8]; float ms = 0.f;
#pragma unroll
            for (int t = 0; t < 8; ++t) { const unsigned long long w = __hip_atomic_load(slot + t, __ATOMIC_RELAXED, __HIP_MEMORY_SCOPE_AGENT); mt[t] = __builtin_bit_cast(float, (unsigned)w); m2[t] = __builtin_bit_cast(float, (unsigned)(w >> 32)); ms += mt[t]; }
            const float mean = ms * 0.125f; float q = 0.f;
#pragma unroll
            for (int t = 0; t < 8; ++t) { const float dm = mt[t] - mean; q += m2[t] + 256.0f * dm * dm; }
            S[row] = (f32x2){mean, 1.0f / sqrtf(q * (1.0f / 2048.0f) + LN_EPS)};
        }
        asm volatile("s_waitcnt lgkmcnt(0)" ::: "memory"); __builtin_amdgcn_s_barrier(); asm volatile("" ::: "memory");
        return bad;
    }
};
struct EpiLnMod {
    static constexpr bool PERM = false, AFTER_DRAIN = true;
    const float* xin; const float* pos; const float* g; const float* lnw; const float* lnb; const float* sc; const float* sh; float* XR; bf16_t* H; PanelStats8 st;
    __device__ __forceinline__ void fused(f32x4 (&acc)[2][2][4][2], const Unit& u, int wr, int wc, int fr, int fq, PG8_LAS unsigned char* lds, int wid, int lane) const {
        const PG8_LAS f32x2* S = (const PG8_LAS f32x2*)(lds + 8192);
        const int col0 = u.pn * BM + wc * 32 + 4 * fq; const size_t mo = (size_t)(u.pm >> 3) * MOD_N;
        f32x4 gv[2][2];
#pragma unroll
        for (int bj = 0; bj < 2; ++bj)
#pragma unroll
            for (int n = 0; n < 2; ++n) gv[bj][n] = *(const f32x4*)(g + mo + col0 + bj * HALF + n * 16);
#pragma unroll
        for (int ai = 0; ai < 2; ++ai)
#pragma unroll
            for (int m = 0; m < 4; ++m) { const int r = u.pm * BM + ai * HALF + wr * 64 + m * 16 + fr; const size_t off = (size_t)r * D + col0; const size_t poff = (size_t)(r % T) * D + col0;
#pragma unroll
                for (int bj = 0; bj < 2; ++bj)
#pragma unroll
                    for (int n = 0; n < 2; ++n) { f32x4 xv = *(const f32x4*)(xin + off + bj * HALF + n * 16); if (pos) xv += *(const f32x4*)(pos + poff + bj * HALF + n * 16);
                        acc[ai][bj][m][n] = xv * ALPHA + gv[bj][n] * acc[ai][bj][m][n]; }
                asm volatile("" : "+v"(acc[ai][0][m][0]), "+v"(acc[ai][0][m][1]), "+v"(acc[ai][1][m][0]), "+v"(acc[ai][1][m][1]));
                asm volatile("" ::: "memory"); }
        const bool bad = st.run(acc, u, wr, wc, fr, fq, lds, wid, lane);
        const float qnan = __builtin_nanf("");
#pragma unroll
        for (int bj = 0; bj < 2; ++bj)
#pragma unroll
            for (int n = 0; n < 2; ++n) { const int c = col0 + bj * HALF + n * 16;
                const f32x4 w4 = *(const f32x4*)(lnw + c), b4 = *(const f32x4*)(lnb + c), s4 = *(const f32x4*)(sc + mo + c) + 1.0f, h4 = *(const f32x4*)(sh + mo + c);
#pragma unroll
                for (int ai = 0; ai < 2; ++ai)
#pragma unroll
                    for (int m = 0; m < 4; ++m) { const int rl = ai * HALF + wr * 64 + m * 16 + fr; const f32x2 sr = S[rl]; const size_t off = (size_t)(u.pm * BM + rl) * D + c;
                        f32x4 xn = (acc[ai][bj][m][n] - sr.x) * sr.y * w4 + b4; if (bad) xn = (f32x4){qnan, qnan, qnan, qnan};
                        *(f32x4*)(XR + off) = xn; const f32x4 hv = xn * s4 + h4;
                        u32x2 hw; hw.x = cvt_pk_bf16(hv[0], hv[1]); hw.y = cvt_pk_bf16(hv[2], hv[3]); *(u32x2*)(H + off) = hw; } }
    }
};

template <class Epi, class Sched, bool ALIGN_EPI = true, bool SP2 = true, int FP8 = 0  , int AUXB = 0>
__device__ __forceinline__ void gemm_phase(PG8_LAS unsigned char* lds, const Shape g, const Sched& S, const Epi& E) {
    const int lane = lane_id(), wid = __builtin_amdgcn_readfirstlane((int)(threadIdx.x >> 6)), tid = wid * 64 + lane, wr = wid >> 2, wc = wid & 3, fr = lane & 15, fq = lane >> 4;
    const int nt = g.nt;
    unsigned voffA[2], voffB[2];
#pragma unroll
    for (int i = 0; i < 2; ++i) { int R, C; stage_rc(tid * 16 + i * 8192, R, C); const int Rb = Epi::PERM ? ((R & ~31) + perm32(R & 31)) : R;
        voffA[i] = (unsigned)(R * g.ldaB + C * 2); voffB[i] = (unsigned)(Rb * g.ldbB + C * 2); }
    const size_t kstep = (size_t)(BK * 2);
    const size_t hstepA = (size_t)HALF * g.ldaB, hstepB = (size_t)HALF * g.ldbB;
    const unsigned ldsw = (unsigned)wid * 1024u;
    const int aoff = lds_byte(wr * 64 + fr, fq * 8), boff = lds_byte(wc * 32 + fr, fq * 8);
#define PG8_SA(b, h) (((b) * 2 + (h)) * HTB)
#define PG8_SB(b, h) ((4 + (b) * 2 + (h)) * HTB)
#define PG8_STAGE(bufoff, gbase, voff) do { _Pragma("unroll") for (int _i = 0; _i < 2; ++_i) \
        __builtin_amdgcn_global_load_lds((const unsigned*)((const char*)(gbase) + (voff)[_i]), (PG8_LAS unsigned*)(lds + (bufoff) + ldsw + _i * 8192), 16, 0, 0); } while (0)
#define PG8_STAGEB(bufoff, gbase, voff) do { _Pragma("unroll") for (int _i = 0; _i < 2; ++_i) \
        __builtin_amdgcn_global_load_lds((const unsigned*)((const char*)(gbase) + (voff)[_i]), (PG8_LAS unsigned*)(lds + (bufoff) + ldsw + _i * 8192), 16, 0, AUXB); } while (0)
#define PG8_LDA(dst, b, h) do { _Pragma("unroll") for (int m = 0; m < 4; ++m) _Pragma("unroll") for (int k = 0; k < 2; ++k) dst[m][k] = *(const PG8_LAS bf16x8*)(lds + PG8_SA(b, h) + aoff + m * 2048 + k * 1024); } while (0)
#define PG8_LDB(dst, b, h) do { _Pragma("unroll") for (int n = 0; n < 2; ++n) _Pragma("unroll") for (int k = 0; k < 2; ++k) dst[n][k] = *(const PG8_LAS bf16x8*)(lds + PG8_SB(b, h) + boff + n * 2048 + k * 1024); } while (0)
#define PG8_MMA(ai, bj, At, Bt) do { __builtin_amdgcn_s_setprio(1); _Pragma("unroll") for (int m = 0; m < 4; ++m) _Pragma("unroll") for (int n = 0; n < 2; ++n) { \
        if constexpr (FP8 == 1) { const i32x4 b0_ = __builtin_bit_cast(i32x4, Bt[n][0]), b1_ = __builtin_bit_cast(i32x4, Bt[n][1]), a0_ = __builtin_bit_cast(i32x4, At[m][0]), a1_ = __builtin_bit_cast(i32x4, At[m][1]); \
            const i32x8 B8_ = __builtin_shufflevector(b0_, b1_, 0, 1, 2, 3, 4, 5, 6, 7), A8_ = __builtin_shufflevector(a0_, a1_, 0, 1, 2, 3, 4, 5, 6, 7); \
            asm volatile("v_mfma_scale_f32_16x16x128_f8f6f4 %0, %1, %2, %0, %3, %3 op_sel:[0,1,0] op_sel_hi:[0,0,0]" : "+v"(acc[ai][bj][m][n]) : "v"(B8_), "v"(A8_), "v"(g.sc)); } \
        else if constexpr (FP8 == 2) { _Pragma("unroll") for (int k = 0; k < 2; ++k) acc[ai][bj][m][n] = __builtin_bit_cast(f32x4, __builtin_amdgcn_mfma_i32_16x16x64_i8(__builtin_bit_cast(i32x4, Bt[n][k]), __builtin_bit_cast(i32x4, At[m][k]), __builtin_bit_cast(i32x4, acc[ai][bj][m][n]), 0, 0, 0)); } \
        else { _Pragma("unroll") for (int k = 0; k < 2; ++k) acc[ai][bj][m][n] = __builtin_amdgcn_mfma_f32_16x16x32_bf16(Bt[n][k], At[m][k], acc[ai][bj][m][n], 0, 0, 0); } } \
        __builtin_amdgcn_s_setprio(0); } while (0)
#define PG8_WAIT_V(n) asm volatile("s_waitcnt vmcnt(" #n ")" ::: "memory")
#define PG8_WAIT_L(n) asm volatile("s_waitcnt lgkmcnt(" #n ")" ::: "memory")
#define PG8_BAR __builtin_amdgcn_s_barrier()
#define PG8_SCHED __builtin_amdgcn_sched_barrier(0)
    Unit cur, nxt; int ui = 0;
    if (!S.next(0, cur)) return;
    f32x4 acc[2][2][4][2];
#pragma unroll
    for (int a = 0; a < 2; ++a)
#pragma unroll
        for (int b = 0; b < 2; ++b)
#pragma unroll
            for (int m = 0; m < 4; ++m)
#pragma unroll
                for (int n = 0; n < 2; ++n) acc[a][b][m][n] = (f32x4){0.f, 0.f, 0.f, 0.f};
    bf16x8 At[4][2], B0[2][2], B1[2][2];
    const char* cA = cur.A; const char* cB = cur.B;
    S.a_ready(cur);
    if constexpr (SP2) {
        PG8_STAGEB(PG8_SB(0, 0), cB, voffB); PG8_STAGEB(PG8_SB(0, 1), cB + hstepB, voffB); PG8_STAGE(PG8_SA(0, 0), cA, voffA); PG8_STAGE(PG8_SA(0, 1), cA + hstepA, voffA);
        if (wr == 1) PG8_BAR;
        PG8_WAIT_V(2); PG8_BAR;
        PG8_STAGEB(PG8_SB(1, 0), cB + kstep, voffB); PG8_STAGE(PG8_SA(1, 0), cA + kstep, voffA); PG8_STAGEB(PG8_SB(1, 1), cB + hstepB + kstep, voffB);
        PG8_WAIT_V(6); PG8_BAR;
    } else {
        PG8_STAGEB(PG8_SB(0, 0), cB, voffB); PG8_STAGE(PG8_SA(0, 0), cA, voffA); PG8_STAGEB(PG8_SB(0, 1), cB + hstepB, voffB); PG8_STAGE(PG8_SA(0, 1), cA + hstepA, voffA);
        if (wr == 1) PG8_BAR;
        PG8_WAIT_V(4); PG8_BAR;
        PG8_STAGEB(PG8_SB(1, 0), cB + kstep, voffB); PG8_STAGE(PG8_SA(1, 0), cA + kstep, voffA); PG8_STAGEB(PG8_SB(1, 1), cB + hstepB + kstep, voffB);
        PG8_WAIT_V(6); PG8_BAR;
    }
    for (;;) {
        const bool has_next = S.next(ui + 1, nxt);
        const char* nA = has_next ? nxt.A : cA; const char* nB = has_next ? nxt.B : cB;
        for (int t = 0; t < nt; t += 2) {
            const bool last = (t == nt - 2);
            const char* a1 = cA + (size_t)(t + 1) * kstep;
            const char* a2 = last ? nA : cA + (size_t)(t + 2) * kstep; const char* b2 = last ? nB : cB + (size_t)(t + 2) * kstep;
            const char* a3 = a2 + kstep; const char* b3 = b2 + kstep;
            if (last && has_next) S.a_ready(nxt);
            if constexpr (SP2) {
            PG8_LDB(B0, 0, 0); PG8_LDB(B1, 0, 1); PG8_SCHED; PG8_LDA(At, 0, 0); PG8_STAGE(PG8_SA(1, 1), a1 + hstepA, voffA);
            PG8_WAIT_V(8); PG8_WAIT_L(0); PG8_BAR; PG8_MMA(0, 0, At, B0); PG8_MMA(0, 1, At, B1); PG8_BAR; PG8_SCHED;
            PG8_LDA(At, 0, 1); PG8_STAGEB(PG8_SB(0, 0), b2, voffB); PG8_STAGEB(PG8_SB(0, 1), b2 + hstepB, voffB); PG8_STAGE(PG8_SA(0, 0), a2, voffA);
            PG8_WAIT_V(8); PG8_WAIT_L(0); PG8_BAR; PG8_MMA(1, 0, At, B0); PG8_MMA(1, 1, At, B1); PG8_BAR; PG8_SCHED;
            PG8_LDB(B0, 1, 0); PG8_LDB(B1, 1, 1); PG8_SCHED; PG8_LDA(At, 1, 0); PG8_STAGE(PG8_SA(0, 1), a2 + hstepA, voffA);
            PG8_WAIT_V(8); PG8_WAIT_L(0); PG8_BAR; PG8_MMA(0, 0, At, B0); PG8_MMA(0, 1, At, B1); PG8_BAR; PG8_SCHED;
            PG8_LDA(At, 1, 1); PG8_STAGEB(PG8_SB(1, 0), b3, voffB); PG8_STAGEB(PG8_SB(1, 1), b3 + hstepB, voffB); PG8_STAGE(PG8_SA(1, 0), a3, voffA);
            PG8_WAIT_V(8); PG8_WAIT_L(0); PG8_BAR; PG8_MMA(1, 0, At, B0); PG8_MMA(1, 1, At, B1); PG8_BAR; PG8_SCHED;
            } else {
            PG8_LDB(B0, 0, 0); PG8_SCHED; PG8_LDA(At, 0, 0); PG8_STAGE(PG8_SA(1, 1), a1 + hstepA, voffA);
            PG8_WAIT_L(8); PG8_BAR; PG8_WAIT_L(0); PG8_MMA(0, 0, At, B0); PG8_BAR; PG8_SCHED;
            PG8_LDB(B1, 0, 1); PG8_STAGEB(PG8_SB(0, 0), b2, voffB);
            PG8_BAR; PG8_WAIT_L(0); PG8_MMA(0, 1, At, B1); PG8_BAR;
            PG8_LDA(At, 0, 1); PG8_STAGE(PG8_SA(0, 0), a2, voffA);
            PG8_BAR; PG8_WAIT_L(0); PG8_MMA(1, 0, At, B0); PG8_BAR; PG8_SCHED;
            PG8_STAGEB(PG8_SB(0, 1), b2 + hstepB, voffB);
            PG8_WAIT_V(6); PG8_BAR; PG8_MMA(1, 1, At, B1); PG8_BAR;
            PG8_LDB(B0, 1, 0); PG8_SCHED; PG8_LDA(At, 1, 0); PG8_STAGE(PG8_SA(0, 1), a2 + hstepA, voffA);
            PG8_WAIT_L(8); PG8_BAR; PG8_WAIT_L(0); PG8_MMA(0, 0, At, B0); PG8_BAR; PG8_SCHED;
            PG8_LDB(B1, 1, 1); PG8_STAGEB(PG8_SB(1, 0), b3, voffB);
            PG8_BAR; PG8_WAIT_L(0); PG8_MMA(0, 1, At, B1); PG8_BAR;
            PG8_LDA(At, 1, 1); PG8_STAGE(PG8_SA(1, 0), a3, voffA);
            PG8_BAR; PG8_WAIT_L(0); PG8_MMA(1, 0, At, B0); PG8_BAR; PG8_SCHED;
            PG8_STAGEB(PG8_SB(1, 1), b3 + hstepB, voffB);
            PG8_WAIT_V(6); PG8_BAR; PG8_MMA(1, 1, At, B1); PG8_BAR;
            }
        }
        if constexpr (ALIGN_EPI) { if (wr == 0) PG8_BAR; }
        if constexpr (FP8 == 1) asm volatile("s_nop 15\n\ts_nop 15\n\ts_nop 15" ::: "memory");
        if constexpr (!Epi::AFTER_DRAIN) { E(acc, cur, wr, wc); S.done(cur); }
        if (!has_next) break;
#pragma unroll
        for (int a = 0; a < 2; ++a)
#pragma unroll
            for (int b = 0; b < 2; ++b)
#pragma unroll
                for (int m = 0; m < 4; ++m)
#pragma unroll
                    for (int n = 0; n < 2; ++n) acc[a][b][m][n] = (f32x4){0.f, 0.f, 0.f, 0.f};
        cur = nxt; cA = nA; cB = nB; ++ui;
        if constexpr (ALIGN_EPI) { if (wr == 1) PG8_BAR; }
    }
    PG8_WAIT_V(0);
    if constexpr (!ALIGN_EPI) { if (wr == 0) PG8_BAR; }
    PG8_BAR;
    if constexpr (Epi::AFTER_DRAIN) { E.fused(acc, cur, wr, wc, fr, fq, lds, wid, lane); S.done(cur); }
#undef PG8_SA
#undef PG8_SB
#undef PG8_STAGE
#undef PG8_STAGEB
#undef PG8_LDA
#undef PG8_LDB
#undef PG8_MMA
#undef PG8_WAIT_V
#undef PG8_WAIT_L
#undef PG8_BAR
#undef PG8_SCHED
}

}

#ifndef MOE_FP8
#define MOE_FP8 1
#endif
#ifndef LN_FUSE
#define LN_FUSE 0
#endif
#ifndef MOE_AUX_UP
#define MOE_AUX_UP 0
#endif
#ifndef MOE_AUX_DN
#define MOE_AUX_DN 0
#endif
#ifndef FFN_FP8
#define FFN_FP8 0
#endif
#ifndef FFN_DN8
#define FFN_DN8 0
#endif
#define FFN_D8 (FFN_FP8 || FFN_DN8)
#ifndef F13_P1_N
#define F13_P1_N 0
#endif
#ifndef CMAX_LAST
#define CMAX_LAST 0
#endif
#ifndef POOL_I8
#define POOL_I8 0
#endif
#ifndef FFN_DN_I8
#define FFN_DN_I8 0
#endif
#ifndef LORA_I8
#define LORA_I8 0
#endif
#ifndef WO_I8
#define WO_I8 0
#endif
#ifndef RKV_I8
#define RKV_I8 0
#endif
#ifndef FFN_I8
#define FFN_I8 0
#endif
constexpr size_t MiB = 1u << 20;
constexpr size_t WS_CTL = 0, CTL_ZERO_BYTES = 1 * MiB;
constexpr size_t WS_MOD = 1 * MiB;
constexpr size_t WS_TOK = 2 * MiB;
constexpr size_t WS_SB  = 3 * MiB;
constexpr size_t WS_POS = 6 * MiB;
constexpr size_t WS_XR  = 22 * MiB;
constexpr size_t WS_W   = 86 * MiB;
constexpr size_t W_WR = WS_W, W_WK = W_WR + 8 * MiB, W_WV = W_WK + 8 * MiB, W_WO = W_WV + 8 * MiB;
constexpr size_t W_WLD = W_WO + 8 * MiB, W_ALD = W_WLD + 1 * MiB, W_G1 = W_ALD + 1 * MiB;
constexpr size_t W_WLU = W_G1 + 1 * MiB, W_ALU = W_WLU + 2 * MiB, W_G2 = W_ALU + 2 * MiB;
constexpr size_t W_PW = W_G2 + 1 * MiB;
constexpr size_t W_F13 = W_PW + 2 * MiB;
constexpr size_t W_F2 = W_F13 + 44 * MiB;
constexpr size_t W_M13 = W_F2 + 22 * MiB;
constexpr size_t W_M2 = W_M13 + 448 * MiB;
constexpr size_t WS_A = W_M2 + 224 * MiB;
constexpr size_t A_A6 = WS_A, A6_STRIDE = 36 * MiB;
constexpr size_t A_R = WS_A + 216 * MiB, A_KX = WS_A + 248 * MiB, A_V = WS_A + 284 * MiB;
constexpr size_t A_LW = WS_A + 320 * MiB, A_LA = WS_A + 325 * MiB, A_G1O = WS_A + 330 * MiB;
constexpr size_t A_EW = WS_A + 336 * MiB, A_AA = WS_A + 408 * MiB;
constexpr size_t A_GATE = WS_A + 480 * MiB, A_YD = WS_A + 512 * MiB;
constexpr size_t A_AO = WS_A + 580 * MiB, A_YO = WS_A + 612 * MiB;
constexpr int LDU = DFF + 64, LDF2 = DFF + 64, LDUG = MOE_FP8 ? DFE + 128 : DFE, LDM2 = MOE_FP8 ? DFE + 128 : DFE;
constexpr size_t A_H2 = WS_A, A_U = WS_A + 32 * MiB, A_YF = WS_A + 122 * MiB, A_HP = WS_A + 154 * MiB, A_PP = WS_A + 186 * MiB, A_YP = WS_A + 218 * MiB, A_H2B = WS_A + 250 * MiB;
constexpr size_t A_HG = WS_A + 282 * MiB, A_UG = WS_A + 354 * MiB, A_Y2 = WS_A + 606 * MiB;
constexpr size_t WS_PART = WS_A + 678 * MiB;
constexpr int MOE_KS = 7, MOE_RT = 64;
constexpr size_t W_F2P = WS_PART + 112 * MiB;
constexpr size_t WS_END = W_F2P + 23 * MiB;
static_assert(A_YO + 32 * MiB <= WS_PART && A_Y2 + (size_t)MROWS_PAD * D * 2 <= WS_PART && A_UG + (size_t)MROWS_PAD * LDUG * (MOE_FP8 ? 1 : 2) <= A_Y2 && A_HG + (size_t)MROWS_PAD * D * 2 <= A_UG && A_U + (size_t)ML * LDU * 2 <= A_YF && (size_t)D * LDF2 * 2 <= 23 * MiB && (size_t)NE * D * LDM2 * (MOE_FP8 ? 1 : 2) <= 224 * MiB, "ws map");
static_assert(W_M13 + (size_t)NE * 2 * DFE * D * 2 == W_M2 && W_M2 + (size_t)NE * D * DFE * 2 == WS_A && W_F13 + (size_t)2 * DFF * D * 2 == W_F2, "weight map");
constexpr int CW_BAR = 4096;
constexpr int CW_LN1 = 32768, CW_LN2 = 32768 + 64 * 32;
constexpr size_t WS_XB1 = 2 * MiB + 512 * 1024, WS_XB2 = 5 * MiB;
constexpr int CW_CMAX = 65536;
constexpr int CW_CMAX4 = 65536 + 2 * 5632 + 5 * 2048;
constexpr size_t WS_RSP = 5 * MiB + 896 * 1024;
constexpr int CW_CMAX3 = 65536 + 2 * 5632 + 4 * 2048;
constexpr size_t WS_RSU = 5 * MiB + 864 * 1024;
constexpr int CW_CMAX2 = 65536 + 2 * 5632;
constexpr size_t WS_CML = 5 * MiB + 832 * 1024;
constexpr size_t WS_RSO = 5 * MiB + 768 * 1024;
constexpr size_t WS_RS6 = 5 * MiB + 512 * 1024;
constexpr size_t WS_RS = 2 * MiB + 384 * 1024;
constexpr int CW_GCNT = 16384;

constexpr int LDS_BYTES = 147456;
constexpr int MISC_OFF = LDS_BYTES - 256;

#define XB_TMO      128
#define XB_XCNT(j)  (256  + 64 * (j))
#define XB_XSUB(j)  (1280 + 64 * (j))
#define XB_XGEN(j)  (2304 + 64 * (j))
#define XB_TOP      3328
#define XB_TOPGEN   3392
#define XCD_BAR_WORDS 3456
#define XB_SPIN_CAP (1u << 18)
__device__ __forceinline__ unsigned xb_ld(unsigned* p)              { return __hip_atomic_load(p, __ATOMIC_RELAXED, __HIP_MEMORY_SCOPE_AGENT); }
__device__ __forceinline__ unsigned xb_add(unsigned* p, unsigned v) { return __hip_atomic_fetch_add(p, v, __ATOMIC_RELAXED, __HIP_MEMORY_SCOPE_AGENT); }
__device__ __forceinline__ unsigned xb_xcc_id() { return (unsigned)__builtin_amdgcn_s_getreg((3 << 11) | 20) & 0xFu; }
#define XB_SPIN(cond, bar) do { unsigned _sp = 0; while (cond) { __builtin_amdgcn_s_sleep(1); \
    if ((++_sp & 255u) == 0u) { if (xb_ld(&(bar)[XB_TMO])) break; if (_sp > XB_SPIN_CAP) { atomicAdd(&(bar)[XB_TMO], 1u); break; } } } } while (0)
struct XcdBarrier { unsigned* bar; unsigned x; volatile LAS unsigned* st; };
__device__ __forceinline__ XcdBarrier xcd_barrier_post(unsigned* bar, volatile LAS unsigned* st) {
    XcdBarrier b; b.bar = bar; b.x = xb_xcc_id(); b.st = st;
    if (threadIdx.x == 0) (void)xb_add(&bar[XB_XCNT(b.x)], 1u);
    return b;
}
__device__ __forceinline__ void xcd_barrier_complete(unsigned* bar, unsigned x, unsigned& nloc, unsigned& nx) {
    const unsigned G = gridDim.x * gridDim.y * gridDim.z;
    unsigned sum, cnt, mine, sp = 0u;
    for (;;) {
        sum = 0u; cnt = 0u; mine = 0u;
#pragma unroll
        for (unsigned j = 0; j < 16; ++j) { const unsigned c = xb_ld(&bar[XB_XCNT(j)]); sum += c; cnt += (c > 0u) ? 1u : 0u; mine = (j == x) ? c : mine; }
        if (sum == G) break;
        __builtin_amdgcn_s_sleep(1);
        if ((++sp & 255u) == 0u) { if (xb_ld(&bar[XB_TMO])) break; if (sp > XB_SPIN_CAP) { atomicAdd(&bar[XB_TMO], 1u); break; } }
    }
    nloc = mine > 0u ? mine : 1u; nx = cnt > 0u ? cnt : 1u;
}
__device__ __forceinline__ void xcd_barrier(const XcdBarrier& b) {
    asm volatile("s_waitcnt vmcnt(0)" ::: "memory");
    __syncthreads();
    if (threadIdx.x == 0) {
        unsigned* bar = b.bar;
        __builtin_amdgcn_s_waitcnt(0);
        unsigned nloc = b.st[0], nx = b.st[1];
        if (nloc == 0u) { xcd_barrier_complete(bar, b.x, nloc, nx); b.st[0] = nloc; b.st[1] = nx; }
        const unsigned old = xb_add(&bar[XB_XSUB(b.x)], 1u);
        const unsigned gen = old / nloc;
        if (old + 1u == (gen + 1u) * nloc) {
            __builtin_amdgcn_fence(__ATOMIC_RELEASE, "agent");
            asm volatile("s_waitcnt vmcnt(0)" ::: "memory");
            const unsigned og = xb_add(&bar[XB_TOP], 1u);
            const unsigned tg = og / nx;
            if (og + 1u == (tg + 1u) * nx) xb_add(&bar[XB_TOPGEN], 1u);
            else XB_SPIN(xb_ld(&bar[XB_TOPGEN]) == tg, bar);
            __builtin_amdgcn_fence(__ATOMIC_ACQUIRE, "agent");
            xb_add(&bar[XB_XGEN(b.x)], 1u);
            asm volatile("s_waitcnt vmcnt(0)" ::: "memory");
        } else {
            XB_SPIN(xb_ld(&bar[XB_XGEN(b.x)]) == gen, bar);
            __builtin_amdgcn_fence(__ATOMIC_ACQUIRE, "agent");
            asm volatile("s_waitcnt vmcnt(0)" ::: "memory");
        }
    }
    __syncthreads();
}

struct Args { const float* in[35]; float* out; unsigned char* ws; int ph_lo, ph_hi, li, pad; };
static_assert(sizeof(Args) == 35 * 8 + 8 + 8 + 16, "Args has no padding");
enum In { I_X = 0, I_C, I_CTX, I_CCTX, I_WMOD, I_BMOD, I_LNW, I_LNB, I_MU, I_WR, I_WK, I_WV, I_WO, I_DW0, I_DW1, I_DW2, I_IA0, I_IA1, I_IA2, I_G1, I_G2, I_KK, I_KA, I_RK, I_GNW, I_GNB,
          I_POOLW, I_POOLS, I_FW1, I_FW3, I_FW2, I_ROUTER, I_MW1, I_MW3, I_MW2 };
struct Frame {
    LAS unsigned char* lds; int wave, vcu, G, gw, NGW;
    unsigned char* ws; unsigned* ctl;
};
#define LDS_WAIT() asm volatile("s_waitcnt lgkmcnt(0)" ::: "memory")
__device__ __forceinline__ void unpack8(const u32x4 w, float (&f)[8]) { f[0] = bflo(w.x); f[1] = bfhi(w.x); f[2] = bflo(w.y); f[3] = bfhi(w.y); f[4] = bflo(w.z); f[5] = bfhi(w.z); f[6] = bflo(w.w); f[7] = bfhi(w.w); }

__device__ __forceinline__ void p0_mod(const Frame& F, const Args& a) {
    const int lane = lane_id(), tid = F.wave * 64 + lane; (void)tid;
    LAS float* sc = (LAS float*)F.lds;
    LAS float* red = (LAS float*)(F.lds + 40960);
    const float* c = a.in[I_C]; const float* cc = a.in[I_CCTX];
    for (int i = tid; i < 5 * D; i += 512) { const int j = i / D, k = i % D; const float v = j < 4 ? c[j * D + k] : cc[k]; sc[i] = siluf_(v); }
    __syncthreads();
    float* MOD = (float*)(F.ws + WS_MOD);
    const int x = lane & 7, q = lane >> 3;
    for (int u = blockIdx.x; u < 2 * (MOD_N / 32); u += F.G) {
        const int l = u / (MOD_N / 32), cb = u % (MOD_N / 32);
        const float* W = a.in[I_WMOD] + (size_t)l * D * MOD_N + cb * 32 + 4 * x;
        float acc[5][4];
#pragma unroll
        for (int j = 0; j < 5; ++j)
#pragma unroll
            for (int e = 0; e < 4; ++e) acc[j][e] = 0.f;
#pragma unroll 8
        for (int i = 0; i < 32; ++i) {
            const int k = F.wave * 256 + 8 * i + q;
            const f32x4 w = __builtin_nontemporal_load((const f32x4*)(W + (size_t)k * MOD_N));
#pragma unroll
            for (int j = 0; j < 5; ++j) { const float s = sc[j * D + k];
#pragma unroll
                for (int e = 0; e < 4; ++e) acc[j][e] += s * w[e]; }
        }
#pragma unroll
        for (int j = 0; j < 5; ++j)
#pragma unroll
            for (int e = 0; e < 4; ++e) { float v = acc[j][e]; v += __shfl_xor(v, 8); v += __shfl_xor(v, 16); v += __shfl_xor(v, 32); acc[j][e] = v; }
        __syncthreads();
        if (q == 0) {
#pragma unroll
            for (int j = 0; j < 5; ++j)
#pragma unroll
                for (int e = 0; e < 4; ++e) red[(F.wave * 5 + j) * 32 + 4 * x + e] = acc[j][e];
        }
        __syncthreads();
        if (tid < 160) { const int j = tid / 32, col = tid % 32; float s = 0.f;
#pragma unroll
            for (int w = 0; w < 8; ++w) s += red[(w * 5 + j) * 32 + col];
            MOD[(size_t)(l * 5 + j) * MOD_N + cb * 32 + col] = s + a.in[I_BMOD][l * MOD_N + cb * 32 + col]; }
    }
    __syncthreads();
}
#ifndef MOD_V2
#define MOD_V2 0
#endif
constexpr int CW_MODCNT = 90112;
__device__ __forceinline__ void p0_mod2(const Frame& F, const Args& a) {
    const int lane = lane_id(), tid = F.wave * 64 + lane;
    LAS float* sc = (LAS float*)F.lds;
    LAS float* red = (LAS float*)(F.lds + 40960);
    LAS unsigned* flag = (LAS unsigned*)(F.lds + 40960 + 40960);
    const float* c = a.in[I_C]; const float* cc = a.in[I_CCTX];
    for (int i = tid; i < 5 * D; i += 512) { const int j = i / D, k = i % D; const float v = j < 4 ? c[j * D + k] : cc[k]; sc[i] = siluf_(v); }
    __syncthreads();
    float* MOD = (float*)(F.ws + WS_MOD); float* PARTM = (float*)(F.ws + WS_PART);
    for (int u = blockIdx.x; u < 768; u += F.G) {
        const int kp = u & 7, g = u >> 3, l = g / 48, cb = g % 48;
        const float* W = a.in[I_WMOD] + ((size_t)l * D + kp * 256 + F.wave * 32) * MOD_N + cb * 256 + 4 * lane;
        float acc[5][4];
#pragma unroll
        for (int j = 0; j < 5; ++j)
#pragma unroll
            for (int e = 0; e < 4; ++e) acc[j][e] = 0.f;
#pragma unroll 8
        for (int i = 0; i < 32; ++i) {
            const int k = kp * 256 + F.wave * 32 + i;
            const f32x4 w = __builtin_nontemporal_load((const f32x4*)(W + (size_t)i * MOD_N));
#pragma unroll
            for (int j = 0; j < 5; ++j) { const float s = sc[j * D + k];
#pragma unroll
                for (int e = 0; e < 4; ++e) acc[j][e] += s * w[e]; }
        }
        __syncthreads();
#pragma unroll
        for (int j = 0; j < 5; ++j) *(LAS f32x4*)(red + (F.wave * 5 + j) * 256 + 4 * lane) = (f32x4){acc[j][0], acc[j][1], acc[j][2], acc[j][3]};
        __syncthreads();
        for (int o = tid; o < 5 * 256; o += 512) { const int j = o >> 8, col = o & 255; float s = 0.f;
#pragma unroll
            for (int w = 0; w < 8; ++w) s += red[(w * 5 + j) * 256 + col];
            __hip_atomic_store(PARTM + ((size_t)(kp * 2 + l) * 5 + j) * MOD_N + cb * 256 + col, s, __ATOMIC_RELAXED, __HIP_MEMORY_SCOPE_AGENT); }
        asm volatile("s_waitcnt vmcnt(0)" ::: "memory");
        __syncthreads();
        if (tid == 0) { const unsigned old = __hip_atomic_fetch_add(F.ctl + CW_MODCNT + g, 1u, __ATOMIC_RELAXED, __HIP_MEMORY_SCOPE_AGENT); flag[0] = (old == 7u) ? 1u : 0u; }
        __syncthreads();
        if (flag[0]) {
            for (int o = tid; o < 5 * 256; o += 512) { const int j = o >> 8, col = o & 255; float s = a.in[I_BMOD][l * MOD_N + cb * 256 + col];
#pragma unroll
                for (int p = 0; p < 8; ++p) s += __hip_atomic_load(PARTM + ((size_t)(p * 2 + l) * 5 + j) * MOD_N + cb * 256 + col, __ATOMIC_RELAXED, __HIP_MEMORY_SCOPE_AGENT);
                MOD[(size_t)(l * 5 + j) * MOD_N + cb * 256 + col] = s; }
        }
    }
    __syncthreads();
}
__device__ __forceinline__ void p0_pos(const Frame& F) {
    const int lane = lane_id(), tid = F.wave * 64 + lane; (void)tid;
    float* POS = (float*)(F.ws + WS_POS);
    for (int t = F.gw; t < T; t += F.NGW) {
        const float frow = (float)(t >> 6), fcol = (float)(t & 63);
#pragma unroll
        for (int j = 0; j < 8; ++j) { const int c0 = 4 * lane + 256 * j; f32x4 o;
#pragma unroll
            for (int e = 0; e < 4; ++e) { const int c = c0 + e, qi = c >> 9, i = c & 511;
                const float omega = fexp(-(float)i * (9.21034037197618f / 512.0f));
                float rev = ((qi < 2) ? frow : fcol) * omega * 0.15915494309189535f;
                rev -= floorf(rev);
                o[e] = (qi & 1) ? __builtin_amdgcn_cosf(rev) : __builtin_amdgcn_sinf(rev); }
            *(f32x4*)(POS + (size_t)t * D + c0) = o; }
    }
}
constexpr int TN_F13 = (FFN_FP8 || FFN_I8) ? 1408 : 2816, TN_F2 = (FFN_D8 || FFN_DN_I8) ? 1408 : 2816, TN_M = MOE_FP8 ? 1792 : 3584;
constexpr int TN_RKV = RKV_I8 ? 512 : 1024, TI_RKV3 = 3 * TN_RKV;
constexpr int TI_RWKV = TI_RKV3 + (WO_I8 ? 512 : 1024), TI_F1 = TI_RWKV + TN_F13, TI_F3 = TI_F1 + TN_F13, TI_POOL = TI_F3 + (POOL_I8 ? 128 : 256), TI_M1 = TI_POOL + 8 * TN_M, TI_M3 = TI_M1 + 8 * TN_M, TI_MW2 = TI_M3 + 8 * TN_M, TI_M2 = TI_MW2 + TN_F2;
struct TrItem { const float* src; unsigned char* dst; int src_ld, dst_ld  , k0  , kbyte  , n0, drow0, f8  ; float sc; const unsigned* cm  ; };
__device__ __forceinline__ TrItem tr_decode(const Frame& F, const Args& a, int it) {
    TrItem t; t.f8 = 0; t.sc = 1.0f; t.cm = nullptr; int kb, nb;
    if (it < TI_RWKV) { const int m = it < TI_RKV3 ? it / TN_RKV : 3, r = it - (m < 3 ? m * TN_RKV : TI_RKV3); kb = r >> 5; nb = r & 31; const bool i8 = RKV_I8 && (m < 3 || WO_I8);
        t.src = a.in[I_WR + m]; t.src_ld = D; t.dst = F.ws + W_WR + (size_t)m * 8 * MiB; t.dst_ld = i8 ? D : 2 * D; t.drow0 = 64 * nb; if (i8) { t.f8 = 2; t.cm = F.ctl + CW_CMAX2 + m * D; } }
    else if (it < TI_F3) { const int w3 = it >= TI_F1, r = it - (w3 ? TI_F1 : TI_RWKV); kb = r / 88; nb = r % 88; const int n0 = 64 * nb;
        t.src = a.in[w3 ? I_FW3 : I_FW1]; t.src_ld = DFF; t.dst = F.ws + W_F13; t.dst_ld = (FFN_FP8 || FFN_I8) ? D : 2 * D; t.drow0 = (n0 >> 7) * 256 + (n0 & 127) + 128 * w3; t.f8 = FFN_I8 ? 2 : FFN_FP8; t.sc = FFN_FP8 ? 64.0f : 1.0f; if (FFN_I8) t.cm = F.ctl + CW_CMAX + w3 * DFF; }
    else if (it < TI_POOL) { const int r = it - TI_F3, g = POOL_I8 ? r >> 5 : r >> 6; kb = POOL_I8 ? (r >> 3) & 3 : (r >> 3) & 7; nb = r & 7;
        t.src = a.in[I_POOLW] + (size_t)g * 512 * 512; t.src_ld = 512; t.dst = F.ws + W_PW + (size_t)g * 512 * 512 * (POOL_I8 ? 1 : 2); t.dst_ld = POOL_I8 ? 512 : 2 * 512; t.drow0 = 64 * nb;
        if (POOL_I8) { t.f8 = 2; t.cm = F.ctl + CW_CMAX4 + g * 512; } }
    else if (it < TI_M3) { const int w3 = it >= TI_M1, r = it - (w3 ? TI_M1 : TI_POOL), e = r / TN_M, rr = r % TN_M; kb = rr / 112; nb = rr % 112; const int n0 = 64 * nb;
        t.src = a.in[w3 ? I_MW3 : I_MW1] + (size_t)e * D * DFE; t.src_ld = DFE; t.dst_ld = MOE_FP8 ? D : 2 * D; t.dst = F.ws + W_M13 + (size_t)e * 2 * DFE * t.dst_ld;
        t.drow0 = (n0 >> 7) * 256 + (n0 & 127) + 128 * w3; t.f8 = MOE_FP8; t.sc = MOE_FP8 ? 64.0f : 1.0f; }
    else if (it >= TI_MW2) { const int r = it - TI_MW2; kb = r >> 5; nb = r & 31;
        t.src = a.in[I_FW2]; t.src_ld = D; t.dst = F.ws + W_F2P; t.dst_ld = (FFN_D8 || FFN_DN_I8) ? LDF2 : 2 * LDF2; t.drow0 = 64 * nb; t.f8 = FFN_DN_I8 ? 2 : FFN_D8; t.sc = FFN_D8 ? 256.0f : 1.0f; if (FFN_DN_I8) t.cm = F.ctl + CW_CMAX3; }
    else { const int r = it - TI_M3, e = r / TN_M, rr = r % TN_M; kb = rr >> 5; nb = rr & 31;
        t.src = a.in[I_MW2] + (size_t)e * DFE * D; t.src_ld = D; t.dst_ld = MOE_FP8 ? LDM2 : 2 * LDM2; t.dst = F.ws + W_M2 + (size_t)e * D * t.dst_ld; t.drow0 = 64 * nb; t.f8 = MOE_FP8; t.sc = MOE_FP8 ? 256.0f : 1.0f; }
    t.n0 = 64 * nb; t.kbyte = 128 * kb; t.k0 = t.f8 ? 128 * kb : 64 * kb; return t;
}
__device__ __forceinline__ void tr_load(const TrItem& t, int h, f32x4 (&r)[4][4], int lane) {
    const int x = lane & 15, q = lane >> 4; const float* p = t.src + (size_t)(t.k0 + 64 * h + 4 * q) * t.src_ld + t.n0 + 4 * x;
#pragma unroll
    for (int i = 0; i < 4; ++i)
#pragma unroll
        for (int s = 0; s < 4; ++s) r[i][s] = __builtin_nontemporal_load((const f32x4*)(p + (size_t)(16 * i + s) * t.src_ld));
}
template <bool I8OK = false>
__device__ __forceinline__ void tr_store(const TrItem& t, int h, const f32x4 (&r)[4][4], LAS unsigned* scr, int lane) {
    const int x = lane & 15, q = lane >> 4;
    if (I8OK && t.f8 == 2) {
        const f32x4 cmx = __builtin_bit_cast(f32x4, *(const u32x4*)(t.cm + t.n0 + 4 * x)); f32x4 inv;
#pragma unroll
        for (int jj = 0; jj < 4; ++jj) inv[jj] = 127.0f * __builtin_amdgcn_rcpf(fmaxf(cmx[jj], 1e-30f));
#pragma unroll
        for (int i = 0; i < 4; ++i)
#pragma unroll
            for (int jj = 0; jj < 4; ++jj) scr[(4 * x + jj) * 33 + 16 * h + 4 * i + q] = pk4_i8(r[i][0][jj] * inv[jj], r[i][1][jj] * inv[jj], r[i][2][jj] * inv[jj], r[i][3][jj] * inv[jj]);
        if (h == 0) return;
    } else if (t.f8) {
#pragma unroll
        for (int i = 0; i < 4; ++i)
#pragma unroll
            for (int jj = 0; jj < 4; ++jj) scr[(4 * x + jj) * 33 + 16 * h + 4 * i + q] = pk4_fp8_nc(r[i][0][jj] * t.sc, r[i][1][jj] * t.sc, r[i][2][jj] * t.sc, r[i][3][jj] * t.sc);
        if (h == 0) return;
    } else {
#pragma unroll
        for (int i = 0; i < 4; ++i)
#pragma unroll
            for (int jj = 0; jj < 4; ++jj) { scr[(4 * x + jj) * 33 + 8 * i + 2 * q] = pk2(r[i][0][jj], r[i][1][jj]); scr[(4 * x + jj) * 33 + 8 * i + 2 * q + 1] = pk2(r[i][2][jj], r[i][3][jj]); }
    }
    LDS_WAIT();
    const int c = lane & 7;
#pragma unroll
    for (int rr = 0; rr < 8; ++rr) { const int n = (lane >> 3) + 8 * rr; const LAS unsigned* s = scr + n * 33 + 4 * c;
        u32x4 o; o.x = s[0]; o.y = s[1]; o.z = s[2]; o.w = s[3];
        *(u32x4*)(t.dst + (size_t)(t.drow0 + n) * t.dst_ld + t.kbyte + 16 * c) = o; }
    LDS_WAIT();
}
template <bool I8OK = false>
__device__ __forceinline__ void p0_transpose_range(const Frame& F, const Args& a, int lo, int hi, int gw, int ngw, LAS unsigned* scr) {
    const int lane = lane_id();
    int it = lo + gw; if (it >= hi) return;
    f32x4 ra[4][4], rb[4][4];
    TrItem ta = tr_decode(F, a, it), tb = ta; int ha = 0, hb = 0; tr_load(ta, 0, ra, lane);
    for (;;) {
        bool hasb; if (ta.f8 && ha == 0) { tb = ta; hb = 1; hasb = true; } else { it += ngw; hasb = it < hi; if (hasb) { tb = tr_decode(F, a, it); hb = 0; } }
        if (hasb) tr_load(tb, hb, rb, lane);
        tr_store<I8OK>(ta, ha, ra, scr, lane);
        if (!hasb) break;
        bool hasa; if (tb.f8 && hb == 0) { ta = tb; ha = 1; hasa = true; } else { it += ngw; hasa = it < hi; if (hasa) { ta = tr_decode(F, a, it); ha = 0; } }
        if (hasa) tr_load(ta, ha, ra, lane);
        tr_store<I8OK>(tb, hb, rb, scr, lane);
        if (!hasa) break;
    }
}
#if defined(PROBE_READ)
__device__ __forceinline__ void probe_read(const Frame& F, const Args& a) {
    const int lane = lane_id(); float acc = 0.f;
    for (int m = 0; m < 3; ++m) { const float* base = a.in[I_MW1 + m]; const size_t n16 = (size_t)NE * D * DFE / 4;
        if (PROBE_READ == 1) { for (size_t i = (size_t)F.gw * 64 + lane; i < n16; i += (size_t)F.NGW * 64 * 16) {
                f32x4 r[16];
#pragma unroll
                for (int u = 0; u < 16; ++u) { const size_t j = i + (size_t)u * F.NGW * 64; r[u] = j < n16 ? __builtin_nontemporal_load((const f32x4*)base + j) : (f32x4){0.f, 0.f, 0.f, 0.f}; }
#pragma unroll
                for (int u = 0; u < 16; ++u) acc += r[u][0] + r[u][3]; } }
        else { const int ld = (m == 2) ? D : DFE; const int nblk = ld / 64; const size_t rows = (size_t)NE * D * DFE / ld; const size_t items = rows / 64 * nblk; const int x = lane & 15, q = lane >> 4;
            for (size_t it = F.gw; it < items; it += F.NGW) { const size_t kb = it / nblk, nb = it % nblk; const float* p = base + (kb * 64 + 4 * q) * ld + nb * 64 + 4 * x;
                f32x4 r[16];
#pragma unroll
                for (int u = 0; u < 16; ++u) r[u] = __builtin_nontemporal_load((const f32x4*)(p + (size_t)((u >> 2) * 16 + (u & 3)) * ld));
#pragma unroll
                for (int u = 0; u < 16; ++u) acc += r[u][0] + r[u][3]; } }
    }
    if (acc == 1.2345e-30f) ((float*)(F.ws + WS_PART))[F.gw * 64 + lane] = acc;
}
#endif
__device__ __forceinline__ void p0_cmax(const Frame& F, const Args& a) {
    const int lane = lane_id();
    constexpr int NU_F = 2 * 22 * 32, NU_R = NU_F + (RKV_I8 ? (WO_I8 ? 4 : 3) * 8 * 32 : 0), NU_D = NU_R + (FFN_DN_I8 ? 8 * 88 : 0), NU = NU_D + (POOL_I8 ? 64 : 0);
    for (int u = F.gw; u < NU; u += F.NGW) {
        const float* src; unsigned* dst; int ld, cb, kc;
        if (u < NU_F) { const int mat = u / 704, r = u % 704; cb = r % 22; kc = r / 22; src = a.in[mat ? I_FW3 : I_FW1]; ld = DFF; dst = F.ctl + CW_CMAX + mat * DFF; }
        else if (u < NU_R) { const int v = u - NU_F, mat = v >> 8, r = v & 255; cb = r & 7; kc = r >> 3; src = a.in[I_WR + mat]; ld = D; dst = F.ctl + CW_CMAX2 + mat * D; }
        else if (u < NU_D) { const int r = u - NU_R; cb = r & 7; kc = r >> 3; src = a.in[I_FW2]; ld = D; dst = F.ctl + CW_CMAX3; }
        else { const int r = u - NU_D, g = r >> 4; cb = r & 1; kc = (r >> 1) & 7; src = a.in[I_POOLW] + (size_t)g * 512 * 512; ld = 512; dst = F.ctl + CW_CMAX4 + g * 512; }
        const float* p = src + (size_t)(kc * 64) * ld + cb * 256 + 4 * lane;
        u32x4 mx = (u32x4){0u, 0u, 0u, 0u};
#pragma unroll
        for (int b = 0; b < 4; ++b) { u32x4 v[16];
#pragma unroll
            for (int i = 0; i < 16; ++i) v[i] = *(const u32x4*)(p + (size_t)(b * 16 + i) * ld);
#pragma unroll
            for (int i = 0; i < 16; ++i) { const u32x4 w = v[i] & 0x7fffffffu; mx.x = w.x > mx.x ? w.x : mx.x; mx.y = w.y > mx.y ? w.y : mx.y; mx.z = w.z > mx.z ? w.z : mx.z; mx.w = w.w > mx.w ? w.w : mx.w; } }
        unsigned* c = dst + cb * 256 + 4 * lane;
        __hip_atomic_fetch_max(c + 0, mx.x, __ATOMIC_RELAXED, __HIP_MEMORY_SCOPE_AGENT); __hip_atomic_fetch_max(c + 1, mx.y, __ATOMIC_RELAXED, __HIP_MEMORY_SCOPE_AGENT);
        __hip_atomic_fetch_max(c + 2, mx.z, __ATOMIC_RELAXED, __HIP_MEMORY_SCOPE_AGENT); __hip_atomic_fetch_max(c + 3, mx.w, __ATOMIC_RELAXED, __HIP_MEMORY_SCOPE_AGENT);
    }
}
__device__ __forceinline__ void p0_small(const Frame& F, const Args& a) {
    const int lane = lane_id(), tid = F.wave * 64 + lane; (void)tid;
    bf16_t* WLD = (bf16_t*)(F.ws + W_WLD); bf16_t* ALD = (bf16_t*)(F.ws + W_ALD); bf16_t* G1T = (bf16_t*)(F.ws + W_G1);
    bf16_t* WLU = (bf16_t*)(F.ws + W_WLU); bf16_t* ALU = (bf16_t*)(F.ws + W_ALU); bf16_t* G2T = (bf16_t*)(F.ws + W_G2);
    const int gt = F.gw * 64 + lane, NT_ = F.NGW * 64;
    if (LORA_I8) {
        for (int task = (F.G == 256) ? (F.wave < 3 ? F.wave * 256 + F.vcu : 768) : F.gw; task < 768; task += (F.G == 256) ? 768 : F.NGW) { const int mat = task >> 8, n = task & 255; f32x4 v[8]; float mx = 0.f;
#pragma unroll
            for (int j = 0; j < 8; ++j)
#pragma unroll
                for (int e = 0; e < 4; ++e) { const int k = 4 * lane + 256 * j + e; float w = 0.f;
                    if (mat < 2) { if (n < 192) { const int d = n >= 96, nn = n - 96 * d; w = a.in[mat == 0 ? I_DW1 : I_IA1][((size_t)d * D + k) * 96 + nn]; } }
                    else w = a.in[I_G1][(size_t)k * 256 + n];
                    v[j][e] = w; mx = fmaxf(mx, fabsf(w)); }
            mx = wave_max(mx);
            mx = fmaxf(mx, 1e-30f); const float inv = 127.0f / mx;
            unsigned char* row = F.ws + (mat == 0 ? W_WLD : mat == 1 ? W_ALD : W_G1) + (size_t)n * D;
#pragma unroll
            for (int j = 0; j < 8; ++j) *(unsigned*)(row + 4 * lane + 256 * j) = pk4_i8(v[j][0] * inv, v[j][1] * inv, v[j][2] * inv, v[j][3] * inv);
            if (lane == 0) ((float*)(F.ws + WS_CML))[task] = mx; }
    } else
    for (int i = gt; i < 256 * D; i += NT_) { const int n = i >> 11, k = i & 2047;
        float w = 0.f, v = 0.f;
        if (n < 192) { const int d = n >= 96, nn = n - 96 * d; w = a.in[I_DW1][((size_t)d * D + k) * 96 + nn]; v = a.in[I_IA1][((size_t)d * D + k) * 96 + nn]; }
        WLD[i] = (bf16_t)f2bf(w); ALD[i] = (bf16_t)f2bf(v); G1T[i] = (bf16_t)f2bf(a.in[I_G1][(size_t)k * 256 + n]); }
    for (int i = gt; i < 2 * D * 256; i += NT_) { const int n = i >> 8, k = i & 255, d = n >> 11, cidx = n & 2047, kk = k - 96 * d;
        float w = 0.f, v = 0.f;
        if (kk >= 0 && kk < 96) { w = a.in[I_DW2][((size_t)d * 96 + kk) * D + cidx]; v = a.in[I_IA2][((size_t)d * 96 + kk) * D + cidx]; }
        WLU[i] = (bf16_t)f2bf(w); ALU[i] = (bf16_t)f2bf(v); }
    for (int i = gt; i < D * 256; i += NT_) { const int n = i >> 8, k = i & 255; G2T[i] = (bf16_t)f2bf(a.in[I_G2][(size_t)k * D + n]); }
}

__device__ __forceinline__ void p1_mix(const Frame& F, const Args& a) {
    const int lane = lane_id();
    const float* MOD = (const float*)(F.ws + WS_MOD); const float* POS = (const float*)(F.ws + WS_POS);
    float* XR = (float*)(F.ws + WS_XR);
    int par = 0; (void)par;
    for (int it = F.gw; it < (MT / 8) * 8; it += F.NGW) {
        const int blk = it >> 3, j = it & 7, m0 = blk * 8; const bool lat = m0 < ML;
        int t0, Tseq, modrow; const float* xs;
        if (lat) { t0 = m0 % T; Tseq = T; modrow = m0 / T; xs = a.in[I_X] + (size_t)m0 * D; }
        else { const int mm = m0 - ML; t0 = mm % TC; Tseq = TC; modrow = 4; xs = a.in[I_CTX] + (size_t)mm * D; }
        const float* sh = MOD + (size_t)modrow * MOD_N; const float* scp = sh + D;
        const float* ps = POS + (size_t)t0 * D;
        const int c = 4 * lane + 256 * j;
        f32x4 xr[10];
#pragma unroll
        for (int i = 0; i < 10; ++i) { const int tr = t0 - 1 + i; const bool ok = tr >= 0 && tr < Tseq; const int ro = ok ? i - 1 : 0;
            xr[i] = *(const f32x4*)(xs + (ptrdiff_t)ro * D + c); if (lat) xr[i] += *(const f32x4*)(ps + (ptrdiff_t)ro * D + c); }
        const f32x4 shv = *(const f32x4*)(sh + c); const f32x4 scv = *(const f32x4*)(scp + c) + 1.0f;
        f32x4 mu[6];
#pragma unroll
        for (int n = 0; n < 6; ++n) mu[n] = *(const f32x4*)(a.in[I_MU] + n * D + c);
        f32x4 h[10];
#pragma unroll
        for (int i = 0; i < 10; ++i) { const int tr = t0 - 1 + i; const bool ok = tr >= 0 && tr < Tseq; h[i] = ok ? xr[i] * scv + shv : (f32x4){0.f, 0.f, 0.f, 0.f}; }
        if (RKV_I8) {
            constexpr int NS = LORA_I8 ? 6 : 3;
            LAS float* PM = (LAS float*)F.lds + (par & 1) * 2048;
            LAS float* FIN = (LAS float*)F.lds + 4096 + F.wave * 64;
#ifndef P1_SHARED_SCALE
#define P1_SHARED_SCALE 0
#endif
            if (P1_SHARED_SCALE) {
#pragma unroll
            for (int r = 0; r < 8; ++r) { const f32x4 h0 = h[r + 1], xx = (h[r] + h[r + 2]) * 0.5f - h0; float mx = 0.f;
#pragma unroll
                for (int q = 0; q < NS; ++q) { const int n = LORA_I8 ? q : (q == 0 ? 0 : q + 1); if (!lat && (n == 0 || n == 5)) continue;
                    const f32x4 v = h0 + xx * mu[n]; mx = fmaxf(mx, fmaxf(fmaxf(fabsf(v[0]), fabsf(v[1])), fmaxf(fabsf(v[2]), fabsf(v[3])))); }
                mx = row_max16(mx);
                if ((lane & 15) == 0) PM[(F.wave * 4 + (lane >> 4)) * 64 + r] = mx; }
            __syncthreads();
            if (lane < 8) { float mx = PM[lane];
#pragma unroll
                for (int w = 1; w < 32; ++w) mx = fmaxf(mx, PM[w * 64 + lane]);
                mx = fmaxf(mx, 1e-30f); const float qf = 127.0f / mx;
#pragma unroll
                for (int q = 0; q < NS; ++q) { const int n = LORA_I8 ? q : (q == 0 ? 0 : q + 1); FIN[NS * lane + q] = qf;
                    if (j == 0 && (lat || (n != 0 && n != 5))) ((float*)(F.ws + WS_RS6))[(size_t)n * MT + m0 + lane] = mx * (1.0f / 127.0f); } }
            } else {
#pragma unroll
            for (int r = 0; r < 8; ++r) { const f32x4 h0 = h[r + 1], xx = (h[r] + h[r + 2]) * 0.5f - h0;
#pragma unroll
                for (int q = 0; q < NS; ++q) { const int n = LORA_I8 ? q : (q == 0 ? 0 : q + 1); const f32x4 v = h0 + xx * mu[n]; float mx = fmaxf(fmaxf(fabsf(v[0]), fabsf(v[1])), fmaxf(fabsf(v[2]), fabsf(v[3])));
                    mx = row_max16(mx);
                    if ((lane & 15) == 0) PM[(F.wave * 4 + (lane >> 4)) * 64 + NS * r + q] = mx; } }
            __syncthreads();
            if (lane < 8 * NS) { float mx = PM[lane];
#pragma unroll
                for (int w = 1; w < 32; ++w) mx = fmaxf(mx, PM[w * 64 + lane]);
                mx = fmaxf(mx, 1e-30f); FIN[lane] = 127.0f / mx;
                const int r = lane / NS, q = lane - NS * r, n = LORA_I8 ? q : (q == 0 ? 0 : q + 1);
                if (j == 0 && (lat || (n != 0 && n != 5))) ((float*)(F.ws + WS_RS6))[(size_t)n * MT + m0 + r] = mx * (1.0f / 127.0f); }
            }
            LDS_WAIT();
#pragma unroll
            for (int r = 0; r < 8; ++r) { const f32x4 h0 = h[r + 1], xx = (h[r] + h[r + 2]) * 0.5f - h0; const size_t o = (size_t)(m0 + r) * D + c;
#pragma unroll
                for (int q = 0; q < NS; ++q) { const int n = LORA_I8 ? q : (q == 0 ? 0 : q + 1); if (!lat && (n == 0 || n == 5)) continue;
                    const float inv = FIN[NS * r + q]; const f32x4 v = (h0 + xx * mu[n]) * inv;
                    *(unsigned*)(F.ws + A_A6 + (size_t)n * A6_STRIDE + o) = pk4_i8(v[0], v[1], v[2], v[3]); }
                if (!LORA_I8) {
#pragma unroll
                for (int n = 1; n < 6; ++n) { if (n == 2 || n == 3 || (!lat && n == 5)) continue;
                    const f32x4 v = h0 + xx * mu[n]; u32x2 w; w.x = pk2(v[0], v[1]); w.y = pk2(v[2], v[3]);
                    *(u32x2*)((bf16_t*)(F.ws + A_A6 + (size_t)n * A6_STRIDE) + o) = w; } } }
            ++par;
        } else {
#pragma unroll
        for (int r = 0; r < 8; ++r) {
            const f32x4 h0 = h[r + 1], xx = (h[r] + h[r + 2]) * 0.5f - h0;
            const size_t o = (size_t)(m0 + r) * D + c;
#pragma unroll
            for (int n = 0; n < 6; ++n) { if (!lat && (n == 0 || n == 5)) continue;
                const f32x4 v = h0 + xx * mu[n]; u32x2 w; w.x = pk2(v[0], v[1]); w.y = pk2(v[2], v[3]);
                *(u32x2*)((bf16_t*)(F.ws + A_A6 + (size_t)n * A6_STRIDE) + o) = w; }
        }
        }
    }
}

__device__ __forceinline__ void p4_scan(const Frame& F, const Args& a) {
    const int lane = lane_id(), tid = F.wave * 64 + lane; (void)tid;
    LAS float* OP = (LAS float*)F.lds;
    LAS float* YS = (LAS float*)(F.lds + 49152);
    const bf16_t* KX = (const bf16_t*)(F.ws + A_KX); const bf16_t* VV = (const bf16_t*)(F.ws + A_V); const bf16_t* RR = (const bf16_t*)(F.ws + A_R);
    const bf16_t* EW = (const bf16_t*)(F.ws + A_EW); const bf16_t* AA = (const bf16_t*)(F.ws + A_AA);
    const int tl = tid >> 5, cp = tid & 31, vi = tid >> 3, kg = tid & 7;
    for (int s = blockIdx.x; s < NB * NH * 2; s += F.G) {
        const int b = s >> 6, h = (s >> 1) & 31, d = s & 1;
        const int ch = h * HS + 2 * cp;
        const float kkc0 = a.in[I_KK][ch], kkc1 = a.in[I_KK][ch + 1], kac0 = a.in[I_KA][ch], kac1 = a.in[I_KA][ch + 1], rkc0 = a.in[I_RK][ch], rkc1 = a.in[I_RK][ch + 1];
        bf16_t* YD = (bf16_t*)(F.ws + A_YD + (size_t)d * 32 * MiB); float* SB = (float*)(F.ws + WS_SB) + (size_t)d * ML * NH;
        float S[8];
#pragma unroll
        for (int j = 0; j < 8; ++j) S[j] = 0.f;
        unsigned rk = 0, rv = 0, rr = 0, re = 0, ra = 0;
#define SCAN_ROW0(ci) (((ci) < 16) ? (ML + b * TC + (d ? 15 - (ci) : (ci)) * 16) : (b * T + (d ? 127 - ((ci) - 16) : ((ci) - 16)) * 16))
#define SCAN_LOAD(ci) do { const int row_ = SCAN_ROW0(ci) + tl; const size_t o_ = (size_t)row_ * D + ch, o2_ = (size_t)row_ * (2 * D) + d * D + ch; \
        rk = *(const unsigned*)(KX + o_); rv = *(const unsigned*)(VV + o_); rr = ((ci) >= 16) ? *(const unsigned*)(RR + o_) : 0u; re = *(const unsigned*)(EW + o2_); ra = *(const unsigned*)(AA + o2_); } while (0)
#define SCAN_PREP(ci) do { LAS float* B_ = OP + ((ci) & 1) * 6144 + tl * 64 + 2 * cp; \
        const float k0 = bflo(rk), k1 = bfhi(rk), q0 = k0 * kkc0, q1 = k1 * kkc1; float n2 = q0 * q0 + q1 * q1; \
        n2 += __shfl_xor(n2, 1); n2 += __shfl_xor(n2, 2); n2 += __shfl_xor(n2, 4); n2 += __shfl_xor(n2, 8); n2 += __shfl_xor(n2, 16); \
        const float inv = 1.0f / fmaxf(sqrtf(n2), 1e-12f), kn0 = q0 * inv, kn1 = q1 * inv; \
        const float a0 = bflo(ra), a1 = bfhi(ra), kd0 = k0 * (1.0f + (a0 - 1.0f) * kac0), kd1 = k1 * (1.0f + (a1 - 1.0f) * kac1); \
        const float r0 = bflo(rr), r1 = bfhi(rr); \
        *(LAS f32x2*)(B_ + 0 * 1024) = (f32x2){kn0, kn1}; \
        *(LAS f32x2*)(B_ + 1 * 1024) = (f32x2){fexp(-bflo(re)), fexp(-bfhi(re))}; \
        *(LAS f32x2*)(B_ + 2 * 1024) = (f32x2){kn0 * a0, kn1 * a1}; \
        *(LAS f32x2*)(B_ + 3 * 1024) = (f32x2){kd0, kd1}; \
        *(LAS f32x2*)(B_ + 4 * 1024) = (f32x2){r0, r1}; \
        *(LAS f32x2*)(B_ + 5 * 1024) = (f32x2){bflo(rv), bfhi(rv)}; \
        if ((ci) >= 16) { float sb = r0 * kd0 * rkc0 + r1 * kd1 * rkc1; \
            sb += __shfl_xor(sb, 1); sb += __shfl_xor(sb, 2); sb += __shfl_xor(sb, 4); sb += __shfl_xor(sb, 8); sb += __shfl_xor(sb, 16); \
            if (cp == 0) SB[(size_t)(SCAN_ROW0(ci) + tl) * NH + h] = sb; } } while (0)
        __syncthreads();
        SCAN_LOAD(0); SCAN_PREP(0);
        __syncthreads();
        for (int ci = 0; ci < 144; ++ci) {
            if (ci + 1 < 144) SCAN_LOAD(ci + 1);
            const LAS float* B = OP + (ci & 1) * 6144; LAS float* Y = YS + (ci & 1) * 1024;
#pragma unroll 4
            for (int st = 0; st < 16; ++st) {
                const int tk = d ? 15 - st : st; const LAS float* p = B + tk * 64 + 8 * kg;
                const f32x4 kkA = *(const LAS f32x4*)(p), kkB = *(const LAS f32x4*)(p + 4);
                const f32x4 wA = *(const LAS f32x4*)(p + 1024), wB = *(const LAS f32x4*)(p + 1028);
                const f32x4 bA = *(const LAS f32x4*)(p + 2048), bB = *(const LAS f32x4*)(p + 2052);
                const f32x4 dA = *(const LAS f32x4*)(p + 3072), dB = *(const LAS f32x4*)(p + 3076);
                const f32x4 rA = *(const LAS f32x4*)(p + 4096), rB = *(const LAS f32x4*)(p + 4100);
                const float v = B[5 * 1024 + tk * 64 + vi];
                float sa = (S[0] * kkA[0] + S[1] * kkA[1]) + (S[2] * kkA[2] + S[3] * kkA[3]) + (S[4] * kkB[0] + S[5] * kkB[1]) + (S[6] * kkB[2] + S[7] * kkB[3]);
                sa = sum8(sa);
#pragma unroll
                for (int j = 0; j < 4; ++j) { S[j] = S[j] * wA[j] + (v * dA[j] - sa * bA[j]); S[4 + j] = S[4 + j] * wB[j] + (v * dB[j] - sa * bB[j]); }
                float y = (S[0] * rA[0] + S[1] * rA[1]) + (S[2] * rA[2] + S[3] * rA[3]) + (S[4] * rB[0] + S[5] * rB[1]) + (S[6] * rB[2] + S[7] * rB[3]);
                y = sum8(y);
                if (kg == 0) Y[tk * 64 + vi] = y;
            }
            if (ci + 1 < 144) SCAN_PREP(ci + 1);
            __syncthreads();
            if (ci >= 16) { const f32x2 yv = *(const LAS f32x2*)(Y + tl * 64 + 2 * cp);
                *(unsigned*)(YD + (size_t)(SCAN_ROW0(ci) + tl) * D + ch) = pk2(yv.x, yv.y); }
        }
#undef SCAN_ROW0
#undef SCAN_LOAD
#undef SCAN_PREP
    }
    __syncthreads();
}

constexpr int SL_KA = 0, SL_RM = 2048, SL_BK = 4096, SL_VC = 8192, SL_ARK = 10240, SL_AAK = 11264, SL_TN = 11776, SL_GC = 12288, SL_BYTES = 12544;
constexpr int SC_PAR = 8 * SL_BYTES;
typedef short s16x8 __attribute__((ext_vector_type(8)));
__device__ __forceinline__ s16x8 mk8(unsigned a, unsigned b, unsigned c, unsigned d) { u32x4 v; v.x = a; v.y = b; v.z = c; v.w = d; return __builtin_bit_cast(s16x8, v); }
__device__ __forceinline__ f32x4 mfma16(s16x8 a, s16x8 b, f32x4 c) { return __builtin_amdgcn_mfma_f32_16x16x32_bf16(a, b, c, 0, 0, 0); }
__device__ __forceinline__ s16x8 mk_d(const f32x4 x) { return mk8(pk2(x[0], x[1]), pk2(x[2], x[3]), 0u, 0u); }
__device__ __forceinline__ void p4_scan2(const Frame& F, const Args& a, unsigned char* yd_base, float* sb_base) {
    const int lane = lane_id(), tt = lane & 15, q = lane >> 4;
    const bf16_t* KX = (const bf16_t*)(F.ws + A_KX); const bf16_t* VV = (const bf16_t*)(F.ws + A_V); const bf16_t* RR = (const bf16_t*)(F.ws + A_R);
    const bf16_t* EW = (const bf16_t*)(F.ws + A_EW); const bf16_t* AA = (const bf16_t*)(F.ws + A_AA);
    LAS unsigned char* slot_w = F.lds + F.wave * SL_BYTES;
    LAS float* PAR = (LAS float*)(F.lds + SC_PAR);
    s16x8 SelF[2];
#pragma unroll
    for (int sel = 0; sel < 2; ++sel) { unsigned w[4];
#pragma unroll
        for (int jj = 0; jj < 4; ++jj) { const int j0 = 2 * jj, j1 = 2 * jj + 1; const bool h0 = (q == (tt >> 2)) && (j0 == 4 * sel + (tt & 3)), h1 = (q == (tt >> 2)) && (j1 == 4 * sel + (tt & 3));
            w[jj] = (h0 ? 0x3f80u : 0u) | (h1 ? 0x3f800000u : 0u); }
        SelF[sel] = mk8(w[0], w[1], w[2], w[3]); }
    for (int s = blockIdx.x; s < NB * NH * 2; s += F.G) {
        const int b = s >> 6, h = (s >> 1) & 31, d = s & 1;
        bf16_t* YD = (bf16_t*)(yd_base + (size_t)d * 32 * MiB); float* SB = sb_base + (size_t)d * ML * NH;
        __syncthreads();
        if (F.wave == 0) { PAR[lane] = a.in[I_KK][h * HS + lane]; PAR[64 + lane] = a.in[I_KA][h * HS + lane]; PAR[128 + lane] = a.in[I_RK][h * HS + lane]; }
        __syncthreads();
        f32x4 G[4];
#pragma unroll
        for (int tk = 0; tk < 4; ++tk) G[tk] = (f32x4){0.f, 0.f, 0.f, 0.f};
#define S2_ROW0(ci) (((ci) < 16) ? (ML + b * TC + (d ? 15 - (ci) : (ci)) * 16) : (b * T + (d ? 127 - ((ci) - 16) : ((ci) - 16)) * 16))
        u32x2 rk[4], rv[4], rr[4], re[4], ra[4];
#define S2_LOAD(ci) do { const int row_ = S2_ROW0(ci) + (d ? 15 - tt : tt); const size_t o_ = (size_t)row_ * D + h * HS + 4 * q, o2_ = (size_t)row_ * (2 * D) + d * D + h * HS + 4 * q; \
        _Pragma("unroll") for (int g_ = 0; g_ < 4; ++g_) { rk[g_] = *(const u32x2*)(KX + o_ + 16 * g_); rv[g_] = *(const u32x2*)(VV + o_ + 16 * g_); \
            rr[g_] = ((ci) >= 16) ? *(const u32x2*)(RR + o_ + 16 * g_) : (u32x2){0u, 0u}; re[g_] = *(const u32x2*)(EW + o2_ + 16 * g_); ra[g_] = *(const u32x2*)(AA + o2_ + 16 * g_); } } while (0)
        S2_LOAD(F.wave);
        for (int rnd = 0; rnd < 18; ++rnd) {
            const int ci = rnd * 8 + F.wave; const bool lat = rnd >= 2;
            {
                float kf[4][4], af[4][4], ef[4][4], vf[4][4], rf[4][4];
#pragma unroll
                for (int g = 0; g < 4; ++g) {
                    kf[g][0] = bflo(rk[g].x); kf[g][1] = bfhi(rk[g].x); kf[g][2] = bflo(rk[g].y); kf[g][3] = bfhi(rk[g].y);
                    af[g][0] = bflo(ra[g].x); af[g][1] = bfhi(ra[g].x); af[g][2] = bflo(ra[g].y); af[g][3] = bfhi(ra[g].y);
                    ef[g][0] = bflo(re[g].x); ef[g][1] = bfhi(re[g].x); ef[g][2] = bflo(re[g].y); ef[g][3] = bfhi(re[g].y);
                    vf[g][0] = bflo(rv[g].x); vf[g][1] = bfhi(rv[g].x); vf[g][2] = bflo(rv[g].y); vf[g][3] = bfhi(rv[g].y);
                    rf[g][0] = bflo(rr[g].x); rf[g][1] = bfhi(rr[g].x); rf[g][2] = bflo(rr[g].y); rf[g][3] = bfhi(rr[g].y); }
                unsigned VP[4][2];
#pragma unroll
                for (int g = 0; g < 4; ++g) { VP[g][0] = rv[g].x; VP[g][1] = rv[g].y; }
                if (rnd + 1 < 18) S2_LOAD((rnd + 1) * 8 + F.wave);
                float kkv[4][4]; float n2 = 0.f;
#pragma unroll
                for (int g = 0; g < 4; ++g) { const f32x4 kc = *(const LAS f32x4*)(PAR + 16 * g + 4 * q);
#pragma unroll
                    for (int i = 0; i < 4; ++i) { kkv[g][i] = kf[g][i] * kc[i]; n2 += kkv[g][i] * kkv[g][i]; } }
                n2 += __shfl_xor(n2, 16); n2 += __shfl_xor(n2, 32);
                const float inv = 1.0f / fmaxf(sqrtf(n2), 1e-12f);
                float sb = 0.f;
                unsigned KaP[4][2], BmP[4][2], KmP[4][2], RmP[4][2]; f32x4 gend[4];
#pragma unroll
                for (int g = 0; g < 4; ++g) { const f32x4 kac = *(const LAS f32x4*)(PAR + 64 + 16 * g + 4 * q), rkc = *(const LAS f32x4*)(PAR + 128 + 16 * g + 4 * q);
                    float ka_[4], bm_[4], km_[4], rm_[4];
#pragma unroll
                    for (int i = 0; i < 4; ++i) {
                        float L = ef[g][i];
                        L += dpp_f<0x111>(L); L += dpp_f<0x112>(L); L += dpp_f<0x114>(L); L += dpp_f<0x118>(L);
                        const float gt = fexp(-L), gi = fexp(L); float gm1 = dpp_f<0x111>(gt); gm1 = (tt == 0) ? 1.0f : gm1;
                        const float kk = kkv[g][i] * inv, kd = kf[g][i] * (1.0f + (af[g][i] - 1.0f) * kac[i]);
                        ka_[i] = kk * gm1; bm_[i] = kk * af[g][i] * gi; km_[i] = kd * gi; rm_[i] = rf[g][i] * gt;
                        sb += rf[g][i] * kd * rkc[i]; gend[g][i] = gt; }
                    KaP[g][0] = pk2(ka_[0], ka_[1]); KaP[g][1] = pk2(ka_[2], ka_[3]); BmP[g][0] = pk2(bm_[0], bm_[1]); BmP[g][1] = pk2(bm_[2], bm_[3]);
                    KmP[g][0] = pk2(km_[0], km_[1]); KmP[g][1] = pk2(km_[2], km_[3]); RmP[g][0] = pk2(rm_[0], rm_[1]); RmP[g][1] = pk2(rm_[2], rm_[3]);
                }
                if (lat) { sb += __shfl_xor(sb, 16); sb += __shfl_xor(sb, 32); if (q == 0) SB[(size_t)(S2_ROW0(ci) + (d ? 15 - tt : tt)) * NH + h] = sb; }
                s16x8 KaF[2], BmF[2], KmF[2], RmF[2], VF[2];
#pragma unroll
                for (int kb = 0; kb < 2; ++kb) { KaF[kb] = mk8(KaP[2 * kb][0], KaP[2 * kb][1], KaP[2 * kb + 1][0], KaP[2 * kb + 1][1]); BmF[kb] = mk8(BmP[2 * kb][0], BmP[2 * kb][1], BmP[2 * kb + 1][0], BmP[2 * kb + 1][1]);
                    KmF[kb] = mk8(KmP[2 * kb][0], KmP[2 * kb][1], KmP[2 * kb + 1][0], KmP[2 * kb + 1][1]); RmF[kb] = mk8(RmP[2 * kb][0], RmP[2 * kb][1], RmP[2 * kb + 1][0], RmP[2 * kb + 1][1]);
                    VF[kb] = mk8(VP[2 * kb][0], VP[2 * kb][1], VP[2 * kb + 1][0], VP[2 * kb + 1][1]); }
                const f32x4 Z = (f32x4){0.f, 0.f, 0.f, 0.f};
                f32x4 Nd = mfma16(KaF[1], BmF[1], mfma16(KaF[0], BmF[0], Z));
                f32x4 Nt = mfma16(BmF[1], KaF[1], mfma16(BmF[0], KaF[0], Z));
                f32x4 AakT = mfma16(KmF[1], KaF[1], mfma16(KmF[0], KaF[0], Z));
                f32x4 ArbT = mfma16(BmF[1], RmF[1], mfma16(BmF[0], RmF[0], Z));
                f32x4 ArkT = mfma16(KmF[1], RmF[1], mfma16(KmF[0], RmF[0], Z));
                f32x4 Q0;
#pragma unroll
                for (int r = 0; r < 4; ++r) { const int row = 4 * q + r;
                    Nd[r] = row > tt ? Nd[r] : 0.f; Nt[r] = row < tt ? Nt[r] : 0.f; AakT[r] = row < tt ? AakT[r] : 0.f; ArbT[r] = row <= tt ? ArbT[r] : 0.f; ArkT[r] = row <= tt ? ArkT[r] : 0.f;
                    Q0[r] = (row == tt ? 1.0f : 0.f) - Nt[r]; }
                const s16x8 oN = mk_d(Nd), oNt = mk_d(Nt);
                const f32x4 N2 = mfma16(oNt, oN, Z), N2t = mfma16(oN, oNt, Z);
                const s16x8 oN2 = mk_d(N2), oN2t = mk_d(N2t);
                const f32x4 N4 = mfma16(oN2t, oN2, Z), N4t = mfma16(oN2, oN2t, Z);
                const s16x8 oN4 = mk_d(N4), oN4t = mk_d(N4t);
                const f32x4 N8 = mfma16(oN4t, oN4, Z);
                const f32x4 Q1 = mfma16(oN2, mk_d(Q0), Q0);
                const f32x4 Q2 = mfma16(oN4, mk_d(Q1), Q1);
                const f32x4 Q3 = mfma16(mk_d(N8), mk_d(Q2), Q2);
                *(LAS u32x4*)(slot_w + SL_KA + lane * 16) = __builtin_bit_cast(u32x4, KaF[0]); *(LAS u32x4*)(slot_w + SL_KA + 1024 + lane * 16) = __builtin_bit_cast(u32x4, KaF[1]);
                *(LAS u32x4*)(slot_w + SL_RM + lane * 16) = __builtin_bit_cast(u32x4, RmF[0]); *(LAS u32x4*)(slot_w + SL_RM + 1024 + lane * 16) = __builtin_bit_cast(u32x4, RmF[1]);
                *(LAS u32x2*)(slot_w + SL_TN + lane * 8) = (u32x2){pk2(-Q3[0], -Q3[1]), pk2(-Q3[2], -Q3[3])};
                *(LAS u32x2*)(slot_w + SL_AAK + lane * 8) = (u32x2){pk2(AakT[0], AakT[1]), pk2(AakT[2], AakT[3])};
                *(LAS u32x4*)(slot_w + SL_ARK + lane * 16) = (u32x4){pk2(ArbT[0], ArbT[1]), pk2(ArbT[2], ArbT[3]), pk2(ArkT[0], ArkT[1]), pk2(ArkT[2], ArkT[3])};
#pragma unroll
                for (int kb = 0; kb < 2; ++kb)
#pragma unroll
                    for (int sel = 0; sel < 2; ++sel) { const int tk = 2 * kb + sel;
                        const f32x4 DB = mfma16(BmF[kb], SelF[sel], Z), DK = mfma16(KmF[kb], SelF[sel], Z), DV = mfma16(VF[kb], SelF[sel], Z);
                        *(LAS u32x4*)(slot_w + SL_BK + tk * 1024 + lane * 16) = (u32x4){pk2(DB[0], DB[1]), pk2(DB[2], DB[3]), pk2(DK[0], DK[1]), pk2(DK[2], DK[3])};
                        *(LAS u32x2*)(slot_w + SL_VC + tk * 512 + lane * 8) = (u32x2){pk2(DV[0], DV[1]), pk2(DV[2], DV[3])}; }
                if (tt == 15) {
#pragma unroll
                    for (int g = 0; g < 4; ++g) *(LAS f32x4*)(slot_w + SL_GC + (g * 4 + q) * 16) = gend[g]; }
            }
            __syncthreads();
            if (F.wave < 4) {
                const int tv = F.wave;
                for (int sl = 0; sl < 8; ++sl) {
                    LAS unsigned char* S = F.lds + sl * SL_BYTES; const int cj = rnd * 8 + sl;
                    const s16x8 KA0 = __builtin_bit_cast(s16x8, *(LAS u32x4*)(S + SL_KA + lane * 16)), KA1 = __builtin_bit_cast(s16x8, *(LAS u32x4*)(S + SL_KA + 1024 + lane * 16));
                    const u32x2 aak = *(LAS u32x2*)(S + SL_AAK + lane * 8), tn = *(LAS u32x2*)(S + SL_TN + lane * 8), vc = *(LAS u32x2*)(S + SL_VC + tv * 512 + lane * 8);
                    const s16x8 Gb0 = mk8(pk2(G[0][0], G[0][1]), pk2(G[0][2], G[0][3]), pk2(G[1][0], G[1][1]), pk2(G[1][2], G[1][3]));
                    const s16x8 Gb1 = mk8(pk2(G[2][0], G[2][1]), pk2(G[2][2], G[2][3]), pk2(G[3][0], G[3][1]), pk2(G[3][2], G[3][3]));
                    const f32x4 Z = (f32x4){0.f, 0.f, 0.f, 0.f};
                    f32x4 P = mfma16(KA0, Gb0, Z); P = mfma16(KA1, Gb1, P); P = mfma16(mk8(aak.x, aak.y, 0u, 0u), mk8(vc.x, vc.y, 0u, 0u), P);
                    const f32x4 U = mfma16(mk8(tn.x, tn.y, 0u, 0u), mk_d(P), Z);
                    const s16x8 UV = mk8(pk2(U[0], U[1]), pk2(U[2], U[3]), vc.x, vc.y);
                    if (lat) {
                        const s16x8 RM0 = __builtin_bit_cast(s16x8, *(LAS u32x4*)(S + SL_RM + lane * 16)), RM1 = __builtin_bit_cast(s16x8, *(LAS u32x4*)(S + SL_RM + 1024 + lane * 16));
                        const s16x8 ARK = __builtin_bit_cast(s16x8, *(LAS u32x4*)(S + SL_ARK + lane * 16));
                        f32x4 Y = mfma16(Gb0, RM0, Z); Y = mfma16(Gb1, RM1, Y); Y = mfma16(UV, ARK, Y);
                        *(u32x2*)(YD + (size_t)(S2_ROW0(cj) + (d ? 15 - tt : tt)) * D + h * HS + 16 * tv + 4 * q) = (u32x2){pk2(Y[0], Y[1]), pk2(Y[2], Y[3])};
                    }
#pragma unroll
                    for (int tk = 0; tk < 4; ++tk) { const s16x8 BK = __builtin_bit_cast(s16x8, *(LAS u32x4*)(S + SL_BK + tk * 1024 + lane * 16));
                        G[tk] = mfma16(BK, UV, G[tk]); G[tk] = G[tk] * *(LAS f32x4*)(S + SL_GC + (tk * 4 + q) * 16); }
                }
            }
            __syncthreads();
        }
#undef S2_ROW0
#undef S2_LOAD
    }
    __syncthreads();
}

__device__ __forceinline__ void p4_scan3(const Frame& F, const Args& a, unsigned char* yd_base, float* sb_base, int clo, int chi) {
    const int lane = lane_id(), tt = lane & 15, q = lane >> 4;
    const bf16_t* KX = (const bf16_t*)(F.ws + A_KX); const bf16_t* VV = (const bf16_t*)(F.ws + A_V); const bf16_t* RR = (const bf16_t*)(F.ws + A_R);
    const bf16_t* EW = (const bf16_t*)(F.ws + A_EW); const bf16_t* AA = (const bf16_t*)(F.ws + A_AA);
    LAS float* PAR = (LAS float*)(F.lds + SC_PAR);
    LAS unsigned* CNT = (LAS unsigned*)(F.lds + SC_PAR + 1024);
    s16x8 SelF[2];
#pragma unroll
    for (int sel = 0; sel < 2; ++sel) { unsigned w[4];
#pragma unroll
        for (int jj = 0; jj < 4; ++jj) { const int j0 = 2 * jj, j1 = 2 * jj + 1; const bool h0 = (q == (tt >> 2)) && (j0 == 4 * sel + (tt & 3)), h1 = (q == (tt >> 2)) && (j1 == 4 * sel + (tt & 3));
            w[jj] = (h0 ? 0x3f80u : 0u) | (h1 ? 0x3f800000u : 0u); }
        SelF[sel] = mk8(w[0], w[1], w[2], w[3]); }
    { const int s = blockIdx.x;
        const int b = s >> 6, h = (s >> 1) & 31, d = s & 1;
        bf16_t* YD = (bf16_t*)(yd_base + (size_t)d * 32 * MiB); float* SB = sb_base + (size_t)d * ML * NH;
        __syncthreads();
        if (F.wave == 0) { PAR[lane] = a.in[I_KK][h * HS + lane]; PAR[64 + lane] = a.in[I_KA][h * HS + lane]; PAR[128 + lane] = a.in[I_RK][h * HS + lane]; if (lane == 0) CNT[0] = 0u; }
        __syncthreads();
        if (F.wave >= 4) { p0_transpose_range(F, a, clo, chi, (int)blockIdx.x * 4 + (F.wave - 4), 4 * 256, (LAS unsigned*)(F.lds + 102400 + (F.wave - 4) * 8448)); }
        else {
        f32x4 G[4];
#pragma unroll
        for (int tk = 0; tk < 4; ++tk) G[tk] = (f32x4){0.f, 0.f, 0.f, 0.f};
#define S2_ROW0(ci) (((ci) < 16) ? (ML + b * TC + (d ? 15 - (ci) : (ci)) * 16) : (b * T + (d ? 127 - ((ci) - 16) : ((ci) - 16)) * 16))
        u32x2 rk[4], rv[4], rr[4], re[4], ra[4];
#define S2_LOAD(ci) do { const int row_ = S2_ROW0(ci) + (d ? 15 - tt : tt); const size_t o_ = (size_t)row_ * D + h * HS + 4 * q, o2_ = (size_t)row_ * (2 * D) + d * D + h * HS + 4 * q; \
        _Pragma("unroll") for (int g_ = 0; g_ < 4; ++g_) { rk[g_] = *(const u32x2*)(KX + o_ + 16 * g_); rv[g_] = *(const u32x2*)(VV + o_ + 16 * g_); \
            rr[g_] = ((ci) >= 16) ? *(const u32x2*)(RR + o_ + 16 * g_) : (u32x2){0u, 0u}; re[g_] = *(const u32x2*)(EW + o2_ + 16 * g_); ra[g_] = *(const u32x2*)(AA + o2_ + 16 * g_); } } while (0)
        S2_LOAD(F.wave);
        for (int rnd = 0; rnd < 36; ++rnd) {
            const int ci = rnd * 4 + F.wave; const bool lat = rnd >= 4;
            LAS unsigned char* slot_w = F.lds + ((rnd & 1) * 4 + F.wave) * SL_BYTES;
            {
                float kf[4][4], af[4][4], ef[4][4], vf[4][4], rf[4][4];
#pragma unroll
                for (int g = 0; g < 4; ++g) {
                    kf[g][0] = bflo(rk[g].x); kf[g][1] = bfhi(rk[g].x); kf[g][2] = bflo(rk[g].y); kf[g][3] = bfhi(rk[g].y);
                    af[g][0] = bflo(ra[g].x); af[g][1] = bfhi(ra[g].x); af[g][2] = bflo(ra[g].y); af[g][3] = bfhi(ra[g].y);
                    ef[g][0] = bflo(re[g].x); ef[g][1] = bfhi(re[g].x); ef[g][2] = bflo(re[g].y); ef[g][3] = bfhi(re[g].y);
                    vf[g][0] = bflo(rv[g].x); vf[g][1] = bfhi(rv[g].x); vf[g][2] = bflo(rv[g].y); vf[g][3] = bfhi(rv[g].y);
                    rf[g][0] = bflo(rr[g].x); rf[g][1] = bfhi(rr[g].x); rf[g][2] = bflo(rr[g].y); rf[g][3] = bfhi(rr[g].y); }
                unsigned VP[4][2];
#pragma unroll
                for (int g = 0; g < 4; ++g) { VP[g][0] = rv[g].x; VP[g][1] = rv[g].y; }
                if (rnd + 1 < 36) S2_LOAD((rnd + 1) * 4 + F.wave);
                float kkv[4][4]; float n2 = 0.f;
#pragma unroll
                for (int g = 0; g < 4; ++g) { const f32x4 kc = *(const LAS f32x4*)(PAR + 16 * g + 4 * q);
#pragma unroll
                    for (int i = 0; i < 4; ++i) { kkv[g][i] = kf[g][i] * kc[i]; n2 += kkv[g][i] * kkv[g][i]; } }
                n2 += __shfl_xor(n2, 16); n2 += __shfl_xor(n2, 32);
                const float inv = 1.0f / fmaxf(sqrtf(n2), 1e-12f);
                float sb = 0.f;
                unsigned KaP[4][2], BmP[4][2], KmP[4][2], RmP[4][2]; f32x4 gend[4];
#pragma unroll
                for (int g = 0; g < 4; ++g) { const f32x4 kac = *(const LAS f32x4*)(PAR + 64 + 16 * g + 4 * q), rkc = *(const LAS f32x4*)(PAR + 128 + 16 * g + 4 * q);
                    float ka_[4], bm_[4], km_[4], rm_[4];
#pragma unroll
                    for (int i = 0; i < 4; ++i) {
                        float L = ef[g][i];
                        L += dpp_f<0x111>(L); L += dpp_f<0x112>(L); L += dpp_f<0x114>(L); L += dpp_f<0x118>(L);
                        const float gt = fexp(-L), gi = fexp(L); float gm1 = dpp_f<0x111>(gt); gm1 = (tt == 0) ? 1.0f : gm1;
                        const float kk = kkv[g][i] * inv, kd = kf[g][i] * (1.0f + (af[g][i] - 1.0f) * kac[i]);
                        ka_[i] = kk * gm1; bm_[i] = kk * af[g][i] * gi; km_[i] = kd * gi; rm_[i] = rf[g][i] * gt;
                        sb += rf[g][i] * kd * rkc[i]; gend[g][i] = gt; }
                    KaP[g][0] = pk2(ka_[0], ka_[1]); KaP[g][1] = pk2(ka_[2], ka_[3]); BmP[g][0] = pk2(bm_[0], bm_[1]); BmP[g][1] = pk2(bm_[2], bm_[3]);
                    KmP[g][0] = pk2(km_[0], km_[1]); KmP[g][1] = pk2(km_[2], km_[3]); RmP[g][0] = pk2(rm_[0], rm_[1]); RmP[g][1] = pk2(rm_[2], rm_[3]);
                }
                if (lat) { sb += __shfl_xor(sb, 16); sb += __shfl_xor(sb, 32); if (q == 0) SB[(size_t)(S2_ROW0(ci) + (d ? 15 - tt : tt)) * NH + h] = sb; }
                s16x8 KaF[2], BmF[2], KmF[2], RmF[2], VF[2];
#pragma unroll
                for (int kb = 0; kb < 2; ++kb) { KaF[kb] = mk8(KaP[2 * kb][0], KaP[2 * kb][1], KaP[2 * kb + 1][0], KaP[2 * kb + 1][1]); BmF[kb] = mk8(BmP[2 * kb][0], BmP[2 * kb][1], BmP[2 * kb + 1][0], BmP[2 * kb + 1][1]);
                    KmF[kb] = mk8(KmP[2 * kb][0], KmP[2 * kb][1], KmP[2 * kb + 1][0], KmP[2 * kb + 1][1]); RmF[kb] = mk8(RmP[2 * kb][0], RmP[2 * kb][1], RmP[2 * kb + 1][0], RmP[2 * kb + 1][1]);
                    VF[kb] = mk8(VP[2 * kb][0], VP[2 * kb][1], VP[2 * kb + 1][0], VP[2 * kb + 1][1]); }
                const f32x4 Z = (f32x4){0.f, 0.f, 0.f, 0.f};
                f32x4 Nd = mfma16(KaF[1], BmF[1], mfma16(KaF[0], BmF[0], Z));
                f32x4 Nt = mfma16(BmF[1], KaF[1], mfma16(BmF[0], KaF[0], Z));
                f32x4 AakT = mfma16(KmF[1], KaF[1], mfma16(KmF[0], KaF[0], Z));
                f32x4 ArbT = mfma16(BmF[1], RmF[1], mfma16(BmF[0], RmF[0], Z));
                f32x4 ArkT = mfma16(KmF[1], RmF[1], mfma16(KmF[0], RmF[0], Z));
                f32x4 Q0;
#pragma unroll
                for (int r = 0; r < 4; ++r) { const int row = 4 * q + r;
                    Nd[r] = row > tt ? Nd[r] : 0.f; Nt[r] = row < tt ? Nt[r] : 0.f; AakT[r] = row < tt ? AakT[r] : 0.f; ArbT[r] = row <= tt ? ArbT[r] : 0.f; ArkT[r] = row <= tt ? ArkT[r] : 0.f;
                    Q0[r] = (row == tt ? 1.0f : 0.f) - Nt[r]; }
                const s16x8 oN = mk_d(Nd), oNt = mk_d(Nt);
                const f32x4 N2 = mfma16(oNt, oN, Z), N2t = mfma16(oN, oNt, Z);
                const s16x8 oN2 = mk_d(N2), oN2t = mk_d(N2t);
                const f32x4 N4 = mfma16(oN2t, oN2, Z), N4t = mfma16(oN2, oN2t, Z);
                const s16x8 oN4 = mk_d(N4), oN4t = mk_d(N4t);
                const f32x4 N8 = mfma16(oN4t, oN4, Z);
                const f32x4 Q1 = mfma16(oN2, mk_d(Q0), Q0);
                const f32x4 Q2 = mfma16(oN4, mk_d(Q1), Q1);
                const f32x4 Q3 = mfma16(mk_d(N8), mk_d(Q2), Q2);
                *(LAS u32x4*)(slot_w + SL_KA + lane * 16) = __builtin_bit_cast(u32x4, KaF[0]); *(LAS u32x4*)(slot_w + SL_KA + 1024 + lane * 16) = __builtin_bit_cast(u32x4, KaF[1]);
                *(LAS u32x4*)(slot_w + SL_RM + lane * 16) = __builtin_bit_cast(u32x4, RmF[0]); *(LAS u32x4*)(slot_w + SL_RM + 1024 + lane * 16) = __builtin_bit_cast(u32x4, RmF[1]);
                *(LAS u32x2*)(slot_w + SL_TN + lane * 8) = (u32x2){pk2(-Q3[0], -Q3[1]), pk2(-Q3[2], -Q3[3])};
                *(LAS u32x2*)(slot_w + SL_AAK + lane * 8) = (u32x2){pk2(AakT[0], AakT[1]), pk2(AakT[2], AakT[3])};
                *(LAS u32x4*)(slot_w + SL_ARK + lane * 16) = (u32x4){pk2(ArbT[0], ArbT[1]), pk2(ArbT[2], ArbT[3]), pk2(ArkT[0], ArkT[1]), pk2(ArkT[2], ArkT[3])};
#pragma unroll
                for (int kb = 0; kb < 2; ++kb)
#pragma unroll
                    for (int sel = 0; sel < 2; ++sel) { const int tk = 2 * kb + sel;
                        const f32x4 DB = mfma16(BmF[kb], SelF[sel], Z), DK = mfma16(KmF[kb], SelF[sel], Z), DV = mfma16(VF[kb], SelF[sel], Z);
                        *(LAS u32x4*)(slot_w + SL_BK + tk * 1024 + lane * 16) = (u32x4){pk2(DB[0], DB[1]), pk2(DB[2], DB[3]), pk2(DK[0], DK[1]), pk2(DK[2], DK[3])};
                        *(LAS u32x2*)(slot_w + SL_VC + tk * 512 + lane * 8) = (u32x2){pk2(DV[0], DV[1]), pk2(DV[2], DV[3])}; }
                if (tt == 15) {
#pragma unroll
                    for (int g = 0; g < 4; ++g) *(LAS f32x4*)(slot_w + SL_GC + (g * 4 + q) * 16) = gend[g]; }
            }
            __builtin_amdgcn_fence(__ATOMIC_RELEASE, "workgroup");
            if (lane == 0) __hip_atomic_fetch_add(CNT, 1u, __ATOMIC_RELAXED, __HIP_MEMORY_SCOPE_WORKGROUP);
            { unsigned spins = 0; while (__hip_atomic_load(CNT, __ATOMIC_RELAXED, __HIP_MEMORY_SCOPE_WORKGROUP) < 4u * (unsigned)(rnd + 1)) { __builtin_amdgcn_s_sleep(1); if (++spins > (1u << 22)) break; } }
            __builtin_amdgcn_fence(__ATOMIC_ACQUIRE, "workgroup");
            {
                const int tv = F.wave;
                for (int sl = 0; sl < 4; ++sl) {
                    LAS unsigned char* S = F.lds + ((rnd & 1) * 4 + sl) * SL_BYTES; const int cj = rnd * 4 + sl;
                    const s16x8 KA0 = __builtin_bit_cast(s16x8, *(LAS u32x4*)(S + SL_KA + lane * 16)), KA1 = __builtin_bit_cast(s16x8, *(LAS u32x4*)(S + SL_KA + 1024 + lane * 16));
                    const u32x2 aak = *(LAS u32x2*)(S + SL_AAK + lane * 8), tn = *(LAS u32x2*)(S + SL_TN + lane * 8), vc = *(LAS u32x2*)(S + SL_VC + tv * 512 + lane * 8);
                    const s16x8 Gb0 = mk8(pk2(G[0][0], G[0][1]), pk2(G[0][2], G[0][3]), pk2(G[1][0], G[1][1]), pk2(G[1][2], G[1][3]));
                    const s16x8 Gb1 = mk8(pk2(G[2][0], G[2][1]), pk2(G[2][2], G[2][3]), pk2(G[3][0], G[3][1]), pk2(G[3][2], G[3][3]));
                    const f32x4 Z = (f32x4){0.f, 0.f, 0.f, 0.f};
                    f32x4 P = mfma16(KA0, Gb0, Z); P = mfma16(KA1, Gb1, P); P = mfma16(mk8(aak.x, aak.y, 0u, 0u), mk8(vc.x, vc.y, 0u, 0u), P);
                    const f32x4 U = mfma16(mk8(tn.x, tn.y, 0u, 0u), mk_d(P), Z);
                    const s16x8 UV = mk8(pk2(U[0], U[1]), pk2(U[2], U[3]), vc.x, vc.y);
                    if (lat) {
                        const s16x8 RM0 = __builtin_bit_cast(s16x8, *(LAS u32x4*)(S + SL_RM + lane * 16)), RM1 = __builtin_bit_cast(s16x8, *(LAS u32x4*)(S + SL_RM + 1024 + lane * 16));
                        const s16x8 ARK = __builtin_bit_cast(s16x8, *(LAS u32x4*)(S + SL_ARK + lane * 16));
                        f32x4 Y = mfma16(Gb0, RM0, Z); Y = mfma16(Gb1, RM1, Y); Y = mfma16(UV, ARK, Y);
                        *(u32x2*)(YD + (size_t)(S2_ROW0(cj) + (d ? 15 - tt : tt)) * D + h * HS + 16 * tv + 4 * q) = (u32x2){pk2(Y[0], Y[1]), pk2(Y[2], Y[3])};
                    }
#pragma unroll
                    for (int tk = 0; tk < 4; ++tk) { const s16x8 BK = __builtin_bit_cast(s16x8, *(LAS u32x4*)(S + SL_BK + tk * 1024 + lane * 16));
                        G[tk] = mfma16(BK, UV, G[tk]); G[tk] = G[tk] * *(LAS f32x4*)(S + SL_GC + (tk * 4 + q) * 16); }
                }
            }
        }
        }
#undef S2_ROW0
#undef S2_LOAD
    }
    __syncthreads();
}

__device__ __forceinline__ void p4_scan4(const Frame& F, const Args& a, unsigned char* yd_base, float* sb_base) {
    const int lane = lane_id(), tt = lane & 15, q = lane >> 4;
    const bf16_t* KX = (const bf16_t*)(F.ws + A_KX); const bf16_t* VV = (const bf16_t*)(F.ws + A_V); const bf16_t* RR = (const bf16_t*)(F.ws + A_R);
    const bf16_t* EW = (const bf16_t*)(F.ws + A_EW); const bf16_t* AA = (const bf16_t*)(F.ws + A_AA);
    LAS float* PAR = (LAS float*)(F.lds + SC_PAR);
    LAS unsigned* CNT = (LAS unsigned*)(F.lds + SC_PAR + 1024);
    s16x8 SelF[2];
#pragma unroll
    for (int sel = 0; sel < 2; ++sel) { unsigned w[4];
#pragma unroll
        for (int jj = 0; jj < 4; ++jj) { const int j0 = 2 * jj, j1 = 2 * jj + 1; const bool h0 = (q == (tt >> 2)) && (j0 == 4 * sel + (tt & 3)), h1 = (q == (tt >> 2)) && (j1 == 4 * sel + (tt & 3));
            w[jj] = (h0 ? 0x3f80u : 0u) | (h1 ? 0x3f800000u : 0u); }
        SelF[sel] = mk8(w[0], w[1], w[2], w[3]); }
    { const int s = blockIdx.x;
        const int b = s >> 6, h = (s >> 1) & 31, d = s & 1;
        bf16_t* YD = (bf16_t*)(yd_base + (size_t)d * 32 * MiB); float* SB = sb_base + (size_t)d * ML * NH;
        __syncthreads();
        if (F.wave == 0) { PAR[lane] = a.in[I_KK][h * HS + lane]; PAR[64 + lane] = a.in[I_KA][h * HS + lane]; PAR[128 + lane] = a.in[I_RK][h * HS + lane]; if (lane < 8) CNT[lane] = 0u; }
        __syncthreads();
        if (F.wave >= 4) {
        const int pw = F.wave - 4;
#define S2_ROW0(ci) (((ci) < 16) ? (ML + b * TC + (d ? 15 - (ci) : (ci)) * 16) : (b * T + (d ? 127 - ((ci) - 16) : ((ci) - 16)) * 16))
        u32x2 rk[4], rv[4], rr[4], re[4], ra[4];
#define S2_LOAD(ci) do { const int row_ = S2_ROW0(ci) + (d ? 15 - tt : tt); const size_t o_ = (size_t)row_ * D + h * HS + 4 * q, o2_ = (size_t)row_ * (2 * D) + d * D + h * HS + 4 * q; \
        _Pragma("unroll") for (int g_ = 0; g_ < 4; ++g_) { rk[g_] = *(const u32x2*)(KX + o_ + 16 * g_); rv[g_] = *(const u32x2*)(VV + o_ + 16 * g_); \
            rr[g_] = ((ci) >= 16) ? *(const u32x2*)(RR + o_ + 16 * g_) : (u32x2){0u, 0u}; re[g_] = *(const u32x2*)(EW + o2_ + 16 * g_); ra[g_] = *(const u32x2*)(AA + o2_ + 16 * g_); } } while (0)
        S2_LOAD(pw);
        for (int rnd = 0; rnd < 36; ++rnd) {
            const int ci = rnd * 4 + pw; const bool lat = rnd >= 4;
            LAS unsigned char* slot_w = F.lds + ((rnd & 1) * 4 + pw) * SL_BYTES;
            if (rnd >= 2) { unsigned spins = 0;
                for (;;) { const unsigned d0 = __hip_atomic_load(CNT + 4, __ATOMIC_RELAXED, __HIP_MEMORY_SCOPE_WORKGROUP), d1 = __hip_atomic_load(CNT + 5, __ATOMIC_RELAXED, __HIP_MEMORY_SCOPE_WORKGROUP), d2 = __hip_atomic_load(CNT + 6, __ATOMIC_RELAXED, __HIP_MEMORY_SCOPE_WORKGROUP), d3 = __hip_atomic_load(CNT + 7, __ATOMIC_RELAXED, __HIP_MEMORY_SCOPE_WORKGROUP);
                    const unsigned need = (unsigned)(rnd - 1); if ((d0 >= need && d1 >= need && d2 >= need && d3 >= need) || ++spins > (1u << 22)) break; __builtin_amdgcn_s_sleep(1); }
                __builtin_amdgcn_fence(__ATOMIC_ACQUIRE, "workgroup"); }
            {
                float kf[4][4], af[4][4], ef[4][4], vf[4][4], rf[4][4];
#pragma unroll
                for (int g = 0; g < 4; ++g) {
                    kf[g][0] = bflo(rk[g].x); kf[g][1] = bfhi(rk[g].x); kf[g][2] = bflo(rk[g].y); kf[g][3] = bfhi(rk[g].y);
                    af[g][0] = bflo(ra[g].x); af[g][1] = bfhi(ra[g].x); af[g][2] = bflo(ra[g].y); af[g][3] = bfhi(ra[g].y);
                    ef[g][0] = bflo(re[g].x); ef[g][1] = bfhi(re[g].x); ef[g][2] = bflo(re[g].y); ef[g][3] = bfhi(re[g].y);
                    vf[g][0] = bflo(rv[g].x); vf[g][1] = bfhi(rv[g].x); vf[g][2] = bflo(rv[g].y); vf[g][3] = bfhi(rv[g].y);
                    rf[g][0] = bflo(rr[g].x); rf[g][1] = bfhi(rr[g].x); rf[g][2] = bflo(rr[g].y); rf[g][3] = bfhi(rr[g].y); }
                unsigned VP[4][2];
#pragma unroll
                for (int g = 0; g < 4; ++g) { VP[g][0] = rv[g].x; VP[g][1] = rv[g].y; }
                if (rnd + 1 < 36) S2_LOAD((rnd + 1) * 4 + pw);
                float kkv[4][4]; float n2 = 0.f;
#pragma unroll
                for (int g = 0; g < 4; ++g) { const f32x4 kc = *(const LAS f32x4*)(PAR + 16 * g + 4 * q);
#pragma unroll
                    for (int i = 0; i < 4; ++i) { kkv[g][i] = kf[g][i] * kc[i]; n2 += kkv[g][i] * kkv[g][i]; } }
                n2 += __shfl_xor(n2, 16); n2 += __shfl_xor(n2, 32);
                const float inv = 1.0f / fmaxf(sqrtf(n2), 1e-12f);
                float sb = 0.f;
                unsigned KaP[4][2], BmP[4][2], KmP[4][2], RmP[4][2]; f32x4 gend[4];
#pragma unroll
                for (int g = 0; g < 4; ++g) { const f32x4 kac = *(const LAS f32x4*)(PAR + 64 + 16 * g + 4 * q), rkc = *(const LAS f32x4*)(PAR + 128 + 16 * g + 4 * q);
                    float ka_[4], bm_[4], km_[4], rm_[4];
#pragma unroll
                    for (int i = 0; i < 4; ++i) {
                        float L = ef[g][i];
                        L += dpp_f<0x111>(L); L += dpp_f<0x112>(L); L += dpp_f<0x114>(L); L += dpp_f<0x118>(L);
                        const float gt = fexp(-L), gi = fexp(L); float gm1 = dpp_f<0x111>(gt); gm1 = (tt == 0) ? 1.0f : gm1;
                        const float kk = kkv[g][i] * inv, kd = kf[g][i] * (1.0f + (af[g][i] - 1.0f) * kac[i]);
                        ka_[i] = kk * gm1; bm_[i] = kk * af[g][i] * gi; km_[i] = kd * gi; rm_[i] = rf[g][i] * gt;
                        sb += rf[g][i] * kd * rkc[i]; gend[g][i] = gt; }
                    KaP[g][0] = pk2(ka_[0], ka_[1]); KaP[g][1] = pk2(ka_[2], ka_[3]); BmP[g][0] = pk2(bm_[0], bm_[1]); BmP[g][1] = pk2(bm_[2], bm_[3]);
                    KmP[g][0] = pk2(km_[0], km_[1]); KmP[g][1] = pk2(km_[2], km_[3]); RmP[g][0] = pk2(rm_[0], rm_[1]); RmP[g][1] = pk2(rm_[2], rm_[3]);
                }
                if (lat) { sb += __shfl_xor(sb, 16); sb += __shfl_xor(sb, 32); if (q == 0) SB[(size_t)(S2_ROW0(ci) + (d ? 15 - tt : tt)) * NH + h] = sb; }
                s16x8 KaF[2], BmF[2], KmF[2], RmF[2], VF[2];
#pragma unroll
                for (int kb = 0; kb < 2; ++kb) { KaF[kb] = mk8(KaP[2 * kb][0], KaP[2 * kb][1], KaP[2 * kb + 1][0], KaP[2 * kb + 1][1]); BmF[kb] = mk8(BmP[2 * kb][0], BmP[2 * kb][1], BmP[2 * kb + 1][0], BmP[2 * kb + 1][1]);
                    KmF[kb] = mk8(KmP[2 * kb][0], KmP[2 * kb][1], KmP[2 * kb + 1][0], KmP[2 * kb + 1][1]); RmF[kb] = mk8(RmP[2 * kb][0], RmP[2 * kb][1], RmP[2 * kb + 1][0], RmP[2 * kb + 1][1]);
                    VF[kb] = mk8(VP[2 * kb][0], VP[2 * kb][1], VP[2 * kb + 1][0], VP[2 * kb + 1][1]); }
                const f32x4 Z = (f32x4){0.f, 0.f, 0.f, 0.f};
                f32x4 Nd = mfma16(KaF[1], BmF[1], mfma16(KaF[0], BmF[0], Z));
                f32x4 Nt = mfma16(BmF[1], KaF[1], mfma16(BmF[0], KaF[0], Z));
                f32x4 AakT = mfma16(KmF[1], KaF[1], mfma16(KmF[0], KaF[0], Z));
                f32x4 ArbT = mfma16(BmF[1], RmF[1], mfma16(BmF[0], RmF[0], Z));
                f32x4 ArkT = mfma16(KmF[1], RmF[1], mfma16(KmF[0], RmF[0], Z));
                f32x4 Q0;
#pragma unroll
                for (int r = 0; r < 4; ++r) { const int row = 4 * q + r;
                    Nd[r] = row > tt ? Nd[r] : 0.f; Nt[r] = row < tt ? Nt[r] : 0.f; AakT[r] = row < tt ? AakT[r] : 0.f; ArbT[r] = row <= tt ? ArbT[r] : 0.f; ArkT[r] = row <= tt ? ArkT[r] : 0.f;
                    Q0[r] = (row == tt ? 1.0f : 0.f) - Nt[r]; }
                const s16x8 oN = mk_d(Nd), oNt = mk_d(Nt);
                const f32x4 N2 = mfma16(oNt, oN, Z), N2t = mfma16(oN, oNt, Z);
                const s16x8 oN2 = mk_d(N2), oN2t = mk_d(N2t);
                const f32x4 N4 = mfma16(oN2t, oN2, Z), N4t = mfma16(oN2, oN2t, Z);
                const s16x8 oN4 = mk_d(N4), oN4t = mk_d(N4t);
                const f32x4 N8 = mfma16(oN4t, oN4, Z);
                const f32x4 Q1 = mfma16(oN2, mk_d(Q0), Q0);
                const f32x4 Q2 = mfma16(oN4, mk_d(Q1), Q1);
                const f32x4 Q3 = mfma16(mk_d(N8), mk_d(Q2), Q2);
                *(LAS u32x4*)(slot_w + SL_KA + lane * 16) = __builtin_bit_cast(u32x4, KaF[0]); *(LAS u32x4*)(slot_w + SL_KA + 1024 + lane * 16) = __builtin_bit_cast(u32x4, KaF[1]);
                *(LAS u32x4*)(slot_w + SL_RM + lane * 16) = __builtin_bit_cast(u32x4, RmF[0]); *(LAS u32x4*)(slot_w + SL_RM + 1024 + lane * 16) = __builtin_bit_cast(u32x4, RmF[1]);
                *(LAS u32x2*)(slot_w + SL_TN + lane * 8) = (u32x2){pk2(-Q3[0], -Q3[1]), pk2(-Q3[2], -Q3[3])};
                *(LAS u32x2*)(slot_w + SL_AAK + lane * 8) = (u32x2){pk2(AakT[0], AakT[1]), pk2(AakT[2], AakT[3])};
                *(LAS u32x4*)(slot_w + SL_ARK + lane * 16) = (u32x4){pk2(ArbT[0], ArbT[1]), pk2(ArbT[2], ArbT[3]), pk2(ArkT[0], ArkT[1]), pk2(ArkT[2], ArkT[3])};
#pragma unroll
                for (int kb = 0; kb < 2; ++kb)
#pragma unroll
                    for (int sel = 0; sel < 2; ++sel) { const int tk = 2 * kb + sel;
                        const f32x4 DB = mfma16(BmF[kb], SelF[sel], Z), DK = mfma16(KmF[kb], SelF[sel], Z), DV = mfma16(VF[kb], SelF[sel], Z);
                        *(LAS u32x4*)(slot_w + SL_BK + tk * 1024 + lane * 16) = (u32x4){pk2(DB[0], DB[1]), pk2(DB[2], DB[3]), pk2(DK[0], DK[1]), pk2(DK[2], DK[3])};
                        *(LAS u32x2*)(slot_w + SL_VC + tk * 512 + lane * 8) = (u32x2){pk2(DV[0], DV[1]), pk2(DV[2], DV[3])}; }
                if (tt == 15) {
#pragma unroll
                    for (int g = 0; g < 4; ++g) *(LAS f32x4*)(slot_w + SL_GC + (g * 4 + q) * 16) = gend[g]; }
            }
            __builtin_amdgcn_fence(__ATOMIC_RELEASE, "workgroup");
            if (lane == 0) __hip_atomic_store(CNT + pw, (unsigned)(rnd + 1), __ATOMIC_RELAXED, __HIP_MEMORY_SCOPE_WORKGROUP);
        }
        } else {
        f32x4 G[4];
#pragma unroll
        for (int tk = 0; tk < 4; ++tk) G[tk] = (f32x4){0.f, 0.f, 0.f, 0.f};
        for (int rnd = 0; rnd < 36; ++rnd) {
            const bool lat = rnd >= 4;
            { unsigned spins = 0;
                for (;;) { const unsigned f0 = __hip_atomic_load(CNT + 0, __ATOMIC_RELAXED, __HIP_MEMORY_SCOPE_WORKGROUP), f1 = __hip_atomic_load(CNT + 1, __ATOMIC_RELAXED, __HIP_MEMORY_SCOPE_WORKGROUP), f2 = __hip_atomic_load(CNT + 2, __ATOMIC_RELAXED, __HIP_MEMORY_SCOPE_WORKGROUP), f3 = __hip_atomic_load(CNT + 3, __ATOMIC_RELAXED, __HIP_MEMORY_SCOPE_WORKGROUP);
                    const unsigned need = (unsigned)(rnd + 1); if ((f0 >= need && f1 >= need && f2 >= need && f3 >= need) || ++spins > (1u << 22)) break; __builtin_amdgcn_s_sleep(1); } }
            __builtin_amdgcn_fence(__ATOMIC_ACQUIRE, "workgroup");
            {
                const int tv = F.wave;
                for (int sl = 0; sl < 4; ++sl) {
                    LAS unsigned char* S = F.lds + ((rnd & 1) * 4 + sl) * SL_BYTES; const int cj = rnd * 4 + sl;
                    const s16x8 KA0 = __builtin_bit_cast(s16x8, *(LAS u32x4*)(S + SL_KA + lane * 16)), KA1 = __builtin_bit_cast(s16x8, *(LAS u32x4*)(S + SL_KA + 1024 + lane * 16));
                    const u32x2 aak = *(LAS u32x2*)(S + SL_AAK + lane * 8), tn = *(LAS u32x2*)(S + SL_TN + lane * 8), vc = *(LAS u32x2*)(S + SL_VC + tv * 512 + lane * 8);
                    const s16x8 Gb0 = mk8(pk2(G[0][0], G[0][1]), pk2(G[0][2], G[0][3]), pk2(G[1][0], G[1][1]), pk2(G[1][2], G[1][3]));
                    const s16x8 Gb1 = mk8(pk2(G[2][0], G[2][1]), pk2(G[2][2], G[2][3]), pk2(G[3][0], G[3][1]), pk2(G[3][2], G[3][3]));
                    const f32x4 Z = (f32x4){0.f, 0.f, 0.f, 0.f};
                    f32x4 P = mfma16(KA0, Gb0, Z); P = mfma16(KA1, Gb1, P); P = mfma16(mk8(aak.x, aak.y, 0u, 0u), mk8(vc.x, vc.y, 0u, 0u), P);
                    const f32x4 U = mfma16(mk8(tn.x, tn.y, 0u, 0u), mk_d(P), Z);
                    const s16x8 UV = mk8(pk2(U[0], U[1]), pk2(U[2], U[3]), vc.x, vc.y);
                    if (lat) {
                        const s16x8 RM0 = __builtin_bit_cast(s16x8, *(LAS u32x4*)(S + SL_RM + lane * 16)), RM1 = __builtin_bit_cast(s16x8, *(LAS u32x4*)(S + SL_RM + 1024 + lane * 16));
                        const s16x8 ARK = __builtin_bit_cast(s16x8, *(LAS u32x4*)(S + SL_ARK + lane * 16));
                        f32x4 Y = mfma16(Gb0, RM0, Z); Y = mfma16(Gb1, RM1, Y); Y = mfma16(UV, ARK, Y);
                        *(u32x2*)(YD + (size_t)(S2_ROW0(cj) + (d ? 15 - tt : tt)) * D + h * HS + 16 * tv + 4 * q) = (u32x2){pk2(Y[0], Y[1]), pk2(Y[2], Y[3])};
                    }
#pragma unroll
                    for (int tk = 0; tk < 4; ++tk) { const s16x8 BK = __builtin_bit_cast(s16x8, *(LAS u32x4*)(S + SL_BK + tk * 1024 + lane * 16));
                        G[tk] = mfma16(BK, UV, G[tk]); G[tk] = G[tk] * *(LAS f32x4*)(S + SL_GC + (tk * 4 + q) * 16); }
                }
            }
            __builtin_amdgcn_fence(__ATOMIC_RELEASE, "workgroup");
            if (lane == 0) __hip_atomic_store(CNT + 4 + F.wave, (unsigned)(rnd + 1), __ATOMIC_RELAXED, __HIP_MEMORY_SCOPE_WORKGROUP);
        }
        }
#undef S2_ROW0
#undef S2_LOAD
    }
    __syncthreads();
}

__device__ __forceinline__ void p4_scan5(const Frame& F, const Args& a, unsigned char* yd_base, float* sb_base, int clo, int chi, int job = -1) {
    const int lane = lane_id(), tt = lane & 15, q = lane >> 4;
    const bf16_t* KX = (const bf16_t*)(F.ws + A_KX); const bf16_t* VV = (const bf16_t*)(F.ws + A_V); const bf16_t* RR = (const bf16_t*)(F.ws + A_R);
    const bf16_t* EW = (const bf16_t*)(F.ws + A_EW); const bf16_t* AA = (const bf16_t*)(F.ws + A_AA);
    LAS float* PAR = (LAS float*)(F.lds + SC_PAR);
    LAS unsigned* CNT = (LAS unsigned*)(F.lds + SC_PAR + 1024);
    s16x8 SelF[2];
#pragma unroll
    for (int sel = 0; sel < 2; ++sel) { unsigned w[4];
#pragma unroll
        for (int jj = 0; jj < 4; ++jj) { const int j0 = 2 * jj, j1 = 2 * jj + 1; const bool h0 = (q == (tt >> 2)) && (j0 == 4 * sel + (tt & 3)), h1 = (q == (tt >> 2)) && (j1 == 4 * sel + (tt & 3));
            w[jj] = (h0 ? 0x3f80u : 0u) | (h1 ? 0x3f800000u : 0u); }
        SelF[sel] = mk8(w[0], w[1], w[2], w[3]); }
    { const int s = job >= 0 ? job : (int)blockIdx.x;
        const int b = s >> 6, h = (s >> 1) & 31, d = s & 1;
        bf16_t* YD = (bf16_t*)(yd_base + (size_t)d * 32 * MiB); float* SB = sb_base + (size_t)d * ML * NH;
        __syncthreads();
        if (F.wave == 0) { PAR[lane] = a.in[I_KK][h * HS + lane]; PAR[64 + lane] = a.in[I_KA][h * HS + lane]; PAR[128 + lane] = a.in[I_RK][h * HS + lane]; if (lane < 8) CNT[lane] = 0u; }
        __syncthreads();
        if (F.wave >= 4) {
        const int pw = F.wave - 4;
#define S2_ROW0(ci) (((ci) < 16) ? (ML + b * TC + (d ? 15 - (ci) : (ci)) * 16) : (b * T + (d ? 127 - ((ci) - 16) : ((ci) - 16)) * 16))
        u32x2 rk[4], rv[4], rr[4], re[4], ra[4];
#define S2_LOAD(ci) do { const int row_ = S2_ROW0(ci) + (d ? 15 - tt : tt); const size_t o_ = (size_t)row_ * D + h * HS + 4 * q, o2_ = (size_t)row_ * (2 * D) + d * D + h * HS + 4 * q; \
        _Pragma("unroll") for (int g_ = 0; g_ < 4; ++g_) { rk[g_] = *(const u32x2*)(KX + o_ + 16 * g_); rv[g_] = *(const u32x2*)(VV + o_ + 16 * g_); \
            rr[g_] = ((ci) >= 16) ? *(const u32x2*)(RR + o_ + 16 * g_) : (u32x2){0u, 0u}; re[g_] = *(const u32x2*)(EW + o2_ + 16 * g_); ra[g_] = *(const u32x2*)(AA + o2_ + 16 * g_); } } while (0)
        S2_LOAD(pw);
        for (int rnd = 0; rnd < 36; ++rnd) {
            const int ci = rnd * 4 + pw; const bool lat = rnd >= 4;
            LAS unsigned char* slot_w = F.lds + ((rnd & 1) * 4 + pw) * SL_BYTES;
            if (rnd >= 2) { unsigned spins = 0;
                for (;;) { const unsigned d0 = __hip_atomic_load(CNT + 4, __ATOMIC_RELAXED, __HIP_MEMORY_SCOPE_WORKGROUP), d1 = __hip_atomic_load(CNT + 5, __ATOMIC_RELAXED, __HIP_MEMORY_SCOPE_WORKGROUP), d2 = __hip_atomic_load(CNT + 6, __ATOMIC_RELAXED, __HIP_MEMORY_SCOPE_WORKGROUP), d3 = __hip_atomic_load(CNT + 7, __ATOMIC_RELAXED, __HIP_MEMORY_SCOPE_WORKGROUP);
                    const unsigned need = (unsigned)(rnd - 1); if ((d0 >= need && d1 >= need && d2 >= need && d3 >= need) || ++spins > (1u << 22)) break; __builtin_amdgcn_s_sleep(1); }
                __builtin_amdgcn_fence(__ATOMIC_ACQUIRE, "workgroup"); }
            {
                float kf[4][4], af[4][4], ef[4][4], vf[4][4], rf[4][4];
#pragma unroll
                for (int g = 0; g < 4; ++g) {
                    kf[g][0] = bflo(rk[g].x); kf[g][1] = bfhi(rk[g].x); kf[g][2] = bflo(rk[g].y); kf[g][3] = bfhi(rk[g].y);
                    af[g][0] = bflo(ra[g].x); af[g][1] = bfhi(ra[g].x); af[g][2] = bflo(ra[g].y); af[g][3] = bfhi(ra[g].y);
                    ef[g][0] = bflo(re[g].x); ef[g][1] = bfhi(re[g].x); ef[g][2] = bflo(re[g].y); ef[g][3] = bfhi(re[g].y);
                    vf[g][0] = bflo(rv[g].x); vf[g][1] = bfhi(rv[g].x); vf[g][2] = bflo(rv[g].y); vf[g][3] = bfhi(rv[g].y);
                    rf[g][0] = bflo(rr[g].x); rf[g][1] = bfhi(rr[g].x); rf[g][2] = bflo(rr[g].y); rf[g][3] = bfhi(rr[g].y); }
                unsigned VP[4][2];
#pragma unroll
                for (int g = 0; g < 4; ++g) { VP[g][0] = rv[g].x; VP[g][1] = rv[g].y; }
                if (rnd + 1 < 36) S2_LOAD((rnd + 1) * 4 + pw);
                float kkv[4][4]; float n2 = 0.f;
#pragma unroll
                for (int g = 0; g < 4; ++g) { const f32x4 kc = *(const LAS f32x4*)(PAR + 16 * g + 4 * q);
#pragma unroll
                    for (int i = 0; i < 4; ++i) { kkv[g][i] = kf[g][i] * kc[i]; n2 += kkv[g][i] * kkv[g][i]; } }
                n2 += __shfl_xor(n2, 16); n2 += __shfl_xor(n2, 32);
                const float inv = 1.0f / fmaxf(sqrtf(n2), 1e-12f);
                float sb = 0.f;
                unsigned KaP[4][2], BmP[4][2], KmP[4][2], RmP[4][2]; f32x4 gend[4];
#pragma unroll
                for (int g = 0; g < 4; ++g) { const f32x4 kac = *(const LAS f32x4*)(PAR + 64 + 16 * g + 4 * q), rkc = *(const LAS f32x4*)(PAR + 128 + 16 * g + 4 * q);
                    float ka_[4], bm_[4], km_[4], rm_[4];
#pragma unroll
                    for (int i = 0; i < 4; ++i) {
                        float L = ef[g][i];
                        L += dpp_f<0x111>(L); L += dpp_f<0x112>(L); L += dpp_f<0x114>(L); L += dpp_f<0x118>(L);
                        const float gt = fexp(-L), gi = fexp(L); float gm1 = dpp_f<0x111>(gt); gm1 = (tt == 0) ? 1.0f : gm1;
                        const float kk = kkv[g][i] * inv, kd = kf[g][i] * (1.0f + (af[g][i] - 1.0f) * kac[i]);
                        ka_[i] = kk * gm1; bm_[i] = kk * af[g][i] * gi; km_[i] = kd * gi; rm_[i] = rf[g][i] * gt;
                        sb += rf[g][i] * kd * rkc[i]; gend[g][i] = gt; }
                    KaP[g][0] = pk2(ka_[0], ka_[1]); KaP[g][1] = pk2(ka_[2], ka_[3]); BmP[g][0] = pk2(bm_[0], bm_[1]); BmP[g][1] = pk2(bm_[2], bm_[3]);
                    KmP[g][0] = pk2(km_[0], km_[1]); KmP[g][1] = pk2(km_[2], km_[3]); RmP[g][0] = pk2(rm_[0], rm_[1]); RmP[g][1] = pk2(rm_[2], rm_[3]);
                }
                if (lat) { sb += __shfl_xor(sb, 16); sb += __shfl_xor(sb, 32); if (q == 0) SB[(size_t)(S2_ROW0(ci) + (d ? 15 - tt : tt)) * NH + h] = sb; }
                s16x8 KaF[2], BmF[2], KmF[2], RmF[2], VF[2];
#pragma unroll
                for (int kb = 0; kb < 2; ++kb) { KaF[kb] = mk8(KaP[2 * kb][0], KaP[2 * kb][1], KaP[2 * kb + 1][0], KaP[2 * kb + 1][1]); BmF[kb] = mk8(BmP[2 * kb][0], BmP[2 * kb][1], BmP[2 * kb + 1][0], BmP[2 * kb + 1][1]);
                    KmF[kb] = mk8(KmP[2 * kb][0], KmP[2 * kb][1], KmP[2 * kb + 1][0], KmP[2 * kb + 1][1]); RmF[kb] = mk8(RmP[2 * kb][0], RmP[2 * kb][1], RmP[2 * kb + 1][0], RmP[2 * kb + 1][1]);
                    VF[kb] = mk8(VP[2 * kb][0], VP[2 * kb][1], VP[2 * kb + 1][0], VP[2 * kb + 1][1]); }
                const f32x4 Z = (f32x4){0.f, 0.f, 0.f, 0.f};
                f32x4 Nd = mfma16(KaF[1], BmF[1], mfma16(KaF[0], BmF[0], Z));
                f32x4 Nt = mfma16(BmF[1], KaF[1], mfma16(BmF[0], KaF[0], Z));
                f32x4 AakT = mfma16(KmF[1], KaF[1], mfma16(KmF[0], KaF[0], Z));
                f32x4 ArbT = mfma16(BmF[1], RmF[1], mfma16(BmF[0], RmF[0], Z));
                f32x4 ArkT = mfma16(KmF[1], RmF[1], mfma16(KmF[0], RmF[0], Z));
                f32x4 Q0;
#pragma unroll
                for (int r = 0; r < 4; ++r) { const int row = 4 * q + r;
                    Nd[r] = row > tt ? Nd[r] : 0.f; Nt[r] = row < tt ? Nt[r] : 0.f; AakT[r] = row < tt ? AakT[r] : 0.f; ArbT[r] = row <= tt ? ArbT[r] : 0.f; ArkT[r] = row <= tt ? ArkT[r] : 0.f;
                    Q0[r] = (row == tt ? 1.0f : 0.f) - Nt[r]; }
                const s16x8 oN = mk_d(Nd), oNt = mk_d(Nt);
                const f32x4 N2 = mfma16(oNt, oN, Z), N2t = mfma16(oN, oNt, Z);
                const s16x8 oN2 = mk_d(N2), oN2t = mk_d(N2t);
                const f32x4 N4 = mfma16(oN2t, oN2, Z), N4t = mfma16(oN2, oN2t, Z);
                const s16x8 oN4 = mk_d(N4), oN4t = mk_d(N4t);
                const f32x4 N8 = mfma16(oN4t, oN4, Z);
                const f32x4 Q1 = mfma16(oN2, mk_d(Q0), Q0);
                const f32x4 Q2 = mfma16(oN4, mk_d(Q1), Q1);
                const f32x4 Q3 = mfma16(mk_d(N8), mk_d(Q2), Q2);
                *(LAS u32x4*)(slot_w + SL_KA + lane * 16) = __builtin_bit_cast(u32x4, KaF[0]); *(LAS u32x4*)(slot_w + SL_KA + 1024 + lane * 16) = __builtin_bit_cast(u32x4, KaF[1]);
                *(LAS u32x4*)(slot_w + SL_RM + lane * 16) = __builtin_bit_cast(u32x4, RmF[0]); *(LAS u32x4*)(slot_w + SL_RM + 1024 + lane * 16) = __builtin_bit_cast(u32x4, RmF[1]);
                *(LAS u32x2*)(slot_w + SL_TN + lane * 8) = (u32x2){pk2(-Q3[0], -Q3[1]), pk2(-Q3[2], -Q3[3])};
                *(LAS u32x2*)(slot_w + SL_AAK + lane * 8) = (u32x2){pk2(AakT[0], AakT[1]), pk2(AakT[2], AakT[3])};
                *(LAS u32x4*)(slot_w + SL_ARK + lane * 16) = (u32x4){pk2(ArbT[0], ArbT[1]), pk2(ArbT[2], ArbT[3]), pk2(ArkT[0], ArkT[1]), pk2(ArkT[2], ArkT[3])};
#pragma unroll
                for (int kb = 0; kb < 2; ++kb)
#pragma unroll
                    for (int sel = 0; sel < 2; ++sel) { const int tk = 2 * kb + sel;
                        const f32x4 DB = mfma16(BmF[kb], SelF[sel], Z), DK = mfma16(KmF[kb], SelF[sel], Z), DV = mfma16(VF[kb], SelF[sel], Z);
                        *(LAS u32x4*)(slot_w + SL_BK + tk * 1024 + lane * 16) = (u32x4){pk2(DB[0], DB[1]), pk2(DB[2], DB[3]), pk2(DK[0], DK[1]), pk2(DK[2], DK[3])};
                        *(LAS u32x2*)(slot_w + SL_VC + tk * 512 + lane * 8) = (u32x2){pk2(DV[0], DV[1]), pk2(DV[2], DV[3])}; }
                if (tt == 15) {
#pragma unroll
                    for (int g = 0; g < 4; ++g) *(LAS f32x4*)(slot_w + SL_GC + (g * 4 + q) * 16) = gend[g]; }
            }
            __builtin_amdgcn_fence(__ATOMIC_RELEASE, "workgroup");
            if (lane == 0) __hip_atomic_store(CNT + pw, (unsigned)(rnd + 1), __ATOMIC_RELAXED, __HIP_MEMORY_SCOPE_WORKGROUP);
        }
        } else {
        f32x4 G[4];
#pragma unroll
        for (int tk = 0; tk < 4; ++tk) G[tk] = (f32x4){0.f, 0.f, 0.f, 0.f};
        LAS unsigned* cscr = (LAS unsigned*)(F.lds + 102400 + F.wave * 8448);
        int cit = clo + (int)blockIdx.x * 4 + F.wave, ch_ = 0; bool chave = cit < chi; TrItem ct; f32x4 cr[4][4];
        if (chave) { ct = tr_decode(F, a, cit); tr_load(ct, 0, cr, lane); }
#define S5_CONV_STEP() do { if (chave) { tr_store(ct, ch_, cr, cscr, lane); \
            if (ct.f8 && ch_ == 0) ch_ = 1; else { cit += 4 * 256; ch_ = 0; chave = cit < chi; if (chave) ct = tr_decode(F, a, cit); } \
            if (chave) tr_load(ct, ch_, cr, lane); } } while (0)
        for (int rnd = 0; rnd < 36; ++rnd) {
            const bool lat = rnd >= 4;
            { unsigned spins = 0;
                for (;;) { const unsigned f0 = __hip_atomic_load(CNT + 0, __ATOMIC_RELAXED, __HIP_MEMORY_SCOPE_WORKGROUP), f1 = __hip_atomic_load(CNT + 1, __ATOMIC_RELAXED, __HIP_MEMORY_SCOPE_WORKGROUP), f2 = __hip_atomic_load(CNT + 2, __ATOMIC_RELAXED, __HIP_MEMORY_SCOPE_WORKGROUP), f3 = __hip_atomic_load(CNT + 3, __ATOMIC_RELAXED, __HIP_MEMORY_SCOPE_WORKGROUP);
                    const unsigned need = (unsigned)(rnd + 1); if ((f0 >= need && f1 >= need && f2 >= need && f3 >= need) || ++spins > (1u << 22)) break; __builtin_amdgcn_s_sleep(1); } }
            __builtin_amdgcn_fence(__ATOMIC_ACQUIRE, "workgroup");
            {
                const int tv = F.wave;
                for (int sl = 0; sl < 4; ++sl) {
                    LAS unsigned char* S = F.lds + ((rnd & 1) * 4 + sl) * SL_BYTES; const int cj = rnd * 4 + sl;
                    const s16x8 KA0 = __builtin_bit_cast(s16x8, *(LAS u32x4*)(S + SL_KA + lane * 16)), KA1 = __builtin_bit_cast(s16x8, *(LAS u32x4*)(S + SL_KA + 1024 + lane * 16));
                    const u32x2 aak = *(LAS u32x2*)(S + SL_AAK + lane * 8), tn = *(LAS u32x2*)(S + SL_TN + lane * 8), vc = *(LAS u32x2*)(S + SL_VC + tv * 512 + lane * 8);
                    const s16x8 Gb0 = mk8(pk2(G[0][0], G[0][1]), pk2(G[0][2], G[0][3]), pk2(G[1][0], G[1][1]), pk2(G[1][2], G[1][3]));
                    const s16x8 Gb1 = mk8(pk2(G[2][0], G[2][1]), pk2(G[2][2], G[2][3]), pk2(G[3][0], G[3][1]), pk2(G[3][2], G[3][3]));
                    const f32x4 Z = (f32x4){0.f, 0.f, 0.f, 0.f};
                    f32x4 P = mfma16(KA0, Gb0, Z); P = mfma16(KA1, Gb1, P); P = mfma16(mk8(aak.x, aak.y, 0u, 0u), mk8(vc.x, vc.y, 0u, 0u), P);
                    const f32x4 U = mfma16(mk8(tn.x, tn.y, 0u, 0u), mk_d(P), Z);
                    const s16x8 UV = mk8(pk2(U[0], U[1]), pk2(U[2], U[3]), vc.x, vc.y);
                    if (lat) {
                        const s16x8 RM0 = __builtin_bit_cast(s16x8, *(LAS u32x4*)(S + SL_RM + lane * 16)), RM1 = __builtin_bit_cast(s16x8, *(LAS u32x4*)(S + SL_RM + 1024 + lane * 16));
                        const s16x8 ARK = __builtin_bit_cast(s16x8, *(LAS u32x4*)(S + SL_ARK + lane * 16));
                        f32x4 Y = mfma16(Gb0, RM0, Z); Y = mfma16(Gb1, RM1, Y); Y = mfma16(UV, ARK, Y);
                        *(u32x2*)(YD + (size_t)(S2_ROW0(cj) + (d ? 15 - tt : tt)) * D + h * HS + 16 * tv + 4 * q) = (u32x2){pk2(Y[0], Y[1]), pk2(Y[2], Y[3])};
                    }
#pragma unroll
                    for (int tk = 0; tk < 4; ++tk) { const s16x8 BK = __builtin_bit_cast(s16x8, *(LAS u32x4*)(S + SL_BK + tk * 1024 + lane * 16));
                        G[tk] = mfma16(BK, UV, G[tk]); G[tk] = G[tk] * *(LAS f32x4*)(S + SL_GC + (tk * 4 + q) * 16); }
                }
            }
            __builtin_amdgcn_fence(__ATOMIC_RELEASE, "workgroup");
            if (lane == 0) __hip_atomic_store(CNT + 4 + F.wave, (unsigned)(rnd + 1), __ATOMIC_RELAXED, __HIP_MEMORY_SCOPE_WORKGROUP);
#if !defined(PROBE_S5TAIL)
            S5_CONV_STEP();
#if defined(S5_TWO)
            S5_CONV_STEP();
#endif
#endif
        }
        while (chave) S5_CONV_STEP();
#undef S5_CONV_STEP
        }
#undef S2_ROW0
#undef S2_LOAD
    }
    __syncthreads();
}

#if defined(PROBE_SCANCHK)
constexpr int CW_CHK = 20480;
__device__ __forceinline__ void p4_compare(const Frame& F) {
    const int lane = lane_id();
    const bf16_t* Y0 = (const bf16_t*)(F.ws + A_YD); const bf16_t* Y1 = (const bf16_t*)(F.ws + A_AO);
    const float* S0 = (const float*)(F.ws + WS_SB); const float* S1 = (const float*)(F.ws + WS_A + 644 * MiB);
    float num = 0.f, den = 0.f, num2 = 0.f, den2 = 0.f;
    for (size_t i = (size_t)F.gw * 64 + lane; i < (size_t)2 * ML * D / 8; i += (size_t)F.NGW * 64) { float a8[8], b8[8]; unpack8(((const u32x4*)Y0)[i], a8); unpack8(((const u32x4*)Y1)[i], b8);
#pragma unroll
        for (int e = 0; e < 8; ++e) { const float dd = b8[e] - a8[e]; num += dd * dd; den += a8[e] * a8[e]; } }
    for (size_t i = (size_t)F.gw * 64 + lane; i < (size_t)2 * ML * NH; i += (size_t)F.NGW * 64) { const float dd = S1[i] - S0[i]; num2 += dd * dd; den2 += S0[i] * S0[i]; }
    num = wave_sum(num); den = wave_sum(den); num2 = wave_sum(num2); den2 = wave_sum(den2);
    if (lane == 0) { atomicAdd((float*)(F.ctl + CW_CHK), num); atomicAdd((float*)(F.ctl + CW_CHK + 64), den); atomicAdd((float*)(F.ctl + CW_CHK + 128), num2); atomicAdd((float*)(F.ctl + CW_CHK + 192), den2); }
}
#endif
__device__ __forceinline__ void p5_ao(const Frame& F, const Args& a) {
    const int lane = lane_id(), tid = F.wave * 64 + lane; (void)tid;
    const bf16_t* Y0 = (const bf16_t*)(F.ws + A_YD); const bf16_t* Y1 = (const bf16_t*)(F.ws + A_YD + 32 * MiB);
    const bf16_t* VV = (const bf16_t*)(F.ws + A_V); const bf16_t* GT = (const bf16_t*)(F.ws + A_GATE); bf16_t* AO = (bf16_t*)(F.ws + A_AO);
    const float* SB0 = (const float*)(F.ws + WS_SB); const float* SB1 = SB0 + (size_t)ML * NH;
    for (int m = F.gw; m < ML; m += F.NGW) {
        float ov[4][8]; float amx = 0.f; (void)ov; (void)amx;
#pragma unroll
        for (int j = 0; j < 4; ++j) {
            const int c = 8 * lane + 512 * j, hd = c >> 6; const size_t o = (size_t)m * D + c;
            float y0[8], y1[8], vv[8], gg[8], y[8];
            unpack8(*(const u32x4*)(Y0 + o), y0); unpack8(*(const u32x4*)(Y1 + o), y1); unpack8(*(const u32x4*)(VV + o), vv); unpack8(*(const u32x4*)(GT + o), gg);
            float s = 0.f;
#pragma unroll
            for (int e = 0; e < 8; ++e) { y[e] = y0[e] + y1[e]; s += y[e]; }
            s = sum8(s); const float mean = s * (1.0f / 64.0f); float qv = 0.f;
#pragma unroll
            for (int e = 0; e < 8; ++e) { y[e] -= mean; qv += y[e] * y[e]; }
            qv = sum8(qv); const float rstd = 1.0f / sqrtf(qv * (1.0f / 64.0f) + GN_EPS);
            const float sb = SB0[(size_t)m * NH + hd] + SB1[(size_t)m * NH + hd];
            const f32x4 gw0 = *(const f32x4*)(a.in[I_GNW] + c), gw1 = *(const f32x4*)(a.in[I_GNW] + c + 4), gb0 = *(const f32x4*)(a.in[I_GNB] + c), gb1 = *(const f32x4*)(a.in[I_GNB] + c + 4);
            float o8[8];
#pragma unroll
            for (int e = 0; e < 8; ++e) { const float gw = e < 4 ? gw0[e & 3] : gw1[e & 3], gb = e < 4 ? gb0[e & 3] : gb1[e & 3]; o8[e] = (y[e] * rstd * gw + gb + sb * vv[e]) * gg[e]; }
            if (WO_I8) {
#pragma unroll
                for (int e = 0; e < 8; ++e) { ov[j][e] = o8[e]; amx = fmaxf(amx, fabsf(o8[e])); } }
            else { u32x4 w; w.x = pk2(o8[0], o8[1]); w.y = pk2(o8[2], o8[3]); w.z = pk2(o8[4], o8[5]); w.w = pk2(o8[6], o8[7]);
                *(u32x4*)(AO + o) = w; }
        }
        if (WO_I8) {
            amx = wave_max(amx);
            amx = fmaxf(amx, 1e-30f); const float inv = 127.0f / amx;
#pragma unroll
            for (int j = 0; j < 4; ++j) { u32x2 w; w.x = pk4_i8(ov[j][0] * inv, ov[j][1] * inv, ov[j][2] * inv, ov[j][3] * inv); w.y = pk4_i8(ov[j][4] * inv, ov[j][5] * inv, ov[j][6] * inv, ov[j][7] * inv);
                *(u32x2*)((unsigned char*)AO + (size_t)m * D + 8 * lane + 512 * j) = w; }
            if (lane == 0) ((float*)(F.ws + WS_RSO))[m] = amx * (1.0f / 127.0f);
        }
    }
}

struct RowLN { f32x4 xn[8]; };
__device__ __forceinline__ void ln_core(int lane, f32x4 (&z)[8], const float* lnw, const float* lnb) {
    float s = 0.f;
#pragma unroll
    for (int j = 0; j < 8; ++j) s += (z[j][0] + z[j][1]) + (z[j][2] + z[j][3]);
    const float mean = wave_sum(s) * (1.0f / D); float q = 0.f;
#pragma unroll
    for (int j = 0; j < 8; ++j) { z[j] = z[j] - mean; q += (z[j][0] * z[j][0] + z[j][1] * z[j][1]) + (z[j][2] * z[j][2] + z[j][3] * z[j][3]); }
    const float rstd = 1.0f / sqrtf(wave_sum(q) * (1.0f / D) + LN_EPS);
#pragma unroll
    for (int j = 0; j < 8; ++j) { const int c = 4 * lane + 256 * j; z[j] = z[j] * rstd * *(const f32x4*)(lnw + c) + *(const f32x4*)(lnb + c); }
}
__device__ __forceinline__ void ln_core_pre(f32x4 (&z)[8], const f32x4 (&lw)[8], const f32x4 (&lb)[8]) {
    float s = 0.f;
#pragma unroll
    for (int j = 0; j < 8; ++j) s += (z[j][0] + z[j][1]) + (z[j][2] + z[j][3]);
    const float mean = wave_sum(s) * (1.0f / D); float q = 0.f;
#pragma unroll
    for (int j = 0; j < 8; ++j) { z[j] = z[j] - mean; q += (z[j][0] * z[j][0] + z[j][1] * z[j][1]) + (z[j][2] * z[j][2] + z[j][3] * z[j][3]); }
    const float rstd = 1.0f / sqrtf(wave_sum(q) * (1.0f / D) + LN_EPS);
#pragma unroll
    for (int j = 0; j < 8; ++j) z[j] = z[j] * rstd * lw[j] + lb[j];
}
__device__ __forceinline__ f32x4 ld_bf4(const bf16_t* p) { const u32x2 w = *(const u32x2*)p; return (f32x4){bflo(w.x), bfhi(w.x), bflo(w.y), bfhi(w.y)}; }
__device__ __forceinline__ void st_bf4(bf16_t* p, const f32x4 v) { u32x2 w; w.x = pk2(v[0], v[1]); w.y = pk2(v[2], v[3]); *(u32x2*)p = w; }
#ifndef XR_BF16
#define XR_BF16 0
#endif
__device__ __forceinline__ f32x4 xr_ld(const float* XR, size_t idx) { if (XR_BF16) return ld_bf4((const bf16_t*)XR + idx); return *(const f32x4*)(XR + idx); }
__device__ __forceinline__ void xr_st(float* XR, size_t idx, const f32x4 v) { if (XR_BF16) st_bf4((bf16_t*)XR + idx, v); else *(f32x4*)(XR + idx) = v; }
__device__ __forceinline__ void st_h(void* H, size_t idx, const f32x4 v, bool f8) { if (f8) *((unsigned*)((unsigned char*)H + idx)) = pk4_fp8(v[0] * 16.f, v[1] * 16.f, v[2] * 16.f, v[3] * 16.f); else st_bf4((bf16_t*)H + idx, v); }
__device__ __forceinline__ void post_norm_rows(const Frame& F, const Args& a, const bf16_t* Y, int gate_off, int lnidx, const float* MODh, int sh_off, int sc_off, void* H, int h8  , bool x0in) {
    const int lane = lane_id(), tid = F.wave * 64 + lane; (void)tid;
    const float* MOD = (const float*)(F.ws + WS_MOD); float* XR = (float*)(F.ws + WS_XR);
    const float* lnw = a.in[I_LNW] + lnidx * D; const float* lnb = a.in[I_LNB] + lnidx * D;
#ifndef LN_HOIST
#define LN_HOIST 0
#endif
    f32x4 lw[8], lb[8], pv[8]; int tprev = -1; (void)lw; (void)lb; (void)pv; (void)tprev;
    if (LN_HOIST) {
#pragma unroll
        for (int j = 0; j < 8; ++j) { const int c = 4 * lane + 256 * j; lw[j] = *(const f32x4*)(lnw + c); lb[j] = *(const f32x4*)(lnb + c); } }
    for (int m = F.gw; m < ML; m += F.NGW) {
        const int b = m / T; const float* g = MOD + gate_off + (size_t)b * MOD_N; const size_t o = (size_t)m * D;
        f32x4 z[8];
        if (LN_HOIST && x0in && (m % T) != tprev) { tprev = m % T;
#pragma unroll
            for (int j = 0; j < 8; ++j) pv[j] = *(const f32x4*)((const float*)(F.ws + WS_POS) + (size_t)tprev * D + 4 * lane + 256 * j); }
#pragma unroll
        for (int j = 0; j < 8; ++j) { const int c = 4 * lane + 256 * j;
            const f32x4 xv = x0in ? (*(const f32x4*)(a.in[I_X] + o + c) + (LN_HOIST ? pv[j] : *(const f32x4*)((const float*)(F.ws + WS_POS) + (size_t)(m % T) * D + c))) : xr_ld(XR, o + c);
            z[j] = xv * ALPHA + *(const f32x4*)(g + c) * ld_bf4(Y + o + c); }
        if (LN_HOIST) ln_core_pre(z, lw, lb); else ln_core(lane, z, lnw, lnb);
        const float* sh = MODh + sh_off + (size_t)b * MOD_N; const float* sc = MODh + sc_off + (size_t)b * MOD_N;
        if (h8 == 2) { float mx = 0.f;
#pragma unroll
            for (int j = 0; j < 8; ++j) { const int c = 4 * lane + 256 * j; xr_st(XR, o + c, z[j]); z[j] = z[j] * (*(const f32x4*)(sc + c) + 1.0f) + *(const f32x4*)(sh + c);
                mx = fmaxf(fmaxf(mx, fmaxf(fabsf(z[j][0]), fabsf(z[j][1]))), fmaxf(fabsf(z[j][2]), fabsf(z[j][3]))); }
            mx = wave_max(mx);
            mx = fmaxf(mx, 1e-30f); const float inv = 127.0f / mx;
#pragma unroll
            for (int j = 0; j < 8; ++j) { const int c = 4 * lane + 256 * j; *(unsigned*)((unsigned char*)H + o + c) = pk4_i8(z[j][0] * inv, z[j][1] * inv, z[j][2] * inv, z[j][3] * inv); }
            if (lane == 0) ((float*)(F.ws + WS_RS))[m] = mx * (1.0f / 127.0f);
            continue; }
#pragma unroll
        for (int j = 0; j < 8; ++j) { const int c = 4 * lane + 256 * j; xr_st(XR, o + c, z[j]);
            st_h(H, o + c, z[j] * (*(const f32x4*)(sc + c) + 1.0f) + *(const f32x4*)(sh + c), h8 != 0); }
    }
}

__device__ __forceinline__ void p9_quant_u(const Frame& F) {
    const int lane = lane_id();
    for (int m = F.gw; m < ML; m += F.NGW) {
        unsigned char* row = F.ws + A_U + (size_t)m * LDU * 2; u32x4 w[11]; float mx = 0.f;
#pragma unroll
        for (int i = 0; i < 11; ++i) w[i] = *(const u32x4*)(row + 16 * lane + 1024 * i);
#pragma unroll
        for (int i = 0; i < 11; ++i) { float f[8]; unpack8(w[i], f);
#pragma unroll
            for (int e = 0; e < 8; ++e) mx = fmaxf(mx, fabsf(f[e])); }
            mx = wave_max(mx);
        mx = fmaxf(mx, 1e-30f); const float inv = 127.0f / mx;
        asm volatile("" ::: "memory");
#pragma unroll
        for (int i = 0; i < 11; ++i) { float f[8]; unpack8(w[i], f); u32x2 o; o.x = pk4_i8(f[0] * inv, f[1] * inv, f[2] * inv, f[3] * inv); o.y = pk4_i8(f[4] * inv, f[5] * inv, f[6] * inv, f[7] * inv);
            *(u32x2*)(row + 8 * lane + 512 * i) = o; }
        if (lane == 0) ((float*)(F.ws + WS_RSU))[m] = mx * (1.0f / 127.0f);
    }
}

#ifndef POOL_SLIDE
#define POOL_SLIDE 0
#endif
template <int G>
__device__ __forceinline__ void pool_group4(const bf16_t* HP, bf16_t* PP, int m0, int t0, int lane) {
    constexpr int h = 1 << G; const int c = 8 * lane + 512 * G;
    float W[2 * h][8], E[3][8], S[8];
#pragma unroll
    for (int e = 0; e < 8; ++e) S[e] = 0.f;
#pragma unroll
    for (int j = 0; j < 2 * h; ++j) { const int tt = t0 - h + j; const bool ok = tt >= 0 && tt < T;
        unpack8(*(const u32x4*)(HP + (size_t)(ok ? m0 - h + j : m0) * D + c), W[j]);
#pragma unroll
        for (int e = 0; e < 8; ++e) { W[j][e] = ok ? W[j][e] : 0.f; S[e] += W[j][e]; } }
#pragma unroll
    for (int j = 0; j < 3; ++j) { const int tt = t0 + h + j; const bool ok = tt < T;
        unpack8(*(const u32x4*)(HP + (size_t)(ok ? m0 + h + j : m0) * D + c), E[j]);
#pragma unroll
        for (int e = 0; e < 8; ++e) E[j][e] = ok ? E[j][e] : 0.f; }
#pragma unroll
    for (int i = 0; i < 4; ++i) {
        if (i > 0) {
#pragma unroll
            for (int e = 0; e < 8; ++e) S[e] += E[i - 1][e] - ((i - 1 < 2 * h) ? W[(i - 1 < 2 * h) ? i - 1 : 0][e] : E[(i - 1 >= 2 * h) ? i - 1 - 2 * h : 0][e]); }
        const int t = t0 + i, lo = t - h > 0 ? t - h : 0, hi = t + h < T ? t + h : T; const float inv = 1.0f / (float)(hi - lo);
        float o[8];
#pragma unroll
        for (int e = 0; e < 8; ++e) { const float ctr = (i < h) ? W[(i < h) ? h + i : 0][e] : E[(i >= h) ? i - h : 0][e]; o[e] = S[e] * inv - ctr; }
        u32x4 w; w.x = pk2(o[0], o[1]); w.y = pk2(o[2], o[3]); w.z = pk2(o[4], o[5]); w.w = pk2(o[6], o[7]);
        *(u32x4*)(PP + (size_t)(m0 + i) * D + c) = w;
    }
}
__device__ __forceinline__ void p11_pool4(const Frame& F) {
    const int lane = lane_id();
    const bf16_t* HP = (const bf16_t*)(F.ws + A_HP); bf16_t* PP = (bf16_t*)(F.ws + A_PP);
    for (int qd = F.gw; qd < ML / 4; qd += F.NGW) { const int m0 = 4 * qd, t0 = m0 % T;
        pool_group4<0>(HP, PP, m0, t0, lane); pool_group4<1>(HP, PP, m0, t0, lane); pool_group4<2>(HP, PP, m0, t0, lane); pool_group4<3>(HP, PP, m0, t0, lane); }
}
__device__ __forceinline__ void p11_pool(const Frame& F) {
    const int lane = lane_id();
    const bf16_t* HP = (const bf16_t*)(F.ws + A_HP); bf16_t* PP = (bf16_t*)(F.ws + A_PP);
    for (int m = F.gw; m < ML; m += F.NGW) {
        const int t = m % T;
#pragma unroll
        for (int g = 0; g < 4; ++g) {
            constexpr int dummy = 0; (void)dummy;
            const int half = 1 << g, c = 8 * lane + 512 * g;
            float acc[8], ctr[8];
#pragma unroll
            for (int e = 0; e < 8; ++e) acc[e] = 0.f;
            int cnt = 0;
#pragma unroll
            for (int o = -8; o < 8; ++o) { if (o < -half || o >= half) continue;
                const int tt = t + o; const bool ok = tt >= 0 && tt < T; float v[8]; unpack8(*(const u32x4*)(HP + (size_t)(m + (ok ? o : 0)) * D + c), v);
                cnt += ok ? 1 : 0;
#pragma unroll
                for (int e = 0; e < 8; ++e) { acc[e] += ok ? v[e] : 0.f; if (o == 0) ctr[e] = v[e]; } }
            const float inv = 1.0f / (float)cnt;
            if (POOL_I8) { float pv[8]; float mx = 0.f;
#pragma unroll
                for (int e = 0; e < 8; ++e) { pv[e] = acc[e] * inv - ctr[e]; mx = fmaxf(mx, fabsf(pv[e])); }
            mx = wave_max(mx);
                mx = fmaxf(mx, 1e-30f); const float qs = 127.0f / mx;
                u32x2 w; w.x = pk4_i8(pv[0] * qs, pv[1] * qs, pv[2] * qs, pv[3] * qs); w.y = pk4_i8(pv[4] * qs, pv[5] * qs, pv[6] * qs, pv[7] * qs);
                *(u32x2*)((unsigned char*)PP + (size_t)m * D + c) = w;
                if (lane == 0) ((float*)(F.ws + WS_RSP))[(size_t)g * ML + m] = mx * (1.0f / 127.0f);
                continue; }
            u32x4 w; w.x = pk2(acc[0] * inv - ctr[0], acc[1] * inv - ctr[1]); w.y = pk2(acc[2] * inv - ctr[2], acc[3] * inv - ctr[3]);
            w.z = pk2(acc[4] * inv - ctr[4], acc[5] * inv - ctr[5]); w.w = pk2(acc[6] * inv - ctr[6], acc[7] * inv - ctr[7]);
            *(u32x4*)(PP + (size_t)m * D + c) = w;
        }
    }
}

__device__ __forceinline__ void p13_norm_router(const Frame& F, const Args& a) {
    const int lane = lane_id(), tid = F.wave * 64 + lane; (void)tid;
    LAS float* RT = (LAS float*)F.lds;
    LAS int* lcnt = (LAS int*)(F.lds + 65536);
    LAS int* le = (LAS int*)(F.lds + 65536 + 64);
    LAS int* lr = (LAS int*)(F.lds + 65536 + 64 + 256);
    for (int i = tid; i < D * NE; i += 512) RT[(i & 7) * D + (i >> 3)] = a.in[I_ROUTER][i];
    const float* MOD = (const float*)(F.ws + WS_MOD); float* XR = (float*)(F.ws + WS_XR);
    const float* MOD1 = MOD + (size_t)5 * MOD_N;
    const bf16_t* Y = (const bf16_t*)(F.ws + A_YP); void* H = (void*)(F.ws + A_H2B);
    const float* lnw = a.in[I_LNW] + 2 * D; const float* lnb = a.in[I_LNB] + 2 * D;
    int* TOKE = (int*)(F.ws + WS_TOK); int* TOKS = TOKE + 2 * ML; float* TOKP = (float*)(TOKE + 6 * ML);
    unsigned* gcnt = F.ctl + CW_GCNT;
    f32x4 lw[8], lb[8]; (void)lw; (void)lb;
    if (LN_HOIST) {
#pragma unroll
        for (int j = 0; j < 8; ++j) { const int c = 4 * lane + 256 * j; lw[j] = *(const f32x4*)(lnw + c); lb[j] = *(const f32x4*)(lnb + c); } }
    for (int rb = blockIdx.x; rb < ML / 32; rb += F.G) {
        __syncthreads();
        if (tid < 8) lcnt[tid] = 0;
        __syncthreads();
        for (int i = 0; i < 4; ++i) {
            const int rl = F.wave * 4 + i, m = rb * 32 + rl, b = m / T; const size_t o = (size_t)m * D;
            const float* g = MOD1 + 2 * D + (size_t)b * MOD_N;
            f32x4 z[8];
#pragma unroll
            for (int j = 0; j < 8; ++j) { const int c = 4 * lane + 256 * j; z[j] = xr_ld(XR, o + c) * ALPHA + *(const f32x4*)(g + c) * ld_bf4(Y + o + c); }
            if (LN_HOIST) ln_core_pre(z, lw, lb); else ln_core(lane, z, lnw, lnb);
            const float* sh = MOD1 + 3 * D + (size_t)b * MOD_N; const float* sc = MOD1 + 4 * D + (size_t)b * MOD_N;
            float lg[8];
#pragma unroll
            for (int e = 0; e < 8; ++e) lg[e] = 0.f;
#pragma unroll
            for (int j = 0; j < 8; ++j) { const int c = 4 * lane + 256 * j; xr_st(XR, o + c, z[j]);
                const f32x4 hv = z[j] * (*(const f32x4*)(sc + c) + 1.0f) + *(const f32x4*)(sh + c);
                st_h(H, o + c, hv, MOE_FP8 != 0);
#pragma unroll
                for (int e = 0; e < 8; ++e) { const f32x4 rt = *(const LAS f32x4*)(RT + e * D + c); lg[e] += (hv[0] * rt[0] + hv[1] * rt[1]) + (hv[2] * rt[2] + hv[3] * rt[3]); } }
#pragma unroll
            for (int e = 0; e < 8; ++e) lg[e] = wave_sum(lg[e]);
            int i0 = 0; float l0 = lg[0];
#pragma unroll
            for (int e = 1; e < 8; ++e) if (lg[e] > l0) { l0 = lg[e]; i0 = e; }
            int i1 = -1; float l1 = -3.0e38f;
#pragma unroll
            for (int e = 0; e < 8; ++e) if (e != i0 && lg[e] > l1) { l1 = lg[e]; i1 = e; }
            if (i1 < 0) { i1 = (i0 + 1) & 7; l1 = l0; }
            const float e1 = fexp(l1 - l0), p0 = 1.0f / (1.0f + e1), p1 = e1 / (1.0f + e1);
            if (lane == 0) { TOKE[2 * m] = i0; TOKE[2 * m + 1] = i1; TOKP[2 * m] = p0; TOKP[2 * m + 1] = p1;
                le[2 * rl] = i0; le[2 * rl + 1] = i1; lr[2 * rl] = __hip_atomic_fetch_add(&lcnt[i0], 1, __ATOMIC_RELAXED, __HIP_MEMORY_SCOPE_WORKGROUP); lr[2 * rl + 1] = __hip_atomic_fetch_add(&lcnt[i1], 1, __ATOMIC_RELAXED, __HIP_MEMORY_SCOPE_WORKGROUP); }
        }
        __syncthreads();
        if (tid < 8) lcnt[8 + tid] = (int)__hip_atomic_fetch_add(gcnt + 64 * tid, (unsigned)lcnt[tid], __ATOMIC_RELAXED, __HIP_MEMORY_SCOPE_AGENT);
        __syncthreads();
        if (tid < 64) TOKS[2 * (rb * 32) + tid] = lcnt[8 + le[tid]] + lr[tid];
    }
    __syncthreads();
}

struct MoeTab { int mt[8], ts[8], ntile; };
__device__ __forceinline__ MoeTab moe_tab(const Frame& F) {
    MoeTab t; int acc = 0;
#pragma unroll
    for (int e = 0; e < 8; ++e) { const int c = __builtin_amdgcn_readfirstlane((int)__hip_atomic_load(F.ctl + CW_GCNT + 64 * e, __ATOMIC_RELAXED, __HIP_MEMORY_SCOPE_AGENT)); t.mt[e] = (c + 255) >> 8; t.ts[e] = acc; acc += t.mt[e]; }
    t.ntile = acc; return t;
}
__device__ __forceinline__ void p14_gather(const Frame& F) {
    const int lane = lane_id(), tid = F.wave * 64 + lane; (void)tid;
    const MoeTab tb = moe_tab(F);
    const int* TOKE = (const int*)(F.ws + WS_TOK); const int* TOKS = TOKE + 2 * ML; int* TOKD = (int*)(TOKE + 4 * ML);
    const bf16_t* H = (const bf16_t*)(F.ws + A_H2B); bf16_t* HG = (bf16_t*)(F.ws + A_HG);
    for (int idx = F.gw; idx < 2 * ML; idx += F.NGW) {
        const int m = idx >> 1, e = TOKE[idx], sl = TOKS[idx]; int ts = 0;
#pragma unroll
        for (int k = 0; k < 8; ++k) ts = (e == k) ? tb.ts[k] : ts;
        const int dst = ts * 256 + sl;
        if (lane == 0) TOKD[idx] = dst;
        constexpr int RB = MOE_FP8 ? D : 2 * D;
        const u32x4* s = (const u32x4*)((const unsigned char*)H + (size_t)m * RB) + lane; u32x4* dd = (u32x4*)((unsigned char*)HG + (size_t)dst * RB) + lane;
        const u32x4 v0 = s[0], v1 = s[64]; dd[0] = v0; dd[64] = v1;
        if (!MOE_FP8) { const u32x4 v2 = s[128], v3 = s[192]; dd[128] = v2; dd[192] = v3; }
    }
}
__device__ __forceinline__ void p17_final(const Frame& F, const Args& a) {
    const int lane = lane_id(), tid = F.wave * 64 + lane; (void)tid;
    const float* MOD1 = (const float*)(F.ws + WS_MOD) + (size_t)5 * MOD_N; const float* XR = (const float*)(F.ws + WS_XR);
    const int* TOKD = (const int*)(F.ws + WS_TOK) + 4 * ML; const float* TOKP = (const float*)((const int*)(F.ws + WS_TOK) + 6 * ML);
    const bf16_t* Y2 = (const bf16_t*)(F.ws + A_Y2); const float* PART = (const float*)(F.ws + WS_PART);
    const int xrow = (MOE_FP8 && F.G == 256) ? MOE_RT * 256 : 0x7fffffff;
    const float* lnw = a.in[I_LNW] + 3 * D; const float* lnb = a.in[I_LNB] + 3 * D;
    f32x4 lw[8], lb[8]; (void)lw; (void)lb;
    if (LN_HOIST) {
#pragma unroll
        for (int j = 0; j < 8; ++j) { const int c = 4 * lane + 256 * j; lw[j] = *(const f32x4*)(lnw + c); lb[j] = *(const f32x4*)(lnb + c); } }
    for (int m = F.gw; m < ML; m += F.NGW) {
        const int b = m / T; const float* g = MOD1 + 5 * D + (size_t)b * MOD_N; const size_t o = (size_t)m * D;
        const int d0 = TOKD[2 * m], d1 = TOKD[2 * m + 1]; const float p0 = TOKP[2 * m], p1 = TOKP[2 * m + 1];
        f32x4 z[8];
#pragma unroll
        for (int j = 0; j < 8; ++j) { const int c = 4 * lane + 256 * j;
            f32x4 y0, y1;
            if (d0 >= xrow) { const float* pp = PART + (size_t)(d0 - xrow) * D + c; y0 = *(const f32x4*)pp;
#pragma unroll
                for (int ks = 1; ks < MOE_KS; ++ks) y0 += *(const f32x4*)(pp + (size_t)ks * 2048 * D); } else y0 = ld_bf4(Y2 + (size_t)d0 * D + c);
            if (d1 >= xrow) { const float* pp = PART + (size_t)(d1 - xrow) * D + c; y1 = *(const f32x4*)pp;
#pragma unroll
                for (int ks = 1; ks < MOE_KS; ++ks) y1 += *(const f32x4*)(pp + (size_t)ks * 2048 * D); } else y1 = ld_bf4(Y2 + (size_t)d1 * D + c);
            const f32x4 y = y0 * p0 + y1 * p1;
            z[j] = xr_ld(XR, o + c) * ALPHA + *(const f32x4*)(g + c) * y; }
        if (LN_HOIST) ln_core_pre(z, lw, lb); else ln_core(lane, z, lnw, lnb);
#if defined(PROBE_STAMP)
        { const float us_ = 0.01f * (float)__hip_atomic_load(F.ctl + 24576, __ATOMIC_RELAXED, __HIP_MEMORY_SCOPE_AGENT); const float sc_ = 1.0f + us_ * (1.0f / 2000.0f);
#pragma unroll
          for (int j = 0; j < 8; ++j) z[j] = z[j] * sc_; }
#endif
#if defined(PROBE_SCANCHK)
        { const float n1 = __hip_atomic_load((float*)(F.ctl + CW_CHK), __ATOMIC_RELAXED, __HIP_MEMORY_SCOPE_AGENT), d1 = __hip_atomic_load((float*)(F.ctl + CW_CHK + 64), __ATOMIC_RELAXED, __HIP_MEMORY_SCOPE_AGENT);
          const float n2 = __hip_atomic_load((float*)(F.ctl + CW_CHK + 128), __ATOMIC_RELAXED, __HIP_MEMORY_SCOPE_AGENT), d2 = __hip_atomic_load((float*)(F.ctl + CW_CHK + 192), __ATOMIC_RELAXED, __HIP_MEMORY_SCOPE_AGENT);
          const float eps = sqrtf(n1 / d1) + sqrtf(n2 / d2), sc = 1.0f + 10.0f * eps;
#pragma unroll
          for (int j = 0; j < 8; ++j) z[j] = z[j] * sc; }
#endif
#pragma unroll
        for (int j = 0; j < 8; ++j) { const int c = 4 * lane + 256 * j; *(f32x4*)(a.out + o + c) = z[j]; }
    }
}

struct SchedBase { __device__ __forceinline__ void a_ready(const pg8::Unit&) const {} __device__ __forceinline__ void done(const pg8::Unit&) const {} };
struct SchedDense : SchedBase {
    const char* A; const char* B; bf16_t* O; const float* bias; int nM, nN, ldaB, ldbB, ldc, act, G, c; const float* rs = nullptr;
    __device__ __forceinline__ bool next(int i, pg8::Unit& u) const {
        const int L = i * G + c; if (L >= nM * nN) return false; u.rs = rs;
        int pm, pn; pg8::tile_of(L, nM, nN, pm, pn);
        u.A = A + (size_t)pm * 256 * ldaB; u.B = B + (size_t)pn * 256 * ldbB; u.O = O; u.bias = bias; u.pm = pm; u.pn = pn; u.ldc = ldc; u.act = act; return true;
    }
};
struct SchedP2 : SchedBase {
    unsigned char* ws; int G, c, lo = 0, hi = 936, coff = 0;
    __device__ __forceinline__ bool next(int i, pg8::Unit& u) const {
        if (c < coff) return false;
        int L = lo + i * G + (c - coff); if (L >= hi) return false;
        int mix, nM, nN, act, ldc; size_t wo, oo;
        if (L < 256)      { mix = 0; nM = 32; nN = 8; act = pg8::ACT_NONE;    wo = W_WR;  oo = A_R;   ldc = D; }
        else if (L < 544) { L -= 256; mix = 2; nM = 36; nN = 8; act = pg8::ACT_NONE; wo = W_WK;  oo = A_KX;  ldc = D; }
        else if (L < 832) { L -= 544; mix = 3; nM = 36; nN = 8; act = pg8::ACT_NONE; wo = W_WV;  oo = A_V;   ldc = D; }
        else if (L < 868) { L -= 832; mix = 1; nM = 36; nN = 1; act = pg8::ACT_TANH; wo = W_WLD; oo = A_LW;  ldc = 256; }
        else if (L < 904) { L -= 868; mix = 4; nM = 36; nN = 1; act = pg8::ACT_NONE; wo = W_ALD; oo = A_LA;  ldc = 256; }
        else              { L -= 904; mix = 5; nM = 32; nN = 1; act = pg8::ACT_SIGMOID; wo = W_G1; oo = A_G1O; ldc = 256; }
        int pm, pn; pg8::tile_of(L, nM, nN, pm, pn);
        const bool i8 = RKV_I8 && (LORA_I8 || mix == 0 || mix == 2 || mix == 3); const size_t eb = i8 ? 1 : 2;
        u.A = (const char*)ws + A_A6 + (size_t)mix * A6_STRIDE + (size_t)pm * 256 * D * eb; u.B = (const char*)ws + wo + (size_t)pn * 256 * D * eb;
        u.O = (bf16_t*)(ws + oo); u.bias = nullptr; u.pm = pm; u.pn = pn; u.ldc = ldc; u.act = act;
        if (i8) { u.rs = (const float*)(ws + WS_RS6) + (size_t)mix * MT;
            if (mix == 0 || mix == 2 || mix == 3) u.bias = (const float*)(ws + WS_CTL) + CW_CMAX2 + (mix == 0 ? 0 : mix - 1) * D;
            else u.bias = (const float*)(ws + WS_CML) + (mix == 1 ? 0 : mix - 3) * 256; }
        return true;
    }
};
struct SchedP3 : SchedBase {
    unsigned char* ws; const float* dw0; const float* ia0; int G, c, lo = 0, hi = 1408, kskip = 0;
    __device__ __forceinline__ bool next(int i, pg8::Unit& u) const {
        int L = lo + i * G + c; if (L >= hi) return false;
        int nM, nN, act, ldc; size_t ao, wo, oo; const float* bias;
        if (L < 576)       { nM = 36; nN = 16; act = pg8::ACT_EW; ao = A_LW; wo = W_WLU; oo = A_EW; ldc = 2 * D; bias = dw0; }
        else if (L < 1152) { L -= 576; nM = 36; nN = 16; act = pg8::ACT_BIAS_SIGMOID; ao = A_LA; wo = W_ALU; oo = A_AA; ldc = 2 * D; bias = ia0; }
        else               { L -= 1152; nM = 32; nN = 8; act = pg8::ACT_NONE; ao = A_G1O; wo = W_G2; oo = A_GATE; ldc = D; bias = nullptr; }
        int pm, pn; pg8::tile_of(L, nM, nN, pm, pn);
        const size_t k0 = (kskip && nN == 16 && pn >= 8) ? 64 * 2 : 0;
        u.A = (const char*)ws + ao + (size_t)pm * 256 * 256 * 2 + k0; u.B = (const char*)ws + wo + (size_t)pn * 256 * 256 * 2 + k0;
        u.O = (bf16_t*)(ws + oo); u.bias = bias; u.pm = pm; u.pn = pn; u.ldc = ldc; u.act = act; return true;
    }
};
struct SchedPool : SchedBase {
    unsigned char* ws; const float* scale; int G, c;
    __device__ __forceinline__ bool next(int i, pg8::Unit& u) const {
        const int L = i * G + c; if (L >= 256) return false;
        int pm, pn; pg8::tile_of(L, 32, 8, pm, pn);
        u.A = (const char*)ws + A_PP + ((size_t)pm * 256 * D + (size_t)(pn >> 1) * 512) * (POOL_I8 ? 1 : 2); u.B = (const char*)ws + W_PW + (size_t)pn * 256 * 512 * (POOL_I8 ? 1 : 2);
        u.O = (bf16_t*)(ws + A_YP); u.bias = scale; u.pm = pm; u.pn = pn; u.ldc = D; u.act = pg8::ACT_COLSCALE;
        if (POOL_I8) { u.act = pg8::ACT_NONE; u.rs = (const float*)(ws + WS_RSP) + (size_t)(pn >> 1) * ML; u.bias = (const float*)(ws + WS_CTL) + CW_CMAX4; }
        return true;
    }
};
struct SchedMoe : SchedBase {
    MoeTab tb; const char* A; const char* B; bf16_t* O; int NT, ldaB, ldbB, ldc; size_t estride; int NL, x, rank, W, mblock;
    __device__ __forceinline__ void init(int G, int c) { NL = (G % 8 == 0) ? 8 : 1; x = c % NL; rank = c / NL; W = G / NL; }
    __device__ __forceinline__ bool next(int i, pg8::Unit& u) const {
        int j = rank + i * W; int e = -1, nt, mtile;
        if (mblock) {
            const int S = (tb.ntile + NL - 1) / NL; mtile = x * S + j / NT; nt = j % NT;
            if (j >= S * NT || mtile >= tb.ntile) return false;
#pragma unroll
            for (int k = 0; k < 8; ++k) e = (mtile >= tb.ts[k] && mtile < tb.ts[k] + tb.mt[k]) ? k : e;
            if (e < 0) return false;
        } else {
            const int nn = (NT - x + NL - 1) / NL; int mte = 1, tse = 0;
#pragma unroll
            for (int k = 0; k < 8; ++k) { const int blk = nn * tb.mt[k]; if (e < 0) { if (j < blk) { e = k; mte = tb.mt[k]; tse = tb.ts[k]; } else j -= blk; } }
            if (e < 0) return false;
            nt = x + NL * (j / mte); mtile = tse + (j % mte);
        }
        u.A = A + (size_t)mtile * 256 * ldaB; u.B = B + (size_t)e * estride + (size_t)nt * 256 * ldbB; u.O = O; u.bias = nullptr; u.pm = mtile; u.pn = nt; u.ldc = ldc; u.act = pg8::ACT_NONE; return true;
    }
};

__device__ __forceinline__ MoeTab moe_tab_trunc(const MoeTab& t, int rt) { MoeTab o; int left = rt, acc = 0;
#pragma unroll
    for (int e = 0; e < 8; ++e) { const int m = t.mt[e] < left ? t.mt[e] : left; o.mt[e] = m; o.ts[e] = t.ts[e]; left -= m; acc += m; }
    o.ntile = acc; return o; }
struct SchedMoeX : SchedBase {
    MoeTab tb; const char* A; const char* B; float* P; int rt, ldaB, ldbB, G, c; size_t estride;
    __device__ __forceinline__ bool next(int i, pg8::Unit& u) const {
        const int j = i * G + c, nsub = (tb.ntile - rt) * 8 * MOE_KS; if (j >= nsub) return false;
        const int ks = j % MOE_KS, r = j / MOE_KS, nt = r & 7, mtile = rt + (r >> 3); int e = 0;
#pragma unroll
        for (int k = 0; k < 8; ++k) e = (mtile >= tb.ts[k] && mtile < tb.ts[k] + tb.mt[k]) ? k : e;
        const int kb = ks * (DFE / MOE_KS);
        u.A = A + (size_t)mtile * 256 * ldaB + kb; u.B = B + (size_t)e * estride + (size_t)nt * 256 * ldbB + kb;
        u.O = (bf16_t*)(P + (size_t)ks * 2048 * D); u.bias = nullptr; u.pm = mtile - rt; u.pn = nt; u.ldc = D; u.act = 0; return true;
    }
};
constexpr int NPHASE = 18;
#ifndef CONV_P2
#define CONV_P2 4096
#endif
#ifndef CONV_P8
#define CONV_P8 (TN_F2 + 3840)
#endif
#if defined(SCAN_NOCONV)
#define CONV_SCAN 0
#elif !defined(CONV_SCAN)
#define CONV_SCAN (MOE_FP8 ? 18432 : 36864)
#endif
#ifndef CONV_P15
#define CONV_P15 0
#endif
#ifndef NC_P15
#define NC_P15 224
#endif
constexpr int TI_C15 = TI_MW2 - CONV_P15;
#ifndef CONV_P3
#define CONV_P3 0
#endif
constexpr int NC_P3 = 235;
#ifndef NC_P8
#define NC_P8 235
#endif
#ifndef NC_P2
#define NC_P2 234
#endif
constexpr int TI_X1 = TI_C15 - (CONV_P8 - TN_F2), TI_X0 = TI_X1 - CONV_P2, TI_W0 = TI_X0 - CONV_SCAN, TI_V0 = TI_W0 - CONV_P3;
__global__ void __launch_bounds__(512, 2) trunk_fwd(Args args) {
    extern __shared__ __attribute__((aligned(16))) unsigned char lds_raw[];
    Frame F;
    F.lds = (LAS unsigned char*)lds_raw;
    F.wave = __builtin_amdgcn_readfirstlane((int)(threadIdx.x >> 6));
    F.G = gridDim.x; { const int bx = blockIdx.x; F.vcu = (F.G % 8 == 0) ? (bx % 8) * (F.G / 8) + bx / 8 : bx; }
    F.gw = F.vcu * 8 + F.wave; F.NGW = F.G * 8;
    F.ws = args.ws; F.ctl = (unsigned*)(args.ws + WS_CTL);
    volatile LAS unsigned* MISC = (volatile LAS unsigned*)(F.lds + MISC_OFF);
    if (threadIdx.x < 32) MISC[threadIdx.x] = 0u;
    __syncthreads();
    XcdBarrier bar; bar.bar = F.ctl + CW_BAR + args.li * XCD_BAR_WORDS; bar.x = 0; bar.st = nullptr;
    if (MK_N_LAUNCHES == 1) bar = xcd_barrier_post(F.ctl + CW_BAR + args.li * XCD_BAR_WORDS, MISC + 8);
    const int lo = args.ph_lo, hi = args.ph_hi;
#define IN(k) (lo <= (k) && (k) < hi)
#if defined(PROBE_BAR2)
#define SEAM(k) do { if (IN(k) && IN((k) + 1)) { xcd_barrier(bar); xcd_barrier(bar); } } while (0)
#else
#define SEAM(k) do { if (IN(k) && IN((k) + 1)) xcd_barrier(bar); } while (0)
#endif
    constexpr bool AL = true, SP = true;
#ifndef ALIGN_I8
#define ALIGN_I8 1
#endif
    constexpr bool AL_I8 = ALIGN_I8 != 0;
#ifndef ALIGN_P15
#define ALIGN_P15 1
#endif
    constexpr bool AL_P15 = ALIGN_P15 != 0;
#if defined(PROBE_STAMP)
#define STAMP(k) do { if (blockIdx.x == 0 && threadIdx.x == 0) { const unsigned now_ = (unsigned)__builtin_amdgcn_s_memrealtime(); if ((k) > 0 && ((PROBE_STAMP >> ((k) - 1)) & 1)) MISC[17] += now_ - MISC[16]; MISC[16] = now_; } } while (0)
#else
#define STAMP(k) do { } while (0)
#endif

    STAMP(0);
    if (IN(0)) {
        if (MOD_V2 && F.G == 256) p0_mod2(F, args); else p0_mod(F, args);
        if (!CMAX_LAST) p0_pos(F);
        p0_small(F, args);
#if defined(PROBE_READ)
        probe_read(F, args);
#endif
#if defined(PROBE_P0A)
        p0_mod(F, args); p0_pos(F); p0_small(F, args);
#endif
        if (FFN_I8) { if (!CMAX_LAST) p0_cmax(F, args);
            p0_transpose_range(F, args, RKV_I8 ? (WO_I8 ? TI_RWKV : TI_RKV3) : 0, TI_RWKV, F.gw, F.NGW, (LAS unsigned*)(F.lds + 53248 + F.wave * 8448));
            p0_transpose_range(F, args, POOL_I8 ? TI_POOL : TI_F3, F.G == 256 ? TI_V0 : (FFN_DN_I8 ? TI_MW2 : TI_M2), F.gw, F.NGW, (LAS unsigned*)(F.lds + 53248 + F.wave * 8448));
            if (CMAX_LAST) { p0_cmax(F, args); p0_pos(F); } }
        else p0_transpose_range(F, args, 0, F.G == 256 ? TI_V0 : (FFN_DN_I8 ? TI_MW2 : TI_M2), F.gw, F.NGW, (LAS unsigned*)(F.lds + 53248 + F.wave * 8448));
    }
    SEAM(0);
    STAMP(1);
    if (IN(1)) { if (POOL_I8) p0_transpose_range<true>(F, args, TI_F3, TI_POOL, F.gw, F.NGW, (LAS unsigned*)(F.lds + 53248 + F.wave * 8448));
        if (RKV_I8) p0_transpose_range<true>(F, args, 0, WO_I8 ? TI_RWKV + F13_P1_N : TI_RKV3, F.gw, F.NGW, (LAS unsigned*)(F.lds + 53248 + F.wave * 8448)); p1_mix(F, args); }
    SEAM(1);
    STAMP(2);
    if (IN(2)) {
        const bool split = F.G == 256;
        if (FFN_I8 && !split) p0_transpose_range<true>(F, args, TI_RWKV + (WO_I8 ? F13_P1_N : 0), TI_F3, F.gw, F.NGW, (LAS unsigned*)(F.lds + 53248 + F.wave * 8448));
        if (split && (int)blockIdx.x >= NC_P2) {
            if (FFN_I8) p0_transpose_range<true>(F, args, TI_RWKV + (WO_I8 ? F13_P1_N : 0), TI_F3, ((int)blockIdx.x - NC_P2) * 8 + F.wave, (256 - NC_P2) * 8, (LAS unsigned*)(F.lds + 53248 + F.wave * 8448));
            p0_transpose_range(F, args, TI_X0, TI_X1, ((int)blockIdx.x - NC_P2) * 8 + F.wave, (256 - NC_P2) * 8, (LAS unsigned*)(F.lds + 53248 + F.wave * 8448)); }
        else if (RKV_I8 && LORA_I8) { SchedP2 S; S.ws = F.ws; S.G = split ? NC_P2 : F.G; S.c = blockIdx.x;
            pg8::gemm_phase<pg8::EpiActI8, SchedP2, AL_I8, SP, 2>(F.lds, pg8::Shape{D, D, D / 128, 0}, S, pg8::EpiActI8{}); }
        else if (RKV_I8) { SchedP2 S; S.ws = F.ws; S.G = split ? NC_P2 : F.G; S.c = blockIdx.x; S.hi = 832;
            pg8::gemm_phase<pg8::EpiActI8, SchedP2, AL_I8, SP, 2>(F.lds, pg8::Shape{D, D, D / 128, 0}, S, pg8::EpiActI8{});
            SchedP2 S2; S2.ws = F.ws; S2.c = blockIdx.x; S2.lo = 832; if (split) { S2.G = 104; S2.coff = 130; } else S2.G = F.G;
            pg8::gemm_phase<pg8::EpiAct, SchedP2, AL, SP>(F.lds, pg8::shape_bf16(D, D, D), S2, pg8::EpiAct{}); }
        else { SchedP2 S; S.ws = F.ws; S.G = split ? NC_P2 : F.G; S.c = blockIdx.x; pg8::gemm_phase<pg8::EpiAct, SchedP2, AL, SP>(F.lds, pg8::shape_bf16(D, D, D), S, pg8::EpiAct{}); }
    }
    SEAM(2);
    STAMP(3);
    if (IN(3) && CONV_P3 > 0 && F.G == 256 && (int)blockIdx.x >= NC_P3) p0_transpose_range(F, args, TI_V0, TI_W0, ((int)blockIdx.x - NC_P3) * 8 + F.wave, (256 - NC_P3) * 8, (LAS unsigned*)(F.lds + 53248 + F.wave * 8448));
    else if (IN(3)) { SchedP3 S; S.ws = F.ws; S.dw0 = args.in[I_DW0]; S.ia0 = args.in[I_IA0]; S.G = (CONV_P3 > 0 && F.G == 256) ? NC_P3 : F.G; S.c = blockIdx.x;
#ifndef P3_KSKIP
#define P3_KSKIP 0
#endif
        if (P3_KSKIP) { S.hi = 1152; S.kskip = 1; pg8::gemm_phase<pg8::EpiAct, SchedP3, AL, SP>(F.lds, pg8::shape_bf16(256, 256, 128), S, pg8::EpiAct{});
            SchedP3 S2 = S; S2.lo = 1152; S2.hi = 1408; S2.kskip = 0; pg8::gemm_phase<pg8::EpiAct, SchedP3, AL, SP>(F.lds, pg8::shape_bf16(256, 256, 256), S2, pg8::EpiAct{}); }
        else pg8::gemm_phase<pg8::EpiAct, SchedP3, AL, SP>(F.lds, pg8::shape_bf16(256, 256, 256), S, pg8::EpiAct{}); }
    SEAM(3);
    STAMP(4);
#if defined(PROBE_SCANCHK)
    if (IN(4)) { p4_scan(F, args); p4_scan2(F, args, F.ws + A_AO, (float*)(F.ws + WS_A + 644 * MiB)); xcd_barrier(bar); p4_compare(F); }
#elif defined(SCAN_STEP)
    if (IN(4)) p4_scan(F, args);
#else
#if defined(SCAN_CONV)
    if (IN(4)) { if (F.G == 256) p4_scan3(F, args, F.ws + A_YD, (float*)(F.ws + WS_SB), TI_W0, TI_X0); else p4_scan2(F, args, F.ws + A_YD, (float*)(F.ws + WS_SB)); }
#elif defined(SCAN_NOCONV)
    if (IN(4)) { if (F.G == 256) p4_scan4(F, args, F.ws + A_YD, (float*)(F.ws + WS_SB)); else p4_scan2(F, args, F.ws + A_YD, (float*)(F.ws + WS_SB)); }
#else
#ifndef SCAN_SPLIT
#define SCAN_SPLIT 0
#endif
    if (IN(4) && SCAN_SPLIT && F.G == 256) {
        if ((int)blockIdx.x < 128) { p4_scan5(F, args, F.ws + A_YD, (float*)(F.ws + WS_SB), 0, 0, (int)blockIdx.x); p4_scan5(F, args, F.ws + A_YD, (float*)(F.ws + WS_SB), 0, 0, (int)blockIdx.x + 128); }
        else p0_transpose_range(F, args, TI_W0, TI_X0, ((int)blockIdx.x - 128) * 8 + F.wave, 128 * 8, (LAS unsigned*)(F.lds + 53248 + F.wave * 8448));
    } else
    if (IN(4)) { if (F.G == 256) p4_scan5(F, args, F.ws + A_YD, (float*)(F.ws + WS_SB), TI_W0, TI_X0); else p4_scan2(F, args, F.ws + A_YD, (float*)(F.ws + WS_SB)); }
#endif
#endif
    SEAM(4);
    STAMP(5);
    if (IN(5)) p5_ao(F, args);
    SEAM(5);
    STAMP(6);
    if (IN(6)) { SchedDense S; S.A = (const char*)F.ws + A_AO; S.B = (const char*)F.ws + W_WO; S.O = (bf16_t*)(F.ws + A_YO); S.bias = nullptr; S.nM = 32; S.nN = 8; S.ldaB = 2 * D; S.ldbB = 2 * D; S.ldc = D; S.act = pg8::ACT_NONE; S.G = F.G; S.c = blockIdx.x;
        if (LN_FUSE && F.G == 256) { const float* MOD = (const float*)(F.ws + WS_MOD);
            pg8::EpiLnMod E{args.in[I_X], (const float*)(F.ws + WS_POS), MOD + 2 * D, args.in[I_LNW], args.in[I_LNB], MOD + 4 * D, MOD + 3 * D, (float*)(F.ws + WS_XR), (bf16_t*)(F.ws + A_H2),
                            pg8::PanelStats8{(unsigned*)(F.ws + WS_XB1), F.ctl + CW_LN1, F.ctl, 0x700u}};
            pg8::gemm_phase<pg8::EpiLnMod, SchedDense, AL, SP>(F.lds, pg8::shape_bf16(D, D, D), S, E); }
        else if (WO_I8) { S.ldaB = D; S.ldbB = D; S.rs = (const float*)(F.ws + WS_RSO); S.bias = (const float*)(F.ws + WS_CTL) + CW_CMAX2 + 3 * D;
            pg8::gemm_phase<pg8::EpiActI8, SchedDense, AL, SP, 2>(F.lds, pg8::Shape{D, D, D / 128, 0}, S, pg8::EpiActI8{}); }
        else pg8::gemm_phase<pg8::EpiAct, SchedDense, AL, SP>(F.lds, pg8::shape_bf16(D, D, D), S, pg8::EpiAct{}); }
    SEAM(6);
    STAMP(7);
    if (IN(7) && !(LN_FUSE && F.G == 256)) { const float* MOD = (const float*)(F.ws + WS_MOD); post_norm_rows(F, args, (const bf16_t*)(F.ws + A_YO), 2 * D, 0, MOD, 3 * D, 4 * D, (void*)(F.ws + A_H2), FFN_I8 ? 2 : (FFN_FP8 != 0), true); }
    if (!(LN_FUSE && F.G == 256)) SEAM(7);
    STAMP(8);
    if (IN(8)) {
        const bool split = F.G == 256;
        if (FFN_DN_I8 && !split) p0_transpose_range<true>(F, args, TI_MW2, TI_M2, F.gw, F.NGW, (LAS unsigned*)(F.lds + 53248 + F.wave * 8448));
        if (split && (int)blockIdx.x >= NC_P8) { p0_transpose_range<FFN_DN_I8 != 0>(F, args, TI_MW2, TI_M2, ((int)blockIdx.x - NC_P8) * 8 + F.wave, (256 - NC_P8) * 8, (LAS unsigned*)(F.lds + 53248 + F.wave * 8448));
            p0_transpose_range(F, args, TI_X1, TI_C15, ((int)blockIdx.x - NC_P8) * 8 + F.wave, (256 - NC_P8) * 8, (LAS unsigned*)(F.lds + 53248 + F.wave * 8448)); }
        else { SchedDense S; S.A = (const char*)F.ws + A_H2; S.B = (const char*)F.ws + W_F13; S.O = (bf16_t*)(F.ws + A_U); S.bias = nullptr; S.nM = 32; S.nN = 44; S.ldaB = (FFN_FP8 || FFN_I8) ? D : 2 * D; S.ldbB = S.ldaB; S.ldc = LDU; S.act = 0; S.G = split ? NC_P8 : F.G; S.c = blockIdx.x;
        if (FFN_I8 && FFN_D8) pg8::gemm_phase<pg8::EpiSwigluI8T<true>, SchedDense, AL_I8, SP, 2>(F.lds, pg8::Shape{D, D, D / 128, 0}, S, pg8::EpiSwigluI8T<true>{(const float*)(F.ws + WS_RS), F.ctl + CW_CMAX, DFF});
        else if (FFN_I8) pg8::gemm_phase<pg8::EpiSwigluI8, SchedDense, AL_I8, SP, 2>(F.lds, pg8::Shape{D, D, D / 128, 0}, S, pg8::EpiSwigluI8{(const float*)(F.ws + WS_RS), F.ctl + CW_CMAX, DFF});
        else if (FFN_FP8) pg8::gemm_phase<pg8::EpiSwiglu8, SchedDense, AL, SP, true>(F.lds, pg8::shape_fp8(D, D, D, 4, 6), S, pg8::EpiSwiglu8{});
        else if (FFN_DN8) pg8::gemm_phase<pg8::EpiSwiglu8, SchedDense, AL, SP>(F.lds, pg8::shape_bf16(D, D, D), S, pg8::EpiSwiglu8{});
        else pg8::gemm_phase<pg8::EpiSwiglu, SchedDense, AL, SP>(F.lds, pg8::shape_bf16(D, D, D), S, pg8::EpiSwiglu{}); } }
    SEAM(8);
    STAMP(9);
    if (IN(9)) { SchedDense S; S.A = (const char*)F.ws + A_U; S.B = (const char*)F.ws + W_F2P; S.O = (bf16_t*)(F.ws + A_YF); S.bias = nullptr; S.nM = 32; S.nN = 8; S.ldaB = FFN_D8 ? LDU : 2 * LDU; S.ldbB = FFN_D8 ? LDF2 : 2 * LDF2; S.ldc = D; S.act = pg8::ACT_NONE; S.G = F.G; S.c = blockIdx.x;
        if (FFN_DN_I8) { p9_quant_u(F); xcd_barrier(bar);
            S.ldaB = 2 * LDU; S.ldbB = LDF2; S.rs = (const float*)(F.ws + WS_RSU); S.bias = (const float*)(F.ws + WS_CTL) + CW_CMAX3;
            pg8::gemm_phase<pg8::EpiActI8, SchedDense, AL, SP, 2>(F.lds, pg8::Shape{2 * LDU, LDF2, DFF / 128, 0}, S, pg8::EpiActI8{}); }
        else if (FFN_D8) pg8::gemm_phase<pg8::EpiAct, SchedDense, AL, SP, true>(F.lds, pg8::shape_fp8(LDU, LDF2, DFF, 3, 8), S, pg8::EpiAct{});
        else if (LN_FUSE && F.G == 256) { const float* MOD = (const float*)(F.ws + WS_MOD); const float* MOD1 = MOD + (size_t)5 * MOD_N;
            pg8::EpiLnMod E{(const float*)(F.ws + WS_XR), nullptr, MOD + 5 * D, args.in[I_LNW] + D, args.in[I_LNB] + D, MOD1 + D, MOD1, (float*)(F.ws + WS_XR), (bf16_t*)(F.ws + A_HP),
                            pg8::PanelStats8{(unsigned*)(F.ws + WS_XB2), F.ctl + CW_LN2, F.ctl, 0x740u}};
            pg8::gemm_phase<pg8::EpiLnMod, SchedDense, AL, SP>(F.lds, pg8::shape_bf16(LDU, LDF2, DFF), S, E); }
        else pg8::gemm_phase<pg8::EpiAct, SchedDense, AL, SP>(F.lds, pg8::shape_bf16(LDU, LDF2, DFF), S, pg8::EpiAct{}); }
    SEAM(9);
    STAMP(10);
    if (IN(10) && !(LN_FUSE && F.G == 256)) { const float* MOD = (const float*)(F.ws + WS_MOD); post_norm_rows(F, args, (const bf16_t*)(F.ws + A_YF), 5 * D, 1, MOD + (size_t)5 * MOD_N, 0, D, (void*)(F.ws + A_HP), false, false); }
    if (!(LN_FUSE && F.G == 256)) SEAM(10);
    STAMP(11);
    if (IN(11)) { if (POOL_SLIDE && !POOL_I8) p11_pool4(F); else p11_pool(F); }
    SEAM(11);
    STAMP(12);
    if (IN(12)) { SchedPool S; S.ws = F.ws; S.scale = args.in[I_POOLS]; S.G = F.G; S.c = blockIdx.x;
        if (POOL_I8) { pg8::EpiActI8 E; E.colmul = args.in[I_POOLS]; pg8::gemm_phase<pg8::EpiActI8, SchedPool, AL, SP, 2>(F.lds, pg8::Shape{D, 512, 512 / 128, 0}, S, E); }
        else pg8::gemm_phase<pg8::EpiAct, SchedPool, AL, SP>(F.lds, pg8::shape_bf16(D, 512, 512), S, pg8::EpiAct{}); }
    SEAM(12);
    STAMP(13);
    if (IN(13)) p13_norm_router(F, args);
    SEAM(13);
    STAMP(14);
    if (IN(14)) p14_gather(F);
    SEAM(14);
    STAMP(15);
    if (IN(15) && CONV_P15 > 0 && F.G == 256 && (int)blockIdx.x >= NC_P15) p0_transpose_range(F, args, TI_C15, TI_MW2, ((int)blockIdx.x - NC_P15) * 8 + F.wave, (256 - NC_P15) * 8, (LAS unsigned*)(F.lds + 53248 + F.wave * 8448));
    else if (IN(15)) { SchedMoe S; S.tb = moe_tab(F); S.A = (const char*)F.ws + A_HG; S.B = (const char*)F.ws + W_M13; S.O = (bf16_t*)(F.ws + A_UG); S.NT = 56; S.mblock = 0; S.ldaB = MOE_FP8 ? D : 2 * D; S.ldbB = S.ldaB; S.ldc = LDUG; S.estride = (size_t)2 * DFE * S.ldbB; S.init((CONV_P15 > 0 && F.G == 256) ? NC_P15 : F.G, blockIdx.x);
        if (MOE_FP8) pg8::gemm_phase<pg8::EpiSwiglu8, SchedMoe, AL_P15, SP, true, MOE_AUX_UP>(F.lds, pg8::shape_fp8(D, D, D, 4, 6), S, pg8::EpiSwiglu8{});
        else pg8::gemm_phase<pg8::EpiSwiglu, SchedMoe, AL, SP>(F.lds, pg8::shape_bf16(D, D, D), S, pg8::EpiSwiglu{}); }
    SEAM(15);
    STAMP(16);
    if (IN(16)) { SchedMoe S; const MoeTab full = moe_tab(F); const bool splitk = MOE_FP8 && F.G == 256 && full.ntile > MOE_RT;
        S.tb = splitk ? moe_tab_trunc(full, MOE_RT) : full; S.A = (const char*)F.ws + A_UG; S.B = (const char*)F.ws + W_M2; S.O = (bf16_t*)(F.ws + A_Y2); S.NT = 8; S.mblock = 1; S.ldaB = MOE_FP8 ? LDUG : 2 * LDUG; S.ldbB = MOE_FP8 ? LDM2 : 2 * LDM2; S.ldc = D; S.estride = (size_t)D * S.ldbB; S.init(F.G, blockIdx.x);
        if (MOE_FP8) pg8::gemm_phase<pg8::EpiAct, SchedMoe, AL, SP, true, MOE_AUX_DN>(F.lds, pg8::shape_fp8(LDUG, LDM2, DFE, 3, 8), S, pg8::EpiAct{});
        else pg8::gemm_phase<pg8::EpiAct, SchedMoe, AL, SP>(F.lds, pg8::shape_bf16(LDUG, LDM2, DFE), S, pg8::EpiAct{});
        if (splitk) { SchedMoeX X; X.tb = full; X.A = S.A; X.B = S.B; X.P = (float*)(F.ws + WS_PART); X.rt = MOE_RT; X.ldaB = LDUG; X.ldbB = LDM2; X.G = F.G; X.c = blockIdx.x; X.estride = S.estride;
            pg8::gemm_phase<pg8::EpiF32P, SchedMoeX, AL, SP, true>(F.lds, pg8::shape_fp8(LDUG, LDM2, DFE / MOE_KS, 3, 8), X, pg8::EpiF32P{}); } }
    STAMP(17);
#if defined(PROBE_STAMP)
    if (blockIdx.x == 0 && threadIdx.x == 0) __hip_atomic_store(F.ctl + 24576, MISC[17], __ATOMIC_RELAXED, __HIP_MEMORY_SCOPE_AGENT);
#endif
    SEAM(16);
    if (IN(17)) p17_final(F, args);
#undef IN
#undef SEAM
}

extern "C" void kernel_launch(void* const* d_in, const int* in_sizes, int n_in, void* d_out, int out_size, void* d_ws, size_t ws_size, hipStream_t stream) {
    static int grid = 0;
    if (grid == 0) {
        if (n_in != 35 || out_size != ML * D || ws_size < WS_END) { fprintf(stderr, "kernel_launch: unexpected problem (n_in %d, out %d, ws %zu < %zu); nothing launched\n", n_in, out_size, ws_size, (size_t)WS_END); grid = -1; return; }
        int dev = 0, cus = 0, per_cu = 0;
        if (hipGetDevice(&dev) != hipSuccess || hipDeviceGetAttribute(&cus, hipDeviceAttributeMultiprocessorCount, dev) != hipSuccess) { grid = -1; return; }
        if (hipFuncSetAttribute((const void*)trunk_fwd, hipFuncAttributeMaxDynamicSharedMemorySize, LDS_BYTES) != hipSuccess) { fprintf(stderr, "kernel_launch: hipFuncSetAttribute failed\n"); grid = -1; return; }
        if (hipOccupancyMaxActiveBlocksPerMultiprocessor(&per_cu, (const void*)trunk_fwd, 512, LDS_BYTES) != hipSuccess || per_cu < 1) fprintf(stderr, "kernel_launch: occupancy query reports %d\n", per_cu);
        (void)hipGetLastError();
        grid = cus;
    }
    if (grid < 0) return;
    if (hipMemsetAsync((char*)d_ws + WS_CTL, 0, CTL_ZERO_BYTES, stream) != hipSuccess) return;
    Args a{};
    for (int i = 0; i < 35; ++i) a.in[i] = (const float*)d_in[i];
    a.out = (float*)d_out; a.ws = (unsigned char*)d_ws;
#if defined(PROBE_DUP)
    a.ph_lo = 0; a.ph_hi = PROBE_DUP + 1; a.li = 0; hipLaunchKernelGGL(trunk_fwd, dim3(grid), dim3(512), LDS_BYTES, stream, a);
    a.ph_lo = PROBE_DUP; a.ph_hi = NPHASE; a.li = 1; hipLaunchKernelGGL(trunk_fwd, dim3(grid), dim3(512), LDS_BYTES, stream, a);
#else
    if (MK_N_LAUNCHES == 1) { a.ph_lo = 0; a.ph_hi = NPHASE; hipLaunchKernelGGL(trunk_fwd, dim3(grid), dim3(512), LDS_BYTES, stream, a); }
#endif
#if !defined(PROBE_DUP)
    else for (int p = 0; p < NPHASE; ++p) { a.ph_lo = p; a.ph_hi = p + 1; hipLaunchKernelGGL(trunk_fwd, dim3(grid), dim3(512), LDS_BYTES, stream, a); }
#endif
}
```
